# Optimizing an MI355X kernel written in HIP

```python
import jax, jax.numpy as jnp
from jax import lax
import numpy as np

D_MODEL = 1024
BATCH = 4
SEQ = 8192
DEPTH = 2

GRID_W = 64
NA_HEAD_DIM = 64
NA_WIDTH = D_MODEL // 2
NA_HEADS = NA_WIDTH // NA_HEAD_DIM
NA_WIN_ROWS = 8
NA_WIN_COLS = 16
LRU_WIDTH = D_MODEL // 2
LRU_BLOCKS = 8
LRU_BLOCK_W = LRU_WIDTH // LRU_BLOCKS
LRU_C = 8.0
CONV_W = 4
FNET_WIDTH = D_MODEL // 2
FNET_GROUPS = 4
FNET_GROUP_W = FNET_WIDTH // FNET_GROUPS
N_BRANCH = 3
IN_COLS = 3 * NA_WIDTH + 2 * LRU_WIDTH + FNET_WIDTH
N_EXPERTS = 32
N_EXPERT_GROUPS = 8
EXPERTS_PER_GROUP = N_EXPERTS // N_EXPERT_GROUPS
TOP_K = 2
D_EXPERT = D_MODEL // 2
MOE_BLOCK = 128
EPS = 1e-6

kernel_name = "hybrid_na_rglru_fnet_moe_encoder"


def rmsnorm(x, g):
    xf = x.astype(jnp.float32)
    y = xf * lax.rsqrt(jnp.mean(xf * xf, axis=-1, keepdims=True) + EPS)
    return (y * g.astype(jnp.float32)).astype(x.dtype)


def modulate(h, shift, scale):
    return h * (1.0 + scale[:, None, :]) + shift[:, None, :]


def neighbourhood_attention(q, k, v, rpb):
    B, T, H, dh = q.shape
    rows = T // GRID_W
    kr = min(NA_WIN_ROWS, rows)
    kc = NA_WIN_COLS
    qg = q.reshape(B, rows, GRID_W, H, dh)
    kg = k.reshape(B, rows, GRID_W, H, dh)
    vg = v.reshape(B, rows, GRID_W, H, dh)
    cols = jnp.arange(GRID_W)
    col_start = jnp.clip(cols - kc // 2, 0, GRID_W - kc)
    col_idx = col_start[:, None] + jnp.arange(kc)[None, :]
    col_bias_idx = col_idx - cols[:, None] + (NA_WIN_COLS - 1)
    scale = dh ** -0.5

    def row_block(r):
        rs = jnp.clip(r - kr // 2, 0, rows - kr)
        q_r = lax.dynamic_index_in_dim(qg, r, axis=1, keepdims=False)
        k_band = lax.dynamic_slice_in_dim(kg, rs, kr, axis=1)
        v_band = lax.dynamic_slice_in_dim(vg, rs, kr, axis=1)
        k_win = k_band[:, :, col_idx]
        v_win = v_band[:, :, col_idx]
        row_bias_idx = rs + jnp.arange(kr) - r + (NA_WIN_ROWS - 1)
        bias = rpb[:, row_bias_idx[:, None, None], col_bias_idx[None, :, :]]
        bias = bias.transpose(0, 2, 1, 3).astype(jnp.float32)
        s = jnp.einsum('bwhd,brwjhd->bhwrj', q_r, k_win).astype(jnp.float32) * scale + bias[None]
        p = jax.nn.softmax(s.reshape(B, H, GRID_W, kr * kc), axis=-1).reshape(B, H, GRID_W, kr, kc)
        return jnp.einsum('bhwrj,brwjhd->bwhd', p.astype(v.dtype), v_win)

    out = lax.map(row_block, jnp.arange(rows))
    return out.transpose(1, 0, 2, 3, 4).reshape(B, T, H * dh)


def centred_dwconv(x, w, b):
    T = x.shape[1]
    left = CONV_W // 2
    right = CONV_W - 1 - left
    xp = jnp.pad(x, ((0, 0), (left, right), (0, 0)))
    y = xp[:, 0:T] * w[0]
    for j in range(1, CONV_W):
        y = y + xp[:, j:j + T] * w[j]
    return y + b


def block_diag(x, w, b):
    B, T, _ = x.shape
    xb = x.reshape(B, T, LRU_BLOCKS, LRU_BLOCK_W)
    return jnp.einsum('btni,nij->btnj', xb, w).reshape(B, T, LRU_WIDTH) + b


def rglru_scan(x, w_r, b_r, w_i, b_i, lam, reverse):
    xf = x.astype(jnp.float32)
    r = jax.nn.sigmoid(block_diag(x, w_r, b_r).astype(jnp.float32))
    i = jax.nn.sigmoid(block_diag(x, w_i, b_i).astype(jnp.float32))
    log_a = -LRU_C * r * jax.nn.softplus(-lam.astype(jnp.float32))
    a = jnp.exp(log_a)
    bx = jnp.sqrt(-jnp.expm1(2.0 * log_a)) * (i * xf)

    def combine(c1, c2):
        a1, b1 = c1
        a2, b2 = c2
        return a1 * a2, a2 * b1 + b2

    _, h = lax.associative_scan(combine, (a, bx), reverse=reverse, axis=1)
    return h


def fourier_mix(f):
    B, T, _ = f.shape
    fg = f.astype(jnp.float32).reshape(B, T, FNET_GROUPS, FNET_GROUP_W)
    y = jnp.fft.fft2(fg, axes=(1, 3), norm='ortho').real
    return y.reshape(B, T, FNET_WIDTH).astype(f.dtype)


def route(u, w_router, router_bias):
    N = u.shape[0]
    scores = jax.nn.sigmoid(jnp.dot(u.astype(jnp.float32), w_router.astype(jnp.float32)))
    sel = scores + router_bias.astype(jnp.float32)
    sel_g = sel.reshape(N, N_EXPERT_GROUPS, EXPERTS_PER_GROUP)
    group_score = lax.top_k(sel_g, TOP_K)[0].sum(axis=-1)
    _, g_idx = lax.top_k(group_score, 1)
    cand = jnp.take_along_axis(sel_g, g_idx[:, :, None], axis=1)[:, 0]
    _, local = lax.top_k(cand, TOP_K)
    e_idx = g_idx * EXPERTS_PER_GROUP + local
    w = jnp.take_along_axis(scores, e_idx, axis=1)
    w = w / jnp.sum(w, axis=-1, keepdims=True)
    return e_idx, w


def moe_ffn(u, w_router, router_bias, w_gate, w_up, w_down):
    B, T, D = u.shape
    N = B * T
    uf = u.reshape(N, D)
    e_idx, gw = route(uf, w_router, router_bias)
    A = N * TOP_K
    flat_e = e_idx.reshape(A)
    flat_tok = jnp.repeat(jnp.arange(N, dtype=jnp.int32), TOP_K)
    flat_w = gw.reshape(A)
    order = jnp.argsort(flat_e)
    sorted_e = flat_e[order]
    counts = jnp.bincount(flat_e, length=N_EXPERTS)
    starts = jnp.cumsum(counts) - counts
    padded = (counts + MOE_BLOCK - 1) // MOE_BLOCK * MOE_BLOCK
    padded_end = jnp.cumsum(padded)
    padded_start = padded_end - padded
    dest = padded_start[sorted_e] + (jnp.arange(A) - starts[sorted_e])
    n_blocks = -(-(A + N_EXPERTS * (MOE_BLOCK - 1)) // MOE_BLOCK)
    P = n_blocks * MOE_BLOCK
    buf_tok = jnp.zeros((P,), jnp.int32).at[dest].set(flat_tok[order])
    buf_w = jnp.zeros((P,), jnp.float32).at[dest].set(flat_w[order])
    block_e = jnp.minimum(
        jnp.searchsorted(padded_end, jnp.arange(n_blocks) * MOE_BLOCK, side='right'), N_EXPERTS - 1)
    xb = uf[buf_tok].reshape(n_blocks, MOE_BLOCK, D)

    def expert_block(args):
        xblk, e = args
        h = jax.nn.silu(xblk @ w_gate[e]) * (xblk @ w_up[e])
        return h @ w_down[e]

    yb = lax.map(expert_block, (xb, block_e)).reshape(P, D)
    y = jax.ops.segment_sum(yb * buf_w[:, None].astype(yb.dtype), buf_tok, num_segments=N)
    return y.reshape(B, T, D)


def setup_inputs(seed: int = 0) -> dict:
    key = jax.random.key(seed)
    ks = jax.random.split(key, 32)
    L, D = DEPTH, D_MODEL
    f32 = jnp.float32

    def nrm(k, shape, fan_in, s=1.0):
        return jax.random.normal(k, shape, f32) * (s * fan_in ** -0.5)

    def small(k, shape, s=0.02):
        return jax.random.normal(k, shape, f32) * s

    u_lam = jax.random.uniform(ks[16], (L, 2, LRU_WIDTH), f32, minval=0.9, maxval=0.999)
    a_lam = u_lam ** (1.0 / LRU_C)
    lru_lambda = jnp.log(a_lam) - jnp.log1p(-a_lam)
    return {
        "x": jax.random.normal(ks[0], (BATCH, SEQ, D), f32),
        "c": jax.random.normal(ks[1], (BATCH, D), f32),
        "ada_w": nrm(ks[2], (L, D, 6 * D), D, 0.5),
        "ada_b": small(ks[3], (L, 6 * D)),
        "norm_mix_g": 1.0 + small(ks[4], (L, D), 0.05),
        "norm_ffn_g": 1.0 + small(ks[5], (L, D), 0.05),
        "w_in": nrm(ks[6], (L, D, IN_COLS), D),
        "w_branch_gate": nrm(ks[7], (L, D, N_BRANCH * D), D),
        "b_branch_gate": small(ks[8], (L, N_BRANCH * D)),
        "na_rpb": small(ks[9], (L, NA_HEADS, 2 * NA_WIN_ROWS - 1, 2 * NA_WIN_COLS - 1), 0.1),
        "lru_conv_w": nrm(ks[10], (L, CONV_W, LRU_WIDTH), CONV_W),
        "lru_conv_b": small(ks[11], (L, LRU_WIDTH)),
        "lru_w_r": nrm(ks[12], (L, 2, LRU_BLOCKS, LRU_BLOCK_W, LRU_BLOCK_W), LRU_BLOCK_W),
        "lru_b_r": small(ks[13], (L, 2, LRU_WIDTH)),
        "lru_w_i": nrm(ks[14], (L, 2, LRU_BLOCKS, LRU_BLOCK_W, LRU_BLOCK_W), LRU_BLOCK_W),
        "lru_b_i": small(ks[15], (L, 2, LRU_WIDTH)),
        "lru_lambda": lru_lambda,
        "w_proj_na": nrm(ks[17], (L, NA_WIDTH, D), NA_WIDTH),
        "w_proj_lru": nrm(ks[18], (L, LRU_WIDTH, D), LRU_WIDTH),
        "w_proj_fnet": nrm(ks[19], (L, FNET_WIDTH, D), FNET_WIDTH),
        "w_out": nrm(ks[20], (L, D, D), D),
        "w_router": nrm(ks[21], (D, N_EXPERTS), D),
        "router_bias": small(ks[22], (N_EXPERTS,), 0.01),
        "w_exp_gate": nrm(ks[23], (L, N_EXPERTS, D, D_EXPERT), D),
        "w_exp_up": nrm(ks[24], (L, N_EXPERTS, D, D_EXPERT), D),
        "w_exp_down": nrm(ks[25], (L, N_EXPERTS, D_EXPERT, D), D_EXPERT),
        "final_g": 1.0 + small(ks[26], (D,), 0.05),
    }


def reference(x, c, ada_w, ada_b, norm_mix_g, norm_ffn_g, w_in, w_branch_gate, b_branch_gate,
              na_rpb, lru_conv_w, lru_conv_b, lru_w_r, lru_b_r, lru_w_i, lru_b_i, lru_lambda,
              w_proj_na, w_proj_lru, w_proj_fnet, w_out, w_router, router_bias,
              w_exp_gate, w_exp_up, w_exp_down, final_g):
    B, T, D = x.shape
    c_act = jax.nn.silu(c)
    splits = [NA_WIDTH, 2 * NA_WIDTH, 3 * NA_WIDTH, 3 * NA_WIDTH + LRU_WIDTH, 3 * NA_WIDTH + 2 * LRU_WIDTH]
    for l in range(DEPTH):
        mod = c_act @ ada_w[l] + ada_b[l]
        sh_mix, sc_mix, gt_mix, sh_ffn, sc_ffn, gt_ffn = jnp.split(mod, 6, axis=-1)

        u = modulate(rmsnorm(x, norm_mix_g[l]), sh_mix, sc_mix)
        proj = u @ w_in[l]
        q, k, v, xr, yr, fr = jnp.split(proj, splits, axis=-1)

        hs = (B, T, NA_HEADS, NA_HEAD_DIM)
        y_na = neighbourhood_attention(q.reshape(hs), k.reshape(hs), v.reshape(hs), na_rpb[l])

        xc = centred_dwconv(xr, lru_conv_w[l], lru_conv_b[l])
        h = (rglru_scan(xc, lru_w_r[l, 0], lru_b_r[l, 0], lru_w_i[l, 0], lru_b_i[l, 0], lru_lambda[l, 0], False)
             + rglru_scan(xc, lru_w_r[l, 1], lru_b_r[l, 1], lru_w_i[l, 1], lru_b_i[l, 1], lru_lambda[l, 1], True))
        y_lru = (h * jax.nn.gelu(yr.astype(jnp.float32))).astype(x.dtype)

        y_f = fourier_mix(fr)

        gates = jax.nn.sigmoid(u @ w_branch_gate[l] + b_branch_gate[l])
        g_na, g_lru, g_f = jnp.split(gates, N_BRANCH, axis=-1)
        merged = (g_na * (y_na @ w_proj_na[l])
                  + g_lru * (y_lru @ w_proj_lru[l])
                  + g_f * (y_f @ w_proj_fnet[l]))
        x = x + gt_mix[:, None, :] * (merged @ w_out[l])

        u2 = modulate(rmsnorm(x, norm_ffn_g[l]), sh_ffn, sc_ffn)
        x = x + gt_ffn[:, None, :] * moe_ffn(u2, w_router, router_bias, w_exp_gate[l], w_exp_up[l], w_exp_down[l])
    return rmsnorm(x, final_g)
```

```cpp
#include <hip/hip_runtime.h>
#include <cstdio>
#include <cstdint>
namespace pg8 {
#define PG8_LAS __attribute__((address_space(3)))
typedef unsigned short bf16_t;
typedef short bf16x8 __attribute__((ext_vector_type(8)));
typedef float f32x4 __attribute__((ext_vector_type(4)));
typedef unsigned u32x4 __attribute__((ext_vector_type(4)));
typedef unsigned u32x2 __attribute__((ext_vector_type(2)));
constexpr int BM = 256, BK = 64, HALF = 128, HTB = HALF * BK * 2  , STAGE_BYTES = 8 * HTB, NXCD = 8, WGM = 8;

__host__ __device__ __forceinline__ int lds_byte(int r, int c) { const int st = (r >> 4) * 2 + (c >> 5), rr = r & 15, cc = c & 31, ob = rr * 64 + cc * 2; return st * 1024 + (ob ^ (((ob >> 9) & 1) << 5)); }
__host__ __device__ __forceinline__ void stage_rc(int b, int& R, int& C) { const int st = b / 1024, sb = b % 1024, swz = sb ^ (((sb >> 9) & 1) << 5); R = (st >> 1) * 16 + swz / 64; C = (st & 1) * 32 + (swz % 64) / 2; }
__host__ __device__ __forceinline__ int perm32(int rho) { const int n = rho >> 4, i = rho & 15; return 8 * (i >> 2) + 4 * n + (i & 3); }

struct Unit { int pm, pn, bt, z; };
struct Gemm { const bf16_t* A0; const bf16_t* A1; const bf16_t* A2; const bf16_t* B0; const bf16_t* B1; const bf16_t* B2; int lda, ldb, K; };

__device__ __forceinline__ unsigned cvt_pk_bf16(float lo, float hi) { unsigned r; asm volatile("v_cvt_pk_bf16_f32 %0, %1, %2" : "=v"(r) : "v"(lo), "v"(hi)); return r; }

struct StaticOrder {
    int nM, nN, nwg, G, c;
    __device__ void init(int M, int N, int G_, int c_) { nM = M / BM; nN = N / BM; nwg = nM * nN; G = G_; c = c_; }
    __device__ __forceinline__ bool tile(long L, Unit& u) const {
        if (L >= nwg) return false;
        int wgid = (int)L; { const int q = nwg / NXCD, r = nwg % NXCD, xcd = wgid % NXCD, off = wgid / NXCD; wgid = (xcd < r ? xcd * (q + 1) : r * (q + 1) + (xcd - r) * q) + off; }
        const int nig = WGM * nN, gid = wgid / nig, fm = gid * WGM, gsz = (nM - fm) < WGM ? (nM - fm) : WGM;
        u.pm = fm + ((wgid % nig) % gsz); u.pn = (wgid % nig) / gsz; u.bt = u.pn; u.z = 0; return true;
    }
    __device__ __forceinline__ bool next(int i, Unit& u) const { return tile((long)i * G + c, u); }
};
struct MergeOrder : StaticOrder {
    __device__ __forceinline__ bool next(int i, Unit& u) const { const int t = i / 3; if (!tile((long)t * G + c, u)) return false; u.z = i - 3 * t; return true; }
};
struct MoeOrder {
    const PG8_LAS int* tb; int G, c;
    __device__ __forceinline__ bool next(int i, Unit& u) const {
        const int L = i * G + c; const int nt = tb[32]; if (L >= nt * 4) return false;
        const int t = L >> 2, j = L & 3; int e = 0;
#pragma unroll 1
        for (int k = 1; k < 32; ++k) e += (tb[k] <= t) ? 1 : 0;
        u.pm = t; u.pn = j; u.bt = e * 4 + j; u.z = 0; return true;
    }
};

template <class Epi, class Sched, bool ALIGN_EPI>
__device__ __forceinline__ void gemm_phase(PG8_LAS unsigned char* lds, const Gemm g, const Sched& S, const Epi& E, const int tid) {
    const int wid = __builtin_amdgcn_readfirstlane(tid >> 6), lane = tid & 63, wr = wid >> 2, wc = wid & 3, fr = lane & 15, fq = lane >> 4;
    const int K = g.K, nt = K / BK;
    unsigned voffA[2], voffB[2];
#pragma unroll
    for (int i = 0; i < 2; ++i) { int R, C; stage_rc(tid * 16 + i * 8192, R, C); const int Rb = Epi::PERM ? ((R & ~31) + perm32(R & 31)) : R;
        voffA[i] = (unsigned)(R * g.lda + C) * 2u; voffB[i] = (unsigned)(Rb * g.ldb + C) * 2u; }
    const size_t kstep = (size_t)(BK * 2);
    const size_t hstepA = (size_t)HALF * g.lda * 2, hstepB = (size_t)HALF * g.ldb * 2;
    const size_t tstepA = 2 * hstepA, tstepB = 2 * hstepB;
    const unsigned ldsw = (unsigned)wid * 1024u;
    const int aoff = lds_byte(wr * 64 + fr, fq * 8), boff = lds_byte(wc * 32 + fr, fq * 8);
#define PG8_SA(b, h) (((b) * 2 + (h)) * HTB)
#define PG8_SB(b, h) ((4 + (b) * 2 + (h)) * HTB)
#define PG8_STAGE(bufoff, gbase, voff) do { _Pragma("unroll") for (int _i = 0; _i < 2; ++_i) \
        __builtin_amdgcn_global_load_lds((const unsigned*)((const char*)(gbase) + (voff)[_i]), (PG8_LAS unsigned*)(lds + (bufoff) + ldsw + _i * 8192), 16, 0, 0); } while (0)
#define PG8_LDA(dst, b, h) do { _Pragma("unroll") for (int m = 0; m < 4; ++m) _Pragma("unroll") for (int k = 0; k < 2; ++k) dst[m][k] = *(const PG8_LAS bf16x8*)(lds + PG8_SA(b, h) + aoff + m * 2048 + k * 1024); } while (0)
#define PG8_LDB(dst, b, h) do { _Pragma("unroll") for (int n = 0; n < 2; ++n) _Pragma("unroll") for (int k = 0; k < 2; ++k) dst[n][k] = *(const PG8_LAS bf16x8*)(lds + PG8_SB(b, h) + boff + n * 2048 + k * 1024); } while (0)
#define PG8_MMA(ai, bj, At, Bt) do { __builtin_amdgcn_s_setprio(1); _Pragma("unroll") for (int m = 0; m < 4; ++m) _Pragma("unroll") for (int n = 0; n < 2; ++n) _Pragma("unroll") for (int k = 0; k < 2; ++k) \
        acc[ai][bj][m][n] = __builtin_amdgcn_mfma_f32_16x16x32_bf16(Bt[n][k], At[m][k], acc[ai][bj][m][n], 0, 0, 0); __builtin_amdgcn_s_setprio(0); } while (0)
#define PG8_WAIT_V(n) asm volatile("s_waitcnt vmcnt(" #n ")" ::: "memory")
#define PG8_WAIT_L(n) asm volatile("s_waitcnt lgkmcnt(" #n ")" ::: "memory")
#define PG8_BAR __builtin_amdgcn_s_barrier()
#define PG8_SCHED __builtin_amdgcn_sched_barrier(0)
#define PG8_APTR(u) ((const char*)((u).z == 0 ? g.A0 : ((u).z == 1 ? g.A1 : g.A2)) + (size_t)(u).pm * tstepA)
#define PG8_BPTR(u) ((const char*)((u).z == 0 ? g.B0 : ((u).z == 1 ? g.B1 : g.B2)) + (size_t)(u).bt * tstepB)
    Unit cur, nxt; int ui = 0;
    if (!S.next(0, cur)) return;
    f32x4 acc[2][2][4][2];
#pragma unroll
    for (int a = 0; a < 2; ++a)
#pragma unroll
        for (int b = 0; b < 2; ++b)
#pragma unroll
            for (int m = 0; m < 4; ++m)
#pragma unroll
                for (int n = 0; n < 2; ++n) acc[a][b][m][n] = (f32x4){0.f, 0.f, 0.f, 0.f};
    bf16x8 At[4][2], B0[2][2], B1[2][2];
    const char* cA = PG8_APTR(cur); const char* cB = PG8_BPTR(cur);
    PG8_STAGE(PG8_SB(0, 0), cB, voffB); PG8_STAGE(PG8_SB(0, 1), cB + hstepB, voffB); PG8_STAGE(PG8_SA(0, 0), cA, voffA); PG8_STAGE(PG8_SA(0, 1), cA + hstepA, voffA);
    if (wr == 1) PG8_BAR;
    PG8_WAIT_V(2); PG8_BAR;
    PG8_STAGE(PG8_SB(1, 0), cB + kstep, voffB); PG8_STAGE(PG8_SA(1, 0), cA + kstep, voffA); PG8_STAGE(PG8_SB(1, 1), cB + hstepB + kstep, voffB);
    PG8_WAIT_V(6); PG8_BAR;
    for (;;) {
        const bool has_next = S.next(ui + 1, nxt);
        const char* nA = has_next ? PG8_APTR(nxt) : cA; const char* nB = has_next ? PG8_BPTR(nxt) : cB;
        for (int t = 0; t < nt; t += 2) {
            const bool last = (t == nt - 2);
            const char* a1 = cA + (size_t)(t + 1) * kstep;
            const char* a2 = last ? nA : cA + (size_t)(t + 2) * kstep; const char* b2 = last ? nB : cB + (size_t)(t + 2) * kstep;
            const char* a3 = a2 + kstep; const char* b3 = b2 + kstep;
            PG8_LDB(B0, 0, 0); PG8_LDB(B1, 0, 1); PG8_SCHED; PG8_LDA(At, 0, 0); PG8_STAGE(PG8_SA(1, 1), a1 + hstepA, voffA);
            PG8_WAIT_V(8); PG8_WAIT_L(0); PG8_BAR; PG8_MMA(0, 0, At, B0); PG8_MMA(0, 1, At, B1); PG8_BAR; PG8_SCHED;
            PG8_LDA(At, 0, 1); PG8_STAGE(PG8_SB(0, 0), b2, voffB); PG8_STAGE(PG8_SB(0, 1), b2 + hstepB, voffB); PG8_STAGE(PG8_SA(0, 0), a2, voffA);
            PG8_WAIT_V(8); PG8_WAIT_L(0); PG8_BAR; PG8_MMA(1, 0, At, B0); PG8_MMA(1, 1, At, B1); PG8_BAR; PG8_SCHED;
            PG8_LDB(B0, 1, 0); PG8_LDB(B1, 1, 1); PG8_SCHED; PG8_LDA(At, 1, 0); PG8_STAGE(PG8_SA(0, 1), a2 + hstepA, voffA);
            PG8_WAIT_V(8); PG8_WAIT_L(0); PG8_BAR; PG8_MMA(0, 0, At, B0); PG8_MMA(0, 1, At, B1); PG8_BAR; PG8_SCHED;
            PG8_LDA(At, 1, 1); PG8_STAGE(PG8_SB(1, 0), b3, voffB); PG8_STAGE(PG8_SB(1, 1), b3 + hstepB, voffB); PG8_STAGE(PG8_SA(1, 0), a3, voffA);
            PG8_WAIT_V(8); PG8_WAIT_L(0); PG8_BAR; PG8_MMA(1, 0, At, B0); PG8_MMA(1, 1, At, B1); PG8_BAR; PG8_SCHED;
        }
        if constexpr (ALIGN_EPI) { if (wr == 0) PG8_BAR; }
        E(acc, cur, wr, wc, fr, fq);
        if (!has_next) break;
#pragma unroll
        for (int a = 0; a < 2; ++a)
#pragma unroll
            for (int b = 0; b < 2; ++b)
#pragma unroll
                for (int m = 0; m < 4; ++m)
#pragma unroll
                    for (int n = 0; n < 2; ++n) acc[a][b][m][n] = (f32x4){0.f, 0.f, 0.f, 0.f};
        cur = nxt; cA = nA; cB = nB; ++ui;
        if constexpr (ALIGN_EPI) { if (wr == 1) PG8_BAR; }
    }
    PG8_WAIT_V(0);
    if constexpr (!ALIGN_EPI) { if (wr == 0) PG8_BAR; }
    PG8_BAR;
#undef PG8_SA
#undef PG8_SB
#undef PG8_STAGE
#undef PG8_LDA
#undef PG8_LDB
#undef PG8_MMA
#undef PG8_WAIT_V
#undef PG8_WAIT_L
#undef PG8_BAR
#undef PG8_SCHED
#undef PG8_APTR
#undef PG8_BPTR
}
}
constexpr int NWAVES = 8;
constexpr int NB = 4, T = 8192, D = 1024, NTOK = NB * T, DEPTH = 2;
constexpr int PROJ_LD = 3072, Q_OFF = 0, K_OFF = 512, XR_OFF = 1024, YR_OFF = 1536, G_OFF = 2048;
constexpr int GATES_LD = 3072;
constexpr int NP2 = 6656;
constexpr int NEXP = 32, XS_ROWS = 73728;
constexpr int LRU_CH = 32, LRU_NCH = T / LRU_CH;
constexpr float EPS = 1e-6f;

constexpr size_t MiB = 1u << 20;
constexpr size_t WS_CTL = 0, CTL_ZERO_BYTES = 1 * MiB;
constexpr size_t WS_MOD = 1 * MiB;
constexpr size_t WS_FA = WS_MOD + 256 * 1024;
constexpr size_t WS_FB = WS_FA + 32 * 1024;
constexpr size_t WS_TW = WS_FB + 64 * 1024;
constexpr size_t WS_WL = 2 * MiB;
constexpr size_t WS_TOKW = 3 * MiB;
constexpr size_t WS_TOKROW = WS_TOKW + 256 * 1024;
constexpr size_t WS_PERM = 4 * MiB;
constexpr size_t WS_LSUM = 8 * MiB;
constexpr size_t WS_LCAR = 16 * MiB;
constexpr size_t WS_WP2 = 20 * MiB;
constexpr size_t WS_WPROJ = 46 * MiB;
constexpr size_t WS_WOUT = 52 * MiB;
constexpr size_t WS_U = 56 * MiB;
constexpr size_t WS_VT = 120 * MiB;
constexpr size_t WS_PROJ = 152 * MiB;
constexpr size_t WS_GATES = 344 * MiB;
constexpr size_t WS_WG1 = WS_GATES, WS_WD = WS_GATES + 64 * MiB, WS_H = WS_GATES + 96 * MiB;
constexpr size_t WS_END = 536 * MiB;
static_assert(WS_H + (size_t)XS_ROWS * 512 * 2 <= WS_END, "ws map");
constexpr int CW_BAR = 4096;
constexpr int CW_ECNT = 16384;

constexpr int RING_OFF = 0, RING_BYTES = 131072;
constexpr int LDSCTL_OFF = RING_BYTES, MISC_OFF = LDSCTL_OFF + 64;
constexpr int XTRA_OFF = MISC_OFF + 384;
constexpr int LDS_BYTES = 147456;

#define GAS __attribute__((address_space(1)))
#define LAS __attribute__((address_space(3)))
typedef unsigned short bf16;
typedef unsigned v4u __attribute__((ext_vector_type(4)));
typedef unsigned v2u __attribute__((ext_vector_type(2)));
typedef float f32x4 __attribute__((ext_vector_type(4)));
typedef float f32x2 __attribute__((ext_vector_type(2)));
typedef float f32x16 __attribute__((ext_vector_type(16)));
typedef short bf16x8 __attribute__((ext_vector_type(8)));
typedef short bf16x4 __attribute__((ext_vector_type(4)));
typedef GAS unsigned gu32;
#define RLX_AGENT __ATOMIC_RELAXED, __HIP_MEMORY_SCOPE_AGENT
#define LDS_WAIT() asm volatile("s_waitcnt lgkmcnt(0)" ::: "memory")
#define VM_WAIT() asm volatile("s_waitcnt vmcnt(0)" ::: "memory")
__device__ __forceinline__ unsigned f2bf(float f) { unsigned u = __builtin_bit_cast(unsigned, f); return (u + 0x7fffu + ((u >> 16) & 1u)) >> 16; }
__device__ __forceinline__ unsigned pk2(float lo, float hi) { return f2bf(lo) | (f2bf(hi) << 16); }
__device__ __forceinline__ float bflo(unsigned w) { return __builtin_bit_cast(float, w << 16); }
__device__ __forceinline__ float bfhi(unsigned w) { return __builtin_bit_cast(float, w & 0xffff0000u); }
__device__ __forceinline__ float bf2f(unsigned short h) { return __builtin_bit_cast(float, (unsigned)h << 16); }
__device__ __forceinline__ float sigmoidf(float v) { return 1.0f / (1.0f + __expf(-v)); }
__device__ __forceinline__ float wave_sum(float v) {
#pragma unroll
    for (int o = 1; o < 64; o <<= 1) v += __shfl_xor(v, o);
    return v;
}
#define XB_TMO      128
#define XB_XCNT(j)  (256  + 64 * (j))
#define XB_XSUB(j)  (1280 + 64 * (j))
#define XB_XGEN(j)  (2304 + 64 * (j))
#define XB_TOP      3328
#define XB_TOPGEN   3392
#define XCD_BAR_WORDS 3456
#define XB_SPIN_CAP (1u << 18)

__device__ __forceinline__ unsigned xb_ld(unsigned* p)              { return __hip_atomic_load(p, __ATOMIC_RELAXED, __HIP_MEMORY_SCOPE_AGENT); }
__device__ __forceinline__ unsigned xb_add(unsigned* p, unsigned v) { return __hip_atomic_fetch_add(p, v, __ATOMIC_RELAXED, __HIP_MEMORY_SCOPE_AGENT); }
__device__ __forceinline__ unsigned xb_xcc_id() { return (unsigned)__builtin_amdgcn_s_getreg((3 << 11) | 20) & 0xFu; }
#define XB_SPIN(cond, bar) do { unsigned _sp = 0; while (cond) { __builtin_amdgcn_s_sleep(1); \
    if ((++_sp & 255u) == 0u) { if (xb_ld(&(bar)[XB_TMO])) break; if (_sp > XB_SPIN_CAP) { atomicAdd(&(bar)[XB_TMO], 1u); break; } } } } while (0)

struct XcdBarrier {
    unsigned* bar; unsigned x;
    volatile LAS unsigned* st;
};

__device__ __forceinline__ XcdBarrier xcd_barrier_post(unsigned* bar, volatile LAS unsigned* st) {
    XcdBarrier b; b.bar = bar; b.x = xb_xcc_id(); b.st = st;
    if (threadIdx.x == 0) (void)xb_add(&bar[XB_XCNT(b.x)], 1u);
    return b;
}
__device__ __forceinline__ void xcd_barrier_complete(unsigned* bar, unsigned x, unsigned& nloc, unsigned& nx) {
    const unsigned G = gridDim.x * gridDim.y * gridDim.z;
    unsigned sum, cnt, mine, sp = 0u;
    for (;;) {
        sum = 0u; cnt = 0u; mine = 0u;
#pragma unroll
        for (unsigned j = 0; j < 16; ++j) { const unsigned c = xb_ld(&bar[XB_XCNT(j)]); sum += c; cnt += (c > 0u) ? 1u : 0u; mine = (j == x) ? c : mine; }
        if (sum == G) break;
        __builtin_amdgcn_s_sleep(1);
        if ((++sp & 255u) == 0u) { if (xb_ld(&bar[XB_TMO])) break; if (sp > XB_SPIN_CAP) { atomicAdd(&bar[XB_TMO], 1u); break; } }
    }
    nloc = mine > 0u ? mine : 1u; nx = cnt > 0u ? cnt : 1u;
}

__device__ __forceinline__ void xcd_barrier(const XcdBarrier& b) {
    asm volatile("s_waitcnt vmcnt(0)" ::: "memory");
    __syncthreads();
    if (threadIdx.x == 0) {
        unsigned* bar = b.bar;
        __builtin_amdgcn_s_waitcnt(0);
        unsigned nloc = b.st[0], nx = b.st[1];
        if (nloc == 0u) { xcd_barrier_complete(bar, b.x, nloc, nx); b.st[0] = nloc; b.st[1] = nx; }
        const unsigned old = xb_add(&bar[XB_XSUB(b.x)], 1u);
        const unsigned gen = old / nloc;
        if (old + 1u == (gen + 1u) * nloc) {
            __builtin_amdgcn_fence(__ATOMIC_RELEASE, "agent");
            asm volatile("s_waitcnt vmcnt(0)" ::: "memory");
            const unsigned og = xb_add(&bar[XB_TOP], 1u);
            const unsigned tg = og / nx;
            if (og + 1u == (tg + 1u) * nx) xb_add(&bar[XB_TOPGEN], 1u);
            else XB_SPIN(xb_ld(&bar[XB_TOPGEN]) == tg, bar);
            __builtin_amdgcn_fence(__ATOMIC_ACQUIRE, "agent");
            xb_add(&bar[XB_XGEN(b.x)], 1u);
            asm volatile("s_waitcnt vmcnt(0)" ::: "memory");
        } else {
            XB_SPIN(xb_ld(&bar[XB_XGEN(b.x)]) == gen, bar);
            __builtin_amdgcn_fence(__ATOMIC_ACQUIRE, "agent");
            asm volatile("s_waitcnt vmcnt(0)" ::: "memory");
        }
    }
    __syncthreads();
}

struct Args { const float* in[27]; float* out; unsigned char* ws; int ph_lo, ph_hi; };
struct Frame {
    LAS unsigned char* lds;
    volatile LAS unsigned* MISC;
    gu32* ctl;
    int tid, lane, wave, vcu, G;
};
__device__ __forceinline__ Frame fresh(const Frame& F) {
    Frame N = F; int t = F.tid; asm volatile("" : "+v"(t)); N.tid = t; N.lane = t & 63; N.wave = __builtin_amdgcn_readfirstlane(t >> 6);
    int v = F.vcu; asm volatile("" : "+s"(v)); N.vcu = v; int g = F.G; asm volatile("" : "+s"(g)); N.G = g; return N;
}
#define WSP(T_, off) ((T_*)(args.ws + (off)))
#define INP(i) (args.in[i])

__device__ __forceinline__ void transpose_item(const float* W, int ldw, int k0, int n0, bf16* dst, int ldd, LAS float* scr, int lane) {
#pragma unroll 8
    for (int i = 0; i < 32; ++i) { const int kk = 2 * i + (lane >> 5); scr[kk * 33 + (lane & 31)] = W[(size_t)(k0 + kk) * ldw + n0 + (lane & 31)]; }
    LDS_WAIT(); asm volatile("" ::: "memory");
    const int c = lane & 7;
#pragma unroll
    for (int j = 0; j < 4; ++j) { const int n = (lane >> 3) + 8 * j; const LAS float* s = scr + (8 * c) * 33 + n;
        v4u o; o.x = pk2(s[0 * 33], s[1 * 33]); o.y = pk2(s[2 * 33], s[3 * 33]); o.z = pk2(s[4 * 33], s[5 * 33]); o.w = pk2(s[6 * 33], s[7 * 33]);
        *(v4u*)(dst + (size_t)n * ldd + k0 + 8 * c) = o; }
    LDS_WAIT(); asm volatile("" ::: "memory");
}

__device__ __forceinline__ void p0_prologue(const Frame& F0, const Args& args) {
    const Frame F = fresh(F0);
    const int tid = F.tid, lane = F.lane, wave = F.wave;
    float* MOD = WSP(float, WS_MOD);
    {
        LAS f32x4* cact4 = (LAS f32x4*)(F.lds + RING_OFF);
        LAS float* red = (LAS float*)(F.lds + RING_OFF + 16384);
        if (F.vcu < 192) {
            const float* c = INP(1);
            for (int i = 0; i < 8; ++i) { const int idx = tid + 512 * i, b = idx >> 10, k = idx & 1023; const float v = c[b * 1024 + k]; ((LAS float*)cact4)[k * 4 + b] = v * sigmoidf(v); }
        }
        __syncthreads();
        for (int u = F.vcu; u < 192; u += F.G) {
            const int l = u / 96, j0 = (u % 96) * 64;
            const float* aw = INP(2) + (size_t)l * 1024 * 6144 + j0 + lane;
            float a0 = 0.f, a1 = 0.f, a2 = 0.f, a3 = 0.f;
#pragma unroll 8
            for (int kk = 0; kk < 128; ++kk) { const int k = 128 * wave + kk; const float wv = aw[(size_t)k * 6144]; const f32x4 c4 = cact4[k]; a0 += c4.x * wv; a1 += c4.y * wv; a2 += c4.z * wv; a3 += c4.w * wv; }
            red[(wave * 4 + 0) * 64 + lane] = a0; red[(wave * 4 + 1) * 64 + lane] = a1; red[(wave * 4 + 2) * 64 + lane] = a2; red[(wave * 4 + 3) * 64 + lane] = a3;
            __syncthreads();
            if (tid < 256) { const int b = tid >> 6, ln = tid & 63; float s = INP(3)[l * 6144 + j0 + ln];
#pragma unroll
                for (int w = 0; w < 8; ++w) s += red[(w * 4 + b) * 64 + ln];
                MOD[(size_t)(l * 4 + b) * 6144 + j0 + ln] = s; }
            __syncthreads();
        }
    }
    {
        LAS float* Tt = (LAS float*)(F.lds + RING_OFF);
        LAS float* cs = (LAS float*)(F.lds + RING_OFF + 33792);
        LAS float* sn = cs + 128;
        if (tid < 128) { cs[tid] = cospif((float)tid * (1.0f / 64.0f)); sn[tid] = sinpif((float)tid * (1.0f / 64.0f)); }
        for (int it = F.vcu; it < 128; it += F.G) {
            const int l = it >> 6, g = (it >> 4) & 3, k0 = (it & 15) * 64;
            const float* src = INP(6) + (size_t)l * 1024 * 3072 + 2560 + g * 128;
            __syncthreads();
            for (int i = 0; i < 16; ++i) { const int idx = tid + 512 * i, row = idx >> 7, cc = idx & 127; Tt[row * 129 + cc] = src[(size_t)(k0 + row) * 3072 + cc]; }
            __syncthreads();
            const int kk = tid & 63, og = wave, part = og >> 2, m0 = (og & 3) * 32;
            float acc[32];
#pragma unroll
            for (int i = 0; i < 32; ++i) acc[i] = 0.f;
            const LAS float* tab = part ? sn : cs;
#pragma unroll 2
            for (int cc = 0; cc < 128; ++cc) { const float t = Tt[kk * 129 + cc];
#pragma unroll
                for (int i = 0; i < 32; ++i) acc[i] += t * tab[((m0 + i) * cc) & 127]; }
            bf16* dst = WSP(bf16, WS_WP2) + (size_t)l * NP2 * 1024 + (size_t)(2560 + part * 512 + g * 128 + m0) * 1024 + k0 + kk;
            const float sg = part ? -1.f : 1.f;
#pragma unroll
            for (int i = 0; i < 32; ++i) dst[(size_t)i * 1024] = (bf16)f2bf(sg * acc[i]);
        }
        __syncthreads();
    }
    {
        LAS float* scr = (LAS float*)(F.lds + RING_OFF + wave * 8704);
        const int gw = F.vcu * NWAVES + wave, NGW = F.G * NWAVES;
        for (int it = gw; it < 8192; it += NGW) {
            const int l = it >> 12; int r = it & 4095;
            if (r < 1280) { const int kb = r / 80, nb = r % 80; transpose_item(INP(6) + (size_t)l * 1024 * 3072, 3072, kb * 64, nb * 32, WSP(bf16, WS_WP2) + (size_t)l * NP2 * 1024 + (size_t)(nb * 32) * 1024, 1024, scr, lane); continue; }
            r -= 1280;
            if (r < 1536) { const int kb = r / 96, nb = r % 96; transpose_item(INP(7) + (size_t)l * 1024 * 3072, 3072, kb * 64, nb * 32, WSP(bf16, WS_WP2) + (size_t)l * NP2 * 1024 + (size_t)(3584 + nb * 32) * 1024, 1024, scr, lane); continue; }
            r -= 1536;
            if (r < 768) { const int which = r >> 8, rr = r & 255, kb = rr >> 5, nb = rr & 31; const float* src = (which == 0 ? INP(17) : (which == 1 ? INP(18) : INP(19))) + (size_t)l * 512 * 1024;
                transpose_item(src, 1024, kb * 64, nb * 32, WSP(bf16, WS_WPROJ) + (size_t)(l * 3 + which) * 1024 * 512 + (size_t)(nb * 32) * 512, 512, scr, lane); continue; }
            r -= 768;
            { const int kb = r >> 5, nb = r & 31; transpose_item(INP(20) + (size_t)l * 1024 * 1024, 1024, kb * 64, nb * 32, WSP(bf16, WS_WOUT) + (size_t)l * 1024 * 1024 + (size_t)(nb * 32) * 1024, 1024, scr, lane); }
        }
    }
    {
        const int gt = F.vcu * 512 + tid, NGT = F.G * 512;
        bf16* WL = WSP(bf16, WS_WL);
        for (int idx = gt; idx < 262144; idx += NGT) {
            const int k = idx & 63, n = (idx >> 6) & 255, nb = (idx >> 14) & 7, l = idx >> 17, gate = n >> 6, j = n & 63, dir = gate >> 1, isI = gate & 1;
            const float* src = isI ? INP(14) : INP(12);
            WL[idx] = (bf16)f2bf(src[((size_t)((l * 2 + dir) * 8 + nb) * 64 + k) * 64 + j]);
        }
        bf16* FA = WSP(bf16, WS_FA);
        for (int idx = gt; idx < 16384; idx += NGT) {
            const int m = idx >> 7, k = idx & 127, k1 = m & 63, pm_ = m >> 6, t1 = k & 63, pk = k >> 6, a = (k1 * t1) & 63;
            const float c = cospif((float)a * (1.0f / 32.0f)), s = sinpif((float)a * (1.0f / 32.0f));
            FA[idx] = (bf16)f2bf(pm_ == 0 ? (pk == 0 ? c : s) : (pk == 0 ? -s : c));
        }
        bf16* FB = WSP(bf16, WS_FB);
        for (int idx = gt; idx < 32768; idx += NGT) {
            const int k2 = idx >> 8, k = idx & 255, part = k >> 7, t2 = k & 127, a = (k2 * t2) & 127;
            FB[idx] = (bf16)f2bf(part == 0 ? cospif((float)a * (1.0f / 64.0f)) : sinpif((float)a * (1.0f / 64.0f)));
        }
        f32x2* TW = WSP(f32x2, WS_TW);
        for (int idx = gt; idx < 8192; idx += NGT) {
            const int t2 = idx >> 6, k1 = idx & 63; const float x = (float)(t2 * k1) * (1.0f / 4096.0f);
            TW[idx] = (f32x2){cospif(x), sinpif(x)};
        }
    }
}

template <int MODE>
__device__ __forceinline__ void rows_phase(const Frame& F0, const Args& args, int l) {
    const Frame F = fresh(F0);
    const int tid = F.tid, lane = F.lane, wave = F.wave;
    const float* MOD = WSP(float, WS_MOD);
    LAS float* gsc = (LAS float*)(F.lds + RING_OFF);
    LAS float* shf = gsc + 4096;
    LAS float* gtf = shf + 4096;
    for (int i = 0; i < 8; ++i) { const int idx = tid + 512 * i, b = idx >> 10, col = idx & 1023;
        if (MODE != 2) { gsc[idx] = INP(4)[l * 1024 + col] * (1.0f + MOD[(size_t)(l * 4 + b) * 6144 + 1024 + col]); shf[idx] = MOD[(size_t)(l * 4 + b) * 6144 + col]; }
        else gsc[idx] = INP(26)[col];
        if (MODE != 0) gtf[idx] = MOD[(size_t)((l - 1) * 4 + b) * 6144 + 5 * 1024 + col]; }
    __syncthreads();
    const float* xin = (MODE == 0) ? INP(0) : args.out;
    bf16* U = WSP(bf16, WS_U);
    const bf16* YE = WSP(bf16, WS_PROJ);
    const int* tokrow = WSP(int, WS_TOKROW); const float* tokw = WSP(float, WS_TOKW);
    const int gw = F.vcu * NWAVES + wave, NGW = F.G * NWAVES;
    for (int m = gw; m < NTOK; m += NGW) {
        const int b = m >> 13;
        const f32x4* xr = (const f32x4*)(xin + (size_t)m * D) + lane;
        f32x4 v[4];
#pragma unroll
        for (int j = 0; j < 4; ++j) v[j] = xr[64 * j];
        if (MODE != 0) {
            const int r0 = tokrow[2 * m], r1 = tokrow[2 * m + 1]; const float w0 = tokw[2 * m], w1 = tokw[2 * m + 1];
            const v2u* y0 = (const v2u*)(YE + (size_t)r0 * 1024) + lane; const v2u* y1 = (const v2u*)(YE + (size_t)r1 * 1024) + lane;
#pragma unroll
            for (int j = 0; j < 4; ++j) { const v2u a = y0[64 * j], c = y1[64 * j]; const f32x4 g = *(const LAS f32x4*)(gtf + b * 1024 + 4 * lane + 256 * j);
                v[j].x += g.x * (w0 * bflo(a.x) + w1 * bflo(c.x)); v[j].y += g.y * (w0 * bfhi(a.x) + w1 * bfhi(c.x));
                v[j].z += g.z * (w0 * bflo(a.y) + w1 * bflo(c.y)); v[j].w += g.w * (w0 * bfhi(a.y) + w1 * bfhi(c.y)); }
        }
        float ss = 0.f;
#pragma unroll
        for (int j = 0; j < 4; ++j) ss += (v[j].x * v[j].x + v[j].y * v[j].y) + (v[j].z * v[j].z + v[j].w * v[j].w);
        const float rstd = 1.0f / sqrtf(wave_sum(ss) * (1.0f / D) + EPS);
        if (MODE == 2) {
            f32x4* o = (f32x4*)(args.out + (size_t)m * D) + lane;
#pragma unroll
            for (int j = 0; j < 4; ++j) { const f32x4 g = *(const LAS f32x4*)(gsc + 4 * lane + 256 * j); o[64 * j] = v[j] * rstd * g; }
        } else {
            if (MODE == 1) { f32x4* o = (f32x4*)(args.out + (size_t)m * D) + lane;
#pragma unroll
                for (int j = 0; j < 4; ++j) o[64 * j] = v[j]; }
            v2u* uo = (v2u*)(U + (size_t)m * D) + lane;
#pragma unroll
            for (int j = 0; j < 4; ++j) { const f32x4 g = *(const LAS f32x4*)(gsc + b * 1024 + 4 * lane + 256 * j), s = *(const LAS f32x4*)(shf + b * 1024 + 4 * lane + 256 * j);
                const f32x4 u = v[j] * rstd * g + s; uo[64 * j] = (v2u){pk2(u.x, u.y), pk2(u.z, u.w)}; }
        }
    }
}

struct EpiP2 {
    static constexpr bool PERM = true;
    bf16* proj; bf16* vt; bf16* gates; const float* gbias;
    __device__ __forceinline__ void operator()(const f32x4 (&acc)[2][2][4][2], const pg8::Unit& u, int wr, int wc, int fr, int fq) const {
        const int row0 = u.pm * 256 + wr * 64 + fr, pn = u.pn;
        if (pn == 4 || pn == 5) {
#pragma unroll
            for (int ai = 0; ai < 2; ++ai)
#pragma unroll
                for (int m = 0; m < 4; ++m) { const int row = row0 + ai * 128 + m * 16, b = row >> 13, t = row & 8191;
#pragma unroll
                    for (int bj = 0; bj < 2; ++bj)
#pragma unroll
                        for (int n = 0; n < 2; ++n) { const int col = (pn - 4) * 256 + bj * 128 + wc * 32 + 8 * fq + 4 * n; bf16* d = vt + ((size_t)(b * 512 + col)) * 8192 + t;
                            d[0] = (bf16)f2bf(acc[ai][bj][m][n][0]); d[8192] = (bf16)f2bf(acc[ai][bj][m][n][1]); d[2 * 8192] = (bf16)f2bf(acc[ai][bj][m][n][2]); d[3 * 8192] = (bf16)f2bf(acc[ai][bj][m][n][3]); } }
        } else if (pn < 14) {
            const int cbase = (pn < 4 ? pn * 256 : (pn - 2) * 256) + wc * 32 + 8 * fq; const float sc = pn < 2 ? 0.125f : 1.0f;
#pragma unroll
            for (int ai = 0; ai < 2; ++ai)
#pragma unroll
                for (int m = 0; m < 4; ++m) { bf16* rowp = proj + (size_t)(row0 + ai * 128 + m * 16) * PROJ_LD + cbase;
#pragma unroll
                    for (int bj = 0; bj < 2; ++bj) { const f32x4 v0 = acc[ai][bj][m][0] * sc, v1 = acc[ai][bj][m][1] * sc;
                        *(v4u*)(rowp + bj * 128) = (v4u){pk2(v0[0], v0[1]), pk2(v0[2], v0[3]), pk2(v1[0], v1[1]), pk2(v1[2], v1[3])}; } }
        } else {
            const int cbase = (pn - 14) * 256 + wc * 32 + 8 * fq;
            f32x4 bv[2][2];
#pragma unroll
            for (int bj = 0; bj < 2; ++bj)
#pragma unroll
                for (int n = 0; n < 2; ++n) bv[bj][n] = *(const f32x4*)(gbias + cbase + bj * 128 + 4 * n);
#pragma unroll
            for (int ai = 0; ai < 2; ++ai)
#pragma unroll
                for (int m = 0; m < 4; ++m) { bf16* rowp = gates + (size_t)(row0 + ai * 128 + m * 16) * GATES_LD + cbase;
#pragma unroll
                    for (int bj = 0; bj < 2; ++bj) { f32x4 v0 = acc[ai][bj][m][0] + bv[bj][0], v1 = acc[ai][bj][m][1] + bv[bj][1];
#pragma unroll
                        for (int e = 0; e < 4; ++e) { v0[e] = sigmoidf(v0[e]); v1[e] = sigmoidf(v1[e]); }
                        *(v4u*)(rowp + bj * 128) = (v4u){pk2(v0[0], v0[1]), pk2(v0[2], v0[3]), pk2(v1[0], v1[1]), pk2(v1[2], v1[3])}; } }
        }
    }
};
struct EpiMerge {
    static constexpr bool PERM = true;
    const bf16* gates; bf16* merged;
    __device__ __forceinline__ void operator()(const f32x4 (&acc)[2][2][4][2], const pg8::Unit& u, int wr, int wc, int fr, int fq) const {
        const int row0 = u.pm * 256 + wr * 64 + fr, cbase = u.pn * 256 + wc * 32 + 8 * fq, z = u.z;
#pragma unroll
        for (int ai = 0; ai < 2; ++ai)
#pragma unroll
            for (int m = 0; m < 4; ++m) { const size_t row = (size_t)(row0 + ai * 128 + m * 16);
#pragma unroll
                for (int bj = 0; bj < 2; ++bj) { const v4u gv = *(const v4u*)(gates + row * GATES_LD + z * 1024 + cbase + bj * 128);
                    bf16* mp = merged + row * 1024 + cbase + bj * 128;
                    f32x4 v0 = acc[ai][bj][m][0], v1 = acc[ai][bj][m][1];
                    v0[0] *= bflo(gv.x); v0[1] *= bfhi(gv.x); v0[2] *= bflo(gv.y); v0[3] *= bfhi(gv.y); v1[0] *= bflo(gv.z); v1[1] *= bfhi(gv.z); v1[2] *= bflo(gv.w); v1[3] *= bfhi(gv.w);
                    if (z > 0) { const v4u ov = *(const v4u*)mp;
                        v0[0] += bflo(ov.x); v0[1] += bfhi(ov.x); v0[2] += bflo(ov.y); v0[3] += bfhi(ov.y); v1[0] += bflo(ov.z); v1[1] += bfhi(ov.z); v1[2] += bflo(ov.w); v1[3] += bfhi(ov.w); }
                    *(v4u*)mp = (v4u){pk2(v0[0], v0[1]), pk2(v0[2], v0[3]), pk2(v1[0], v1[1]), pk2(v1[2], v1[3])}; } }
    }
};
struct EpiResid {
    static constexpr bool PERM = false;
    const float* xin; float* xout; const float* gt;
    __device__ __forceinline__ void operator()(const f32x4 (&acc)[2][2][4][2], const pg8::Unit& u, int wr, int wc, int fr, int fq) const {
        const int row0 = u.pm * 256 + wr * 64 + fr, col0 = u.pn * 256 + wc * 32 + 4 * fq, b = (u.pm * 256) >> 13;
        f32x4 gv[2][2];
#pragma unroll
        for (int bj = 0; bj < 2; ++bj)
#pragma unroll
            for (int n = 0; n < 2; ++n) gv[bj][n] = *(const f32x4*)(gt + (size_t)b * 6144 + col0 + bj * 128 + n * 16);
#pragma unroll
        for (int ai = 0; ai < 2; ++ai)
#pragma unroll
            for (int m = 0; m < 4; ++m) { const size_t off = (size_t)(row0 + ai * 128 + m * 16) * D + col0;
#pragma unroll
                for (int bj = 0; bj < 2; ++bj)
#pragma unroll
                    for (int n = 0; n < 2; ++n) { const f32x4 xv = *(const f32x4*)(xin + off + bj * 128 + n * 16); *(f32x4*)(xout + off + bj * 128 + n * 16) = xv + gv[bj][n] * acc[ai][bj][m][n]; } }
    }
};
struct EpiSwiGLU {
    static constexpr bool PERM = true;
    bf16* H;
    __device__ __forceinline__ void operator()(const f32x4 (&acc)[2][2][4][2], const pg8::Unit& u, int wr, int wc, int fr, int fq) const {
        const int row0 = u.pm * 256 + wr * 64 + fr, cbase = u.pn * 128 + wc * 32 + 8 * fq;
#pragma unroll
        for (int ai = 0; ai < 2; ++ai)
#pragma unroll
            for (int m = 0; m < 4; ++m) { f32x4 h0, h1;
#pragma unroll
                for (int e = 0; e < 4; ++e) { const float g0 = acc[ai][0][m][0][e], g1 = acc[ai][0][m][1][e]; h0[e] = g0 * sigmoidf(g0) * acc[ai][1][m][0][e]; h1[e] = g1 * sigmoidf(g1) * acc[ai][1][m][1][e]; }
                *(v4u*)(H + (size_t)(row0 + ai * 128 + m * 16) * 512 + cbase) = (v4u){pk2(h0[0], h0[1]), pk2(h0[2], h0[3]), pk2(h1[0], h1[1]), pk2(h1[2], h1[3])}; }
    }
};
struct EpiYE {
    static constexpr bool PERM = true;
    bf16* YE;
    __device__ __forceinline__ void operator()(const f32x4 (&acc)[2][2][4][2], const pg8::Unit& u, int wr, int wc, int fr, int fq) const {
        const int row0 = u.pm * 256 + wr * 64 + fr, cbase = u.pn * 256 + wc * 32 + 8 * fq;
#pragma unroll
        for (int ai = 0; ai < 2; ++ai)
#pragma unroll
            for (int m = 0; m < 4; ++m) { bf16* rowp = YE + (size_t)(row0 + ai * 128 + m * 16) * 1024 + cbase;
#pragma unroll
                for (int bj = 0; bj < 2; ++bj) { const f32x4 v0 = acc[ai][bj][m][0], v1 = acc[ai][bj][m][1];
                    *(v4u*)(rowp + bj * 128) = (v4u){pk2(v0[0], v0[1]), pk2(v0[2], v0[3]), pk2(v1[0], v1[1]), pk2(v1[2], v1[3])}; } }
    }
};

__device__ __forceinline__ void attn_unit(bf16* PROJ, const bf16* VT, const LAS float* rpb, int b, int h, int r, int qb, int lane) {
    const int qn = lane & 15, g = lane >> 4;
    const int rs = min(max(r - 4, 0), 120);
    const int cb = (qb == 0) ? 0 : ((qb == 1) ? 8 : ((qb == 2) ? 24 : 32));
    const int w = 16 * qb + qn, cs = min(max(w - 8, 0), 48);
    const size_t tokq = (size_t)b * T + r * 64 + w;
    bf16* qp = PROJ + tokq * PROJ_LD + Q_OFF + h * 64;
    bf16x8 qf0 = *(const bf16x8*)(qp + 8 * g), qf1 = *(const bf16x8*)(qp + 32 + 8 * g);
    const bf16* kbase = PROJ + ((size_t)b * T + rs * 64 + cb + qn) * PROJ_LD + K_OFF + h * 64 + 8 * g;
    f32x4 sc[16];
#pragma unroll
    for (int kt = 0; kt < 16; ++kt) {
        const int kr = kt >> 1, ch = kt & 1;
        const bf16* kp = kbase + (size_t)(kr * 64 + 16 * ch) * PROJ_LD;
        const bf16x8 kf0 = *(const bf16x8*)kp, kf1 = *(const bf16x8*)(kp + 32);
        f32x4 a = (f32x4){0.f, 0.f, 0.f, 0.f};
        a = __builtin_amdgcn_mfma_f32_16x16x32_bf16(kf0, qf0, a, 0, 0, 0);
        a = __builtin_amdgcn_mfma_f32_16x16x32_bf16(kf1, qf1, a, 0, 0, 0);
        sc[kt] = a;
    }
    const LAS float* rp = rpb + h * 465;
    float mx = -1e30f;
#pragma unroll
    for (int kt = 0; kt < 16; ++kt) {
        const int kr = kt >> 1, ch = kt & 1;
        const int brow = (rs + kr - r + 7) * 31;
#pragma unroll
        for (int j = 0; j < 4; ++j) {
            const int kc = cb + 16 * ch + 4 * g + j, dc = kc - w + 15;
            const bool ok = (kc >= cs) && (kc <= cs + 15);
            const float bias = rp[brow + (ok ? dc : 15)];
            const float s = ok ? sc[kt][j] + bias : -1e30f;
            sc[kt][j] = s; mx = fmaxf(mx, s);
        }
    }
    mx = fmaxf(mx, __shfl_xor(mx, 16)); mx = fmaxf(mx, __shfl_xor(mx, 32));
    float sum = 0.f;
#pragma unroll
    for (int kt = 0; kt < 16; ++kt)
#pragma unroll
        for (int j = 0; j < 4; ++j) { const float p = __expf(sc[kt][j] - mx); sc[kt][j] = p; sum += p; }
    sum += __shfl_xor(sum, 16); sum += __shfl_xor(sum, 32);
    const float inv = 1.0f / sum;
    f32x4 o[4];
#pragma unroll
    for (int dt = 0; dt < 4; ++dt) o[dt] = (f32x4){0.f, 0.f, 0.f, 0.f};
    const bf16* vbase = VT + ((size_t)(b * 512 + h * 64 + qn)) * T + rs * 64 + cb + 4 * g;
#pragma unroll
    for (int kr = 0; kr < 8; ++kr) {
        v4u pw; pw.x = pk2(sc[2 * kr][0], sc[2 * kr][1]); pw.y = pk2(sc[2 * kr][2], sc[2 * kr][3]); pw.z = pk2(sc[2 * kr + 1][0], sc[2 * kr + 1][1]); pw.w = pk2(sc[2 * kr + 1][2], sc[2 * kr + 1][3]);
        const bf16x8 pf = __builtin_bit_cast(bf16x8, pw);
#pragma unroll
        for (int dt = 0; dt < 4; ++dt) {
            const bf16* vp = vbase + (size_t)(16 * dt) * T + kr * 64;
            const v2u lo = *(const v2u*)vp, hi = *(const v2u*)(vp + 16);
            const v4u vw = (v4u){lo.x, lo.y, hi.x, hi.y};
            o[dt] = __builtin_amdgcn_mfma_f32_16x16x32_bf16(__builtin_bit_cast(bf16x8, vw), pf, o[dt], 0, 0, 0);
        }
    }
#pragma unroll
    for (int dt = 0; dt < 4; ++dt) *(v2u*)(qp + 16 * dt + 4 * g) = (v2u){pk2(o[dt][0] * inv, o[dt][1] * inv), pk2(o[dt][2] * inv, o[dt][3] * inv)};
}
__device__ __forceinline__ void attn_phase(const Frame& F0, const Args& args, int l) {
    const Frame F = fresh(F0);
    LAS float* rpb = (LAS float*)(F.lds + RING_OFF);
    for (int i = F.tid; i < 8 * 465; i += 512) rpb[i] = INP(9)[l * 8 * 465 + i];
    __syncthreads();
    bf16* PROJ = WSP(bf16, WS_PROJ); const bf16* VT = WSP(bf16, WS_VT);
    for (int wu = F.vcu * NWAVES + F.wave; wu < 16384; wu += F.G * NWAVES) {
        const int bh = wu >> 9, rem = wu & 511;
        attn_unit(PROJ, VT, rpb, bh >> 3, bh & 7, rem >> 2, rem & 3, F.lane);
    }
    __syncthreads();
}

__device__ __forceinline__ float gelu_tanh(float x) { const float u = 0.7978845608028654f * (x + 0.044715f * x * x * x); const float t = 1.0f - 2.0f / (1.0f + __expf(2.0f * u)); return 0.5f * x * (1.0f + t); }
template <bool FINAL>
__device__ __forceinline__ void lru_phase(const Frame& F0, const Args& args, int l) {
    const Frame F = fresh(F0);
    const int tid = F.tid, lane = F.lane, wave = F.wave;
    LAS float* XH = (LAS float*)(F.lds + RING_OFF);
    LAS float* XCF = (LAS float*)(F.lds + RING_OFF + 18432);
    LAS bf16* XCB = (LAS bf16*)(F.lds + RING_OFF + 34816);
    LAS float* AG = (LAS float*)(F.lds + RING_OFF + 45056);
    LAS float* BX = (LAS float*)(F.lds + RING_OFF + 77824);
    bf16* PROJ = WSP(bf16, WS_PROJ);
    const bf16* WL = WSP(bf16, WS_WL) + (size_t)l * 8 * 256 * 64;
    f32x2* LSUM = WSP(f32x2, WS_LSUM); const float* LCAR = WSP(float, WS_LCAR);
    const float* cw = INP(10) + l * 4 * 512; const float* cbias = INP(11) + l * 512;
    for (int un = F.vcu; un < 4096; un += F.G) {
        const int b = un >> 10, rem = un & 1023, c = rem >> 2, qd = rem & 3, t0 = c * LRU_CH, ch0 = qd * 128;
        for (int idx = tid; idx < 35 * 16; idx += 512) { const int rr = idx >> 4, cg = idx & 15, t = t0 + rr - 2;
            v4u v = (v4u){0u, 0u, 0u, 0u}; if (t >= 0 && t < T) v = *(const v4u*)(PROJ + ((size_t)b * T + t) * PROJ_LD + XR_OFF + ch0 + cg * 8);
            LAS float* d = XH + rr * 128 + cg * 8;
            d[0] = bflo(v.x); d[1] = bfhi(v.x); d[2] = bflo(v.y); d[3] = bfhi(v.y); d[4] = bflo(v.z); d[5] = bfhi(v.z); d[6] = bflo(v.w); d[7] = bfhi(v.w); }
        __syncthreads();
        { const int tok = tid >> 4, cg = tid & 15;
#pragma unroll
            for (int e = 0; e < 8; ++e) { const int chl = cg * 8 + e, ch = ch0 + chl;
                float a = cbias[ch];
#pragma unroll
                for (int j = 0; j < 4; ++j) a += cw[j * 512 + ch] * XH[(tok + j) * 128 + chl];
                XCF[tok * 128 + chl] = a; XCB[((chl >> 6) * 32 + tok) * 72 + (chl & 63)] = (bf16)f2bf(a); } }
        __syncthreads();
        { const int hb = wave >> 2, dir = (wave >> 1) & 1, half = wave & 1, nl = lane & 31, hh = lane >> 5;
            const int chl = 64 * hb + 32 * half + nl, ch = ch0 + chl;
            const bf16* wr_ = WL + ((size_t)(2 * qd + hb) * 256 + (2 * dir + 0) * 64 + 32 * half + nl) * 64 + 8 * hh;
            const bf16* wi_ = WL + ((size_t)(2 * qd + hb) * 256 + (2 * dir + 1) * 64 + 32 * half + nl) * 64 + 8 * hh;
            f32x16 ar = {}, ai = {};
#pragma unroll
            for (int s = 0; s < 4; ++s) {
                const bf16x8 af = *(const LAS bf16x8*)(XCB + (hb * 32 + nl) * 72 + 16 * s + 8 * hh);
                const bf16x8 br = *(const bf16x8*)(wr_ + 16 * s), bi = *(const bf16x8*)(wi_ + 16 * s);
                ar = __builtin_amdgcn_mfma_f32_32x32x16_bf16(af, br, ar, 0, 0, 0);
                ai = __builtin_amdgcn_mfma_f32_32x32x16_bf16(af, bi, ai, 0, 0, 0);
            }
            const float b_r = INP(13)[(l * 2 + dir) * 512 + ch], b_i = INP(15)[(l * 2 + dir) * 512 + ch], lam = INP(16)[(l * 2 + dir) * 512 + ch];
            const float sp = (lam > 15.f) ? __expf(-lam) : log1pf(__expf(-lam));
#pragma unroll
            for (int rg = 0; rg < 16; ++rg) { const int tok = (rg & 3) + 8 * (rg >> 2) + 4 * hh;
                const float rr = sigmoidf(ar[rg] + b_r), ii = sigmoidf(ai[rg] + b_i);
                const float la = -8.0f * rr * sp, a = __expf(la);
                const float bx = sqrtf(fmaxf(-expm1f(2.0f * la), 0.f)) * (ii * XCF[tok * 128 + chl]);
                AG[(dir * 32 + tok) * 128 + chl] = a; BX[(dir * 32 + tok) * 128 + chl] = bx; } }
        __syncthreads();
        if (tid < 256) { const int dir = tid >> 7, chl = tid & 127; const size_t sidx = ((size_t)(b * LRU_NCH + c) * 2 + dir) * 512 + ch0 + chl;
            if (!FINAL) { float A = 1.f, B = 0.f;
#pragma unroll 8
                for (int i = 0; i < 32; ++i) { const int t = dir ? 31 - i : i; const float a = AG[(dir * 32 + t) * 128 + chl]; B = a * B + BX[(dir * 32 + t) * 128 + chl]; A *= a; }
                LSUM[sidx] = (f32x2){A, B};
            } else { float h = LCAR[sidx];
#pragma unroll 8
                for (int i = 0; i < 32; ++i) { const int t = dir ? 31 - i : i; h = AG[(dir * 32 + t) * 128 + chl] * h + BX[(dir * 32 + t) * 128 + chl]; BX[(dir * 32 + t) * 128 + chl] = h; } } }
        if (FINAL) {
            __syncthreads();
            const int tok = tid >> 4, cg = tid & 15; bf16* yp = PROJ + ((size_t)b * T + t0 + tok) * PROJ_LD + YR_OFF + ch0 + cg * 8;
            const v4u yv = *(const v4u*)yp; float y[8] = {bflo(yv.x), bfhi(yv.x), bflo(yv.y), bfhi(yv.y), bflo(yv.z), bfhi(yv.z), bflo(yv.w), bfhi(yv.w)};
#pragma unroll
            for (int e = 0; e < 8; ++e) { const int chl = cg * 8 + e; y[e] = (BX[tok * 128 + chl] + BX[(32 + tok) * 128 + chl]) * gelu_tanh(y[e]); }
            *(v4u*)yp = (v4u){pk2(y[0], y[1]), pk2(y[2], y[3]), pk2(y[4], y[5]), pk2(y[6], y[7])};
        }
        __syncthreads();
    }
}
__device__ __forceinline__ void lru_carry(const Frame& F0, const Args& args) {
    const Frame F = fresh(F0);
    if (F.wave != 0 || F.vcu >= 64) return;
    const int seq = F.vcu * 64 + F.lane, b = seq >> 10, dir = (seq >> 9) & 1, ch = seq & 511;
    const f32x2* LSUM = WSP(f32x2, WS_LSUM); float* LCAR = WSP(float, WS_LCAR);
    float h = 0.f;
#pragma unroll 8
    for (int i = 0; i < LRU_NCH; ++i) { const int c = dir ? LRU_NCH - 1 - i : i; const size_t sidx = ((size_t)(b * LRU_NCH + c) * 2 + dir) * 512 + ch;
        const f32x2 ab = LSUM[sidx]; LCAR[sidx] = h; h = ab.x * h + ab.y; }
}

__device__ __forceinline__ void fft_a_phase(const Frame& F0, const Args& args) {
    const Frame F = fresh(F0);
    const int lane = F.lane, nl = lane & 31, hh = lane >> 5;
    const bf16* PROJ = WSP(bf16, WS_PROJ); const bf16* FA = WSP(bf16, WS_FA); const f32x2* TW = WSP(f32x2, WS_TW); bf16* ZP = WSP(bf16, WS_U);
    for (int wu = F.vcu * NWAVES + F.wave; wu < 8192; wu += F.G * NWAVES) {
        const int ct = wu & 15, t2 = (wu >> 4) & 127, b = wu >> 11;
        bf16x8 bf[8];
#pragma unroll
        for (int s = 0; s < 8; ++s) { const int part = s >> 2, t1b = 16 * (s & 3) + 8 * hh;
            const bf16* p = PROJ + ((size_t)b * T + (size_t)128 * t1b + t2) * PROJ_LD + G_OFF + part * 512 + 32 * ct + nl;
            unsigned short e[8];
#pragma unroll
            for (int j = 0; j < 8; ++j) e[j] = p[(size_t)j * 128 * PROJ_LD];
            v4u w; w.x = e[0] | ((unsigned)e[1] << 16); w.y = e[2] | ((unsigned)e[3] << 16); w.z = e[4] | ((unsigned)e[5] << 16); w.w = e[6] | ((unsigned)e[7] << 16);
            bf[s] = __builtin_bit_cast(bf16x8, w); }
        f32x16 acc[4];
#pragma unroll
        for (int mt = 0; mt < 4; ++mt) { acc[mt] = (f32x16){};
#pragma unroll
            for (int s = 0; s < 8; ++s) { const bf16x8 af = *(const bf16x8*)(FA + (32 * mt + nl) * 128 + 16 * s + 8 * hh); acc[mt] = __builtin_amdgcn_mfma_f32_32x32x16_bf16(af, bf[s], acc[mt], 0, 0, 0); } }
#pragma unroll
        for (int mt = 0; mt < 2; ++mt)
#pragma unroll
            for (int rg = 0; rg < 16; ++rg) { const int k1 = 32 * mt + (rg & 3) + 8 * (rg >> 2) + 4 * hh; const f32x2 cs = TW[t2 * 64 + k1];
                const float zr = acc[mt][rg], zi = acc[mt + 2][rg];
                bf16* d = ZP + ((size_t)(b * 64 + k1) * 128 + t2) * 1024 + 32 * ct + nl;
                d[0] = (bf16)f2bf(zr * cs.x + zi * cs.y); d[512] = (bf16)f2bf(zi * cs.x - zr * cs.y); }
    }
}
__device__ __forceinline__ void fft_b_phase(const Frame& F0, const Args& args) {
    const Frame F = fresh(F0);
    const int lane = F.lane, nl = lane & 31, hh = lane >> 5;
    bf16* PROJ = WSP(bf16, WS_PROJ); const bf16* FB = WSP(bf16, WS_FB); const bf16* ZP = WSP(bf16, WS_U);
    for (int wu = F.vcu * NWAVES + F.wave; wu < 4096; wu += F.G * NWAVES) {
        const int ct = wu & 15, k1 = (wu >> 4) & 63, b = wu >> 10;
        f32x16 acc[4];
#pragma unroll
        for (int mt = 0; mt < 4; ++mt) acc[mt] = (f32x16){};
#pragma unroll 1
        for (int sc = 0; sc < 4; ++sc) {
            bf16x8 bf[4];
#pragma unroll
            for (int q = 0; q < 4; ++q) { const int s = 4 * sc + q, part = s >> 3, t2b = 16 * (s & 7) + 8 * hh;
                const bf16* p = ZP + ((size_t)(b * 64 + k1) * 128 + t2b) * 1024 + part * 512 + 32 * ct + nl;
                unsigned short e[8];
#pragma unroll
                for (int j = 0; j < 8; ++j) e[j] = p[(size_t)j * 1024];
                v4u w; w.x = e[0] | ((unsigned)e[1] << 16); w.y = e[2] | ((unsigned)e[3] << 16); w.z = e[4] | ((unsigned)e[5] << 16); w.w = e[6] | ((unsigned)e[7] << 16);
                bf[q] = __builtin_bit_cast(bf16x8, w); }
#pragma unroll
            for (int mt = 0; mt < 4; ++mt)
#pragma unroll
                for (int q = 0; q < 4; ++q) { const bf16x8 af = *(const bf16x8*)(FB + (32 * mt + nl) * 256 + 16 * (4 * sc + q) + 8 * hh); acc[mt] = __builtin_amdgcn_mfma_f32_32x32x16_bf16(af, bf[q], acc[mt], 0, 0, 0); }
        }
#pragma unroll
        for (int mt = 0; mt < 4; ++mt)
#pragma unroll
            for (int rg = 0; rg < 16; ++rg) { const int k2 = 32 * mt + (rg & 3) + 8 * (rg >> 2) + 4 * hh;
                PROJ[((size_t)b * T + k1 + 64 * k2) * PROJ_LD + G_OFF + 32 * ct + nl] = (bf16)f2bf(acc[mt][rg] * (1.0f / 1024.0f)); }
    }
}

__device__ __forceinline__ void router_phase(const Frame& F0, const Args& args, int l) {
    const Frame F = fresh(F0);
    const int tid = F.tid, lane = F.lane, wave = F.wave;
    const float* MOD = WSP(float, WS_MOD);
    LAS float* WPL = (LAS float*)(F.lds + RING_OFF);
    LAS float* gsc = (LAS float*)(F.lds + XTRA_OFF);
    LAS float* shf = gsc + 1024;
    LAS float* c0 = shf + 1024;
    LAS float* rb = c0 + 32;
    LAS unsigned* lcnt = (LAS unsigned*)(rb + 32);
    LAS unsigned* lbase = lcnt + 32;
    LAS float* red = (LAS float*)(lbase + 32);
    const float* x = args.out; bf16* U2 = WSP(bf16, WS_U);
    float* tokw = WSP(float, WS_TOKW); int* perm = WSP(int, WS_PERM);
    unsigned* ecnt = (unsigned*)(F.ctl + CW_ECNT + l * 32 * 64);
    const int nround = (2048 + F.G * NWAVES - 1) / (F.G * NWAVES);
    int cur_b = -1;
    for (int rd = 0; rd < nround; ++rd) {
        const int unit = (rd * F.G + F.vcu) * NWAVES + wave;
        const int ub = (((rd * F.G + F.vcu) * NWAVES) * 16) >> 13;
        const bool wg_active = ((rd * F.G + F.vcu) * NWAVES) < 2048;
        if (wg_active && ub != cur_b) {
            cur_b = ub; __syncthreads();
            for (int i = 0; i < 2; ++i) { const int col = tid + 512 * i; gsc[col] = INP(5)[l * 1024 + col] * (1.0f + MOD[(size_t)(l * 4 + ub) * 6144 + 4 * 1024 + col]); shf[col] = MOD[(size_t)(l * 4 + ub) * 6144 + 3 * 1024 + col]; }
            if (tid < 32) rb[tid] = INP(22)[tid];
            __syncthreads();
            for (int i = 0; i < 64; ++i) { const int idx = tid + 512 * i, k = idx >> 5, e = idx & 31; WPL[k * 32 + (e ^ (((k >> 8) & 1) << 4))] = gsc[k] * INP(21)[idx]; }
            { const int e = tid & 31, pt = tid >> 5; float s = 0.f;
                for (int k = pt * 64; k < pt * 64 + 64; ++k) s += shf[k] * INP(21)[k * 32 + e];
                red[tid] = s; }
            __syncthreads();
            if (tid < 32) { float s = 0.f; for (int p = 0; p < 16; ++p) s += red[p * 32 + tid]; c0[tid] = s; }
        }
        if (tid < 32) lcnt[tid] = 0u;
        __syncthreads();
        int e0 = 0, e1 = 0; unsigned rk0 = 0, rk1 = 0; float w0 = 0.f, w1 = 0.f; bool owner = false; int mytok = 0;
        if (unit < 2048) {
            const int tok0 = unit * 16;
            float rs_reg = 0.f;
            for (int i = 0; i < 16; ++i) { const int m = tok0 + i;
                const f32x4* xr = (const f32x4*)(x + (size_t)m * D) + lane; f32x4 v[4]; float ss = 0.f;
#pragma unroll
                for (int j = 0; j < 4; ++j) { v[j] = xr[64 * j]; ss += (v[j].x * v[j].x + v[j].y * v[j].y) + (v[j].z * v[j].z + v[j].w * v[j].w); }
                const float rstd = 1.0f / sqrtf(wave_sum(ss) * (1.0f / D) + EPS);
                if ((lane & 15) == i) rs_reg = rstd;
                v2u* uo = (v2u*)(U2 + (size_t)m * D) + lane;
#pragma unroll
                for (int j = 0; j < 4; ++j) { const f32x4 g = *(const LAS f32x4*)(gsc + 4 * lane + 256 * j), s = *(const LAS f32x4*)(shf + 4 * lane + 256 * j);
                    const f32x4 u = v[j] * rstd * g + s; uo[64 * j] = (v2u){pk2(u.x, u.y), pk2(u.z, u.w)}; } }
            const int ti = lane & 15, kq = lane >> 4;
            const f32x4* xrow = (const f32x4*)(x + (size_t)(tok0 + ti) * D + 256 * kq);
            const LAS float* wp0 = WPL + (256 * kq) * 32 + (ti ^ ((kq & 1) << 4));
            const LAS float* wp1 = WPL + (256 * kq) * 32 + ((16 + ti) ^ ((kq & 1) << 4));
            f32x4 a0 = {0.f, 0.f, 0.f, 0.f}, a1 = {0.f, 0.f, 0.f, 0.f};
#pragma unroll 4
            for (int t4 = 0; t4 < 64; ++t4) { const f32x4 xv = xrow[t4];
#pragma unroll
                for (int jj = 0; jj < 4; ++jj) { const int kk = 4 * t4 + jj;
                    a0 = __builtin_amdgcn_mfma_f32_16x16x4f32(wp0[kk * 32], xv[jj], a0, 0, 0, 0);
                    a1 = __builtin_amdgcn_mfma_f32_16x16x4f32(wp1[kk * 32], xv[jj], a1, 0, 0, 0); } }
            float sco[2][4], sel[2][4], gs[2];
#pragma unroll
            for (int nt = 0; nt < 2; ++nt) {
#pragma unroll
                for (int rg = 0; rg < 4; ++rg) { const int e = 16 * nt + 4 * kq + rg; const float lg = rs_reg * (nt ? a1[rg] : a0[rg]) + c0[e]; sco[nt][rg] = sigmoidf(lg); sel[nt][rg] = sco[nt][rg] + rb[e]; }
                float m1 = fmaxf(sel[nt][0], sel[nt][1]), m2 = fminf(sel[nt][0], sel[nt][1]);
                { const float v = sel[nt][2]; if (v > m1) { m2 = m1; m1 = v; } else if (v > m2) m2 = v; }
                { const float v = sel[nt][3]; if (v > m1) { m2 = m1; m1 = v; } else if (v > m2) m2 = v; }
                gs[nt] = m1 + m2; }
            float bv = gs[0]; int bg = kq; if (gs[1] > bv) { bv = gs[1]; bg = 4 + kq; }
#pragma unroll
            for (int o = 16; o < 64; o <<= 1) { const float ov = __shfl_xor(bv, o); const int og = __shfl_xor(bg, o); if (ov > bv || (ov == bv && og < bg)) { bv = ov; bg = og; } }
            owner = ((bg & 3) == kq); mytok = tok0 + ti;
            if (owner) { const int nt = bg >> 2; float cd[4], sv[4];
#pragma unroll
                for (int rg = 0; rg < 4; ++rg) { cd[rg] = nt ? sel[1][rg] : sel[0][rg]; sv[rg] = nt ? sco[1][rg] : sco[0][rg]; }
                int i1 = 0; float v1 = cd[0];
#pragma unroll
                for (int rg = 1; rg < 4; ++rg) if (cd[rg] > v1) { v1 = cd[rg]; i1 = rg; }
                int i2 = -1; float v2 = -1e30f;
#pragma unroll
                for (int rg = 0; rg < 4; ++rg) if (rg != i1 && cd[rg] > v2) { v2 = cd[rg]; i2 = rg; }
                const float s1 = (i1 == 0 ? sv[0] : (i1 == 1 ? sv[1] : (i1 == 2 ? sv[2] : sv[3]))), s2 = (i2 == 0 ? sv[0] : (i2 == 1 ? sv[1] : (i2 == 2 ? sv[2] : sv[3])));
                e0 = 4 * bg + i1; e1 = 4 * bg + i2; w0 = s1 / (s1 + s2); w1 = s2 / (s1 + s2);
                rk0 = __hip_atomic_fetch_add(lcnt + e0, 1u, __ATOMIC_RELAXED, __HIP_MEMORY_SCOPE_WORKGROUP);
                rk1 = __hip_atomic_fetch_add(lcnt + e1, 1u, __ATOMIC_RELAXED, __HIP_MEMORY_SCOPE_WORKGROUP); }
        }
        __syncthreads();
        if (tid < 32) { const unsigned n = lcnt[tid]; lbase[tid] = n ? __hip_atomic_fetch_add(ecnt + 64 * tid, n, RLX_AGENT) : 0u; }
        __syncthreads();
        if (owner) { perm[(size_t)e0 * NTOK + lbase[e0] + rk0] = 2 * mytok; perm[(size_t)e1 * NTOK + lbase[e1] + rk1] = 2 * mytok + 1; tokw[2 * mytok] = w0; tokw[2 * mytok + 1] = w1; }
    }
    __syncthreads();
    {
        LAS float* scr = (LAS float*)(F.lds + RING_OFF + wave * 8704);
        const int gw = F.vcu * NWAVES + wave, NGW = F.G * NWAVES;
        bf16* WG1 = WSP(bf16, WS_WG1); bf16* WD = WSP(bf16, WS_WD);
        for (int it = gw; it < 24576; it += NGW) {
            const int kind = it >> 13, r = it & 8191, e = r >> 8, rr = r & 255;
            if (kind < 2) { const int kb = rr >> 4, nb = rr & 15, n0 = nb * 32; const float* src = (kind == 0 ? INP(23) : INP(24)) + (size_t)(l * 32 + e) * 1024 * 512;
                transpose_item(src, 512, kb * 64, n0, WG1 + ((size_t)e * 1024 + (n0 >> 7) * 256 + kind * 128 + (n0 & 127)) * 1024, 1024, scr, lane); }
            else { const int kb = rr >> 5, nb = rr & 31, n0 = nb * 32; const float* src = INP(25) + (size_t)(l * 32 + e) * 512 * 1024;
                transpose_item(src, 1024, kb * 64, n0, WD + ((size_t)e * 1024 + n0) * 512, 512, scr, lane); }
        }
    }
}
__device__ __forceinline__ void moe_tilebase(const Frame& F0, const Args& args, int l) {
    const Frame F = fresh(F0);
    if (F.tid == 0) { unsigned* ecnt = (unsigned*)(F.ctl + CW_ECNT + l * 32 * 64); int acc = 0;
        for (int e = 0; e < 32; ++e) { F.MISC[16 + e] = (unsigned)acc; acc += (int)((__hip_atomic_load(ecnt + 64 * e, RLX_AGENT) + 255u) >> 8); }
        F.MISC[48] = (unsigned)acc; }
    __syncthreads();
}
__device__ __forceinline__ void gather_phase(const Frame& F0, const Args& args, int l) {
    const Frame F = fresh(F0);
    moe_tilebase(F, args, l);
    const unsigned* ecnt = (const unsigned*)(F.ctl + CW_ECNT + l * 32 * 64);
    const int* perm = WSP(int, WS_PERM); int* tokrow = WSP(int, WS_TOKROW);
    const bf16* U2 = WSP(bf16, WS_U); bf16* XS = WSP(bf16, WS_PROJ);
    const int nrows = (int)F.MISC[48] * 256;
    for (int r = F.vcu * NWAVES + F.wave; r < nrows; r += F.G * NWAVES) {
        const int t = r >> 8; int e = 0;
        for (int k = 1; k < 32; ++k) e += ((int)F.MISC[16 + k] <= t) ? 1 : 0;
        const int s = r - 256 * (int)F.MISC[16 + e];
        const int cnt = (int)__hip_atomic_load(ecnt + 64 * e, RLX_AGENT);
        if (s < cnt) { const int tk = perm[(size_t)e * NTOK + s], tok = tk >> 1;
            const v4u* src = (const v4u*)(U2 + (size_t)tok * 1024) + F.lane; v4u* dst = (v4u*)(XS + (size_t)r * 1024) + F.lane;
            dst[0] = src[0]; dst[64] = src[64];
            if (F.lane == 0) tokrow[tk] = r; }
    }
}
__device__ __forceinline__ int fresh_bid() { int b = (int)blockIdx.x; asm volatile("" : "+s"(b)); return b; }
constexpr int N_PHASES = 24;
__global__ void __launch_bounds__(NWAVES * 64, 2) mega_fwd(Args args, int li) {
    extern __shared__ __attribute__((aligned(16))) unsigned char lds[];
    Frame F;
    F.lds = (LAS unsigned char*)lds;
    F.MISC = (volatile LAS unsigned*)(F.lds + MISC_OFF);
    F.tid = threadIdx.x; F.lane = F.tid & 63; F.wave = __builtin_amdgcn_readfirstlane(F.tid >> 6);
    F.G = gridDim.x; { const int bx = blockIdx.x; F.vcu = (F.G % 8 == 0) ? (bx % 8) * (F.G / 8) + bx / 8 : bx; }
    F.ctl = (gu32*)(args.ws + WS_CTL);
    for (int u = F.tid; u < (XTRA_OFF - LDSCTL_OFF) / 4; u += NWAVES * 64) ((LAS unsigned*)(F.lds + LDSCTL_OFF))[u] = 0u;
    __syncthreads();
    const int lo = args.ph_lo, hi = args.ph_hi;
    XcdBarrier bar; bar.bar = (unsigned*)(F.ctl + CW_BAR) + li * XCD_BAR_WORDS; bar.x = 0; bar.st = nullptr;
    if (hi - lo > 1) bar = xcd_barrier_post((unsigned*)(F.ctl + CW_BAR) + li * XCD_BAR_WORDS, F.MISC + 8);
#ifndef PHMASK
#define PHMASK 0xFFFF
#endif
#define EN(kind) ((PHMASK >> (kind)) & 1)
#define IN(k) (lo <= (k) && (k) < hi)
#define SEAM(k) do { if (IN(k) && IN((k) + 1)) xcd_barrier(bar); } while (0)

    if (EN(0) && IN(0)) { p0_prologue(F, args); SEAM(0); }
    for (int l = 0; l < DEPTH; ++l) {
        const int pb = 1 + 11 * l;
        bf16* U = WSP(bf16, WS_U); bf16* PROJ = WSP(bf16, WS_PROJ); bf16* GATES = WSP(bf16, WS_GATES);
        if (EN(1) && IN(pb + 0)) { if (l == 0) rows_phase<0>(F, args, l); else rows_phase<1>(F, args, l); SEAM(pb + 0); }
        if (EN(2) && IN(pb + 1)) {
            pg8::Gemm g{U, U, U, WSP(bf16, WS_WP2) + (size_t)l * NP2 * 1024, nullptr, nullptr, 1024, 1024, 1024};
            pg8::StaticOrder S; S.init(NTOK, NP2, F.G, fresh_bid());
            EpiP2 E{PROJ, WSP(bf16, WS_VT), GATES, INP(8) + l * 3072};
            pg8::gemm_phase<EpiP2, pg8::StaticOrder, true>(F.lds + RING_OFF, g, S, E, fresh(F).tid);
            SEAM(pb + 1);
        }
        if (EN(3) && IN(pb + 2)) { if (EN(13)) attn_phase(F, args, l); if (EN(14)) lru_phase<false>(F, args, l); if (EN(15)) fft_a_phase(F, args); SEAM(pb + 2); }
        if (EN(4) && IN(pb + 3)) { lru_carry(F, args); fft_b_phase(F, args); SEAM(pb + 3); }
        if (EN(5) && IN(pb + 4)) { lru_phase<true>(F, args, l); SEAM(pb + 4); }
        if (EN(6) && IN(pb + 5)) {
            const bf16* WP = WSP(bf16, WS_WPROJ) + (size_t)l * 3 * 1024 * 512;
            pg8::Gemm g{PROJ + Q_OFF, PROJ + YR_OFF, PROJ + G_OFF, WP, WP + 1024 * 512, WP + 2 * 1024 * 512, PROJ_LD, 512, 512};
            pg8::MergeOrder S; S.init(NTOK, 1024, F.G, fresh_bid());
            EpiMerge E{GATES, U};
            pg8::gemm_phase<EpiMerge, pg8::MergeOrder, true>(F.lds + RING_OFF, g, S, E, fresh(F).tid);
            SEAM(pb + 5);
        }
        if (EN(7) && IN(pb + 6)) {
            pg8::Gemm g{U, U, U, WSP(bf16, WS_WOUT) + (size_t)l * 1024 * 1024, nullptr, nullptr, 1024, 1024, 1024};
            pg8::StaticOrder S; S.init(NTOK, 1024, F.G, fresh_bid());
            EpiResid E{l == 0 ? INP(0) : (const float*)args.out, args.out, WSP(float, WS_MOD) + (size_t)l * 4 * 6144 + 2 * 1024};
            pg8::gemm_phase<EpiResid, pg8::StaticOrder, true>(F.lds + RING_OFF, g, S, E, fresh(F).tid);
            SEAM(pb + 6);
        }
        if (EN(8) && IN(pb + 7)) { router_phase(F, args, l); SEAM(pb + 7); }
        if (EN(9) && IN(pb + 8)) { gather_phase(F, args, l); SEAM(pb + 8); }
        if (EN(10) && IN(pb + 9)) {
            moe_tilebase(F, args, l);
            pg8::Gemm g{PROJ, PROJ, PROJ, WSP(bf16, WS_WG1), nullptr, nullptr, 1024, 1024, 1024};
            pg8::MoeOrder S{(const LAS int*)(F.lds + MISC_OFF + 64), F.G, fresh_bid()};
            EpiSwiGLU E{WSP(bf16, WS_H)};
            pg8::gemm_phase<EpiSwiGLU, pg8::MoeOrder, true>(F.lds + RING_OFF, g, S, E, fresh(F).tid);
            SEAM(pb + 9);
        }
        if (EN(11) && IN(pb + 10)) {
            moe_tilebase(F, args, l);
            const bf16* H = WSP(bf16, WS_H);
            pg8::Gemm g{H, H, H, WSP(bf16, WS_WD), nullptr, nullptr, 512, 512, 512};
            pg8::MoeOrder S{(const LAS int*)(F.lds + MISC_OFF + 64), F.G, fresh_bid()};
            EpiYE E{PROJ};
            pg8::gemm_phase<EpiYE, pg8::MoeOrder, true>(F.lds + RING_OFF, g, S, E, fresh(F).tid);
            SEAM(pb + 10);
        }
    }
    if (EN(12) && IN(23)) rows_phase<2>(F, args, DEPTH);
#undef IN
#undef SEAM
}

#ifndef MK_MODE
#define MK_MODE 1
#endif
extern "C" void kernel_launch(void* const* d_in, const int* in_sizes, int n_in, void* d_out, int out_size, void* d_ws, size_t ws_size, hipStream_t stream) {
    static int grid = 0;
    if (grid == 0) {
        if (n_in != 27 || in_sizes[0] != NTOK * D || out_size != NTOK * D || ws_size < WS_END) { fprintf(stderr, "kernel_launch: unexpected shapes (n_in %d, in0 %d, out %d, ws %zu < %zu)\n", n_in, n_in > 0 ? in_sizes[0] : -1, out_size, ws_size, (size_t)WS_END); grid = -1; return; }
        int dev = 0, cus = 0;
        if (hipGetDevice(&dev) != hipSuccess || hipDeviceGetAttribute(&cus, hipDeviceAttributeMultiprocessorCount, dev) != hipSuccess) { grid = -1; return; }
        if (hipFuncSetAttribute((const void*)mega_fwd, hipFuncAttributeMaxDynamicSharedMemorySize, LDS_BYTES) != hipSuccess) { fprintf(stderr, "kernel_launch: hipFuncSetAttribute failed\n"); grid = -1; return; }
        (void)hipGetLastError();
        grid = cus;
    }
    if (grid < 0) return;
    if (hipMemsetAsync((char*)d_ws + WS_CTL, 0, CTL_ZERO_BYTES, stream) != hipSuccess) return;
    Args a{};
    for (int i = 0; i < 27; ++i) a.in[i] = (const float*)d_in[i];
    a.out = (float*)d_out; a.ws = (unsigned char*)d_ws;
#if MK_MODE == 0
    a.ph_lo = 0; a.ph_hi = N_PHASES;
    hipLaunchKernelGGL(mega_fwd, dim3(grid), dim3(NWAVES * 64), LDS_BYTES, stream, a, 0);
#else
    for (int p = 0; p < N_PHASES; ++p) { a.ph_lo = p; a.ph_hi = p + 1; hipLaunchKernelGGL(mega_fwd, dim3(grid), dim3(NWAVES * 64), LDS_BYTES, stream, a, 0); }
#endif
}
```

```cpp
#include <hip/hip_runtime.h>
#include <cstdio>
#include <cstdint>
namespace pg8 {
#define PG8_LAS __attribute__((address_space(3)))
typedef unsigned short bf16_t;
typedef short bf16x8 __attribute__((ext_vector_type(8)));
typedef float f32x4 __attribute__((ext_vector_type(4)));
typedef unsigned u32x4 __attribute__((ext_vector_type(4)));
typedef unsigned u32x2 __attribute__((ext_vector_type(2)));
constexpr int BM = 256, BK = 64, HALF = 128, HTB = HALF * BK * 2  , STAGE_BYTES = 8 * HTB, NXCD = 8, WGM = 8;

__host__ __device__ __forceinline__ int lds_byte(int r, int c) { const int st = (r >> 4) * 2 + (c >> 5), rr = r & 15, cc = c & 31, ob = rr * 64 + cc * 2; return st * 1024 + (ob ^ (((ob >> 9) & 1) << 5)); }
__host__ __device__ __forceinline__ void stage_rc(int b, int& R, int& C) { const int st = b / 1024, sb = b % 1024, swz = sb ^ (((sb >> 9) & 1) << 5); R = (st >> 1) * 16 + swz / 64; C = (st & 1) * 32 + (swz % 64) / 2; }
__host__ __device__ __forceinline__ int perm32(int rho) { const int n = rho >> 4, i = rho & 15; return 8 * (i >> 2) + 4 * n + (i & 3); }

struct Unit { int pm, pn, bt, z; };
struct Gemm { const bf16_t* A0; const bf16_t* A1; const bf16_t* A2; const bf16_t* B0; const bf16_t* B1; const bf16_t* B2; int lda, ldb, K; };

__device__ __forceinline__ unsigned cvt_pk_bf16(float lo, float hi) { unsigned r; asm volatile("v_cvt_pk_bf16_f32 %0, %1, %2" : "=v"(r) : "v"(lo), "v"(hi)); return r; }

struct StaticOrder {
    int nM, nN, nwg, G, c;
    __device__ void init(int M, int N, int G_, int c_) { nM = M / BM; nN = N / BM; nwg = nM * nN; G = G_; c = c_; }
    __device__ __forceinline__ bool tile(long L, Unit& u) const {
        if (L >= nwg) return false;
        int wgid = (int)L; { const int q = nwg / NXCD, r = nwg % NXCD, xcd = wgid % NXCD, off = wgid / NXCD; wgid = (xcd < r ? xcd * (q + 1) : r * (q + 1) + (xcd - r) * q) + off; }
        const int nig = WGM * nN, gid = wgid / nig, fm = gid * WGM, gsz = (nM - fm) < WGM ? (nM - fm) : WGM;
        u.pm = fm + ((wgid % nig) % gsz); u.pn = (wgid % nig) / gsz; u.bt = u.pn; u.z = 0; return true;
    }
    __device__ __forceinline__ bool next(int i, Unit& u) const { return tile((long)i * G + c, u); }
};
struct MergeOrder : StaticOrder {
    __device__ __forceinline__ bool next(int i, Unit& u) const { const int t = i / 3; if (!tile((long)t * G + c, u)) return false; u.z = i - 3 * t; return true; }
};
struct MoeOrder {
    const PG8_LAS int* tb; int G, c;
    __device__ __forceinline__ bool next(int i, Unit& u) const {
        const int L = i * G + c; const int nt = tb[32]; if (L >= nt * 4) return false;
        const int t = L >> 2, j = L & 3; int e = 0;
#pragma unroll 1
        for (int k = 1; k < 32; ++k) e += (tb[k] <= t) ? 1 : 0;
        u.pm = t; u.pn = j; u.bt = e * 4 + j; u.z = 0; return true;
    }
};

template <class Epi, class Sched, bool ALIGN_EPI>
__device__ __forceinline__ void gemm_phase(PG8_LAS unsigned char* lds, const Gemm g, const Sched& S, const Epi& E, const int tid) {
    const int wid = __builtin_amdgcn_readfirstlane(tid >> 6), lane = tid & 63, wr = wid >> 2, wc = wid & 3, fr = lane & 15, fq = lane >> 4;
    const int K = g.K, nt = K / BK;
    unsigned voffA[2], voffB[2];
#pragma unroll
    for (int i = 0; i < 2; ++i) { int R, C; stage_rc(tid * 16 + i * 8192, R, C); const int Rb = Epi::PERM ? ((R & ~31) + perm32(R & 31)) : R;
        voffA[i] = (unsigned)(R * g.lda + C) * 2u; voffB[i] = (unsigned)(Rb * g.ldb + C) * 2u; }
    const size_t kstep = (size_t)(BK * 2);
    const size_t hstepA = (size_t)HALF * g.lda * 2, hstepB = (size_t)HALF * g.ldb * 2;
    const size_t tstepA = 2 * hstepA, tstepB = 2 * hstepB;
    const unsigned ldsw = (unsigned)wid * 1024u;
    const int aoff = lds_byte(wr * 64 + fr, fq * 8), boff = lds_byte(wc * 32 + fr, fq * 8);
#define PG8_SA(b, h) (((b) * 2 + (h)) * HTB)
#define PG8_SB(b, h) ((4 + (b) * 2 + (h)) * HTB)
#define PG8_STAGE(bufoff, gbase, voff) do { _Pragma("unroll") for (int _i = 0; _i < 2; ++_i) \
        __builtin_amdgcn_global_load_lds((const unsigned*)((const char*)(gbase) + (voff)[_i]), (PG8_LAS unsigned*)(lds + (bufoff) + ldsw + _i * 8192), 16, 0, 0); } while (0)
#define PG8_LDA(dst, b, h) do { _Pragma("unroll") for (int m = 0; m < 4; ++m) _Pragma("unroll") for (int k = 0; k < 2; ++k) dst[m][k] = *(const PG8_LAS bf16x8*)(lds + PG8_SA(b, h) + aoff + m * 2048 + k * 1024); } while (0)
#define PG8_LDB(dst, b, h) do { _Pragma("unroll") for (int n = 0; n < 2; ++n) _Pragma("unroll") for (int k = 0; k < 2; ++k) dst[n][k] = *(const PG8_LAS bf16x8*)(lds + PG8_SB(b, h) + boff + n * 2048 + k * 1024); } while (0)
#define PG8_MMA(ai, bj, At, Bt) do { __builtin_amdgcn_s_setprio(1); _Pragma("unroll") for (int m = 0; m < 4; ++m) _Pragma("unroll") for (int n = 0; n < 2; ++n) _Pragma("unroll") for (int k = 0; k < 2; ++k) \
        acc[ai][bj][m][n] = __builtin_amdgcn_mfma_f32_16x16x32_bf16(Bt[n][k], At[m][k], acc[ai][bj][m][n], 0, 0, 0); __builtin_amdgcn_s_setprio(0); } while (0)
#define PG8_WAIT_V(n) asm volatile("s_waitcnt vmcnt(" #n ")" ::: "memory")
#define PG8_WAIT_L(n) asm volatile("s_waitcnt lgkmcnt(" #n ")" ::: "memory")
#define PG8_BAR __builtin_amdgcn_s_barrier()
#define PG8_SCHED __builtin_amdgcn_sched_barrier(0)
#define PG8_APTR(u) ((const char*)((u).z == 0 ? g.A0 : ((u).z == 1 ? g.A1 : g.A2)) + (size_t)(u).pm * tstepA)
#define PG8_BPTR(u) ((const char*)((u).z == 0 ? g.B0 : ((u).z == 1 ? g.B1 : g.B2)) + (size_t)(u).bt * tstepB)
    Unit cur, nxt; int ui = 0;
    if (!S.next(0, cur)) return;
    f32x4 acc[2][2][4][2];
#pragma unroll
    for (int a = 0; a < 2; ++a)
#pragma unroll
        for (int b = 0; b < 2; ++b)
#pragma unroll
            for (int m = 0; m < 4; ++m)
#pragma unroll
                for (int n = 0; n < 2; ++n) acc[a][b][m][n] = (f32x4){0.f, 0.f, 0.f, 0.f};
    bf16x8 At[4][2], B0[2][2], B1[2][2];
    const char* cA = PG8_APTR(cur); const char* cB = PG8_BPTR(cur);
    PG8_STAGE(PG8_SB(0, 0), cB, voffB); PG8_STAGE(PG8_SB(0, 1), cB + hstepB, voffB); PG8_STAGE(PG8_SA(0, 0), cA, voffA); PG8_STAGE(PG8_SA(0, 1), cA + hstepA, voffA);
    if (wr == 1) PG8_BAR;
    PG8_WAIT_V(2); PG8_BAR;
    PG8_STAGE(PG8_SB(1, 0), cB + kstep, voffB); PG8_STAGE(PG8_SA(1, 0), cA + kstep, voffA); PG8_STAGE(PG8_SB(1, 1), cB + hstepB + kstep, voffB);
    PG8_WAIT_V(6); PG8_BAR;
    for (;;) {
        const bool has_next = S.next(ui + 1, nxt);
        const char* nA = has_next ? PG8_APTR(nxt) : cA; const char* nB = has_next ? PG8_BPTR(nxt) : cB;
        for (int t = 0; t < nt; t += 2) {
            const bool last = (t == nt - 2);
            const char* a1 = cA + (size_t)(t + 1) * kstep;
            const char* a2 = last ? nA : cA + (size_t)(t + 2) * kstep; const char* b2 = last ? nB : cB + (size_t)(t + 2) * kstep;
            const char* a3 = a2 + kstep; const char* b3 = b2 + kstep;
            PG8_LDB(B0, 0, 0); PG8_LDB(B1, 0, 1); PG8_SCHED; PG8_LDA(At, 0, 0); PG8_STAGE(PG8_SA(1, 1), a1 + hstepA, voffA);
            PG8_WAIT_V(8); PG8_WAIT_L(0); PG8_BAR; PG8_MMA(0, 0, At, B0); PG8_MMA(0, 1, At, B1); PG8_BAR; PG8_SCHED;
            PG8_LDA(At, 0, 1); PG8_STAGE(PG8_SB(0, 0), b2, voffB); PG8_STAGE(PG8_SB(0, 1), b2 + hstepB, voffB); PG8_STAGE(PG8_SA(0, 0), a2, voffA);
            PG8_WAIT_V(8); PG8_WAIT_L(0); PG8_BAR; PG8_MMA(1, 0, At, B0); PG8_MMA(1, 1, At, B1); PG8_BAR; PG8_SCHED;
            PG8_LDB(B0, 1, 0); PG8_LDB(B1, 1, 1); PG8_SCHED; PG8_LDA(At, 1, 0); PG8_STAGE(PG8_SA(0, 1), a2 + hstepA, voffA);
            PG8_WAIT_V(8); PG8_WAIT_L(0); PG8_BAR; PG8_MMA(0, 0, At, B0); PG8_MMA(0, 1, At, B1); PG8_BAR; PG8_SCHED;
            PG8_LDA(At, 1, 1); PG8_STAGE(PG8_SB(1, 0), b3, voffB); PG8_STAGE(PG8_SB(1, 1), b3 + hstepB, voffB); PG8_STAGE(PG8_SA(1, 0), a3, voffA);
            PG8_WAIT_V(8); PG8_WAIT_L(0); PG8_BAR; PG8_MMA(1, 0, At, B0); PG8_MMA(1, 1, At, B1); PG8_BAR; PG8_SCHED;
        }
        if constexpr (ALIGN_EPI) { if (wr == 0) PG8_BAR; }
        E(acc, cur, wr, wc, fr, fq);
        if (!has_next) break;
#pragma unroll
        for (int a = 0; a < 2; ++a)
#pragma unroll
            for (int b = 0; b < 2; ++b)
#pragma unroll
                for (int m = 0; m < 4; ++m)
#pragma unroll
                    for (int n = 0; n < 2; ++n) acc[a][b][m][n] = (f32x4){0.f, 0.f, 0.f, 0.f};
        cur = nxt; cA = nA; cB = nB; ++ui;
        if constexpr (ALIGN_EPI) { if (wr == 1) PG8_BAR; }
    }
    PG8_WAIT_V(0);
    if constexpr (!ALIGN_EPI) { if (wr == 0) PG8_BAR; }
    PG8_BAR;
#undef PG8_SA
#undef PG8_SB
#undef PG8_STAGE
#undef PG8_LDA
#undef PG8_LDB
#undef PG8_MMA
#undef PG8_WAIT_V
#undef PG8_WAIT_L
#undef PG8_BAR
#undef PG8_SCHED
#undef PG8_APTR
#undef PG8_BPTR
}
}
constexpr int NWAVES = 8;
constexpr int NB = 4, T = 8192, D = 1024, NTOK = NB * T, DEPTH = 2;
constexpr int PROJ_LD = 3072, Q_OFF = 0, K_OFF = 512, XR_OFF = 1024, YR_OFF = 1536, G_OFF = 2048;
constexpr int GATES_LD = 3072;
constexpr int NP2 = 6656;
constexpr int NEXP = 32, XS_ROWS = 73728;
constexpr int LRU_CH = 32, LRU_NCH = T / LRU_CH;
constexpr float EPS = 1e-6f;

constexpr size_t MiB = 1u << 20;
constexpr size_t WS_CTL = 0, CTL_ZERO_BYTES = 1 * MiB;
constexpr size_t WS_MOD = 1 * MiB;
constexpr size_t WS_FA = WS_MOD + 256 * 1024;
constexpr size_t WS_FB = WS_FA + 32 * 1024;
constexpr size_t WS_TW = WS_FB + 64 * 1024;
constexpr size_t WS_WL = 2 * MiB;
constexpr size_t WS_TOKW = 3 * MiB;
constexpr size_t WS_TOKROW = WS_TOKW + 256 * 1024;
constexpr size_t WS_PERM = 4 * MiB;
constexpr size_t WS_LSUM = 8 * MiB;
constexpr size_t WS_LCAR = 16 * MiB;
constexpr size_t WS_WP2 = 20 * MiB;
constexpr size_t WS_WPROJ = 46 * MiB;
constexpr size_t WS_WOUT = 52 * MiB;
constexpr size_t WS_U = 56 * MiB;
constexpr size_t WS_VT = 120 * MiB;
constexpr size_t WS_PROJ = 152 * MiB;
constexpr size_t WS_GATES = 344 * MiB;
constexpr size_t WS_WG1 = WS_GATES, WS_WD = WS_GATES + 64 * MiB, WS_H = WS_GATES + 96 * MiB;
constexpr size_t WS_END = 536 * MiB;
static_assert(WS_H + (size_t)XS_ROWS * 512 * 2 <= WS_END, "ws map");
constexpr int CW_BAR = 4096;
constexpr int CW_ECNT = 16384;

constexpr int RING_OFF = 0, RING_BYTES = 131072;
constexpr int LDSCTL_OFF = RING_BYTES, MISC_OFF = LDSCTL_OFF + 64;
constexpr int XTRA_OFF = MISC_OFF + 384;
constexpr int LDS_BYTES = 147456;

#define GAS __attribute__((address_space(1)))
#define LAS __attribute__((address_space(3)))
typedef unsigned short bf16;
typedef unsigned v4u __attribute__((ext_vector_type(4)));
typedef unsigned v2u __attribute__((ext_vector_type(2)));
typedef float f32x4 __attribute__((ext_vector_type(4)));
typedef float f32x2 __attribute__((ext_vector_type(2)));
typedef float f32x16 __attribute__((ext_vector_type(16)));
typedef short bf16x8 __attribute__((ext_vector_type(8)));
typedef short bf16x4 __attribute__((ext_vector_type(4)));
typedef GAS unsigned gu32;
#define RLX_AGENT __ATOMIC_RELAXED, __HIP_MEMORY_SCOPE_AGENT
#define LDS_WAIT() asm volatile("s_waitcnt lgkmcnt(0)" ::: "memory")
#define VM_WAIT() asm volatile("s_waitcnt vmcnt(0)" ::: "memory")
__device__ __forceinline__ unsigned f2bf(float f) { unsigned u = __builtin_bit_cast(unsigned, f); return (u + 0x7fffu + ((u >> 16) & 1u)) >> 16; }
__device__ __forceinline__ unsigned pk2(float lo, float hi) { return f2bf(lo) | (f2bf(hi) << 16); }
__device__ __forceinline__ float bflo(unsigned w) { return __builtin_bit_cast(float, w << 16); }
__device__ __forceinline__ float bfhi(unsigned w) { return __builtin_bit_cast(float, w & 0xffff0000u); }
__device__ __forceinline__ float bf2f(unsigned short h) { return __builtin_bit_cast(float, (unsigned)h << 16); }
__device__ __forceinline__ float sigmoidf(float v) { return 1.0f / (1.0f + __expf(-v)); }
__device__ __forceinline__ float wave_sum(float v) {
#pragma unroll
    for (int o = 1; o < 64; o <<= 1) v += __shfl_xor(v, o);
    return v;
}
#define XB_TMO      128
#define XB_XCNT(j)  (256  + 64 * (j))
#define XB_XSUB(j)  (1280 + 64 * (j))
#define XB_XGEN(j)  (2304 + 64 * (j))
#define XB_TOP      3328
#define XB_TOPGEN   3392
#define XCD_BAR_WORDS 3456
#define XB_SPIN_CAP (1u << 18)

__device__ __forceinline__ unsigned xb_ld(unsigned* p)              { return __hip_atomic_load(p, __ATOMIC_RELAXED, __HIP_MEMORY_SCOPE_AGENT); }
__device__ __forceinline__ unsigned xb_add(unsigned* p, unsigned v) { return __hip_atomic_fetch_add(p, v, __ATOMIC_RELAXED, __HIP_MEMORY_SCOPE_AGENT); }
__device__ __forceinline__ unsigned xb_xcc_id() { return (unsigned)__builtin_amdgcn_s_getreg((3 << 11) | 20) & 0xFu; }
#define XB_SPIN(cond, bar) do { unsigned _sp = 0; while (cond) { __builtin_amdgcn_s_sleep(1); \
    if ((++_sp & 255u) == 0u) { if (xb_ld(&(bar)[XB_TMO])) break; if (_sp > XB_SPIN_CAP) { atomicAdd(&(bar)[XB_TMO], 1u); break; } } } } while (0)

struct XcdBarrier {
    unsigned* bar; unsigned x;
    volatile LAS unsigned* st;
};

__device__ __forceinline__ XcdBarrier xcd_barrier_post(unsigned* bar, volatile LAS unsigned* st) {
    XcdBarrier b; b.bar = bar; b.x = xb_xcc_id(); b.st = st;
    if (threadIdx.x == 0) (void)xb_add(&bar[XB_XCNT(b.x)], 1u);
    return b;
}
__device__ __forceinline__ void xcd_barrier_complete(unsigned* bar, unsigned x, unsigned& nloc, unsigned& nx) {
    const unsigned G = gridDim.x * gridDim.y * gridDim.z;
    unsigned sum, cnt, mine, sp = 0u;
    for (;;) {
        sum = 0u; cnt = 0u; mine = 0u;
#pragma unroll
        for (unsigned j = 0; j < 16; ++j) { const unsigned c = xb_ld(&bar[XB_XCNT(j)]); sum += c; cnt += (c > 0u) ? 1u : 0u; mine = (j == x) ? c : mine; }
        if (sum == G) break;
        __builtin_amdgcn_s_sleep(1);
        if ((++sp & 255u) == 0u) { if (xb_ld(&bar[XB_TMO])) break; if (sp > XB_SPIN_CAP) { atomicAdd(&bar[XB_TMO], 1u); break; } }
    }
    nloc = mine > 0u ? mine : 1u; nx = cnt > 0u ? cnt : 1u;
}

__device__ __forceinline__ void xcd_barrier(const XcdBarrier& b) {
    asm volatile("s_waitcnt vmcnt(0)" ::: "memory");
    __syncthreads();
    if (threadIdx.x == 0) {
        unsigned* bar = b.bar;
        __builtin_amdgcn_s_waitcnt(0);
        unsigned nloc = b.st[0], nx = b.st[1];
        if (nloc == 0u) { xcd_barrier_complete(bar, b.x, nloc, nx); b.st[0] = nloc; b.st[1] = nx; }
        const unsigned old = xb_add(&bar[XB_XSUB(b.x)], 1u);
        const unsigned gen = old / nloc;
        if (old + 1u == (gen + 1u) * nloc) {
            __builtin_amdgcn_fence(__ATOMIC_RELEASE, "agent");
            asm volatile("s_waitcnt vmcnt(0)" ::: "memory");
            const unsigned og = xb_add(&bar[XB_TOP], 1u);
            const unsigned tg = og / nx;
            if (og + 1u == (tg + 1u) * nx) xb_add(&bar[XB_TOPGEN], 1u);
            else XB_SPIN(xb_ld(&bar[XB_TOPGEN]) == tg, bar);
            __builtin_amdgcn_fence(__ATOMIC_ACQUIRE, "agent");
            xb_add(&bar[XB_XGEN(b.x)], 1u);
            asm volatile("s_waitcnt vmcnt(0)" ::: "memory");
        } else {
            XB_SPIN(xb_ld(&bar[XB_XGEN(b.x)]) == gen, bar);
            __builtin_amdgcn_fence(__ATOMIC_ACQUIRE, "agent");
            asm volatile("s_waitcnt vmcnt(0)" ::: "memory");
        }
    }
    __syncthreads();
}

struct Args { const float* in[27]; float* out; unsigned char* ws; int ph_lo, ph_hi; };
struct Frame {
    LAS unsigned char* lds;
    volatile LAS unsigned* MISC;
    gu32* ctl;
    int tid, lane, wave, vcu, G;
};
__device__ __forceinline__ Frame fresh(const Frame& F) {
    Frame N = F; int t = F.tid; asm volatile("" : "+v"(t)); N.tid = t; N.lane = t & 63; N.wave = __builtin_amdgcn_readfirstlane(t >> 6);
    int v = F.vcu; asm volatile("" : "+s"(v)); N.vcu = v; int g = F.G; asm volatile("" : "+s"(g)); N.G = g; return N;
}
#define WSP(T_, off) ((T_*)(args.ws + (off)))
#define INP(i) (args.in[i])

__device__ __forceinline__ void transpose_item(const float* W, int ldw, int k0, int n0, bf16* dst, int ldd, LAS float* scr, int lane) {
#pragma unroll 8
    for (int i = 0; i < 32; ++i) { const int kk = 2 * i + (lane >> 5); scr[kk * 33 + (lane & 31)] = W[(size_t)(k0 + kk) * ldw + n0 + (lane & 31)]; }
    LDS_WAIT(); asm volatile("" ::: "memory");
    const int c = lane & 7;
#pragma unroll
    for (int j = 0; j < 4; ++j) { const int n = (lane >> 3) + 8 * j; const LAS float* s = scr + (8 * c) * 33 + n;
        v4u o; o.x = pk2(s[0 * 33], s[1 * 33]); o.y = pk2(s[2 * 33], s[3 * 33]); o.z = pk2(s[4 * 33], s[5 * 33]); o.w = pk2(s[6 * 33], s[7 * 33]);
        *(v4u*)(dst + (size_t)n * ldd + k0 + 8 * c) = o; }
    LDS_WAIT(); asm volatile("" ::: "memory");
}

__device__ __forceinline__ void p0_prologue(const Frame& F0, const Args& args) {
    const Frame F = fresh(F0);
    const int tid = F.tid, lane = F.lane, wave = F.wave;
    float* MOD = WSP(float, WS_MOD);
    {
        LAS f32x4* cact4 = (LAS f32x4*)(F.lds + RING_OFF);
        LAS float* red = (LAS float*)(F.lds + RING_OFF + 16384);
        if (F.vcu < 192) {
            const float* c = INP(1);
            for (int i = 0; i < 8; ++i) { const int idx = tid + 512 * i, b = idx >> 10, k = idx & 1023; const float v = c[b * 1024 + k]; ((LAS float*)cact4)[k * 4 + b] = v * sigmoidf(v); }
        }
        __syncthreads();
        for (int u = F.vcu; u < 192; u += F.G) {
            const int l = u / 96, j0 = (u % 96) * 64;
            const float* aw = INP(2) + (size_t)l * 1024 * 6144 + j0 + lane;
            float a0 = 0.f, a1 = 0.f, a2 = 0.f, a3 = 0.f;
#pragma unroll 8
            for (int kk = 0; kk < 128; ++kk) { const int k = 128 * wave + kk; const float wv = aw[(size_t)k * 6144]; const f32x4 c4 = cact4[k]; a0 += c4.x * wv; a1 += c4.y * wv; a2 += c4.z * wv; a3 += c4.w * wv; }
            red[(wave * 4 + 0) * 64 + lane] = a0; red[(wave * 4 + 1) * 64 + lane] = a1; red[(wave * 4 + 2) * 64 + lane] = a2; red[(wave * 4 + 3) * 64 + lane] = a3;
            __syncthreads();
            if (tid < 256) { const int b = tid >> 6, ln = tid & 63; float s = INP(3)[l * 6144 + j0 + ln];
#pragma unroll
                for (int w = 0; w < 8; ++w) s += red[(w * 4 + b) * 64 + ln];
                MOD[(size_t)(l * 4 + b) * 6144 + j0 + ln] = s; }
            __syncthreads();
        }
    }
    {
        LAS float* Tt = (LAS float*)(F.lds + RING_OFF);
        LAS float* cs = (LAS float*)(F.lds + RING_OFF + 33792);
        LAS float* sn = cs + 128;
        if (tid < 128) { cs[tid] = cospif((float)tid * (1.0f / 64.0f)); sn[tid] = sinpif((float)tid * (1.0f / 64.0f)); }
        for (int it = F.vcu; it < 128; it += F.G) {
            const int l = it >> 6, g = (it >> 4) & 3, k0 = (it & 15) * 64;
            const float* src = INP(6) + (size_t)l * 1024 * 3072 + 2560 + g * 128;
            __syncthreads();
            for (int i = 0; i < 16; ++i) { const int idx = tid + 512 * i, row = idx >> 7, cc = idx & 127; Tt[row * 129 + cc] = src[(size_t)(k0 + row) * 3072 + cc]; }
            __syncthreads();
            const int kk = tid & 63, og = wave, part = og >> 2, m0 = (og & 3) * 32;
            float acc[32];
#pragma unroll
            for (int i = 0; i < 32; ++i) acc[i] = 0.f;
            const LAS float* tab = part ? sn : cs;
#pragma unroll 2
            for (int cc = 0; cc < 128; ++cc) { const float t = Tt[kk * 129 + cc];
#pragma unroll
                for (int i = 0; i < 32; ++i) acc[i] += t * tab[((m0 + i) * cc) & 127]; }
            bf16* dst = WSP(bf16, WS_WP2) + (size_t)l * NP2 * 1024 + (size_t)(2560 + part * 512 + g * 128 + m0) * 1024 + k0 + kk;
            const float sg = part ? -1.f : 1.f;
#pragma unroll
            for (int i = 0; i < 32; ++i) dst[(size_t)i * 1024] = (bf16)f2bf(sg * acc[i]);
        }
        __syncthreads();
    }
    {
        LAS float* scr = (LAS float*)(F.lds + RING_OFF + wave * 8704);
        const int gw = F.vcu * NWAVES + wave, NGW = F.G * NWAVES;
        for (int it = gw; it < 8192; it += NGW) {
            const int l = it >> 12; int r = it & 4095;
            if (r < 1280) { const int kb = r / 80, nb = r % 80; transpose_item(INP(6) + (size_t)l * 1024 * 3072, 3072, kb * 64, nb * 32, WSP(bf16, WS_WP2) + (size_t)l * NP2 * 1024 + (size_t)(nb * 32) * 1024, 1024, scr, lane); continue; }
            r -= 1280;
            if (r < 1536) { const int kb = r / 96, nb = r % 96; transpose_item(INP(7) + (size_t)l * 1024 * 3072, 3072, kb * 64, nb * 32, WSP(bf16, WS_WP2) + (size_t)l * NP2 * 1024 + (size_t)(3584 + nb * 32) * 1024, 1024, scr, lane); continue; }
            r -= 1536;
            if (r < 768) { const int which = r >> 8, rr = r & 255, kb = rr >> 5, nb = rr & 31; const float* src = (which == 0 ? INP(17) : (which == 1 ? INP(18) : INP(19))) + (size_t)l * 512 * 1024;
                transpose_item(src, 1024, kb * 64, nb * 32, WSP(bf16, WS_WPROJ) + (size_t)(l * 3 + which) * 1024 * 512 + (size_t)(nb * 32) * 512, 512, scr, lane); continue; }
            r -= 768;
            { const int kb = r >> 5, nb = r & 31; transpose_item(INP(20) + (size_t)l * 1024 * 1024, 1024, kb * 64, nb * 32, WSP(bf16, WS_WOUT) + (size_t)l * 1024 * 1024 + (size_t)(nb * 32) * 1024, 1024, scr, lane); }
        }
    }
    {
        const int gt = F.vcu * 512 + tid, NGT = F.G * 512;
        bf16* WL = WSP(bf16, WS_WL);
        for (int idx = gt; idx < 262144; idx += NGT) {
            const int k = idx & 63, n = (idx >> 6) & 255, nb = (idx >> 14) & 7, l = idx >> 17, gate = n >> 6, j = n & 63, dir = gate >> 1, isI = gate & 1;
            const float* src = isI ? INP(14) : INP(12);
            WL[idx] = (bf16)f2bf(src[((size_t)((l * 2 + dir) * 8 + nb) * 64 + k) * 64 + j]);
        }
        bf16* FA = WSP(bf16, WS_FA);
        for (int idx = gt; idx < 16384; idx += NGT) {
            const int m = idx >> 7, k = idx & 127, k1 = m & 63, pm_ = m >> 6, t1 = k & 63, pk = k >> 6, a = (k1 * t1) & 63;
            const float c = cospif((float)a * (1.0f / 32.0f)), s = sinpif((float)a * (1.0f / 32.0f));
            FA[idx] = (bf16)f2bf(pm_ == 0 ? (pk == 0 ? c : s) : (pk == 0 ? -s : c));
        }
        bf16* FB = WSP(bf16, WS_FB);
        for (int idx = gt; idx < 32768; idx += NGT) {
            const int k2 = idx >> 8, k = idx & 255, part = k >> 7, t2 = k & 127, a = (k2 * t2) & 127;
            FB[idx] = (bf16)f2bf(part == 0 ? cospif((float)a * (1.0f / 64.0f)) : sinpif((float)a * (1.0f / 64.0f)));
        }
        f32x2* TW = WSP(f32x2, WS_TW);
        for (int idx = gt; idx < 8192; idx += NGT) {
            const int t2 = idx >> 6, k1 = idx & 63; const float x = (float)(t2 * k1) * (1.0f / 4096.0f);
            TW[idx] = (f32x2){cospif(x), sinpif(x)};
        }
    }
}

template <int MODE>
__device__ __forceinline__ void rows_phase(const Frame& F0, const Args& args, int l) {
    const Frame F = fresh(F0);
    const int tid = F.tid, lane = F.lane, wave = F.wave;
    const float* MOD = WSP(float, WS_MOD);
    LAS float* gsc = (LAS float*)(F.lds + RING_OFF);
    LAS float* shf = gsc + 4096;
    LAS float* gtf = shf + 4096;
    for (int i = 0; i < 8; ++i) { const int idx = tid + 512 * i, b = idx >> 10, col = idx & 1023;
        if (MODE != 2) { gsc[idx] = INP(4)[l * 1024 + col] * (1.0f + MOD[(size_t)(l * 4 + b) * 6144 + 1024 + col]); shf[idx] = MOD[(size_t)(l * 4 + b) * 6144 + col]; }
        else gsc[idx] = INP(26)[col];
        if (MODE != 0) gtf[idx] = MOD[(size_t)((l - 1) * 4 + b) * 6144 + 5 * 1024 + col]; }
    __syncthreads();
    const float* xin = (MODE == 0) ? INP(0) : args.out;
    bf16* U = WSP(bf16, WS_U);
    const bf16* YE = WSP(bf16, WS_PROJ);
    const int* tokrow = WSP(int, WS_TOKROW); const float* tokw = WSP(float, WS_TOKW);
    const int gw = F.vcu * NWAVES + wave, NGW = F.G * NWAVES;
    for (int m = gw; m < NTOK; m += NGW) {
        const int b = m >> 13;
        const f32x4* xr = (const f32x4*)(xin + (size_t)m * D) + lane;
        f32x4 v[4];
#pragma unroll
        for (int j = 0; j < 4; ++j) v[j] = xr[64 * j];
        if (MODE != 0) {
            const int r0 = tokrow[2 * m], r1 = tokrow[2 * m + 1]; const float w0 = tokw[2 * m], w1 = tokw[2 * m + 1];
            const v2u* y0 = (const v2u*)(YE + (size_t)r0 * 1024) + lane; const v2u* y1 = (const v2u*)(YE + (size_t)r1 * 1024) + lane;
#pragma unroll
            for (int j = 0; j < 4; ++j) { const v2u a = y0[64 * j], c = y1[64 * j]; const f32x4 g = *(const LAS f32x4*)(gtf + b * 1024 + 4 * lane + 256 * j);
                v[j].x += g.x * (w0 * bflo(a.x) + w1 * bflo(c.x)); v[j].y += g.y * (w0 * bfhi(a.x) + w1 * bfhi(c.x));
                v[j].z += g.z * (w0 * bflo(a.y) + w1 * bflo(c.y)); v[j].w += g.w * (w0 * bfhi(a.y) + w1 * bfhi(c.y)); }
        }
        float ss = 0.f;
#pragma unroll
        for (int j = 0; j < 4; ++j) ss += (v[j].x * v[j].x + v[j].y * v[j].y) + (v[j].z * v[j].z + v[j].w * v[j].w);
        const float rstd = 1.0f / sqrtf(wave_sum(ss) * (1.0f / D) + EPS);
        if (MODE == 2) {
            f32x4* o = (f32x4*)(args.out + (size_t)m * D) + lane;
#pragma unroll
            for (int j = 0; j < 4; ++j) { const f32x4 g = *(const LAS f32x4*)(gsc + 4 * lane + 256 * j); o[64 * j] = v[j] * rstd * g; }
        } else {
            if (MODE == 1) { f32x4* o = (f32x4*)(args.out + (size_t)m * D) + lane;
#pragma unroll
                for (int j = 0; j < 4; ++j) o[64 * j] = v[j]; }
            v2u* uo = (v2u*)(U + (size_t)m * D) + lane;
#pragma unroll
            for (int j = 0; j < 4; ++j) { const f32x4 g = *(const LAS f32x4*)(gsc + b * 1024 + 4 * lane + 256 * j), s = *(const LAS f32x4*)(shf + b * 1024 + 4 * lane + 256 * j);
                const f32x4 u = v[j] * rstd * g + s; uo[64 * j] = (v2u){pk2(u.x, u.y), pk2(u.z, u.w)}; }
        }
    }
}

struct EpiP2 {
    static constexpr bool PERM = true;
    bf16* proj; bf16* vt; bf16* gates; const float* gbias;
    __device__ __forceinline__ void operator()(const f32x4 (&acc)[2][2][4][2], const pg8::Unit& u, int wr, int wc, int fr, int fq) const {
        const int row0 = u.pm * 256 + wr * 64 + fr, pn = u.pn;
        if (pn == 4 || pn == 5) {
#pragma unroll
            for (int ai = 0; ai < 2; ++ai)
#pragma unroll
                for (int m = 0; m < 4; ++m) { const int row = row0 + ai * 128 + m * 16, b = row >> 13, t = row & 8191;
#pragma unroll
                    for (int bj = 0; bj < 2; ++bj)
#pragma unroll
                        for (int n = 0; n < 2; ++n) { const int col = (pn - 4) * 256 + bj * 128 + wc * 32 + 8 * fq + 4 * n; bf16* d = vt + ((size_t)(b * 512 + col)) * 8192 + t;
                            d[0] = (bf16)f2bf(acc[ai][bj][m][n][0]); d[8192] = (bf16)f2bf(acc[ai][bj][m][n][1]); d[2 * 8192] = (bf16)f2bf(acc[ai][bj][m][n][2]); d[3 * 8192] = (bf16)f2bf(acc[ai][bj][m][n][3]); } }
        } else if (pn < 14) {
            const int cbase = (pn < 4 ? pn * 256 : (pn - 2) * 256) + wc * 32 + 8 * fq; const float sc = pn < 2 ? 0.125f : 1.0f;
#pragma unroll
            for (int ai = 0; ai < 2; ++ai)
#pragma unroll
                for (int m = 0; m < 4; ++m) { bf16* rowp = proj + (size_t)(row0 + ai * 128 + m * 16) * PROJ_LD + cbase;
#pragma unroll
                    for (int bj = 0; bj < 2; ++bj) { const f32x4 v0 = acc[ai][bj][m][0] * sc, v1 = acc[ai][bj][m][1] * sc;
                        *(v4u*)(rowp + bj * 128) = (v4u){pk2(v0[0], v0[1]), pk2(v0[2], v0[3]), pk2(v1[0], v1[1]), pk2(v1[2], v1[3])}; } }
        } else {
            const int cbase = (pn - 14) * 256 + wc * 32 + 8 * fq;
            f32x4 bv[2][2];
#pragma unroll
            for (int bj = 0; bj < 2; ++bj)
#pragma unroll
                for (int n = 0; n < 2; ++n) bv[bj][n] = *(const f32x4*)(gbias + cbase + bj * 128 + 4 * n);
#pragma unroll
            for (int ai = 0; ai < 2; ++ai)
#pragma unroll
                for (int m = 0; m < 4; ++m) { bf16* rowp = gates + (size_t)(row0 + ai * 128 + m * 16) * GATES_LD + cbase;
#pragma unroll
                    for (int bj = 0; bj < 2; ++bj) { f32x4 v0 = acc[ai][bj][m][0] + bv[bj][0], v1 = acc[ai][bj][m][1] + bv[bj][1];
#pragma unroll
                        for (int e = 0; e < 4; ++e) { v0[e] = sigmoidf(v0[e]); v1[e] = sigmoidf(v1[e]); }
                        *(v4u*)(rowp + bj * 128) = (v4u){pk2(v0[0], v0[1]), pk2(v0[2], v0[3]), pk2(v1[0], v1[1]), pk2(v1[2], v1[3])}; } }
        }
    }
};
struct EpiMerge {
    static constexpr bool PERM = true;
    const bf16* gates; bf16* merged;
    __device__ __forceinline__ void operator()(const f32x4 (&acc)[2][2][4][2], const pg8::Unit& u, int wr, int wc, int fr, int fq) const {
        const int row0 = u.pm * 256 + wr * 64 + fr, cbase = u.pn * 256 + wc * 32 + 8 * fq, z = u.z;
#pragma unroll
        for (int ai = 0; ai < 2; ++ai)
#pragma unroll
            for (int m = 0; m < 4; ++m) { const size_t row = (size_t)(row0 + ai * 128 + m * 16);
#pragma unroll
                for (int bj = 0; bj < 2; ++bj) { const v4u gv = *(const v4u*)(gates + row * GATES_LD + z * 1024 + cbase + bj * 128);
                    bf16* mp = merged + row * 1024 + cbase + bj * 128;
                    f32x4 v0 = acc[ai][bj][m][0], v1 = acc[ai][bj][m][1];
                    v0[0] *= bflo(gv.x); v0[1] *= bfhi(gv.x); v0[2] *= bflo(gv.y); v0[3] *= bfhi(gv.y); v1[0] *= bflo(gv.z); v1[1] *= bfhi(gv.z); v1[2] *= bflo(gv.w); v1[3] *= bfhi(gv.w);
                    if (z > 0) { const v4u ov = *(const v4u*)mp;
                        v0[0] += bflo(ov.x); v0[1] += bfhi(ov.x); v0[2] += bflo(ov.y); v0[3] += bfhi(ov.y); v1[0] += bflo(ov.z); v1[1] += bfhi(ov.z); v1[2] += bflo(ov.w); v1[3] += bfhi(ov.w); }
                    *(v4u*)mp = (v4u){pk2(v0[0], v0[1]), pk2(v0[2], v0[3]), pk2(v1[0], v1[1]), pk2(v1[2], v1[3])}; } }
    }
};
struct EpiResid {
    static constexpr bool PERM = false;
    const float* xin; float* xout; const float* gt;
    __device__ __forceinline__ void operator()(const f32x4 (&acc)[2][2][4][2], const pg8::Unit& u, int wr, int wc, int fr, int fq) const {
        const int row0 = u.pm * 256 + wr * 64 + fr, col0 = u.pn * 256 + wc * 32 + 4 * fq, b = (u.pm * 256) >> 13;
        f32x4 gv[2][2];
#pragma unroll
        for (int bj = 0; bj < 2; ++bj)
#pragma unroll
            for (int n = 0; n < 2; ++n) gv[bj][n] = *(const f32x4*)(gt + (size_t)b * 6144 + col0 + bj * 128 + n * 16);
#pragma unroll
        for (int ai = 0; ai < 2; ++ai)
#pragma unroll
            for (int m = 0; m < 4; ++m) { const size_t off = (size_t)(row0 + ai * 128 + m * 16) * D + col0;
#pragma unroll
                for (int bj = 0; bj < 2; ++bj)
#pragma unroll
                    for (int n = 0; n < 2; ++n) { const f32x4 xv = *(const f32x4*)(xin + off + bj * 128 + n * 16); *(f32x4*)(xout + off + bj * 128 + n * 16) = xv + gv[bj][n] * acc[ai][bj][m][n]; } }
    }
};
struct EpiSwiGLU {
    static constexpr bool PERM = true;
    bf16* H;
    __device__ __forceinline__ void operator()(const f32x4 (&acc)[2][2][4][2], const pg8::Unit& u, int wr, int wc, int fr, int fq) const {
        const int row0 = u.pm * 256 + wr * 64 + fr, cbase = u.pn * 128 + wc * 32 + 8 * fq;
#pragma unroll
        for (int ai = 0; ai < 2; ++ai)
#pragma unroll
            for (int m = 0; m < 4; ++m) { f32x4 h0, h1;
#pragma unroll
                for (int e = 0; e < 4; ++e) { const float g0 = acc[ai][0][m][0][e], g1 = acc[ai][0][m][1][e]; h0[e] = g0 * sigmoidf(g0) * acc[ai][1][m][0][e]; h1[e] = g1 * sigmoidf(g1) * acc[ai][1][m][1][e]; }
                *(v4u*)(H + (size_t)(row0 + ai * 128 + m * 16) * 512 + cbase) = (v4u){pk2(h0[0], h0[1]), pk2(h0[2], h0[3]), pk2(h1[0], h1[1]), pk2(h1[2], h1[3])}; }
    }
};
struct EpiYE {
    static constexpr bool PERM = true;
    bf16* YE;
    __device__ __forceinline__ void operator()(const f32x4 (&acc)[2][2][4][2], const pg8::Unit& u, int wr, int wc, int fr, int fq) const {
        const int row0 = u.pm * 256 + wr * 64 + fr, cbase = u.pn * 256 + wc * 32 + 8 * fq;
#pragma unroll
        for (int ai = 0; ai < 2; ++ai)
#pragma unroll
            for (int m = 0; m < 4; ++m) { bf16* rowp = YE + (size_t)(row0 + ai * 128 + m * 16) * 1024 + cbase;
#pragma unroll
                for (int bj = 0; bj < 2; ++bj) { const f32x4 v0 = acc[ai][bj][m][0], v1 = acc[ai][bj][m][1];
                    *(v4u*)(rowp + bj * 128) = (v4u){pk2(v0[0], v0[1]), pk2(v0[2], v0[3]), pk2(v1[0], v1[1]), pk2(v1[2], v1[3])}; } }
    }
};

__device__ __forceinline__ void attn_unit(bf16* PROJ, const bf16* VT, const LAS float* rpb, int b, int h, int r, int qb, int lane) {
    const int qn = lane & 15, g = lane >> 4;
    const int rs = min(max(r - 4, 0), 120);
    const int cb = (qb == 0) ? 0 : ((qb == 1) ? 8 : ((qb == 2) ? 24 : 32));
    const int w = 16 * qb + qn, cs = min(max(w - 8, 0), 48);
    const size_t tokq = (size_t)b * T + r * 64 + w;
    bf16* qp = PROJ + tokq * PROJ_LD + Q_OFF + h * 64;
    bf16x8 qf0 = *(const bf16x8*)(qp + 8 * g), qf1 = *(const bf16x8*)(qp + 32 + 8 * g);
    const bf16* kbase = PROJ + ((size_t)b * T + rs * 64 + cb + qn) * PROJ_LD + K_OFF + h * 64 + 8 * g;
    f32x4 sc[16];
#pragma unroll
    for (int kt = 0; kt < 16; ++kt) {
        const int kr = kt >> 1, ch = kt & 1;
        const bf16* kp = kbase + (size_t)(kr * 64 + 16 * ch) * PROJ_LD;
        const bf16x8 kf0 = *(const bf16x8*)kp, kf1 = *(const bf16x8*)(kp + 32);
        f32x4 a = (f32x4){0.f, 0.f, 0.f, 0.f};
        a = __builtin_amdgcn_mfma_f32_16x16x32_bf16(kf0, qf0, a, 0, 0, 0);
        a = __builtin_amdgcn_mfma_f32_16x16x32_bf16(kf1, qf1, a, 0, 0, 0);
        sc[kt] = a;
    }
    const LAS float* rp = rpb + h * 465;
    float mx = -1e30f;
#pragma unroll
    for (int kt = 0; kt < 16; ++kt) {
        const int kr = kt >> 1, ch = kt & 1;
        const int brow = (rs + kr - r + 7) * 31;
#pragma unroll
        for (int j = 0; j < 4; ++j) {
            const int kc = cb + 16 * ch + 4 * g + j, dc = kc - w + 15;
            const bool ok = (kc >= cs) && (kc <= cs + 15);
            const float bias = rp[brow + (ok ? dc : 15)];
            const float s = ok ? sc[kt][j] + bias : -1e30f;
            sc[kt][j] = s; mx = fmaxf(mx, s);
        }
    }
    mx = fmaxf(mx, __shfl_xor(mx, 16)); mx = fmaxf(mx, __shfl_xor(mx, 32));
    float sum = 0.f;
#pragma unroll
    for (int kt = 0; kt < 16; ++kt)
#pragma unroll
        for (int j = 0; j < 4; ++j) { const float p = __expf(sc[kt][j] - mx); sc[kt][j] = p; sum += p; }
    sum += __shfl_xor(sum, 16); sum += __shfl_xor(sum, 32);
    const float inv = 1.0f / sum;
    f32x4 o[4];
#pragma unroll
    for (int dt = 0; dt < 4; ++dt) o[dt] = (f32x4){0.f, 0.f, 0.f, 0.f};
    const bf16* vbase = VT + ((size_t)(b * 512 + h * 64 + qn)) * T + rs * 64 + cb + 4 * g;
#pragma unroll
    for (int kr = 0; kr < 8; ++kr) {
        v4u pw; pw.x = pk2(sc[2 * kr][0], sc[2 * kr][1]); pw.y = pk2(sc[2 * kr][2], sc[2 * kr][3]); pw.z = pk2(sc[2 * kr + 1][0], sc[2 * kr + 1][1]); pw.w = pk2(sc[2 * kr + 1][2], sc[2 * kr + 1][3]);
        const bf16x8 pf = __builtin_bit_cast(bf16x8, pw);
#pragma unroll
        for (int dt = 0; dt < 4; ++dt) {
            const bf16* vp = vbase + (size_t)(16 * dt) * T + kr * 64;
            const v2u lo = *(const v2u*)vp, hi = *(const v2u*)(vp + 16);
            const v4u vw = (v4u){lo.x, lo.y, hi.x, hi.y};
            o[dt] = __builtin_amdgcn_mfma_f32_16x16x32_bf16(__builtin_bit_cast(bf16x8, vw), pf, o[dt], 0, 0, 0);
        }
    }
#pragma unroll
    for (int dt = 0; dt < 4; ++dt) *(v2u*)(qp + 16 * dt + 4 * g) = (v2u){pk2(o[dt][0] * inv, o[dt][1] * inv), pk2(o[dt][2] * inv, o[dt][3] * inv)};
}
__device__ __forceinline__ void attn_phase(const Frame& F0, const Args& args, int l) {
    const Frame F = fresh(F0);
    LAS float* rpb = (LAS float*)(F.lds + RING_OFF);
    for (int i = F.tid; i < 8 * 465; i += 512) rpb[i] = INP(9)[l * 8 * 465 + i];
    __syncthreads();
    bf16* PROJ = WSP(bf16, WS_PROJ); const bf16* VT = WSP(bf16, WS_VT);
    for (int wu = F.vcu * NWAVES + F.wave; wu < 16384; wu += F.G * NWAVES) {
        const int bh = wu >> 9, rem = wu & 511;
        attn_unit(PROJ, VT, rpb, bh >> 3, bh & 7, rem >> 2, rem & 3, F.lane);
    }
    __syncthreads();
}

__device__ __forceinline__ float gelu_tanh(float x) { const float u = 0.7978845608028654f * (x + 0.044715f * x * x * x); const float t = 1.0f - 2.0f / (1.0f + __expf(2.0f * u)); return 0.5f * x * (1.0f + t); }
template <bool FINAL>
__device__ __forceinline__ void lru_phase(const Frame& F0, const Args& args, int l) {
    const Frame F = fresh(F0);
    const int tid = F.tid, lane = F.lane, wave = F.wave;
    LAS float* XH = (LAS float*)(F.lds + RING_OFF);
    LAS float* XCF = (LAS float*)(F.lds + RING_OFF + 18432);
    LAS bf16* XCB = (LAS bf16*)(F.lds + RING_OFF + 34816);
    LAS float* AG = (LAS float*)(F.lds + RING_OFF + 45056);
    LAS float* BX = (LAS float*)(F.lds + RING_OFF + 77824);
    bf16* PROJ = WSP(bf16, WS_PROJ);
    const bf16* WL = WSP(bf16, WS_WL) + (size_t)l * 8 * 256 * 64;
    f32x2* LSUM = WSP(f32x2, WS_LSUM); const float* LCAR = WSP(float, WS_LCAR);
    const float* cw = INP(10) + l * 4 * 512; const float* cbias = INP(11) + l * 512;
    for (int un = F.vcu; un < 4096; un += F.G) {
        const int b = un >> 10, rem = un & 1023, c = rem >> 2, qd = rem & 3, t0 = c * LRU_CH, ch0 = qd * 128;
        for (int idx = tid; idx < 35 * 16; idx += 512) { const int rr = idx >> 4, cg = idx & 15, t = t0 + rr - 2;
            v4u v = (v4u){0u, 0u, 0u, 0u}; if (t >= 0 && t < T) v = *(const v4u*)(PROJ + ((size_t)b * T + t) * PROJ_LD + XR_OFF + ch0 + cg * 8);
            LAS float* d = XH + rr * 128 + cg * 8;
            d[0] = bflo(v.x); d[1] = bfhi(v.x); d[2] = bflo(v.y); d[3] = bfhi(v.y); d[4] = bflo(v.z); d[5] = bfhi(v.z); d[6] = bflo(v.w); d[7] = bfhi(v.w); }
        __syncthreads();
        { const int tok = tid >> 4, cg = tid & 15;
#pragma unroll
            for (int e = 0; e < 8; ++e) { const int chl = cg * 8 + e, ch = ch0 + chl;
                float a = cbias[ch];
#pragma unroll
                for (int j = 0; j < 4; ++j) a += cw[j * 512 + ch] * XH[(tok + j) * 128 + chl];
                XCF[tok * 128 + chl] = a; XCB[((chl >> 6) * 32 + tok) * 72 + (chl & 63)] = (bf16)f2bf(a); } }
        __syncthreads();
        { const int hb = wave >> 2, dir = (wave >> 1) & 1, half = wave & 1, nl = lane & 31, hh = lane >> 5;
            const int chl = 64 * hb + 32 * half + nl, ch = ch0 + chl;
            const bf16* wr_ = WL + ((size_t)(2 * qd + hb) * 256 + (2 * dir + 0) * 64 + 32 * half + nl) * 64 + 8 * hh;
            const bf16* wi_ = WL + ((size_t)(2 * qd + hb) * 256 + (2 * dir + 1) * 64 + 32 * half + nl) * 64 + 8 * hh;
            f32x16 ar = {}, ai = {};
#pragma unroll
            for (int s = 0; s < 4; ++s) {
                const bf16x8 af = *(const LAS bf16x8*)(XCB + (hb * 32 + nl) * 72 + 16 * s + 8 * hh);
                const bf16x8 br = *(const bf16x8*)(wr_ + 16 * s), bi = *(const bf16x8*)(wi_ + 16 * s);
                ar = __builtin_amdgcn_mfma_f32_32x32x16_bf16(af, br, ar, 0, 0, 0);
                ai = __builtin_amdgcn_mfma_f32_32x32x16_bf16(af, bi, ai, 0, 0, 0);
            }
            const float b_r = INP(13)[(l * 2 + dir) * 512 + ch], b_i = INP(15)[(l * 2 + dir) * 512 + ch], lam = INP(16)[(l * 2 + dir) * 512 + ch];
            const float sp = (lam > 15.f) ? __expf(-lam) : log1pf(__expf(-lam));
#pragma unroll
            for (int rg = 0; rg < 16; ++rg) { const int tok = (rg & 3) + 8 * (rg >> 2) + 4 * hh;
                const float rr = sigmoidf(ar[rg] + b_r), ii = sigmoidf(ai[rg] + b_i);
                const float la = -8.0f * rr * sp, a = __expf(la);
                const float bx = sqrtf(fmaxf(-expm1f(2.0f * la), 0.f)) * (ii * XCF[tok * 128 + chl]);
                AG[(dir * 32 + tok) * 128 + chl] = a; BX[(dir * 32 + tok) * 128 + chl] = bx; } }
        __syncthreads();
        if (tid < 256) { const int dir = tid >> 7, chl = tid & 127; const size_t sidx = ((size_t)(b * LRU_NCH + c) * 2 + dir) * 512 + ch0 + chl;
            if (!FINAL) { float A = 1.f, B = 0.f;
#pragma unroll 8
                for (int i = 0; i < 32; ++i) { const int t = dir ? 31 - i : i; const float a = AG[(dir * 32 + t) * 128 + chl]; B = a * B + BX[(dir * 32 + t) * 128 + chl]; A *= a; }
                LSUM[sidx] = (f32x2){A, B};
            } else { float h = LCAR[sidx];
#pragma unroll 8
                for (int i = 0; i < 32; ++i) { const int t = dir ? 31 - i : i; h = AG[(dir * 32 + t) * 128 + chl] * h + BX[(dir * 32 + t) * 128 + chl]; BX[(dir * 32 + t) * 128 + chl] = h; } } }
        if (FINAL) {
            __syncthreads();
            const int tok = tid >> 4, cg = tid & 15; bf16* yp = PROJ + ((size_t)b * T + t0 + tok) * PROJ_LD + YR_OFF + ch0 + cg * 8;
            const v4u yv = *(const v4u*)yp; float y[8] = {bflo(yv.x), bfhi(yv.x), bflo(yv.y), bfhi(yv.y), bflo(yv.z), bfhi(yv.z), bflo(yv.w), bfhi(yv.w)};
#pragma unroll
            for (int e = 0; e < 8; ++e) { const int chl = cg * 8 + e; y[e] = (BX[tok * 128 + chl] + BX[(32 + tok) * 128 + chl]) * gelu_tanh(y[e]); }
            *(v4u*)yp = (v4u){pk2(y[0], y[1]), pk2(y[2], y[3]), pk2(y[4], y[5]), pk2(y[6], y[7])};
        }
        __syncthreads();
    }
}
__device__ __forceinline__ void lru_carry(const Frame& F0, const Args& args) {
    const Frame F = fresh(F0);
    if (F.wave != 0 || F.vcu >= 64) return;
    const int seq = F.vcu * 64 + F.lane, b = seq >> 10, dir = (seq >> 9) & 1, ch = seq & 511;
    const f32x2* LSUM = WSP(f32x2, WS_LSUM); float* LCAR = WSP(float, WS_LCAR);
    float h = 0.f;
#pragma unroll 8
    for (int i = 0; i < LRU_NCH; ++i) { const int c = dir ? LRU_NCH - 1 - i : i; const size_t sidx = ((size_t)(b * LRU_NCH + c) * 2 + dir) * 512 + ch;
        const f32x2 ab = LSUM[sidx]; LCAR[sidx] = h; h = ab.x * h + ab.y; }
}

__device__ __forceinline__ void fft_a_phase(const Frame& F0, const Args& args) {
    const Frame F = fresh(F0);
    const int lane = F.lane, nl = lane & 31, hh = lane >> 5;
    const bf16* PROJ = WSP(bf16, WS_PROJ); const bf16* FA = WSP(bf16, WS_FA); const f32x2* TW = WSP(f32x2, WS_TW); bf16* ZP = WSP(bf16, WS_U);
    for (int wu = F.vcu * NWAVES + F.wave; wu < 8192; wu += F.G * NWAVES) {
        const int ct = wu & 15, t2 = (wu >> 4) & 127, b = wu >> 11;
        bf16x8 bf[8];
#pragma unroll
        for (int s = 0; s < 8; ++s) { const int part = s >> 2, t1b = 16 * (s & 3) + 8 * hh;
            const bf16* p = PROJ + ((size_t)b * T + (size_t)128 * t1b + t2) * PROJ_LD + G_OFF + part * 512 + 32 * ct + nl;
            unsigned short e[8];
#pragma unroll
            for (int j = 0; j < 8; ++j) e[j] = p[(size_t)j * 128 * PROJ_LD];
            v4u w; w.x = e[0] | ((unsigned)e[1] << 16); w.y = e[2] | ((unsigned)e[3] << 16); w.z = e[4] | ((unsigned)e[5] << 16); w.w = e[6] | ((unsigned)e[7] << 16);
            bf[s] = __builtin_bit_cast(bf16x8, w); }
        f32x16 acc[4];
#pragma unroll
        for (int mt = 0; mt < 4; ++mt) { acc[mt] = (f32x16){};
#pragma unroll
            for (int s = 0; s < 8; ++s) { const bf16x8 af = *(const bf16x8*)(FA + (32 * mt + nl) * 128 + 16 * s + 8 * hh); acc[mt] = __builtin_amdgcn_mfma_f32_32x32x16_bf16(af, bf[s], acc[mt], 0, 0, 0); } }
#pragma unroll
        for (int mt = 0; mt < 2; ++mt)
#pragma unroll
            for (int rg = 0; rg < 16; ++rg) { const int k1 = 32 * mt + (rg & 3) + 8 * (rg >> 2) + 4 * hh; const f32x2 cs = TW[t2 * 64 + k1];
                const float zr = acc[mt][rg], zi = acc[mt + 2][rg];
                bf16* d = ZP + ((size_t)(b * 64 + k1) * 128 + t2) * 1024 + 32 * ct + nl;
                d[0] = (bf16)f2bf(zr * cs.x + zi * cs.y); d[512] = (bf16)f2bf(zi * cs.x - zr * cs.y); }
    }
}
__device__ __forceinline__ void fft_b_phase(const Frame& F0, const Args& args) {
    const Frame F = fresh(F0);
    const int lane = F.lane, nl = lane & 31, hh = lane >> 5;
    bf16* PROJ = WSP(bf16, WS_PROJ); const bf16* FB = WSP(bf16, WS_FB); const bf16* ZP = WSP(bf16, WS_U);
    for (int wu = F.vcu * NWAVES + F.wave; wu < 4096; wu += F.G * NWAVES) {
        const int ct = wu & 15, k1 = (wu >> 4) & 63, b = wu >> 10;
        f32x16 acc[4];
#pragma unroll
        for (int mt = 0; mt < 4; ++mt) acc[mt] = (f32x16){};
#pragma unroll 1
        for (int sc = 0; sc < 4; ++sc) {
            bf16x8 bf[4];
#pragma unroll
            for (int q = 0; q < 4; ++q) { const int s = 4 * sc + q, part = s >> 3, t2b = 16 * (s & 7) + 8 * hh;
                const bf16* p = ZP + ((size_t)(b * 64 + k1) * 128 + t2b) * 1024 + part * 512 + 32 * ct + nl;
                unsigned short e[8];
#pragma unroll
                for (int j = 0; j < 8; ++j) e[j] = p[(size_t)j * 1024];
                v4u w; w.x = e[0] | ((unsigned)e[1] << 16); w.y = e[2] | ((unsigned)e[3] << 16); w.z = e[4] | ((unsigned)e[5] << 16); w.w = e[6] | ((unsigned)e[7] << 16);
                bf[q] = __builtin_bit_cast(bf16x8, w); }
#pragma unroll
            for (int mt = 0; mt < 4; ++mt)
#pragma unroll
                for (int q = 0; q < 4; ++q) { const bf16x8 af = *(const bf16x8*)(FB + (32 * mt + nl) * 256 + 16 * (4 * sc + q) + 8 * hh); acc[mt] = __builtin_amdgcn_mfma_f32_32x32x16_bf16(af, bf[q], acc[mt], 0, 0, 0); }
        }
#pragma unroll
        for (int mt = 0; mt < 4; ++mt)
#pragma unroll
            for (int rg = 0; rg < 16; ++rg) { const int k2 = 32 * mt + (rg & 3) + 8 * (rg >> 2) + 4 * hh;
                PROJ[((size_t)b * T + k1 + 64 * k2) * PROJ_LD + G_OFF + 32 * ct + nl] = (bf16)f2bf(acc[mt][rg] * (1.0f / 1024.0f)); }
    }
}

__device__ __forceinline__ void router_phase(const Frame& F0, const Args& args, int l) {
    const Frame F = fresh(F0);
    const int tid = F.tid, lane = F.lane, wave = F.wave;
    const float* MOD = WSP(float, WS_MOD);
    LAS float* WPL = (LAS float*)(F.lds + RING_OFF);
    LAS float* gsc = (LAS float*)(F.lds + XTRA_OFF);
    LAS float* shf = gsc + 1024;
    LAS float* c0 = shf + 1024;
    LAS float* rb = c0 + 32;
    LAS unsigned* lcnt = (LAS unsigned*)(rb + 32);
    LAS unsigned* lbase = lcnt + 32;
    LAS float* red = (LAS float*)(lbase + 32);
    const float* x = args.out; bf16* U2 = WSP(bf16, WS_U);
    float* tokw = WSP(float, WS_TOKW); int* perm = WSP(int, WS_PERM);
    unsigned* ecnt = (unsigned*)(F.ctl + CW_ECNT + l * 32 * 64);
    const int nround = (2048 + F.G * NWAVES - 1) / (F.G * NWAVES);
    int cur_b = -1;
    for (int rd = 0; rd < nround; ++rd) {
        const int unit = (rd * F.G + F.vcu) * NWAVES + wave;
        const int ub = (((rd * F.G + F.vcu) * NWAVES) * 16) >> 13;
        const bool wg_active = ((rd * F.G + F.vcu) * NWAVES) < 2048;
        if (wg_active && ub != cur_b) {
            cur_b = ub; __syncthreads();
            for (int i = 0; i < 2; ++i) { const int col = tid + 512 * i; gsc[col] = INP(5)[l * 1024 + col] * (1.0f + MOD[(size_t)(l * 4 + ub) * 6144 + 4 * 1024 + col]); shf[col] = MOD[(size_t)(l * 4 + ub) * 6144 + 3 * 1024 + col]; }
            if (tid < 32) rb[tid] = INP(22)[tid];
            __syncthreads();
            for (int i = 0; i < 64; ++i) { const int idx = tid + 512 * i, k = idx >> 5, e = idx & 31; WPL[k * 32 + (e ^ (((k >> 8) & 1) << 4))] = gsc[k] * INP(21)[idx]; }
            { const int e = tid & 31, pt = tid >> 5; float s = 0.f;
                for (int k = pt * 64; k < pt * 64 + 64; ++k) s += shf[k] * INP(21)[k * 32 + e];
                red[tid] = s; }
            __syncthreads();
            if (tid < 32) { float s = 0.f; for (int p = 0; p < 16; ++p) s += red[p * 32 + tid]; c0[tid] = s; }
        }
        if (tid < 32) lcnt[tid] = 0u;
        __syncthreads();
        int e0 = 0, e1 = 0; unsigned rk0 = 0, rk1 = 0; float w0 = 0.f, w1 = 0.f; bool owner = false; int mytok = 0;
        if (unit < 2048) {
            const int tok0 = unit * 16;
            float rs_reg = 0.f;
            for (int i = 0; i < 16; ++i) { const int m = tok0 + i;
                const f32x4* xr = (const f32x4*)(x + (size_t)m * D) + lane; f32x4 v[4]; float ss = 0.f;
#pragma unroll
                for (int j = 0; j < 4; ++j) { v[j] = xr[64 * j]; ss += (v[j].x * v[j].x + v[j].y * v[j].y) + (v[j].z * v[j].z + v[j].w * v[j].w); }
                const float rstd = 1.0f / sqrtf(wave_sum(ss) * (1.0f / D) + EPS);
                if ((lane & 15) == i) rs_reg = rstd;
                v2u* uo = (v2u*)(U2 + (size_t)m * D) + lane;
#pragma unroll
                for (int j = 0; j < 4; ++j) { const f32x4 g = *(const LAS f32x4*)(gsc + 4 * lane + 256 * j), s = *(const LAS f32x4*)(shf + 4 * lane + 256 * j);
                    const f32x4 u = v[j] * rstd * g + s; uo[64 * j] = (v2u){pk2(u.x, u.y), pk2(u.z, u.w)}; } }
            const int ti = lane & 15, kq = lane >> 4;
            const f32x4* xrow = (const f32x4*)(x + (size_t)(tok0 + ti) * D + 256 * kq);
            const LAS float* wp0 = WPL + (256 * kq) * 32 + (ti ^ ((kq & 1) << 4));
            const LAS float* wp1 = WPL + (256 * kq) * 32 + ((16 + ti) ^ ((kq & 1) << 4));
            f32x4 a0 = {0.f, 0.f, 0.f, 0.f}, a1 = {0.f, 0.f, 0.f, 0.f};
#pragma unroll 4
            for (int t4 = 0; t4 < 64; ++t4) { const f32x4 xv = xrow[t4];
#pragma unroll
                for (int jj = 0; jj < 4; ++jj) { const int kk = 4 * t4 + jj;
                    a0 = __builtin_amdgcn_mfma_f32_16x16x4f32(wp0[kk * 32], xv[jj], a0, 0, 0, 0);
                    a1 = __builtin_amdgcn_mfma_f32_16x16x4f32(wp1[kk * 32], xv[jj], a1, 0, 0, 0); } }
            float sco[2][4], sel[2][4], gs[2];
#pragma unroll
            for (int nt = 0; nt < 2; ++nt) {
#pragma unroll
                for (int rg = 0; rg < 4; ++rg) { const int e = 16 * nt + 4 * kq + rg; const float lg = rs_reg * (nt ? a1[rg] : a0[rg]) + c0[e]; sco[nt][rg] = sigmoidf(lg); sel[nt][rg] = sco[nt][rg] + rb[e]; }
                float m1 = fmaxf(sel[nt][0], sel[nt][1]), m2 = fminf(sel[nt][0], sel[nt][1]);
                { const float v = sel[nt][2]; if (v > m1) { m2 = m1; m1 = v; } else if (v > m2) m2 = v; }
                { const float v = sel[nt][3]; if (v > m1) { m2 = m1; m1 = v; } else if (v > m2) m2 = v; }
                gs[nt] = m1 + m2; }
            float bv = gs[0]; int bg = kq; if (gs[1] > bv) { bv = gs[1]; bg = 4 + kq; }
#pragma unroll
            for (int o = 16; o < 64; o <<= 1) { const float ov = __shfl_xor(bv, o); const int og = __shfl_xor(bg, o); if (ov > bv || (ov == bv && og < bg)) { bv = ov; bg = og; } }
            owner = ((bg & 3) == kq); mytok = tok0 + ti;
            if (owner) { const int nt = bg >> 2; float cd[4], sv[4];
#pragma unroll
                for (int rg = 0; rg < 4; ++rg) { cd[rg] = nt ? sel[1][rg] : sel[0][rg]; sv[rg] = nt ? sco[1][rg] : sco[0][rg]; }
                int i1 = 0; float v1 = cd[0];
#pragma unroll
                for (int rg = 1; rg < 4; ++rg) if (cd[rg] > v1) { v1 = cd[rg]; i1 = rg; }
                int i2 = -1; float v2 = -1e30f;
#pragma unroll
                for (int rg = 0; rg < 4; ++rg) if (rg != i1 && cd[rg] > v2) { v2 = cd[rg]; i2 = rg; }
                const float s1 = (i1 == 0 ? sv[0] : (i1 == 1 ? sv[1] : (i1 == 2 ? sv[2] : sv[3]))), s2 = (i2 == 0 ? sv[0] : (i2 == 1 ? sv[1] : (i2 == 2 ? sv[2] : sv[3])));
                e0 = 4 * bg + i1; e1 = 4 * bg + i2; w0 = s1 / (s1 + s2); w1 = s2 / (s1 + s2);
                rk0 = __hip_atomic_fetch_add(lcnt + e0, 1u, __ATOMIC_RELAXED, __HIP_MEMORY_SCOPE_WORKGROUP);
                rk1 = __hip_atomic_fetch_add(lcnt + e1, 1u, __ATOMIC_RELAXED, __HIP_MEMORY_SCOPE_WORKGROUP); }
        }
        __syncthreads();
        if (tid < 32) { const unsigned n = lcnt[tid]; lbase[tid] = n ? __hip_atomic_fetch_add(ecnt + 64 * tid, n, RLX_AGENT) : 0u; }
        __syncthreads();
        if (owner) { perm[(size_t)e0 * NTOK + lbase[e0] + rk0] = 2 * mytok; perm[(size_t)e1 * NTOK + lbase[e1] + rk1] = 2 * mytok + 1; tokw[2 * mytok] = w0; tokw[2 * mytok + 1] = w1; }
    }
    __syncthreads();
    {
        LAS float* scr = (LAS float*)(F.lds + RING_OFF + wave * 8704);
        const int gw = F.vcu * NWAVES + wave, NGW = F.G * NWAVES;
        bf16* WG1 = WSP(bf16, WS_WG1); bf16* WD = WSP(bf16, WS_WD);
        for (int it = gw; it < 24576; it += NGW) {
            const int kind = it >> 13, r = it & 8191, e = r >> 8, rr = r & 255;
            if (kind < 2) { const int kb = rr >> 4, nb = rr & 15, n0 = nb * 32; const float* src = (kind == 0 ? INP(23) : INP(24)) + (size_t)(l * 32 + e) * 1024 * 512;
                transpose_item(src, 512, kb * 64, n0, WG1 + ((size_t)e * 1024 + (n0 >> 7) * 256 + kind * 128 + (n0 & 127)) * 1024, 1024, scr, lane); }
            else { const int kb = rr >> 5, nb = rr & 31, n0 = nb * 32; const float* src = INP(25) + (size_t)(l * 32 + e) * 512 * 1024;
                transpose_item(src, 1024, kb * 64, n0, WD + ((size_t)e * 1024 + n0) * 512, 512, scr, lane); }
        }
    }
}
__device__ __forceinline__ void moe_tilebase(const Frame& F0, const Args& args, int l) {
    const Frame F = fresh(F0);
    if (F.tid == 0) { unsigned* ecnt = (unsigned*)(F.ctl + CW_ECNT + l * 32 * 64); int acc = 0;
        for (int e = 0; e < 32; ++e) { F.MISC[16 + e] = (unsigned)acc; acc += (int)((__hip_atomic_load(ecnt + 64 * e, RLX_AGENT) + 255u) >> 8); }
        F.MISC[48] = (unsigned)acc; }
    __syncthreads();
}
__device__ __forceinline__ void gather_phase(const Frame& F0, const Args& args, int l) {
    const Frame F = fresh(F0);
    moe_tilebase(F, args, l);
    const unsigned* ecnt = (const unsigned*)(F.ctl + CW_ECNT + l * 32 * 64);
    const int* perm = WSP(int, WS_PERM); int* tokrow = WSP(int, WS_TOKROW);
    const bf16* U2 = WSP(bf16, WS_U); bf16* XS = WSP(bf16, WS_PROJ);
    const int nrows = (int)F.MISC[48] * 256;
    for (int r = F.vcu * NWAVES + F.wave; r < nrows; r += F.G * NWAVES) {
        const int t = r >> 8; int e = 0;
        for (int k = 1; k < 32; ++k) e += ((int)F.MISC[16 + k] <= t) ? 1 : 0;
        const int s = r - 256 * (int)F.MISC[16 + e];
        const int cnt = (int)__hip_atomic_load(ecnt + 64 * e, RLX_AGENT);
        if (s < cnt) { const int tk = perm[(size_t)e * NTOK + s], tok = tk >> 1;
            const v4u* src = (const v4u*)(U2 + (size_t)tok * 1024) + F.lane; v4u* dst = (v4u*)(XS + (size_t)r * 1024) + F.lane;
            dst[0] = src[0]; dst[64] = src[64];
            if (F.lane == 0) tokrow[tk] = r; }
    }
}
__device__ __forceinline__ int fresh_bid() { int b = (int)blockIdx.x; asm volatile("" : "+s"(b)); return b; }
constexpr int N_PHASES = 24;
__global__ void __launch_bounds__(NWAVES * 64, 2) mega_fwd(Args args, int li) {
    extern __shared__ __attribute__((aligned(16))) unsigned char lds[];
    Frame F;
    F.lds = (LAS unsigned char*)lds;
    F.MISC = (volatile LAS unsigned*)(F.lds + MISC_OFF);
    F.tid = threadIdx.x; F.lane = F.tid & 63; F.wave = __builtin_amdgcn_readfirstlane(F.tid >> 6);
    F.G = gridDim.x; { const int bx = blockIdx.x; F.vcu = (F.G % 8 == 0) ? (bx % 8) * (F.G / 8) + bx / 8 : bx; }
    F.ctl = (gu32*)(args.ws + WS_CTL);
    for (int u = F.tid; u < (XTRA_OFF - LDSCTL_OFF) / 4; u += NWAVES * 64) ((LAS unsigned*)(F.lds + LDSCTL_OFF))[u] = 0u;
    __syncthreads();
    const int lo = args.ph_lo, hi = args.ph_hi;
    XcdBarrier bar; bar.bar = (unsigned*)(F.ctl + CW_BAR) + li * XCD_BAR_WORDS; bar.x = 0; bar.st = nullptr;
    if (hi - lo > 1) bar = xcd_barrier_post((unsigned*)(F.ctl + CW_BAR) + li * XCD_BAR_WORDS, F.MISC + 8);
#ifndef PHMASK
#define PHMASK 0xFFFF
#endif
#define EN(kind) ((PHMASK >> (kind)) & 1)
#define IN(k) (lo <= (k) && (k) < hi)
#define SEAM(k) do { if (IN(k) && IN((k) + 1)) xcd_barrier(bar); } while (0)

    if (EN(0) && IN(0)) { p0_prologue(F, args); SEAM(0); }
    for (int l = 0; l < DEPTH; ++l) {
        const int pb = 1 + 11 * l;
        bf16* U = WSP(bf16, WS_U); bf16* PROJ = WSP(bf16, WS_PROJ); bf16* GATES = WSP(bf16, WS_GATES);
        if (EN(1) && IN(pb + 0)) { if (l == 0) rows_phase<0>(F, args, l); else rows_phase<1>(F, args, l); SEAM(pb + 0); }
        if (EN(2) && IN(pb + 1)) {
            pg8::Gemm g{U, U, U, WSP(bf16, WS_WP2) + (size_t)l * NP2 * 1024, nullptr, nullptr, 1024, 1024, 1024};
            pg8::StaticOrder S; S.init(NTOK, NP2, F.G, fresh_bid());
            EpiP2 E{PROJ, WSP(bf16, WS_VT), GATES, INP(8) + l * 3072};
            pg8::gemm_phase<EpiP2, pg8::StaticOrder, true>(F.lds + RING_OFF, g, S, E, fresh(F).tid);
            SEAM(pb + 1);
        }
        if (EN(3) && IN(pb + 2)) { if (EN(13)) attn_phase(F, args, l); if (EN(14)) lru_phase<false>(F, args, l); if (EN(15)) fft_a_phase(F, args); SEAM(pb + 2); }
        if (EN(4) && IN(pb + 3)) { lru_carry(F, args); fft_b_phase(F, args); SEAM(pb + 3); }
        if (EN(5) && IN(pb + 4)) { lru_phase<true>(F, args, l); SEAM(pb + 4); }
        if (EN(6) && IN(pb + 5)) {
            const bf16* WP = WSP(bf16, WS_WPROJ) + (size_t)l * 3 * 1024 * 512;
            pg8::Gemm g{PROJ + Q_OFF, PROJ + YR_OFF, PROJ + G_OFF, WP, WP + 1024 * 512, WP + 2 * 1024 * 512, PROJ_LD, 512, 512};
            pg8::MergeOrder S; S.init(NTOK, 1024, F.G, fresh_bid());
            EpiMerge E{GATES, U};
            pg8::gemm_phase<EpiMerge, pg8::MergeOrder, true>(F.lds + RING_OFF, g, S, E, fresh(F).tid);
            SEAM(pb + 5);
        }
        if (EN(7) && IN(pb + 6)) {
            pg8::Gemm g{U, U, U, WSP(bf16, WS_WOUT) + (size_t)l * 1024 * 1024, nullptr, nullptr, 1024, 1024, 1024};
            pg8::StaticOrder S; S.init(NTOK, 1024, F.G, fresh_bid());
            EpiResid E{l == 0 ? INP(0) : (const float*)args.out, args.out, WSP(float, WS_MOD) + (size_t)l * 4 * 6144 + 2 * 1024};
            pg8::gemm_phase<EpiResid, pg8::StaticOrder, true>(F.lds + RING_OFF, g, S, E, fresh(F).tid);
            SEAM(pb + 6);
        }
        if (EN(8) && IN(pb + 7)) { router_phase(F, args, l); SEAM(pb + 7); }
        if (EN(9) && IN(pb + 8)) { gather_phase(F, args, l); SEAM(pb + 8); }
        if (EN(10) && IN(pb + 9)) {
            moe_tilebase(F, args, l);
            pg8::Gemm g{PROJ, PROJ, PROJ, WSP(bf16, WS_WG1), nullptr, nullptr, 1024, 1024, 1024};
            pg8::MoeOrder S{(const LAS int*)(F.lds + MISC_OFF + 64), F.G, fresh_bid()};
            EpiSwiGLU E{WSP(bf16, WS_H)};
            pg8::gemm_phase<EpiSwiGLU, pg8::MoeOrder, true>(F.lds + RING_OFF, g, S, E, fresh(F).tid);
            SEAM(pb + 9);
        }
        if (EN(11) && IN(pb + 10)) {
            moe_tilebase(F, args, l);
            const bf16* H = WSP(bf16, WS_H);
            pg8::Gemm g{H, H, H, WSP(bf16, WS_WD), nullptr, nullptr, 512, 512, 512};
            pg8::MoeOrder S{(const LAS int*)(F.lds + MISC_OFF + 64), F.G, fresh_bid()};
            EpiYE E{PROJ};
            pg8::gemm_phase<EpiYE, pg8::MoeOrder, true>(F.lds + RING_OFF, g, S, E, fresh(F).tid);
            SEAM(pb + 10);
        }
    }
    if (EN(12) && IN(23)) rows_phase<2>(F, args, DEPTH);
#undef IN
#undef SEAM
}

#ifndef MK_MODE
#define MK_MODE 0
#endif
extern "C" void kernel_launch(void* const* d_in, const int* in_sizes, int n_in, void* d_out, int out_size, void* d_ws, size_t ws_size, hipStream_t stream) {
    static int grid = 0;
    if (grid == 0) {
        if (n_in != 27 || in_sizes[0] != NTOK * D || out_size != NTOK * D || ws_size < WS_END) { fprintf(stderr, "kernel_launch: unexpected shapes (n_in %d, in0 %d, out %d, ws %zu < %zu)\n", n_in, n_in > 0 ? in_sizes[0] : -1, out_size, ws_size, (size_t)WS_END); grid = -1; return; }
        int dev = 0, cus = 0;
        if (hipGetDevice(&dev) != hipSuccess || hipDeviceGetAttribute(&cus, hipDeviceAttributeMultiprocessorCount, dev) != hipSuccess) { grid = -1; return; }
        if (hipFuncSetAttribute((const void*)mega_fwd, hipFuncAttributeMaxDynamicSharedMemorySize, LDS_BYTES) != hipSuccess) { fprintf(stderr, "kernel_launch: hipFuncSetAttribute failed\n"); grid = -1; return; }
        (void)hipGetLastError();
        grid = cus;
    }
    if (grid < 0) return;
    if (hipMemsetAsync((char*)d_ws + WS_CTL, 0, CTL_ZERO_BYTES, stream) != hipSuccess) return;
    Args a{};
    for (int i = 0; i < 27; ++i) a.in[i] = (const float*)d_in[i];
    a.out = (float*)d_out; a.ws = (unsigned char*)d_ws;
#if MK_MODE == 0
    a.ph_lo = 0; a.ph_hi = N_PHASES;
    hipLaunchKernelGGL(mega_fwd, dim3(grid), dim3(NWAVES * 64), LDS_BYTES, stream, a, 0);
#else
    for (int p = 0; p < N_PHASES; ++p) { a.ph_lo = p; a.ph_hi = p + 1; hipLaunchKernelGGL(mega_fwd, dim3(grid), dim3(NWAVES * 64), LDS_BYTES, stream, a, 0); }
#endif
}
```

```cpp
#include <hip/hip_runtime.h>
#include <cstdio>
#include <cstdint>
namespace pg8 {
#define PG8_LAS __attribute__((address_space(3)))
typedef unsigned short bf16_t;
typedef short bf16x8 __attribute__((ext_vector_type(8)));
typedef float f32x4 __attribute__((ext_vector_type(4)));
typedef unsigned u32x4 __attribute__((ext_vector_type(4)));
typedef unsigned u32x2 __attribute__((ext_vector_type(2)));
constexpr int BM = 256, BK = 64, HALF = 128, HTB = HALF * BK * 2  , STAGE_BYTES = 8 * HTB, NXCD = 8, WGM = 8;

__host__ __device__ __forceinline__ int lds_byte(int r, int c) { const int st = (r >> 4) * 2 + (c >> 5), rr = r & 15, cc = c & 31, ob = rr * 64 + cc * 2; return st * 1024 + (ob ^ (((ob >> 9) & 1) << 5)); }
__host__ __device__ __forceinline__ void stage_rc(int b, int& R, int& C) { const int st = b / 1024, sb = b % 1024, swz = sb ^ (((sb >> 9) & 1) << 5); R = (st >> 1) * 16 + swz / 64; C = (st & 1) * 32 + (swz % 64) / 2; }
__host__ __device__ __forceinline__ int perm32(int rho) { const int n = rho >> 4, i = rho & 15; return 8 * (i >> 2) + 4 * n + (i & 3); }

struct Unit { int pm, pn, bt, z; };
struct Gemm { const bf16_t* A0; const bf16_t* A1; const bf16_t* A2; const bf16_t* B0; const bf16_t* B1; const bf16_t* B2; int lda, ldb, K; };

__device__ __forceinline__ unsigned cvt_pk_bf16(float lo, float hi) { unsigned r; asm volatile("v_cvt_pk_bf16_f32 %0, %1, %2" : "=v"(r) : "v"(lo), "v"(hi)); return r; }

struct StaticOrder {
    int nM, nN, nwg, G, c;
    __device__ void init(int M, int N, int G_, int c_) { nM = M / BM; nN = N / BM; nwg = nM * nN; G = G_; c = c_; }
    __device__ __forceinline__ bool tile(long L, Unit& u) const {
        if (L >= nwg) return false;
        int wgid = (int)L; { const int q = nwg / NXCD, r = nwg % NXCD, xcd = wgid % NXCD, off = wgid / NXCD; wgid = (xcd < r ? xcd * (q + 1) : r * (q + 1) + (xcd - r) * q) + off; }
        const int nig = WGM * nN, gid = wgid / nig, fm = gid * WGM, gsz = (nM - fm) < WGM ? (nM - fm) : WGM;
        u.pm = fm + ((wgid % nig) % gsz); u.pn = (wgid % nig) / gsz; u.bt = u.pn; u.z = 0; return true;
    }
    __device__ __forceinline__ bool next(int i, Unit& u) const { return tile((long)i * G + c, u); }
};
struct MergeOrder : StaticOrder {
    __device__ __forceinline__ bool next(int i, Unit& u) const { const int t = i / 3; if (!tile((long)t * G + c, u)) return false; u.z = i - 3 * t; return true; }
};
struct MoeOrder {
    const PG8_LAS int* tb; int G, c;
    __device__ __forceinline__ bool next(int i, Unit& u) const {
        const int L = i * G + c; const int nt = tb[32]; if (L >= nt * 4) return false;
        const int t = L >> 2, j = L & 3; int e = 0;
#pragma unroll 1
        for (int k = 1; k < 32; ++k) e += (tb[k] <= t) ? 1 : 0;
        u.pm = t; u.pn = j; u.bt = e * 4 + j; u.z = 0; return true;
    }
};

template <class Epi, class Sched, bool ALIGN_EPI>
__device__ __forceinline__ void gemm_phase(PG8_LAS unsigned char* lds, const Gemm g, const Sched& S, const Epi& E, const int tid) {
    const int wid = __builtin_amdgcn_readfirstlane(tid >> 6), lane = tid & 63, wr = wid >> 2, wc = wid & 3, fr = lane & 15, fq = lane >> 4;
    const int K = g.K, nt = K / BK;
    unsigned voffA[2], voffB[2];
#pragma unroll
    for (int i = 0; i < 2; ++i) { int R, C; stage_rc(tid * 16 + i * 8192, R, C); const int Rb = Epi::PERM ? ((R & ~31) + perm32(R & 31)) : R;
        voffA[i] = (unsigned)(R * g.lda + C) * 2u; voffB[i] = (unsigned)(Rb * g.ldb + C) * 2u; }
    const size_t kstep = (size_t)(BK * 2);
    const size_t hstepA = (size_t)HALF * g.lda * 2, hstepB = (size_t)HALF * g.ldb * 2;
    const size_t tstepA = 2 * hstepA, tstepB = 2 * hstepB;
    const unsigned ldsw = (unsigned)wid * 1024u;
    const int aoff = lds_byte(wr * 64 + fr, fq * 8), boff = lds_byte(wc * 32 + fr, fq * 8);
#define PG8_SA(b, h) (((b) * 2 + (h)) * HTB)
#define PG8_SB(b, h) ((4 + (b) * 2 + (h)) * HTB)
#define PG8_STAGE(bufoff, gbase, voff) do { _Pragma("unroll") for (int _i = 0; _i < 2; ++_i) \
        __builtin_amdgcn_global_load_lds((const unsigned*)((const char*)(gbase) + (voff)[_i]), (PG8_LAS unsigned*)(lds + (bufoff) + ldsw + _i * 8192), 16, 0, 0); } while (0)
#define PG8_LDA(dst, b, h) do { _Pragma("unroll") for (int m = 0; m < 4; ++m) _Pragma("unroll") for (int k = 0; k < 2; ++k) dst[m][k] = *(const PG8_LAS bf16x8*)(lds + PG8_SA(b, h) + aoff + m * 2048 + k * 1024); } while (0)
#define PG8_LDB(dst, b, h) do { _Pragma("unroll") for (int n = 0; n < 2; ++n) _Pragma("unroll") for (int k = 0; k < 2; ++k) dst[n][k] = *(const PG8_LAS bf16x8*)(lds + PG8_SB(b, h) + boff + n * 2048 + k * 1024); } while (0)
#define PG8_MMA(ai, bj, At, Bt) do { __builtin_amdgcn_s_setprio(1); _Pragma("unroll") for (int m = 0; m < 4; ++m) _Pragma("unroll") for (int n = 0; n < 2; ++n) _Pragma("unroll") for (int k = 0; k < 2; ++k) \
        acc[ai][bj][m][n] = __builtin_amdgcn_mfma_f32_16x16x32_bf16(Bt[n][k], At[m][k], acc[ai][bj][m][n], 0, 0, 0); __builtin_amdgcn_s_setprio(0); } while (0)
#define PG8_WAIT_V(n) asm volatile("s_waitcnt vmcnt(" #n ")" ::: "memory")
#define PG8_WAIT_L(n) asm volatile("s_waitcnt lgkmcnt(" #n ")" ::: "memory")
#define PG8_BAR __builtin_amdgcn_s_barrier()
#define PG8_SCHED __builtin_amdgcn_sched_barrier(0)
#define PG8_APTR(u) ((const char*)((u).z == 0 ? g.A0 : ((u).z == 1 ? g.A1 : g.A2)) + (size_t)(u).pm * tstepA)
#define PG8_BPTR(u) ((const char*)((u).z == 0 ? g.B0 : ((u).z == 1 ? g.B1 : g.B2)) + (size_t)(u).bt * tstepB)
    Unit cur, nxt; int ui = 0;
    if (!S.next(0, cur)) return;
    f32x4 acc[2][2][4][2];
#pragma unroll
    for (int a = 0; a < 2; ++a)
#pragma unroll
        for (int b = 0; b < 2; ++b)
#pragma unroll
            for (int m = 0; m < 4; ++m)
#pragma unroll
                for (int n = 0; n < 2; ++n) acc[a][b][m][n] = (f32x4){0.f, 0.f, 0.f, 0.f};
    bf16x8 At[4][2], B0[2][2], B1[2][2];
    const char* cA = PG8_APTR(cur); const char* cB = PG8_BPTR(cur);
    PG8_STAGE(PG8_SB(0, 0), cB, voffB); PG8_STAGE(PG8_SB(0, 1), cB + hstepB, voffB); PG8_STAGE(PG8_SA(0, 0), cA, voffA); PG8_STAGE(PG8_SA(0, 1), cA + hstepA, voffA);
    if (wr == 1) PG8_BAR;
    PG8_WAIT_V(2); PG8_BAR;
    PG8_STAGE(PG8_SB(1, 0), cB + kstep, voffB); PG8_STAGE(PG8_SA(1, 0), cA + kstep, voffA); PG8_STAGE(PG8_SB(1, 1), cB + hstepB + kstep, voffB);
    PG8_WAIT_V(6); PG8_BAR;
    for (;;) {
        const bool has_next = S.next(ui + 1, nxt);
        const char* nA = has_next ? PG8_APTR(nxt) : cA; const char* nB = has_next ? PG8_BPTR(nxt) : cB;
        for (int t = 0; t < nt; t += 2) {
            const bool last = (t == nt - 2);
            const char* a1 = cA + (size_t)(t + 1) * kstep;
            const char* a2 = last ? nA : cA + (size_t)(t + 2) * kstep; const char* b2 = last ? nB : cB + (size_t)(t + 2) * kstep;
            const char* a3 = a2 + kstep; const char* b3 = b2 + kstep;
            PG8_LDB(B0, 0, 0); PG8_LDB(B1, 0, 1); PG8_SCHED; PG8_LDA(At, 0, 0); PG8_STAGE(PG8_SA(1, 1), a1 + hstepA, voffA);
            PG8_WAIT_V(8); PG8_WAIT_L(0); PG8_BAR; PG8_MMA(0, 0, At, B0); PG8_MMA(0, 1, At, B1); PG8_BAR; PG8_SCHED;
            PG8_LDA(At, 0, 1); PG8_STAGE(PG8_SB(0, 0), b2, voffB); PG8_STAGE(PG8_SB(0, 1), b2 + hstepB, voffB); PG8_STAGE(PG8_SA(0, 0), a2, voffA);
            PG8_WAIT_V(8); PG8_WAIT_L(0); PG8_BAR; PG8_MMA(1, 0, At, B0); PG8_MMA(1, 1, At, B1); PG8_BAR; PG8_SCHED;
            PG8_LDB(B0, 1, 0); PG8_LDB(B1, 1, 1); PG8_SCHED; PG8_LDA(At, 1, 0); PG8_STAGE(PG8_SA(0, 1), a2 + hstepA, voffA);
            PG8_WAIT_V(8); PG8_WAIT_L(0); PG8_BAR; PG8_MMA(0, 0, At, B0); PG8_MMA(0, 1, At, B1); PG8_BAR; PG8_SCHED;
            PG8_LDA(At, 1, 1); PG8_STAGE(PG8_SB(1, 0), b3, voffB); PG8_STAGE(PG8_SB(1, 1), b3 + hstepB, voffB); PG8_STAGE(PG8_SA(1, 0), a3, voffA);
            PG8_WAIT_V(8); PG8_WAIT_L(0); PG8_BAR; PG8_MMA(1, 0, At, B0); PG8_MMA(1, 1, At, B1); PG8_BAR; PG8_SCHED;
        }
        if constexpr (ALIGN_EPI) { if (wr == 0) PG8_BAR; }
        E(acc, cur, wr, wc, fr, fq);
        if (!has_next) break;
#pragma unroll
        for (int a = 0; a < 2; ++a)
#pragma unroll
            for (int b = 0; b < 2; ++b)
#pragma unroll
                for (int m = 0; m < 4; ++m)
#pragma unroll
                    for (int n = 0; n < 2; ++n) acc[a][b][m][n] = (f32x4){0.f, 0.f, 0.f, 0.f};
        cur = nxt; cA = nA; cB = nB; ++ui;
        if constexpr (ALIGN_EPI) { if (wr == 1) PG8_BAR; }
    }
    PG8_WAIT_V(0);
    if constexpr (!ALIGN_EPI) { if (wr == 0) PG8_BAR; }
    PG8_BAR;
#undef PG8_SA
#undef PG8_SB
#undef PG8_STAGE
#undef PG8_LDA
#undef PG8_LDB
#undef PG8_MMA
#undef PG8_WAIT_V
#undef PG8_WAIT_L
#undef PG8_BAR
#undef PG8_SCHED
#undef PG8_APTR
#undef PG8_BPTR
}
}
constexpr int NWAVES = 8;
constexpr int NB = 4, T = 8192, D = 1024, NTOK = NB * T, DEPTH = 2;
constexpr int PROJ_LD = 3072, Q_OFF = 0, K_OFF = 512, XR_OFF = 1024, YR_OFF = 1536, G_OFF = 2048;
constexpr int GATES_LD = 3072;
constexpr int NP2 = 6656;
constexpr int NEXP = 32, XS_ROWS = 73728;
constexpr int LRU_CH = 32, LRU_NCH = T / LRU_CH;
constexpr float EPS = 1e-6f;

constexpr size_t MiB = 1u << 20;
constexpr size_t WS_CTL = 0, CTL_ZERO_BYTES = 1 * MiB;
constexpr size_t WS_MOD = 1 * MiB;
constexpr size_t WS_FA = WS_MOD + 256 * 1024;
constexpr size_t WS_FB = WS_FA + 32 * 1024;
constexpr size_t WS_TW = WS_FB + 64 * 1024;
constexpr size_t WS_WL = 2 * MiB;
constexpr size_t WS_TOKW = 3 * MiB;
constexpr size_t WS_TOKROW = WS_TOKW + 256 * 1024;
constexpr size_t WS_PERM = 4 * MiB;
constexpr size_t WS_LSUM = 8 * MiB;
constexpr size_t WS_LCAR = 16 * MiB;
constexpr size_t WS_WP2 = 20 * MiB;
constexpr size_t WS_WPROJ = 46 * MiB;
constexpr size_t WS_WOUT = 52 * MiB;
constexpr size_t WS_U = 56 * MiB;
constexpr size_t WS_VT = 120 * MiB;
constexpr size_t WS_PROJ = 152 * MiB;
constexpr size_t WS_GATES = 344 * MiB;
constexpr size_t WS_WG1 = WS_GATES, WS_WD = WS_GATES + 64 * MiB, WS_H = WS_GATES + 96 * MiB;
constexpr size_t WS_XC = 536 * MiB;
constexpr size_t WS_END = 568 * MiB;
constexpr size_t WS_SCR = 568 * MiB;
#ifndef REP_G
#define REP_G 0
#endif
#ifndef REP_C
#define REP_C 0
#endif
#ifndef REP_MS
#define REP_MS 15
#endif
#ifndef REP_M
#define REP_M 0
#endif
static_assert(WS_H + (size_t)XS_ROWS * 512 * 2 <= WS_END, "ws map");
constexpr int CW_BAR = 4096;
constexpr int CW_ECNT = 16384;

constexpr int LDS_BYTES = 163840;
constexpr int RING_OFF = 0, RING_BYTES = 131072;
constexpr int XTRA_OFF = RING_BYTES;
constexpr int LDSCTL_OFF = LDS_BYTES - 512, MISC_OFF = LDSCTL_OFF + 64;

#define GAS __attribute__((address_space(1)))
#define LAS __attribute__((address_space(3)))
typedef unsigned short bf16;
typedef unsigned v4u __attribute__((ext_vector_type(4)));
typedef unsigned v2u __attribute__((ext_vector_type(2)));
typedef float f32x4 __attribute__((ext_vector_type(4)));
typedef float f32x2 __attribute__((ext_vector_type(2)));
typedef float f32x16 __attribute__((ext_vector_type(16)));
typedef short bf16x8 __attribute__((ext_vector_type(8)));
typedef short bf16x4 __attribute__((ext_vector_type(4)));
typedef GAS unsigned gu32;
#define RLX_AGENT __ATOMIC_RELAXED, __HIP_MEMORY_SCOPE_AGENT
#define LDS_WAIT() asm volatile("s_waitcnt lgkmcnt(0)" ::: "memory")
#define VM_WAIT() asm volatile("s_waitcnt vmcnt(0)" ::: "memory")
typedef __bf16 hwbf16x2 __attribute__((ext_vector_type(2)));
__device__ __forceinline__ unsigned pk2(float lo, float hi) { f32x2 v = {lo, hi}; hwbf16x2 b = __builtin_convertvector(v, hwbf16x2); return __builtin_bit_cast(unsigned, b); }
__device__ __forceinline__ unsigned f2bf(float f) { return pk2(f, 0.f) & 0xffffu; }
__device__ __forceinline__ float bflo(unsigned w) { return __builtin_bit_cast(float, w << 16); }
__device__ __forceinline__ float bfhi(unsigned w) { return __builtin_bit_cast(float, w & 0xffff0000u); }
__device__ __forceinline__ float bf2f(unsigned short h) { return __builtin_bit_cast(float, (unsigned)h << 16); }
__device__ __forceinline__ float sigmoidf(float v) { return 1.0f / (1.0f + __expf(-v)); }
__device__ __forceinline__ float fsigmoid(float v) { return __builtin_amdgcn_rcpf(1.0f + __expf(-v)); }
__device__ __forceinline__ float wave_sum(float v) {
#pragma unroll
    for (int o = 1; o < 64; o <<= 1) v += __shfl_xor(v, o);
    return v;
}
#define XB_TMO      128
#define XB_XCNT(j)  (256  + 64 * (j))
#define XB_XSUB(j)  (1280 + 64 * (j))
#define XB_XGEN(j)  (2304 + 64 * (j))
#define XB_TOP      3328
#define XB_TOPGEN   3392
#define XCD_BAR_WORDS 3456
#define XB_SPIN_CAP (1u << 18)

__device__ __forceinline__ unsigned xb_ld(unsigned* p)              { return __hip_atomic_load(p, __ATOMIC_RELAXED, __HIP_MEMORY_SCOPE_AGENT); }
__device__ __forceinline__ unsigned xb_add(unsigned* p, unsigned v) { return __hip_atomic_fetch_add(p, v, __ATOMIC_RELAXED, __HIP_MEMORY_SCOPE_AGENT); }
__device__ __forceinline__ unsigned xb_xcc_id() { return (unsigned)__builtin_amdgcn_s_getreg((3 << 11) | 20) & 0xFu; }
#define XB_SPIN(cond, bar) do { unsigned _sp = 0; while (cond) { __builtin_amdgcn_s_sleep(1); \
    if ((++_sp & 255u) == 0u) { if (xb_ld(&(bar)[XB_TMO])) break; if (_sp > XB_SPIN_CAP) { atomicAdd(&(bar)[XB_TMO], 1u); break; } } } } while (0)

struct XcdBarrier {
    unsigned* bar; unsigned x;
    volatile LAS unsigned* st;
};

__device__ __forceinline__ XcdBarrier xcd_barrier_post(unsigned* bar, volatile LAS unsigned* st) {
    XcdBarrier b; b.bar = bar; b.x = xb_xcc_id(); b.st = st;
    if (threadIdx.x == 0) (void)xb_add(&bar[XB_XCNT(b.x)], 1u);
    return b;
}
__device__ __forceinline__ void xcd_barrier_complete(unsigned* bar, unsigned x, unsigned& nloc, unsigned& nx) {
    const unsigned G = gridDim.x * gridDim.y * gridDim.z;
    unsigned sum, cnt, mine, sp = 0u;
    for (;;) {
        sum = 0u; cnt = 0u; mine = 0u;
#pragma unroll
        for (unsigned j = 0; j < 16; ++j) { const unsigned c = xb_ld(&bar[XB_XCNT(j)]); sum += c; cnt += (c > 0u) ? 1u : 0u; mine = (j == x) ? c : mine; }
        if (sum == G) break;
        __builtin_amdgcn_s_sleep(1);
        if ((++sp & 255u) == 0u) { if (xb_ld(&bar[XB_TMO])) break; if (sp > XB_SPIN_CAP) { atomicAdd(&bar[XB_TMO], 1u); break; } }
    }
    nloc = mine > 0u ? mine : 1u; nx = cnt > 0u ? cnt : 1u;
}

__device__ __forceinline__ void xcd_barrier(const XcdBarrier& b) {
    asm volatile("s_waitcnt vmcnt(0)" ::: "memory");
    __syncthreads();
    if (threadIdx.x == 0) {
        unsigned* bar = b.bar;
        __builtin_amdgcn_s_waitcnt(0);
        unsigned nloc = b.st[0], nx = b.st[1];
        if (nloc == 0u) { xcd_barrier_complete(bar, b.x, nloc, nx); b.st[0] = nloc; b.st[1] = nx; }
        const unsigned old = xb_add(&bar[XB_XSUB(b.x)], 1u);
        const unsigned gen = old / nloc;
        if (old + 1u == (gen + 1u) * nloc) {
            __builtin_amdgcn_fence(__ATOMIC_RELEASE, "agent");
            asm volatile("s_waitcnt vmcnt(0)" ::: "memory");
            const unsigned og = xb_add(&bar[XB_TOP], 1u);
            const unsigned tg = og / nx;
            if (og + 1u == (tg + 1u) * nx) xb_add(&bar[XB_TOPGEN], 1u);
            else XB_SPIN(xb_ld(&bar[XB_TOPGEN]) == tg, bar);
            __builtin_amdgcn_fence(__ATOMIC_ACQUIRE, "agent");
            xb_add(&bar[XB_XGEN(b.x)], 1u);
            asm volatile("s_waitcnt vmcnt(0)" ::: "memory");
        } else {
            XB_SPIN(xb_ld(&bar[XB_XGEN(b.x)]) == gen, bar);
            __builtin_amdgcn_fence(__ATOMIC_ACQUIRE, "agent");
            asm volatile("s_waitcnt vmcnt(0)" ::: "memory");
        }
    }
    __syncthreads();
}

struct Args { const float* in[27]; float* out; unsigned char* ws; int ph_lo, ph_hi; };
struct Frame {
    LAS unsigned char* lds;
    volatile LAS unsigned* MISC;
    gu32* ctl;
    int tid, lane, wave, vcu, G;
};
__device__ __forceinline__ Frame fresh(const Frame& F) {
    Frame N = F; int t = F.tid; asm volatile("" : "+v"(t)); N.tid = t; N.lane = t & 63; N.wave = __builtin_amdgcn_readfirstlane(t >> 6);
    int v = F.vcu; asm volatile("" : "+s"(v)); N.vcu = v; int g = F.G; asm volatile("" : "+s"(g)); N.G = g; return N;
}
#define WSP(T_, off) ((T_*)(args.ws + (off)))
#define INP(i) (args.in[i])

__device__ __forceinline__ void transpose_item(const float* W, int ldw, int k0, int n0, bf16* dst, int ldd, LAS float* scr, int lane) {
#pragma unroll 8
    for (int i = 0; i < 32; ++i) { const int kk = 2 * i + (lane >> 5); scr[kk * 33 + (lane & 31)] = W[(size_t)(k0 + kk) * ldw + n0 + (lane & 31)]; }
    LDS_WAIT(); asm volatile("" ::: "memory");
    const int c = lane & 7;
#pragma unroll
    for (int j = 0; j < 4; ++j) { const int n = (lane >> 3) + 8 * j; const LAS float* s = scr + (8 * c) * 33 + n;
        v4u o; o.x = pk2(s[0 * 33], s[1 * 33]); o.y = pk2(s[2 * 33], s[3 * 33]); o.z = pk2(s[4 * 33], s[5 * 33]); o.w = pk2(s[6 * 33], s[7 * 33]);
        *(v4u*)(dst + (size_t)n * ldd + k0 + 8 * c) = o; }
    LDS_WAIT(); asm volatile("" ::: "memory");
}

__device__ __forceinline__ void p0_prologue(const Frame& F0, const Args& args) {
    const Frame F = fresh(F0);
    const int tid = F.tid, lane = F.lane, wave = F.wave;
    float* MOD = WSP(float, WS_MOD);
    {
        LAS f32x4* cact4 = (LAS f32x4*)(F.lds + RING_OFF);
        LAS float* red = (LAS float*)(F.lds + RING_OFF + 16384);
        if (F.vcu < 192) {
            const float* c = INP(1);
            for (int i = 0; i < 8; ++i) { const int idx = tid + 512 * i, b = idx >> 10, k = idx & 1023; const float v = c[b * 1024 + k]; ((LAS float*)cact4)[k * 4 + b] = v * sigmoidf(v); }
        }
        __syncthreads();
        for (int u = F.vcu; u < 192; u += F.G) {
            const int l = u / 96, j0 = (u % 96) * 64;
            const float* aw = INP(2) + (size_t)l * 1024 * 6144 + j0 + lane;
            float a0 = 0.f, a1 = 0.f, a2 = 0.f, a3 = 0.f;
#pragma unroll 8
            for (int kk = 0; kk < 128; ++kk) { const int k = 128 * wave + kk; const float wv = aw[(size_t)k * 6144]; const f32x4 c4 = cact4[k]; a0 += c4.x * wv; a1 += c4.y * wv; a2 += c4.z * wv; a3 += c4.w * wv; }
            red[(wave * 4 + 0) * 64 + lane] = a0; red[(wave * 4 + 1) * 64 + lane] = a1; red[(wave * 4 + 2) * 64 + lane] = a2; red[(wave * 4 + 3) * 64 + lane] = a3;
            __syncthreads();
            if (tid < 256) { const int b = tid >> 6, ln = tid & 63; float s = INP(3)[l * 6144 + j0 + ln];
#pragma unroll
                for (int w = 0; w < 8; ++w) s += red[(w * 4 + b) * 64 + ln];
                MOD[(size_t)(l * 4 + b) * 6144 + j0 + ln] = s; }
            __syncthreads();
        }
    }
    {
        LAS float* Tt = (LAS float*)(F.lds + RING_OFF);
        LAS float* cs = (LAS float*)(F.lds + RING_OFF + 33792);
        LAS float* sn = cs + 128;
        if (tid < 128) { cs[tid] = cospif((float)tid * (1.0f / 64.0f)); sn[tid] = sinpif((float)tid * (1.0f / 64.0f)); }
        for (int it = F.vcu; it < 128; it += F.G) {
            const int l = it >> 6, g = (it >> 4) & 3, k0 = (it & 15) * 64;
            const float* src = INP(6) + (size_t)l * 1024 * 3072 + 2560 + g * 128;
            __syncthreads();
            for (int i = 0; i < 16; ++i) { const int idx = tid + 512 * i, row = idx >> 7, cc = idx & 127; Tt[row * 129 + cc] = src[(size_t)(k0 + row) * 3072 + cc]; }
            __syncthreads();
            const int kk = tid & 63, og = wave, part = og >> 2, m0 = (og & 3) * 32;
            float acc[32];
#pragma unroll
            for (int i = 0; i < 32; ++i) acc[i] = 0.f;
            const LAS float* tab = part ? sn : cs;
#pragma unroll 2
            for (int cc = 0; cc < 128; ++cc) { const float t = Tt[kk * 129 + cc];
#pragma unroll
                for (int i = 0; i < 32; ++i) acc[i] += t * tab[((m0 + i) * cc) & 127]; }
            bf16* dst = WSP(bf16, WS_WP2) + (size_t)l * NP2 * 1024 + (size_t)(2560 + part * 512 + g * 128 + m0) * 1024 + k0 + kk;
            const float sg = part ? -1.f : 1.f;
#pragma unroll
            for (int i = 0; i < 32; ++i) dst[(size_t)i * 1024] = (bf16)f2bf(sg * acc[i]);
        }
        __syncthreads();
    }
    {
        LAS float* scr = (LAS float*)(F.lds + RING_OFF + wave * 8704);
        const int gw = F.vcu * NWAVES + wave, NGW = F.G * NWAVES;
        for (int it = gw; it < 8192; it += NGW) {
            const int l = it >> 12; int r = it & 4095;
            if (r < 1280) { const int kb = r / 80, nb = r % 80; transpose_item(INP(6) + (size_t)l * 1024 * 3072, 3072, kb * 64, nb * 32, WSP(bf16, WS_WP2) + (size_t)l * NP2 * 1024 + (size_t)(nb * 32) * 1024, 1024, scr, lane); continue; }
            r -= 1280;
            if (r < 1536) { const int kb = r / 96, nb = r % 96; transpose_item(INP(7) + (size_t)l * 1024 * 3072, 3072, kb * 64, nb * 32, WSP(bf16, WS_WP2) + (size_t)l * NP2 * 1024 + (size_t)(3584 + nb * 32) * 1024, 1024, scr, lane); continue; }
            r -= 1536;
            if (r < 768) { const int which = r >> 8, rr = r & 255, kb = rr >> 5, nb = rr & 31; const float* src = (which == 0 ? INP(17) : (which == 1 ? INP(18) : INP(19))) + (size_t)l * 512 * 1024;
                transpose_item(src, 1024, kb * 64, nb * 32, WSP(bf16, WS_WPROJ) + (size_t)(l * 3 + which) * 1024 * 512 + (size_t)(nb * 32) * 512, 512, scr, lane); continue; }
            r -= 768;
            { const int kb = r >> 5, nb = r & 31; transpose_item(INP(20) + (size_t)l * 1024 * 1024, 1024, kb * 64, nb * 32, WSP(bf16, WS_WOUT) + (size_t)l * 1024 * 1024 + (size_t)(nb * 32) * 1024, 1024, scr, lane); }
        }
    }
    {
        const int gt = F.vcu * 512 + tid, NGT = F.G * 512;
        bf16* WL = WSP(bf16, WS_WL);
        for (int idx = gt; idx < 262144; idx += NGT) {
            const int k = idx & 63, n = (idx >> 6) & 255, nb = (idx >> 14) & 7, l = idx >> 17, gate = n >> 6, j = n & 63, dir = gate >> 1, isI = gate & 1;
            const float* src = isI ? INP(14) : INP(12);
            WL[idx] = (bf16)f2bf(src[((size_t)((l * 2 + dir) * 8 + nb) * 64 + k) * 64 + j]);
        }
        bf16* FA = WSP(bf16, WS_FA);
        for (int idx = gt; idx < 16384; idx += NGT) {
            const int m = idx >> 7, k = idx & 127, k1 = m & 63, pm_ = m >> 6, t1 = k & 63, pk = k >> 6, a = (k1 * t1) & 63;
            const float c = cospif((float)a * (1.0f / 32.0f)), s = sinpif((float)a * (1.0f / 32.0f));
            FA[idx] = (bf16)f2bf(pm_ == 0 ? (pk == 0 ? c : s) : (pk == 0 ? -s : c));
        }
        bf16* FB = WSP(bf16, WS_FB);
        for (int idx = gt; idx < 32768; idx += NGT) {
            const int k2 = idx >> 8, k = idx & 255, part = k >> 7, t2 = k & 127, a = (k2 * t2) & 127;
            FB[idx] = (bf16)f2bf(part == 0 ? cospif((float)a * (1.0f / 64.0f)) : sinpif((float)a * (1.0f / 64.0f)));
        }
        f32x2* TW = WSP(f32x2, WS_TW);
        for (int idx = gt; idx < 8192; idx += NGT) {
            const int t2 = idx >> 6, k1 = idx & 63; const float x = (float)(t2 * k1) * (1.0f / 4096.0f);
            TW[idx] = (f32x2){cospif(x), sinpif(x)};
        }
    }
}

template <int MODE>
__device__ __forceinline__ void rows_phase(const Frame& F0, const Args& args, int l) {
    const Frame F = fresh(F0);
    const int tid = F.tid, lane = F.lane, wave = F.wave;
    const float* MOD = WSP(float, WS_MOD);
    LAS float* gsc = (LAS float*)(F.lds + RING_OFF);
    LAS float* shf = gsc + 4096;
    LAS float* gtf = shf + 4096;
    for (int i = 0; i < 8; ++i) { const int idx = tid + 512 * i, b = idx >> 10, col = idx & 1023;
        if (MODE != 2) { gsc[idx] = INP(4)[l * 1024 + col] * (1.0f + MOD[(size_t)(l * 4 + b) * 6144 + 1024 + col]); shf[idx] = MOD[(size_t)(l * 4 + b) * 6144 + col]; }
        else gsc[idx] = INP(26)[col];
        if (MODE != 0) gtf[idx] = MOD[(size_t)((l - 1) * 4 + b) * 6144 + 5 * 1024 + col]; }
    __syncthreads();
    const float* xin = (MODE == 0) ? INP(0) : args.out;
    bf16* U = WSP(bf16, WS_U);
    const bf16* YE = WSP(bf16, WS_PROJ);
    const int* tokrow = WSP(int, WS_TOKROW); const float* tokw = WSP(float, WS_TOKW);
    const int gw = F.vcu * NWAVES + wave, NGW = F.G * NWAVES;
    for (int m = gw; m < NTOK; m += NGW) {
        const int b = m >> 13;
        const f32x4* xr = (const f32x4*)(xin + (size_t)m * D) + lane;
        f32x4 v[4];
#pragma unroll
        for (int j = 0; j < 4; ++j) v[j] = xr[64 * j];
        if (MODE != 0) {
            const int r0 = tokrow[2 * m], r1 = tokrow[2 * m + 1]; const float w0 = tokw[2 * m], w1 = tokw[2 * m + 1];
            const v2u* y0 = (const v2u*)(YE + (size_t)r0 * 1024) + lane; const v2u* y1 = (const v2u*)(YE + (size_t)r1 * 1024) + lane;
#pragma unroll
            for (int j = 0; j < 4; ++j) { const v2u a = y0[64 * j], c = y1[64 * j]; const f32x4 g = *(const LAS f32x4*)(gtf + b * 1024 + 4 * lane + 256 * j);
                v[j].x += g.x * (w0 * bflo(a.x) + w1 * bflo(c.x)); v[j].y += g.y * (w0 * bfhi(a.x) + w1 * bfhi(c.x));
                v[j].z += g.z * (w0 * bflo(a.y) + w1 * bflo(c.y)); v[j].w += g.w * (w0 * bfhi(a.y) + w1 * bfhi(c.y)); }
        }
        float ss = 0.f;
#pragma unroll
        for (int j = 0; j < 4; ++j) ss += (v[j].x * v[j].x + v[j].y * v[j].y) + (v[j].z * v[j].z + v[j].w * v[j].w);
        const float rstd = 1.0f / sqrtf(wave_sum(ss) * (1.0f / D) + EPS);
        if (MODE == 2) {
            f32x4* o = (f32x4*)(args.out + (size_t)m * D) + lane;
#pragma unroll
            for (int j = 0; j < 4; ++j) { const f32x4 g = *(const LAS f32x4*)(gsc + 4 * lane + 256 * j); o[64 * j] = v[j] * rstd * g; }
        } else {
            if (MODE == 1) { f32x4* o = (f32x4*)(args.out + (size_t)m * D) + lane;
#pragma unroll
                for (int j = 0; j < 4; ++j) o[64 * j] = v[j]; }
            v2u* uo = (v2u*)(U + (size_t)m * D) + lane;
#pragma unroll
            for (int j = 0; j < 4; ++j) { const f32x4 g = *(const LAS f32x4*)(gsc + b * 1024 + 4 * lane + 256 * j), s = *(const LAS f32x4*)(shf + b * 1024 + 4 * lane + 256 * j);
                const f32x4 u = v[j] * rstd * g + s; uo[64 * j] = (v2u){pk2(u.x, u.y), pk2(u.z, u.w)}; }
        }
    }
}

struct EpiP2 {
    static constexpr bool PERM = true;
    bf16* proj; bf16* vt; bf16* gates; const float* gbias;
    __device__ __forceinline__ void operator()(const f32x4 (&acc)[2][2][4][2], const pg8::Unit& u, int wr, int wc, int fr, int fq) const {
        const int row0 = u.pm * 256 + wr * 64 + fr, pn = u.pn;
        if (pn == 4 || pn == 5) {
#pragma unroll
            for (int ai = 0; ai < 2; ++ai)
#pragma unroll
                for (int m = 0; m < 4; ++m) { const int row = row0 + ai * 128 + m * 16, b = row >> 13, t = row & 8191;
#pragma unroll
                    for (int bj = 0; bj < 2; ++bj)
#pragma unroll
                        for (int n = 0; n < 2; ++n) { const int col = (pn - 4) * 256 + bj * 128 + wc * 32 + 8 * fq + 4 * n; bf16* d = vt + ((size_t)(b * 512 + col)) * 8192 + t;
                            d[0] = (bf16)f2bf(acc[ai][bj][m][n][0]); d[8192] = (bf16)f2bf(acc[ai][bj][m][n][1]); d[2 * 8192] = (bf16)f2bf(acc[ai][bj][m][n][2]); d[3 * 8192] = (bf16)f2bf(acc[ai][bj][m][n][3]); } }
        } else if (pn < 14) {
            const int cbase = (pn < 4 ? pn * 256 : (pn - 2) * 256) + wc * 32 + 8 * fq; const float sc = pn < 2 ? 0.125f : 1.0f;
#pragma unroll
            for (int ai = 0; ai < 2; ++ai)
#pragma unroll
                for (int m = 0; m < 4; ++m) { bf16* rowp = proj + (size_t)(row0 + ai * 128 + m * 16) * PROJ_LD + cbase;
#pragma unroll
                    for (int bj = 0; bj < 2; ++bj) { const f32x4 v0 = acc[ai][bj][m][0] * sc, v1 = acc[ai][bj][m][1] * sc;
                        *(v4u*)(rowp + bj * 128) = (v4u){pk2(v0[0], v0[1]), pk2(v0[2], v0[3]), pk2(v1[0], v1[1]), pk2(v1[2], v1[3])}; } }
        } else {
            const int cbase = (pn - 14) * 256 + wc * 32 + 8 * fq;
            f32x4 bv[2][2];
#pragma unroll
            for (int bj = 0; bj < 2; ++bj)
#pragma unroll
                for (int n = 0; n < 2; ++n) bv[bj][n] = *(const f32x4*)(gbias + cbase + bj * 128 + 4 * n);
#pragma unroll
            for (int ai = 0; ai < 2; ++ai)
#pragma unroll
                for (int m = 0; m < 4; ++m) { bf16* rowp = gates + (size_t)(row0 + ai * 128 + m * 16) * GATES_LD + cbase;
#pragma unroll
                    for (int bj = 0; bj < 2; ++bj) { f32x4 v0 = acc[ai][bj][m][0] + bv[bj][0], v1 = acc[ai][bj][m][1] + bv[bj][1];
#pragma unroll
                        for (int e = 0; e < 4; ++e) { v0[e] = sigmoidf(v0[e]); v1[e] = sigmoidf(v1[e]); }
                        *(v4u*)(rowp + bj * 128) = (v4u){pk2(v0[0], v0[1]), pk2(v0[2], v0[3]), pk2(v1[0], v1[1]), pk2(v1[2], v1[3])}; } }
        }
    }
};
struct EpiMerge {
    static constexpr bool PERM = true;
    const bf16* gates; bf16* merged;
    __device__ __forceinline__ void operator()(const f32x4 (&acc)[2][2][4][2], const pg8::Unit& u, int wr, int wc, int fr, int fq) const {
        const int row0 = u.pm * 256 + wr * 64 + fr, cbase = u.pn * 256 + wc * 32 + 8 * fq, z = u.z;
#pragma unroll
        for (int ai = 0; ai < 2; ++ai)
#pragma unroll
            for (int m = 0; m < 4; ++m) { const size_t row = (size_t)(row0 + ai * 128 + m * 16);
#pragma unroll
                for (int bj = 0; bj < 2; ++bj) { const v4u gv = *(const v4u*)(gates + row * GATES_LD + z * 1024 + cbase + bj * 128);
                    bf16* mp = merged + row * 1024 + cbase + bj * 128;
                    f32x4 v0 = acc[ai][bj][m][0], v1 = acc[ai][bj][m][1];
                    v0[0] *= bflo(gv.x); v0[1] *= bfhi(gv.x); v0[2] *= bflo(gv.y); v0[3] *= bfhi(gv.y); v1[0] *= bflo(gv.z); v1[1] *= bfhi(gv.z); v1[2] *= bflo(gv.w); v1[3] *= bfhi(gv.w);
                    if (z > 0) { const v4u ov = *(const v4u*)mp;
                        v0[0] += bflo(ov.x); v0[1] += bfhi(ov.x); v0[2] += bflo(ov.y); v0[3] += bfhi(ov.y); v1[0] += bflo(ov.z); v1[1] += bfhi(ov.z); v1[2] += bflo(ov.w); v1[3] += bfhi(ov.w); }
                    *(v4u*)mp = (v4u){pk2(v0[0], v0[1]), pk2(v0[2], v0[3]), pk2(v1[0], v1[1]), pk2(v1[2], v1[3])}; } }
    }
};
struct EpiResid {
    static constexpr bool PERM = false;
    const float* xin; float* xout; const float* gt;
    __device__ __forceinline__ void operator()(const f32x4 (&acc)[2][2][4][2], const pg8::Unit& u, int wr, int wc, int fr, int fq) const {
        const int row0 = u.pm * 256 + wr * 64 + fr, col0 = u.pn * 256 + wc * 32 + 4 * fq, b = (u.pm * 256) >> 13;
        f32x4 gv[2][2];
#pragma unroll
        for (int bj = 0; bj < 2; ++bj)
#pragma unroll
            for (int n = 0; n < 2; ++n) gv[bj][n] = *(const f32x4*)(gt + (size_t)b * 6144 + col0 + bj * 128 + n * 16);
#pragma unroll
        for (int ai = 0; ai < 2; ++ai)
#pragma unroll
            for (int m = 0; m < 4; ++m) { const size_t off = (size_t)(row0 + ai * 128 + m * 16) * D + col0;
#pragma unroll
                for (int bj = 0; bj < 2; ++bj)
#pragma unroll
                    for (int n = 0; n < 2; ++n) { const f32x4 xv = *(const f32x4*)(xin + off + bj * 128 + n * 16); *(f32x4*)(xout + off + bj * 128 + n * 16) = xv + gv[bj][n] * acc[ai][bj][m][n]; } }
    }
};
struct EpiSwiGLU {
    static constexpr bool PERM = true;
    bf16* H;
    __device__ __forceinline__ void operator()(const f32x4 (&acc)[2][2][4][2], const pg8::Unit& u, int wr, int wc, int fr, int fq) const {
        const int row0 = u.pm * 256 + wr * 64 + fr, cbase = u.pn * 128 + wc * 32 + 8 * fq;
#pragma unroll
        for (int ai = 0; ai < 2; ++ai)
#pragma unroll
            for (int m = 0; m < 4; ++m) { f32x4 h0, h1;
#pragma unroll
                for (int e = 0; e < 4; ++e) { const float g0 = acc[ai][0][m][0][e], g1 = acc[ai][0][m][1][e]; h0[e] = g0 * sigmoidf(g0) * acc[ai][1][m][0][e]; h1[e] = g1 * sigmoidf(g1) * acc[ai][1][m][1][e]; }
                *(v4u*)(H + (size_t)(row0 + ai * 128 + m * 16) * 512 + cbase) = (v4u){pk2(h0[0], h0[1]), pk2(h0[2], h0[3]), pk2(h1[0], h1[1]), pk2(h1[2], h1[3])}; }
    }
};
struct EpiYE {
    static constexpr bool PERM = true;
    bf16* YE;
    __device__ __forceinline__ void operator()(const f32x4 (&acc)[2][2][4][2], const pg8::Unit& u, int wr, int wc, int fr, int fq) const {
        const int row0 = u.pm * 256 + wr * 64 + fr, cbase = u.pn * 256 + wc * 32 + 8 * fq;
#pragma unroll
        for (int ai = 0; ai < 2; ++ai)
#pragma unroll
            for (int m = 0; m < 4; ++m) { bf16* rowp = YE + (size_t)(row0 + ai * 128 + m * 16) * 1024 + cbase;
#pragma unroll
                for (int bj = 0; bj < 2; ++bj) { const f32x4 v0 = acc[ai][bj][m][0], v1 = acc[ai][bj][m][1];
                    *(v4u*)(rowp + bj * 128) = (v4u){pk2(v0[0], v0[1]), pk2(v0[2], v0[3]), pk2(v1[0], v1[1]), pk2(v1[2], v1[3])}; } }
    }
};

__device__ __forceinline__ void attn_unit(bf16* PROJ, const bf16* VT, const LAS float* rpb, int b, int h, int r, int qb, int lane, bf16* obase, int opitch) {
    const int qn = lane & 15, g = lane >> 4;
    const int rs = min(max(r - 4, 0), 120);
    const int cb = (qb == 0) ? 0 : ((qb == 1) ? 8 : ((qb == 2) ? 24 : 32));
    const int w = 16 * qb + qn, cs = min(max(w - 8, 0), 48);
    const size_t tokq = (size_t)b * T + r * 64 + w;
    bf16* qp = PROJ + tokq * PROJ_LD + Q_OFF + h * 64;
    bf16x8 qf0 = *(const bf16x8*)(qp + 8 * g), qf1 = *(const bf16x8*)(qp + 32 + 8 * g);
    const bf16* kbase = PROJ + ((size_t)b * T + rs * 64 + cb + qn) * PROJ_LD + K_OFF + h * 64 + 8 * g;
    f32x4 sc[16];
#pragma unroll
    for (int kt = 0; kt < 16; ++kt) {
        const int kr = kt >> 1, ch = kt & 1;
        const bf16* kp = kbase + (size_t)(kr * 64 + 16 * ch) * PROJ_LD;
        const bf16x8 kf0 = *(const bf16x8*)kp, kf1 = *(const bf16x8*)(kp + 32);
        f32x4 a = (f32x4){0.f, 0.f, 0.f, 0.f};
        a = __builtin_amdgcn_mfma_f32_16x16x32_bf16(kf0, qf0, a, 0, 0, 0);
        a = __builtin_amdgcn_mfma_f32_16x16x32_bf16(kf1, qf1, a, 0, 0, 0);
        sc[kt] = a;
    }
    const LAS float* rp = rpb + h * 465;
    float mx = -1e30f;
#pragma unroll
    for (int kt = 0; kt < 16; ++kt) {
        const int kr = kt >> 1, ch = kt & 1;
        const int brow = (rs + kr - r + 7) * 31;
#pragma unroll
        for (int j = 0; j < 4; ++j) {
            const int kc = cb + 16 * ch + 4 * g + j, dc = kc - w + 15;
            const bool ok = (kc >= cs) && (kc <= cs + 15);
            const float bias = rp[brow + (ok ? dc : 15)];
            const float s = ok ? sc[kt][j] + bias : -1e30f;
            sc[kt][j] = s; mx = fmaxf(mx, s);
        }
    }
    mx = fmaxf(mx, __shfl_xor(mx, 16)); mx = fmaxf(mx, __shfl_xor(mx, 32));
    float sum = 0.f;
#pragma unroll
    for (int kt = 0; kt < 16; ++kt)
#pragma unroll
        for (int j = 0; j < 4; ++j) { const float p = __expf(sc[kt][j] - mx); sc[kt][j] = p; sum += p; }
    sum += __shfl_xor(sum, 16); sum += __shfl_xor(sum, 32);
    const float inv = 1.0f / sum;
    f32x4 o[4];
#pragma unroll
    for (int dt = 0; dt < 4; ++dt) o[dt] = (f32x4){0.f, 0.f, 0.f, 0.f};
    const bf16* vbase = VT + ((size_t)(b * 512 + h * 64 + qn)) * T + rs * 64 + cb + 4 * g;
#pragma unroll
    for (int kr = 0; kr < 8; ++kr) {
        v4u pw; pw.x = pk2(sc[2 * kr][0], sc[2 * kr][1]); pw.y = pk2(sc[2 * kr][2], sc[2 * kr][3]); pw.z = pk2(sc[2 * kr + 1][0], sc[2 * kr + 1][1]); pw.w = pk2(sc[2 * kr + 1][2], sc[2 * kr + 1][3]);
        const bf16x8 pf = __builtin_bit_cast(bf16x8, pw);
#pragma unroll
        for (int dt = 0; dt < 4; ++dt) {
            const bf16* vp = vbase + (size_t)(16 * dt) * T + kr * 64;
            const v2u lo = *(const v2u*)vp, hi = *(const v2u*)(vp + 16);
            const v4u vw = (v4u){lo.x, lo.y, hi.x, hi.y};
            o[dt] = __builtin_amdgcn_mfma_f32_16x16x32_bf16(__builtin_bit_cast(bf16x8, vw), pf, o[dt], 0, 0, 0);
        }
    }
    bf16* op = obase + tokq * opitch + h * 64;
#pragma unroll
    for (int dt = 0; dt < 4; ++dt) *(v2u*)(op + 16 * dt + 4 * g) = (v2u){pk2(o[dt][0] * inv, o[dt][1] * inv), pk2(o[dt][2] * inv, o[dt][3] * inv)};
}
__device__ __forceinline__ void attn_phase(const Frame& F0, const Args& args, int l, bf16* obase, int opitch) {
    const Frame F = fresh(F0);
    LAS float* rpb = (LAS float*)(F.lds + RING_OFF);
    for (int i = F.tid; i < 8 * 465; i += 512) rpb[i] = INP(9)[l * 8 * 465 + i];
    __syncthreads();
    bf16* PROJ = WSP(bf16, WS_PROJ); const bf16* VT = WSP(bf16, WS_VT);
    for (int wu = F.vcu * NWAVES + F.wave; wu < 16384; wu += F.G * NWAVES) {
        const int bh = wu >> 9, rem = wu & 511;
        attn_unit(PROJ, VT, rpb, bh >> 3, bh & 7, rem >> 2, rem & 3, F.lane, obase, opitch);
    }
    __syncthreads();
}

__device__ __forceinline__ float gelu_tanh(float x) { const float u = 0.7978845608028654f * (x + 0.044715f * x * x * x); const float t = 1.0f - 2.0f * __builtin_amdgcn_rcpf(1.0f + __expf(2.0f * u)); return 0.5f * x * (1.0f + t); }
__device__ __forceinline__ void fft_a_phase(const Frame& F0, const Args& args) {
    const Frame F = fresh(F0);
    const int lane = F.lane, nl = lane & 31, hh = lane >> 5;
    const bf16* PROJ = WSP(bf16, WS_PROJ); const bf16* FA = WSP(bf16, WS_FA); const f32x2* TW = WSP(f32x2, WS_TW); bf16* ZP = WSP(bf16, WS_U);
    for (int wu = F.vcu * NWAVES + F.wave; wu < 8192; wu += F.G * NWAVES) {
        const int ct = wu & 15, t2 = (wu >> 4) & 127, b = wu >> 11;
        bf16x8 bf[8];
#pragma unroll
        for (int s = 0; s < 8; ++s) { const int part = s >> 2, t1b = 16 * (s & 3) + 8 * hh;
            const bf16* p = PROJ + ((size_t)b * T + (size_t)128 * t1b + t2) * PROJ_LD + G_OFF + part * 512 + 32 * ct + nl;
            unsigned short e[8];
#pragma unroll
            for (int j = 0; j < 8; ++j) e[j] = p[(size_t)j * 128 * PROJ_LD];
            v4u w; w.x = e[0] | ((unsigned)e[1] << 16); w.y = e[2] | ((unsigned)e[3] << 16); w.z = e[4] | ((unsigned)e[5] << 16); w.w = e[6] | ((unsigned)e[7] << 16);
            bf[s] = __builtin_bit_cast(bf16x8, w); }
        f32x16 acc[4];
#pragma unroll
        for (int mt = 0; mt < 4; ++mt) { acc[mt] = (f32x16){};
#pragma unroll
            for (int s = 0; s < 8; ++s) { const bf16x8 af = *(const bf16x8*)(FA + (32 * mt + nl) * 128 + 16 * s + 8 * hh); acc[mt] = __builtin_amdgcn_mfma_f32_32x32x16_bf16(af, bf[s], acc[mt], 0, 0, 0); } }
#pragma unroll
        for (int mt = 0; mt < 2; ++mt)
#pragma unroll
            for (int rg = 0; rg < 16; ++rg) { const int k1 = 32 * mt + (rg & 3) + 8 * (rg >> 2) + 4 * hh; const f32x2 cs = TW[t2 * 64 + k1];
                const float zr = acc[mt][rg], zi = acc[mt + 2][rg];
                bf16* d = ZP + ((size_t)(b * 64 + k1) * 128 + t2) * 1024 + 32 * ct + nl;
                d[0] = (bf16)f2bf(zr * cs.x + zi * cs.y); d[512] = (bf16)f2bf(zi * cs.x - zr * cs.y); }
    }
}
__device__ __forceinline__ void fft_b_phase(const Frame& F0, const Args& args) {
    const Frame F = fresh(F0);
    const int lane = F.lane, nl = lane & 31, hh = lane >> 5;
    bf16* PROJ = WSP(bf16, WS_PROJ); const bf16* FB = WSP(bf16, WS_FB); const bf16* ZP = WSP(bf16, WS_U);
    for (int wu = F.vcu * NWAVES + F.wave; wu < 4096; wu += F.G * NWAVES) {
        const int ct = wu & 15, k1 = (wu >> 4) & 63, b = wu >> 10;
        f32x16 acc[4];
#pragma unroll
        for (int mt = 0; mt < 4; ++mt) acc[mt] = (f32x16){};
#pragma unroll 1
        for (int sc = 0; sc < 4; ++sc) {
            bf16x8 bf[4];
#pragma unroll
            for (int q = 0; q < 4; ++q) { const int s = 4 * sc + q, part = s >> 3, t2b = 16 * (s & 7) + 8 * hh;
                const bf16* p = ZP + ((size_t)(b * 64 + k1) * 128 + t2b) * 1024 + part * 512 + 32 * ct + nl;
                unsigned short e[8];
#pragma unroll
                for (int j = 0; j < 8; ++j) e[j] = p[(size_t)j * 1024];
                v4u w; w.x = e[0] | ((unsigned)e[1] << 16); w.y = e[2] | ((unsigned)e[3] << 16); w.z = e[4] | ((unsigned)e[5] << 16); w.w = e[6] | ((unsigned)e[7] << 16);
                bf[q] = __builtin_bit_cast(bf16x8, w); }
#pragma unroll
            for (int mt = 0; mt < 4; ++mt)
#pragma unroll
                for (int q = 0; q < 4; ++q) { const bf16x8 af = *(const bf16x8*)(FB + (32 * mt + nl) * 256 + 16 * (4 * sc + q) + 8 * hh); acc[mt] = __builtin_amdgcn_mfma_f32_32x32x16_bf16(af, bf[q], acc[mt], 0, 0, 0); }
        }
#pragma unroll
        for (int mt = 0; mt < 4; ++mt)
#pragma unroll
            for (int rg = 0; rg < 16; ++rg) { const int k2 = 32 * mt + (rg & 3) + 8 * (rg >> 2) + 4 * hh;
                PROJ[((size_t)b * T + k1 + 64 * k2) * PROJ_LD + G_OFF + 32 * ct + nl] = (bf16)f2bf(acc[mt][rg] * (1.0f / 1024.0f)); }
    }
}

__device__ __forceinline__ void router_phase(const Frame& F0, const Args& args, int l) {
    const Frame F = fresh(F0);
    const int tid = F.tid, lane = F.lane, wave = F.wave;
    const float* MOD = WSP(float, WS_MOD);
    LAS float* WPL = (LAS float*)(F.lds + RING_OFF);
    LAS float* gsc = (LAS float*)(F.lds + XTRA_OFF);
    LAS float* shf = gsc + 1024;
    LAS float* c0 = shf + 1024;
    LAS float* rb = c0 + 32;
    LAS unsigned* lcnt = (LAS unsigned*)(rb + 32);
    LAS unsigned* lbase = lcnt + 32;
    LAS float* red = (LAS float*)(lbase + 32);
    const float* x = args.out; bf16* U2 = WSP(bf16, WS_U);
    float* tokw = WSP(float, WS_TOKW); int* perm = WSP(int, WS_PERM);
    unsigned* ecnt = (unsigned*)(F.ctl + CW_ECNT + l * 32 * 64);
    const int nround = (2048 + F.G * NWAVES - 1) / (F.G * NWAVES);
    int cur_b = -1;
    for (int rd = 0; rd < nround; ++rd) {
        const int unit = (rd * F.G + F.vcu) * NWAVES + wave;
        const int ub = (((rd * F.G + F.vcu) * NWAVES) * 16) >> 13;
        const bool wg_active = ((rd * F.G + F.vcu) * NWAVES) < 2048;
        if (wg_active && ub != cur_b) {
            cur_b = ub; __syncthreads();
            for (int i = 0; i < 2; ++i) { const int col = tid + 512 * i; gsc[col] = INP(5)[l * 1024 + col] * (1.0f + MOD[(size_t)(l * 4 + ub) * 6144 + 4 * 1024 + col]); shf[col] = MOD[(size_t)(l * 4 + ub) * 6144 + 3 * 1024 + col]; }
            if (tid < 32) rb[tid] = INP(22)[tid];
            __syncthreads();
            for (int i = 0; i < 64; ++i) { const int idx = tid + 512 * i, k = idx >> 5, e = idx & 31; WPL[k * 32 + (e ^ (((k >> 8) & 1) << 4))] = gsc[k] * INP(21)[idx]; }
            { const int e = tid & 31, pt = tid >> 5; float s = 0.f;
                for (int k = pt * 64; k < pt * 64 + 64; ++k) s += shf[k] * INP(21)[k * 32 + e];
                red[tid] = s; }
            __syncthreads();
            if (tid < 32) { float s = 0.f; for (int p = 0; p < 16; ++p) s += red[p * 32 + tid]; c0[tid] = s; }
        }
        if (tid < 32) lcnt[tid] = 0u;
        __syncthreads();
        int e0 = 0, e1 = 0; unsigned rk0 = 0, rk1 = 0; float w0 = 0.f, w1 = 0.f; bool owner = false; int mytok = 0;
        if (unit < 2048) {
            const int tok0 = unit * 16;
            float rs_reg = 0.f;
            for (int i = 0; i < 16; ++i) { const int m = tok0 + i;
                const f32x4* xr = (const f32x4*)(x + (size_t)m * D) + lane; f32x4 v[4]; float ss = 0.f;
#pragma unroll
                for (int j = 0; j < 4; ++j) { v[j] = xr[64 * j]; ss += (v[j].x * v[j].x + v[j].y * v[j].y) + (v[j].z * v[j].z + v[j].w * v[j].w); }
                const float rstd = 1.0f / sqrtf(wave_sum(ss) * (1.0f / D) + EPS);
                if ((lane & 15) == i) rs_reg = rstd;
                v2u* uo = (v2u*)(U2 + (size_t)m * D) + lane;
#pragma unroll
                for (int j = 0; j < 4; ++j) { const f32x4 g = *(const LAS f32x4*)(gsc + 4 * lane + 256 * j), s = *(const LAS f32x4*)(shf + 4 * lane + 256 * j);
                    const f32x4 u = v[j] * rstd * g + s; uo[64 * j] = (v2u){pk2(u.x, u.y), pk2(u.z, u.w)}; } }
            const int ti = lane & 15, kq = lane >> 4;
            const f32x4* xrow = (const f32x4*)(x + (size_t)(tok0 + ti) * D + 256 * kq);
            const LAS float* wp0 = WPL + (256 * kq) * 32 + (ti ^ ((kq & 1) << 4));
            const LAS float* wp1 = WPL + (256 * kq) * 32 + ((16 + ti) ^ ((kq & 1) << 4));
            f32x4 a0 = {0.f, 0.f, 0.f, 0.f}, a1 = {0.f, 0.f, 0.f, 0.f};
#pragma unroll 4
            for (int t4 = 0; t4 < 64; ++t4) { const f32x4 xv = xrow[t4];
#pragma unroll
                for (int jj = 0; jj < 4; ++jj) { const int kk = 4 * t4 + jj;
                    a0 = __builtin_amdgcn_mfma_f32_16x16x4f32(wp0[kk * 32], xv[jj], a0, 0, 0, 0);
                    a1 = __builtin_amdgcn_mfma_f32_16x16x4f32(wp1[kk * 32], xv[jj], a1, 0, 0, 0); } }
            float sco[2][4], sel[2][4], gs[2];
#pragma unroll
            for (int nt = 0; nt < 2; ++nt) {
#pragma unroll
                for (int rg = 0; rg < 4; ++rg) { const int e = 16 * nt + 4 * kq + rg; const float lg = rs_reg * (nt ? a1[rg] : a0[rg]) + c0[e]; sco[nt][rg] = sigmoidf(lg); sel[nt][rg] = sco[nt][rg] + rb[e]; }
                float m1 = fmaxf(sel[nt][0], sel[nt][1]), m2 = fminf(sel[nt][0], sel[nt][1]);
                { const float v = sel[nt][2]; if (v > m1) { m2 = m1; m1 = v; } else if (v > m2) m2 = v; }
                { const float v = sel[nt][3]; if (v > m1) { m2 = m1; m1 = v; } else if (v > m2) m2 = v; }
                gs[nt] = m1 + m2; }
            float bv = gs[0]; int bg = kq; if (gs[1] > bv) { bv = gs[1]; bg = 4 + kq; }
#pragma unroll
            for (int o = 16; o < 64; o <<= 1) { const float ov = __shfl_xor(bv, o); const int og = __shfl_xor(bg, o); if (ov > bv || (ov == bv && og < bg)) { bv = ov; bg = og; } }
            owner = ((bg & 3) == kq); mytok = tok0 + ti;
            if (owner) { const int nt = bg >> 2; float cd[4], sv[4];
#pragma unroll
                for (int rg = 0; rg < 4; ++rg) { cd[rg] = nt ? sel[1][rg] : sel[0][rg]; sv[rg] = nt ? sco[1][rg] : sco[0][rg]; }
                int i1 = 0; float v1 = cd[0];
#pragma unroll
                for (int rg = 1; rg < 4; ++rg) if (cd[rg] > v1) { v1 = cd[rg]; i1 = rg; }
                int i2 = -1; float v2 = -1e30f;
#pragma unroll
                for (int rg = 0; rg < 4; ++rg) if (rg != i1 && cd[rg] > v2) { v2 = cd[rg]; i2 = rg; }
                const float s1 = (i1 == 0 ? sv[0] : (i1 == 1 ? sv[1] : (i1 == 2 ? sv[2] : sv[3]))), s2 = (i2 == 0 ? sv[0] : (i2 == 1 ? sv[1] : (i2 == 2 ? sv[2] : sv[3])));
                e0 = 4 * bg + i1; e1 = 4 * bg + i2; w0 = s1 / (s1 + s2); w1 = s2 / (s1 + s2);
                rk0 = __hip_atomic_fetch_add(lcnt + e0, 1u, __ATOMIC_RELAXED, __HIP_MEMORY_SCOPE_WORKGROUP);
                rk1 = __hip_atomic_fetch_add(lcnt + e1, 1u, __ATOMIC_RELAXED, __HIP_MEMORY_SCOPE_WORKGROUP); }
        }
        __syncthreads();
        if (tid < 32) { const unsigned n = lcnt[tid]; lbase[tid] = n ? __hip_atomic_fetch_add(ecnt + 64 * tid, n, RLX_AGENT) : 0u; }
        __syncthreads();
        if (owner) { perm[(size_t)e0 * NTOK + lbase[e0] + rk0] = 2 * mytok; perm[(size_t)e1 * NTOK + lbase[e1] + rk1] = 2 * mytok + 1; tokw[2 * mytok] = w0; tokw[2 * mytok + 1] = w1; }
    }
    __syncthreads();
    {
        LAS float* scr = (LAS float*)(F.lds + RING_OFF + wave * 8704);
        const int gw = F.vcu * NWAVES + wave, NGW = F.G * NWAVES;
        bf16* WG1 = WSP(bf16, WS_WG1); bf16* WD = WSP(bf16, WS_WD);
        for (int rep = 0; rep < 1 + REP_C; ++rep)
        for (int it = gw; it < 24576; it += NGW) {
            const int kind = it >> 13, r = it & 8191, e = r >> 8, rr = r & 255;
            if (kind < 2) { const int kb = rr >> 4, nb = rr & 15, n0 = nb * 32; const float* src = (kind == 0 ? INP(23) : INP(24)) + (size_t)(l * 32 + e) * 1024 * 512;
                transpose_item(src, 512, kb * 64, n0, WG1 + ((size_t)e * 1024 + (n0 >> 7) * 256 + kind * 128 + (n0 & 127)) * 1024, 1024, scr, lane); }
            else { const int kb = rr >> 5, nb = rr & 31, n0 = nb * 32; const float* src = INP(25) + (size_t)(l * 32 + e) * 512 * 1024;
                transpose_item(src, 1024, kb * 64, n0, WD + ((size_t)e * 1024 + n0) * 512, 512, scr, lane); }
        }
    }
}
__device__ __forceinline__ void moe_tilebase(const Frame& F0, const Args& args, int l) {
    const Frame F = fresh(F0);
    if (F.tid == 0) { unsigned* ecnt = (unsigned*)(F.ctl + CW_ECNT + l * 32 * 64); int acc = 0;
        for (int e = 0; e < 32; ++e) { F.MISC[16 + e] = (unsigned)acc; acc += (int)((__hip_atomic_load(ecnt + 64 * e, RLX_AGENT) + 255u) >> 8); }
        F.MISC[48] = (unsigned)acc; }
    __syncthreads();
}
__device__ __forceinline__ void gather_phase(const Frame& F0, const Args& args, int l) {
    const Frame F = fresh(F0);
    moe_tilebase(F, args, l);
    const unsigned* ecnt = (const unsigned*)(F.ctl + CW_ECNT + l * 32 * 64);
    const int* perm = WSP(int, WS_PERM); int* tokrow = WSP(int, WS_TOKROW);
    const bf16* U2 = WSP(bf16, WS_U); bf16* XS = WSP(bf16, WS_PROJ);
    const int nrows = (int)F.MISC[48] * 256;
    for (int r = F.vcu * NWAVES + F.wave; r < nrows; r += F.G * NWAVES) {
        const int t = r >> 8; int e = 0;
        for (int k = 1; k < 32; ++k) e += ((int)F.MISC[16 + k] <= t) ? 1 : 0;
        const int s = r - 256 * (int)F.MISC[16 + e];
        const int cnt = (int)__hip_atomic_load(ecnt + 64 * e, RLX_AGENT);
        if (s < cnt) { const int tk = perm[(size_t)e * NTOK + s], tok = tk >> 1;
            const v4u* src = (const v4u*)(U2 + (size_t)tok * 1024) + F.lane; v4u* dst = (v4u*)(XS + (size_t)r * 1024) + F.lane;
            dst[0] = src[0]; dst[64] = src[64];
            if (F.lane == 0) tokrow[tk] = r; }
    }
}
__device__ __forceinline__ void lru_conv_phase(const Frame& F0, const Args& args, int l) {
    const Frame F = fresh(F0);
    const int lane = F.lane, cg = lane & 7, tg = lane >> 3;
    const bf16* PROJ = WSP(bf16, WS_PROJ); bf16* XC = WSP(bf16, WS_XC);
    for (int wu = F.vcu * NWAVES + F.wave; wu < 4096; wu += F.G * NWAVES) {
        const int hb = wu & 7, c = (wu >> 3) & 127, b = wu >> 10, t0 = c * 64, ch0 = hb * 64 + 8 * cg;
        const bf16* xrp = PROJ + (size_t)b * T * PROJ_LD + XR_OFF + ch0;
        v4u raw[11];
#pragma unroll
        for (int rr = 0; rr < 11; ++rr) { const int t = t0 + 8 * tg - 2 + rr, tc = min(max(t, 0), T - 1); raw[rr] = *(const v4u*)(xrp + (size_t)tc * PROJ_LD); }
        f32x4 wv[5][2];
#pragma unroll
        for (int j = 0; j < 4; ++j) { wv[j][0] = *(const f32x4*)(INP(10) + (l * 4 + j) * 512 + ch0); wv[j][1] = *(const f32x4*)(INP(10) + (l * 4 + j) * 512 + ch0 + 4); }
        wv[4][0] = *(const f32x4*)(INP(11) + l * 512 + ch0); wv[4][1] = *(const f32x4*)(INP(11) + l * 512 + ch0 + 4);
        unsigned ow[8][4];
#pragma unroll
        for (int pp = 0; pp < 4; ++pp) {
            float xl[11], xh[11];
#pragma unroll
            for (int rr = 0; rr < 11; ++rr) { const int t = t0 + 8 * tg - 2 + rr; const unsigned w = (t >= 0 && t < T) ? raw[rr][pp] : 0u; xl[rr] = bflo(w); xh[rr] = bfhi(w); }
#pragma unroll
            for (int tk = 0; tk < 8; ++tk) { float ol = wv[4][pp >> 1][2 * (pp & 1)], oh = wv[4][pp >> 1][2 * (pp & 1) + 1];
#pragma unroll
                for (int j = 0; j < 4; ++j) { ol += wv[j][pp >> 1][2 * (pp & 1)] * xl[tk + j]; oh += wv[j][pp >> 1][2 * (pp & 1) + 1] * xh[tk + j]; }
                ow[tk][pp] = pk2(ol, oh); }
        }
#pragma unroll
        for (int tk = 0; tk < 8; ++tk) *(v4u*)(XC + ((size_t)b * T + t0 + 8 * tg + tk) * 512 + ch0) = (v4u){ow[tk][0], ow[tk][1], ow[tk][2], ow[tk][3]};
    }
}
__device__ __forceinline__ void lru_load_frags(bf16x8 (&af)[4][2], const bf16* xcp, int t0, int lane) {
#pragma unroll
    for (int mt = 0; mt < 4; ++mt) { const int tau = 16 * ((lane & 15) >> 2) + 4 * mt + (lane & 3);
#pragma unroll
        for (int s = 0; s < 2; ++s) af[mt][s] = *(const bf16x8*)(xcp + (size_t)(t0 + tau) * 512 + 32 * s); }
}
__device__ __forceinline__ void lru2_phase(const Frame& F0, const Args& args, int l, bf16* obase, int opitch, int ooff) {
    const Frame F = fresh(F0);
    const int lane = F.lane, wave = F.wave;
    LAS bf16* YRT = (LAS bf16*)(F.lds + RING_OFF + wave * 1024);
    LAS f32x2* SUMT = (LAS f32x2*)(F.lds + RING_OFF + 8192);
    LAS float* CARRY = (LAS float*)(F.lds + RING_OFF + 24576);
    const bf16* PROJ = WSP(bf16, WS_PROJ); const bf16* XC = WSP(bf16, WS_XC);
    for (int un = F.vcu; un < 256; un += F.G) {
        const int b = un >> 6, hb = (un >> 3) & 7, s8 = un & 7;
        const int n = lane & 15, g = lane >> 4, dir = n >> 3, cj = n & 7;
        const int chg = hb * 64 + s8 * 8 + cj;
        const bf16* WLp = WSP(bf16, WS_WL) + ((size_t)(l * 8 + hb) * 256) * 64;
        bf16x8 br[2], bi[2], bs[2];
#pragma unroll
        for (int s = 0; s < 2; ++s) { br[s] = *(const bf16x8*)(WLp + ((2 * dir + 0) * 64 + s8 * 8 + cj) * 64 + 32 * s + 8 * g); bi[s] = *(const bf16x8*)(WLp + ((2 * dir + 1) * 64 + s8 * 8 + cj) * 64 + 32 * s + 8 * g);
            v4u sel = (v4u){0u, 0u, 0u, 0u};
            if (32 * s + 8 * g == 8 * s8) { const unsigned one = (cj & 1) ? 0x3F800000u : 0x00003F80u; sel[0] = (cj >> 1) == 0 ? one : 0u; sel[1] = (cj >> 1) == 1 ? one : 0u; sel[2] = (cj >> 1) == 2 ? one : 0u; sel[3] = (cj >> 1) == 3 ? one : 0u; }
            bs[s] = __builtin_bit_cast(bf16x8, sel); }
        const float b_r = INP(13)[(l * 2 + dir) * 512 + chg], b_i = INP(15)[(l * 2 + dir) * 512 + chg], lam = INP(16)[(l * 2 + dir) * 512 + chg];
        const float m8sp = -8.0f * ((lam > 15.f) ? __expf(-lam) : log1pf(__expf(-lam)));
        const bf16* xcp = XC + (size_t)b * T * 512 + hb * 64 + 8 * g;
        const bf16* yrp = PROJ + (size_t)b * T * PROJ_LD + YR_OFF + hb * 64 + s8 * 8;
        bf16* outp = obase + (size_t)b * T * opitch + ooff + hb * 64 + s8 * 8;
#pragma unroll 1
        for (int sweep = 0; sweep < 2; ++sweep) {
            bf16x8 nxt[4][2]; v4u ynx = (v4u){0u, 0u, 0u, 0u};
            lru_load_frags(nxt, xcp, wave * 64, lane);
            if (sweep == 1) ynx = *(const v4u*)(yrp + (size_t)(wave * 64 + lane) * PROJ_LD);
#pragma unroll 1
            for (int ci = 0; ci < 16; ++ci) {
                const int c = wave + 8 * ci, t0 = c * 64;
                bf16x8 af[4][2];
#pragma unroll
                for (int mt = 0; mt < 4; ++mt) { af[mt][0] = nxt[mt][0]; af[mt][1] = nxt[mt][1]; }
                const v4u ycur = ynx;
                if (ci + 1 < 16) { lru_load_frags(nxt, xcp, t0 + 512, lane); if (sweep == 1) ynx = *(const v4u*)(yrp + (size_t)(t0 + 512 + lane) * PROJ_LD); }
                if (sweep == 1) *(LAS v4u*)(YRT + lane * 8) = ycur;
                f32x4 ar[4], ai[4], ax[4];
#pragma unroll
                for (int mt = 0; mt < 4; ++mt) { ar[mt] = (f32x4){0.f, 0.f, 0.f, 0.f}; ai[mt] = (f32x4){0.f, 0.f, 0.f, 0.f}; ax[mt] = (f32x4){0.f, 0.f, 0.f, 0.f};
#pragma unroll
                    for (int s = 0; s < 2; ++s) { ar[mt] = __builtin_amdgcn_mfma_f32_16x16x32_bf16(af[mt][s], br[s], ar[mt], 0, 0, 0); ai[mt] = __builtin_amdgcn_mfma_f32_16x16x32_bf16(af[mt][s], bi[s], ai[mt], 0, 0, 0);
                        ax[mt] = __builtin_amdgcn_mfma_f32_16x16x32_bf16(af[mt][s], bs[s], ax[mt], 0, 0, 0); } }
                float a[16], bx[16];
#pragma unroll
                for (int j = 0; j < 16; ++j) { const float rr = fsigmoid(ar[j >> 2][j & 3] + b_r), ii = fsigmoid(ai[j >> 2][j & 3] + b_i);
                    const float av = __expf(m8sp * rr); a[j] = av; bx[j] = __builtin_amdgcn_sqrtf(fmaxf(1.0f - av * av, 0.f)) * (ii * ax[j >> 2][j & 3]); }
                float A16 = 1.f, B16 = 0.f;
                if (dir == 0) {
#pragma unroll
                    for (int j = 0; j < 16; ++j) { B16 = a[j] * B16 + bx[j]; A16 *= a[j]; }
                } else {
#pragma unroll
                    for (int j = 15; j >= 0; --j) { B16 = a[j] * B16 + bx[j]; A16 *= a[j]; }
                }
                float Ag[4], Bg[4];
#pragma unroll
                for (int k = 0; k < 4; ++k) { const int src = n + 16 * (dir ? 3 - k : k); Ag[k] = __shfl(A16, src); Bg[k] = __shfl(B16, src); }
                if (sweep == 0) {
                    float At = 1.f, Bt = 0.f;
#pragma unroll
                    for (int k = 0; k < 4; ++k) { Bt = Ag[k] * Bt + Bg[k]; At *= Ag[k]; }
                    if (g == 0) SUMT[c * 16 + n] = (f32x2){At, Bt};
                } else {
                    const int pos = dir ? 3 - g : g;
                    float h = CARRY[c * 16 + n];
#pragma unroll
                    for (int k = 0; k < 3; ++k) if (k < pos) h = Ag[k] * h + Bg[k];
                    float hj[16];
                    if (dir == 0) {
#pragma unroll
                        for (int j = 0; j < 16; ++j) { h = a[j] * h + bx[j]; hj[j] = h; }
                    } else {
#pragma unroll
                        for (int j = 15; j >= 0; --j) { h = a[j] * h + bx[j]; hj[j] = h; }
                    }
#pragma unroll
                    for (int j = 0; j < 16; ++j) hj[j] += __shfl_xor(hj[j], 8);
                    LDS_WAIT(); asm volatile("" ::: "memory");
                    {
                        float hv[8], yv[8];
#pragma unroll
                        for (int j = 0; j < 8; ++j) { hv[j] = dir ? hj[8 + j] : hj[j]; yv[j] = bf2f(YRT[(16 * g + 8 * dir + j) * 8 + cj]); }
#pragma unroll
                        for (int j = 0; j < 8; ++j) YRT[(16 * g + 8 * dir + j) * 8 + cj] = (bf16)f2bf(hv[j] * gelu_tanh(yv[j]));
                    }
                    LDS_WAIT(); asm volatile("" ::: "memory");
                    *(v4u*)(outp + (size_t)(t0 + lane) * opitch) = *(const LAS v4u*)(YRT + lane * 8);
                    LDS_WAIT(); asm volatile("" ::: "memory");
                }
            }
            if (sweep == 0) {
                __syncthreads();
                if (F.tid < 16) { const int nn = F.tid, dd = nn >> 3; float h = 0.f;
#pragma unroll 4
                    for (int i = 0; i < 128; ++i) { const int c = dd ? 127 - i : i; const f32x2 ab = SUMT[c * 16 + nn]; CARRY[c * 16 + nn] = h; h = ab.x * h + ab.y; } }
                __syncthreads();
            }
        }
        __syncthreads();
    }
}
constexpr int AT_KR = 0, AT_VR = 73728, AT_VPITCH = 1168, AT_RPB = 148480;
__device__ __forceinline__ void attn2_phase(const Frame& F0, const Args& args, int l, bf16* obase, int opitch) {
    const Frame F = fresh(F0);
    const int tid = F.tid, lane = F.lane, wave = F.wave;
    LAS unsigned char* KR = F.lds + AT_KR; LAS unsigned char* VR = F.lds + AT_VR;
    LAS float* rpb = (LAS float*)(F.lds + AT_RPB);
    const bf16* PROJ = WSP(bf16, WS_PROJ); const bf16* VT = WSP(bf16, WS_VT);
    const int qb = wave & 3, dh = wave >> 2, qn = lane & 15, g = lane >> 4;
    const int cb = (qb == 0) ? 0 : ((qb == 1) ? 8 : ((qb == 2) ? 24 : 32));
    const int w = 16 * qb + qn, cs = min(max(w - 8, 0), 48);
    const int st = tid >> 3, sc = tid & 7;
    for (int un = F.vcu; un < 256; un += F.G) {
        const int bh = un >> 3, b = bh >> 3, h = bh & 7, R0 = (un & 7) * 16;
        __syncthreads();
        for (int i = tid; i < 465; i += 512) rpb[i] = INP(9)[(l * 8 + h) * 465 + i];
        const bf16* kg = PROJ + ((size_t)b * T + st) * PROJ_LD + K_OFF + h * 64 + 8 * sc;
        const bf16* vg = VT + ((size_t)(b * 512 + h * 64 + st)) * T + 8 * sc;
        const int kdst = st * 128 + ((sc ^ ((st >> 1) & 7)) * 16);
        const int vdst = st * AT_VPITCH + sc * 16;
        const int rs0 = min(max(R0 - 4, 0), 120);
        {
            v4u kk[8], vv[8];
#pragma unroll
            for (int j = 0; j < 8; ++j) { kk[j] = *(const v4u*)(kg + (size_t)(rs0 + j) * 64 * PROJ_LD); vv[j] = *(const v4u*)(vg + (rs0 + j) * 64); }
#pragma unroll
            for (int j = 0; j < 8; ++j) { const int slot = (rs0 + j) % 9; *(LAS v4u*)(KR + slot * 8192 + kdst) = kk[j]; *(LAS v4u*)(VR + slot * 128 + vdst) = vv[j]; }
        }
        __syncthreads();
        int have = rs0 + 7;
        v2u py0 = (v2u){0u, 0u}, py1 = (v2u){0u, 0u}; bf16* pop = nullptr;
#pragma unroll 1
        for (int s = 0; s < 16; ++s) {
            const int r = R0 + s;
            if (s > 0) { *(v2u*)pop = py0; *(v2u*)(pop + 16) = py1; }
            const size_t tokq = (size_t)b * T + r * 64 + w;
            const bf16* qp = PROJ + tokq * PROJ_LD + Q_OFF + h * 64;
            const bf16x8 qf0 = *(const bf16x8*)(qp + 8 * g), qf1 = *(const bf16x8*)(qp + 32 + 8 * g);
            const int rsn = min(max(r + 1 - 4, 0), 120); const bool newrow = (s + 1 < 16) && (rsn + 7 > have); const int nrow = min(rsn + 7, 127);
            const v4u pk = *(const v4u*)(kg + (size_t)nrow * 64 * PROJ_LD), pv = *(const v4u*)(vg + nrow * 64);
            const int rs = min(max(r - 4, 0), 120);
            int slot = rs % 9;
            f32x4 sc4[16];
#pragma unroll
            for (int kr = 0; kr < 8; ++kr) {
#pragma unroll
                for (int ch = 0; ch < 2; ++ch) { const int kt = cb + 16 * ch + qn; const LAS unsigned char* kp = KR + slot * 8192 + kt * 128; const int sw = (kt >> 1) & 7;
                    const bf16x8 kf0 = *(const LAS bf16x8*)(kp + ((g ^ sw) * 16)), kf1 = *(const LAS bf16x8*)(kp + (((4 + g) ^ sw) * 16));
                    f32x4 a = (f32x4){0.f, 0.f, 0.f, 0.f};
                    a = __builtin_amdgcn_mfma_f32_16x16x32_bf16(kf0, qf0, a, 0, 0, 0);
                    a = __builtin_amdgcn_mfma_f32_16x16x32_bf16(kf1, qf1, a, 0, 0, 0);
                    sc4[2 * kr + ch] = a; }
                slot = (slot == 8) ? 0 : slot + 1;
            }
            float mx = -1e30f;
#pragma unroll
            for (int kt = 0; kt < 16; ++kt) { const int kr = kt >> 1, ch = kt & 1; const int brow = (rs + kr - r + 7) * 31;
#pragma unroll
                for (int j = 0; j < 4; ++j) { const int kc = cb + 16 * ch + 4 * g + j, dc = kc - w + 15; const bool ok = (kc >= cs) && (kc <= cs + 15);
                    const float bias = rpb[brow + (ok ? dc : 15)]; const float sv = ok ? sc4[kt][j] + bias : -1e30f; sc4[kt][j] = sv; mx = fmaxf(mx, sv); } }
            mx = fmaxf(mx, __shfl_xor(mx, 16)); mx = fmaxf(mx, __shfl_xor(mx, 32));
            float sum = 0.f;
#pragma unroll
            for (int kt = 0; kt < 16; ++kt)
#pragma unroll
                for (int j = 0; j < 4; ++j) { const float p = __expf(sc4[kt][j] - mx); sc4[kt][j] = p; sum += p; }
            sum += __shfl_xor(sum, 16); sum += __shfl_xor(sum, 32);
            const float inv = __builtin_amdgcn_rcpf(sum);
            f32x4 o0 = (f32x4){0.f, 0.f, 0.f, 0.f}, o1 = (f32x4){0.f, 0.f, 0.f, 0.f};
            slot = rs % 9;
            const LAS unsigned char* vb0 = VR + (32 * dh + qn) * AT_VPITCH + (cb + 4 * g) * 2;
#pragma unroll
            for (int kr = 0; kr < 8; ++kr) {
                v4u pw; pw.x = pk2(sc4[2 * kr][0], sc4[2 * kr][1]); pw.y = pk2(sc4[2 * kr][2], sc4[2 * kr][3]); pw.z = pk2(sc4[2 * kr + 1][0], sc4[2 * kr + 1][1]); pw.w = pk2(sc4[2 * kr + 1][2], sc4[2 * kr + 1][3]);
                const bf16x8 pf = __builtin_bit_cast(bf16x8, pw);
                const LAS unsigned char* vp = vb0 + slot * 128;
                const v2u lo0 = *(const LAS v2u*)vp, hi0 = *(const LAS v2u*)(vp + 32), lo1 = *(const LAS v2u*)(vp + 16 * AT_VPITCH), hi1 = *(const LAS v2u*)(vp + 16 * AT_VPITCH + 32);
                o0 = __builtin_amdgcn_mfma_f32_16x16x32_bf16(__builtin_bit_cast(bf16x8, ((v4u){lo0.x, lo0.y, hi0.x, hi0.y})), pf, o0, 0, 0, 0);
                o1 = __builtin_amdgcn_mfma_f32_16x16x32_bf16(__builtin_bit_cast(bf16x8, ((v4u){lo1.x, lo1.y, hi1.x, hi1.y})), pf, o1, 0, 0, 0);
                slot = (slot == 8) ? 0 : slot + 1;
            }
            py0 = (v2u){pk2(o0[0] * inv, o0[1] * inv), pk2(o0[2] * inv, o0[3] * inv)}; py1 = (v2u){pk2(o1[0] * inv, o1[1] * inv), pk2(o1[2] * inv, o1[3] * inv)};
            pop = obase + tokq * opitch + h * 64 + 32 * dh + 4 * g;
            if (newrow) { const int ns = nrow % 9; *(LAS v4u*)(KR + ns * 8192 + kdst) = pk; *(LAS v4u*)(VR + ns * 128 + vdst) = pv; have = nrow; }
            __syncthreads();
        }
        *(v2u*)pop = py0; *(v2u*)(pop + 16) = py1;
    }
    __syncthreads();
}
__device__ __forceinline__ int fresh_bid() { int b = (int)blockIdx.x; asm volatile("" : "+s"(b)); return b; }
constexpr int PPL = 10, N_PHASES = 2 + PPL * DEPTH;
__global__ void __launch_bounds__(NWAVES * 64, 2) mega_fwd(Args args, int li) {
    extern __shared__ __attribute__((aligned(16))) unsigned char lds[];
    Frame F;
    F.lds = (LAS unsigned char*)lds;
    F.MISC = (volatile LAS unsigned*)(F.lds + MISC_OFF);
    F.tid = threadIdx.x; F.lane = F.tid & 63; F.wave = __builtin_amdgcn_readfirstlane(F.tid >> 6);
    F.G = gridDim.x; { const int bx = blockIdx.x; F.vcu = (F.G % 8 == 0) ? (bx % 8) * (F.G / 8) + bx / 8 : bx; }
    F.ctl = (gu32*)(args.ws + WS_CTL);
    for (int u = F.tid; u < (LDS_BYTES - LDSCTL_OFF) / 4; u += NWAVES * 64) ((LAS unsigned*)(F.lds + LDSCTL_OFF))[u] = 0u;
    __syncthreads();
    const int lo = args.ph_lo, hi = args.ph_hi;
    XcdBarrier bar; bar.bar = (unsigned*)(F.ctl + CW_BAR) + li * XCD_BAR_WORDS; bar.x = 0; bar.st = nullptr;
    if (hi - lo > 1) bar = xcd_barrier_post((unsigned*)(F.ctl + CW_BAR) + li * XCD_BAR_WORDS, F.MISC + 8);
#ifndef PHMASK
#define PHMASK 0xFFFF
#endif
#define EN(kind) ((PHMASK >> (kind)) & 1)
#define IN(k) (lo <= (k) && (k) < hi)
#define SEAM(k) do { if (IN(k) && IN((k) + 1)) xcd_barrier(bar); } while (0)

    if (EN(0) && IN(0)) { for (int rep = 0; rep < 1 + REP_C; ++rep) p0_prologue(F, args); SEAM(0); }
    for (int l = 0; l < DEPTH; ++l) {
        const int pb = 1 + PPL * l;
        bf16* U = WSP(bf16, WS_U); bf16* PROJ = WSP(bf16, WS_PROJ); bf16* GATES = WSP(bf16, WS_GATES);
        if (EN(1) && IN(pb + 0)) { if (l == 0) rows_phase<0>(F, args, l); else rows_phase<1>(F, args, l); SEAM(pb + 0); }
        if (EN(2) && IN(pb + 1)) {
            pg8::Gemm g{U, U, U, WSP(bf16, WS_WP2) + (size_t)l * NP2 * 1024, nullptr, nullptr, 1024, 1024, 1024};
            pg8::StaticOrder S; S.init(NTOK, NP2, F.G, fresh_bid());
            EpiP2 E{PROJ, WSP(bf16, WS_VT), GATES, INP(8) + l * 3072};
            for (int rep = 0; rep < 1 + REP_G; ++rep) pg8::gemm_phase<EpiP2, pg8::StaticOrder, true>(F.lds + RING_OFF, g, S, E, fresh(F).tid);
            SEAM(pb + 1);
        }
        if (EN(3) && IN(pb + 2)) {
            for (int rep = 0; rep < REP_M; ++rep) { if (REP_MS & 1) attn2_phase(F, args, l, WSP(bf16, WS_SCR), 512); if (REP_MS & 2) lru_conv_phase(F, args, l); if (REP_MS & 4) fft_a_phase(F, args); }
            lru_conv_phase(F, args, l); attn2_phase(F, args, l, PROJ, PROJ_LD); fft_a_phase(F, args); SEAM(pb + 2); }
        if (EN(4) && IN(pb + 3)) { for (int rep = 0; rep < REP_M; ++rep) { if (REP_MS & 2) lru2_phase(F, args, l, WSP(bf16, WS_SCR), 512, 0); if (REP_MS & 4) fft_b_phase(F, args); }
            lru2_phase(F, args, l, PROJ, PROJ_LD, YR_OFF); fft_b_phase(F, args); SEAM(pb + 3); }
        if (EN(6) && IN(pb + 4)) {
            const bf16* WP = WSP(bf16, WS_WPROJ) + (size_t)l * 3 * 1024 * 512;
            pg8::Gemm g{PROJ + Q_OFF, PROJ + YR_OFF, PROJ + G_OFF, WP, WP + 1024 * 512, WP + 2 * 1024 * 512, PROJ_LD, 512, 512};
            pg8::MergeOrder S; S.init(NTOK, 1024, F.G, fresh_bid());
            EpiMerge E{GATES, U};
            for (int rep = 0; rep < 1 + REP_G; ++rep) pg8::gemm_phase<EpiMerge, pg8::MergeOrder, true>(F.lds + RING_OFF, g, S, E, fresh(F).tid);
            SEAM(pb + 4);
        }
        if (EN(7) && IN(pb + 5)) {
            pg8::Gemm g{U, U, U, WSP(bf16, WS_WOUT) + (size_t)l * 1024 * 1024, nullptr, nullptr, 1024, 1024, 1024};
            pg8::StaticOrder S; S.init(NTOK, 1024, F.G, fresh_bid());
            EpiResid E{l == 0 ? INP(0) : (const float*)args.out, args.out, WSP(float, WS_MOD) + (size_t)l * 4 * 6144 + 2 * 1024};
            for (int rep = 0; rep < REP_G; ++rep) { EpiResid E2{E.xin, WSP(float, WS_GATES), E.gt}; pg8::gemm_phase<EpiResid, pg8::StaticOrder, true>(F.lds + RING_OFF, g, S, E2, fresh(F).tid); }
            pg8::gemm_phase<EpiResid, pg8::StaticOrder, true>(F.lds + RING_OFF, g, S, E, fresh(F).tid);
            SEAM(pb + 5);
        }
        if (EN(8) && IN(pb + 6)) { router_phase(F, args, l); SEAM(pb + 6); }
        if (EN(9) && IN(pb + 7)) { gather_phase(F, args, l); SEAM(pb + 7); }
        if (EN(10) && IN(pb + 8)) {
            moe_tilebase(F, args, l);
            pg8::Gemm g{PROJ, PROJ, PROJ, WSP(bf16, WS_WG1), nullptr, nullptr, 1024, 1024, 1024};
            pg8::MoeOrder S{(const LAS int*)(F.lds + MISC_OFF + 64), F.G, fresh_bid()};
            EpiSwiGLU E{WSP(bf16, WS_H)};
            for (int rep = 0; rep < 1 + REP_G; ++rep) pg8::gemm_phase<EpiSwiGLU, pg8::MoeOrder, true>(F.lds + RING_OFF, g, S, E, fresh(F).tid);
            SEAM(pb + 8);
        }
        if (EN(11) && IN(pb + 9)) {
            moe_tilebase(F, args, l);
            const bf16* H = WSP(bf16, WS_H);
            pg8::Gemm g{H, H, H, WSP(bf16, WS_WD), nullptr, nullptr, 512, 512, 512};
            pg8::MoeOrder S{(const LAS int*)(F.lds + MISC_OFF + 64), F.G, fresh_bid()};
            EpiYE E{PROJ};
            for (int rep = 0; rep < 1 + REP_G; ++rep) pg8::gemm_phase<EpiYE, pg8::MoeOrder, true>(F.lds + RING_OFF, g, S, E, fresh(F).tid);
            SEAM(pb + 9);
        }
    }
    if (EN(12) && IN(N_PHASES - 1)) rows_phase<2>(F, args, DEPTH);
#undef IN
#undef SEAM
}

#ifndef MK_MODE
#define MK_MODE 0
#endif
extern "C" void kernel_launch(void* const* d_in, const int* in_sizes, int n_in, void* d_out, int out_size, void* d_ws, size_t ws_size, hipStream_t stream) {
    static int grid = 0;
    if (grid == 0) {
        if (n_in != 27 || in_sizes[0] != NTOK * D || out_size != NTOK * D || ws_size < WS_END) { fprintf(stderr, "kernel_launch: unexpected shapes (n_in %d, in0 %d, out %d, ws %zu < %zu)\n", n_in, n_in > 0 ? in_sizes[0] : -1, out_size, ws_size, (size_t)WS_END); grid = -1; return; }
        int dev = 0, cus = 0;
        if (hipGetDevice(&dev) != hipSuccess || hipDeviceGetAttribute(&cus, hipDeviceAttributeMultiprocessorCount, dev) != hipSuccess) { grid = -1; return; }
        if (hipFuncSetAttribute((const void*)mega_fwd, hipFuncAttributeMaxDynamicSharedMemorySize, LDS_BYTES) != hipSuccess) { fprintf(stderr, "kernel_launch: hipFuncSetAttribute failed\n"); grid = -1; return; }
        (void)hipGetLastError();
        grid = cus;
    }
    if (grid < 0) return;
    if (hipMemsetAsync((char*)d_ws + WS_CTL, 0, CTL_ZERO_BYTES, stream) != hipSuccess) return;
    Args a{};
    for (int i = 0; i < 27; ++i) a.in[i] = (const float*)d_in[i];
    a.out = (float*)d_out; a.ws = (unsigned char*)d_ws;
#if MK_MODE == 0
    a.ph_lo = 0; a.ph_hi = N_PHASES;
    hipLaunchKernelGGL(mega_fwd, dim3(grid), dim3(NWAVES * 64), LDS_BYTES, stream, a, 0);
#else
    for (int p = 0; p < N_PHASES; ++p) { a.ph_lo = p; a.ph_hi = p + 1; hipLaunchKernelGGL(mega_fwd, dim3(grid), dim3(NWAVES * 64), LDS_BYTES, stream, a, 0); }
#endif
}
```

```cpp
#include <hip/hip_runtime.h>
#include <cstdio>
#include <cstdint>
namespace pg8 {
#define PG8_LAS __attribute__((address_space(3)))
typedef unsigned short bf16_t;
typedef short bf16x8 __attribute__((ext_vector_type(8)));
typedef float f32x4 __attribute__((ext_vector_type(4)));
typedef unsigned u32x4 __attribute__((ext_vector_type(4)));
typedef unsigned u32x2 __attribute__((ext_vector_type(2)));
constexpr int BM = 256, BK = 64, HALF = 128, HTB = HALF * BK * 2  , STAGE_BYTES = 8 * HTB, NXCD = 8, WGM = 8;

__host__ __device__ __forceinline__ int lds_byte(int r, int c) { const int st = (r >> 4) * 2 + (c >> 5), rr = r & 15, cc = c & 31, ob = rr * 64 + cc * 2; return st * 1024 + (ob ^ (((ob >> 9) & 1) << 5)); }
__host__ __device__ __forceinline__ void stage_rc(int b, int& R, int& C) { const int st = b / 1024, sb = b % 1024, swz = sb ^ (((sb >> 9) & 1) << 5); R = (st >> 1) * 16 + swz / 64; C = (st & 1) * 32 + (swz % 64) / 2; }
__host__ __device__ __forceinline__ int perm32(int rho) { const int n = rho >> 4, i = rho & 15; return 8 * (i >> 2) + 4 * n + (i & 3); }

struct Unit { int pm, pn, bt, z; };
struct Gemm { const bf16_t* A0; const bf16_t* A1; const bf16_t* A2; const bf16_t* B0; const bf16_t* B1; const bf16_t* B2; int lda, ldb, K; };

__device__ __forceinline__ unsigned cvt_pk_bf16(float lo, float hi) { unsigned r; asm volatile("v_cvt_pk_bf16_f32 %0, %1, %2" : "=v"(r) : "v"(lo), "v"(hi)); return r; }

struct StaticOrder {
    int nM, nN, nwg, G, c;
    __device__ void init(int M, int N, int G_, int c_) { nM = M / BM; nN = N / BM; nwg = nM * nN; G = G_; c = c_; }
    __device__ __forceinline__ bool tile(long L, Unit& u) const {
        if (L >= nwg) return false;
        int wgid = (int)L; { const int q = nwg / NXCD, r = nwg % NXCD, xcd = wgid % NXCD, off = wgid / NXCD; wgid = (xcd < r ? xcd * (q + 1) : r * (q + 1) + (xcd - r) * q) + off; }
        const int nig = WGM * nN, gid = wgid / nig, fm = gid * WGM, gsz = (nM - fm) < WGM ? (nM - fm) : WGM;
        u.pm = fm + ((wgid % nig) % gsz); u.pn = (wgid % nig) / gsz; u.bt = u.pn; u.z = 0; return true;
    }
    __device__ __forceinline__ bool next(int i, Unit& u) const { return tile((long)i * G + c, u); }
};
struct MergeOrder : StaticOrder {
    __device__ __forceinline__ bool next(int i, Unit& u) const { const int t = i / 3; if (!tile((long)t * G + c, u)) return false; u.z = i - 3 * t; return true; }
};
struct MoeOrder {
    const PG8_LAS int* tb; int G, c;
    __device__ __forceinline__ bool next(int i, Unit& u) const {
        const int L = i * G + c; const int nt = tb[32]; if (L >= nt * 4) return false;
        const int t = L >> 2, j = L & 3; int e = 0;
#pragma unroll 1
        for (int k = 1; k < 32; ++k) e += (tb[k] <= t) ? 1 : 0;
        u.pm = t; u.pn = j; u.bt = e * 4 + j; u.z = 0; return true;
    }
};

template <class Epi, class Sched, bool ALIGN_EPI>
__device__ __forceinline__ void gemm_phase(PG8_LAS unsigned char* lds, const Gemm g, const Sched& S, const Epi& E, const int tid) {
    const int wid = __builtin_amdgcn_readfirstlane(tid >> 6), lane = tid & 63, wr = wid >> 2, wc = wid & 3, fr = lane & 15, fq = lane >> 4;
    const int K = g.K, nt = K / BK;
    unsigned voffA[2], voffB[2];
#pragma unroll
    for (int i = 0; i < 2; ++i) { int R, C; stage_rc(tid * 16 + i * 8192, R, C); const int Rb = Epi::PERM ? ((R & ~31) + perm32(R & 31)) : R;
        voffA[i] = (unsigned)(R * g.lda + C) * 2u; voffB[i] = (unsigned)(Rb * g.ldb + C) * 2u; }
    const size_t kstep = (size_t)(BK * 2);
    const size_t hstepA = (size_t)HALF * g.lda * 2, hstepB = (size_t)HALF * g.ldb * 2;
    const size_t tstepA = 2 * hstepA, tstepB = 2 * hstepB;
    const unsigned ldsw = (unsigned)wid * 1024u;
    const int aoff = lds_byte(wr * 64 + fr, fq * 8), boff = lds_byte(wc * 32 + fr, fq * 8);
#define PG8_SA(b, h) (((b) * 2 + (h)) * HTB)
#define PG8_SB(b, h) ((4 + (b) * 2 + (h)) * HTB)
#define PG8_STAGE(bufoff, gbase, voff) do { _Pragma("unroll") for (int _i = 0; _i < 2; ++_i) \
        __builtin_amdgcn_global_load_lds((const unsigned*)((const char*)(gbase) + (voff)[_i]), (PG8_LAS unsigned*)(lds + (bufoff) + ldsw + _i * 8192), 16, 0, 0); } while (0)
#define PG8_LDA(dst, b, h) do { _Pragma("unroll") for (int m = 0; m < 4; ++m) _Pragma("unroll") for (int k = 0; k < 2; ++k) dst[m][k] = *(const PG8_LAS bf16x8*)(lds + PG8_SA(b, h) + aoff + m * 2048 + k * 1024); } while (0)
#define PG8_LDB(dst, b, h) do { _Pragma("unroll") for (int n = 0; n < 2; ++n) _Pragma("unroll") for (int k = 0; k < 2; ++k) dst[n][k] = *(const PG8_LAS bf16x8*)(lds + PG8_SB(b, h) + boff + n * 2048 + k * 1024); } while (0)
#define PG8_MMA(ai, bj, At, Bt) do { __builtin_amdgcn_s_setprio(1); _Pragma("unroll") for (int m = 0; m < 4; ++m) _Pragma("unroll") for (int n = 0; n < 2; ++n) _Pragma("unroll") for (int k = 0; k < 2; ++k) \
        acc[ai][bj][m][n] = __builtin_amdgcn_mfma_f32_16x16x32_bf16(Bt[n][k], At[m][k], acc[ai][bj][m][n], 0, 0, 0); __builtin_amdgcn_s_setprio(0); } while (0)
#define PG8_WAIT_V(n) asm volatile("s_waitcnt vmcnt(" #n ")" ::: "memory")
#define PG8_WAIT_L(n) asm volatile("s_waitcnt lgkmcnt(" #n ")" ::: "memory")
#define PG8_BAR __builtin_amdgcn_s_barrier()
#define PG8_SCHED __builtin_amdgcn_sched_barrier(0)
#define PG8_APTR(u) ((const char*)((u).z == 0 ? g.A0 : ((u).z == 1 ? g.A1 : g.A2)) + (size_t)(u).pm * tstepA)
#define PG8_BPTR(u) ((const char*)((u).z == 0 ? g.B0 : ((u).z == 1 ? g.B1 : g.B2)) + (size_t)(u).bt * tstepB)
    Unit cur, nxt; int ui = 0;
    if (!S.next(0, cur)) return;
    f32x4 acc[2][2][4][2];
#pragma unroll
    for (int a = 0; a < 2; ++a)
#pragma unroll
        for (int b = 0; b < 2; ++b)
#pragma unroll
            for (int m = 0; m < 4; ++m)
#pragma unroll
                for (int n = 0; n < 2; ++n) acc[a][b][m][n] = (f32x4){0.f, 0.f, 0.f, 0.f};
    bf16x8 At[4][2], B0[2][2], B1[2][2];
    const char* cA = PG8_APTR(cur); const char* cB = PG8_BPTR(cur);
    PG8_STAGE(PG8_SB(0, 0), cB, voffB); PG8_STAGE(PG8_SB(0, 1), cB + hstepB, voffB); PG8_STAGE(PG8_SA(0, 0), cA, voffA); PG8_STAGE(PG8_SA(0, 1), cA + hstepA, voffA);
    if (wr == 1) PG8_BAR;
    PG8_WAIT_V(2); PG8_BAR;
    PG8_STAGE(PG8_SB(1, 0), cB + kstep, voffB); PG8_STAGE(PG8_SA(1, 0), cA + kstep, voffA); PG8_STAGE(PG8_SB(1, 1), cB + hstepB + kstep, voffB);
    PG8_WAIT_V(6); PG8_BAR;
    for (;;) {
        const bool has_next = S.next(ui + 1, nxt);
        const char* nA = has_next ? PG8_APTR(nxt) : cA; const char* nB = has_next ? PG8_BPTR(nxt) : cB;
        for (int t = 0; t < nt; t += 2) {
            const bool last = (t == nt - 2);
            const char* a1 = cA + (size_t)(t + 1) * kstep;
            const char* a2 = last ? nA : cA + (size_t)(t + 2) * kstep; const char* b2 = last ? nB : cB + (size_t)(t + 2) * kstep;
            const char* a3 = a2 + kstep; const char* b3 = b2 + kstep;
            PG8_LDB(B0, 0, 0); PG8_LDB(B1, 0, 1); PG8_SCHED; PG8_LDA(At, 0, 0); PG8_STAGE(PG8_SA(1, 1), a1 + hstepA, voffA);
            PG8_WAIT_V(8); PG8_WAIT_L(0); PG8_BAR; PG8_MMA(0, 0, At, B0); PG8_MMA(0, 1, At, B1); PG8_BAR; PG8_SCHED;
            PG8_LDA(At, 0, 1); PG8_STAGE(PG8_SB(0, 0), b2, voffB); PG8_STAGE(PG8_SB(0, 1), b2 + hstepB, voffB); PG8_STAGE(PG8_SA(0, 0), a2, voffA);
            PG8_WAIT_V(8); PG8_WAIT_L(0); PG8_BAR; PG8_MMA(1, 0, At, B0); PG8_MMA(1, 1, At, B1); PG8_BAR; PG8_SCHED;
            PG8_LDB(B0, 1, 0); PG8_LDB(B1, 1, 1); PG8_SCHED; PG8_LDA(At, 1, 0); PG8_STAGE(PG8_SA(0, 1), a2 + hstepA, voffA);
            PG8_WAIT_V(8); PG8_WAIT_L(0); PG8_BAR; PG8_MMA(0, 0, At, B0); PG8_MMA(0, 1, At, B1); PG8_BAR; PG8_SCHED;
            PG8_LDA(At, 1, 1); PG8_STAGE(PG8_SB(1, 0), b3, voffB); PG8_STAGE(PG8_SB(1, 1), b3 + hstepB, voffB); PG8_STAGE(PG8_SA(1, 0), a3, voffA);
            PG8_WAIT_V(8); PG8_WAIT_L(0); PG8_BAR; PG8_MMA(1, 0, At, B0); PG8_MMA(1, 1, At, B1); PG8_BAR; PG8_SCHED;
        }
        if constexpr (ALIGN_EPI) { if (wr == 0) PG8_BAR; }
        E(acc, cur, wr, wc, fr, fq);
        if (!has_next) break;
#pragma unroll
        for (int a = 0; a < 2; ++a)
#pragma unroll
            for (int b = 0; b < 2; ++b)
#pragma unroll
                for (int m = 0; m < 4; ++m)
#pragma unroll
                    for (int n = 0; n < 2; ++n) acc[a][b][m][n] = (f32x4){0.f, 0.f, 0.f, 0.f};
        cur = nxt; cA = nA; cB = nB; ++ui;
        if constexpr (ALIGN_EPI) { if (wr == 1) PG8_BAR; }
    }
    PG8_WAIT_V(0);
    if constexpr (!ALIGN_EPI) { if (wr == 0) PG8_BAR; }
    PG8_BAR;
#undef PG8_SA
#undef PG8_SB
#undef PG8_STAGE
#undef PG8_LDA
#undef PG8_LDB
#undef PG8_MMA
#undef PG8_WAIT_V
#undef PG8_WAIT_L
#undef PG8_BAR
#undef PG8_SCHED
#undef PG8_APTR
#undef PG8_BPTR
}
}
constexpr int NWAVES = 8;
constexpr int NB = 4, T = 8192, D = 1024, NTOK = NB * T, DEPTH = 2;
constexpr int PROJ_LD = 3072, Q_OFF = 0, K_OFF = 512, XR_OFF = 1024, YR_OFF = 1536, G_OFF = 2048;
constexpr int GATES_LD = 3072;
constexpr int NP2 = 6656;
constexpr int NEXP = 32, XS_ROWS = 73728;
constexpr int LRU_CH = 32, LRU_NCH = T / LRU_CH;
constexpr float EPS = 1e-6f;

constexpr size_t MiB = 1u << 20;
constexpr size_t WS_CTL = 0, CTL_ZERO_BYTES = 1 * MiB;
constexpr size_t WS_MOD = 1 * MiB;
constexpr size_t WS_FA = WS_MOD + 256 * 1024;
constexpr size_t WS_FB = WS_FA + 32 * 1024;
constexpr size_t WS_TW = WS_FB + 64 * 1024;
constexpr size_t WS_WL = 2 * MiB;
constexpr size_t WS_TOKW = 3 * MiB;
constexpr size_t WS_TOKROW = WS_TOKW + 256 * 1024;
constexpr size_t WS_PERM = 4 * MiB;
constexpr size_t WS_LSUM = 8 * MiB;
constexpr size_t WS_LCAR = 16 * MiB;
constexpr size_t WS_WP2 = 20 * MiB;
constexpr size_t WS_WPROJ = 46 * MiB;
constexpr size_t WS_WOUT = 52 * MiB;
constexpr size_t WS_U = 56 * MiB;
constexpr size_t WS_VT = 120 * MiB;
constexpr size_t WS_PROJ = 152 * MiB;
constexpr size_t WS_GATES = 344 * MiB;
constexpr size_t WS_WG1 = WS_GATES, WS_WD = WS_GATES + 64 * MiB, WS_H = WS_GATES + 96 * MiB;
constexpr size_t WS_XC = 536 * MiB;
constexpr size_t WS_END = 568 * MiB;
constexpr size_t WS_SCR = 568 * MiB;
#ifndef REP_G
#define REP_G 0
#endif
#ifndef REP_C
#define REP_C 0
#endif
#ifndef REP_R
#define REP_R 0
#endif
#ifndef REP_GS
#define REP_GS 31
#endif
#ifndef REP_MS
#define REP_MS 15
#endif
#ifndef REP_M
#define REP_M 0
#endif
static_assert(WS_H + (size_t)XS_ROWS * 512 * 2 <= WS_END, "ws map");
constexpr int CW_BAR = 4096;
constexpr int CW_ECNT = 16384;

constexpr int LDS_BYTES = 163840;
constexpr int RING_OFF = 0, RING_BYTES = 131072;
constexpr int XTRA_OFF = RING_BYTES;
constexpr int LDSCTL_OFF = LDS_BYTES - 512, MISC_OFF = LDSCTL_OFF + 64;

#define GAS __attribute__((address_space(1)))
#define LAS __attribute__((address_space(3)))
typedef unsigned short bf16;
typedef unsigned v4u __attribute__((ext_vector_type(4)));
typedef unsigned v2u __attribute__((ext_vector_type(2)));
typedef float f32x4 __attribute__((ext_vector_type(4)));
typedef float f32x2 __attribute__((ext_vector_type(2)));
typedef float f32x16 __attribute__((ext_vector_type(16)));
typedef short bf16x8 __attribute__((ext_vector_type(8)));
typedef short bf16x4 __attribute__((ext_vector_type(4)));
typedef GAS unsigned gu32;
#define RLX_AGENT __ATOMIC_RELAXED, __HIP_MEMORY_SCOPE_AGENT
#define LDS_WAIT() asm volatile("s_waitcnt lgkmcnt(0)" ::: "memory")
#define VM_WAIT() asm volatile("s_waitcnt vmcnt(0)" ::: "memory")
typedef __bf16 hwbf16x2 __attribute__((ext_vector_type(2)));
__device__ __forceinline__ unsigned pk2(float lo, float hi) { f32x2 v = {lo, hi}; hwbf16x2 b = __builtin_convertvector(v, hwbf16x2); return __builtin_bit_cast(unsigned, b); }
__device__ __forceinline__ unsigned f2bf(float f) { return pk2(f, 0.f) & 0xffffu; }
__device__ __forceinline__ float bflo(unsigned w) { return __builtin_bit_cast(float, w << 16); }
__device__ __forceinline__ float bfhi(unsigned w) { return __builtin_bit_cast(float, w & 0xffff0000u); }
__device__ __forceinline__ float bf2f(unsigned short h) { return __builtin_bit_cast(float, (unsigned)h << 16); }
__device__ __forceinline__ float sigmoidf(float v) { return 1.0f / (1.0f + __expf(-v)); }
__device__ __forceinline__ float fsigmoid(float v) { return __builtin_amdgcn_rcpf(1.0f + __expf(-v)); }
__device__ __forceinline__ float wave_sum(float v) {
#pragma unroll
    for (int o = 1; o < 64; o <<= 1) v += __shfl_xor(v, o);
    return v;
}
#define XB_TMO      128
#define XB_XCNT(j)  (256  + 64 * (j))
#define XB_XSUB(j)  (1280 + 64 * (j))
#define XB_XGEN(j)  (2304 + 64 * (j))
#define XB_TOP      3328
#define XB_TOPGEN   3392
#define XCD_BAR_WORDS 3456
#define XB_SPIN_CAP (1u << 18)

__device__ __forceinline__ unsigned xb_ld(unsigned* p)              { return __hip_atomic_load(p, __ATOMIC_RELAXED, __HIP_MEMORY_SCOPE_AGENT); }
__device__ __forceinline__ unsigned xb_add(unsigned* p, unsigned v) { return __hip_atomic_fetch_add(p, v, __ATOMIC_RELAXED, __HIP_MEMORY_SCOPE_AGENT); }
__device__ __forceinline__ unsigned xb_xcc_id() { return (unsigned)__builtin_amdgcn_s_getreg((3 << 11) | 20) & 0xFu; }
#define XB_SPIN(cond, bar) do { unsigned _sp = 0; while (cond) { __builtin_amdgcn_s_sleep(1); \
    if ((++_sp & 255u) == 0u) { if (xb_ld(&(bar)[XB_TMO])) break; if (_sp > XB_SPIN_CAP) { atomicAdd(&(bar)[XB_TMO], 1u); break; } } } } while (0)

struct XcdBarrier {
    unsigned* bar; unsigned x;
    volatile LAS unsigned* st;
};

__device__ __forceinline__ XcdBarrier xcd_barrier_post(unsigned* bar, volatile LAS unsigned* st) {
    XcdBarrier b; b.bar = bar; b.x = xb_xcc_id(); b.st = st;
    if (threadIdx.x == 0) (void)xb_add(&bar[XB_XCNT(b.x)], 1u);
    return b;
}
__device__ __forceinline__ void xcd_barrier_complete(unsigned* bar, unsigned x, unsigned& nloc, unsigned& nx) {
    const unsigned G = gridDim.x * gridDim.y * gridDim.z;
    unsigned sum, cnt, mine, sp = 0u;
    for (;;) {
        sum = 0u; cnt = 0u; mine = 0u;
#pragma unroll
        for (unsigned j = 0; j < 16; ++j) { const unsigned c = xb_ld(&bar[XB_XCNT(j)]); sum += c; cnt += (c > 0u) ? 1u : 0u; mine = (j == x) ? c : mine; }
        if (sum == G) break;
        __builtin_amdgcn_s_sleep(1);
        if ((++sp & 255u) == 0u) { if (xb_ld(&bar[XB_TMO])) break; if (sp > XB_SPIN_CAP) { atomicAdd(&bar[XB_TMO], 1u); break; } }
    }
    nloc = mine > 0u ? mine : 1u; nx = cnt > 0u ? cnt : 1u;
}

__device__ __forceinline__ void xcd_barrier(const XcdBarrier& b) {
    asm volatile("s_waitcnt vmcnt(0)" ::: "memory");
    __syncthreads();
    if (threadIdx.x == 0) {
        unsigned* bar = b.bar;
        __builtin_amdgcn_s_waitcnt(0);
        unsigned nloc = b.st[0], nx = b.st[1];
        if (nloc == 0u) { xcd_barrier_complete(bar, b.x, nloc, nx); b.st[0] = nloc; b.st[1] = nx; }
        const unsigned old = xb_add(&bar[XB_XSUB(b.x)], 1u);
        const unsigned gen = old / nloc;
        if (old + 1u == (gen + 1u) * nloc) {
            __builtin_amdgcn_fence(__ATOMIC_RELEASE, "agent");
            asm volatile("s_waitcnt vmcnt(0)" ::: "memory");
            const unsigned og = xb_add(&bar[XB_TOP], 1u);
            const unsigned tg = og / nx;
            if (og + 1u == (tg + 1u) * nx) xb_add(&bar[XB_TOPGEN], 1u);
            else XB_SPIN(xb_ld(&bar[XB_TOPGEN]) == tg, bar);
            __builtin_amdgcn_fence(__ATOMIC_ACQUIRE, "agent");
            xb_add(&bar[XB_XGEN(b.x)], 1u);
            asm volatile("s_waitcnt vmcnt(0)" ::: "memory");
        } else {
            XB_SPIN(xb_ld(&bar[XB_XGEN(b.x)]) == gen, bar);
            __builtin_amdgcn_fence(__ATOMIC_ACQUIRE, "agent");
            asm volatile("s_waitcnt vmcnt(0)" ::: "memory");
        }
    }
    __syncthreads();
}

struct Args { const float* in[27]; float* out; unsigned char* ws; int ph_lo, ph_hi; };
struct Frame {
    LAS unsigned char* lds;
    volatile LAS unsigned* MISC;
    gu32* ctl;
    int tid, lane, wave, vcu, G;
};
__device__ __forceinline__ Frame fresh(const Frame& F) {
    Frame N = F; int t = F.tid; asm volatile("" : "+v"(t)); N.tid = t; N.lane = t & 63; N.wave = __builtin_amdgcn_readfirstlane(t >> 6);
    int v = F.vcu; asm volatile("" : "+s"(v)); N.vcu = v; int g = F.G; asm volatile("" : "+s"(g)); N.G = g; return N;
}
#define WSP(T_, off) ((T_*)(args.ws + (off)))
#define INP(i) (args.in[i])

struct TrItem { const float* W; int ldw, k0, n0; bf16* dst; int ldd; };
__device__ __forceinline__ void tr_load(const TrItem& it, f32x4 (&v)[8], int lane) {
    const float* p = it.W + (size_t)(it.k0 + (lane >> 3)) * it.ldw + it.n0 + 4 * (lane & 7);
#pragma unroll
    for (int i = 0; i < 8; ++i) v[i] = *(const f32x4*)(p + (size_t)(8 * i) * it.ldw);
}
__device__ __forceinline__ void tr_finish(const TrItem& it, const f32x4 (&v)[8], LAS float* scr, int lane) {
#pragma unroll
    for (int i = 0; i < 8; ++i) { LAS float* d = scr + (8 * i + (lane >> 3)) * 33 + 4 * (lane & 7); d[0] = v[i].x; d[1] = v[i].y; d[2] = v[i].z; d[3] = v[i].w; }
    LDS_WAIT(); asm volatile("" ::: "memory");
    const int c = lane & 7;
#pragma unroll
    for (int j = 0; j < 4; ++j) { const int n = (lane >> 3) + 8 * j; const LAS float* s = scr + (8 * c) * 33 + n;
        v4u o; o.x = pk2(s[0 * 33], s[1 * 33]); o.y = pk2(s[2 * 33], s[3 * 33]); o.z = pk2(s[4 * 33], s[5 * 33]); o.w = pk2(s[6 * 33], s[7 * 33]);
        *(v4u*)(it.dst + (size_t)n * it.ldd + it.k0 + 8 * c) = o; }
    LDS_WAIT(); asm volatile("" ::: "memory");
}
__device__ __forceinline__ void transpose_item(const float* W, int ldw, int k0, int n0, bf16* dst, int ldd, LAS float* scr, int lane) {
    const TrItem it{W, ldw, k0, n0, dst, ldd}; f32x4 v[8]; tr_load(it, v, lane); tr_finish(it, v, scr, lane);
}
__device__ __forceinline__ void p0_prologue(const Frame& F0, const Args& args) {
    const Frame F = fresh(F0);
    const int tid = F.tid, lane = F.lane, wave = F.wave;
    float* MOD = WSP(float, WS_MOD);
    {
        LAS f32x4* cact4 = (LAS f32x4*)(F.lds + RING_OFF);
        LAS float* red = (LAS float*)(F.lds + RING_OFF + 16384);
        if (F.vcu < 192) {
            const float* c = INP(1);
            for (int i = 0; i < 8; ++i) { const int idx = tid + 512 * i, b = idx >> 10, k = idx & 1023; const float v = c[b * 1024 + k]; ((LAS float*)cact4)[k * 4 + b] = v * sigmoidf(v); }
        }
        __syncthreads();
        for (int u = F.vcu; u < 192; u += F.G) {
            const int l = u / 96, j0 = (u % 96) * 64;
            const float* aw = INP(2) + (size_t)l * 1024 * 6144 + j0 + lane;
            float a0 = 0.f, a1 = 0.f, a2 = 0.f, a3 = 0.f;
#pragma unroll 8
            for (int kk = 0; kk < 128; ++kk) { const int k = 128 * wave + kk; const float wv = aw[(size_t)k * 6144]; const f32x4 c4 = cact4[k]; a0 += c4.x * wv; a1 += c4.y * wv; a2 += c4.z * wv; a3 += c4.w * wv; }
            red[(wave * 4 + 0) * 64 + lane] = a0; red[(wave * 4 + 1) * 64 + lane] = a1; red[(wave * 4 + 2) * 64 + lane] = a2; red[(wave * 4 + 3) * 64 + lane] = a3;
            __syncthreads();
            if (tid < 256) { const int b = tid >> 6, ln = tid & 63; float s = INP(3)[l * 6144 + j0 + ln];
#pragma unroll
                for (int w = 0; w < 8; ++w) s += red[(w * 4 + b) * 64 + ln];
                MOD[(size_t)(l * 4 + b) * 6144 + j0 + ln] = s; }
            __syncthreads();
        }
    }
    {
        LAS float* Tt = (LAS float*)(F.lds + RING_OFF);
        LAS float* cs = (LAS float*)(F.lds + RING_OFF + 33792);
        LAS float* sn = cs + 128;
        if (tid < 128) { cs[tid] = cospif((float)tid * (1.0f / 64.0f)); sn[tid] = sinpif((float)tid * (1.0f / 64.0f)); }
        for (int it = F.vcu; it < 128; it += F.G) {
            const int l = it >> 6, g = (it >> 4) & 3, k0 = (it & 15) * 64;
            const float* src = INP(6) + (size_t)l * 1024 * 3072 + 2560 + g * 128;
            __syncthreads();
            for (int i = 0; i < 16; ++i) { const int idx = tid + 512 * i, row = idx >> 7, cc = idx & 127; Tt[row * 129 + cc] = src[(size_t)(k0 + row) * 3072 + cc]; }
            __syncthreads();
            const int kk = tid & 63, og = wave, part = og >> 2, m0 = (og & 3) * 32;
            float acc[32];
#pragma unroll
            for (int i = 0; i < 32; ++i) acc[i] = 0.f;
            const LAS float* tab = part ? sn : cs;
#pragma unroll 2
            for (int cc = 0; cc < 128; ++cc) { const float t = Tt[kk * 129 + cc];
#pragma unroll
                for (int i = 0; i < 32; ++i) acc[i] += t * tab[((m0 + i) * cc) & 127]; }
            bf16* dst = WSP(bf16, WS_WP2) + (size_t)l * NP2 * 1024 + (size_t)(2560 + part * 512 + g * 128 + m0) * 1024 + k0 + kk;
            const float sg = part ? -1.f : 1.f;
#pragma unroll
            for (int i = 0; i < 32; ++i) dst[(size_t)i * 1024] = (bf16)f2bf(sg * acc[i]);
        }
        __syncthreads();
    }
    {
        LAS float* scr = (LAS float*)(F.lds + RING_OFF + wave * 8704);
        const int gw = F.vcu * NWAVES + wave, NGW = F.G * NWAVES;
        for (int it = gw; it < 8192; it += NGW) {
            const int l = it >> 12; int r = it & 4095;
            if (r < 1280) { const int kb = r / 80, nb = r % 80; transpose_item(INP(6) + (size_t)l * 1024 * 3072, 3072, kb * 64, nb * 32, WSP(bf16, WS_WP2) + (size_t)l * NP2 * 1024 + (size_t)(nb * 32) * 1024, 1024, scr, lane); continue; }
            r -= 1280;
            if (r < 1536) { const int kb = r / 96, nb = r % 96; transpose_item(INP(7) + (size_t)l * 1024 * 3072, 3072, kb * 64, nb * 32, WSP(bf16, WS_WP2) + (size_t)l * NP2 * 1024 + (size_t)(3584 + nb * 32) * 1024, 1024, scr, lane); continue; }
            r -= 1536;
            if (r < 768) { const int which = r >> 8, rr = r & 255, kb = rr >> 5, nb = rr & 31; const float* src = (which == 0 ? INP(17) : (which == 1 ? INP(18) : INP(19))) + (size_t)l * 512 * 1024;
                transpose_item(src, 1024, kb * 64, nb * 32, WSP(bf16, WS_WPROJ) + (size_t)(l * 3 + which) * 1024 * 512 + (size_t)(nb * 32) * 512, 512, scr, lane); continue; }
            r -= 768;
            { const int kb = r >> 5, nb = r & 31; transpose_item(INP(20) + (size_t)l * 1024 * 1024, 1024, kb * 64, nb * 32, WSP(bf16, WS_WOUT) + (size_t)l * 1024 * 1024 + (size_t)(nb * 32) * 1024, 1024, scr, lane); }
        }
    }
    {
        const int gt = F.vcu * 512 + tid, NGT = F.G * 512;
        bf16* WL = WSP(bf16, WS_WL);
        for (int idx = gt; idx < 262144; idx += NGT) {
            const int k = idx & 63, n = (idx >> 6) & 255, nb = (idx >> 14) & 7, l = idx >> 17, gate = n >> 6, j = n & 63, dir = gate >> 1, isI = gate & 1;
            const float* src = isI ? INP(14) : INP(12);
            WL[idx] = (bf16)f2bf(src[((size_t)((l * 2 + dir) * 8 + nb) * 64 + k) * 64 + j]);
        }
        bf16* FA = WSP(bf16, WS_FA);
        for (int idx = gt; idx < 16384; idx += NGT) {
            const int m = idx >> 7, k = idx & 127, k1 = m & 63, pm_ = m >> 6, t1 = k & 63, pk = k >> 6, a = (k1 * t1) & 63;
            const float c = cospif((float)a * (1.0f / 32.0f)), s = sinpif((float)a * (1.0f / 32.0f));
            FA[idx] = (bf16)f2bf(pm_ == 0 ? (pk == 0 ? c : s) : (pk == 0 ? -s : c));
        }
        bf16* FB = WSP(bf16, WS_FB);
        for (int idx = gt; idx < 32768; idx += NGT) {
            const int k2 = idx >> 8, k = idx & 255, part = k >> 7, t2 = k & 127, a = (k2 * t2) & 127;
            FB[idx] = (bf16)f2bf(part == 0 ? cospif((float)a * (1.0f / 64.0f)) : sinpif((float)a * (1.0f / 64.0f)));
        }
        f32x2* TW = WSP(f32x2, WS_TW);
        for (int idx = gt; idx < 8192; idx += NGT) {
            const int t2 = idx >> 6, k1 = idx & 63; const float x = (float)(t2 * k1) * (1.0f / 4096.0f);
            TW[idx] = (f32x2){cospif(x), sinpif(x)};
        }
    }
}

template <int MODE>
__device__ __forceinline__ void rows_phase(const Frame& F0, const Args& args, int l) {
    const Frame F = fresh(F0);
    const int tid = F.tid, lane = F.lane, wave = F.wave;
    const float* MOD = WSP(float, WS_MOD);
    LAS float* gsc = (LAS float*)(F.lds + RING_OFF);
    LAS float* shf = gsc + 4096;
    LAS float* gtf = shf + 4096;
    for (int i = 0; i < 8; ++i) { const int idx = tid + 512 * i, b = idx >> 10, col = idx & 1023;
        if (MODE != 2) { gsc[idx] = INP(4)[l * 1024 + col] * (1.0f + MOD[(size_t)(l * 4 + b) * 6144 + 1024 + col]); shf[idx] = MOD[(size_t)(l * 4 + b) * 6144 + col]; }
        else gsc[idx] = INP(26)[col];
        if (MODE != 0) gtf[idx] = MOD[(size_t)((l - 1) * 4 + b) * 6144 + 5 * 1024 + col]; }
    __syncthreads();
    const float* xin = (MODE == 0) ? INP(0) : args.out;
    bf16* U = WSP(bf16, WS_U);
    const bf16* YE = WSP(bf16, WS_PROJ);
    const int* tokrow = WSP(int, WS_TOKROW); const float* tokw = WSP(float, WS_TOKW);
    const int gw = F.vcu * NWAVES + wave, NGW = F.G * NWAVES;
    for (int m0 = gw; m0 < NTOK; m0 += 2 * NGW) {
        f32x4 v[2][4]; v2u ya[2][4], yc[2][4]; float w0[2], w1[2];
#pragma unroll
        for (int q = 0; q < 2; ++q) { const int m = m0 + q * NGW; const f32x4* xr = (const f32x4*)(xin + (size_t)m * D) + lane;
#pragma unroll
            for (int j = 0; j < 4; ++j) v[q][j] = xr[64 * j];
            if (MODE != 0) { const int r0 = tokrow[2 * m], r1 = tokrow[2 * m + 1]; w0[q] = tokw[2 * m]; w1[q] = tokw[2 * m + 1];
                const v2u* y0 = (const v2u*)(YE + (size_t)r0 * 1024) + lane; const v2u* y1 = (const v2u*)(YE + (size_t)r1 * 1024) + lane;
#pragma unroll
                for (int j = 0; j < 4; ++j) { ya[q][j] = y0[64 * j]; yc[q][j] = y1[64 * j]; } } }
#pragma unroll
        for (int q = 0; q < 2; ++q) { const int m = m0 + q * NGW, b = m >> 13;
            if (MODE != 0) {
#pragma unroll
                for (int j = 0; j < 4; ++j) { const v2u a = ya[q][j], c = yc[q][j]; const f32x4 g = *(const LAS f32x4*)(gtf + b * 1024 + 4 * lane + 256 * j);
                    v[q][j].x += g.x * (w0[q] * bflo(a.x) + w1[q] * bflo(c.x)); v[q][j].y += g.y * (w0[q] * bfhi(a.x) + w1[q] * bfhi(c.x));
                    v[q][j].z += g.z * (w0[q] * bflo(a.y) + w1[q] * bflo(c.y)); v[q][j].w += g.w * (w0[q] * bfhi(a.y) + w1[q] * bfhi(c.y)); }
            }
            float ss = 0.f;
#pragma unroll
            for (int j = 0; j < 4; ++j) ss += (v[q][j].x * v[q][j].x + v[q][j].y * v[q][j].y) + (v[q][j].z * v[q][j].z + v[q][j].w * v[q][j].w);
            const float rstd = 1.0f / sqrtf(wave_sum(ss) * (1.0f / D) + EPS);
            if (MODE == 2) {
                f32x4* o = (f32x4*)(args.out + (size_t)m * D) + lane;
#pragma unroll
                for (int j = 0; j < 4; ++j) { const f32x4 g = *(const LAS f32x4*)(gsc + 4 * lane + 256 * j); o[64 * j] = v[q][j] * rstd * g; }
            } else {
                if (MODE == 1) { f32x4* o = (f32x4*)(args.out + (size_t)m * D) + lane;
#pragma unroll
                    for (int j = 0; j < 4; ++j) o[64 * j] = v[q][j]; }
                v2u* uo = (v2u*)(U + (size_t)m * D) + lane;
#pragma unroll
                for (int j = 0; j < 4; ++j) { const f32x4 g = *(const LAS f32x4*)(gsc + b * 1024 + 4 * lane + 256 * j), s = *(const LAS f32x4*)(shf + b * 1024 + 4 * lane + 256 * j);
                    const f32x4 u = v[q][j] * rstd * g + s; uo[64 * j] = (v2u){pk2(u.x, u.y), pk2(u.z, u.w)}; }
            }
        }
    }
}

struct EpiP2 {
    static constexpr bool PERM = true;
    bf16* proj; bf16* vt; bf16* gates; const float* gbias;
    __device__ __forceinline__ void operator()(const f32x4 (&acc)[2][2][4][2], const pg8::Unit& u, int wr, int wc, int fr, int fq) const {
        const int row0 = u.pm * 256 + wr * 64 + fr, pn = u.pn;
        if (pn == 4 || pn == 5) {
#pragma unroll
            for (int ai = 0; ai < 2; ++ai)
#pragma unroll
                for (int m = 0; m < 4; ++m) { const int row = row0 + ai * 128 + m * 16, b = row >> 13, t = row & 8191;
#pragma unroll
                    for (int bj = 0; bj < 2; ++bj)
#pragma unroll
                        for (int n = 0; n < 2; ++n) { const int col = (pn - 4) * 256 + bj * 128 + wc * 32 + 8 * fq + 4 * n; bf16* d = vt + ((size_t)(b * 512 + col)) * 8192 + t;
                            d[0] = (bf16)f2bf(acc[ai][bj][m][n][0]); d[8192] = (bf16)f2bf(acc[ai][bj][m][n][1]); d[2 * 8192] = (bf16)f2bf(acc[ai][bj][m][n][2]); d[3 * 8192] = (bf16)f2bf(acc[ai][bj][m][n][3]); } }
        } else if (pn < 14) {
            const int cbase = (pn < 4 ? pn * 256 : (pn - 2) * 256) + wc * 32 + 8 * fq; const float sc = pn < 2 ? 0.125f : 1.0f;
#pragma unroll
            for (int ai = 0; ai < 2; ++ai)
#pragma unroll
                for (int m = 0; m < 4; ++m) { bf16* rowp = proj + (size_t)(row0 + ai * 128 + m * 16) * PROJ_LD + cbase;
#pragma unroll
                    for (int bj = 0; bj < 2; ++bj) { const f32x4 v0 = acc[ai][bj][m][0] * sc, v1 = acc[ai][bj][m][1] * sc;
                        *(v4u*)(rowp + bj * 128) = (v4u){pk2(v0[0], v0[1]), pk2(v0[2], v0[3]), pk2(v1[0], v1[1]), pk2(v1[2], v1[3])}; } }
        } else {
            const int cbase = (pn - 14) * 256 + wc * 32 + 8 * fq;
            f32x4 bv[2][2];
#pragma unroll
            for (int bj = 0; bj < 2; ++bj)
#pragma unroll
                for (int n = 0; n < 2; ++n) bv[bj][n] = *(const f32x4*)(gbias + cbase + bj * 128 + 4 * n);
#pragma unroll
            for (int ai = 0; ai < 2; ++ai)
#pragma unroll
                for (int m = 0; m < 4; ++m) { bf16* rowp = gates + (size_t)(row0 + ai * 128 + m * 16) * GATES_LD + cbase;
#pragma unroll
                    for (int bj = 0; bj < 2; ++bj) { f32x4 v0 = acc[ai][bj][m][0] + bv[bj][0], v1 = acc[ai][bj][m][1] + bv[bj][1];
#pragma unroll
                        for (int e = 0; e < 4; ++e) { v0[e] = sigmoidf(v0[e]); v1[e] = sigmoidf(v1[e]); }
                        *(v4u*)(rowp + bj * 128) = (v4u){pk2(v0[0], v0[1]), pk2(v0[2], v0[3]), pk2(v1[0], v1[1]), pk2(v1[2], v1[3])}; } }
        }
    }
};
struct EpiMerge {
    static constexpr bool PERM = true;
    const bf16* gates; bf16* merged;
    __device__ __forceinline__ void operator()(const f32x4 (&acc)[2][2][4][2], const pg8::Unit& u, int wr, int wc, int fr, int fq) const {
        const int row0 = u.pm * 256 + wr * 64 + fr, cbase = u.pn * 256 + wc * 32 + 8 * fq, z = u.z;
#pragma unroll
        for (int ai = 0; ai < 2; ++ai)
#pragma unroll
            for (int m = 0; m < 4; ++m) { const size_t row = (size_t)(row0 + ai * 128 + m * 16);
#pragma unroll
                for (int bj = 0; bj < 2; ++bj) { const v4u gv = *(const v4u*)(gates + row * GATES_LD + z * 1024 + cbase + bj * 128);
                    bf16* mp = merged + row * 1024 + cbase + bj * 128;
                    f32x4 v0 = acc[ai][bj][m][0], v1 = acc[ai][bj][m][1];
                    v0[0] *= bflo(gv.x); v0[1] *= bfhi(gv.x); v0[2] *= bflo(gv.y); v0[3] *= bfhi(gv.y); v1[0] *= bflo(gv.z); v1[1] *= bfhi(gv.z); v1[2] *= bflo(gv.w); v1[3] *= bfhi(gv.w);
                    if (z > 0) { const v4u ov = *(const v4u*)mp;
                        v0[0] += bflo(ov.x); v0[1] += bfhi(ov.x); v0[2] += bflo(ov.y); v0[3] += bfhi(ov.y); v1[0] += bflo(ov.z); v1[1] += bfhi(ov.z); v1[2] += bflo(ov.w); v1[3] += bfhi(ov.w); }
                    *(v4u*)mp = (v4u){pk2(v0[0], v0[1]), pk2(v0[2], v0[3]), pk2(v1[0], v1[1]), pk2(v1[2], v1[3])}; } }
    }
};
struct EpiResid {
    static constexpr bool PERM = false;
    const float* xin; float* xout; const float* gt;
    __device__ __forceinline__ void operator()(const f32x4 (&acc)[2][2][4][2], const pg8::Unit& u, int wr, int wc, int fr, int fq) const {
        const int row0 = u.pm * 256 + wr * 64 + fr, col0 = u.pn * 256 + wc * 32 + 4 * fq, b = (u.pm * 256) >> 13;
        f32x4 gv[2][2];
#pragma unroll
        for (int bj = 0; bj < 2; ++bj)
#pragma unroll
            for (int n = 0; n < 2; ++n) gv[bj][n] = *(const f32x4*)(gt + (size_t)b * 6144 + col0 + bj * 128 + n * 16);
#pragma unroll
        for (int ai = 0; ai < 2; ++ai)
#pragma unroll
            for (int m = 0; m < 4; ++m) { const size_t off = (size_t)(row0 + ai * 128 + m * 16) * D + col0;
#pragma unroll
                for (int bj = 0; bj < 2; ++bj)
#pragma unroll
                    for (int n = 0; n < 2; ++n) { const f32x4 xv = *(const f32x4*)(xin + off + bj * 128 + n * 16); *(f32x4*)(xout + off + bj * 128 + n * 16) = xv + gv[bj][n] * acc[ai][bj][m][n]; } }
    }
};
struct EpiSwiGLU {
    static constexpr bool PERM = true;
    bf16* H;
    __device__ __forceinline__ void operator()(const f32x4 (&acc)[2][2][4][2], const pg8::Unit& u, int wr, int wc, int fr, int fq) const {
        const int row0 = u.pm * 256 + wr * 64 + fr, cbase = u.pn * 128 + wc * 32 + 8 * fq;
#pragma unroll
        for (int ai = 0; ai < 2; ++ai)
#pragma unroll
            for (int m = 0; m < 4; ++m) { f32x4 h0, h1;
#pragma unroll
                for (int e = 0; e < 4; ++e) { const float g0 = acc[ai][0][m][0][e], g1 = acc[ai][0][m][1][e]; h0[e] = g0 * sigmoidf(g0) * acc[ai][1][m][0][e]; h1[e] = g1 * sigmoidf(g1) * acc[ai][1][m][1][e]; }
                *(v4u*)(H + (size_t)(row0 + ai * 128 + m * 16) * 512 + cbase) = (v4u){pk2(h0[0], h0[1]), pk2(h0[2], h0[3]), pk2(h1[0], h1[1]), pk2(h1[2], h1[3])}; }
    }
};
struct EpiYE {
    static constexpr bool PERM = true;
    bf16* YE;
    __device__ __forceinline__ void operator()(const f32x4 (&acc)[2][2][4][2], const pg8::Unit& u, int wr, int wc, int fr, int fq) const {
        const int row0 = u.pm * 256 + wr * 64 + fr, cbase = u.pn * 256 + wc * 32 + 8 * fq;
#pragma unroll
        for (int ai = 0; ai < 2; ++ai)
#pragma unroll
            for (int m = 0; m < 4; ++m) { bf16* rowp = YE + (size_t)(row0 + ai * 128 + m * 16) * 1024 + cbase;
#pragma unroll
                for (int bj = 0; bj < 2; ++bj) { const f32x4 v0 = acc[ai][bj][m][0], v1 = acc[ai][bj][m][1];
                    *(v4u*)(rowp + bj * 128) = (v4u){pk2(v0[0], v0[1]), pk2(v0[2], v0[3]), pk2(v1[0], v1[1]), pk2(v1[2], v1[3])}; } }
    }
};

__device__ __forceinline__ void attn_unit(bf16* PROJ, const bf16* VT, const LAS float* rpb, int b, int h, int r, int qb, int lane, bf16* obase, int opitch) {
    const int qn = lane & 15, g = lane >> 4;
    const int rs = min(max(r - 4, 0), 120);
    const int cb = (qb == 0) ? 0 : ((qb == 1) ? 8 : ((qb == 2) ? 24 : 32));
    const int w = 16 * qb + qn, cs = min(max(w - 8, 0), 48);
    const size_t tokq = (size_t)b * T + r * 64 + w;
    bf16* qp = PROJ + tokq * PROJ_LD + Q_OFF + h * 64;
    bf16x8 qf0 = *(const bf16x8*)(qp + 8 * g), qf1 = *(const bf16x8*)(qp + 32 + 8 * g);
    const bf16* kbase = PROJ + ((size_t)b * T + rs * 64 + cb + qn) * PROJ_LD + K_OFF + h * 64 + 8 * g;
    f32x4 sc[16];
#pragma unroll
    for (int kt = 0; kt < 16; ++kt) {
        const int kr = kt >> 1, ch = kt & 1;
        const bf16* kp = kbase + (size_t)(kr * 64 + 16 * ch) * PROJ_LD;
        const bf16x8 kf0 = *(const bf16x8*)kp, kf1 = *(const bf16x8*)(kp + 32);
        f32x4 a = (f32x4){0.f, 0.f, 0.f, 0.f};
        a = __builtin_amdgcn_mfma_f32_16x16x32_bf16(kf0, qf0, a, 0, 0, 0);
        a = __builtin_amdgcn_mfma_f32_16x16x32_bf16(kf1, qf1, a, 0, 0, 0);
        sc[kt] = a;
    }
    const LAS float* rp = rpb + h * 465;
    float mx = -1e30f;
#pragma unroll
    for (int kt = 0; kt < 16; ++kt) {
        const int kr = kt >> 1, ch = kt & 1;
        const int brow = (rs + kr - r + 7) * 31;
#pragma unroll
        for (int j = 0; j < 4; ++j) {
            const int kc = cb + 16 * ch + 4 * g + j, dc = kc - w + 15;
            const bool ok = (kc >= cs) && (kc <= cs + 15);
            const float bias = rp[brow + (ok ? dc : 15)];
            const float s = ok ? sc[kt][j] + bias : -1e30f;
            sc[kt][j] = s; mx = fmaxf(mx, s);
        }
    }
    mx = fmaxf(mx, __shfl_xor(mx, 16)); mx = fmaxf(mx, __shfl_xor(mx, 32));
    float sum = 0.f;
#pragma unroll
    for (int kt = 0; kt < 16; ++kt)
#pragma unroll
        for (int j = 0; j < 4; ++j) { const float p = __expf(sc[kt][j] - mx); sc[kt][j] = p; sum += p; }
    sum += __shfl_xor(sum, 16); sum += __shfl_xor(sum, 32);
    const float inv = 1.0f / sum;
    f32x4 o[4];
#pragma unroll
    for (int dt = 0; dt < 4; ++dt) o[dt] = (f32x4){0.f, 0.f, 0.f, 0.f};
    const bf16* vbase = VT + ((size_t)(b * 512 + h * 64 + qn)) * T + rs * 64 + cb + 4 * g;
#pragma unroll
    for (int kr = 0; kr < 8; ++kr) {
        v4u pw; pw.x = pk2(sc[2 * kr][0], sc[2 * kr][1]); pw.y = pk2(sc[2 * kr][2], sc[2 * kr][3]); pw.z = pk2(sc[2 * kr + 1][0], sc[2 * kr + 1][1]); pw.w = pk2(sc[2 * kr + 1][2], sc[2 * kr + 1][3]);
        const bf16x8 pf = __builtin_bit_cast(bf16x8, pw);
#pragma unroll
        for (int dt = 0; dt < 4; ++dt) {
            const bf16* vp = vbase + (size_t)(16 * dt) * T + kr * 64;
            const v2u lo = *(const v2u*)vp, hi = *(const v2u*)(vp + 16);
            const v4u vw = (v4u){lo.x, lo.y, hi.x, hi.y};
            o[dt] = __builtin_amdgcn_mfma_f32_16x16x32_bf16(__builtin_bit_cast(bf16x8, vw), pf, o[dt], 0, 0, 0);
        }
    }
    bf16* op = obase + tokq * opitch + h * 64;
#pragma unroll
    for (int dt = 0; dt < 4; ++dt) *(v2u*)(op + 16 * dt + 4 * g) = (v2u){pk2(o[dt][0] * inv, o[dt][1] * inv), pk2(o[dt][2] * inv, o[dt][3] * inv)};
}
__device__ __forceinline__ void attn_phase(const Frame& F0, const Args& args, int l, bf16* obase, int opitch) {
    const Frame F = fresh(F0);
    LAS float* rpb = (LAS float*)(F.lds + RING_OFF);
    for (int i = F.tid; i < 8 * 465; i += 512) rpb[i] = INP(9)[l * 8 * 465 + i];
    __syncthreads();
    bf16* PROJ = WSP(bf16, WS_PROJ); const bf16* VT = WSP(bf16, WS_VT);
    for (int wu = F.vcu * NWAVES + F.wave; wu < 16384; wu += F.G * NWAVES) {
        const int bh = wu >> 9, rem = wu & 511;
        attn_unit(PROJ, VT, rpb, bh >> 3, bh & 7, rem >> 2, rem & 3, F.lane, obase, opitch);
    }
    __syncthreads();
}

__device__ __forceinline__ float gelu_tanh(float x) { const float u = 0.7978845608028654f * (x + 0.044715f * x * x * x); const float t = 1.0f - 2.0f * __builtin_amdgcn_rcpf(1.0f + __expf(2.0f * u)); return 0.5f * x * (1.0f + t); }
__device__ __forceinline__ void fft_a_phase(const Frame& F0, const Args& args) {
    const Frame F = fresh(F0);
    const int lane = F.lane, nl = lane & 31, hh = lane >> 5;
    const bf16* PROJ = WSP(bf16, WS_PROJ); const bf16* FA = WSP(bf16, WS_FA); const f32x2* TW = WSP(f32x2, WS_TW); bf16* ZP = WSP(bf16, WS_U);
    for (int wu = F.vcu * NWAVES + F.wave; wu < 8192; wu += F.G * NWAVES) {
        const int ct = wu & 15, t2 = (wu >> 4) & 127, b = wu >> 11;
        bf16x8 bf[8];
#pragma unroll
        for (int s = 0; s < 8; ++s) { const int part = s >> 2, t1b = 16 * (s & 3) + 8 * hh;
            const bf16* p = PROJ + ((size_t)b * T + (size_t)128 * t1b + t2) * PROJ_LD + G_OFF + part * 512 + 32 * ct + nl;
            unsigned short e[8];
#pragma unroll
            for (int j = 0; j < 8; ++j) e[j] = p[(size_t)j * 128 * PROJ_LD];
            v4u w; w.x = e[0] | ((unsigned)e[1] << 16); w.y = e[2] | ((unsigned)e[3] << 16); w.z = e[4] | ((unsigned)e[5] << 16); w.w = e[6] | ((unsigned)e[7] << 16);
            bf[s] = __builtin_bit_cast(bf16x8, w); }
        f32x16 acc[4];
#pragma unroll
        for (int mt = 0; mt < 4; ++mt) { acc[mt] = (f32x16){};
#pragma unroll
            for (int s = 0; s < 8; ++s) { const bf16x8 af = *(const bf16x8*)(FA + (32 * mt + nl) * 128 + 16 * s + 8 * hh); acc[mt] = __builtin_amdgcn_mfma_f32_32x32x16_bf16(af, bf[s], acc[mt], 0, 0, 0); } }
#pragma unroll
        for (int mt = 0; mt < 2; ++mt)
#pragma unroll
            for (int rg = 0; rg < 16; ++rg) { const int k1 = 32 * mt + (rg & 3) + 8 * (rg >> 2) + 4 * hh; const f32x2 cs = TW[t2 * 64 + k1];
                const float zr = acc[mt][rg], zi = acc[mt + 2][rg];
                bf16* d = ZP + ((size_t)(b * 64 + k1) * 128 + t2) * 1024 + 32 * ct + nl;
                d[0] = (bf16)f2bf(zr * cs.x + zi * cs.y); d[512] = (bf16)f2bf(zi * cs.x - zr * cs.y); }
    }
}
__device__ __forceinline__ void fft_b_phase(const Frame& F0, const Args& args) {
    const Frame F = fresh(F0);
    const int lane = F.lane, nl = lane & 31, hh = lane >> 5;
    bf16* PROJ = WSP(bf16, WS_PROJ); const bf16* FB = WSP(bf16, WS_FB); const bf16* ZP = WSP(bf16, WS_U);
    for (int wu = F.vcu * NWAVES + F.wave; wu < 4096; wu += F.G * NWAVES) {
        const int ct = wu & 15, k1 = (wu >> 4) & 63, b = wu >> 10;
        f32x16 acc[4];
#pragma unroll
        for (int mt = 0; mt < 4; ++mt) acc[mt] = (f32x16){};
#pragma unroll 1
        for (int sc = 0; sc < 4; ++sc) {
            bf16x8 bf[4];
#pragma unroll
            for (int q = 0; q < 4; ++q) { const int s = 4 * sc + q, part = s >> 3, t2b = 16 * (s & 7) + 8 * hh;
                const bf16* p = ZP + ((size_t)(b * 64 + k1) * 128 + t2b) * 1024 + part * 512 + 32 * ct + nl;
                unsigned short e[8];
#pragma unroll
                for (int j = 0; j < 8; ++j) e[j] = p[(size_t)j * 1024];
                v4u w; w.x = e[0] | ((unsigned)e[1] << 16); w.y = e[2] | ((unsigned)e[3] << 16); w.z = e[4] | ((unsigned)e[5] << 16); w.w = e[6] | ((unsigned)e[7] << 16);
                bf[q] = __builtin_bit_cast(bf16x8, w); }
#pragma unroll
            for (int mt = 0; mt < 4; ++mt)
#pragma unroll
                for (int q = 0; q < 4; ++q) { const bf16x8 af = *(const bf16x8*)(FB + (32 * mt + nl) * 256 + 16 * (4 * sc + q) + 8 * hh); acc[mt] = __builtin_amdgcn_mfma_f32_32x32x16_bf16(af, bf[q], acc[mt], 0, 0, 0); }
        }
#pragma unroll
        for (int mt = 0; mt < 4; ++mt)
#pragma unroll
            for (int rg = 0; rg < 16; ++rg) { const int k2 = 32 * mt + (rg & 3) + 8 * (rg >> 2) + 4 * hh;
                PROJ[((size_t)b * T + k1 + 64 * k2) * PROJ_LD + G_OFF + 32 * ct + nl] = (bf16)f2bf(acc[mt][rg] * (1.0f / 1024.0f)); }
    }
}

__device__ __forceinline__ void router_phase(const Frame& F0, const Args& args, int l, int cset) {
    const Frame F = fresh(F0);
    const int tid = F.tid, lane = F.lane, wave = F.wave;
    const float* MOD = WSP(float, WS_MOD);
    LAS float* WPL = (LAS float*)(F.lds + RING_OFF);
    LAS float* gsc = (LAS float*)(F.lds + XTRA_OFF);
    LAS float* shf = gsc + 1024;
    LAS float* c0 = shf + 1024;
    LAS float* rb = c0 + 32;
    LAS unsigned* lcnt = (LAS unsigned*)(rb + 32);
    LAS unsigned* lbase = lcnt + 32;
    LAS float* red = (LAS float*)(lbase + 32);
    const float* x = args.out; bf16* U2 = WSP(bf16, WS_U);
    float* tokw = WSP(float, WS_TOKW); int* perm = WSP(int, WS_PERM);
    unsigned* ecnt = (unsigned*)(F.ctl + CW_ECNT + cset * 32 * 64);
    const int nround = (2048 + F.G * NWAVES - 1) / (F.G * NWAVES);
    int cur_b = -1;
    for (int rd = 0; rd < nround; ++rd) {
        const int unit = (rd * F.G + F.vcu) * NWAVES + wave;
        const int ub = (((rd * F.G + F.vcu) * NWAVES) * 16) >> 13;
        const bool wg_active = ((rd * F.G + F.vcu) * NWAVES) < 2048;
        if (wg_active && ub != cur_b) {
            cur_b = ub; __syncthreads();
            for (int i = 0; i < 2; ++i) { const int col = tid + 512 * i; gsc[col] = INP(5)[l * 1024 + col] * (1.0f + MOD[(size_t)(l * 4 + ub) * 6144 + 4 * 1024 + col]); shf[col] = MOD[(size_t)(l * 4 + ub) * 6144 + 3 * 1024 + col]; }
            if (tid < 32) rb[tid] = INP(22)[tid];
            __syncthreads();
            for (int i = 0; i < 64; ++i) { const int idx = tid + 512 * i, k = idx >> 5, e = idx & 31; WPL[k * 32 + (e ^ (((k >> 8) & 1) << 4))] = gsc[k] * INP(21)[idx]; }
            { const int e = tid & 31, pt = tid >> 5; float s = 0.f;
                for (int k = pt * 64; k < pt * 64 + 64; ++k) s += shf[k] * INP(21)[k * 32 + e];
                red[tid] = s; }
            __syncthreads();
            if (tid < 32) { float s = 0.f; for (int p = 0; p < 16; ++p) s += red[p * 32 + tid]; c0[tid] = s; }
        }
        if (tid < 32) lcnt[tid] = 0u;
        __syncthreads();
        int e0 = 0, e1 = 0; unsigned rk0 = 0, rk1 = 0; float w0 = 0.f, w1 = 0.f; bool owner = false; int mytok = 0;
        if (unit < 2048) {
            const int tok0 = unit * 16;
            float rs_reg = 0.f;
#pragma unroll 1
            for (int i4 = 0; i4 < 16; i4 += 4) {
                f32x4 v[4][4];
#pragma unroll
                for (int q = 0; q < 4; ++q) { const f32x4* xr = (const f32x4*)(x + (size_t)(tok0 + i4 + q) * D) + lane;
#pragma unroll
                    for (int j = 0; j < 4; ++j) v[q][j] = xr[64 * j]; }
#pragma unroll
                for (int q = 0; q < 4; ++q) { const int m = tok0 + i4 + q; float ss = 0.f;
#pragma unroll
                    for (int j = 0; j < 4; ++j) ss += (v[q][j].x * v[q][j].x + v[q][j].y * v[q][j].y) + (v[q][j].z * v[q][j].z + v[q][j].w * v[q][j].w);
                    const float rstd = 1.0f / sqrtf(wave_sum(ss) * (1.0f / D) + EPS);
                    if ((lane & 15) == i4 + q) rs_reg = rstd;
                    v2u* uo = (v2u*)(U2 + (size_t)m * D) + lane;
#pragma unroll
                    for (int j = 0; j < 4; ++j) { const f32x4 g = *(const LAS f32x4*)(gsc + 4 * lane + 256 * j), s = *(const LAS f32x4*)(shf + 4 * lane + 256 * j);
                        const f32x4 u = v[q][j] * rstd * g + s; uo[64 * j] = (v2u){pk2(u.x, u.y), pk2(u.z, u.w)}; } }
            }
            const int ti = lane & 15, kq = lane >> 4;
            const f32x4* xrow = (const f32x4*)(x + (size_t)(tok0 + ti) * D + 256 * kq);
            const LAS float* wp0 = WPL + (256 * kq) * 32 + (ti ^ ((kq & 1) << 4));
            const LAS float* wp1 = WPL + (256 * kq) * 32 + ((16 + ti) ^ ((kq & 1) << 4));
            f32x4 a0 = {0.f, 0.f, 0.f, 0.f}, a1 = {0.f, 0.f, 0.f, 0.f};
#pragma unroll 1
            for (int t32 = 0; t32 < 8; ++t32) {
                f32x4 xv[8];
#pragma unroll
                for (int q = 0; q < 8; ++q) xv[q] = xrow[8 * t32 + q];
#pragma unroll
                for (int q = 0; q < 8; ++q)
#pragma unroll
                    for (int jj = 0; jj < 4; ++jj) { const int kk = 32 * t32 + 4 * q + jj;
                        a0 = __builtin_amdgcn_mfma_f32_16x16x4f32(wp0[kk * 32], xv[q][jj], a0, 0, 0, 0);
                        a1 = __builtin_amdgcn_mfma_f32_16x16x4f32(wp1[kk * 32], xv[q][jj], a1, 0, 0, 0); }
            }
            float sco[2][4], sel[2][4], gs[2];
#pragma unroll
            for (int nt = 0; nt < 2; ++nt) {
#pragma unroll
                for (int rg = 0; rg < 4; ++rg) { const int e = 16 * nt + 4 * kq + rg; const float lg = rs_reg * (nt ? a1[rg] : a0[rg]) + c0[e]; sco[nt][rg] = sigmoidf(lg); sel[nt][rg] = sco[nt][rg] + rb[e]; }
                float m1 = fmaxf(sel[nt][0], sel[nt][1]), m2 = fminf(sel[nt][0], sel[nt][1]);
                { const float v = sel[nt][2]; if (v > m1) { m2 = m1; m1 = v; } else if (v > m2) m2 = v; }
                { const float v = sel[nt][3]; if (v > m1) { m2 = m1; m1 = v; } else if (v > m2) m2 = v; }
                gs[nt] = m1 + m2; }
            float bv = gs[0]; int bg = kq; if (gs[1] > bv) { bv = gs[1]; bg = 4 + kq; }
#pragma unroll
            for (int o = 16; o < 64; o <<= 1) { const float ov = __shfl_xor(bv, o); const int og = __shfl_xor(bg, o); if (ov > bv || (ov == bv && og < bg)) { bv = ov; bg = og; } }
            owner = ((bg & 3) == kq); mytok = tok0 + ti;
            if (owner) { const int nt = bg >> 2; float cd[4], sv[4];
#pragma unroll
                for (int rg = 0; rg < 4; ++rg) { cd[rg] = nt ? sel[1][rg] : sel[0][rg]; sv[rg] = nt ? sco[1][rg] : sco[0][rg]; }
                int i1 = 0; float v1 = cd[0];
#pragma unroll
                for (int rg = 1; rg < 4; ++rg) if (cd[rg] > v1) { v1 = cd[rg]; i1 = rg; }
                int i2 = -1; float v2 = -1e30f;
#pragma unroll
                for (int rg = 0; rg < 4; ++rg) if (rg != i1 && cd[rg] > v2) { v2 = cd[rg]; i2 = rg; }
                const float s1 = (i1 == 0 ? sv[0] : (i1 == 1 ? sv[1] : (i1 == 2 ? sv[2] : sv[3]))), s2 = (i2 == 0 ? sv[0] : (i2 == 1 ? sv[1] : (i2 == 2 ? sv[2] : sv[3])));
                e0 = 4 * bg + i1; e1 = 4 * bg + i2; w0 = s1 / (s1 + s2); w1 = s2 / (s1 + s2);
                rk0 = __hip_atomic_fetch_add(lcnt + e0, 1u, __ATOMIC_RELAXED, __HIP_MEMORY_SCOPE_WORKGROUP);
                rk1 = __hip_atomic_fetch_add(lcnt + e1, 1u, __ATOMIC_RELAXED, __HIP_MEMORY_SCOPE_WORKGROUP); }
        }
        __syncthreads();
        if (tid < 32) { const unsigned n = lcnt[tid]; lbase[tid] = n ? __hip_atomic_fetch_add(ecnt + 64 * tid, n, RLX_AGENT) : 0u; }
        __syncthreads();
        if (owner) { perm[(size_t)e0 * NTOK + lbase[e0] + rk0] = 2 * mytok; perm[(size_t)e1 * NTOK + lbase[e1] + rk1] = 2 * mytok + 1; tokw[2 * mytok] = w0; tokw[2 * mytok + 1] = w1; }
    }
    __syncthreads();
    {
        LAS float* scr = (LAS float*)(F.lds + RING_OFF + wave * 8704);
        const int gw = F.vcu * NWAVES + wave, NGW = F.G * NWAVES;
        bf16* WG1 = WSP(bf16, WS_WG1); bf16* WD = WSP(bf16, WS_WD);
        auto mk = [&](int it) -> TrItem {
            const int kind = it >> 13, r = it & 8191, e = r >> 8, rr = r & 255;
            if (kind < 2) { const int kb = rr >> 4, nb = rr & 15, n0 = nb * 32; const float* src = (kind == 0 ? INP(23) : INP(24)) + (size_t)(l * 32 + e) * 1024 * 512;
                return TrItem{src, 512, kb * 64, n0, WG1 + ((size_t)e * 1024 + (n0 >> 7) * 256 + kind * 128 + (n0 & 127)) * 1024, 1024}; }
            const int kb = rr >> 5, nb = rr & 31, n0 = nb * 32; const float* src = INP(25) + (size_t)(l * 32 + e) * 512 * 1024;
            return TrItem{src, 1024, kb * 64, n0, WD + ((size_t)e * 1024 + n0) * 512, 512}; };
        for (int rep = 0; rep < 1 + REP_C; ++rep)
        for (int it = gw; it < 24576; it += 2 * NGW) {
            const bool two = (it + NGW) < 24576;
            const TrItem a = mk(it), b = mk(two ? it + NGW : it);
            f32x4 va[8], vb[8]; tr_load(a, va, lane); tr_load(b, vb, lane);
            tr_finish(a, va, scr, lane); if (two) tr_finish(b, vb, scr, lane);
        }
    }
}
__device__ __forceinline__ void moe_tilebase(const Frame& F0, const Args& args, int l) {
    const Frame F = fresh(F0);
    if (F.tid == 0) { unsigned* ecnt = (unsigned*)(F.ctl + CW_ECNT + l * 32 * 64); int acc = 0;
        for (int e = 0; e < 32; ++e) { F.MISC[16 + e] = (unsigned)acc; acc += (int)((__hip_atomic_load(ecnt + 64 * e, RLX_AGENT) + 255u) >> 8); }
        F.MISC[48] = (unsigned)acc; }
    __syncthreads();
}
__device__ __forceinline__ void gather_phase(const Frame& F0, const Args& args, int l) {
    const Frame F = fresh(F0);
    moe_tilebase(F, args, l);
    const unsigned* ecnt = (const unsigned*)(F.ctl + CW_ECNT + l * 32 * 64);
    const int* perm = WSP(int, WS_PERM); int* tokrow = WSP(int, WS_TOKROW);
    const bf16* U2 = WSP(bf16, WS_U); bf16* XS = WSP(bf16, WS_PROJ);
    const int nrows = (int)F.MISC[48] * 256, NGW = F.G * NWAVES;
    for (int r0 = F.vcu * NWAVES + F.wave; r0 < nrows; r0 += 4 * NGW) {
        int tk[4]; bool ok[4];
#pragma unroll
        for (int q = 0; q < 4; ++q) { const int r = r0 + q * NGW; ok[q] = false; tk[q] = 0;
            if (r < nrows) { const int t = r >> 8; int e = 0;
                for (int k = 1; k < 32; ++k) e += ((int)F.MISC[16 + k] <= t) ? 1 : 0;
                const int s = r - 256 * (int)F.MISC[16 + e]; const int cnt = (int)__hip_atomic_load(ecnt + 64 * e, RLX_AGENT);
                if (s < cnt) { ok[q] = true; tk[q] = perm[(size_t)e * NTOK + s]; } } }
        v4u a[4][2];
#pragma unroll
        for (int q = 0; q < 4; ++q) { const v4u* src = (const v4u*)(U2 + (size_t)(tk[q] >> 1) * 1024) + F.lane; a[q][0] = src[0]; a[q][1] = src[64]; }
#pragma unroll
        for (int q = 0; q < 4; ++q) if (ok[q]) { const int r = r0 + q * NGW; v4u* dst = (v4u*)(XS + (size_t)r * 1024) + F.lane; dst[0] = a[q][0]; dst[64] = a[q][1]; if (F.lane == 0) tokrow[tk[q]] = r; }
    }
}
__device__ __forceinline__ void lru_conv_phase(const Frame& F0, const Args& args, int l) {
    const Frame F = fresh(F0);
    const int lane = F.lane, cg = lane & 7, tg = lane >> 3;
    const bf16* PROJ = WSP(bf16, WS_PROJ); bf16* XC = WSP(bf16, WS_XC);
    for (int wu = F.vcu * NWAVES + F.wave; wu < 4096; wu += F.G * NWAVES) {
        const int hb = wu & 7, c = (wu >> 3) & 127, b = wu >> 10, t0 = c * 64, ch0 = hb * 64 + 8 * cg;
        const bf16* xrp = PROJ + (size_t)b * T * PROJ_LD + XR_OFF + ch0;
        v4u raw[11];
#pragma unroll
        for (int rr = 0; rr < 11; ++rr) { const int t = t0 + 8 * tg - 2 + rr, tc = min(max(t, 0), T - 1); raw[rr] = *(const v4u*)(xrp + (size_t)tc * PROJ_LD); }
        f32x4 wv[5][2];
#pragma unroll
        for (int j = 0; j < 4; ++j) { wv[j][0] = *(const f32x4*)(INP(10) + (l * 4 + j) * 512 + ch0); wv[j][1] = *(const f32x4*)(INP(10) + (l * 4 + j) * 512 + ch0 + 4); }
        wv[4][0] = *(const f32x4*)(INP(11) + l * 512 + ch0); wv[4][1] = *(const f32x4*)(INP(11) + l * 512 + ch0 + 4);
        unsigned ow[8][4];
#pragma unroll
        for (int pp = 0; pp < 4; ++pp) {
            float xl[11], xh[11];
#pragma unroll
            for (int rr = 0; rr < 11; ++rr) { const int t = t0 + 8 * tg - 2 + rr; const unsigned w = (t >= 0 && t < T) ? raw[rr][pp] : 0u; xl[rr] = bflo(w); xh[rr] = bfhi(w); }
#pragma unroll
            for (int tk = 0; tk < 8; ++tk) { float ol = wv[4][pp >> 1][2 * (pp & 1)], oh = wv[4][pp >> 1][2 * (pp & 1) + 1];
#pragma unroll
                for (int j = 0; j < 4; ++j) { ol += wv[j][pp >> 1][2 * (pp & 1)] * xl[tk + j]; oh += wv[j][pp >> 1][2 * (pp & 1) + 1] * xh[tk + j]; }
                ow[tk][pp] = pk2(ol, oh); }
        }
#pragma unroll
        for (int tk = 0; tk < 8; ++tk) *(v4u*)(XC + ((size_t)b * T + t0 + 8 * tg + tk) * 512 + ch0) = (v4u){ow[tk][0], ow[tk][1], ow[tk][2], ow[tk][3]};
    }
}
__device__ __forceinline__ void lru_load_frags(bf16x8 (&af)[4][2], const bf16* xcp, int t0, int lane) {
#pragma unroll
    for (int mt = 0; mt < 4; ++mt) { const int tau = 16 * ((lane & 15) >> 2) + 4 * mt + (lane & 3);
#pragma unroll
        for (int s = 0; s < 2; ++s) af[mt][s] = *(const bf16x8*)(xcp + (size_t)(t0 + tau) * 512 + 32 * s); }
}
__device__ __forceinline__ void lru2_phase(const Frame& F0, const Args& args, int l, bf16* obase, int opitch, int ooff) {
    const Frame F = fresh(F0);
    const int lane = F.lane, wave = F.wave;
    LAS bf16* YRT = (LAS bf16*)(F.lds + RING_OFF + wave * 1024);
    LAS f32x2* SUMT = (LAS f32x2*)(F.lds + RING_OFF + 8192);
    LAS float* CARRY = (LAS float*)(F.lds + RING_OFF + 24576);
    const bf16* PROJ = WSP(bf16, WS_PROJ); const bf16* XC = WSP(bf16, WS_XC);
    for (int un = F.vcu; un < 256; un += F.G) {
        const int b = un >> 6, hb = (un >> 3) & 7, s8 = un & 7;
        const int n = lane & 15, g = lane >> 4, dir = n >> 3, cj = n & 7;
        const int chg = hb * 64 + s8 * 8 + cj;
        const bf16* WLp = WSP(bf16, WS_WL) + ((size_t)(l * 8 + hb) * 256) * 64;
        bf16x8 br[2], bi[2], bs[2];
#pragma unroll
        for (int s = 0; s < 2; ++s) { br[s] = *(const bf16x8*)(WLp + ((2 * dir + 0) * 64 + s8 * 8 + cj) * 64 + 32 * s + 8 * g); bi[s] = *(const bf16x8*)(WLp + ((2 * dir + 1) * 64 + s8 * 8 + cj) * 64 + 32 * s + 8 * g);
            v4u sel = (v4u){0u, 0u, 0u, 0u};
            if (32 * s + 8 * g == 8 * s8) { const unsigned one = (cj & 1) ? 0x3F800000u : 0x00003F80u; sel[0] = (cj >> 1) == 0 ? one : 0u; sel[1] = (cj >> 1) == 1 ? one : 0u; sel[2] = (cj >> 1) == 2 ? one : 0u; sel[3] = (cj >> 1) == 3 ? one : 0u; }
            bs[s] = __builtin_bit_cast(bf16x8, sel); }
        const float b_r = INP(13)[(l * 2 + dir) * 512 + chg], b_i = INP(15)[(l * 2 + dir) * 512 + chg], lam = INP(16)[(l * 2 + dir) * 512 + chg];
        const float m8sp = -8.0f * ((lam > 15.f) ? __expf(-lam) : log1pf(__expf(-lam)));
        const bf16* xcp = XC + (size_t)b * T * 512 + hb * 64 + 8 * g;
        const bf16* yrp = PROJ + (size_t)b * T * PROJ_LD + YR_OFF + hb * 64 + s8 * 8;
        bf16* outp = obase + (size_t)b * T * opitch + ooff + hb * 64 + s8 * 8;
#pragma unroll 1
        for (int sweep = 0; sweep < 2; ++sweep) {
            bf16x8 nxt[4][2]; v4u ynx = (v4u){0u, 0u, 0u, 0u};
            lru_load_frags(nxt, xcp, wave * 64, lane);
            if (sweep == 1) ynx = *(const v4u*)(yrp + (size_t)(wave * 64 + lane) * PROJ_LD);
#pragma unroll 1
            for (int ci = 0; ci < 16; ++ci) {
                const int c = wave + 8 * ci, t0 = c * 64;
                bf16x8 af[4][2];
#pragma unroll
                for (int mt = 0; mt < 4; ++mt) { af[mt][0] = nxt[mt][0]; af[mt][1] = nxt[mt][1]; }
                const v4u ycur = ynx;
                if (ci + 1 < 16) { lru_load_frags(nxt, xcp, t0 + 512, lane); if (sweep == 1) ynx = *(const v4u*)(yrp + (size_t)(t0 + 512 + lane) * PROJ_LD); }
                if (sweep == 1) *(LAS v4u*)(YRT + lane * 8) = ycur;
                f32x4 ar[4], ai[4], ax[4];
#pragma unroll
                for (int mt = 0; mt < 4; ++mt) { ar[mt] = (f32x4){0.f, 0.f, 0.f, 0.f}; ai[mt] = (f32x4){0.f, 0.f, 0.f, 0.f}; ax[mt] = (f32x4){0.f, 0.f, 0.f, 0.f};
#pragma unroll
                    for (int s = 0; s < 2; ++s) { ar[mt] = __builtin_amdgcn_mfma_f32_16x16x32_bf16(af[mt][s], br[s], ar[mt], 0, 0, 0); ai[mt] = __builtin_amdgcn_mfma_f32_16x16x32_bf16(af[mt][s], bi[s], ai[mt], 0, 0, 0);
                        ax[mt] = __builtin_amdgcn_mfma_f32_16x16x32_bf16(af[mt][s], bs[s], ax[mt], 0, 0, 0); } }
                float a[16], bx[16];
#pragma unroll
                for (int j = 0; j < 16; ++j) { const float rr = fsigmoid(ar[j >> 2][j & 3] + b_r), ii = fsigmoid(ai[j >> 2][j & 3] + b_i);
                    const float av = __expf(m8sp * rr); a[j] = av; bx[j] = __builtin_amdgcn_sqrtf(fmaxf(1.0f - av * av, 0.f)) * (ii * ax[j >> 2][j & 3]); }
                float A16 = 1.f, B16 = 0.f;
                if (dir == 0) {
#pragma unroll
                    for (int j = 0; j < 16; ++j) { B16 = a[j] * B16 + bx[j]; A16 *= a[j]; }
                } else {
#pragma unroll
                    for (int j = 15; j >= 0; --j) { B16 = a[j] * B16 + bx[j]; A16 *= a[j]; }
                }
                float Ag[4], Bg[4];
#pragma unroll
                for (int k = 0; k < 4; ++k) { const int src = n + 16 * (dir ? 3 - k : k); Ag[k] = __shfl(A16, src); Bg[k] = __shfl(B16, src); }
                if (sweep == 0) {
                    float At = 1.f, Bt = 0.f;
#pragma unroll
                    for (int k = 0; k < 4; ++k) { Bt = Ag[k] * Bt + Bg[k]; At *= Ag[k]; }
                    if (g == 0) SUMT[c * 16 + n] = (f32x2){At, Bt};
                } else {
                    const int pos = dir ? 3 - g : g;
                    float h = CARRY[c * 16 + n];
#pragma unroll
                    for (int k = 0; k < 3; ++k) if (k < pos) h = Ag[k] * h + Bg[k];
                    float hj[16];
                    if (dir == 0) {
#pragma unroll
                        for (int j = 0; j < 16; ++j) { h = a[j] * h + bx[j]; hj[j] = h; }
                    } else {
#pragma unroll
                        for (int j = 15; j >= 0; --j) { h = a[j] * h + bx[j]; hj[j] = h; }
                    }
#pragma unroll
                    for (int j = 0; j < 16; ++j) hj[j] += __shfl_xor(hj[j], 8);
                    LDS_WAIT(); asm volatile("" ::: "memory");
                    {
                        float hv[8], yv[8];
#pragma unroll
                        for (int j = 0; j < 8; ++j) { hv[j] = dir ? hj[8 + j] : hj[j]; yv[j] = bf2f(YRT[(16 * g + 8 * dir + j) * 8 + cj]); }
#pragma unroll
                        for (int j = 0; j < 8; ++j) YRT[(16 * g + 8 * dir + j) * 8 + cj] = (bf16)f2bf(hv[j] * gelu_tanh(yv[j]));
                    }
                    LDS_WAIT(); asm volatile("" ::: "memory");
                    *(v4u*)(outp + (size_t)(t0 + lane) * opitch) = *(const LAS v4u*)(YRT + lane * 8);
                    LDS_WAIT(); asm volatile("" ::: "memory");
                }
            }
            if (sweep == 0) {
                __syncthreads();
                if (F.tid < 16) { const int nn = F.tid, dd = nn >> 3; float h = 0.f;
#pragma unroll 4
                    for (int i = 0; i < 128; ++i) { const int c = dd ? 127 - i : i; const f32x2 ab = SUMT[c * 16 + nn]; CARRY[c * 16 + nn] = h; h = ab.x * h + ab.y; } }
                __syncthreads();
            }
        }
        __syncthreads();
    }
}
constexpr int AT_KR = 0, AT_VR = 73728, AT_VPITCH = 1168, AT_RPB = 148480;
__device__ __forceinline__ void attn2_phase(const Frame& F0, const Args& args, int l, bf16* obase, int opitch) {
    const Frame F = fresh(F0);
    const int tid = F.tid, lane = F.lane, wave = F.wave;
    LAS unsigned char* KR = F.lds + AT_KR; LAS unsigned char* VR = F.lds + AT_VR;
    LAS float* rpb = (LAS float*)(F.lds + AT_RPB);
    const bf16* PROJ = WSP(bf16, WS_PROJ); const bf16* VT = WSP(bf16, WS_VT);
    const int qb = wave & 3, dh = wave >> 2, qn = lane & 15, g = lane >> 4;
    const int cb = (qb == 0) ? 0 : ((qb == 1) ? 8 : ((qb == 2) ? 24 : 32));
    const int w = 16 * qb + qn, cs = min(max(w - 8, 0), 48);
    const int st = tid >> 3, sc = tid & 7;
    for (int un = F.vcu; un < 256; un += F.G) {
        const int bh = un >> 3, b = bh >> 3, h = bh & 7, R0 = (un & 7) * 16;
        __syncthreads();
        for (int i = tid; i < 465; i += 512) rpb[i] = INP(9)[(l * 8 + h) * 465 + i];
        const bf16* kg = PROJ + ((size_t)b * T + st) * PROJ_LD + K_OFF + h * 64 + 8 * sc;
        const bf16* vg = VT + ((size_t)(b * 512 + h * 64 + st)) * T + 8 * sc;
        const int kdst = st * 128 + ((sc ^ ((st >> 1) & 7)) * 16);
        const int vdst = st * AT_VPITCH + sc * 16;
        const int rs0 = min(max(R0 - 4, 0), 120);
        {
            v4u kk[8], vv[8];
#pragma unroll
            for (int j = 0; j < 8; ++j) { kk[j] = *(const v4u*)(kg + (size_t)(rs0 + j) * 64 * PROJ_LD); vv[j] = *(const v4u*)(vg + (rs0 + j) * 64); }
#pragma unroll
            for (int j = 0; j < 8; ++j) { const int slot = (rs0 + j) % 9; *(LAS v4u*)(KR + slot * 8192 + kdst) = kk[j]; *(LAS v4u*)(VR + slot * 128 + vdst) = vv[j]; }
        }
        __syncthreads();
        int have = rs0 + 7;
        v2u py0 = (v2u){0u, 0u}, py1 = (v2u){0u, 0u}; bf16* pop = nullptr;
#pragma unroll 1
        for (int s = 0; s < 16; ++s) {
            const int r = R0 + s;
            if (s > 0) { *(v2u*)pop = py0; *(v2u*)(pop + 16) = py1; }
            const size_t tokq = (size_t)b * T + r * 64 + w;
            const bf16* qp = PROJ + tokq * PROJ_LD + Q_OFF + h * 64;
            const bf16x8 qf0 = *(const bf16x8*)(qp + 8 * g), qf1 = *(const bf16x8*)(qp + 32 + 8 * g);
            const int rsn = min(max(r + 1 - 4, 0), 120); const bool newrow = (s + 1 < 16) && (rsn + 7 > have); const int nrow = min(rsn + 7, 127);
            const v4u pk = *(const v4u*)(kg + (size_t)nrow * 64 * PROJ_LD), pv = *(const v4u*)(vg + nrow * 64);
            const int rs = min(max(r - 4, 0), 120);
            int slot = rs % 9;
            f32x4 sc4[16];
#pragma unroll
            for (int kr = 0; kr < 8; ++kr) {
#pragma unroll
                for (int ch = 0; ch < 2; ++ch) { const int kt = cb + 16 * ch + qn; const LAS unsigned char* kp = KR + slot * 8192 + kt * 128; const int sw = (kt >> 1) & 7;
                    const bf16x8 kf0 = *(const LAS bf16x8*)(kp + ((g ^ sw) * 16)), kf1 = *(const LAS bf16x8*)(kp + (((4 + g) ^ sw) * 16));
                    f32x4 a = (f32x4){0.f, 0.f, 0.f, 0.f};
                    a = __builtin_amdgcn_mfma_f32_16x16x32_bf16(kf0, qf0, a, 0, 0, 0);
                    a = __builtin_amdgcn_mfma_f32_16x16x32_bf16(kf1, qf1, a, 0, 0, 0);
                    sc4[2 * kr + ch] = a; }
                slot = (slot == 8) ? 0 : slot + 1;
            }
            float mx = -1e30f;
#pragma unroll
            for (int kt = 0; kt < 16; ++kt) { const int kr = kt >> 1, ch = kt & 1; const int brow = (rs + kr - r + 7) * 31;
#pragma unroll
                for (int j = 0; j < 4; ++j) { const int kc = cb + 16 * ch + 4 * g + j, dc = kc - w + 15; const bool ok = (kc >= cs) && (kc <= cs + 15);
                    const float bias = rpb[brow + (ok ? dc : 15)]; const float sv = ok ? sc4[kt][j] + bias : -1e30f; sc4[kt][j] = sv; mx = fmaxf(mx, sv); } }
            mx = fmaxf(mx, __shfl_xor(mx, 16)); mx = fmaxf(mx, __shfl_xor(mx, 32));
            float sum = 0.f;
#pragma unroll
            for (int kt = 0; kt < 16; ++kt)
#pragma unroll
                for (int j = 0; j < 4; ++j) { const float p = __expf(sc4[kt][j] - mx); sc4[kt][j] = p; sum += p; }
            sum += __shfl_xor(sum, 16); sum += __shfl_xor(sum, 32);
            const float inv = __builtin_amdgcn_rcpf(sum);
            f32x4 o0 = (f32x4){0.f, 0.f, 0.f, 0.f}, o1 = (f32x4){0.f, 0.f, 0.f, 0.f};
            slot = rs % 9;
            const LAS unsigned char* vb0 = VR + (32 * dh + qn) * AT_VPITCH + (cb + 4 * g) * 2;
#pragma unroll
            for (int kr = 0; kr < 8; ++kr) {
                v4u pw; pw.x = pk2(sc4[2 * kr][0], sc4[2 * kr][1]); pw.y = pk2(sc4[2 * kr][2], sc4[2 * kr][3]); pw.z = pk2(sc4[2 * kr + 1][0], sc4[2 * kr + 1][1]); pw.w = pk2(sc4[2 * kr + 1][2], sc4[2 * kr + 1][3]);
                const bf16x8 pf = __builtin_bit_cast(bf16x8, pw);
                const LAS unsigned char* vp = vb0 + slot * 128;
                const v2u lo0 = *(const LAS v2u*)vp, hi0 = *(const LAS v2u*)(vp + 32), lo1 = *(const LAS v2u*)(vp + 16 * AT_VPITCH), hi1 = *(const LAS v2u*)(vp + 16 * AT_VPITCH + 32);
                o0 = __builtin_amdgcn_mfma_f32_16x16x32_bf16(__builtin_bit_cast(bf16x8, ((v4u){lo0.x, lo0.y, hi0.x, hi0.y})), pf, o0, 0, 0, 0);
                o1 = __builtin_amdgcn_mfma_f32_16x16x32_bf16(__builtin_bit_cast(bf16x8, ((v4u){lo1.x, lo1.y, hi1.x, hi1.y})), pf, o1, 0, 0, 0);
                slot = (slot == 8) ? 0 : slot + 1;
            }
            py0 = (v2u){pk2(o0[0] * inv, o0[1] * inv), pk2(o0[2] * inv, o0[3] * inv)}; py1 = (v2u){pk2(o1[0] * inv, o1[1] * inv), pk2(o1[2] * inv, o1[3] * inv)};
            pop = obase + tokq * opitch + h * 64 + 32 * dh + 4 * g;
            if (newrow) { const int ns = nrow % 9; *(LAS v4u*)(KR + ns * 8192 + kdst) = pk; *(LAS v4u*)(VR + ns * 128 + vdst) = pv; have = nrow; }
            __syncthreads();
        }
        *(v2u*)pop = py0; *(v2u*)(pop + 16) = py1;
    }
    __syncthreads();
}
__device__ __forceinline__ bf16x8 lds_gather8(const LAS bf16* p, int stride) {
    unsigned short e[8];
#pragma unroll
    for (int j = 0; j < 8; ++j) e[j] = p[j * stride];
    v4u w; w.x = e[0] | ((unsigned)e[1] << 16); w.y = e[2] | ((unsigned)e[3] << 16); w.z = e[4] | ((unsigned)e[5] << 16); w.w = e[6] | ((unsigned)e[7] << 16);
    return __builtin_bit_cast(bf16x8, w);
}
constexpr int FA_PITCH = 136, FB_PITCH = 264;
__device__ __forceinline__ void fft_a2_phase(const Frame& F0, const Args& args) {
    const Frame F = fresh(F0);
    const int tid = F.tid, lane = F.lane, wave = F.wave, nl = lane & 31, hh = lane >> 5;
    LAS bf16* GT = (LAS bf16*)(F.lds + RING_OFF);
    LAS bf16* FAL = (LAS bf16*)(F.lds + RING_OFF + 65536);
    const bf16* PROJ = WSP(bf16, WS_PROJ); const bf16* FA = WSP(bf16, WS_FA); const f32x2* TW = WSP(f32x2, WS_TW); bf16* ZP = WSP(bf16, WS_U);
    __syncthreads();
    for (int i = tid; i < 2048; i += 512) { const int r = i >> 4, c = i & 15; *(LAS v4u*)(FAL + r * FA_PITCH + 8 * c) = *(const v4u*)(FA + r * 128 + 8 * c); }
    for (int un = F.vcu; un < 1024; un += F.G) {
        const int b = un >> 8, t2 = (un >> 1) & 127, half = un & 1;
        __syncthreads();
        {
            v4u v[8];
#pragma unroll
            for (int i = 0; i < 8; ++i) { const int idx = tid + 512 * i, k = idx >> 5, c = idx & 31, part = k >> 6, t1 = k & 63;
                v[i] = *(const v4u*)(PROJ + ((size_t)b * T + 128 * t1 + t2) * PROJ_LD + G_OFF + part * 512 + half * 256 + 8 * c); }
#pragma unroll
            for (int i = 0; i < 8; ++i) { const int idx = tid + 512 * i; *(LAS v4u*)(GT + (size_t)idx * 8) = v[i]; }
        }
        __syncthreads();
        {
            const int ch = 32 * wave + nl;
            bf16x8 bf[8];
#pragma unroll
            for (int s = 0; s < 8; ++s) bf[s] = lds_gather8(GT + (16 * s + 8 * hh) * 256 + ch, 256);
            f32x16 acc[4];
#pragma unroll
            for (int mt = 0; mt < 4; ++mt) { acc[mt] = (f32x16){};
#pragma unroll
                for (int s = 0; s < 8; ++s) { const bf16x8 af = *(const LAS bf16x8*)(FAL + (32 * mt + nl) * FA_PITCH + 16 * s + 8 * hh); acc[mt] = __builtin_amdgcn_mfma_f32_32x32x16_bf16(af, bf[s], acc[mt], 0, 0, 0); } }
#pragma unroll
            for (int mt = 0; mt < 2; ++mt)
#pragma unroll
                for (int rg = 0; rg < 16; ++rg) { const int k1 = 32 * mt + (rg & 3) + 8 * (rg >> 2) + 4 * hh; const f32x2 cs = TW[t2 * 64 + k1];
                    const float zr = acc[mt][rg], zi = acc[mt + 2][rg];
                    GT[k1 * 256 + ch] = (bf16)f2bf(zr * cs.x + zi * cs.y); GT[(64 + k1) * 256 + ch] = (bf16)f2bf(zi * cs.x - zr * cs.y);
                    if ((rg & 7) == 7) asm volatile("" ::: "memory"); }
        }
        __syncthreads();
#pragma unroll
        for (int i = 0; i < 8; ++i) { const int idx = tid + 512 * i, m = idx >> 5, c = idx & 31, pp = m >> 6, k1 = m & 63;
            *(v4u*)(ZP + ((size_t)(b * 64 + k1) * 128 + t2) * 1024 + pp * 512 + half * 256 + 8 * c) = *(const LAS v4u*)(GT + (size_t)idx * 8); }
    }
    __syncthreads();
}
__device__ __forceinline__ void fft_b2_phase(const Frame& F0, const Args& args) {
    const Frame F = fresh(F0);
    const int tid = F.tid, lane = F.lane, wave = F.wave, nl = lane & 31, hh = lane >> 5;
    LAS bf16* ZT = (LAS bf16*)(F.lds + RING_OFF);
    LAS bf16* FBL = (LAS bf16*)(F.lds + RING_OFF + 65536);
    bf16* PROJ = WSP(bf16, WS_PROJ); const bf16* FB = WSP(bf16, WS_FB); const bf16* ZP = WSP(bf16, WS_U);
    __syncthreads();
    for (int i = tid; i < 4096; i += 512) { const int r = i >> 5, c = i & 31; *(LAS v4u*)(FBL + r * FB_PITCH + 8 * c) = *(const v4u*)(FB + r * 256 + 8 * c); }
    const int nt = wave & 3, mh = wave >> 2;
    for (int un = F.vcu; un < 1024; un += F.G) {
        const int b = un >> 8, k1 = (un >> 2) & 63, qt = un & 3;
        __syncthreads();
        {
            v4u v[8];
#pragma unroll
            for (int i = 0; i < 8; ++i) { const int idx = tid + 512 * i, k = idx >> 4, c = idx & 15, part = k >> 7, t2 = k & 127;
                v[i] = *(const v4u*)(ZP + ((size_t)(b * 64 + k1) * 128 + t2) * 1024 + part * 512 + qt * 128 + 8 * c); }
#pragma unroll
            for (int i = 0; i < 8; ++i) { const int idx = tid + 512 * i; *(LAS v4u*)(ZT + (size_t)idx * 8) = v[i]; }
        }
        __syncthreads();
        const int ch = 32 * nt + nl;
        f32x16 acc[2];
        acc[0] = (f32x16){}; acc[1] = (f32x16){};
#pragma unroll 1
        for (int sc = 0; sc < 4; ++sc) {
            bf16x8 bf[4];
#pragma unroll
            for (int q = 0; q < 4; ++q) bf[q] = lds_gather8(ZT + (16 * (4 * sc + q) + 8 * hh) * 128 + ch, 128);
#pragma unroll
            for (int m2 = 0; m2 < 2; ++m2)
#pragma unroll
                for (int q = 0; q < 4; ++q) { const bf16x8 af = *(const LAS bf16x8*)(FBL + (64 * mh + 32 * m2 + nl) * FB_PITCH + 16 * (4 * sc + q) + 8 * hh); acc[m2] = __builtin_amdgcn_mfma_f32_32x32x16_bf16(af, bf[q], acc[m2], 0, 0, 0); }
        }
        __syncthreads();
#pragma unroll
        for (int m2 = 0; m2 < 2; ++m2)
#pragma unroll
            for (int rg = 0; rg < 16; ++rg) { const int k2 = 64 * mh + 32 * m2 + (rg & 3) + 8 * (rg >> 2) + 4 * hh; ZT[k2 * 128 + ch] = (bf16)f2bf(acc[m2][rg] * (1.0f / 1024.0f)); }
        __syncthreads();
#pragma unroll
        for (int i = 0; i < 4; ++i) { const int idx = tid + 512 * i, k2 = idx >> 4, c = idx & 15;
            *(v4u*)(PROJ + ((size_t)b * T + k1 + 64 * k2) * PROJ_LD + G_OFF + qt * 128 + 8 * c) = *(const LAS v4u*)(ZT + (size_t)idx * 8); }
    }
    __syncthreads();
}
__device__ __forceinline__ int fresh_bid() { int b = (int)blockIdx.x; asm volatile("" : "+s"(b)); return b; }
constexpr int PPL = 10, N_PHASES = 2 + PPL * DEPTH;
__global__ void __launch_bounds__(NWAVES * 64, 2) mega_fwd(Args args, int li) {
    extern __shared__ __attribute__((aligned(16))) unsigned char lds[];
    Frame F;
    F.lds = (LAS unsigned char*)lds;
    F.MISC = (volatile LAS unsigned*)(F.lds + MISC_OFF);
    F.tid = threadIdx.x; F.lane = F.tid & 63; F.wave = __builtin_amdgcn_readfirstlane(F.tid >> 6);
    F.G = gridDim.x; { const int bx = blockIdx.x; F.vcu = (F.G % 8 == 0) ? (bx % 8) * (F.G / 8) + bx / 8 : bx; }
    F.ctl = (gu32*)(args.ws + WS_CTL);
    for (int u = F.tid; u < (LDS_BYTES - LDSCTL_OFF) / 4; u += NWAVES * 64) ((LAS unsigned*)(F.lds + LDSCTL_OFF))[u] = 0u;
    __syncthreads();
    const int lo = args.ph_lo, hi = args.ph_hi;
    XcdBarrier bar; bar.bar = (unsigned*)(F.ctl + CW_BAR) + li * XCD_BAR_WORDS; bar.x = 0; bar.st = nullptr;
    if (hi - lo > 1) bar = xcd_barrier_post((unsigned*)(F.ctl + CW_BAR) + li * XCD_BAR_WORDS, F.MISC + 8);
#ifndef PHMASK
#define PHMASK 0xFFFF
#endif
#define EN(kind) ((PHMASK >> (kind)) & 1)
#define IN(k) (lo <= (k) && (k) < hi)
#define SEAM(k) do { if (IN(k) && IN((k) + 1)) xcd_barrier(bar); } while (0)

    if (EN(0) && IN(0)) { for (int rep = 0; rep < 1 + REP_C; ++rep) p0_prologue(F, args); SEAM(0); }
    for (int l = 0; l < DEPTH; ++l) {
        const int pb = 1 + PPL * l;
        bf16* U = WSP(bf16, WS_U); bf16* PROJ = WSP(bf16, WS_PROJ); bf16* GATES = WSP(bf16, WS_GATES);
        if (EN(1) && IN(pb + 0)) { if (l == 0) { for (int rep = 0; rep < (REP_R & 1); ++rep) rows_phase<0>(F, args, l); rows_phase<0>(F, args, l); } else rows_phase<1>(F, args, l); SEAM(pb + 0); }
        if (EN(2) && IN(pb + 1)) {
            pg8::Gemm g{U, U, U, WSP(bf16, WS_WP2) + (size_t)l * NP2 * 1024, nullptr, nullptr, 1024, 1024, 1024};
            pg8::StaticOrder S; S.init(NTOK, NP2, F.G, fresh_bid());
            EpiP2 E{PROJ, WSP(bf16, WS_VT), GATES, INP(8) + l * 3072};
            for (int rep = 0; rep < 1 + (REP_GS & 1 ? REP_G : 0); ++rep) pg8::gemm_phase<EpiP2, pg8::StaticOrder, true>(F.lds + RING_OFF, g, S, E, fresh(F).tid);
            SEAM(pb + 1);
        }
        if (EN(3) && IN(pb + 2)) {
            for (int rep = 0; rep < REP_M; ++rep) { if (REP_MS & 1) attn2_phase(F, args, l, WSP(bf16, WS_SCR), 512); if (REP_MS & 2) lru_conv_phase(F, args, l); if (REP_MS & 4) fft_a2_phase(F, args); if (REP_MS & 16) fft_a2_phase(F, args); }
            lru_conv_phase(F, args, l); attn2_phase(F, args, l, PROJ, PROJ_LD); fft_a2_phase(F, args); SEAM(pb + 2); }
        if (EN(4) && IN(pb + 3)) { for (int rep = 0; rep < REP_M; ++rep) { if (REP_MS & 2) lru2_phase(F, args, l, WSP(bf16, WS_SCR), 512, 0); if (REP_MS & 4) fft_b2_phase(F, args); if (REP_MS & 32) fft_b2_phase(F, args); }
            lru2_phase(F, args, l, PROJ, PROJ_LD, YR_OFF); fft_b2_phase(F, args); SEAM(pb + 3); }
        if (EN(6) && IN(pb + 4)) {
            const bf16* WP = WSP(bf16, WS_WPROJ) + (size_t)l * 3 * 1024 * 512;
            pg8::Gemm g{PROJ + Q_OFF, PROJ + YR_OFF, PROJ + G_OFF, WP, WP + 1024 * 512, WP + 2 * 1024 * 512, PROJ_LD, 512, 512};
            pg8::MergeOrder S; S.init(NTOK, 1024, F.G, fresh_bid());
            EpiMerge E{GATES, U};
            for (int rep = 0; rep < 1 + (REP_GS & 2 ? REP_G : 0); ++rep) pg8::gemm_phase<EpiMerge, pg8::MergeOrder, true>(F.lds + RING_OFF, g, S, E, fresh(F).tid);
            SEAM(pb + 4);
        }
        if (EN(7) && IN(pb + 5)) {
            pg8::Gemm g{U, U, U, WSP(bf16, WS_WOUT) + (size_t)l * 1024 * 1024, nullptr, nullptr, 1024, 1024, 1024};
            pg8::StaticOrder S; S.init(NTOK, 1024, F.G, fresh_bid());
            EpiResid E{l == 0 ? INP(0) : (const float*)args.out, args.out, WSP(float, WS_MOD) + (size_t)l * 4 * 6144 + 2 * 1024};
            for (int rep = 0; rep < (REP_GS & 4 ? REP_G : 0); ++rep) { EpiResid E2{E.xin, WSP(float, WS_GATES), E.gt}; pg8::gemm_phase<EpiResid, pg8::StaticOrder, true>(F.lds + RING_OFF, g, S, E2, fresh(F).tid); }
            pg8::gemm_phase<EpiResid, pg8::StaticOrder, true>(F.lds + RING_OFF, g, S, E, fresh(F).tid);
            SEAM(pb + 5);
        }
        if (EN(8) && IN(pb + 6)) { if (REP_R & 2) router_phase(F, args, l, 2 + l); router_phase(F, args, l, l); SEAM(pb + 6); }
        if (EN(9) && IN(pb + 7)) { if (REP_R & 4) gather_phase(F, args, l); gather_phase(F, args, l); SEAM(pb + 7); }
        if (EN(10) && IN(pb + 8)) {
            moe_tilebase(F, args, l);
            pg8::Gemm g{PROJ, PROJ, PROJ, WSP(bf16, WS_WG1), nullptr, nullptr, 1024, 1024, 1024};
            pg8::MoeOrder S{(const LAS int*)(F.lds + MISC_OFF + 64), F.G, fresh_bid()};
            EpiSwiGLU E{WSP(bf16, WS_H)};
            for (int rep = 0; rep < 1 + (REP_GS & 8 ? REP_G : 0); ++rep) pg8::gemm_phase<EpiSwiGLU, pg8::MoeOrder, true>(F.lds + RING_OFF, g, S, E, fresh(F).tid);
            SEAM(pb + 8);
        }
        if (EN(11) && IN(pb + 9)) {
            moe_tilebase(F, args, l);
            const bf16* H = WSP(bf16, WS_H);
            pg8::Gemm g{H, H, H, WSP(bf16, WS_WD), nullptr, nullptr, 512, 512, 512};
            pg8::MoeOrder S{(const LAS int*)(F.lds + MISC_OFF + 64), F.G, fresh_bid()};
            EpiYE E{PROJ};
            for (int rep = 0; rep < 1 + (REP_GS & 16 ? REP_G : 0); ++rep) pg8::gemm_phase<EpiYE, pg8::MoeOrder, true>(F.lds + RING_OFF, g, S, E, fresh(F).tid);
            SEAM(pb + 9);
        }
    }
    if (EN(12) && IN(N_PHASES - 1)) rows_phase<2>(F, args, DEPTH);
#undef IN
#undef SEAM
}

#ifndef MK_MODE
#define MK_MODE 0
#endif
extern "C" void kernel_launch(void* const* d_in, const int* in_sizes, int n_in, void* d_out, int out_size, void* d_ws, size_t ws_size, hipStream_t stream) {
    static int grid = 0;
    if (grid == 0) {
        if (n_in != 27 || in_sizes[0] != NTOK * D || out_size != NTOK * D || ws_size < WS_END) { fprintf(stderr, "kernel_launch: unexpected shapes (n_in %d, in0 %d, out %d, ws %zu < %zu)\n", n_in, n_in > 0 ? in_sizes[0] : -1, out_size, ws_size, (size_t)WS_END); grid = -1; return; }
        int dev = 0, cus = 0;
        if (hipGetDevice(&dev) != hipSuccess || hipDeviceGetAttribute(&cus, hipDeviceAttributeMultiprocessorCount, dev) != hipSuccess) { grid = -1; return; }
        if (hipFuncSetAttribute((const void*)mega_fwd, hipFuncAttributeMaxDynamicSharedMemorySize, LDS_BYTES) != hipSuccess) { fprintf(stderr, "kernel_launch: hipFuncSetAttribute failed\n"); grid = -1; return; }
        (void)hipGetLastError();
        grid = cus;
    }
    if (grid < 0) return;
    if (hipMemsetAsync((char*)d_ws + WS_CTL, 0, CTL_ZERO_BYTES, stream) != hipSuccess) return;
    Args a{};
    for (int i = 0; i < 27; ++i) a.in[i] = (const float*)d_in[i];
    a.out = (float*)d_out; a.ws = (unsigned char*)d_ws;
#if MK_MODE == 0
    a.ph_lo = 0; a.ph_hi = N_PHASES;
    hipLaunchKernelGGL(mega_fwd, dim3(grid), dim3(NWAVES * 64), LDS_BYTES, stream, a, 0);
#else
    for (int p = 0; p < N_PHASES; ++p) { a.ph_lo = p; a.ph_hi = p + 1; hipLaunchKernelGGL(mega_fwd, dim3(grid), dim3(NWAVES * 64), LDS_BYTES, stream, a, 0); }
#endif
}
```

```cpp
#include <hip/hip_runtime.h>
#include <cstdio>
#include <cstdint>
namespace pg8 {
#define PG8_LAS __attribute__((address_space(3)))
typedef unsigned short bf16_t;
typedef short bf16x8 __attribute__((ext_vector_type(8)));
typedef float f32x4 __attribute__((ext_vector_type(4)));
typedef unsigned u32x4 __attribute__((ext_vector_type(4)));
typedef unsigned u32x2 __attribute__((ext_vector_type(2)));
constexpr int BM = 256, BK = 64, HALF = 128, HTB = HALF * BK * 2  , STAGE_BYTES = 8 * HTB, NXCD = 8, WGM = 8;

__host__ __device__ __forceinline__ int lds_byte(int r, int c) { const int st = (r >> 4) * 2 + (c >> 5), rr = r & 15, cc = c & 31, ob = rr * 64 + cc * 2; return st * 1024 + (ob ^ (((ob >> 9) & 1) << 5)); }
__host__ __device__ __forceinline__ void stage_rc(int b, int& R, int& C) { const int st = b / 1024, sb = b % 1024, swz = sb ^ (((sb >> 9) & 1) << 5); R = (st >> 1) * 16 + swz / 64; C = (st & 1) * 32 + (swz % 64) / 2; }
__host__ __device__ __forceinline__ int perm32(int rho) { const int n = rho >> 4, i = rho & 15; return 8 * (i >> 2) + 4 * n + (i & 3); }

struct Unit { int pm, pn, bt, z, gbase, gcnt; };
struct Gemm { const bf16_t* A0; const bf16_t* A1; const bf16_t* A2; const bf16_t* B0; const bf16_t* B1; const bf16_t* B2; int lda, ldb, K; };

__device__ __forceinline__ unsigned cvt_pk_bf16(float lo, float hi) { unsigned r; asm volatile("v_cvt_pk_bf16_f32 %0, %1, %2" : "=v"(r) : "v"(lo), "v"(hi)); return r; }

struct StaticOrder {
    int nM, nN, nwg, G, c;
    __device__ void init(int M, int N, int G_, int c_) { nM = M / BM; nN = N / BM; nwg = nM * nN; G = G_; c = c_; }
    __device__ __forceinline__ bool tile(long L, Unit& u) const {
        if (L >= nwg) return false;
        int wgid = (int)L; { const int q = nwg / NXCD, r = nwg % NXCD, xcd = wgid % NXCD, off = wgid / NXCD; wgid = (xcd < r ? xcd * (q + 1) : r * (q + 1) + (xcd - r) * q) + off; }
        const int nig = WGM * nN, gid = wgid / nig, fm = gid * WGM, gsz = (nM - fm) < WGM ? (nM - fm) : WGM;
        u.pm = fm + ((wgid % nig) % gsz); u.pn = (wgid % nig) / gsz; u.bt = u.pn; u.z = 0; u.gbase = 0; u.gcnt = 0; return true;
    }
    __device__ __forceinline__ bool next(int i, Unit& u) const { return tile((long)i * G + c, u); }
};
struct MergeOrder : StaticOrder {
    __device__ __forceinline__ bool next(int i, Unit& u) const { const int t = i / 3; if (!tile((long)t * G + c, u)) return false; u.z = i - 3 * t; return true; }
};
struct MoeOrder {
    const PG8_LAS int* tb; int G, c;
    __device__ __forceinline__ bool next(int i, Unit& u) const {
        const int L = i * G + c; const int nt = tb[32]; if (L >= nt * 4) return false;
        const int t = L >> 2, j = L & 3; int e = 0;
#pragma unroll 1
        for (int k = 1; k < 32; ++k) e += (tb[k] <= t) ? 1 : 0;
        const int tl = t - tb[e];
        u.pm = t; u.pn = j; u.bt = e * 4 + j; u.z = 0; u.gbase = e * 32768 + 256 * tl; u.gcnt = tb[33 + e] - 256 * tl; return true;
    }
};

template <class Epi, class Sched, bool ALIGN_EPI, bool GATHER = false>
__device__ __forceinline__ void gemm_phase(PG8_LAS unsigned char* lds, const Gemm g, const Sched& S, const Epi& E, const int tid, const PG8_LAS int* rowmap = nullptr) {
    const int wid = __builtin_amdgcn_readfirstlane(tid >> 6), lane = tid & 63, wr = wid >> 2, wc = wid & 3, fr = lane & 15, fq = lane >> 4;
    const int K = g.K, nt = K / BK;
    unsigned voffA[2], voffB[2]; int gR[2];
#pragma unroll
    for (int i = 0; i < 2; ++i) { int R, C; stage_rc(tid * 16 + i * 8192, R, C); const int Rb = Epi::PERM ? ((R & ~31) + perm32(R & 31)) : R;
        voffA[i] = GATHER ? (unsigned)C * 2u : (unsigned)(R * g.lda + C) * 2u; voffB[i] = (unsigned)(Rb * g.ldb + C) * 2u; gR[i] = R; }
    unsigned offC[2][2], offN[2][2];
#define PG8_GOFF(dst, ui_) do { _Pragma("unroll") for (int h_ = 0; h_ < 2; ++h_) _Pragma("unroll") for (int i_ = 0; i_ < 2; ++i_) dst[h_][i_] = (unsigned)rowmap[(ui_) * 256 + 128 * h_ + gR[i_]] * (unsigned)(g.lda * 2) + voffA[i_]; } while (0)
    const size_t kstep = (size_t)(BK * 2);
    const size_t hstepA = (size_t)HALF * g.lda * 2, hstepB = (size_t)HALF * g.ldb * 2;
    const size_t tstepA = 2 * hstepA, tstepB = 2 * hstepB;
    const unsigned ldsw = (unsigned)wid * 1024u;
    const int aoff = lds_byte(wr * 64 + fr, fq * 8), boff = lds_byte(wc * 32 + fr, fq * 8);
#define PG8_SA(b, h) (((b) * 2 + (h)) * HTB)
#define PG8_SB(b, h) ((4 + (b) * 2 + (h)) * HTB)
#define PG8_STAGE(bufoff, gbase, voff) do { _Pragma("unroll") for (int _i = 0; _i < 2; ++_i) \
        __builtin_amdgcn_global_load_lds((const unsigned*)((const char*)(gbase) + (voff)[_i]), (PG8_LAS unsigned*)(lds + (bufoff) + ldsw + _i * 8192), 16, 0, 0); } while (0)
#define PG8_STAGE_A(bufoff, gbase, h, nf) do { _Pragma("unroll") for (int _i = 0; _i < 2; ++_i) { const unsigned o_ = GATHER ? ((nf) ? offN[h][_i] : offC[h][_i]) : (voffA[_i] + (unsigned)((h) * hstepA)); \
        __builtin_amdgcn_global_load_lds((const unsigned*)((const char*)(gbase) + o_), (PG8_LAS unsigned*)(lds + (bufoff) + ldsw + _i * 8192), 16, 0, 0); } } while (0)
#define PG8_LDA(dst, b, h) do { _Pragma("unroll") for (int m = 0; m < 4; ++m) _Pragma("unroll") for (int k = 0; k < 2; ++k) dst[m][k] = *(const PG8_LAS bf16x8*)(lds + PG8_SA(b, h) + aoff + m * 2048 + k * 1024); } while (0)
#define PG8_LDB(dst, b, h) do { _Pragma("unroll") for (int n = 0; n < 2; ++n) _Pragma("unroll") for (int k = 0; k < 2; ++k) dst[n][k] = *(const PG8_LAS bf16x8*)(lds + PG8_SB(b, h) + boff + n * 2048 + k * 1024); } while (0)
#define PG8_MMA(ai, bj, At, Bt) do { __builtin_amdgcn_s_setprio(1); _Pragma("unroll") for (int m = 0; m < 4; ++m) _Pragma("unroll") for (int n = 0; n < 2; ++n) _Pragma("unroll") for (int k = 0; k < 2; ++k) \
        acc[ai][bj][m][n] = __builtin_amdgcn_mfma_f32_16x16x32_bf16(Bt[n][k], At[m][k], acc[ai][bj][m][n], 0, 0, 0); __builtin_amdgcn_s_setprio(0); } while (0)
#define PG8_WAIT_V(n) asm volatile("s_waitcnt vmcnt(" #n ")" ::: "memory")
#define PG8_WAIT_L(n) asm volatile("s_waitcnt lgkmcnt(" #n ")" ::: "memory")
#define PG8_BAR __builtin_amdgcn_s_barrier()
#define PG8_SCHED __builtin_amdgcn_sched_barrier(0)
#define PG8_APTR(u) (GATHER ? (const char*)g.A0 : (const char*)((u).z == 0 ? g.A0 : ((u).z == 1 ? g.A1 : g.A2)) + (size_t)(u).pm * tstepA)
#define PG8_BPTR(u) ((const char*)((u).z == 0 ? g.B0 : ((u).z == 1 ? g.B1 : g.B2)) + (size_t)(u).bt * tstepB)
    Unit cur, nxt; int ui = 0;
    if (!S.next(0, cur)) return;
    f32x4 acc[2][2][4][2];
#pragma unroll
    for (int a = 0; a < 2; ++a)
#pragma unroll
        for (int b = 0; b < 2; ++b)
#pragma unroll
            for (int m = 0; m < 4; ++m)
#pragma unroll
                for (int n = 0; n < 2; ++n) acc[a][b][m][n] = (f32x4){0.f, 0.f, 0.f, 0.f};
    bf16x8 At[4][2], B0[2][2], B1[2][2];
    const char* cA = PG8_APTR(cur); const char* cB = PG8_BPTR(cur);
    if constexpr (GATHER) { PG8_GOFF(offC, 0); PG8_GOFF(offN, 0); }
    PG8_STAGE(PG8_SB(0, 0), cB, voffB); PG8_STAGE(PG8_SB(0, 1), cB + hstepB, voffB); PG8_STAGE_A(PG8_SA(0, 0), cA, 0, false); PG8_STAGE_A(PG8_SA(0, 1), cA, 1, false);
    if (wr == 1) PG8_BAR;
    PG8_WAIT_V(2); PG8_BAR;
    PG8_STAGE(PG8_SB(1, 0), cB + kstep, voffB); PG8_STAGE_A(PG8_SA(1, 0), cA + kstep, 0, false); PG8_STAGE(PG8_SB(1, 1), cB + hstepB + kstep, voffB);
    PG8_WAIT_V(6); PG8_BAR;
    for (;;) {
        const bool has_next = S.next(ui + 1, nxt);
        const char* nA = has_next ? PG8_APTR(nxt) : cA; const char* nB = has_next ? PG8_BPTR(nxt) : cB;
        if constexpr (GATHER) { if (has_next) { PG8_GOFF(offN, ui + 1); } else { _Pragma("unroll") for (int h_ = 0; h_ < 2; ++h_) _Pragma("unroll") for (int i_ = 0; i_ < 2; ++i_) offN[h_][i_] = offC[h_][i_]; } }
        for (int t = 0; t < nt; t += 2) {
            const bool last = (t == nt - 2);
            const char* a1 = cA + (size_t)(t + 1) * kstep;
            const char* a2 = last ? nA : cA + (size_t)(t + 2) * kstep; const char* b2 = last ? nB : cB + (size_t)(t + 2) * kstep;
            const char* a3 = a2 + kstep; const char* b3 = b2 + kstep;
            PG8_LDB(B0, 0, 0); PG8_LDB(B1, 0, 1); PG8_SCHED; PG8_LDA(At, 0, 0); PG8_STAGE_A(PG8_SA(1, 1), a1, 1, false);
            PG8_WAIT_V(8); PG8_WAIT_L(0); PG8_BAR; PG8_MMA(0, 0, At, B0); PG8_MMA(0, 1, At, B1); PG8_BAR; PG8_SCHED;
            PG8_LDA(At, 0, 1); PG8_STAGE(PG8_SB(0, 0), b2, voffB); PG8_STAGE(PG8_SB(0, 1), b2 + hstepB, voffB); PG8_STAGE_A(PG8_SA(0, 0), a2, 0, last);
            PG8_WAIT_V(8); PG8_WAIT_L(0); PG8_BAR; PG8_MMA(1, 0, At, B0); PG8_MMA(1, 1, At, B1); PG8_BAR; PG8_SCHED;
            PG8_LDB(B0, 1, 0); PG8_LDB(B1, 1, 1); PG8_SCHED; PG8_LDA(At, 1, 0); PG8_STAGE_A(PG8_SA(0, 1), a2, 1, last);
            PG8_WAIT_V(8); PG8_WAIT_L(0); PG8_BAR; PG8_MMA(0, 0, At, B0); PG8_MMA(0, 1, At, B1); PG8_BAR; PG8_SCHED;
            PG8_LDA(At, 1, 1); PG8_STAGE(PG8_SB(1, 0), b3, voffB); PG8_STAGE(PG8_SB(1, 1), b3 + hstepB, voffB); PG8_STAGE_A(PG8_SA(1, 0), a3, 0, last);
            PG8_WAIT_V(8); PG8_WAIT_L(0); PG8_BAR; PG8_MMA(1, 0, At, B0); PG8_MMA(1, 1, At, B1); PG8_BAR; PG8_SCHED;
        }
        if constexpr (ALIGN_EPI) { if (wr == 0) PG8_BAR; }
        E(acc, cur, wr, wc, fr, fq);
        if (!has_next) break;
#pragma unroll
        for (int a = 0; a < 2; ++a)
#pragma unroll
            for (int b = 0; b < 2; ++b)
#pragma unroll
                for (int m = 0; m < 4; ++m)
#pragma unroll
                    for (int n = 0; n < 2; ++n) acc[a][b][m][n] = (f32x4){0.f, 0.f, 0.f, 0.f};
        cur = nxt; cA = nA; cB = nB; ++ui;
        if constexpr (GATHER) { _Pragma("unroll") for (int h_ = 0; h_ < 2; ++h_) _Pragma("unroll") for (int i_ = 0; i_ < 2; ++i_) offC[h_][i_] = offN[h_][i_]; }
        if constexpr (ALIGN_EPI) { if (wr == 1) PG8_BAR; }
    }
    PG8_WAIT_V(0);
    if constexpr (!ALIGN_EPI) { if (wr == 0) PG8_BAR; }
    PG8_BAR;
#undef PG8_SA
#undef PG8_SB
#undef PG8_STAGE
#undef PG8_LDA
#undef PG8_LDB
#undef PG8_MMA
#undef PG8_WAIT_V
#undef PG8_WAIT_L
#undef PG8_BAR
#undef PG8_SCHED
#undef PG8_APTR
#undef PG8_STAGE_A
#undef PG8_GOFF
#undef PG8_BPTR
}
}
constexpr int NWAVES = 8;
constexpr int NB = 4, T = 8192, D = 1024, NTOK = NB * T, DEPTH = 2;
constexpr int PROJ_LD = 3072, Q_OFF = 0, K_OFF = 512, XR_OFF = 1024, YR_OFF = 1536, G_OFF = 2048;
constexpr int GATES_LD = 3072;
constexpr int NP2 = 6656;
constexpr int NEXP = 32, XS_ROWS = 73728;
constexpr int LRU_CH = 32, LRU_NCH = T / LRU_CH;
constexpr float EPS = 1e-6f;

constexpr size_t MiB = 1u << 20;
constexpr size_t WS_CTL = 0, CTL_ZERO_BYTES = 1 * MiB;
constexpr size_t WS_MOD = 1 * MiB;
constexpr size_t WS_FA = WS_MOD + 256 * 1024;
constexpr size_t WS_FB = WS_FA + 32 * 1024;
constexpr size_t WS_TW = WS_FB + 64 * 1024;
constexpr size_t WS_WL = 2 * MiB;
constexpr size_t WS_TOKW = 3 * MiB;
constexpr size_t WS_TOKROW = WS_TOKW + 256 * 1024;
constexpr size_t WS_PERM = 4 * MiB;
constexpr size_t WS_LSUM = 8 * MiB;
constexpr size_t WS_LCAR = 16 * MiB;
constexpr size_t WS_WP2 = 20 * MiB;
constexpr size_t WS_WPROJ = 46 * MiB;
constexpr size_t WS_WOUT = 52 * MiB;
constexpr size_t WS_U = 56 * MiB;
constexpr size_t WS_VT = 120 * MiB;
constexpr size_t WS_PROJ = 152 * MiB;
constexpr size_t WS_GATES = 344 * MiB;
constexpr size_t WS_WG1 = WS_GATES, WS_WD = WS_GATES + 64 * MiB, WS_H = WS_GATES + 96 * MiB;
constexpr size_t WS_XC = 536 * MiB;
constexpr size_t WS_END = 568 * MiB;
constexpr size_t WS_SCR = 568 * MiB;
#ifndef REP_G
#define REP_G 0
#endif
#ifndef REP_C
#define REP_C 0
#endif
#ifndef REP_B
#define REP_B 0
#endif
#ifndef REP_R
#define REP_R 0
#endif
#ifndef REP_GS
#define REP_GS 31
#endif
#ifndef REP_MS
#define REP_MS 15
#endif
#ifndef REP_M
#define REP_M 0
#endif
static_assert(WS_H + (size_t)XS_ROWS * 512 * 2 <= WS_END, "ws map");
constexpr int CW_BAR = 4096;
constexpr int CW_ECNT = 16384;

constexpr int LDS_BYTES = 163840;
constexpr int RING_OFF = 0, RING_BYTES = 131072;
constexpr int XTRA_OFF = RING_BYTES;
constexpr int LDSCTL_OFF = LDS_BYTES - 512, MISC_OFF = LDSCTL_OFF + 64;

#define GAS __attribute__((address_space(1)))
#define LAS __attribute__((address_space(3)))
typedef unsigned short bf16;
typedef unsigned v4u __attribute__((ext_vector_type(4)));
typedef unsigned v2u __attribute__((ext_vector_type(2)));
typedef float f32x4 __attribute__((ext_vector_type(4)));
typedef float f32x2 __attribute__((ext_vector_type(2)));
typedef float f32x16 __attribute__((ext_vector_type(16)));
typedef short bf16x8 __attribute__((ext_vector_type(8)));
typedef short bf16x4 __attribute__((ext_vector_type(4)));
typedef GAS unsigned gu32;
#define RLX_AGENT __ATOMIC_RELAXED, __HIP_MEMORY_SCOPE_AGENT
#define LDS_WAIT() asm volatile("s_waitcnt lgkmcnt(0)" ::: "memory")
#define VM_WAIT() asm volatile("s_waitcnt vmcnt(0)" ::: "memory")
typedef __bf16 hwbf16x2 __attribute__((ext_vector_type(2)));
__device__ __forceinline__ unsigned pk2(float lo, float hi) { f32x2 v = {lo, hi}; hwbf16x2 b = __builtin_convertvector(v, hwbf16x2); return __builtin_bit_cast(unsigned, b); }
__device__ __forceinline__ unsigned f2bf(float f) { return pk2(f, 0.f) & 0xffffu; }
__device__ __forceinline__ float bflo(unsigned w) { return __builtin_bit_cast(float, w << 16); }
__device__ __forceinline__ float bfhi(unsigned w) { return __builtin_bit_cast(float, w & 0xffff0000u); }
__device__ __forceinline__ float bf2f(unsigned short h) { return __builtin_bit_cast(float, (unsigned)h << 16); }
__device__ __forceinline__ float sigmoidf(float v) { return 1.0f / (1.0f + __expf(-v)); }
__device__ __forceinline__ float fsigmoid(float v) { return __builtin_amdgcn_rcpf(1.0f + __expf(-v)); }
__device__ __forceinline__ float wave_sum(float v) {
#pragma unroll
    for (int o = 1; o < 64; o <<= 1) v += __shfl_xor(v, o);
    return v;
}
#define XB_TMO      128
#define XB_XCNT(j)  (256  + 64 * (j))
#define XB_XSUB(j)  (1280 + 64 * (j))
#define XB_XGEN(j)  (2304 + 64 * (j))
#define XB_TOP      3328
#define XB_TOPGEN   3392
#define XCD_BAR_WORDS 3456
#define XB_SPIN_CAP (1u << 18)

__device__ __forceinline__ unsigned xb_ld(unsigned* p)              { return __hip_atomic_load(p, __ATOMIC_RELAXED, __HIP_MEMORY_SCOPE_AGENT); }
__device__ __forceinline__ unsigned xb_add(unsigned* p, unsigned v) { return __hip_atomic_fetch_add(p, v, __ATOMIC_RELAXED, __HIP_MEMORY_SCOPE_AGENT); }
__device__ __forceinline__ unsigned xb_xcc_id() { return (unsigned)__builtin_amdgcn_s_getreg((3 << 11) | 20) & 0xFu; }
#define XB_SPIN(cond, bar) do { unsigned _sp = 0; while (cond) { __builtin_amdgcn_s_sleep(1); \
    if ((++_sp & 255u) == 0u) { if (xb_ld(&(bar)[XB_TMO])) break; if (_sp > XB_SPIN_CAP) { atomicAdd(&(bar)[XB_TMO], 1u); break; } } } } while (0)

struct XcdBarrier {
    unsigned* bar; unsigned x;
    volatile LAS unsigned* st;
};

__device__ __forceinline__ XcdBarrier xcd_barrier_post(unsigned* bar, volatile LAS unsigned* st) {
    XcdBarrier b; b.bar = bar; b.x = xb_xcc_id(); b.st = st;
    if (threadIdx.x == 0) (void)xb_add(&bar[XB_XCNT(b.x)], 1u);
    return b;
}
__device__ __forceinline__ void xcd_barrier_complete(unsigned* bar, unsigned x, unsigned& nloc, unsigned& nx) {
    const unsigned G = gridDim.x * gridDim.y * gridDim.z;
    unsigned sum, cnt, mine, sp = 0u;
    for (;;) {
        sum = 0u; cnt = 0u; mine = 0u;
#pragma unroll
        for (unsigned j = 0; j < 16; ++j) { const unsigned c = xb_ld(&bar[XB_XCNT(j)]); sum += c; cnt += (c > 0u) ? 1u : 0u; mine = (j == x) ? c : mine; }
        if (sum == G) break;
        __builtin_amdgcn_s_sleep(1);
        if ((++sp & 255u) == 0u) { if (xb_ld(&bar[XB_TMO])) break; if (sp > XB_SPIN_CAP) { atomicAdd(&bar[XB_TMO], 1u); break; } }
    }
    nloc = mine > 0u ? mine : 1u; nx = cnt > 0u ? cnt : 1u;
}

__device__ __forceinline__ void xcd_barrier(const XcdBarrier& b) {
    asm volatile("s_waitcnt vmcnt(0)" ::: "memory");
    __syncthreads();
    if (threadIdx.x == 0) {
        unsigned* bar = b.bar;
        __builtin_amdgcn_s_waitcnt(0);
        unsigned nloc = b.st[0], nx = b.st[1];
        if (nloc == 0u) { xcd_barrier_complete(bar, b.x, nloc, nx); b.st[0] = nloc; b.st[1] = nx; }
        const unsigned old = xb_add(&bar[XB_XSUB(b.x)], 1u);
        const unsigned gen = old / nloc;
        if (old + 1u == (gen + 1u) * nloc) {
            __builtin_amdgcn_fence(__ATOMIC_RELEASE, "agent");
            asm volatile("s_waitcnt vmcnt(0)" ::: "memory");
            const unsigned og = xb_add(&bar[XB_TOP], 1u);
            const unsigned tg = og / nx;
            if (og + 1u == (tg + 1u) * nx) xb_add(&bar[XB_TOPGEN], 1u);
            else XB_SPIN(xb_ld(&bar[XB_TOPGEN]) == tg, bar);
            __builtin_amdgcn_fence(__ATOMIC_ACQUIRE, "agent");
            xb_add(&bar[XB_XGEN(b.x)], 1u);
            asm volatile("s_waitcnt vmcnt(0)" ::: "memory");
        } else {
            XB_SPIN(xb_ld(&bar[XB_XGEN(b.x)]) == gen, bar);
            __builtin_amdgcn_fence(__ATOMIC_ACQUIRE, "agent");
            asm volatile("s_waitcnt vmcnt(0)" ::: "memory");
        }
    }
    __syncthreads();
}

struct Args { const float* in[27]; float* out; unsigned char* ws; int ph_lo, ph_hi; };
struct Frame {
    LAS unsigned char* lds;
    volatile LAS unsigned* MISC;
    gu32* ctl;
    int tid, lane, wave, vcu, G;
};
__device__ __forceinline__ Frame fresh(const Frame& F) {
    Frame N = F; int t = F.tid; asm volatile("" : "+v"(t)); N.tid = t; N.lane = t & 63; N.wave = __builtin_amdgcn_readfirstlane(t >> 6);
    int v = F.vcu; asm volatile("" : "+s"(v)); N.vcu = v; int g = F.G; asm volatile("" : "+s"(g)); N.G = g; return N;
}
#define WSP(T_, off) ((T_*)(args.ws + (off)))
#define INP(i) (args.in[i])

struct TrItem { const float* W; int ldw, k0, n0; bf16* dst; int ldd; };
__device__ __forceinline__ void tr_load(const TrItem& it, f32x4 (&v)[8], int lane) {
    const float* p = it.W + (size_t)(it.k0 + (lane >> 3)) * it.ldw + it.n0 + 4 * (lane & 7);
#pragma unroll
    for (int i = 0; i < 8; ++i) v[i] = *(const f32x4*)(p + (size_t)(8 * i) * it.ldw);
}
__device__ __forceinline__ void tr_finish(const TrItem& it, const f32x4 (&v)[8], LAS float* scr, int lane) {
#pragma unroll
    for (int i = 0; i < 8; ++i) { LAS float* d = scr + (8 * i + (lane >> 3)) * 33 + 4 * (lane & 7); d[0] = v[i].x; d[1] = v[i].y; d[2] = v[i].z; d[3] = v[i].w; }
    LDS_WAIT(); asm volatile("" ::: "memory");
    const int c = lane & 7;
#pragma unroll
    for (int j = 0; j < 4; ++j) { const int n = (lane >> 3) + 8 * j; const LAS float* s = scr + (8 * c) * 33 + n;
        v4u o; o.x = pk2(s[0 * 33], s[1 * 33]); o.y = pk2(s[2 * 33], s[3 * 33]); o.z = pk2(s[4 * 33], s[5 * 33]); o.w = pk2(s[6 * 33], s[7 * 33]);
        *(v4u*)(it.dst + (size_t)n * it.ldd + it.k0 + 8 * c) = o; }
    LDS_WAIT(); asm volatile("" ::: "memory");
}
__device__ __forceinline__ void transpose_item(const float* W, int ldw, int k0, int n0, bf16* dst, int ldd, LAS float* scr, int lane) {
    const TrItem it{W, ldw, k0, n0, dst, ldd}; f32x4 v[8]; tr_load(it, v, lane); tr_finish(it, v, scr, lane);
}
__device__ __forceinline__ void p0_prologue(const Frame& F0, const Args& args) {
    const Frame F = fresh(F0);
    const int tid = F.tid, lane = F.lane, wave = F.wave;
    float* MOD = WSP(float, WS_MOD);
    {
        LAS f32x4* cact4 = (LAS f32x4*)(F.lds + RING_OFF);
        LAS float* red = (LAS float*)(F.lds + RING_OFF + 16384);
        if (F.vcu < 192) {
            const float* c = INP(1);
            for (int i = 0; i < 8; ++i) { const int idx = tid + 512 * i, b = idx >> 10, k = idx & 1023; const float v = c[b * 1024 + k]; ((LAS float*)cact4)[k * 4 + b] = v * sigmoidf(v); }
        }
        __syncthreads();
        for (int u = F.vcu; u < 192; u += F.G) {
            const int l = u / 96, j0 = (u % 96) * 64;
            const float* aw = INP(2) + (size_t)l * 1024 * 6144 + j0 + lane;
            float a0 = 0.f, a1 = 0.f, a2 = 0.f, a3 = 0.f;
#pragma unroll 8
            for (int kk = 0; kk < 128; ++kk) { const int k = 128 * wave + kk; const float wv = aw[(size_t)k * 6144]; const f32x4 c4 = cact4[k]; a0 += c4.x * wv; a1 += c4.y * wv; a2 += c4.z * wv; a3 += c4.w * wv; }
            red[(wave * 4 + 0) * 64 + lane] = a0; red[(wave * 4 + 1) * 64 + lane] = a1; red[(wave * 4 + 2) * 64 + lane] = a2; red[(wave * 4 + 3) * 64 + lane] = a3;
            __syncthreads();
            if (tid < 256) { const int b = tid >> 6, ln = tid & 63; float s = INP(3)[l * 6144 + j0 + ln];
#pragma unroll
                for (int w = 0; w < 8; ++w) s += red[(w * 4 + b) * 64 + ln];
                MOD[(size_t)(l * 4 + b) * 6144 + j0 + ln] = s; }
            __syncthreads();
        }
    }
    {
        LAS float* Tt = (LAS float*)(F.lds + RING_OFF);
        LAS float* cs = (LAS float*)(F.lds + RING_OFF + 33792);
        LAS float* sn = cs + 128;
        if (tid < 128) { cs[tid] = cospif((float)tid * (1.0f / 64.0f)); sn[tid] = sinpif((float)tid * (1.0f / 64.0f)); }
        for (int it = F.vcu; it < 128; it += F.G) {
            const int l = it >> 6, g = (it >> 4) & 3, k0 = (it & 15) * 64;
            const float* src = INP(6) + (size_t)l * 1024 * 3072 + 2560 + g * 128;
            __syncthreads();
            for (int i = 0; i < 16; ++i) { const int idx = tid + 512 * i, row = idx >> 7, cc = idx & 127; Tt[row * 129 + cc] = src[(size_t)(k0 + row) * 3072 + cc]; }
            __syncthreads();
            const int kk = tid & 63, og = wave, part = og >> 2, m0 = (og & 3) * 32;
            float acc[32];
#pragma unroll
            for (int i = 0; i < 32; ++i) acc[i] = 0.f;
            const LAS float* tab = part ? sn : cs;
#pragma unroll 2
            for (int cc = 0; cc < 128; ++cc) { const float t = Tt[kk * 129 + cc];
#pragma unroll
                for (int i = 0; i < 32; ++i) acc[i] += t * tab[((m0 + i) * cc) & 127]; }
            bf16* dst = WSP(bf16, WS_WP2) + (size_t)l * NP2 * 1024 + (size_t)(2560 + part * 512 + g * 128 + m0) * 1024 + k0 + kk;
            const float sg = part ? -1.f : 1.f;
#pragma unroll
            for (int i = 0; i < 32; ++i) dst[(size_t)i * 1024] = (bf16)f2bf(sg * acc[i]);
        }
        __syncthreads();
    }
    {
        LAS float* scr = (LAS float*)(F.lds + RING_OFF + wave * 8704);
        const int gw = F.vcu * NWAVES + wave, NGW = F.G * NWAVES;
        for (int it = gw; it < 8192; it += NGW) {
            const int l = it >> 12; int r = it & 4095;
            if (r < 1280) { const int kb = r / 80, nb = r % 80; transpose_item(INP(6) + (size_t)l * 1024 * 3072, 3072, kb * 64, nb * 32, WSP(bf16, WS_WP2) + (size_t)l * NP2 * 1024 + (size_t)(nb * 32) * 1024, 1024, scr, lane); continue; }
            r -= 1280;
            if (r < 1536) { const int kb = r / 96, nb = r % 96; transpose_item(INP(7) + (size_t)l * 1024 * 3072, 3072, kb * 64, nb * 32, WSP(bf16, WS_WP2) + (size_t)l * NP2 * 1024 + (size_t)(3584 + nb * 32) * 1024, 1024, scr, lane); continue; }
            r -= 1536;
            if (r < 768) { const int which = r >> 8, rr = r & 255, kb = rr >> 5, nb = rr & 31; const float* src = (which == 0 ? INP(17) : (which == 1 ? INP(18) : INP(19))) + (size_t)l * 512 * 1024;
                transpose_item(src, 1024, kb * 64, nb * 32, WSP(bf16, WS_WPROJ) + (size_t)(l * 3 + which) * 1024 * 512 + (size_t)(nb * 32) * 512, 512, scr, lane); continue; }
            r -= 768;
            { const int kb = r >> 5, nb = r & 31; transpose_item(INP(20) + (size_t)l * 1024 * 1024, 1024, kb * 64, nb * 32, WSP(bf16, WS_WOUT) + (size_t)l * 1024 * 1024 + (size_t)(nb * 32) * 1024, 1024, scr, lane); }
        }
    }
    {
        const int gt = F.vcu * 512 + tid, NGT = F.G * 512;
        bf16* WL = WSP(bf16, WS_WL);
        for (int idx = gt; idx < 262144; idx += NGT) {
            const int k = idx & 63, n = (idx >> 6) & 255, nb = (idx >> 14) & 7, l = idx >> 17, gate = n >> 6, j = n & 63, dir = gate >> 1, isI = gate & 1;
            const float* src = isI ? INP(14) : INP(12);
            WL[idx] = (bf16)f2bf(src[((size_t)((l * 2 + dir) * 8 + nb) * 64 + k) * 64 + j]);
        }
        bf16* FA = WSP(bf16, WS_FA);
        for (int idx = gt; idx < 16384; idx += NGT) {
            const int m = idx >> 7, k = idx & 127, k1 = m & 63, pm_ = m >> 6, t1 = k & 63, pk = k >> 6, a = (k1 * t1) & 63;
            const float c = cospif((float)a * (1.0f / 32.0f)), s = sinpif((float)a * (1.0f / 32.0f));
            FA[idx] = (bf16)f2bf(pm_ == 0 ? (pk == 0 ? c : s) : (pk == 0 ? -s : c));
        }
        bf16* FB = WSP(bf16, WS_FB);
        for (int idx = gt; idx < 32768; idx += NGT) {
            const int k2 = idx >> 8, k = idx & 255, part = k >> 7, t2 = k & 127, a = (k2 * t2) & 127;
            FB[idx] = (bf16)f2bf(part == 0 ? cospif((float)a * (1.0f / 64.0f)) : sinpif((float)a * (1.0f / 64.0f)));
        }
        f32x2* TW = WSP(f32x2, WS_TW);
        for (int idx = gt; idx < 8192; idx += NGT) {
            const int t2 = idx >> 6, k1 = idx & 63; const float x = (float)(t2 * k1) * (1.0f / 4096.0f);
            TW[idx] = (f32x2){cospif(x), sinpif(x)};
        }
    }
}

__device__ __forceinline__ void moe_tilebase(const Frame& F0, const Args& args, int l);
template <int MODE>
__device__ __forceinline__ void rows_phase(const Frame& F0, const Args& args, int l) {
    const Frame F = fresh(F0);
    const int tid = F.tid, lane = F.lane, wave = F.wave;
    const float* MOD = WSP(float, WS_MOD);
    LAS float* gsc = (LAS float*)(F.lds + RING_OFF);
    LAS float* shf = gsc + 4096;
    LAS float* gtf = shf + 4096;
    if (MODE != 0) moe_tilebase(F, args, l - 1);
    for (int i = 0; i < 8; ++i) { const int idx = tid + 512 * i, b = idx >> 10, col = idx & 1023;
        if (MODE != 2) { gsc[idx] = INP(4)[l * 1024 + col] * (1.0f + MOD[(size_t)(l * 4 + b) * 6144 + 1024 + col]); shf[idx] = MOD[(size_t)(l * 4 + b) * 6144 + col]; }
        else gsc[idx] = INP(26)[col];
        if (MODE != 0) gtf[idx] = MOD[(size_t)((l - 1) * 4 + b) * 6144 + 5 * 1024 + col]; }
    __syncthreads();
    const float* xin = (MODE == 0) ? INP(0) : args.out;
    bf16* U = WSP(bf16, WS_U);
    const bf16* YE = WSP(bf16, WS_PROJ);
    const int* tokes = WSP(int, WS_TOKROW); const float* tokw = WSP(float, WS_TOKW);
    const int gw = F.vcu * NWAVES + wave, NGW = F.G * NWAVES;
    for (int m0 = gw; m0 < NTOK; m0 += 2 * NGW) {
        f32x4 v[2][4]; v2u ya[2][4], yc[2][4]; float w0[2], w1[2];
#pragma unroll
        for (int q = 0; q < 2; ++q) { const int m = m0 + q * NGW; const f32x4* xr = (const f32x4*)(xin + (size_t)m * D) + lane;
#pragma unroll
            for (int j = 0; j < 4; ++j) v[q][j] = xr[64 * j];
            if (MODE != 0) { const int es0 = tokes[2 * m], es1 = tokes[2 * m + 1]; const int r0 = 256 * (int)F.MISC[16 + (es0 >> 16)] + (es0 & 0xffff), r1 = 256 * (int)F.MISC[16 + (es1 >> 16)] + (es1 & 0xffff); w0[q] = tokw[2 * m]; w1[q] = tokw[2 * m + 1];
                const v2u* y0 = (const v2u*)(YE + (size_t)r0 * 1024) + lane; const v2u* y1 = (const v2u*)(YE + (size_t)r1 * 1024) + lane;
#pragma unroll
                for (int j = 0; j < 4; ++j) { ya[q][j] = y0[64 * j]; yc[q][j] = y1[64 * j]; } } }
#pragma unroll
        for (int q = 0; q < 2; ++q) { const int m = m0 + q * NGW, b = m >> 13;
            if (MODE != 0) {
#pragma unroll
                for (int j = 0; j < 4; ++j) { const v2u a = ya[q][j], c = yc[q][j]; const f32x4 g = *(const LAS f32x4*)(gtf + b * 1024 + 4 * lane + 256 * j);
                    v[q][j].x += g.x * (w0[q] * bflo(a.x) + w1[q] * bflo(c.x)); v[q][j].y += g.y * (w0[q] * bfhi(a.x) + w1[q] * bfhi(c.x));
                    v[q][j].z += g.z * (w0[q] * bflo(a.y) + w1[q] * bflo(c.y)); v[q][j].w += g.w * (w0[q] * bfhi(a.y) + w1[q] * bfhi(c.y)); }
            }
            float ss = 0.f;
#pragma unroll
            for (int j = 0; j < 4; ++j) ss += (v[q][j].x * v[q][j].x + v[q][j].y * v[q][j].y) + (v[q][j].z * v[q][j].z + v[q][j].w * v[q][j].w);
            const float rstd = 1.0f / sqrtf(wave_sum(ss) * (1.0f / D) + EPS);
            if (MODE == 2) {
                f32x4* o = (f32x4*)(args.out + (size_t)m * D) + lane;
#pragma unroll
                for (int j = 0; j < 4; ++j) { const f32x4 g = *(const LAS f32x4*)(gsc + 4 * lane + 256 * j); o[64 * j] = v[q][j] * rstd * g; }
            } else {
                if (MODE == 1) { f32x4* o = (f32x4*)(args.out + (size_t)m * D) + lane;
#pragma unroll
                    for (int j = 0; j < 4; ++j) o[64 * j] = v[q][j]; }
                v2u* uo = (v2u*)(U + (size_t)m * D) + lane;
#pragma unroll
                for (int j = 0; j < 4; ++j) { const f32x4 g = *(const LAS f32x4*)(gsc + b * 1024 + 4 * lane + 256 * j), s = *(const LAS f32x4*)(shf + b * 1024 + 4 * lane + 256 * j);
                    const f32x4 u = v[q][j] * rstd * g + s; uo[64 * j] = (v2u){pk2(u.x, u.y), pk2(u.z, u.w)}; }
            }
        }
    }
}

struct EpiP2 {
    static constexpr bool PERM = true;
    bf16* proj; bf16* vt; bf16* gates; const float* gbias;
    __device__ __forceinline__ void operator()(const f32x4 (&acc)[2][2][4][2], const pg8::Unit& u, int wr, int wc, int fr, int fq) const {
        const int row0 = u.pm * 256 + wr * 64 + fr, pn = u.pn;
        if (pn == 4 || pn == 5) {
#pragma unroll
            for (int ai = 0; ai < 2; ++ai)
#pragma unroll
                for (int m = 0; m < 4; ++m) { const int row = row0 + ai * 128 + m * 16, b = row >> 13, t = row & 8191;
#pragma unroll
                    for (int bj = 0; bj < 2; ++bj)
#pragma unroll
                        for (int n = 0; n < 2; ++n) { const int col = (pn - 4) * 256 + bj * 128 + wc * 32 + 8 * fq + 4 * n; bf16* d = vt + ((size_t)(b * 512 + col)) * 8192 + t;
                            d[0] = (bf16)f2bf(acc[ai][bj][m][n][0]); d[8192] = (bf16)f2bf(acc[ai][bj][m][n][1]); d[2 * 8192] = (bf16)f2bf(acc[ai][bj][m][n][2]); d[3 * 8192] = (bf16)f2bf(acc[ai][bj][m][n][3]); } }
        } else if (pn < 14) {
            const int cbase = (pn < 4 ? pn * 256 : (pn - 2) * 256) + wc * 32 + 8 * fq; const float sc = pn < 2 ? 0.125f : 1.0f;
#pragma unroll
            for (int ai = 0; ai < 2; ++ai)
#pragma unroll
                for (int m = 0; m < 4; ++m) { bf16* rowp = proj + (size_t)(row0 + ai * 128 + m * 16) * PROJ_LD + cbase;
#pragma unroll
                    for (int bj = 0; bj < 2; ++bj) { const f32x4 v0 = acc[ai][bj][m][0] * sc, v1 = acc[ai][bj][m][1] * sc;
                        *(v4u*)(rowp + bj * 128) = (v4u){pk2(v0[0], v0[1]), pk2(v0[2], v0[3]), pk2(v1[0], v1[1]), pk2(v1[2], v1[3])}; } }
        } else {
            const int cbase = (pn - 14) * 256 + wc * 32 + 8 * fq;
            f32x4 bv[2][2];
#pragma unroll
            for (int bj = 0; bj < 2; ++bj)
#pragma unroll
                for (int n = 0; n < 2; ++n) bv[bj][n] = *(const f32x4*)(gbias + cbase + bj * 128 + 4 * n);
#pragma unroll
            for (int ai = 0; ai < 2; ++ai)
#pragma unroll
                for (int m = 0; m < 4; ++m) { bf16* rowp = gates + (size_t)(row0 + ai * 128 + m * 16) * GATES_LD + cbase;
#pragma unroll
                    for (int bj = 0; bj < 2; ++bj) { f32x4 v0 = acc[ai][bj][m][0] + bv[bj][0], v1 = acc[ai][bj][m][1] + bv[bj][1];
#pragma unroll
                        for (int e = 0; e < 4; ++e) { v0[e] = sigmoidf(v0[e]); v1[e] = sigmoidf(v1[e]); }
                        *(v4u*)(rowp + bj * 128) = (v4u){pk2(v0[0], v0[1]), pk2(v0[2], v0[3]), pk2(v1[0], v1[1]), pk2(v1[2], v1[3])}; } }
        }
    }
};
struct EpiMerge {
    static constexpr bool PERM = true;
    const bf16* gates; bf16* merged;
    __device__ __forceinline__ void operator()(const f32x4 (&acc)[2][2][4][2], const pg8::Unit& u, int wr, int wc, int fr, int fq) const {
        const int row0 = u.pm * 256 + wr * 64 + fr, cbase = u.pn * 256 + wc * 32 + 8 * fq, z = u.z;
#pragma unroll
        for (int ai = 0; ai < 2; ++ai)
#pragma unroll
            for (int m = 0; m < 4; ++m) { const size_t row = (size_t)(row0 + ai * 128 + m * 16);
#pragma unroll
                for (int bj = 0; bj < 2; ++bj) { const v4u gv = *(const v4u*)(gates + row * GATES_LD + z * 1024 + cbase + bj * 128);
                    bf16* mp = merged + row * 1024 + cbase + bj * 128;
                    f32x4 v0 = acc[ai][bj][m][0], v1 = acc[ai][bj][m][1];
                    v0[0] *= bflo(gv.x); v0[1] *= bfhi(gv.x); v0[2] *= bflo(gv.y); v0[3] *= bfhi(gv.y); v1[0] *= bflo(gv.z); v1[1] *= bfhi(gv.z); v1[2] *= bflo(gv.w); v1[3] *= bfhi(gv.w);
                    if (z > 0) { const v4u ov = *(const v4u*)mp;
                        v0[0] += bflo(ov.x); v0[1] += bfhi(ov.x); v0[2] += bflo(ov.y); v0[3] += bfhi(ov.y); v1[0] += bflo(ov.z); v1[1] += bfhi(ov.z); v1[2] += bflo(ov.w); v1[3] += bfhi(ov.w); }
                    *(v4u*)mp = (v4u){pk2(v0[0], v0[1]), pk2(v0[2], v0[3]), pk2(v1[0], v1[1]), pk2(v1[2], v1[3])}; } }
    }
};
struct EpiResid {
    static constexpr bool PERM = false;
    const float* xin; float* xout; const float* gt;
    __device__ __forceinline__ void operator()(const f32x4 (&acc)[2][2][4][2], const pg8::Unit& u, int wr, int wc, int fr, int fq) const {
        const int row0 = u.pm * 256 + wr * 64 + fr, col0 = u.pn * 256 + wc * 32 + 4 * fq, b = (u.pm * 256) >> 13;
        f32x4 gv[2][2];
#pragma unroll
        for (int bj = 0; bj < 2; ++bj)
#pragma unroll
            for (int n = 0; n < 2; ++n) gv[bj][n] = *(const f32x4*)(gt + (size_t)b * 6144 + col0 + bj * 128 + n * 16);
#pragma unroll
        for (int ai = 0; ai < 2; ++ai)
#pragma unroll
            for (int m = 0; m < 4; ++m) { const size_t off = (size_t)(row0 + ai * 128 + m * 16) * D + col0;
#pragma unroll
                for (int bj = 0; bj < 2; ++bj)
#pragma unroll
                    for (int n = 0; n < 2; ++n) { const f32x4 xv = *(const f32x4*)(xin + off + bj * 128 + n * 16); *(f32x4*)(xout + off + bj * 128 + n * 16) = xv + gv[bj][n] * acc[ai][bj][m][n]; } }
    }
};
struct EpiSwiGLU {
    static constexpr bool PERM = true;
    bf16* H;
    __device__ __forceinline__ void operator()(const f32x4 (&acc)[2][2][4][2], const pg8::Unit& u, int wr, int wc, int fr, int fq) const {
        const int row0 = u.pm * 256 + wr * 64 + fr, cbase = u.pn * 128 + wc * 32 + 8 * fq;
#pragma unroll
        for (int ai = 0; ai < 2; ++ai)
#pragma unroll
            for (int m = 0; m < 4; ++m) { f32x4 h0, h1;
#pragma unroll
                for (int e = 0; e < 4; ++e) { const float g0 = acc[ai][0][m][0][e], g1 = acc[ai][0][m][1][e]; h0[e] = g0 * sigmoidf(g0) * acc[ai][1][m][0][e]; h1[e] = g1 * sigmoidf(g1) * acc[ai][1][m][1][e]; }
                *(v4u*)(H + (size_t)(row0 + ai * 128 + m * 16) * 512 + cbase) = (v4u){pk2(h0[0], h0[1]), pk2(h0[2], h0[3]), pk2(h1[0], h1[1]), pk2(h1[2], h1[3])}; }
    }
};
struct EpiYE {
    static constexpr bool PERM = true;
    bf16* YE;
    __device__ __forceinline__ void operator()(const f32x4 (&acc)[2][2][4][2], const pg8::Unit& u, int wr, int wc, int fr, int fq) const {
        const int row0 = u.pm * 256 + wr * 64 + fr, cbase = u.pn * 256 + wc * 32 + 8 * fq;
#pragma unroll
        for (int ai = 0; ai < 2; ++ai)
#pragma unroll
            for (int m = 0; m < 4; ++m) { bf16* rowp = YE + (size_t)(row0 + ai * 128 + m * 16) * 1024 + cbase;
#pragma unroll
                for (int bj = 0; bj < 2; ++bj) { const f32x4 v0 = acc[ai][bj][m][0], v1 = acc[ai][bj][m][1];
                    *(v4u*)(rowp + bj * 128) = (v4u){pk2(v0[0], v0[1]), pk2(v0[2], v0[3]), pk2(v1[0], v1[1]), pk2(v1[2], v1[3])}; } }
    }
};

__device__ __forceinline__ void attn_unit(bf16* PROJ, const bf16* VT, const LAS float* rpb, int b, int h, int r, int qb, int lane, bf16* obase, int opitch) {
    const int qn = lane & 15, g = lane >> 4;
    const int rs = min(max(r - 4, 0), 120);
    const int cb = (qb == 0) ? 0 : ((qb == 1) ? 8 : ((qb == 2) ? 24 : 32));
    const int w = 16 * qb + qn, cs = min(max(w - 8, 0), 48);
    const size_t tokq = (size_t)b * T + r * 64 + w;
    bf16* qp = PROJ + tokq * PROJ_LD + Q_OFF + h * 64;
    bf16x8 qf0 = *(const bf16x8*)(qp + 8 * g), qf1 = *(const bf16x8*)(qp + 32 + 8 * g);
    const bf16* kbase = PROJ + ((size_t)b * T + rs * 64 + cb + qn) * PROJ_LD + K_OFF + h * 64 + 8 * g;
    f32x4 sc[16];
#pragma unroll
    for (int kt = 0; kt < 16; ++kt) {
        const int kr = kt >> 1, ch = kt & 1;
        const bf16* kp = kbase + (size_t)(kr * 64 + 16 * ch) * PROJ_LD;
        const bf16x8 kf0 = *(const bf16x8*)kp, kf1 = *(const bf16x8*)(kp + 32);
        f32x4 a = (f32x4){0.f, 0.f, 0.f, 0.f};
        a = __builtin_amdgcn_mfma_f32_16x16x32_bf16(kf0, qf0, a, 0, 0, 0);
        a = __builtin_amdgcn_mfma_f32_16x16x32_bf16(kf1, qf1, a, 0, 0, 0);
        sc[kt] = a;
    }
    const LAS float* rp = rpb + h * 465;
    float mx = -1e30f;
#pragma unroll
    for (int kt = 0; kt < 16; ++kt) {
        const int kr = kt >> 1, ch = kt & 1;
        const int brow = (rs + kr - r + 7) * 31;
#pragma unroll
        for (int j = 0; j < 4; ++j) {
            const int kc = cb + 16 * ch + 4 * g + j, dc = kc - w + 15;
            const bool ok = (kc >= cs) && (kc <= cs + 15);
            const float bias = rp[brow + (ok ? dc : 15)];
            const float s = ok ? sc[kt][j] + bias : -1e30f;
            sc[kt][j] = s; mx = fmaxf(mx, s);
        }
    }
    mx = fmaxf(mx, __shfl_xor(mx, 16)); mx = fmaxf(mx, __shfl_xor(mx, 32));
    float sum = 0.f;
#pragma unroll
    for (int kt = 0; kt < 16; ++kt)
#pragma unroll
        for (int j = 0; j < 4; ++j) { const float p = __expf(sc[kt][j] - mx); sc[kt][j] = p; sum += p; }
    sum += __shfl_xor(sum, 16); sum += __shfl_xor(sum, 32);
    const float inv = 1.0f / sum;
    f32x4 o[4];
#pragma unroll
    for (int dt = 0; dt < 4; ++dt) o[dt] = (f32x4){0.f, 0.f, 0.f, 0.f};
    const bf16* vbase = VT + ((size_t)(b * 512 + h * 64 + qn)) * T + rs * 64 + cb + 4 * g;
#pragma unroll
    for (int kr = 0; kr < 8; ++kr) {
        v4u pw; pw.x = pk2(sc[2 * kr][0], sc[2 * kr][1]); pw.y = pk2(sc[2 * kr][2], sc[2 * kr][3]); pw.z = pk2(sc[2 * kr + 1][0], sc[2 * kr + 1][1]); pw.w = pk2(sc[2 * kr + 1][2], sc[2 * kr + 1][3]);
        const bf16x8 pf = __builtin_bit_cast(bf16x8, pw);
#pragma unroll
        for (int dt = 0; dt < 4; ++dt) {
            const bf16* vp = vbase + (size_t)(16 * dt) * T + kr * 64;
            const v2u lo = *(const v2u*)vp, hi = *(const v2u*)(vp + 16);
            const v4u vw = (v4u){lo.x, lo.y, hi.x, hi.y};
            o[dt] = __builtin_amdgcn_mfma_f32_16x16x32_bf16(__builtin_bit_cast(bf16x8, vw), pf, o[dt], 0, 0, 0);
        }
    }
    bf16* op = obase + tokq * opitch + h * 64;
#pragma unroll
    for (int dt = 0; dt < 4; ++dt) *(v2u*)(op + 16 * dt + 4 * g) = (v2u){pk2(o[dt][0] * inv, o[dt][1] * inv), pk2(o[dt][2] * inv, o[dt][3] * inv)};
}
__device__ __forceinline__ void attn_phase(const Frame& F0, const Args& args, int l, bf16* obase, int opitch) {
    const Frame F = fresh(F0);
    LAS float* rpb = (LAS float*)(F.lds + RING_OFF);
    for (int i = F.tid; i < 8 * 465; i += 512) rpb[i] = INP(9)[l * 8 * 465 + i];
    __syncthreads();
    bf16* PROJ = WSP(bf16, WS_PROJ); const bf16* VT = WSP(bf16, WS_VT);
    for (int wu = F.vcu * NWAVES + F.wave; wu < 16384; wu += F.G * NWAVES) {
        const int bh = wu >> 9, rem = wu & 511;
        attn_unit(PROJ, VT, rpb, bh >> 3, bh & 7, rem >> 2, rem & 3, F.lane, obase, opitch);
    }
    __syncthreads();
}

__device__ __forceinline__ float gelu_tanh(float x) { const float u = 0.7978845608028654f * (x + 0.044715f * x * x * x); const float t = 1.0f - 2.0f * __builtin_amdgcn_rcpf(1.0f + __expf(2.0f * u)); return 0.5f * x * (1.0f + t); }
__device__ __forceinline__ void fft_a_phase(const Frame& F0, const Args& args) {
    const Frame F = fresh(F0);
    const int lane = F.lane, nl = lane & 31, hh = lane >> 5;
    const bf16* PROJ = WSP(bf16, WS_PROJ); const bf16* FA = WSP(bf16, WS_FA); const f32x2* TW = WSP(f32x2, WS_TW); bf16* ZP = WSP(bf16, WS_U);
    for (int wu = F.vcu * NWAVES + F.wave; wu < 8192; wu += F.G * NWAVES) {
        const int ct = wu & 15, t2 = (wu >> 4) & 127, b = wu >> 11;
        bf16x8 bf[8];
#pragma unroll
        for (int s = 0; s < 8; ++s) { const int part = s >> 2, t1b = 16 * (s & 3) + 8 * hh;
            const bf16* p = PROJ + ((size_t)b * T + (size_t)128 * t1b + t2) * PROJ_LD + G_OFF + part * 512 + 32 * ct + nl;
            unsigned short e[8];
#pragma unroll
            for (int j = 0; j < 8; ++j) e[j] = p[(size_t)j * 128 * PROJ_LD];
            v4u w; w.x = e[0] | ((unsigned)e[1] << 16); w.y = e[2] | ((unsigned)e[3] << 16); w.z = e[4] | ((unsigned)e[5] << 16); w.w = e[6] | ((unsigned)e[7] << 16);
            bf[s] = __builtin_bit_cast(bf16x8, w); }
        f32x16 acc[4];
#pragma unroll
        for (int mt = 0; mt < 4; ++mt) { acc[mt] = (f32x16){};
#pragma unroll
            for (int s = 0; s < 8; ++s) { const bf16x8 af = *(const bf16x8*)(FA + (32 * mt + nl) * 128 + 16 * s + 8 * hh); acc[mt] = __builtin_amdgcn_mfma_f32_32x32x16_bf16(af, bf[s], acc[mt], 0, 0, 0); } }
#pragma unroll
        for (int mt = 0; mt < 2; ++mt)
#pragma unroll
            for (int rg = 0; rg < 16; ++rg) { const int k1 = 32 * mt + (rg & 3) + 8 * (rg >> 2) + 4 * hh; const f32x2 cs = TW[t2 * 64 + k1];
                const float zr = acc[mt][rg], zi = acc[mt + 2][rg];
                bf16* d = ZP + ((size_t)(b * 64 + k1) * 128 + t2) * 1024 + 32 * ct + nl;
                d[0] = (bf16)f2bf(zr * cs.x + zi * cs.y); d[512] = (bf16)f2bf(zi * cs.x - zr * cs.y); }
    }
}
__device__ __forceinline__ void fft_b_phase(const Frame& F0, const Args& args) {
    const Frame F = fresh(F0);
    const int lane = F.lane, nl = lane & 31, hh = lane >> 5;
    bf16* PROJ = WSP(bf16, WS_PROJ); const bf16* FB = WSP(bf16, WS_FB); const bf16* ZP = WSP(bf16, WS_U);
    for (int wu = F.vcu * NWAVES + F.wave; wu < 4096; wu += F.G * NWAVES) {
        const int ct = wu & 15, k1 = (wu >> 4) & 63, b = wu >> 10;
        f32x16 acc[4];
#pragma unroll
        for (int mt = 0; mt < 4; ++mt) acc[mt] = (f32x16){};
#pragma unroll 1
        for (int sc = 0; sc < 4; ++sc) {
            bf16x8 bf[4];
#pragma unroll
            for (int q = 0; q < 4; ++q) { const int s = 4 * sc + q, part = s >> 3, t2b = 16 * (s & 7) + 8 * hh;
                const bf16* p = ZP + ((size_t)(b * 64 + k1) * 128 + t2b) * 1024 + part * 512 + 32 * ct + nl;
                unsigned short e[8];
#pragma unroll
                for (int j = 0; j < 8; ++j) e[j] = p[(size_t)j * 1024];
                v4u w; w.x = e[0] | ((unsigned)e[1] << 16); w.y = e[2] | ((unsigned)e[3] << 16); w.z = e[4] | ((unsigned)e[5] << 16); w.w = e[6] | ((unsigned)e[7] << 16);
                bf[q] = __builtin_bit_cast(bf16x8, w); }
#pragma unroll
            for (int mt = 0; mt < 4; ++mt)
#pragma unroll
                for (int q = 0; q < 4; ++q) { const bf16x8 af = *(const bf16x8*)(FB + (32 * mt + nl) * 256 + 16 * (4 * sc + q) + 8 * hh); acc[mt] = __builtin_amdgcn_mfma_f32_32x32x16_bf16(af, bf[q], acc[mt], 0, 0, 0); }
        }
#pragma unroll
        for (int mt = 0; mt < 4; ++mt)
#pragma unroll
            for (int rg = 0; rg < 16; ++rg) { const int k2 = 32 * mt + (rg & 3) + 8 * (rg >> 2) + 4 * hh;
                PROJ[((size_t)b * T + k1 + 64 * k2) * PROJ_LD + G_OFF + 32 * ct + nl] = (bf16)f2bf(acc[mt][rg] * (1.0f / 1024.0f)); }
    }
}

__device__ __forceinline__ void router_phase(const Frame& F0, const Args& args, int l, int cset) {
    const Frame F = fresh(F0);
    const int tid = F.tid, lane = F.lane, wave = F.wave;
    const float* MOD = WSP(float, WS_MOD);
    LAS float* WPL = (LAS float*)(F.lds + RING_OFF);
    LAS float* gsc = (LAS float*)(F.lds + XTRA_OFF);
    LAS float* shf = gsc + 1024;
    LAS float* c0 = shf + 1024;
    LAS float* rb = c0 + 32;
    LAS unsigned* lcnt = (LAS unsigned*)(rb + 32);
    LAS unsigned* lbase = lcnt + 32;
    LAS float* red = (LAS float*)(lbase + 32);
    const float* x = args.out; bf16* U2 = WSP(bf16, WS_U);
    float* tokw = WSP(float, WS_TOKW); int* perm = WSP(int, WS_PERM); int* tokes = WSP(int, WS_TOKROW);
    unsigned* ecnt = (unsigned*)(F.ctl + CW_ECNT + cset * 32 * 64);
    const int nround = (2048 + F.G * NWAVES - 1) / (F.G * NWAVES);
    int cur_b = -1;
    for (int rd = 0; rd < nround; ++rd) {
        const int unit = (rd * F.G + F.vcu) * NWAVES + wave;
        const int ub = (((rd * F.G + F.vcu) * NWAVES) * 16) >> 13;
        const bool wg_active = ((rd * F.G + F.vcu) * NWAVES) < 2048;
        if (wg_active && ub != cur_b) {
            cur_b = ub; __syncthreads();
            for (int i = 0; i < 2; ++i) { const int col = tid + 512 * i; gsc[col] = INP(5)[l * 1024 + col] * (1.0f + MOD[(size_t)(l * 4 + ub) * 6144 + 4 * 1024 + col]); shf[col] = MOD[(size_t)(l * 4 + ub) * 6144 + 3 * 1024 + col]; }
            if (tid < 32) rb[tid] = INP(22)[tid];
            __syncthreads();
            for (int i = 0; i < 64; ++i) { const int idx = tid + 512 * i, k = idx >> 5, e = idx & 31; WPL[k * 32 + (e ^ (((k >> 8) & 1) << 4))] = gsc[k] * INP(21)[idx]; }
            { const int e = tid & 31, pt = tid >> 5; float s = 0.f;
                for (int k = pt * 64; k < pt * 64 + 64; ++k) s += shf[k] * INP(21)[k * 32 + e];
                red[tid] = s; }
            __syncthreads();
            if (tid < 32) { float s = 0.f; for (int p = 0; p < 16; ++p) s += red[p * 32 + tid]; c0[tid] = s; }
        }
        if (tid < 32) lcnt[tid] = 0u;
        __syncthreads();
        int e0 = 0, e1 = 0; unsigned rk0 = 0, rk1 = 0; float w0 = 0.f, w1 = 0.f; bool owner = false; int mytok = 0;
        if (unit < 2048) {
            const int tok0 = unit * 16;
            float rs_reg = 0.f;
#pragma unroll 1
            for (int i4 = 0; i4 < 16; i4 += 4) {
                f32x4 v[4][4];
#pragma unroll
                for (int q = 0; q < 4; ++q) { const f32x4* xr = (const f32x4*)(x + (size_t)(tok0 + i4 + q) * D) + lane;
#pragma unroll
                    for (int j = 0; j < 4; ++j) v[q][j] = xr[64 * j]; }
#pragma unroll
                for (int q = 0; q < 4; ++q) { const int m = tok0 + i4 + q; float ss = 0.f;
#pragma unroll
                    for (int j = 0; j < 4; ++j) ss += (v[q][j].x * v[q][j].x + v[q][j].y * v[q][j].y) + (v[q][j].z * v[q][j].z + v[q][j].w * v[q][j].w);
                    const float rstd = 1.0f / sqrtf(wave_sum(ss) * (1.0f / D) + EPS);
                    if ((lane & 15) == i4 + q) rs_reg = rstd;
                    v2u* uo = (v2u*)(U2 + (size_t)m * D) + lane;
#pragma unroll
                    for (int j = 0; j < 4; ++j) { const f32x4 g = *(const LAS f32x4*)(gsc + 4 * lane + 256 * j), s = *(const LAS f32x4*)(shf + 4 * lane + 256 * j);
                        const f32x4 u = v[q][j] * rstd * g + s; uo[64 * j] = (v2u){pk2(u.x, u.y), pk2(u.z, u.w)}; } }
            }
            const int ti = lane & 15, kq = lane >> 4;
            const f32x4* xrow = (const f32x4*)(x + (size_t)(tok0 + ti) * D + 256 * kq);
            const LAS float* wp0 = WPL + (256 * kq) * 32 + (ti ^ ((kq & 1) << 4));
            const LAS float* wp1 = WPL + (256 * kq) * 32 + ((16 + ti) ^ ((kq & 1) << 4));
            f32x4 a0 = {0.f, 0.f, 0.f, 0.f}, a1 = {0.f, 0.f, 0.f, 0.f};
#pragma unroll 1
            for (int t32 = 0; t32 < 8; ++t32) {
                f32x4 xv[8];
#pragma unroll
                for (int q = 0; q < 8; ++q) xv[q] = xrow[8 * t32 + q];
#pragma unroll
                for (int q = 0; q < 8; ++q)
#pragma unroll
                    for (int jj = 0; jj < 4; ++jj) { const int kk = 32 * t32 + 4 * q + jj;
                        a0 = __builtin_amdgcn_mfma_f32_16x16x4f32(wp0[kk * 32], xv[q][jj], a0, 0, 0, 0);
                        a1 = __builtin_amdgcn_mfma_f32_16x16x4f32(wp1[kk * 32], xv[q][jj], a1, 0, 0, 0); }
            }
            float sco[2][4], sel[2][4], gs[2];
#pragma unroll
            for (int nt = 0; nt < 2; ++nt) {
#pragma unroll
                for (int rg = 0; rg < 4; ++rg) { const int e = 16 * nt + 4 * kq + rg; const float lg = rs_reg * (nt ? a1[rg] : a0[rg]) + c0[e]; sco[nt][rg] = sigmoidf(lg); sel[nt][rg] = sco[nt][rg] + rb[e]; }
                float m1 = fmaxf(sel[nt][0], sel[nt][1]), m2 = fminf(sel[nt][0], sel[nt][1]);
                { const float v = sel[nt][2]; if (v > m1) { m2 = m1; m1 = v; } else if (v > m2) m2 = v; }
                { const float v = sel[nt][3]; if (v > m1) { m2 = m1; m1 = v; } else if (v > m2) m2 = v; }
                gs[nt] = m1 + m2; }
            float bv = gs[0]; int bg = kq; if (gs[1] > bv) { bv = gs[1]; bg = 4 + kq; }
#pragma unroll
            for (int o = 16; o < 64; o <<= 1) { const float ov = __shfl_xor(bv, o); const int og = __shfl_xor(bg, o); if (ov > bv || (ov == bv && og < bg)) { bv = ov; bg = og; } }
            owner = ((bg & 3) == kq); mytok = tok0 + ti;
            if (owner) { const int nt = bg >> 2; float cd[4], sv[4];
#pragma unroll
                for (int rg = 0; rg < 4; ++rg) { cd[rg] = nt ? sel[1][rg] : sel[0][rg]; sv[rg] = nt ? sco[1][rg] : sco[0][rg]; }
                int i1 = 0; float v1 = cd[0];
#pragma unroll
                for (int rg = 1; rg < 4; ++rg) if (cd[rg] > v1) { v1 = cd[rg]; i1 = rg; }
                int i2 = -1; float v2 = -1e30f;
#pragma unroll
                for (int rg = 0; rg < 4; ++rg) if (rg != i1 && cd[rg] > v2) { v2 = cd[rg]; i2 = rg; }
                const float s1 = (i1 == 0 ? sv[0] : (i1 == 1 ? sv[1] : (i1 == 2 ? sv[2] : sv[3]))), s2 = (i2 == 0 ? sv[0] : (i2 == 1 ? sv[1] : (i2 == 2 ? sv[2] : sv[3])));
                e0 = 4 * bg + i1; e1 = 4 * bg + i2; w0 = s1 / (s1 + s2); w1 = s2 / (s1 + s2);
                rk0 = __hip_atomic_fetch_add(lcnt + e0, 1u, __ATOMIC_RELAXED, __HIP_MEMORY_SCOPE_WORKGROUP);
                rk1 = __hip_atomic_fetch_add(lcnt + e1, 1u, __ATOMIC_RELAXED, __HIP_MEMORY_SCOPE_WORKGROUP); }
        }
        __syncthreads();
        if (tid < 32) { const unsigned n = lcnt[tid]; lbase[tid] = n ? __hip_atomic_fetch_add(ecnt + 64 * tid, n, RLX_AGENT) : 0u; }
        __syncthreads();
        if (owner) { const unsigned s0 = lbase[e0] + rk0, s1 = lbase[e1] + rk1; perm[(size_t)e0 * NTOK + s0] = 2 * mytok; perm[(size_t)e1 * NTOK + s1] = 2 * mytok + 1; tokw[2 * mytok] = w0; tokw[2 * mytok + 1] = w1;
            tokes[2 * mytok] = (e0 << 16) | (int)s0; tokes[2 * mytok + 1] = (e1 << 16) | (int)s1; }
    }
    __syncthreads();
    {
        LAS float* scr = (LAS float*)(F.lds + RING_OFF + wave * 8704);
        const int gw = F.vcu * NWAVES + wave, NGW = F.G * NWAVES;
        bf16* WG1 = WSP(bf16, WS_WG1); bf16* WD = WSP(bf16, WS_WD);
        auto mk = [&](int it) -> TrItem {
            const int kind = it >> 13, r = it & 8191, e = r >> 8, rr = r & 255;
            if (kind < 2) { const int kb = rr >> 4, nb = rr & 15, n0 = nb * 32; const float* src = (kind == 0 ? INP(23) : INP(24)) + (size_t)(l * 32 + e) * 1024 * 512;
                return TrItem{src, 512, kb * 64, n0, WG1 + ((size_t)e * 1024 + (n0 >> 7) * 256 + kind * 128 + (n0 & 127)) * 1024, 1024}; }
            const int kb = rr >> 5, nb = rr & 31, n0 = nb * 32; const float* src = INP(25) + (size_t)(l * 32 + e) * 512 * 1024;
            return TrItem{src, 1024, kb * 64, n0, WD + ((size_t)e * 1024 + n0) * 512, 512}; };
        for (int rep = 0; rep < 1 + REP_C; ++rep)
        for (int it = gw; it < 24576; it += 2 * NGW) {
            const bool two = (it + NGW) < 24576;
            const TrItem a = mk(it), b = mk(two ? it + NGW : it);
            f32x4 va[8], vb[8]; tr_load(a, va, lane); tr_load(b, vb, lane);
            tr_finish(a, va, scr, lane); if (two) tr_finish(b, vb, scr, lane);
        }
    }
}
__device__ __forceinline__ void moe_tilebase(const Frame& F0, const Args& args, int l) {
    const Frame F = fresh(F0);
    __syncthreads();
    if (F.tid == 0) { unsigned* ecnt = (unsigned*)(F.ctl + CW_ECNT + l * 32 * 64); int acc = 0;
        for (int e = 0; e < 32; ++e) { const unsigned c = __hip_atomic_load(ecnt + 64 * e, RLX_AGENT); F.MISC[16 + e] = (unsigned)acc; F.MISC[49 + e] = c; acc += (int)((c + 255u) >> 8); }
        F.MISC[48] = (unsigned)acc; }
    __syncthreads();
}
__device__ __forceinline__ void moe_rowmaps(const Frame& F0, const Args& args, const pg8::MoeOrder& S, LAS int* rowmap) {
    const Frame F = fresh(F0);
    const int* perm = WSP(int, WS_PERM);
    pg8::Unit u;
    for (int i = 0; i < 8 && S.next(i, u); ++i) { if (F.tid < 256) { const int idx = min(F.tid, u.gcnt - 1); rowmap[i * 256 + F.tid] = perm[(size_t)u.gbase + idx] >> 1; } }
    __syncthreads();
}
__device__ __forceinline__ void lru_conv_phase(const Frame& F0, const Args& args, int l) {
    const Frame F = fresh(F0);
    const int lane = F.lane, cg = lane & 7, tg = lane >> 3;
    const bf16* PROJ = WSP(bf16, WS_PROJ); bf16* XC = WSP(bf16, WS_XC);
    for (int wu = F.vcu * NWAVES + F.wave; wu < 4096; wu += F.G * NWAVES) {
        const int hb = wu & 7, c = (wu >> 3) & 127, b = wu >> 10, t0 = c * 64, ch0 = hb * 64 + 8 * cg;
        const bf16* xrp = PROJ + (size_t)b * T * PROJ_LD + XR_OFF + ch0;
        v4u raw[11];
#pragma unroll
        for (int rr = 0; rr < 11; ++rr) { const int t = t0 + 8 * tg - 2 + rr, tc = min(max(t, 0), T - 1); raw[rr] = *(const v4u*)(xrp + (size_t)tc * PROJ_LD); }
        f32x4 wv[5][2];
#pragma unroll
        for (int j = 0; j < 4; ++j) { wv[j][0] = *(const f32x4*)(INP(10) + (l * 4 + j) * 512 + ch0); wv[j][1] = *(const f32x4*)(INP(10) + (l * 4 + j) * 512 + ch0 + 4); }
        wv[4][0] = *(const f32x4*)(INP(11) + l * 512 + ch0); wv[4][1] = *(const f32x4*)(INP(11) + l * 512 + ch0 + 4);
        unsigned ow[8][4];
#pragma unroll
        for (int pp = 0; pp < 4; ++pp) {
            float xl[11], xh[11];
#pragma unroll
            for (int rr = 0; rr < 11; ++rr) { const int t = t0 + 8 * tg - 2 + rr; const unsigned w = (t >= 0 && t < T) ? raw[rr][pp] : 0u; xl[rr] = bflo(w); xh[rr] = bfhi(w); }
#pragma unroll
            for (int tk = 0; tk < 8; ++tk) { float ol = wv[4][pp >> 1][2 * (pp & 1)], oh = wv[4][pp >> 1][2 * (pp & 1) + 1];
#pragma unroll
                for (int j = 0; j < 4; ++j) { ol += wv[j][pp >> 1][2 * (pp & 1)] * xl[tk + j]; oh += wv[j][pp >> 1][2 * (pp & 1) + 1] * xh[tk + j]; }
                ow[tk][pp] = pk2(ol, oh); }
        }
#pragma unroll
        for (int tk = 0; tk < 8; ++tk) *(v4u*)(XC + ((size_t)b * T + t0 + 8 * tg + tk) * 512 + ch0) = (v4u){ow[tk][0], ow[tk][1], ow[tk][2], ow[tk][3]};
    }
}
__device__ __forceinline__ void lru_load_frags(bf16x8 (&af)[4][2], const bf16* xcp, int t0, int lane) {
#pragma unroll
    for (int mt = 0; mt < 4; ++mt) { const int tau = 16 * ((lane & 15) >> 2) + 4 * mt + (lane & 3);
#pragma unroll
        for (int s = 0; s < 2; ++s) af[mt][s] = *(const bf16x8*)(xcp + (size_t)(t0 + tau) * 512 + 32 * s); }
}
__device__ __forceinline__ void lru2_phase(const Frame& F0, const Args& args, int l, bf16* obase, int opitch, int ooff) {
    const Frame F = fresh(F0);
    const int lane = F.lane, wave = F.wave;
    LAS bf16* YRT = (LAS bf16*)(F.lds + RING_OFF + wave * 1024);
    LAS f32x2* SUMT = (LAS f32x2*)(F.lds + RING_OFF + 8192);
    LAS float* CARRY = (LAS float*)(F.lds + RING_OFF + 24576);
    const bf16* PROJ = WSP(bf16, WS_PROJ); const bf16* XC = WSP(bf16, WS_XC);
    for (int un = F.vcu; un < 256; un += F.G) {
        const int b = un >> 6, hb = (un >> 3) & 7, s8 = un & 7;
        const int n = lane & 15, g = lane >> 4, dir = n >> 3, cj = n & 7;
        const int chg = hb * 64 + s8 * 8 + cj;
        const bf16* WLp = WSP(bf16, WS_WL) + ((size_t)(l * 8 + hb) * 256) * 64;
        bf16x8 br[2], bi[2], bs[2];
#pragma unroll
        for (int s = 0; s < 2; ++s) { br[s] = *(const bf16x8*)(WLp + ((2 * dir + 0) * 64 + s8 * 8 + cj) * 64 + 32 * s + 8 * g); bi[s] = *(const bf16x8*)(WLp + ((2 * dir + 1) * 64 + s8 * 8 + cj) * 64 + 32 * s + 8 * g);
            v4u sel = (v4u){0u, 0u, 0u, 0u};
            if (32 * s + 8 * g == 8 * s8) { const unsigned one = (cj & 1) ? 0x3F800000u : 0x00003F80u; sel[0] = (cj >> 1) == 0 ? one : 0u; sel[1] = (cj >> 1) == 1 ? one : 0u; sel[2] = (cj >> 1) == 2 ? one : 0u; sel[3] = (cj >> 1) == 3 ? one : 0u; }
            bs[s] = __builtin_bit_cast(bf16x8, sel); }
        const float b_r = INP(13)[(l * 2 + dir) * 512 + chg], b_i = INP(15)[(l * 2 + dir) * 512 + chg], lam = INP(16)[(l * 2 + dir) * 512 + chg];
        const float m8sp = -8.0f * ((lam > 15.f) ? __expf(-lam) : log1pf(__expf(-lam)));
        const bf16* xcp = XC + (size_t)b * T * 512 + hb * 64 + 8 * g;
        const bf16* yrp = PROJ + (size_t)b * T * PROJ_LD + YR_OFF + hb * 64 + s8 * 8;
        bf16* outp = obase + (size_t)b * T * opitch + ooff + hb * 64 + s8 * 8;
#pragma unroll 1
        for (int sweep = 0; sweep < 2; ++sweep) {
            bf16x8 nxt[4][2]; v4u ynx = (v4u){0u, 0u, 0u, 0u};
            lru_load_frags(nxt, xcp, wave * 64, lane);
            if (sweep == 1) ynx = *(const v4u*)(yrp + (size_t)(wave * 64 + lane) * PROJ_LD);
#pragma unroll 1
            for (int ci = 0; ci < 16; ++ci) {
                const int c = wave + 8 * ci, t0 = c * 64;
                bf16x8 af[4][2];
#pragma unroll
                for (int mt = 0; mt < 4; ++mt) { af[mt][0] = nxt[mt][0]; af[mt][1] = nxt[mt][1]; }
                const v4u ycur = ynx;
                if (ci + 1 < 16) { lru_load_frags(nxt, xcp, t0 + 512, lane); if (sweep == 1) ynx = *(const v4u*)(yrp + (size_t)(t0 + 512 + lane) * PROJ_LD); }
                if (sweep == 1) *(LAS v4u*)(YRT + lane * 8) = ycur;
                f32x4 ar[4], ai[4], ax[4];
#pragma unroll
                for (int mt = 0; mt < 4; ++mt) { ar[mt] = (f32x4){0.f, 0.f, 0.f, 0.f}; ai[mt] = (f32x4){0.f, 0.f, 0.f, 0.f}; ax[mt] = (f32x4){0.f, 0.f, 0.f, 0.f};
#pragma unroll
                    for (int s = 0; s < 2; ++s) { ar[mt] = __builtin_amdgcn_mfma_f32_16x16x32_bf16(af[mt][s], br[s], ar[mt], 0, 0, 0); ai[mt] = __builtin_amdgcn_mfma_f32_16x16x32_bf16(af[mt][s], bi[s], ai[mt], 0, 0, 0);
                        ax[mt] = __builtin_amdgcn_mfma_f32_16x16x32_bf16(af[mt][s], bs[s], ax[mt], 0, 0, 0); } }
                float a[16], bx[16];
#pragma unroll
                for (int j = 0; j < 16; ++j) { const float rr = fsigmoid(ar[j >> 2][j & 3] + b_r), ii = fsigmoid(ai[j >> 2][j & 3] + b_i);
                    const float av = __expf(m8sp * rr); a[j] = av; bx[j] = __builtin_amdgcn_sqrtf(fmaxf(1.0f - av * av, 0.f)) * (ii * ax[j >> 2][j & 3]); }
                float A16 = 1.f, B16 = 0.f;
                if (dir == 0) {
#pragma unroll
                    for (int j = 0; j < 16; ++j) { B16 = a[j] * B16 + bx[j]; A16 *= a[j]; }
                } else {
#pragma unroll
                    for (int j = 15; j >= 0; --j) { B16 = a[j] * B16 + bx[j]; A16 *= a[j]; }
                }
                float Ag[4], Bg[4];
#pragma unroll
                for (int k = 0; k < 4; ++k) { const int src = n + 16 * (dir ? 3 - k : k); Ag[k] = __shfl(A16, src); Bg[k] = __shfl(B16, src); }
                if (sweep == 0) {
                    float At = 1.f, Bt = 0.f;
#pragma unroll
                    for (int k = 0; k < 4; ++k) { Bt = Ag[k] * Bt + Bg[k]; At *= Ag[k]; }
                    if (g == 0) SUMT[c * 16 + n] = (f32x2){At, Bt};
                } else {
                    const int pos = dir ? 3 - g : g;
                    float h = CARRY[c * 16 + n];
#pragma unroll
                    for (int k = 0; k < 3; ++k) if (k < pos) h = Ag[k] * h + Bg[k];
                    float hj[16];
                    if (dir == 0) {
#pragma unroll
                        for (int j = 0; j < 16; ++j) { h = a[j] * h + bx[j]; hj[j] = h; }
                    } else {
#pragma unroll
                        for (int j = 15; j >= 0; --j) { h = a[j] * h + bx[j]; hj[j] = h; }
                    }
#pragma unroll
                    for (int j = 0; j < 16; ++j) hj[j] += __shfl_xor(hj[j], 8);
                    LDS_WAIT(); asm volatile("" ::: "memory");
                    {
                        float hv[8], yv[8];
#pragma unroll
                        for (int j = 0; j < 8; ++j) { hv[j] = dir ? hj[8 + j] : hj[j]; yv[j] = bf2f(YRT[(16 * g + 8 * dir + j) * 8 + cj]); }
#pragma unroll
                        for (int j = 0; j < 8; ++j) YRT[(16 * g + 8 * dir + j) * 8 + cj] = (bf16)f2bf(hv[j] * gelu_tanh(yv[j]));
                    }
                    LDS_WAIT(); asm volatile("" ::: "memory");
                    *(v4u*)(outp + (size_t)(t0 + lane) * opitch) = *(const LAS v4u*)(YRT + lane * 8);
                    LDS_WAIT(); asm volatile("" ::: "memory");
                }
            }
            if (sweep == 0) {
                __syncthreads();
                if (F.tid < 16) { const int nn = F.tid, dd = nn >> 3; float h = 0.f;
#pragma unroll 4
                    for (int i = 0; i < 128; ++i) { const int c = dd ? 127 - i : i; const f32x2 ab = SUMT[c * 16 + nn]; CARRY[c * 16 + nn] = h; h = ab.x * h + ab.y; } }
                __syncthreads();
            }
        }
        __syncthreads();
    }
}
constexpr int AT_KR = 0, AT_VR = 73728, AT_VPITCH = 1168, AT_RPB = 148480;
__device__ __forceinline__ void attn2_phase(const Frame& F0, const Args& args, int l, bf16* obase, int opitch) {
    const Frame F = fresh(F0);
    const int tid = F.tid, lane = F.lane, wave = F.wave;
    LAS unsigned char* KR = F.lds + AT_KR; LAS unsigned char* VR = F.lds + AT_VR;
    LAS float* rpb = (LAS float*)(F.lds + AT_RPB);
    const bf16* PROJ = WSP(bf16, WS_PROJ); const bf16* VT = WSP(bf16, WS_VT);
    const int qb = wave & 3, dh = wave >> 2, qn = lane & 15, g = lane >> 4;
    const int cb = (qb == 0) ? 0 : ((qb == 1) ? 8 : ((qb == 2) ? 24 : 32));
    const int w = 16 * qb + qn, cs = min(max(w - 8, 0), 48);
    const int st = tid >> 3, sc = tid & 7;
    bool v0[4]; int dsel[4];
#pragma unroll
    for (int j = 0; j < 4; ++j) { const int kc0 = cb + 4 * g + j; v0[j] = (kc0 >= cs) && (kc0 <= cs + 15); dsel[j] = (v0[j] ? kc0 : kc0 + 16) - w + 15; }
    for (int un = F.vcu; un < 256; un += F.G) {
        const int bh = un >> 3, b = bh >> 3, h = bh & 7, R0 = (un & 7) * 16;
        __syncthreads();
        for (int i = tid; i < 465; i += 512) rpb[i] = INP(9)[(l * 8 + h) * 465 + i];
        const bf16* kg = PROJ + ((size_t)b * T + st) * PROJ_LD + K_OFF + h * 64 + 8 * sc;
        const bf16* vg = VT + ((size_t)(b * 512 + h * 64 + st)) * T + 8 * sc;
        const int kdst = st * 128 + ((sc ^ ((st >> 1) & 7)) * 16);
        const int vdst = st * AT_VPITCH + sc * 16;
        const int rs0 = min(max(R0 - 4, 0), 120);
        {
            v4u kk[8], vv[8];
#pragma unroll
            for (int j = 0; j < 8; ++j) { kk[j] = *(const v4u*)(kg + (size_t)(rs0 + j) * 64 * PROJ_LD); vv[j] = *(const v4u*)(vg + (rs0 + j) * 64); }
#pragma unroll
            for (int j = 0; j < 8; ++j) { const int slot = (rs0 + j) % 9; *(LAS v4u*)(KR + slot * 8192 + kdst) = kk[j]; *(LAS v4u*)(VR + slot * 128 + vdst) = vv[j]; }
        }
        __syncthreads();
        int have = rs0 + 7;
        v2u py0 = (v2u){0u, 0u}, py1 = (v2u){0u, 0u}; bf16* pop = nullptr;
        bf16x8 qn0, qn1;
        { const bf16* qp = PROJ + ((size_t)b * T + R0 * 64 + w) * PROJ_LD + Q_OFF + h * 64; qn0 = *(const bf16x8*)(qp + 8 * g); qn1 = *(const bf16x8*)(qp + 32 + 8 * g); }
#pragma unroll 1
        for (int s = 0; s < 16; ++s) {
            const int r = R0 + s;
            if (s > 0) { *(v2u*)pop = py0; *(v2u*)(pop + 16) = py1; }
            const size_t tokq = (size_t)b * T + r * 64 + w;
            const bf16x8 qf0 = qn0, qf1 = qn1;
            { const int r2 = min(r + 1, R0 + 15); const bf16* qp = PROJ + ((size_t)b * T + r2 * 64 + w) * PROJ_LD + Q_OFF + h * 64; qn0 = *(const bf16x8*)(qp + 8 * g); qn1 = *(const bf16x8*)(qp + 32 + 8 * g); }
            const int rsn = min(max(r + 1 - 4, 0), 120); const bool newrow = (s + 1 < 16) && (rsn + 7 > have); const int nrow = min(rsn + 7, 127);
            const v4u pk = *(const v4u*)(kg + (size_t)nrow * 64 * PROJ_LD), pv = *(const v4u*)(vg + nrow * 64);
            const int rs = min(max(r - 4, 0), 120);
            int slot = rs % 9;
            f32x4 sc4[16];
#pragma unroll
            for (int kr = 0; kr < 8; ++kr) {
#pragma unroll
                for (int ch = 0; ch < 2; ++ch) { const int kt = cb + 16 * ch + qn; const LAS unsigned char* kp = KR + slot * 8192 + kt * 128; const int sw = (kt >> 1) & 7;
                    const bf16x8 kf0 = *(const LAS bf16x8*)(kp + ((g ^ sw) * 16)), kf1 = *(const LAS bf16x8*)(kp + (((4 + g) ^ sw) * 16));
                    f32x4 a = (f32x4){0.f, 0.f, 0.f, 0.f};
                    a = __builtin_amdgcn_mfma_f32_16x16x32_bf16(kf0, qf0, a, 0, 0, 0);
                    a = __builtin_amdgcn_mfma_f32_16x16x32_bf16(kf1, qf1, a, 0, 0, 0);
                    sc4[2 * kr + ch] = a; }
                slot = (slot == 8) ? 0 : slot + 1;
            }
            float sv[8][4]; float mx = -1e30f;
            const LAS float* rp = rpb + (rs - r + 7) * 31;
#pragma unroll
            for (int kr = 0; kr < 8; ++kr)
#pragma unroll
                for (int j = 0; j < 4; ++j) { const float s = (v0[j] ? sc4[2 * kr][j] : sc4[2 * kr + 1][j]) + rp[kr * 31 + dsel[j]]; sv[kr][j] = s; mx = fmaxf(mx, s); }
            mx = fmaxf(mx, __shfl_xor(mx, 16)); mx = fmaxf(mx, __shfl_xor(mx, 32));
            float sum = 0.f;
#pragma unroll
            for (int kr = 0; kr < 8; ++kr)
#pragma unroll
                for (int j = 0; j < 4; ++j) { const float pe = __expf(sv[kr][j] - mx); sum += pe; sc4[2 * kr][j] = v0[j] ? pe : 0.f; sc4[2 * kr + 1][j] = v0[j] ? 0.f : pe; }
            sum += __shfl_xor(sum, 16); sum += __shfl_xor(sum, 32);
            const float inv = __builtin_amdgcn_rcpf(sum);
            f32x4 o0 = (f32x4){0.f, 0.f, 0.f, 0.f}, o1 = (f32x4){0.f, 0.f, 0.f, 0.f};
            slot = rs % 9;
            const LAS unsigned char* vb0 = VR + (32 * dh + qn) * AT_VPITCH + (cb + 4 * g) * 2;
#pragma unroll
            for (int kr = 0; kr < 8; ++kr) {
                v4u pw; pw.x = pk2(sc4[2 * kr][0], sc4[2 * kr][1]); pw.y = pk2(sc4[2 * kr][2], sc4[2 * kr][3]); pw.z = pk2(sc4[2 * kr + 1][0], sc4[2 * kr + 1][1]); pw.w = pk2(sc4[2 * kr + 1][2], sc4[2 * kr + 1][3]);
                const bf16x8 pf = __builtin_bit_cast(bf16x8, pw);
                const LAS unsigned char* vp = vb0 + slot * 128;
                const v2u lo0 = *(const LAS v2u*)vp, hi0 = *(const LAS v2u*)(vp + 32), lo1 = *(const LAS v2u*)(vp + 16 * AT_VPITCH), hi1 = *(const LAS v2u*)(vp + 16 * AT_VPITCH + 32);
                o0 = __builtin_amdgcn_mfma_f32_16x16x32_bf16(__builtin_bit_cast(bf16x8, ((v4u){lo0.x, lo0.y, hi0.x, hi0.y})), pf, o0, 0, 0, 0);
                o1 = __builtin_amdgcn_mfma_f32_16x16x32_bf16(__builtin_bit_cast(bf16x8, ((v4u){lo1.x, lo1.y, hi1.x, hi1.y})), pf, o1, 0, 0, 0);
                slot = (slot == 8) ? 0 : slot + 1;
            }
            py0 = (v2u){pk2(o0[0] * inv, o0[1] * inv), pk2(o0[2] * inv, o0[3] * inv)}; py1 = (v2u){pk2(o1[0] * inv, o1[1] * inv), pk2(o1[2] * inv, o1[3] * inv)};
            pop = obase + tokq * opitch + h * 64 + 32 * dh + 4 * g;
            if (newrow) { const int ns = nrow % 9; *(LAS v4u*)(KR + ns * 8192 + kdst) = pk; *(LAS v4u*)(VR + ns * 128 + vdst) = pv; have = nrow; }
            __syncthreads();
        }
        *(v2u*)pop = py0; *(v2u*)(pop + 16) = py1;
    }
    __syncthreads();
}
__device__ __forceinline__ bf16x8 lds_gather8(const LAS bf16* p, int stride) {
    unsigned short e[8];
#pragma unroll
    for (int j = 0; j < 8; ++j) e[j] = p[j * stride];
    v4u w; w.x = e[0] | ((unsigned)e[1] << 16); w.y = e[2] | ((unsigned)e[3] << 16); w.z = e[4] | ((unsigned)e[5] << 16); w.w = e[6] | ((unsigned)e[7] << 16);
    return __builtin_bit_cast(bf16x8, w);
}
constexpr int FA_PITCH = 136, FB_PITCH = 264;
__device__ __forceinline__ void fft_a2_phase(const Frame& F0, const Args& args) {
    const Frame F = fresh(F0);
    const int tid = F.tid, lane = F.lane, wave = F.wave, nl = lane & 31, hh = lane >> 5;
    LAS bf16* GT = (LAS bf16*)(F.lds + RING_OFF);
    LAS bf16* FAL = (LAS bf16*)(F.lds + RING_OFF + 65536);
    const bf16* PROJ = WSP(bf16, WS_PROJ); const bf16* FA = WSP(bf16, WS_FA); const f32x2* TW = WSP(f32x2, WS_TW); bf16* ZP = WSP(bf16, WS_U);
    __syncthreads();
    for (int i = tid; i < 2048; i += 512) { const int r = i >> 4, c = i & 15; *(LAS v4u*)(FAL + r * FA_PITCH + 8 * c) = *(const v4u*)(FA + r * 128 + 8 * c); }
    for (int un = F.vcu; un < 1024; un += F.G) {
        const int b = un >> 8, t2 = (un >> 1) & 127, half = un & 1;
        __syncthreads();
        {
            v4u v[8];
#pragma unroll
            for (int i = 0; i < 8; ++i) { const int idx = tid + 512 * i, k = idx >> 5, c = idx & 31, part = k >> 6, t1 = k & 63;
                v[i] = *(const v4u*)(PROJ + ((size_t)b * T + 128 * t1 + t2) * PROJ_LD + G_OFF + part * 512 + half * 256 + 8 * c); }
#pragma unroll
            for (int i = 0; i < 8; ++i) { const int idx = tid + 512 * i; *(LAS v4u*)(GT + (size_t)idx * 8) = v[i]; }
        }
        __syncthreads();
        {
            const int ch = 32 * wave + nl;
            bf16x8 bf[8];
#pragma unroll
            for (int s = 0; s < 8; ++s) bf[s] = lds_gather8(GT + (16 * s + 8 * hh) * 256 + ch, 256);
            f32x16 acc[4];
#pragma unroll
            for (int mt = 0; mt < 4; ++mt) { acc[mt] = (f32x16){};
#pragma unroll
                for (int s = 0; s < 8; ++s) { const bf16x8 af = *(const LAS bf16x8*)(FAL + (32 * mt + nl) * FA_PITCH + 16 * s + 8 * hh); acc[mt] = __builtin_amdgcn_mfma_f32_32x32x16_bf16(af, bf[s], acc[mt], 0, 0, 0); } }
#pragma unroll
            for (int mt = 0; mt < 2; ++mt)
#pragma unroll
                for (int rg = 0; rg < 16; ++rg) { const int k1 = 32 * mt + (rg & 3) + 8 * (rg >> 2) + 4 * hh; const f32x2 cs = TW[t2 * 64 + k1];
                    const float zr = acc[mt][rg], zi = acc[mt + 2][rg];
                    GT[k1 * 256 + ch] = (bf16)f2bf(zr * cs.x + zi * cs.y); GT[(64 + k1) * 256 + ch] = (bf16)f2bf(zi * cs.x - zr * cs.y);
                    if ((rg & 7) == 7) asm volatile("" ::: "memory"); }
        }
        __syncthreads();
#pragma unroll
        for (int i = 0; i < 8; ++i) { const int idx = tid + 512 * i, m = idx >> 5, c = idx & 31, pp = m >> 6, k1 = m & 63;
            *(v4u*)(ZP + ((size_t)(b * 64 + k1) * 128 + t2) * 1024 + pp * 512 + half * 256 + 8 * c) = *(const LAS v4u*)(GT + (size_t)idx * 8); }
    }
    __syncthreads();
}
__device__ __forceinline__ void fft_b2_phase(const Frame& F0, const Args& args) {
    const Frame F = fresh(F0);
    const int tid = F.tid, lane = F.lane, wave = F.wave, nl = lane & 31, hh = lane >> 5;
    LAS bf16* ZT = (LAS bf16*)(F.lds + RING_OFF);
    LAS bf16* FBL = (LAS bf16*)(F.lds + RING_OFF + 65536);
    bf16* PROJ = WSP(bf16, WS_PROJ); const bf16* FB = WSP(bf16, WS_FB); const bf16* ZP = WSP(bf16, WS_U);
    __syncthreads();
    for (int i = tid; i < 4096; i += 512) { const int r = i >> 5, c = i & 31; *(LAS v4u*)(FBL + r * FB_PITCH + 8 * c) = *(const v4u*)(FB + r * 256 + 8 * c); }
    const int nt = wave & 3, mh = wave >> 2;
    for (int un = F.vcu; un < 1024; un += F.G) {
        const int b = un >> 8, k1 = (un >> 2) & 63, qt = un & 3;
        __syncthreads();
        {
            v4u v[8];
#pragma unroll
            for (int i = 0; i < 8; ++i) { const int idx = tid + 512 * i, k = idx >> 4, c = idx & 15, part = k >> 7, t2 = k & 127;
                v[i] = *(const v4u*)(ZP + ((size_t)(b * 64 + k1) * 128 + t2) * 1024 + part * 512 + qt * 128 + 8 * c); }
#pragma unroll
            for (int i = 0; i < 8; ++i) { const int idx = tid + 512 * i; *(LAS v4u*)(ZT + (size_t)idx * 8) = v[i]; }
        }
        __syncthreads();
        const int ch = 32 * nt + nl;
        f32x16 acc[2];
        acc[0] = (f32x16){}; acc[1] = (f32x16){};
#pragma unroll 1
        for (int sc = 0; sc < 4; ++sc) {
            bf16x8 bf[4];
#pragma unroll
            for (int q = 0; q < 4; ++q) bf[q] = lds_gather8(ZT + (16 * (4 * sc + q) + 8 * hh) * 128 + ch, 128);
#pragma unroll
            for (int m2 = 0; m2 < 2; ++m2)
#pragma unroll
                for (int q = 0; q < 4; ++q) { const bf16x8 af = *(const LAS bf16x8*)(FBL + (64 * mh + 32 * m2 + nl) * FB_PITCH + 16 * (4 * sc + q) + 8 * hh); acc[m2] = __builtin_amdgcn_mfma_f32_32x32x16_bf16(af, bf[q], acc[m2], 0, 0, 0); }
        }
        __syncthreads();
#pragma unroll
        for (int m2 = 0; m2 < 2; ++m2)
#pragma unroll
            for (int rg = 0; rg < 16; ++rg) { const int k2 = 64 * mh + 32 * m2 + (rg & 3) + 8 * (rg >> 2) + 4 * hh; ZT[k2 * 128 + ch] = (bf16)f2bf(acc[m2][rg] * (1.0f / 1024.0f)); }
        __syncthreads();
#pragma unroll
        for (int i = 0; i < 4; ++i) { const int idx = tid + 512 * i, k2 = idx >> 4, c = idx & 15;
            *(v4u*)(PROJ + ((size_t)b * T + k1 + 64 * k2) * PROJ_LD + G_OFF + qt * 128 + 8 * c) = *(const LAS v4u*)(ZT + (size_t)idx * 8); }
    }
    __syncthreads();
}
__device__ __forceinline__ int fresh_bid() { int b = (int)blockIdx.x; asm volatile("" : "+s"(b)); return b; }
constexpr int PPL = 9, N_PHASES = 2 + PPL * DEPTH;
__global__ void __launch_bounds__(NWAVES * 64, 2) mega_fwd(Args args, int li) {
    extern __shared__ __attribute__((aligned(16))) unsigned char lds[];
    Frame F;
    F.lds = (LAS unsigned char*)lds;
    F.MISC = (volatile LAS unsigned*)(F.lds + MISC_OFF);
    F.tid = threadIdx.x; F.lane = F.tid & 63; F.wave = __builtin_amdgcn_readfirstlane(F.tid >> 6);
    F.G = gridDim.x; { const int bx = blockIdx.x; F.vcu = (F.G % 8 == 0) ? (bx % 8) * (F.G / 8) + bx / 8 : bx; }
    F.ctl = (gu32*)(args.ws + WS_CTL);
    for (int u = F.tid; u < (LDS_BYTES - LDSCTL_OFF) / 4; u += NWAVES * 64) ((LAS unsigned*)(F.lds + LDSCTL_OFF))[u] = 0u;
    __syncthreads();
    const int lo = args.ph_lo, hi = args.ph_hi;
    XcdBarrier bar; bar.bar = (unsigned*)(F.ctl + CW_BAR) + li * XCD_BAR_WORDS; bar.x = 0; bar.st = nullptr;
    if (hi - lo > 1) bar = xcd_barrier_post((unsigned*)(F.ctl + CW_BAR) + li * XCD_BAR_WORDS, F.MISC + 8);
#ifndef PHMASK
#define PHMASK 0xFFFF
#endif
#define EN(kind) ((PHMASK >> (kind)) & 1)
#define IN(k) (lo <= (k) && (k) < hi)
#define SEAM(k) do { if (IN(k) && IN((k) + 1)) { xcd_barrier(bar); for (int rb_ = 0; rb_ < REP_B; ++rb_) xcd_barrier(bar); } } while (0)

    if (EN(0) && IN(0)) { for (int rep = 0; rep < 1 + REP_C; ++rep) p0_prologue(F, args); SEAM(0); }
    for (int l = 0; l < DEPTH; ++l) {
        const int pb = 1 + PPL * l;
        bf16* U = WSP(bf16, WS_U); bf16* PROJ = WSP(bf16, WS_PROJ); bf16* GATES = WSP(bf16, WS_GATES);
        if (EN(1) && IN(pb + 0)) { if (l == 0) { for (int rep = 0; rep < (REP_R & 1); ++rep) rows_phase<0>(F, args, l); rows_phase<0>(F, args, l); } else rows_phase<1>(F, args, l); SEAM(pb + 0); }
        if (EN(2) && IN(pb + 1)) {
            pg8::Gemm g{U, U, U, WSP(bf16, WS_WP2) + (size_t)l * NP2 * 1024, nullptr, nullptr, 1024, 1024, 1024};
            pg8::StaticOrder S; S.init(NTOK, NP2, F.G, fresh_bid());
            EpiP2 E{PROJ, WSP(bf16, WS_VT), GATES, INP(8) + l * 3072};
            for (int rep = 0; rep < 1 + (REP_GS & 1 ? REP_G : 0); ++rep) pg8::gemm_phase<EpiP2, pg8::StaticOrder, true>(F.lds + RING_OFF, g, S, E, fresh(F).tid);
            SEAM(pb + 1);
        }
        if (EN(3) && IN(pb + 2)) {
            for (int rep = 0; rep < REP_M; ++rep) { if (REP_MS & 1) attn2_phase(F, args, l, WSP(bf16, WS_SCR), 512); if (REP_MS & 2) lru_conv_phase(F, args, l); if (REP_MS & 4) fft_a2_phase(F, args); if (REP_MS & 16) fft_a2_phase(F, args); }
            lru_conv_phase(F, args, l); attn2_phase(F, args, l, PROJ, PROJ_LD); fft_a2_phase(F, args); SEAM(pb + 2); }
        if (EN(4) && IN(pb + 3)) { for (int rep = 0; rep < REP_M; ++rep) { if (REP_MS & 2) lru2_phase(F, args, l, WSP(bf16, WS_SCR), 512, 0); if (REP_MS & 4) fft_b2_phase(F, args); if (REP_MS & 32) fft_b2_phase(F, args); }
            lru2_phase(F, args, l, PROJ, PROJ_LD, YR_OFF); fft_b2_phase(F, args); SEAM(pb + 3); }
        if (EN(6) && IN(pb + 4)) {
            const bf16* WP = WSP(bf16, WS_WPROJ) + (size_t)l * 3 * 1024 * 512;
            pg8::Gemm g{PROJ + Q_OFF, PROJ + YR_OFF, PROJ + G_OFF, WP, WP + 1024 * 512, WP + 2 * 1024 * 512, PROJ_LD, 512, 512};
            pg8::MergeOrder S; S.init(NTOK, 1024, F.G, fresh_bid());
            EpiMerge E{GATES, U};
            for (int rep = 0; rep < 1 + (REP_GS & 2 ? REP_G : 0); ++rep) pg8::gemm_phase<EpiMerge, pg8::MergeOrder, true>(F.lds + RING_OFF, g, S, E, fresh(F).tid);
            SEAM(pb + 4);
        }
        if (EN(7) && IN(pb + 5)) {
            pg8::Gemm g{U, U, U, WSP(bf16, WS_WOUT) + (size_t)l * 1024 * 1024, nullptr, nullptr, 1024, 1024, 1024};
            pg8::StaticOrder S; S.init(NTOK, 1024, F.G, fresh_bid());
            EpiResid E{l == 0 ? INP(0) : (const float*)args.out, args.out, WSP(float, WS_MOD) + (size_t)l * 4 * 6144 + 2 * 1024};
            for (int rep = 0; rep < (REP_GS & 4 ? REP_G : 0); ++rep) { EpiResid E2{E.xin, WSP(float, WS_GATES), E.gt}; pg8::gemm_phase<EpiResid, pg8::StaticOrder, true>(F.lds + RING_OFF, g, S, E2, fresh(F).tid); }
            pg8::gemm_phase<EpiResid, pg8::StaticOrder, true>(F.lds + RING_OFF, g, S, E, fresh(F).tid);
            SEAM(pb + 5);
        }
        if (EN(8) && IN(pb + 6)) { if (REP_R & 2) router_phase(F, args, l, 2 + l); router_phase(F, args, l, l); SEAM(pb + 6); }
        if (EN(10) && IN(pb + 7)) {
            moe_tilebase(F, args, l);
            pg8::Gemm g{U, U, U, WSP(bf16, WS_WG1), nullptr, nullptr, 1024, 1024, 1024};
            pg8::MoeOrder S{(const LAS int*)(F.lds + MISC_OFF + 64), F.G, fresh_bid()};
            LAS int* rowmap = (LAS int*)(F.lds + XTRA_OFF);
            moe_rowmaps(F, args, S, rowmap);
            EpiSwiGLU E{WSP(bf16, WS_H)};
            for (int rep = 0; rep < 1 + (REP_GS & 8 ? REP_G : 0); ++rep) pg8::gemm_phase<EpiSwiGLU, pg8::MoeOrder, true, true>(F.lds + RING_OFF, g, S, E, fresh(F).tid, rowmap);
            SEAM(pb + 7);
        }
        if (EN(11) && IN(pb + 8)) {
            moe_tilebase(F, args, l);
            const bf16* H = WSP(bf16, WS_H);
            pg8::Gemm g{H, H, H, WSP(bf16, WS_WD), nullptr, nullptr, 512, 512, 512};
            pg8::MoeOrder S{(const LAS int*)(F.lds + MISC_OFF + 64), F.G, fresh_bid()};
            EpiYE E{PROJ};
            for (int rep = 0; rep < 1 + (REP_GS & 16 ? REP_G : 0); ++rep) pg8::gemm_phase<EpiYE, pg8::MoeOrder, true>(F.lds + RING_OFF, g, S, E, fresh(F).tid);
            SEAM(pb + 8);
        }
    }
    if (EN(12) && IN(N_PHASES - 1)) rows_phase<2>(F, args, DEPTH);
#undef IN
#undef SEAM
}

#ifndef MK_MODE
#define MK_MODE 0
#endif
extern "C" void kernel_launch(void* const* d_in, const int* in_sizes, int n_in, void* d_out, int out_size, void* d_ws, size_t ws_size, hipStream_t stream) {
    static int grid = 0;
    if (grid == 0) {
        if (n_in != 27 || in_sizes[0] != NTOK * D || out_size != NTOK * D || ws_size < WS_END) { fprintf(stderr, "kernel_launch: unexpected shapes (n_in %d, in0 %d, out %d, ws %zu < %zu)\n", n_in, n_in > 0 ? in_sizes[0] : -1, out_size, ws_size, (size_t)WS_END); grid = -1; return; }
        int dev = 0, cus = 0;
        if (hipGetDevice(&dev) != hipSuccess || hipDeviceGetAttribute(&cus, hipDeviceAttributeMultiprocessorCount, dev) != hipSuccess) { grid = -1; return; }
        if (hipFuncSetAttribute((const void*)mega_fwd, hipFuncAttributeMaxDynamicSharedMemorySize, LDS_BYTES) != hipSuccess) { fprintf(stderr, "kernel_launch: hipFuncSetAttribute failed\n"); grid = -1; return; }
        (void)hipGetLastError();
        grid = cus;
    }
    if (grid < 0) return;
    if (hipMemsetAsync((char*)d_ws + WS_CTL, 0, CTL_ZERO_BYTES, stream) != hipSuccess) return;
    Args a{};
    for (int i = 0; i < 27; ++i) a.in[i] = (const float*)d_in[i];
    a.out = (float*)d_out; a.ws = (unsigned char*)d_ws;
#if MK_MODE == 0
    a.ph_lo = 0; a.ph_hi = N_PHASES;
    hipLaunchKernelGGL(mega_fwd, dim3(grid), dim3(NWAVES * 64), LDS_BYTES, stream, a, 0);
#else
    for (int p = 0; p < N_PHASES; ++p) { a.ph_lo = p; a.ph_hi = p + 1; hipLaunchKernelGGL(mega_fwd, dim3(grid), dim3(NWAVES * 64), LDS_BYTES, stream, a, 0); }
#endif
}
```

```cpp
#include <hip/hip_runtime.h>
#include <cstdio>
#include <cstdint>
namespace pg8 {
#define PG8_LAS __attribute__((address_space(3)))
typedef unsigned short bf16_t;
typedef short bf16x8 __attribute__((ext_vector_type(8)));
typedef float f32x4 __attribute__((ext_vector_type(4)));
typedef unsigned u32x4 __attribute__((ext_vector_type(4)));
typedef unsigned u32x2 __attribute__((ext_vector_type(2)));
constexpr int BM = 256, BK = 64, HALF = 128, HTB = HALF * BK * 2  , STAGE_BYTES = 8 * HTB, NXCD = 8, WGM = 8;

__host__ __device__ __forceinline__ int lds_byte(int r, int c) { const int st = (r >> 4) * 2 + (c >> 5), rr = r & 15, cc = c & 31, ob = rr * 64 + cc * 2; return st * 1024 + (ob ^ (((ob >> 9) & 1) << 5)); }
__host__ __device__ __forceinline__ void stage_rc(int b, int& R, int& C) { const int st = b / 1024, sb = b % 1024, swz = sb ^ (((sb >> 9) & 1) << 5); R = (st >> 1) * 16 + swz / 64; C = (st & 1) * 32 + (swz % 64) / 2; }
__host__ __device__ __forceinline__ int perm32(int rho) { const int n = rho >> 4, i = rho & 15; return 8 * (i >> 2) + 4 * n + (i & 3); }

struct Unit { int pm, pn, bt, z, gbase, gcnt; };
struct Gemm { const bf16_t* A0; const bf16_t* A1; const bf16_t* A2; const bf16_t* B0; const bf16_t* B1; const bf16_t* B2; int lda, ldb, K; };

__device__ __forceinline__ unsigned cvt_pk_bf16(float lo, float hi) { unsigned r; asm volatile("v_cvt_pk_bf16_f32 %0, %1, %2" : "=v"(r) : "v"(lo), "v"(hi)); return r; }

struct StaticOrder {
    int nM, nN, nwg, G, c;
    __device__ void init(int M, int N, int G_, int c_) { nM = M / BM; nN = N / BM; nwg = nM * nN; G = G_; c = c_; }
    __device__ __forceinline__ bool tile(long L, Unit& u) const {
        if (L >= nwg) return false;
        int wgid = (int)L; { const int q = nwg / NXCD, r = nwg % NXCD, xcd = wgid % NXCD, off = wgid / NXCD; wgid = (xcd < r ? xcd * (q + 1) : r * (q + 1) + (xcd - r) * q) + off; }
        const int nig = WGM * nN, gid = wgid / nig, fm = gid * WGM, gsz = (nM - fm) < WGM ? (nM - fm) : WGM;
        u.pm = fm + ((wgid % nig) % gsz); u.pn = (wgid % nig) / gsz; u.bt = u.pn; u.z = 0; u.gbase = 0; u.gcnt = 0; return true;
    }
    __device__ __forceinline__ bool next(int i, Unit& u) const { return tile((long)i * G + c, u); }
};
struct MergeOrder : StaticOrder {
    __device__ __forceinline__ bool next(int i, Unit& u) const { const int t = i / 3; if (!tile((long)t * G + c, u)) return false; u.z = i - 3 * t; return true; }
};
struct MoeOrder {
    const PG8_LAS int* tb; int G, c;
    __device__ __forceinline__ bool next(int i, Unit& u) const {
        const int L = i * G + c; const int nt = tb[32]; if (L >= nt * 4) return false;
        const int t = L >> 2, j = L & 3; int e = 0;
#pragma unroll 1
        for (int k = 1; k < 32; ++k) e += (tb[k] <= t) ? 1 : 0;
        const int tl = t - tb[e];
        u.pm = t; u.pn = j; u.bt = e * 4 + j; u.z = 0; u.gbase = e * 32768 + 256 * tl; u.gcnt = tb[33 + e] - 256 * tl; return true;
    }
};

template <class Epi, class Sched, bool ALIGN_EPI, bool GATHER = false>
__device__ __forceinline__ void gemm_phase(PG8_LAS unsigned char* lds, const Gemm g, const Sched& S, const Epi& E, const int tid, const PG8_LAS int* rowmap = nullptr) {
    const int wid = __builtin_amdgcn_readfirstlane(tid >> 6), lane = tid & 63, wr = wid >> 2, wc = wid & 3, fr = lane & 15, fq = lane >> 4;
    const int K = g.K, nt = K / BK;
    unsigned voffA[2], voffB[2]; int gR[2];
#pragma unroll
    for (int i = 0; i < 2; ++i) { int R, C; stage_rc(tid * 16 + i * 8192, R, C); const int Rb = Epi::PERM ? ((R & ~31) + perm32(R & 31)) : R;
        voffA[i] = GATHER ? (unsigned)C * 2u : (unsigned)(R * g.lda + C) * 2u; voffB[i] = (unsigned)(Rb * g.ldb + C) * 2u; gR[i] = R; }
    unsigned offC[2][2], offN[2][2];
#define PG8_GOFF(dst, ui_) do { _Pragma("unroll") for (int h_ = 0; h_ < 2; ++h_) _Pragma("unroll") for (int i_ = 0; i_ < 2; ++i_) dst[h_][i_] = (unsigned)rowmap[(ui_) * 256 + 128 * h_ + gR[i_]] * (unsigned)(g.lda * 2) + voffA[i_]; } while (0)
    const size_t kstep = (size_t)(BK * 2);
    const size_t hstepA = (size_t)HALF * g.lda * 2, hstepB = (size_t)HALF * g.ldb * 2;
    const size_t tstepA = 2 * hstepA, tstepB = 2 * hstepB;
    const unsigned ldsw = (unsigned)wid * 1024u;
    const int aoff = lds_byte(wr * 64 + fr, fq * 8), boff = lds_byte(wc * 32 + fr, fq * 8);
#define PG8_SA(b, h) (((b) * 2 + (h)) * HTB)
#define PG8_SB(b, h) ((4 + (b) * 2 + (h)) * HTB)
#define PG8_STAGE(bufoff, gbase, voff) do { _Pragma("unroll") for (int _i = 0; _i < 2; ++_i) \
        __builtin_amdgcn_global_load_lds((const unsigned*)((const char*)(gbase) + (voff)[_i]), (PG8_LAS unsigned*)(lds + (bufoff) + ldsw + _i * 8192), 16, 0, 0); } while (0)
#define PG8_STAGE_A(bufoff, gbase, h, nf) do { _Pragma("unroll") for (int _i = 0; _i < 2; ++_i) { const unsigned o_ = GATHER ? ((nf) ? offN[h][_i] : offC[h][_i]) : (voffA[_i] + (unsigned)((h) * hstepA)); \
        __builtin_amdgcn_global_load_lds((const unsigned*)((const char*)(gbase) + o_), (PG8_LAS unsigned*)(lds + (bufoff) + ldsw + _i * 8192), 16, 0, 0); } } while (0)
#define PG8_LDA(dst, b, h) do { _Pragma("unroll") for (int m = 0; m < 4; ++m) _Pragma("unroll") for (int k = 0; k < 2; ++k) dst[m][k] = *(const PG8_LAS bf16x8*)(lds + PG8_SA(b, h) + aoff + m * 2048 + k * 1024); } while (0)
#define PG8_LDB(dst, b, h) do { _Pragma("unroll") for (int n = 0; n < 2; ++n) _Pragma("unroll") for (int k = 0; k < 2; ++k) dst[n][k] = *(const PG8_LAS bf16x8*)(lds + PG8_SB(b, h) + boff + n * 2048 + k * 1024); } while (0)
#define PG8_MMA(ai, bj, At, Bt) do { __builtin_amdgcn_s_setprio(1); _Pragma("unroll") for (int m = 0; m < 4; ++m) _Pragma("unroll") for (int n = 0; n < 2; ++n) _Pragma("unroll") for (int k = 0; k < 2; ++k) \
        acc[ai][bj][m][n] = __builtin_amdgcn_mfma_f32_16x16x32_bf16(Bt[n][k], At[m][k], acc[ai][bj][m][n], 0, 0, 0); __builtin_amdgcn_s_setprio(0); } while (0)
#define PG8_WAIT_V(n) asm volatile("s_waitcnt vmcnt(" #n ")" ::: "memory")
#define PG8_WAIT_L(n) asm volatile("s_waitcnt lgkmcnt(" #n ")" ::: "memory")
#define PG8_BAR __builtin_amdgcn_s_barrier()
#define PG8_SCHED __builtin_amdgcn_sched_barrier(0)
#define PG8_APTR(u) (GATHER ? (const char*)g.A0 : (const char*)((u).z == 0 ? g.A0 : ((u).z == 1 ? g.A1 : g.A2)) + (size_t)(u).pm * tstepA)
#define PG8_BPTR(u) ((const char*)((u).z == 0 ? g.B0 : ((u).z == 1 ? g.B1 : g.B2)) + (size_t)(u).bt * tstepB)
    Unit cur, nxt; int ui = 0;
    if (!S.next(0, cur)) return;
    f32x4 acc[2][2][4][2];
#pragma unroll
    for (int a = 0; a < 2; ++a)
#pragma unroll
        for (int b = 0; b < 2; ++b)
#pragma unroll
            for (int m = 0; m < 4; ++m)
#pragma unroll
                for (int n = 0; n < 2; ++n) acc[a][b][m][n] = (f32x4){0.f, 0.f, 0.f, 0.f};
    bf16x8 At[4][2], B0[2][2], B1[2][2];
    const char* cA = PG8_APTR(cur); const char* cB = PG8_BPTR(cur);
    if constexpr (GATHER) { PG8_GOFF(offC, 0); PG8_GOFF(offN, 0); }
    PG8_STAGE(PG8_SB(0, 0), cB, voffB); PG8_STAGE(PG8_SB(0, 1), cB + hstepB, voffB); PG8_STAGE_A(PG8_SA(0, 0), cA, 0, false); PG8_STAGE_A(PG8_SA(0, 1), cA, 1, false);
    if (wr == 1) PG8_BAR;
    PG8_WAIT_V(2); PG8_BAR;
    PG8_STAGE(PG8_SB(1, 0), cB + kstep, voffB); PG8_STAGE_A(PG8_SA(1, 0), cA + kstep, 0, false); PG8_STAGE(PG8_SB(1, 1), cB + hstepB + kstep, voffB);
    PG8_WAIT_V(6); PG8_BAR;
    for (;;) {
        const bool has_next = S.next(ui + 1, nxt);
        const char* nA = has_next ? PG8_APTR(nxt) : cA; const char* nB = has_next ? PG8_BPTR(nxt) : cB;
        if constexpr (GATHER) { if (has_next) { PG8_GOFF(offN, ui + 1); } else { _Pragma("unroll") for (int h_ = 0; h_ < 2; ++h_) _Pragma("unroll") for (int i_ = 0; i_ < 2; ++i_) offN[h_][i_] = offC[h_][i_]; } }
        for (int t = 0; t < nt; t += 2) {
            const bool last = (t == nt - 2);
            const char* a1 = cA + (size_t)(t + 1) * kstep;
            const char* a2 = last ? nA : cA + (size_t)(t + 2) * kstep; const char* b2 = last ? nB : cB + (size_t)(t + 2) * kstep;
            const char* a3 = a2 + kstep; const char* b3 = b2 + kstep;
            PG8_LDB(B0, 0, 0); PG8_LDB(B1, 0, 1); PG8_SCHED; PG8_LDA(At, 0, 0); PG8_STAGE_A(PG8_SA(1, 1), a1, 1, false);
            PG8_WAIT_V(8); PG8_WAIT_L(0); PG8_BAR; PG8_MMA(0, 0, At, B0); PG8_MMA(0, 1, At, B1); PG8_BAR; PG8_SCHED;
            PG8_LDA(At, 0, 1); PG8_STAGE(PG8_SB(0, 0), b2, voffB); PG8_STAGE(PG8_SB(0, 1), b2 + hstepB, voffB); PG8_STAGE_A(PG8_SA(0, 0), a2, 0, last);
            PG8_WAIT_V(8); PG8_WAIT_L(0); PG8_BAR; PG8_MMA(1, 0, At, B0); PG8_MMA(1, 1, At, B1); PG8_BAR; PG8_SCHED;
            PG8_LDB(B0, 1, 0); PG8_LDB(B1, 1, 1); PG8_SCHED; PG8_LDA(At, 1, 0); PG8_STAGE_A(PG8_SA(0, 1), a2, 1, last);
            PG8_WAIT_V(8); PG8_WAIT_L(0); PG8_BAR; PG8_MMA(0, 0, At, B0); PG8_MMA(0, 1, At, B1); PG8_BAR; PG8_SCHED;
            PG8_LDA(At, 1, 1); PG8_STAGE(PG8_SB(1, 0), b3, voffB); PG8_STAGE(PG8_SB(1, 1), b3 + hstepB, voffB); PG8_STAGE_A(PG8_SA(1, 0), a3, 0, last);
            PG8_WAIT_V(8); PG8_WAIT_L(0); PG8_BAR; PG8_MMA(1, 0, At, B0); PG8_MMA(1, 1, At, B1); PG8_BAR; PG8_SCHED;
        }
        if constexpr (ALIGN_EPI) { if (wr == 0) PG8_BAR; }
        E(acc, cur, wr, wc, fr, fq);
        if (!has_next) break;
#pragma unroll
        for (int a = 0; a < 2; ++a)
#pragma unroll
            for (int b = 0; b < 2; ++b)
#pragma unroll
                for (int m = 0; m < 4; ++m)
#pragma unroll
                    for (int n = 0; n < 2; ++n) acc[a][b][m][n] = (f32x4){0.f, 0.f, 0.f, 0.f};
        cur = nxt; cA = nA; cB = nB; ++ui;
        if constexpr (GATHER) { _Pragma("unroll") for (int h_ = 0; h_ < 2; ++h_) _Pragma("unroll") for (int i_ = 0; i_ < 2; ++i_) offC[h_][i_] = offN[h_][i_]; }
        if constexpr (ALIGN_EPI) { if (wr == 1) PG8_BAR; }
    }
    PG8_WAIT_V(0);
    if constexpr (!ALIGN_EPI) { if (wr == 0) PG8_BAR; }
    PG8_BAR;
#undef PG8_SA
#undef PG8_SB
#undef PG8_STAGE
#undef PG8_LDA
#undef PG8_LDB
#undef PG8_MMA
#undef PG8_WAIT_V
#undef PG8_WAIT_L
#undef PG8_BAR
#undef PG8_SCHED
#undef PG8_APTR
#undef PG8_STAGE_A
#undef PG8_GOFF
#undef PG8_BPTR
}
}
constexpr int NWAVES = 8;
constexpr int NB = 4, T = 8192, D = 1024, NTOK = NB * T, DEPTH = 2;
constexpr int PROJ_LD = 3072, Q_OFF = 0, K_OFF = 512, XR_OFF = 1024, YR_OFF = 1536, G_OFF = 2048;
constexpr int GATES_LD = 3072;
constexpr int NP2 = 6656;
constexpr int NEXP = 32, XS_ROWS = 73728;
constexpr int LRU_CH = 32, LRU_NCH = T / LRU_CH;
constexpr float EPS = 1e-6f;

constexpr size_t MiB = 1u << 20;
constexpr size_t WS_CTL = 0, CTL_ZERO_BYTES = 1 * MiB;
constexpr size_t WS_MOD = 1 * MiB;
constexpr size_t WS_FA = WS_MOD + 256 * 1024;
constexpr size_t WS_FB = WS_FA + 32 * 1024;
constexpr size_t WS_TW = WS_FB + 64 * 1024;
constexpr size_t WS_WL = 2 * MiB;
constexpr size_t WS_TOKW = 3 * MiB;
constexpr size_t WS_TOKROW = WS_TOKW + 256 * 1024;
constexpr size_t WS_PERM = 4 * MiB;
constexpr size_t WS_LSUM = 8 * MiB;
constexpr size_t WS_LCAR = 16 * MiB;
constexpr size_t WS_WP2 = 20 * MiB;
constexpr size_t WS_WPROJ = 46 * MiB;
constexpr size_t WS_WOUT = 52 * MiB;
constexpr size_t WS_U = 56 * MiB;
constexpr size_t WS_VT = 120 * MiB;
constexpr size_t WS_PROJ = 152 * MiB;
constexpr size_t WS_GATES = 344 * MiB;
constexpr size_t WS_WG1 = WS_GATES, WS_WD = WS_GATES + 64 * MiB, WS_H = WS_GATES + 96 * MiB;
constexpr size_t WS_XC = 536 * MiB;
constexpr size_t WS_END = 568 * MiB;
constexpr size_t WS_SCR = 568 * MiB;
#ifndef REP_G
#define REP_G 0
#endif
#ifndef REP_C
#define REP_C 0
#endif
#ifndef REP_DBG
#define REP_DBG 0
#endif
#ifndef REP_B
#define REP_B 0
#endif
#ifndef REP_R
#define REP_R 0
#endif
#ifndef REP_GS
#define REP_GS 31
#endif
#ifndef REP_MS
#define REP_MS 15
#endif
#ifndef REP_M
#define REP_M 0
#endif
static_assert(WS_H + (size_t)XS_ROWS * 512 * 2 <= WS_END, "ws map");
constexpr int CW_BAR = 4096;
constexpr int CW_ECNT = 16384;

constexpr int LDS_BYTES = 163840;
constexpr int RING_OFF = 0, RING_BYTES = 131072;
constexpr int XTRA_OFF = RING_BYTES;
constexpr int LDSCTL_OFF = LDS_BYTES - 512, MISC_OFF = LDSCTL_OFF + 64;

#define GAS __attribute__((address_space(1)))
#define LAS __attribute__((address_space(3)))
typedef unsigned short bf16;
typedef unsigned v4u __attribute__((ext_vector_type(4)));
typedef unsigned v2u __attribute__((ext_vector_type(2)));
typedef float f32x4 __attribute__((ext_vector_type(4)));
typedef float f32x2 __attribute__((ext_vector_type(2)));
typedef float f32x16 __attribute__((ext_vector_type(16)));
typedef short bf16x8 __attribute__((ext_vector_type(8)));
typedef short bf16x4 __attribute__((ext_vector_type(4)));
typedef GAS unsigned gu32;
#define RLX_AGENT __ATOMIC_RELAXED, __HIP_MEMORY_SCOPE_AGENT
#define LDS_WAIT() asm volatile("s_waitcnt lgkmcnt(0)" ::: "memory")
#define VM_WAIT() asm volatile("s_waitcnt vmcnt(0)" ::: "memory")
typedef __bf16 hwbf16x2 __attribute__((ext_vector_type(2)));
__device__ __forceinline__ unsigned pk2(float lo, float hi) { f32x2 v = {lo, hi}; hwbf16x2 b = __builtin_convertvector(v, hwbf16x2); return __builtin_bit_cast(unsigned, b); }
__device__ __forceinline__ unsigned f2bf(float f) { return pk2(f, 0.f) & 0xffffu; }
__device__ __forceinline__ float bflo(unsigned w) { return __builtin_bit_cast(float, w << 16); }
__device__ __forceinline__ float bfhi(unsigned w) { return __builtin_bit_cast(float, w & 0xffff0000u); }
__device__ __forceinline__ float bf2f(unsigned short h) { return __builtin_bit_cast(float, (unsigned)h << 16); }
__device__ __forceinline__ float sigmoidf(float v) { return 1.0f / (1.0f + __expf(-v)); }
__device__ __forceinline__ float fsigmoid(float v) { return __builtin_amdgcn_rcpf(1.0f + __expf(-v)); }
__device__ __forceinline__ float wave_sum(float v) {
#pragma unroll
    for (int o = 1; o < 64; o <<= 1) v += __shfl_xor(v, o);
    return v;
}
#define XB_TMO      128
#define XB_XCNT(j)  (256  + 64 * (j))
#define XB_XSUB(j)  (1280 + 64 * (j))
#define XB_XGEN(j)  (2304 + 64 * (j))
#define XB_TOP      3328
#define XB_TOPGEN   3392
#define XCD_BAR_WORDS 3456
#define XB_SPIN_CAP (1u << 18)

__device__ __forceinline__ unsigned xb_ld(unsigned* p)              { return __hip_atomic_load(p, __ATOMIC_RELAXED, __HIP_MEMORY_SCOPE_AGENT); }
__device__ __forceinline__ unsigned xb_add(unsigned* p, unsigned v) { return __hip_atomic_fetch_add(p, v, __ATOMIC_RELAXED, __HIP_MEMORY_SCOPE_AGENT); }
__device__ __forceinline__ unsigned xb_xcc_id() { return (unsigned)__builtin_amdgcn_s_getreg((3 << 11) | 20) & 0xFu; }
#define XB_SPIN(cond, bar) do { unsigned _sp = 0; while (cond) { __builtin_amdgcn_s_sleep(1); \
    if ((++_sp & 255u) == 0u) { if (xb_ld(&(bar)[XB_TMO])) break; if (_sp > XB_SPIN_CAP) { atomicAdd(&(bar)[XB_TMO], 1u); break; } } } } while (0)

struct XcdBarrier {
    unsigned* bar; unsigned x;
    volatile LAS unsigned* st;
};

__device__ __forceinline__ XcdBarrier xcd_barrier_post(unsigned* bar, volatile LAS unsigned* st) {
    XcdBarrier b; b.bar = bar; b.x = xb_xcc_id(); b.st = st;
    if (threadIdx.x == 0) (void)xb_add(&bar[XB_XCNT(b.x)], 1u);
    return b;
}
__device__ __forceinline__ void xcd_barrier_complete(unsigned* bar, unsigned x, unsigned& nloc, unsigned& nx) {
    const unsigned G = gridDim.x * gridDim.y * gridDim.z;
    unsigned sum, cnt, mine, sp = 0u;
    for (;;) {
        sum = 0u; cnt = 0u; mine = 0u;
#pragma unroll
        for (unsigned j = 0; j < 16; ++j) { const unsigned c = xb_ld(&bar[XB_XCNT(j)]); sum += c; cnt += (c > 0u) ? 1u : 0u; mine = (j == x) ? c : mine; }
        if (sum == G) break;
        __builtin_amdgcn_s_sleep(1);
        if ((++sp & 255u) == 0u) { if (xb_ld(&bar[XB_TMO])) break; if (sp > XB_SPIN_CAP) { atomicAdd(&bar[XB_TMO], 1u); break; } }
    }
    nloc = mine > 0u ? mine : 1u; nx = cnt > 0u ? cnt : 1u;
}

__device__ __forceinline__ void xcd_barrier(const XcdBarrier& b) {
    asm volatile("s_waitcnt vmcnt(0)" ::: "memory");
    __syncthreads();
    if (threadIdx.x == 0) {
        unsigned* bar = b.bar;
        __builtin_amdgcn_s_waitcnt(0);
        unsigned nloc = b.st[0], nx = b.st[1];
        if (nloc == 0u) { xcd_barrier_complete(bar, b.x, nloc, nx); b.st[0] = nloc; b.st[1] = nx; }
        const unsigned old = xb_add(&bar[XB_XSUB(b.x)], 1u);
        const unsigned gen = old / nloc;
        if (old + 1u == (gen + 1u) * nloc) {
            __builtin_amdgcn_fence(__ATOMIC_RELEASE, "agent");
            asm volatile("s_waitcnt vmcnt(0)" ::: "memory");
            const unsigned og = xb_add(&bar[XB_TOP], 1u);
            const unsigned tg = og / nx;
            if (og + 1u == (tg + 1u) * nx) xb_add(&bar[XB_TOPGEN], 1u);
            else XB_SPIN(xb_ld(&bar[XB_TOPGEN]) == tg, bar);
            __builtin_amdgcn_fence(__ATOMIC_ACQUIRE, "agent");
            xb_add(&bar[XB_XGEN(b.x)], 1u);
            asm volatile("s_waitcnt vmcnt(0)" ::: "memory");
        } else {
            XB_SPIN(xb_ld(&bar[XB_XGEN(b.x)]) == gen, bar);
            __builtin_amdgcn_fence(__ATOMIC_ACQUIRE, "agent");
            asm volatile("s_waitcnt vmcnt(0)" ::: "memory");
        }
    }
    __syncthreads();
}

struct Args { const float* in[27]; float* out; unsigned char* ws; int ph_lo, ph_hi; };
struct Frame {
    LAS unsigned char* lds;
    volatile LAS unsigned* MISC;
    gu32* ctl;
    int tid, lane, wave, vcu, G;
};
__device__ __forceinline__ Frame fresh(const Frame& F) {
    Frame N = F; int t = F.tid; asm volatile("" : "+v"(t)); N.tid = t; N.lane = t & 63; N.wave = __builtin_amdgcn_readfirstlane(t >> 6);
    int v = F.vcu; asm volatile("" : "+s"(v)); N.vcu = v; int g = F.G; asm volatile("" : "+s"(g)); N.G = g; return N;
}
#define WSP(T_, off) ((T_*)(args.ws + (off)))
#define INP(i) (args.in[i])

struct TrItem { const float* W; int ldw, k0, n0; bf16* dst; int ldd; };
__device__ __forceinline__ void tr_load(const TrItem& it, f32x4 (&v)[8], int lane) {
    const float* p = it.W + (size_t)(it.k0 + (lane >> 3)) * it.ldw + it.n0 + 4 * (lane & 7);
#pragma unroll
    for (int i = 0; i < 8; ++i) v[i] = *(const f32x4*)(p + (size_t)(8 * i) * it.ldw);
}
__device__ __forceinline__ void tr_finish(const TrItem& it, const f32x4 (&v)[8], LAS float* scr, int lane) {
#pragma unroll
    for (int i = 0; i < 8; ++i) { LAS float* d = scr + (8 * i + (lane >> 3)) * 33 + 4 * (lane & 7); d[0] = v[i].x; d[1] = v[i].y; d[2] = v[i].z; d[3] = v[i].w; }
    LDS_WAIT(); asm volatile("" ::: "memory");
    const int c = lane & 7;
#pragma unroll
    for (int j = 0; j < 4; ++j) { const int n = (lane >> 3) + 8 * j; const LAS float* s = scr + (8 * c) * 33 + n;
        v4u o; o.x = pk2(s[0 * 33], s[1 * 33]); o.y = pk2(s[2 * 33], s[3 * 33]); o.z = pk2(s[4 * 33], s[5 * 33]); o.w = pk2(s[6 * 33], s[7 * 33]);
        *(v4u*)(it.dst + (size_t)n * it.ldd + it.k0 + 8 * c) = o; }
    LDS_WAIT(); asm volatile("" ::: "memory");
}
__device__ __forceinline__ void transpose_item(const float* W, int ldw, int k0, int n0, bf16* dst, int ldd, LAS float* scr, int lane) {
    const TrItem it{W, ldw, k0, n0, dst, ldd}; f32x4 v[8]; tr_load(it, v, lane); tr_finish(it, v, scr, lane);
}
__device__ __forceinline__ void p0_prologue(const Frame& F0, const Args& args) {
    const Frame F = fresh(F0);
    const int tid = F.tid, lane = F.lane, wave = F.wave;
    float* MOD = WSP(float, WS_MOD);
    {
        LAS f32x4* cact4 = (LAS f32x4*)(F.lds + RING_OFF);
        LAS float* red = (LAS float*)(F.lds + RING_OFF + 16384);
        if (F.vcu < 192) {
            const float* c = INP(1);
#pragma unroll
            for (int i = 0; i < 8; ++i) { const int idx = tid + 512 * i, b = idx >> 10, k = idx & 1023; const float v = c[b * 1024 + k]; ((LAS float*)cact4)[k * 4 + b] = v * sigmoidf(v); }
        }
        __syncthreads();
        for (int u = F.vcu; u < 192; u += F.G) {
            const int l = u / 96, j0 = (u % 96) * 64;
            const float* aw = INP(2) + (size_t)l * 1024 * 6144 + j0 + lane;
            float a0 = 0.f, a1 = 0.f, a2 = 0.f, a3 = 0.f;
#pragma unroll 32
            for (int kk = 0; kk < 128; ++kk) { const int k = 128 * wave + kk; const float wv = aw[(size_t)k * 6144]; const f32x4 c4 = cact4[k]; a0 += c4.x * wv; a1 += c4.y * wv; a2 += c4.z * wv; a3 += c4.w * wv; }
            red[(wave * 4 + 0) * 64 + lane] = a0; red[(wave * 4 + 1) * 64 + lane] = a1; red[(wave * 4 + 2) * 64 + lane] = a2; red[(wave * 4 + 3) * 64 + lane] = a3;
            __syncthreads();
            if (tid < 256) { const int b = tid >> 6, ln = tid & 63; float s = INP(3)[l * 6144 + j0 + ln];
#pragma unroll
                for (int w = 0; w < 8; ++w) s += red[(w * 4 + b) * 64 + ln];
                MOD[(size_t)(l * 4 + b) * 6144 + j0 + ln] = s; }
            __syncthreads();
        }
    }
    {
        LAS float* Tt = (LAS float*)(F.lds + RING_OFF);
        LAS float* cs = (LAS float*)(F.lds + RING_OFF + 33792);
        LAS float* sn = cs + 128;
        if (tid < 128) { cs[tid] = cospif((float)tid * (1.0f / 64.0f)); sn[tid] = sinpif((float)tid * (1.0f / 64.0f)); }
        for (int it = F.G - 1 - F.vcu; it < 256; it += F.G) {
            const int l = it >> 7, g = (it >> 5) & 3, k0 = (it & 31) * 32;
            const float* src = INP(6) + (size_t)l * 1024 * 3072 + 2560 + g * 128;
            __syncthreads();
#pragma unroll
            for (int i = 0; i < 8; ++i) { const int idx = tid + 512 * i, row = idx >> 7, cc = idx & 127; Tt[row * 129 + cc] = src[(size_t)(k0 + row) * 3072 + cc]; }
            __syncthreads();
            const int kk = tid & 31, og = tid >> 5, part = og >> 3, m0 = (og & 7) * 16;
            float acc[16];
#pragma unroll
            for (int i = 0; i < 16; ++i) acc[i] = 0.f;
            const LAS float* tab = part ? sn : cs;
#pragma unroll 2
            for (int cc = 0; cc < 128; ++cc) { const float t = Tt[kk * 129 + cc];
#pragma unroll
                for (int i = 0; i < 16; ++i) acc[i] += t * tab[((m0 + i) * cc) & 127]; }
            bf16* dst = WSP(bf16, WS_WP2) + (size_t)l * NP2 * 1024 + (size_t)(2560 + part * 512 + g * 128 + m0) * 1024 + k0 + kk;
            const float sg = part ? -1.f : 1.f;
#pragma unroll
            for (int i = 0; i < 16; ++i) dst[(size_t)i * 1024] = (bf16)f2bf(sg * acc[i]);
        }
        __syncthreads();
    }
    {
        LAS float* scr = (LAS float*)(F.lds + RING_OFF + wave * 8704);
        const int gw = F.vcu * NWAVES + wave, NGW = F.G * NWAVES;
        for (int it = gw; it < 8192; it += NGW) {
            const int l = it >> 12; int r = it & 4095;
            if (r < 1280) { const int kb = r / 80, nb = r % 80; transpose_item(INP(6) + (size_t)l * 1024 * 3072, 3072, kb * 64, nb * 32, WSP(bf16, WS_WP2) + (size_t)l * NP2 * 1024 + (size_t)(nb * 32) * 1024, 1024, scr, lane); continue; }
            r -= 1280;
            if (r < 1536) { const int kb = r / 96, nb = r % 96; transpose_item(INP(7) + (size_t)l * 1024 * 3072, 3072, kb * 64, nb * 32, WSP(bf16, WS_WP2) + (size_t)l * NP2 * 1024 + (size_t)(3584 + nb * 32) * 1024, 1024, scr, lane); continue; }
            r -= 1536;
            if (r < 768) { const int which = r >> 8, rr = r & 255, kb = rr >> 5, nb = rr & 31; const float* src = (which == 0 ? INP(17) : (which == 1 ? INP(18) : INP(19))) + (size_t)l * 512 * 1024;
                transpose_item(src, 1024, kb * 64, nb * 32, WSP(bf16, WS_WPROJ) + (size_t)(l * 3 + which) * 1024 * 512 + (size_t)(nb * 32) * 512, 512, scr, lane); continue; }
            r -= 768;
            { const int kb = r >> 5, nb = r & 31; transpose_item(INP(20) + (size_t)l * 1024 * 1024, 1024, kb * 64, nb * 32, WSP(bf16, WS_WOUT) + (size_t)l * 1024 * 1024 + (size_t)(nb * 32) * 1024, 1024, scr, lane); }
        }
    }
    {
        const int gt = F.vcu * 512 + tid, NGT = F.G * 512;
        bf16* WL = WSP(bf16, WS_WL);
        for (int idx = gt; idx < 262144; idx += NGT) {
            const int k = idx & 63, n = (idx >> 6) & 255, nb = (idx >> 14) & 7, l = idx >> 17, gate = n >> 6, j = n & 63, dir = gate >> 1, isI = gate & 1;
            const float* src = isI ? INP(14) : INP(12);
            WL[idx] = (bf16)f2bf(src[((size_t)((l * 2 + dir) * 8 + nb) * 64 + k) * 64 + j]);
        }
        bf16* FA = WSP(bf16, WS_FA);
        for (int idx = gt; idx < 16384; idx += NGT) {
            const int m = idx >> 7, k = idx & 127, k1 = m & 63, pm_ = m >> 6, t1 = k & 63, pk = k >> 6, a = (k1 * t1) & 63;
            const float c = cospif((float)a * (1.0f / 32.0f)), s = sinpif((float)a * (1.0f / 32.0f));
            FA[idx] = (bf16)f2bf(pm_ == 0 ? (pk == 0 ? c : s) : (pk == 0 ? -s : c));
        }
        bf16* FB = WSP(bf16, WS_FB);
        for (int idx = gt; idx < 32768; idx += NGT) {
            const int k2 = idx >> 8, k = idx & 255, part = k >> 7, t2 = k & 127, a = (k2 * t2) & 127;
            FB[idx] = (bf16)f2bf(part == 0 ? cospif((float)a * (1.0f / 64.0f)) : sinpif((float)a * (1.0f / 64.0f)));
        }
        f32x2* TW = WSP(f32x2, WS_TW);
        for (int idx = gt; idx < 8192; idx += NGT) {
            const int t2 = idx >> 6, k1 = idx & 63; const float x = (float)(t2 * k1) * (1.0f / 4096.0f);
            TW[idx] = (f32x2){cospif(x), sinpif(x)};
        }
    }
}

__device__ __forceinline__ void moe_tilebase(const Frame& F0, const Args& args, int l);
template <int MODE>
__device__ __forceinline__ void rows_phase(const Frame& F0, const Args& args, int l) {
    const Frame F = fresh(F0);
    const int tid = F.tid, lane = F.lane, wave = F.wave;
    const float* MOD = WSP(float, WS_MOD);
    LAS float* gsc = (LAS float*)(F.lds + RING_OFF);
    LAS float* shf = gsc + 4096;
    LAS float* gtf = shf + 4096;
    if (MODE != 0) moe_tilebase(F, args, l - 1);
#pragma unroll
    for (int i = 0; i < 8; ++i) { const int idx = tid + 512 * i, b = idx >> 10, col = idx & 1023;
        if (MODE != 2) { gsc[idx] = INP(4)[l * 1024 + col] * (1.0f + MOD[(size_t)(l * 4 + b) * 6144 + 1024 + col]); shf[idx] = MOD[(size_t)(l * 4 + b) * 6144 + col]; }
        else gsc[idx] = INP(26)[col];
        if (MODE != 0) gtf[idx] = MOD[(size_t)((l - 1) * 4 + b) * 6144 + 5 * 1024 + col]; }
    __syncthreads();
    const float* xin = (MODE == 0) ? INP(0) : args.out;
    bf16* U = WSP(bf16, WS_U);
    const bf16* YE = WSP(bf16, WS_PROJ);
    const int* tokes = WSP(int, WS_TOKROW); const float* tokw = WSP(float, WS_TOKW);
    const int gw = F.vcu * NWAVES + wave, NGW = F.G * NWAVES;
    for (int m0 = gw; m0 < NTOK; m0 += 2 * NGW) {
        f32x4 v[2][4]; v2u ya[2][4], yc[2][4]; float w0[2], w1[2];
#pragma unroll
        for (int q = 0; q < 2; ++q) { const int m = m0 + q * NGW; const f32x4* xr = (const f32x4*)(xin + (size_t)m * D) + lane;
#pragma unroll
            for (int j = 0; j < 4; ++j) v[q][j] = xr[64 * j];
            if (MODE != 0) { const int es0 = tokes[2 * m], es1 = tokes[2 * m + 1]; const int r0 = 256 * (int)F.MISC[16 + (es0 >> 16)] + (es0 & 0xffff), r1 = 256 * (int)F.MISC[16 + (es1 >> 16)] + (es1 & 0xffff); w0[q] = tokw[2 * m]; w1[q] = tokw[2 * m + 1];
                const v2u* y0 = (const v2u*)(YE + (size_t)r0 * 1024) + lane; const v2u* y1 = (const v2u*)(YE + (size_t)r1 * 1024) + lane;
#pragma unroll
                for (int j = 0; j < 4; ++j) { ya[q][j] = y0[64 * j]; yc[q][j] = y1[64 * j]; } } }
#pragma unroll
        for (int q = 0; q < 2; ++q) { const int m = m0 + q * NGW, b = m >> 13;
            if (MODE != 0) {
#pragma unroll
                for (int j = 0; j < 4; ++j) { const v2u a = ya[q][j], c = yc[q][j]; const f32x4 g = *(const LAS f32x4*)(gtf + b * 1024 + 4 * lane + 256 * j);
                    v[q][j].x += g.x * (w0[q] * bflo(a.x) + w1[q] * bflo(c.x)); v[q][j].y += g.y * (w0[q] * bfhi(a.x) + w1[q] * bfhi(c.x));
                    v[q][j].z += g.z * (w0[q] * bflo(a.y) + w1[q] * bflo(c.y)); v[q][j].w += g.w * (w0[q] * bfhi(a.y) + w1[q] * bfhi(c.y)); }
            }
            float ss = 0.f;
#pragma unroll
            for (int j = 0; j < 4; ++j) ss += (v[q][j].x * v[q][j].x + v[q][j].y * v[q][j].y) + (v[q][j].z * v[q][j].z + v[q][j].w * v[q][j].w);
            const float rstd = 1.0f / sqrtf(wave_sum(ss) * (1.0f / D) + EPS);
            if (MODE == 2) {
                f32x4* o = (f32x4*)(args.out + (size_t)m * D) + lane;
#pragma unroll
                for (int j = 0; j < 4; ++j) { const f32x4 g = *(const LAS f32x4*)(gsc + 4 * lane + 256 * j); o[64 * j] = v[q][j] * rstd * g; }
            } else {
                if (MODE == 1) { f32x4* o = (f32x4*)(args.out + (size_t)m * D) + lane;
#pragma unroll
                    for (int j = 0; j < 4; ++j) o[64 * j] = v[q][j]; }
                v2u* uo = (v2u*)(U + (size_t)m * D) + lane;
#pragma unroll
                for (int j = 0; j < 4; ++j) { const f32x4 g = *(const LAS f32x4*)(gsc + b * 1024 + 4 * lane + 256 * j), s = *(const LAS f32x4*)(shf + b * 1024 + 4 * lane + 256 * j);
                    const f32x4 u = v[q][j] * rstd * g + s; uo[64 * j] = (v2u){pk2(u.x, u.y), pk2(u.z, u.w)}; }
            }
        }
    }
}

struct EpiP2 {
    static constexpr bool PERM = true;
    bf16* proj; bf16* vt; bf16* gates; const float* gbias;
    __device__ __forceinline__ void operator()(const f32x4 (&acc)[2][2][4][2], const pg8::Unit& u, int wr, int wc, int fr, int fq) const {
        const int row0 = u.pm * 256 + wr * 64 + fr, pn = u.pn;
        if (pn == 4 || pn == 5) {
#pragma unroll
            for (int ai = 0; ai < 2; ++ai)
#pragma unroll
                for (int m = 0; m < 4; ++m) { const int row = row0 + ai * 128 + m * 16, b = row >> 13, t = row & 8191;
#pragma unroll
                    for (int bj = 0; bj < 2; ++bj)
#pragma unroll
                        for (int n = 0; n < 2; ++n) { const int col = (pn - 4) * 256 + bj * 128 + wc * 32 + 8 * fq + 4 * n; bf16* d = vt + ((size_t)(b * 512 + col)) * 8192 + t;
                            d[0] = (bf16)f2bf(acc[ai][bj][m][n][0]); d[8192] = (bf16)f2bf(acc[ai][bj][m][n][1]); d[2 * 8192] = (bf16)f2bf(acc[ai][bj][m][n][2]); d[3 * 8192] = (bf16)f2bf(acc[ai][bj][m][n][3]); } }
        } else if (pn < 14) {
            const int cbase = (pn < 4 ? pn * 256 : (pn - 2) * 256) + wc * 32 + 8 * fq; const float sc = pn < 2 ? 0.125f : 1.0f;
#pragma unroll
            for (int ai = 0; ai < 2; ++ai)
#pragma unroll
                for (int m = 0; m < 4; ++m) { bf16* rowp = proj + (size_t)(row0 + ai * 128 + m * 16) * PROJ_LD + cbase;
#pragma unroll
                    for (int bj = 0; bj < 2; ++bj) { const f32x4 v0 = acc[ai][bj][m][0] * sc, v1 = acc[ai][bj][m][1] * sc;
                        *(v4u*)(rowp + bj * 128) = (v4u){pk2(v0[0], v0[1]), pk2(v0[2], v0[3]), pk2(v1[0], v1[1]), pk2(v1[2], v1[3])}; } }
        } else {
            const int cbase = (pn - 14) * 256 + wc * 32 + 8 * fq, tid = (wr * 4 + wc) * 64 + fq * 16 + fr;
            f32x4 bv[2][2];
#pragma unroll
            for (int bj = 0; bj < 2; ++bj)
#pragma unroll
                for (int n = 0; n < 2; ++n) bv[bj][n] = *(const f32x4*)(gbias + cbase + bj * 128 + 4 * n);
            bf16* blob = gates + (size_t)(u.pm * 12 + (pn - 14)) * 65536 + tid * 8;
#pragma unroll
            for (int ai = 0; ai < 2; ++ai)
#pragma unroll
                for (int m = 0; m < 4; ++m)
#pragma unroll
                    for (int bj = 0; bj < 2; ++bj) { f32x4 v0 = acc[ai][bj][m][0] + bv[bj][0], v1 = acc[ai][bj][m][1] + bv[bj][1];
#pragma unroll
                        for (int e = 0; e < 4; ++e) { v0[e] = fsigmoid(v0[e]); v1[e] = fsigmoid(v1[e]); }
                        *(v4u*)(blob + ((ai * 4 + m) * 2 + bj) * 4096) = (v4u){pk2(v0[0], v0[1]), pk2(v0[2], v0[3]), pk2(v1[0], v1[1]), pk2(v1[2], v1[3])}; }
        }
    }
};
struct EpiMerge {
    static constexpr bool PERM = true;
    const bf16* gates; bf16* merged; bf16* scratch;
    __device__ __forceinline__ void operator()(const f32x4 (&acc)[2][2][4][2], const pg8::Unit& u, int wr, int wc, int fr, int fq) const {
        const int row0 = u.pm * 256 + wr * 64 + fr, cbase = u.pn * 256 + wc * 32 + 8 * fq, z = u.z, tid = (wr * 4 + wc) * 64 + fq * 16 + fr;
        const char* gblob = (const char*)(gates + (size_t)(u.pm * 12 + z * 4 + u.pn) * 65536 + tid * 8); char* sblob = (char*)(scratch + tid * 8);
        unsigned pc = 0;
#pragma unroll
        for (int ai = 0; ai < 2; ++ai)
#pragma unroll
            for (int m = 0; m < 4; ++m) { const size_t row = (size_t)(row0 + ai * 128 + m * 16);
#pragma unroll
                for (int bj = 0; bj < 2; ++bj) { asm volatile("" : "+v"(pc)); const v4u gv = *(const v4u*)(gblob + pc);
                    f32x4 v0 = acc[ai][bj][m][0], v1 = acc[ai][bj][m][1];
                    v0[0] *= bflo(gv.x); v0[1] *= bfhi(gv.x); v0[2] *= bflo(gv.y); v0[3] *= bfhi(gv.y); v1[0] *= bflo(gv.z); v1[1] *= bfhi(gv.z); v1[2] *= bflo(gv.w); v1[3] *= bfhi(gv.w);
                    if (z > 0) { const v4u ov = *(const v4u*)(sblob + pc);
                        v0[0] += bflo(ov.x); v0[1] += bfhi(ov.x); v0[2] += bflo(ov.y); v0[3] += bfhi(ov.y); v1[0] += bflo(ov.z); v1[1] += bfhi(ov.z); v1[2] += bflo(ov.w); v1[3] += bfhi(ov.w); }
                    const v4u o = (v4u){pk2(v0[0], v0[1]), pk2(v0[2], v0[3]), pk2(v1[0], v1[1]), pk2(v1[2], v1[3])};
                    if (z < 2) *(v4u*)(sblob + pc) = o; else *(v4u*)(merged + row * 1024 + cbase + bj * 128) = o;
                    pc += 8192u; }
                if (m & 1) asm volatile("" ::: "memory"); }
    }
};
struct EpiResid {
    static constexpr bool PERM = false;
    const float* xin; float* xout; const float* gt;
    __device__ __forceinline__ void operator()(const f32x4 (&acc)[2][2][4][2], const pg8::Unit& u, int wr, int wc, int fr, int fq) const {
        const int row0 = u.pm * 256 + wr * 64 + fr, col0 = u.pn * 256 + wc * 32 + 4 * fq, b = (u.pm * 256) >> 13;
        f32x4 gv[2][2];
#pragma unroll
        for (int bj = 0; bj < 2; ++bj)
#pragma unroll
            for (int n = 0; n < 2; ++n) gv[bj][n] = *(const f32x4*)(gt + (size_t)b * 6144 + col0 + bj * 128 + n * 16);
#pragma unroll
        for (int ai = 0; ai < 2; ++ai)
#pragma unroll
            for (int m = 0; m < 4; ++m) { const size_t off = (size_t)(row0 + ai * 128 + m * 16) * D + col0;
#pragma unroll
                for (int bj = 0; bj < 2; ++bj)
#pragma unroll
                    for (int n = 0; n < 2; ++n) { const f32x4 xv = *(const f32x4*)(xin + off + bj * 128 + n * 16); *(f32x4*)(xout + off + bj * 128 + n * 16) = xv + gv[bj][n] * acc[ai][bj][m][n]; } }
    }
};
struct EpiSwiGLU {
    static constexpr bool PERM = true;
    bf16* H;
    __device__ __forceinline__ void operator()(const f32x4 (&acc)[2][2][4][2], const pg8::Unit& u, int wr, int wc, int fr, int fq) const {
        const int row0 = u.pm * 256 + wr * 64 + fr, cbase = u.pn * 128 + wc * 32 + 8 * fq;
#pragma unroll
        for (int ai = 0; ai < 2; ++ai)
#pragma unroll
            for (int m = 0; m < 4; ++m) { f32x4 h0, h1;
#pragma unroll
                for (int e = 0; e < 4; ++e) { const float g0 = acc[ai][0][m][0][e], g1 = acc[ai][0][m][1][e]; h0[e] = g0 * sigmoidf(g0) * acc[ai][1][m][0][e]; h1[e] = g1 * sigmoidf(g1) * acc[ai][1][m][1][e]; }
                *(v4u*)(H + (size_t)(row0 + ai * 128 + m * 16) * 512 + cbase) = (v4u){pk2(h0[0], h0[1]), pk2(h0[2], h0[3]), pk2(h1[0], h1[1]), pk2(h1[2], h1[3])}; }
    }
};
struct EpiYE {
    static constexpr bool PERM = true;
    bf16* YE;
    __device__ __forceinline__ void operator()(const f32x4 (&acc)[2][2][4][2], const pg8::Unit& u, int wr, int wc, int fr, int fq) const {
        const int row0 = u.pm * 256 + wr * 64 + fr, cbase = u.pn * 256 + wc * 32 + 8 * fq;
#pragma unroll
        for (int ai = 0; ai < 2; ++ai)
#pragma unroll
            for (int m = 0; m < 4; ++m) { bf16* rowp = YE + (size_t)(row0 + ai * 128 + m * 16) * 1024 + cbase;
#pragma unroll
                for (int bj = 0; bj < 2; ++bj) { const f32x4 v0 = acc[ai][bj][m][0], v1 = acc[ai][bj][m][1];
                    *(v4u*)(rowp + bj * 128) = (v4u){pk2(v0[0], v0[1]), pk2(v0[2], v0[3]), pk2(v1[0], v1[1]), pk2(v1[2], v1[3])}; } }
    }
};

__device__ __forceinline__ void attn_unit(bf16* PROJ, const bf16* VT, const LAS float* rpb, int b, int h, int r, int qb, int lane, bf16* obase, int opitch) {
    const int qn = lane & 15, g = lane >> 4;
    const int rs = min(max(r - 4, 0), 120);
    const int cb = (qb == 0) ? 0 : ((qb == 1) ? 8 : ((qb == 2) ? 24 : 32));
    const int w = 16 * qb + qn, cs = min(max(w - 8, 0), 48);
    const size_t tokq = (size_t)b * T + r * 64 + w;
    bf16* qp = PROJ + tokq * PROJ_LD + Q_OFF + h * 64;
    bf16x8 qf0 = *(const bf16x8*)(qp + 8 * g), qf1 = *(const bf16x8*)(qp + 32 + 8 * g);
    const bf16* kbase = PROJ + ((size_t)b * T + rs * 64 + cb + qn) * PROJ_LD + K_OFF + h * 64 + 8 * g;
    f32x4 sc[16];
#pragma unroll
    for (int kt = 0; kt < 16; ++kt) {
        const int kr = kt >> 1, ch = kt & 1;
        const bf16* kp = kbase + (size_t)(kr * 64 + 16 * ch) * PROJ_LD;
        const bf16x8 kf0 = *(const bf16x8*)kp, kf1 = *(const bf16x8*)(kp + 32);
        f32x4 a = (f32x4){0.f, 0.f, 0.f, 0.f};
        a = __builtin_amdgcn_mfma_f32_16x16x32_bf16(kf0, qf0, a, 0, 0, 0);
        a = __builtin_amdgcn_mfma_f32_16x16x32_bf16(kf1, qf1, a, 0, 0, 0);
        sc[kt] = a;
    }
    const LAS float* rp = rpb + h * 465;
    float mx = -1e30f;
#pragma unroll
    for (int kt = 0; kt < 16; ++kt) {
        const int kr = kt >> 1, ch = kt & 1;
        const int brow = (rs + kr - r + 7) * 31;
#pragma unroll
        for (int j = 0; j < 4; ++j) {
            const int kc = cb + 16 * ch + 4 * g + j, dc = kc - w + 15;
            const bool ok = (kc >= cs) && (kc <= cs + 15);
            const float bias = rp[brow + (ok ? dc : 15)];
            const float s = ok ? sc[kt][j] + bias : -1e30f;
            sc[kt][j] = s; mx = fmaxf(mx, s);
        }
    }
    mx = fmaxf(mx, __shfl_xor(mx, 16)); mx = fmaxf(mx, __shfl_xor(mx, 32));
    float sum = 0.f;
#pragma unroll
    for (int kt = 0; kt < 16; ++kt)
#pragma unroll
        for (int j = 0; j < 4; ++j) { const float p = __expf(sc[kt][j] - mx); sc[kt][j] = p; sum += p; }
    sum += __shfl_xor(sum, 16); sum += __shfl_xor(sum, 32);
    const float inv = 1.0f / sum;
    f32x4 o[4];
#pragma unroll
    for (int dt = 0; dt < 4; ++dt) o[dt] = (f32x4){0.f, 0.f, 0.f, 0.f};
    const bf16* vbase = VT + ((size_t)(b * 512 + h * 64 + qn)) * T + rs * 64 + cb + 4 * g;
#pragma unroll
    for (int kr = 0; kr < 8; ++kr) {
        v4u pw; pw.x = pk2(sc[2 * kr][0], sc[2 * kr][1]); pw.y = pk2(sc[2 * kr][2], sc[2 * kr][3]); pw.z = pk2(sc[2 * kr + 1][0], sc[2 * kr + 1][1]); pw.w = pk2(sc[2 * kr + 1][2], sc[2 * kr + 1][3]);
        const bf16x8 pf = __builtin_bit_cast(bf16x8, pw);
#pragma unroll
        for (int dt = 0; dt < 4; ++dt) {
            const bf16* vp = vbase + (size_t)(16 * dt) * T + kr * 64;
            const v2u lo = *(const v2u*)vp, hi = *(const v2u*)(vp + 16);
            const v4u vw = (v4u){lo.x, lo.y, hi.x, hi.y};
            o[dt] = __builtin_amdgcn_mfma_f32_16x16x32_bf16(__builtin_bit_cast(bf16x8, vw), pf, o[dt], 0, 0, 0);
        }
    }
    bf16* op = obase + tokq * opitch + h * 64;
#pragma unroll
    for (int dt = 0; dt < 4; ++dt) *(v2u*)(op + 16 * dt + 4 * g) = (v2u){pk2(o[dt][0] * inv, o[dt][1] * inv), pk2(o[dt][2] * inv, o[dt][3] * inv)};
}
__device__ __forceinline__ void attn_phase(const Frame& F0, const Args& args, int l, bf16* obase, int opitch) {
    const Frame F = fresh(F0);
    LAS float* rpb = (LAS float*)(F.lds + RING_OFF);
    for (int i = F.tid; i < 8 * 465; i += 512) rpb[i] = INP(9)[l * 8 * 465 + i];
    __syncthreads();
    bf16* PROJ = WSP(bf16, WS_PROJ); const bf16* VT = WSP(bf16, WS_VT);
    for (int wu = F.vcu * NWAVES + F.wave; wu < 16384; wu += F.G * NWAVES) {
        const int bh = wu >> 9, rem = wu & 511;
        attn_unit(PROJ, VT, rpb, bh >> 3, bh & 7, rem >> 2, rem & 3, F.lane, obase, opitch);
    }
    __syncthreads();
}

__device__ __forceinline__ float gelu_tanh(float x) { const float u = 0.7978845608028654f * (x + 0.044715f * x * x * x); const float t = 1.0f - 2.0f * __builtin_amdgcn_rcpf(1.0f + __expf(2.0f * u)); return 0.5f * x * (1.0f + t); }
__device__ __forceinline__ void fft_a_phase(const Frame& F0, const Args& args) {
    const Frame F = fresh(F0);
    const int lane = F.lane, nl = lane & 31, hh = lane >> 5;
    const bf16* PROJ = WSP(bf16, WS_PROJ); const bf16* FA = WSP(bf16, WS_FA); const f32x2* TW = WSP(f32x2, WS_TW); bf16* ZP = WSP(bf16, WS_U);
    for (int wu = F.vcu * NWAVES + F.wave; wu < 8192; wu += F.G * NWAVES) {
        const int ct = wu & 15, t2 = (wu >> 4) & 127, b = wu >> 11;
        bf16x8 bf[8];
#pragma unroll
        for (int s = 0; s < 8; ++s) { const int part = s >> 2, t1b = 16 * (s & 3) + 8 * hh;
            const bf16* p = PROJ + ((size_t)b * T + (size_t)128 * t1b + t2) * PROJ_LD + G_OFF + part * 512 + 32 * ct + nl;
            unsigned short e[8];
#pragma unroll
            for (int j = 0; j < 8; ++j) e[j] = p[(size_t)j * 128 * PROJ_LD];
            v4u w; w.x = e[0] | ((unsigned)e[1] << 16); w.y = e[2] | ((unsigned)e[3] << 16); w.z = e[4] | ((unsigned)e[5] << 16); w.w = e[6] | ((unsigned)e[7] << 16);
            bf[s] = __builtin_bit_cast(bf16x8, w); }
        f32x16 acc[4];
#pragma unroll
        for (int mt = 0; mt < 4; ++mt) { acc[mt] = (f32x16){};
#pragma unroll
            for (int s = 0; s < 8; ++s) { const bf16x8 af = *(const bf16x8*)(FA + (32 * mt + nl) * 128 + 16 * s + 8 * hh); acc[mt] = __builtin_amdgcn_mfma_f32_32x32x16_bf16(af, bf[s], acc[mt], 0, 0, 0); } }
#pragma unroll
        for (int mt = 0; mt < 2; ++mt)
#pragma unroll
            for (int rg = 0; rg < 16; ++rg) { const int k1 = 32 * mt + (rg & 3) + 8 * (rg >> 2) + 4 * hh; const f32x2 cs = TW[t2 * 64 + k1];
                const float zr = acc[mt][rg], zi = acc[mt + 2][rg];
                bf16* d = ZP + ((size_t)(b * 64 + k1) * 128 + t2) * 1024 + 32 * ct + nl;
                d[0] = (bf16)f2bf(zr * cs.x + zi * cs.y); d[512] = (bf16)f2bf(zi * cs.x - zr * cs.y); }
    }
}
__device__ __forceinline__ void fft_b_phase(const Frame& F0, const Args& args) {
    const Frame F = fresh(F0);
    const int lane = F.lane, nl = lane & 31, hh = lane >> 5;
    bf16* PROJ = WSP(bf16, WS_PROJ); const bf16* FB = WSP(bf16, WS_FB); const bf16* ZP = WSP(bf16, WS_U);
    for (int wu = F.vcu * NWAVES + F.wave; wu < 4096; wu += F.G * NWAVES) {
        const int ct = wu & 15, k1 = (wu >> 4) & 63, b = wu >> 10;
        f32x16 acc[4];
#pragma unroll
        for (int mt = 0; mt < 4; ++mt) acc[mt] = (f32x16){};
#pragma unroll 1
        for (int sc = 0; sc < 4; ++sc) {
            bf16x8 bf[4];
#pragma unroll
            for (int q = 0; q < 4; ++q) { const int s = 4 * sc + q, part = s >> 3, t2b = 16 * (s & 7) + 8 * hh;
                const bf16* p = ZP + ((size_t)(b * 64 + k1) * 128 + t2b) * 1024 + part * 512 + 32 * ct + nl;
                unsigned short e[8];
#pragma unroll
                for (int j = 0; j < 8; ++j) e[j] = p[(size_t)j * 1024];
                v4u w; w.x = e[0] | ((unsigned)e[1] << 16); w.y = e[2] | ((unsigned)e[3] << 16); w.z = e[4] | ((unsigned)e[5] << 16); w.w = e[6] | ((unsigned)e[7] << 16);
                bf[q] = __builtin_bit_cast(bf16x8, w); }
#pragma unroll
            for (int mt = 0; mt < 4; ++mt)
#pragma unroll
                for (int q = 0; q < 4; ++q) { const bf16x8 af = *(const bf16x8*)(FB + (32 * mt + nl) * 256 + 16 * (4 * sc + q) + 8 * hh); acc[mt] = __builtin_amdgcn_mfma_f32_32x32x16_bf16(af, bf[q], acc[mt], 0, 0, 0); }
        }
#pragma unroll
        for (int mt = 0; mt < 4; ++mt)
#pragma unroll
            for (int rg = 0; rg < 16; ++rg) { const int k2 = 32 * mt + (rg & 3) + 8 * (rg >> 2) + 4 * hh;
                PROJ[((size_t)b * T + k1 + 64 * k2) * PROJ_LD + G_OFF + 32 * ct + nl] = (bf16)f2bf(acc[mt][rg] * (1.0f / 1024.0f)); }
    }
}

__device__ __forceinline__ void router_phase(const Frame& F0, const Args& args, int l, int cset) {
    const Frame F = fresh(F0);
    const int tid = F.tid, lane = F.lane, wave = F.wave;
    const float* MOD = WSP(float, WS_MOD);
    LAS float* WPL = (LAS float*)(F.lds + RING_OFF);
    LAS float* gsc = (LAS float*)(F.lds + XTRA_OFF);
    LAS float* shf = gsc + 1024;
    LAS float* c0 = shf + 1024;
    LAS float* rb = c0 + 32;
    LAS unsigned* lcnt = (LAS unsigned*)(rb + 32);
    LAS unsigned* lbase = lcnt + 32;
    LAS float* red = (LAS float*)(lbase + 32);
    const float* x = args.out; bf16* U2 = WSP(bf16, WS_U);
    float* tokw = WSP(float, WS_TOKW); int* perm = WSP(int, WS_PERM); int* tokes = WSP(int, WS_TOKROW);
    unsigned* ecnt = (unsigned*)(F.ctl + CW_ECNT + cset * 32 * 64);
    const int nround = (2048 + F.G * NWAVES - 1) / (F.G * NWAVES);
    int cur_b = -1;
    for (int rd = 0; rd < nround; ++rd) {
        const int unit = (rd * F.G + F.vcu) * NWAVES + wave;
        const int ub = (((rd * F.G + F.vcu) * NWAVES) * 16) >> 13;
        const bool wg_active = ((rd * F.G + F.vcu) * NWAVES) < 2048;
        if (wg_active && ub != cur_b) {
            cur_b = ub; __syncthreads();
            for (int i = 0; i < 2; ++i) { const int col = tid + 512 * i; gsc[col] = INP(5)[l * 1024 + col] * (1.0f + MOD[(size_t)(l * 4 + ub) * 6144 + 4 * 1024 + col]); shf[col] = MOD[(size_t)(l * 4 + ub) * 6144 + 3 * 1024 + col]; }
            if (tid < 32) rb[tid] = INP(22)[tid];
            __syncthreads();
            { f32x4 wv[16];
#pragma unroll
                for (int i = 0; i < 16; ++i) wv[i] = *(const f32x4*)(INP(21) + 4 * (tid + 512 * i));
#pragma unroll
                for (int i = 0; i < 16; ++i) { const int idx = 4 * (tid + 512 * i), k = idx >> 5, e = idx & 31; const float gk = gsc[k]; LAS float* d = WPL + k * 32 + (e ^ (((k >> 8) & 1) << 4));
                    d[0] = gk * wv[i].x; d[1] = gk * wv[i].y; d[2] = gk * wv[i].z; d[3] = gk * wv[i].w; } }
            { const int e = tid & 31, pt = tid >> 5; float s = 0.f;
#pragma unroll 16
                for (int k = pt * 64; k < pt * 64 + 64; ++k) s += shf[k] * INP(21)[k * 32 + e];
                red[tid] = s; }
            __syncthreads();
            if (tid < 32) { float s = 0.f; for (int p = 0; p < 16; ++p) s += red[p * 32 + tid]; c0[tid] = s; }
        }
        if (tid < 32) lcnt[tid] = 0u;
        __syncthreads();
        int e0 = 0, e1 = 0; unsigned rk0 = 0, rk1 = 0; float w0 = 0.f, w1 = 0.f; bool owner = false; int mytok = 0;
        if (unit < 2048) {
            const int tok0 = unit * 16;
            float rs_reg = 0.f;
#pragma unroll 1
            for (int i4 = 0; i4 < 16; i4 += 4) {
                f32x4 v[4][4];
#pragma unroll
                for (int q = 0; q < 4; ++q) { const f32x4* xr = (const f32x4*)(x + (size_t)(tok0 + i4 + q) * D) + lane;
#pragma unroll
                    for (int j = 0; j < 4; ++j) v[q][j] = xr[64 * j]; }
#pragma unroll
                for (int q = 0; q < 4; ++q) { const int m = tok0 + i4 + q; float ss = 0.f;
#pragma unroll
                    for (int j = 0; j < 4; ++j) ss += (v[q][j].x * v[q][j].x + v[q][j].y * v[q][j].y) + (v[q][j].z * v[q][j].z + v[q][j].w * v[q][j].w);
                    const float rstd = 1.0f / sqrtf(wave_sum(ss) * (1.0f / D) + EPS);
                    if ((lane & 15) == i4 + q) rs_reg = rstd;
                    v2u* uo = (v2u*)(U2 + (size_t)m * D) + lane;
#pragma unroll
                    for (int j = 0; j < 4; ++j) { const f32x4 g = *(const LAS f32x4*)(gsc + 4 * lane + 256 * j), s = *(const LAS f32x4*)(shf + 4 * lane + 256 * j);
                        const f32x4 u = v[q][j] * rstd * g + s; uo[64 * j] = (v2u){pk2(u.x, u.y), pk2(u.z, u.w)}; } }
            }
            const int ti = lane & 15, kq = lane >> 4;
            const f32x4* xrow = (const f32x4*)(x + (size_t)(tok0 + ti) * D + 256 * kq);
            const LAS float* wp0 = WPL + (256 * kq) * 32 + (ti ^ ((kq & 1) << 4));
            const LAS float* wp1 = WPL + (256 * kq) * 32 + ((16 + ti) ^ ((kq & 1) << 4));
            f32x4 a0 = {0.f, 0.f, 0.f, 0.f}, a1 = {0.f, 0.f, 0.f, 0.f};
            f32x4 xn[8];
#pragma unroll
            for (int q = 0; q < 8; ++q) xn[q] = xrow[q];
#pragma unroll 1
            for (int t32 = 0; t32 < 8; ++t32) {
                f32x4 xv[8];
#pragma unroll
                for (int q = 0; q < 8; ++q) xv[q] = xn[q];
                const int tn = (t32 + 1 < 8) ? t32 + 1 : t32;
#pragma unroll
                for (int q = 0; q < 8; ++q) xn[q] = xrow[8 * tn + q];
#pragma unroll
                for (int q = 0; q < 8; ++q)
#pragma unroll
                    for (int jj = 0; jj < 4; ++jj) { const int kk = 32 * t32 + 4 * q + jj;
                        a0 = __builtin_amdgcn_mfma_f32_16x16x4f32(wp0[kk * 32], xv[q][jj], a0, 0, 0, 0);
                        a1 = __builtin_amdgcn_mfma_f32_16x16x4f32(wp1[kk * 32], xv[q][jj], a1, 0, 0, 0); }
            }
            float sco[2][4], sel[2][4], gs[2];
#pragma unroll
            for (int nt = 0; nt < 2; ++nt) {
#pragma unroll
                for (int rg = 0; rg < 4; ++rg) { const int e = 16 * nt + 4 * kq + rg; const float lg = rs_reg * (nt ? a1[rg] : a0[rg]) + c0[e]; sco[nt][rg] = sigmoidf(lg); sel[nt][rg] = sco[nt][rg] + rb[e]; }
                float m1 = fmaxf(sel[nt][0], sel[nt][1]), m2 = fminf(sel[nt][0], sel[nt][1]);
                { const float v = sel[nt][2]; if (v > m1) { m2 = m1; m1 = v; } else if (v > m2) m2 = v; }
                { const float v = sel[nt][3]; if (v > m1) { m2 = m1; m1 = v; } else if (v > m2) m2 = v; }
                gs[nt] = m1 + m2; }
            float bv = gs[0]; int bg = kq; if (gs[1] > bv) { bv = gs[1]; bg = 4 + kq; }
#pragma unroll
            for (int o = 16; o < 64; o <<= 1) { const float ov = __shfl_xor(bv, o); const int og = __shfl_xor(bg, o); if (ov > bv || (ov == bv && og < bg)) { bv = ov; bg = og; } }
            owner = ((bg & 3) == kq); mytok = tok0 + ti;
            if (owner) { const int nt = bg >> 2; float cd[4], sv[4];
#pragma unroll
                for (int rg = 0; rg < 4; ++rg) { cd[rg] = nt ? sel[1][rg] : sel[0][rg]; sv[rg] = nt ? sco[1][rg] : sco[0][rg]; }
                int i1 = 0; float v1 = cd[0];
#pragma unroll
                for (int rg = 1; rg < 4; ++rg) if (cd[rg] > v1) { v1 = cd[rg]; i1 = rg; }
                int i2 = -1; float v2 = -1e30f;
#pragma unroll
                for (int rg = 0; rg < 4; ++rg) if (rg != i1 && cd[rg] > v2) { v2 = cd[rg]; i2 = rg; }
                const float s1 = (i1 == 0 ? sv[0] : (i1 == 1 ? sv[1] : (i1 == 2 ? sv[2] : sv[3]))), s2 = (i2 == 0 ? sv[0] : (i2 == 1 ? sv[1] : (i2 == 2 ? sv[2] : sv[3])));
                e0 = 4 * bg + i1; e1 = 4 * bg + i2; w0 = s1 / (s1 + s2); w1 = s2 / (s1 + s2);
                rk0 = __hip_atomic_fetch_add(lcnt + e0, 1u, __ATOMIC_RELAXED, __HIP_MEMORY_SCOPE_WORKGROUP);
                rk1 = __hip_atomic_fetch_add(lcnt + e1, 1u, __ATOMIC_RELAXED, __HIP_MEMORY_SCOPE_WORKGROUP); }
        }
        __syncthreads();
        if (tid < 32) { const unsigned n = lcnt[tid]; lbase[tid] = n ? __hip_atomic_fetch_add(ecnt + 64 * tid, n, RLX_AGENT) : 0u; }
        __syncthreads();
        if (owner) { const unsigned s0 = lbase[e0] + rk0, s1 = lbase[e1] + rk1; perm[(size_t)e0 * NTOK + s0] = 2 * mytok; perm[(size_t)e1 * NTOK + s1] = 2 * mytok + 1; tokw[2 * mytok] = w0; tokw[2 * mytok + 1] = w1;
            tokes[2 * mytok] = (e0 << 16) | (int)s0; tokes[2 * mytok + 1] = (e1 << 16) | (int)s1; }
    }
    __syncthreads();
    {
        LAS float* scr = (LAS float*)(F.lds + RING_OFF + wave * 8704);
        const int gw = F.vcu * NWAVES + wave, NGW = F.G * NWAVES;
        bf16* WG1 = WSP(bf16, WS_WG1); bf16* WD = WSP(bf16, WS_WD);
        auto mk = [&](int it) -> TrItem {
            const int kind = it >> 13, r = it & 8191, e = r >> 8, rr = r & 255;
            if (kind < 2) { const int kb = rr >> 4, nb = rr & 15, n0 = nb * 32; const float* src = (kind == 0 ? INP(23) : INP(24)) + (size_t)(l * 32 + e) * 1024 * 512;
                return TrItem{src, 512, kb * 64, n0, WG1 + ((size_t)e * 1024 + (n0 >> 7) * 256 + kind * 128 + (n0 & 127)) * 1024, 1024}; }
            const int kb = rr >> 5, nb = rr & 31, n0 = nb * 32; const float* src = INP(25) + (size_t)(l * 32 + e) * 512 * 1024;
            return TrItem{src, 1024, kb * 64, n0, WD + ((size_t)e * 1024 + n0) * 512, 512}; };
        for (int rep = 0; rep < 1 + REP_C; ++rep)
        for (int it = gw; it < 24576; it += 2 * NGW) {
            const bool two = (it + NGW) < 24576;
            const TrItem a = mk(it), b = mk(two ? it + NGW : it);
            f32x4 va[8], vb[8]; tr_load(a, va, lane); tr_load(b, vb, lane);
            tr_finish(a, va, scr, lane); if (two) tr_finish(b, vb, scr, lane);
        }
    }
}
__device__ __forceinline__ void moe_tilebase(const Frame& F0, const Args& args, int l) {
    const Frame F = fresh(F0);
    __syncthreads();
    if (F.tid < 32) { unsigned* ecnt = (unsigned*)(F.ctl + CW_ECNT + l * 32 * 64); F.MISC[49 + F.tid] = __hip_atomic_load(ecnt + 64 * F.tid, RLX_AGENT); }
    __syncthreads();
    if (F.tid == 0) { int acc = 0;
        for (int e = 0; e < 32; ++e) { const unsigned c = F.MISC[49 + e]; F.MISC[16 + e] = (unsigned)acc; acc += (int)((c + 255u) >> 8); }
        F.MISC[48] = (unsigned)acc; }
    __syncthreads();
}
__device__ __forceinline__ void moe_rowmaps(const Frame& F0, const Args& args, const pg8::MoeOrder& S, LAS int* rowmap) {
    const Frame F = fresh(F0);
    const int* perm = WSP(int, WS_PERM);
    pg8::Unit u; int idxs[8]; int nu = 0;
#pragma unroll
    for (int i = 0; i < 8; ++i) { idxs[i] = -1; if (S.next(i, u)) { idxs[i] = u.gbase + min(F.tid & 255, u.gcnt - 1); nu = i + 1; } }
    if (F.tid < 256) { int v[8];
#pragma unroll
        for (int i = 0; i < 8; ++i) v[i] = perm[idxs[i] < 0 ? 0 : idxs[i]];
#pragma unroll
        for (int i = 0; i < 8; ++i) if (idxs[i] >= 0) rowmap[i * 256 + F.tid] = v[i] >> 1; }
    __syncthreads();
}
__device__ __forceinline__ void lru_conv_phase(const Frame& F0, const Args& args, int l) {
    const Frame F = fresh(F0);
    const int lane = F.lane, cg = lane & 7, tg = lane >> 3;
    const bf16* PROJ = WSP(bf16, WS_PROJ); bf16* XC = WSP(bf16, WS_XC);
    for (int wu = F.vcu * NWAVES + F.wave; wu < 4096; wu += F.G * NWAVES) {
        const int hb = wu & 7, c = (wu >> 3) & 127, b = wu >> 10, t0 = c * 64, ch0 = hb * 64 + 8 * cg;
        const bf16* xrp = PROJ + (size_t)b * T * PROJ_LD + XR_OFF + ch0;
        v4u raw[11];
#pragma unroll
        for (int rr = 0; rr < 11; ++rr) { const int t = t0 + 8 * tg - 2 + rr, tc = min(max(t, 0), T - 1); raw[rr] = *(const v4u*)(xrp + (size_t)tc * PROJ_LD); }
        f32x4 wv[5][2];
#pragma unroll
        for (int j = 0; j < 4; ++j) { wv[j][0] = *(const f32x4*)(INP(10) + (l * 4 + j) * 512 + ch0); wv[j][1] = *(const f32x4*)(INP(10) + (l * 4 + j) * 512 + ch0 + 4); }
        wv[4][0] = *(const f32x4*)(INP(11) + l * 512 + ch0); wv[4][1] = *(const f32x4*)(INP(11) + l * 512 + ch0 + 4);
        unsigned ow[8][4];
#pragma unroll
        for (int pp = 0; pp < 4; ++pp) {
            float xl[11], xh[11];
#pragma unroll
            for (int rr = 0; rr < 11; ++rr) { const int t = t0 + 8 * tg - 2 + rr; const unsigned w = (t >= 0 && t < T) ? raw[rr][pp] : 0u; xl[rr] = bflo(w); xh[rr] = bfhi(w); }
#pragma unroll
            for (int tk = 0; tk < 8; ++tk) { float ol = wv[4][pp >> 1][2 * (pp & 1)], oh = wv[4][pp >> 1][2 * (pp & 1) + 1];
#pragma unroll
                for (int j = 0; j < 4; ++j) { ol += wv[j][pp >> 1][2 * (pp & 1)] * xl[tk + j]; oh += wv[j][pp >> 1][2 * (pp & 1) + 1] * xh[tk + j]; }
                ow[tk][pp] = pk2(ol, oh); }
        }
#pragma unroll
        for (int tk = 0; tk < 8; ++tk) *(v4u*)(XC + ((size_t)b * T + t0 + 8 * tg + tk) * 512 + ch0) = (v4u){ow[tk][0], ow[tk][1], ow[tk][2], ow[tk][3]};
    }
}
__device__ __forceinline__ void lru_load_frags(bf16x8 (&af)[4][2], const bf16* xcp, int t0, int lane) {
#pragma unroll
    for (int mt = 0; mt < 4; ++mt) { const int tau = 16 * ((lane & 15) >> 2) + 4 * mt + (lane & 3);
#pragma unroll
        for (int s = 0; s < 2; ++s) af[mt][s] = *(const bf16x8*)(xcp + (size_t)(t0 + tau) * 512 + 32 * s); }
}
template <int DBG = 0>
__device__ __forceinline__ void lru2_phase(const Frame& F0, const Args& args, int l, bf16* obase, int opitch, int ooff) {
    const Frame F = fresh(F0);
    const int lane = F.lane, wave = F.wave, dw = wave >> 2, wq = wave & 3;
    LAS bf16* HP = (LAS bf16*)(F.lds + RING_OFF);
    LAS bf16* YRT = (LAS bf16*)(F.lds + RING_OFF + 131072 + wave * 1024);
    LAS f32x2* CT = (LAS f32x2*)(F.lds + RING_OFF + 139264);
    const bf16* PROJ = WSP(bf16, WS_PROJ); const bf16* XC = WSP(bf16, WS_XC);
    for (int un = F.vcu; un < 256; un += F.G) {
        const int b = un >> 6, hb = (un >> 3) & 7, s8 = un & 7;
        const int n = lane & 15, g = lane >> 4, hf = n >> 3, cj = n & 7;
        const int chg = hb * 64 + s8 * 8 + cj;
        const bf16* WLp = WSP(bf16, WS_WL) + ((size_t)(l * 8 + hb) * 256) * 64;
        bf16x8 bg[2], bs[2];
#pragma unroll
        for (int s = 0; s < 2; ++s) { bg[s] = *(const bf16x8*)(WLp + ((2 * dw + hf) * 64 + s8 * 8 + cj) * 64 + 32 * s + 8 * g);
            v4u sel = (v4u){0u, 0u, 0u, 0u};
            if (32 * s + 8 * g == 8 * s8) { const unsigned one = (cj & 1) ? 0x3F800000u : 0x00003F80u; sel[0] = (cj >> 1) == 0 ? one : 0u; sel[1] = (cj >> 1) == 1 ? one : 0u; sel[2] = (cj >> 1) == 2 ? one : 0u; sel[3] = (cj >> 1) == 3 ? one : 0u; }
            bs[s] = __builtin_bit_cast(bf16x8, sel); }
        const float b_r = INP(13)[(l * 2 + dw) * 512 + chg], b_i = INP(15)[(l * 2 + dw) * 512 + chg], lam = INP(16)[(l * 2 + dw) * 512 + chg];
        const float m8sp = -8.0f * ((lam > 15.f) ? __expf(-lam) : log1pf(__expf(-lam)));
        const bf16* xcp = XC + (size_t)b * T * 512 + hb * 64 + 8 * g;
        const bf16* yrp = PROJ + (size_t)b * T * PROJ_LD + YR_OFF + hb * 64 + s8 * 8;
        bf16* outp = obase + (size_t)b * T * opitch + ooff + hb * 64 + s8 * 8;
        const int pos = dw ? 7 - (2 * g + hf) : 2 * g + hf;
        float hrun = 0.f;
        bf16x8 nxt[4][2]; v4u ynx = (v4u){0u, 0u, 0u, 0u};
        { const int c0 = dw ? 127 - wq : wq; lru_load_frags(nxt, xcp, c0 * 64, lane); }
        __syncthreads();
#pragma unroll 1
        for (int rd = 0; rd < 32; ++rd) {
            const int c = dw ? 127 - (4 * rd + wq) : 4 * rd + wq, t0 = c * 64;
            const bool second = (DBG & 2) ? false : rd >= 16;
            bf16x8 af[4][2];
#pragma unroll
            for (int mt = 0; mt < 4; ++mt) { af[mt][0] = nxt[mt][0]; af[mt][1] = nxt[mt][1]; }
            const v4u ycur = ynx;
            { const int rn = min(rd + 1, 31), cn = dw ? 127 - (4 * rn + wq) : 4 * rn + wq; if (!(DBG & 1)) lru_load_frags(nxt, xcp, cn * 64, lane);
              if (rn >= 16) ynx = *(const v4u*)(yrp + (size_t)(cn * 64 + lane) * PROJ_LD); }
            if (second) *(LAS v4u*)(YRT + lane * 8) = ycur;
            f32x4 ag[4], ax[4];
#pragma unroll
            for (int mt = 0; mt < 4; ++mt) { ag[mt] = (f32x4){0.f, 0.f, 0.f, 0.f}; ax[mt] = (f32x4){0.f, 0.f, 0.f, 0.f};
#pragma unroll
                for (int s = 0; s < 2; ++s) { ag[mt] = __builtin_amdgcn_mfma_f32_16x16x32_bf16(af[mt][s], bg[s], ag[mt], 0, 0, 0); ax[mt] = __builtin_amdgcn_mfma_f32_16x16x32_bf16(af[mt][s], bs[s], ax[mt], 0, 0, 0); } }
            float a[8], bx[8];
#pragma unroll
            for (int jj = 0; jj < 8; ++jj) {
                const float lo = ag[jj >> 2][jj & 3], hi = ag[2 + (jj >> 2)][jj & 3];
                const float mine = hf ? hi : lo, send = hf ? lo : hi, other = __shfl_xor(send, 8);
                const float xcv = hf ? ax[2 + (jj >> 2)][jj & 3] : ax[jj >> 2][jj & 3];
                const float rr = fsigmoid((hf ? other : mine) + b_r), ii = fsigmoid((hf ? mine : other) + b_i);
                const float av = __expf(m8sp * rr); a[jj] = av; bx[jj] = __builtin_amdgcn_sqrtf(fmaxf(1.0f - av * av, 0.f)) * (ii * xcv); }
            float A8 = 1.f, B8 = 0.f;
            if (dw == 0) {
#pragma unroll
                for (int jj = 0; jj < 8; ++jj) { B8 = a[jj] * B8 + bx[jj]; A8 *= a[jj]; }
            } else {
#pragma unroll
                for (int jj = 7; jj >= 0; --jj) { B8 = a[jj] * B8 + bx[jj]; A8 *= a[jj]; }
            }
            float Ap = 1.f, Bp = 0.f, At = 1.f, Bt = 0.f;
#pragma unroll
            for (int k = 0; k < 8; ++k) { const int seg = dw ? 7 - k : k; const int src = cj + 8 * (seg & 1) + 16 * (seg >> 1);
                const float Ak = __shfl(A8, src), Bk = __shfl(B8, src);
                if (k < pos) { Bp = Ak * Bp + Bk; Ap *= Ak; }
                Bt = Ak * Bt + Bk; At *= Ak; }
            const int par = rd & 1;
            if (g == 0 && hf == 0) CT[((par * 2 + dw) * 4 + wq) * 8 + cj] = (f32x2){At, Bt};
            __syncthreads();
            float h = hrun;
#pragma unroll
            for (int q = 0; q < 4; ++q) { const f32x2 ab = CT[((par * 2 + dw) * 4 + q) * 8 + cj]; if (q < wq) h = ab.x * h + ab.y; hrun = ab.x * hrun + ab.y; }
            h = Ap * h + Bp;
            float hv[8];
            if (dw == 0) {
#pragma unroll
                for (int jj = 0; jj < 8; ++jj) { h = a[jj] * h + bx[jj]; hv[jj] = h; }
            } else {
#pragma unroll
                for (int jj = 7; jj >= 0; --jj) { h = a[jj] * h + bx[jj]; hv[jj] = h; }
            }
            const int tl0 = 16 * g + 8 * hf;
            if (DBG & 4) { if (hv[0] + hv[7] == 123.456f) outp[0] = 1; } else if (!second) {
                LAS bf16* hp = HP + ((size_t)(dw * 64 + (dw ? c - 64 : c)) * 64 + tl0) * 8 + cj;
#pragma unroll
                for (int jj = 0; jj < 8; ++jj) hp[jj * 8] = (bf16)f2bf(hv[jj]);
            } else {
                const LAS bf16* hp = HP + ((size_t)((1 - dw) * 64 + (dw ? c : c - 64)) * 64 + tl0) * 8 + cj;
                LDS_WAIT(); asm volatile("" ::: "memory");
                float yv[8], pv[8];
#pragma unroll
                for (int jj = 0; jj < 8; ++jj) { yv[jj] = bf2f(YRT[(tl0 + jj) * 8 + cj]); pv[jj] = bf2f(hp[jj * 8]); }
#pragma unroll
                for (int jj = 0; jj < 8; ++jj) YRT[(tl0 + jj) * 8 + cj] = (bf16)f2bf((hv[jj] + pv[jj]) * gelu_tanh(yv[jj]));
                LDS_WAIT(); asm volatile("" ::: "memory");
                *(v4u*)(outp + (size_t)(t0 + lane) * opitch) = *(const LAS v4u*)(YRT + lane * 8);
                LDS_WAIT(); asm volatile("" ::: "memory");
            }
        }
        __syncthreads();
    }
}
constexpr int AT_KR = 0, AT_VR = 73728, AT_VPITCH = 1168, AT_RPB = 148480;
__device__ __forceinline__ void attn2_phase(const Frame& F0, const Args& args, int l, bf16* obase, int opitch) {
    const Frame F = fresh(F0);
    const int tid = F.tid, lane = F.lane, wave = F.wave;
    LAS unsigned char* KR = F.lds + AT_KR; LAS unsigned char* VR = F.lds + AT_VR;
    LAS float* rpb = (LAS float*)(F.lds + AT_RPB);
    const bf16* PROJ = WSP(bf16, WS_PROJ); const bf16* VT = WSP(bf16, WS_VT);
    const int qb = wave & 3, dh = wave >> 2, qn = lane & 15, g = lane >> 4;
    const int cb = (qb == 0) ? 0 : ((qb == 1) ? 8 : ((qb == 2) ? 24 : 32));
    const int w = 16 * qb + qn, cs = min(max(w - 8, 0), 48);
    const int st = tid >> 3, sc = tid & 7;
    bool v0[4]; int dsel[4];
#pragma unroll
    for (int j = 0; j < 4; ++j) { const int kc0 = cb + 4 * g + j; v0[j] = (kc0 >= cs) && (kc0 <= cs + 15); dsel[j] = (v0[j] ? kc0 : kc0 + 16) - w + 15; }
    for (int un = F.vcu; un < 256; un += F.G) {
        const int bh = un >> 3, b = bh >> 3, h = bh & 7, R0 = (un & 7) * 16;
        __syncthreads();
        for (int i = tid; i < 465; i += 512) rpb[i] = INP(9)[(l * 8 + h) * 465 + i];
        const bf16* kg = PROJ + ((size_t)b * T + st) * PROJ_LD + K_OFF + h * 64 + 8 * sc;
        const bf16* vg = VT + ((size_t)(b * 512 + h * 64 + st)) * T + 8 * sc;
        const int kdst = st * 128 + ((sc ^ ((st >> 1) & 7)) * 16);
        const int vdst = st * AT_VPITCH + sc * 16;
        const int rs0 = min(max(R0 - 4, 0), 120);
        {
            v4u kk[8], vv[8];
#pragma unroll
            for (int j = 0; j < 8; ++j) { kk[j] = *(const v4u*)(kg + (size_t)(rs0 + j) * 64 * PROJ_LD); vv[j] = *(const v4u*)(vg + (rs0 + j) * 64); }
#pragma unroll
            for (int j = 0; j < 8; ++j) { const int slot = (rs0 + j) % 9; *(LAS v4u*)(KR + slot * 8192 + kdst) = kk[j]; *(LAS v4u*)(VR + slot * 128 + vdst) = vv[j]; }
        }
        __syncthreads();
        int have = rs0 + 7;
        v2u py0 = (v2u){0u, 0u}, py1 = (v2u){0u, 0u}; bf16* pop = nullptr;
        bf16x8 qn0, qn1;
        { const bf16* qp = PROJ + ((size_t)b * T + R0 * 64 + w) * PROJ_LD + Q_OFF + h * 64; qn0 = *(const bf16x8*)(qp + 8 * g); qn1 = *(const bf16x8*)(qp + 32 + 8 * g); }
#pragma unroll 1
        for (int s = 0; s < 16; ++s) {
            const int r = R0 + s;
            if (s > 0) { *(v2u*)pop = py0; *(v2u*)(pop + 16) = py1; }
            const size_t tokq = (size_t)b * T + r * 64 + w;
            const bf16x8 qf0 = qn0, qf1 = qn1;
            { const int r2 = min(r + 1, R0 + 15); const bf16* qp = PROJ + ((size_t)b * T + r2 * 64 + w) * PROJ_LD + Q_OFF + h * 64; qn0 = *(const bf16x8*)(qp + 8 * g); qn1 = *(const bf16x8*)(qp + 32 + 8 * g); }
            const int rsn = min(max(r + 1 - 4, 0), 120); const bool newrow = (s + 1 < 16) && (rsn + 7 > have); const int nrow = min(rsn + 7, 127);
            const v4u pk = *(const v4u*)(kg + (size_t)nrow * 64 * PROJ_LD), pv = *(const v4u*)(vg + nrow * 64);
            const int rs = min(max(r - 4, 0), 120);
            int slot = rs % 9;
            f32x4 sc4[16];
#pragma unroll
            for (int kr = 0; kr < 8; ++kr) {
#pragma unroll
                for (int ch = 0; ch < 2; ++ch) { const int kt = cb + 16 * ch + qn; const LAS unsigned char* kp = KR + slot * 8192 + kt * 128; const int sw = (kt >> 1) & 7;
                    const bf16x8 kf0 = *(const LAS bf16x8*)(kp + ((g ^ sw) * 16)), kf1 = *(const LAS bf16x8*)(kp + (((4 + g) ^ sw) * 16));
                    f32x4 a = (f32x4){0.f, 0.f, 0.f, 0.f};
                    a = __builtin_amdgcn_mfma_f32_16x16x32_bf16(kf0, qf0, a, 0, 0, 0);
                    a = __builtin_amdgcn_mfma_f32_16x16x32_bf16(kf1, qf1, a, 0, 0, 0);
                    sc4[2 * kr + ch] = a; }
                slot = (slot == 8) ? 0 : slot + 1;
            }
            float sv[8][4]; float mx = -1e30f;
            const LAS float* rp = rpb + (rs - r + 7) * 31;
#pragma unroll
            for (int kr = 0; kr < 8; ++kr)
#pragma unroll
                for (int j = 0; j < 4; ++j) { const float s = (v0[j] ? sc4[2 * kr][j] : sc4[2 * kr + 1][j]) + rp[kr * 31 + dsel[j]]; sv[kr][j] = s; mx = fmaxf(mx, s); }
            mx = fmaxf(mx, __shfl_xor(mx, 16)); mx = fmaxf(mx, __shfl_xor(mx, 32));
            float sum = 0.f;
#pragma unroll
            for (int kr = 0; kr < 8; ++kr)
#pragma unroll
                for (int j = 0; j < 4; ++j) { const float pe = __expf(sv[kr][j] - mx); sum += pe; sc4[2 * kr][j] = v0[j] ? pe : 0.f; sc4[2 * kr + 1][j] = v0[j] ? 0.f : pe; }
            sum += __shfl_xor(sum, 16); sum += __shfl_xor(sum, 32);
            const float inv = __builtin_amdgcn_rcpf(sum);
            f32x4 o0 = (f32x4){0.f, 0.f, 0.f, 0.f}, o1 = (f32x4){0.f, 0.f, 0.f, 0.f};
            slot = rs % 9;
            const LAS unsigned char* vb0 = VR + (32 * dh + qn) * AT_VPITCH + (cb + 4 * g) * 2;
#pragma unroll
            for (int kr = 0; kr < 8; ++kr) {
                v4u pw; pw.x = pk2(sc4[2 * kr][0], sc4[2 * kr][1]); pw.y = pk2(sc4[2 * kr][2], sc4[2 * kr][3]); pw.z = pk2(sc4[2 * kr + 1][0], sc4[2 * kr + 1][1]); pw.w = pk2(sc4[2 * kr + 1][2], sc4[2 * kr + 1][3]);
                const bf16x8 pf = __builtin_bit_cast(bf16x8, pw);
                const LAS unsigned char* vp = vb0 + slot * 128;
                const v2u lo0 = *(const LAS v2u*)vp, hi0 = *(const LAS v2u*)(vp + 32), lo1 = *(const LAS v2u*)(vp + 16 * AT_VPITCH), hi1 = *(const LAS v2u*)(vp + 16 * AT_VPITCH + 32);
                o0 = __builtin_amdgcn_mfma_f32_16x16x32_bf16(__builtin_bit_cast(bf16x8, ((v4u){lo0.x, lo0.y, hi0.x, hi0.y})), pf, o0, 0, 0, 0);
                o1 = __builtin_amdgcn_mfma_f32_16x16x32_bf16(__builtin_bit_cast(bf16x8, ((v4u){lo1.x, lo1.y, hi1.x, hi1.y})), pf, o1, 0, 0, 0);
                slot = (slot == 8) ? 0 : slot + 1;
            }
            py0 = (v2u){pk2(o0[0] * inv, o0[1] * inv), pk2(o0[2] * inv, o0[3] * inv)}; py1 = (v2u){pk2(o1[0] * inv, o1[1] * inv), pk2(o1[2] * inv, o1[3] * inv)};
            pop = obase + tokq * opitch + h * 64 + 32 * dh + 4 * g;
            if (newrow) { const int ns = nrow % 9; *(LAS v4u*)(KR + ns * 8192 + kdst) = pk; *(LAS v4u*)(VR + ns * 128 + vdst) = pv; have = nrow; }
            __syncthreads();
        }
        *(v2u*)pop = py0; *(v2u*)(pop + 16) = py1;
    }
    __syncthreads();
}
__device__ __forceinline__ bf16x8 lds_gather8(const LAS bf16* p, int stride) {
    unsigned short e[8];
#pragma unroll
    for (int j = 0; j < 8; ++j) e[j] = p[j * stride];
    v4u w; w.x = e[0] | ((unsigned)e[1] << 16); w.y = e[2] | ((unsigned)e[3] << 16); w.z = e[4] | ((unsigned)e[5] << 16); w.w = e[6] | ((unsigned)e[7] << 16);
    return __builtin_bit_cast(bf16x8, w);
}
constexpr int FA_PITCH = 136, FB_PITCH = 264;
__device__ __forceinline__ void fft_a2_phase(const Frame& F0, const Args& args) {
    const Frame F = fresh(F0);
    const int tid = F.tid, lane = F.lane, wave = F.wave, nl = lane & 31, hh = lane >> 5;
    LAS bf16* GT = (LAS bf16*)(F.lds + RING_OFF);
    LAS bf16* FAL = (LAS bf16*)(F.lds + RING_OFF + 65536);
    LAS f32x2* TWL = (LAS f32x2*)(F.lds + RING_OFF + 65536 + 34816);
    const bf16* PROJ = WSP(bf16, WS_PROJ); const bf16* FA = WSP(bf16, WS_FA); const f32x2* TW = WSP(f32x2, WS_TW); bf16* ZP = WSP(bf16, WS_U);
    __syncthreads();
#pragma unroll
    for (int i_ = 0; i_ < 4; ++i_) { const int i = tid + 512 * i_, r = i >> 4, c = i & 15; *(LAS v4u*)(FAL + r * FA_PITCH + 8 * c) = *(const v4u*)(FA + r * 128 + 8 * c); }
    for (int un = F.vcu; un < 1024; un += F.G) {
        const int b = un >> 8, t2 = (un >> 1) & 127, half = un & 1;
        __syncthreads();
        if (tid < 64) TWL[tid] = TW[t2 * 64 + tid];
        {
            v4u v[8];
#pragma unroll
            for (int i = 0; i < 8; ++i) { const int idx = tid + 512 * i, k = idx >> 5, c = idx & 31, part = k >> 6, t1 = k & 63;
                v[i] = *(const v4u*)(PROJ + ((size_t)b * T + 128 * t1 + t2) * PROJ_LD + G_OFF + part * 512 + half * 256 + 8 * c); }
#pragma unroll
            for (int i = 0; i < 8; ++i) { const int idx = tid + 512 * i; *(LAS v4u*)(GT + (size_t)idx * 8) = v[i]; }
        }
        __syncthreads();
        {
            const int ch = 32 * wave + nl;
            bf16x8 bf[8];
#pragma unroll
            for (int s = 0; s < 8; ++s) bf[s] = lds_gather8(GT + (16 * s + 8 * hh) * 256 + ch, 256);
            f32x16 acc[4];
#pragma unroll
            for (int mt = 0; mt < 4; ++mt) { acc[mt] = (f32x16){};
#pragma unroll
                for (int s = 0; s < 8; ++s) { const bf16x8 af = *(const LAS bf16x8*)(FAL + (32 * mt + nl) * FA_PITCH + 16 * s + 8 * hh); acc[mt] = __builtin_amdgcn_mfma_f32_32x32x16_bf16(af, bf[s], acc[mt], 0, 0, 0); } }
#pragma unroll
            for (int mt = 0; mt < 2; ++mt)
#pragma unroll
                for (int rg = 0; rg < 16; ++rg) { const int k1 = 32 * mt + (rg & 3) + 8 * (rg >> 2) + 4 * hh; const f32x2 cs = TWL[k1];
                    const float zr = acc[mt][rg], zi = acc[mt + 2][rg];
                    GT[k1 * 256 + ch] = (bf16)f2bf(zr * cs.x + zi * cs.y); GT[(64 + k1) * 256 + ch] = (bf16)f2bf(zi * cs.x - zr * cs.y);
                }
        }
        __syncthreads();
#pragma unroll
        for (int i = 0; i < 8; ++i) { const int idx = tid + 512 * i, m = idx >> 5, c = idx & 31, pp = m >> 6, k1 = m & 63;
            *(v4u*)(ZP + ((size_t)(b * 64 + k1) * 128 + t2) * 1024 + pp * 512 + half * 256 + 8 * c) = *(const LAS v4u*)(GT + (size_t)idx * 8); }
    }
    __syncthreads();
}
__device__ __forceinline__ void fft_b2_phase(const Frame& F0, const Args& args) {
    const Frame F = fresh(F0);
    const int tid = F.tid, lane = F.lane, wave = F.wave, nl = lane & 31, hh = lane >> 5;
    LAS bf16* ZT = (LAS bf16*)(F.lds + RING_OFF);
    LAS bf16* FBL = (LAS bf16*)(F.lds + RING_OFF + 65536);
    bf16* PROJ = WSP(bf16, WS_PROJ); const bf16* FB = WSP(bf16, WS_FB); const bf16* ZP = WSP(bf16, WS_U);
    __syncthreads();
#pragma unroll
    for (int i_ = 0; i_ < 8; ++i_) { const int i = tid + 512 * i_, r = i >> 5, c = i & 31; *(LAS v4u*)(FBL + r * FB_PITCH + 8 * c) = *(const v4u*)(FB + r * 256 + 8 * c); }
    const int nt = wave & 3, mh = wave >> 2;
    for (int un = F.vcu; un < 1024; un += F.G) {
        const int b = un >> 8, k1 = (un >> 2) & 63, qt = un & 3;
        __syncthreads();
        {
            v4u v[8];
#pragma unroll
            for (int i = 0; i < 8; ++i) { const int idx = tid + 512 * i, k = idx >> 4, c = idx & 15, part = k >> 7, t2 = k & 127;
                v[i] = *(const v4u*)(ZP + ((size_t)(b * 64 + k1) * 128 + t2) * 1024 + part * 512 + qt * 128 + 8 * c); }
#pragma unroll
            for (int i = 0; i < 8; ++i) { const int idx = tid + 512 * i; *(LAS v4u*)(ZT + (size_t)idx * 8) = v[i]; }
        }
        __syncthreads();
        const int ch = 32 * nt + nl;
        f32x16 acc[2];
        acc[0] = (f32x16){}; acc[1] = (f32x16){};
#pragma unroll 1
        for (int sc = 0; sc < 4; ++sc) {
            bf16x8 bf[4];
#pragma unroll
            for (int q = 0; q < 4; ++q) bf[q] = lds_gather8(ZT + (16 * (4 * sc + q) + 8 * hh) * 128 + ch, 128);
#pragma unroll
            for (int m2 = 0; m2 < 2; ++m2)
#pragma unroll
                for (int q = 0; q < 4; ++q) { const bf16x8 af = *(const LAS bf16x8*)(FBL + (64 * mh + 32 * m2 + nl) * FB_PITCH + 16 * (4 * sc + q) + 8 * hh); acc[m2] = __builtin_amdgcn_mfma_f32_32x32x16_bf16(af, bf[q], acc[m2], 0, 0, 0); }
        }
        __syncthreads();
#pragma unroll
        for (int m2 = 0; m2 < 2; ++m2)
#pragma unroll
            for (int rg = 0; rg < 16; ++rg) { const int k2 = 64 * mh + 32 * m2 + (rg & 3) + 8 * (rg >> 2) + 4 * hh; ZT[k2 * 128 + ch] = (bf16)f2bf(acc[m2][rg] * (1.0f / 1024.0f)); }
        __syncthreads();
#pragma unroll
        for (int i = 0; i < 4; ++i) { const int idx = tid + 512 * i, k2 = idx >> 4, c = idx & 15;
            *(v4u*)(PROJ + ((size_t)b * T + k1 + 64 * k2) * PROJ_LD + G_OFF + qt * 128 + 8 * c) = *(const LAS v4u*)(ZT + (size_t)idx * 8); }
    }
    __syncthreads();
}
__device__ __forceinline__ int fresh_bid() { int b = (int)blockIdx.x; asm volatile("" : "+s"(b)); return b; }
constexpr int PPL = 9, N_PHASES = 2 + PPL * DEPTH;
__global__ void __launch_bounds__(NWAVES * 64, 2) mega_fwd(Args args, int li) {
    extern __shared__ __attribute__((aligned(16))) unsigned char lds[];
    Frame F;
    F.lds = (LAS unsigned char*)lds;
    F.MISC = (volatile LAS unsigned*)(F.lds + MISC_OFF);
    F.tid = threadIdx.x; F.lane = F.tid & 63; F.wave = __builtin_amdgcn_readfirstlane(F.tid >> 6);
    F.G = gridDim.x; { const int bx = blockIdx.x; F.vcu = (F.G % 8 == 0) ? (bx % 8) * (F.G / 8) + bx / 8 : bx; }
    F.ctl = (gu32*)(args.ws + WS_CTL);
    for (int u = F.tid; u < (LDS_BYTES - LDSCTL_OFF) / 4; u += NWAVES * 64) ((LAS unsigned*)(F.lds + LDSCTL_OFF))[u] = 0u;
    __syncthreads();
    const int lo = args.ph_lo, hi = args.ph_hi;
    XcdBarrier bar; bar.bar = (unsigned*)(F.ctl + CW_BAR) + li * XCD_BAR_WORDS; bar.x = 0; bar.st = nullptr;
    if (hi - lo > 1) bar = xcd_barrier_post((unsigned*)(F.ctl + CW_BAR) + li * XCD_BAR_WORDS, F.MISC + 8);
#ifndef PHMASK
#define PHMASK 0xFFFF
#endif
#define EN(kind) ((PHMASK >> (kind)) & 1)
#define IN(k) (lo <= (k) && (k) < hi)
#define SEAM(k) do { if (IN(k) && IN((k) + 1)) { xcd_barrier(bar); for (int rb_ = 0; rb_ < REP_B; ++rb_) xcd_barrier(bar); } } while (0)

    if (EN(0) && IN(0)) { for (int rep = 0; rep < 1 + REP_C; ++rep) p0_prologue(F, args); SEAM(0); }
    for (int l = 0; l < DEPTH; ++l) {
        const int pb = 1 + PPL * l;
        bf16* U = WSP(bf16, WS_U); bf16* PROJ = WSP(bf16, WS_PROJ); bf16* GATES = WSP(bf16, WS_GATES);
        if (EN(1) && IN(pb + 0)) { if (l == 0) { for (int rep = 0; rep < (REP_R & 1); ++rep) rows_phase<0>(F, args, l); rows_phase<0>(F, args, l); } else rows_phase<1>(F, args, l); SEAM(pb + 0); }
        if (EN(2) && IN(pb + 1)) {
            pg8::Gemm g{U, U, U, WSP(bf16, WS_WP2) + (size_t)l * NP2 * 1024, nullptr, nullptr, 1024, 1024, 1024};
            pg8::StaticOrder S; S.init(NTOK, NP2, F.G, fresh_bid());
            EpiP2 E{PROJ, WSP(bf16, WS_VT), GATES, INP(8) + l * 3072};
            for (int rep = 0; rep < 1 + (REP_GS & 1 ? REP_G : 0); ++rep) pg8::gemm_phase<EpiP2, pg8::StaticOrder, true>(F.lds + RING_OFF, g, S, E, fresh(F).tid);
            SEAM(pb + 1);
        }
        if (EN(3) && IN(pb + 2)) {
            for (int rep = 0; rep < REP_M; ++rep) { if (REP_MS & 1) attn2_phase(F, args, l, WSP(bf16, WS_SCR), 512); if (REP_MS & 2) lru_conv_phase(F, args, l); if (REP_MS & 4) fft_a2_phase(F, args); if (REP_MS & 16) fft_a2_phase(F, args); }
            lru_conv_phase(F, args, l); attn2_phase(F, args, l, PROJ, PROJ_LD); fft_a2_phase(F, args); SEAM(pb + 2); }
        if (EN(4) && IN(pb + 3)) { for (int rep = 0; rep < REP_M; ++rep) { if (REP_MS & 2) lru2_phase<REP_DBG>(F, args, l, WSP(bf16, WS_SCR), 512, 0); if (REP_MS & 4) fft_b2_phase(F, args); if (REP_MS & 32) fft_b2_phase(F, args); }
            lru2_phase(F, args, l, PROJ, PROJ_LD, YR_OFF); fft_b2_phase(F, args); SEAM(pb + 3); }
        if (EN(6) && IN(pb + 4)) {
            const bf16* WP = WSP(bf16, WS_WPROJ) + (size_t)l * 3 * 1024 * 512;
            pg8::Gemm g{PROJ + Q_OFF, PROJ + YR_OFF, PROJ + G_OFF, WP, WP + 1024 * 512, WP + 2 * 1024 * 512, PROJ_LD, 512, 512};
            pg8::MergeOrder S; S.init(NTOK, 1024, F.G, fresh_bid());
            EpiMerge E{GATES, U, WSP(bf16, WS_VT) + (size_t)fresh_bid() * 65536};
            for (int rep = 0; rep < 1 + (REP_GS & 2 ? REP_G : 0); ++rep) pg8::gemm_phase<EpiMerge, pg8::MergeOrder, true>(F.lds + RING_OFF, g, S, E, fresh(F).tid);
            SEAM(pb + 4);
        }
        if (EN(7) && IN(pb + 5)) {
            pg8::Gemm g{U, U, U, WSP(bf16, WS_WOUT) + (size_t)l * 1024 * 1024, nullptr, nullptr, 1024, 1024, 1024};
            pg8::StaticOrder S; S.init(NTOK, 1024, F.G, fresh_bid());
            EpiResid E{l == 0 ? INP(0) : (const float*)args.out, args.out, WSP(float, WS_MOD) + (size_t)l * 4 * 6144 + 2 * 1024};
            for (int rep = 0; rep < (REP_GS & 4 ? REP_G : 0); ++rep) { EpiResid E2{E.xin, WSP(float, WS_GATES), E.gt}; pg8::gemm_phase<EpiResid, pg8::StaticOrder, true>(F.lds + RING_OFF, g, S, E2, fresh(F).tid); }
            pg8::gemm_phase<EpiResid, pg8::StaticOrder, true>(F.lds + RING_OFF, g, S, E, fresh(F).tid);
            SEAM(pb + 5);
        }
        if (EN(8) && IN(pb + 6)) { if (REP_R & 2) router_phase(F, args, l, 2 + l); router_phase(F, args, l, l); SEAM(pb + 6); }
        if (EN(10) && IN(pb + 7)) {
            moe_tilebase(F, args, l);
            pg8::Gemm g{U, U, U, WSP(bf16, WS_WG1), nullptr, nullptr, 1024, 1024, 1024};
            pg8::MoeOrder S{(const LAS int*)(F.lds + MISC_OFF + 64), F.G, fresh_bid()};
            LAS int* rowmap = (LAS int*)(F.lds + XTRA_OFF);
            moe_rowmaps(F, args, S, rowmap);
            EpiSwiGLU E{WSP(bf16, WS_H)};
            for (int rep = 0; rep < 1 + (REP_GS & 8 ? REP_G : 0); ++rep) pg8::gemm_phase<EpiSwiGLU, pg8::MoeOrder, true, true>(F.lds + RING_OFF, g, S, E, fresh(F).tid, rowmap);
            SEAM(pb + 7);
        }
        if (EN(11) && IN(pb + 8)) {
            moe_tilebase(F, args, l);
            const bf16* H = WSP(bf16, WS_H);
            pg8::Gemm g{H, H, H, WSP(bf16, WS_WD), nullptr, nullptr, 512, 512, 512};
            pg8::MoeOrder S{(const LAS int*)(F.lds + MISC_OFF + 64), F.G, fresh_bid()};
            EpiYE E{PROJ};
            for (int rep = 0; rep < 1 + (REP_GS & 16 ? REP_G : 0); ++rep) pg8::gemm_phase<EpiYE, pg8::MoeOrder, true>(F.lds + RING_OFF, g, S, E, fresh(F).tid);
            SEAM(pb + 8);
        }
    }
    if (EN(12) && IN(N_PHASES - 1)) rows_phase<2>(F, args, DEPTH);
#undef IN
#undef SEAM
}

#ifndef MK_MODE
#define MK_MODE 0
#endif
extern "C" void kernel_launch(void* const* d_in, const int* in_sizes, int n_in, void* d_out, int out_size, void* d_ws, size_t ws_size, hipStream_t stream) {
    static int grid = 0;
    if (grid == 0) {
        if (n_in != 27 || in_sizes[0] != NTOK * D || out_size != NTOK * D || ws_size < WS_END) { fprintf(stderr, "kernel_launch: unexpected shapes (n_in %d, in0 %d, out %d, ws %zu < %zu)\n", n_in, n_in > 0 ? in_sizes[0] : -1, out_size, ws_size, (size_t)WS_END); grid = -1; return; }
        int dev = 0, cus = 0;
        if (hipGetDevice(&dev) != hipSuccess || hipDeviceGetAttribute(&cus, hipDeviceAttributeMultiprocessorCount, dev) != hipSuccess) { grid = -1; return; }
        if (hipFuncSetAttribute((const void*)mega_fwd, hipFuncAttributeMaxDynamicSharedMemorySize, LDS_BYTES) != hipSuccess) { fprintf(stderr, "kernel_launch: hipFuncSetAttribute failed\n"); grid = -1; return; }
        (void)hipGetLastError();
        grid = cus;
    }
    if (grid < 0) return;
    if (hipMemsetAsync((char*)d_ws + WS_CTL, 0, CTL_ZERO_BYTES, stream) != hipSuccess) return;
    Args a{};
    for (int i = 0; i < 27; ++i) a.in[i] = (const float*)d_in[i];
    a.out = (float*)d_out; a.ws = (unsigned char*)d_ws;
#if MK_MODE == 0
    a.ph_lo = 0; a.ph_hi = N_PHASES;
    hipLaunchKernelGGL(mega_fwd, dim3(grid), dim3(NWAVES * 64), LDS_BYTES, stream, a, 0);
#else
    for (int p = 0; p < N_PHASES; ++p) { a.ph_lo = p; a.ph_hi = p + 1; hipLaunchKernelGGL(mega_fwd, dim3(grid), dim3(NWAVES * 64), LDS_BYTES, stream, a, 0); }
#endif
}
```

```cpp
#include <hip/hip_runtime.h>
#include <cstdio>
#include <cstdint>
namespace pg8 {
#define PG8_LAS __attribute__((address_space(3)))
typedef unsigned short bf16_t;
typedef short bf16x8 __attribute__((ext_vector_type(8)));
typedef float f32x4 __attribute__((ext_vector_type(4)));
typedef unsigned u32x4 __attribute__((ext_vector_type(4)));
typedef unsigned u32x2 __attribute__((ext_vector_type(2)));
typedef int v4i_ __attribute__((ext_vector_type(4)));
constexpr int BM = 256, BK = 64, HALF = 128, HTB = HALF * BK * 2  , STAGE_BYTES = 8 * HTB, NXCD = 8, WGM = 8;

__host__ __device__ __forceinline__ int lds_byte(int r, int c) { const int st = (r >> 4) * 2 + (c >> 5), rr = r & 15, cc = c & 31, ob = rr * 64 + cc * 2; return st * 1024 + (ob ^ (((ob >> 9) & 1) << 5)); }
__host__ __device__ __forceinline__ void stage_rc(int b, int& R, int& C) { const int st = b / 1024, sb = b % 1024, swz = sb ^ (((sb >> 9) & 1) << 5); R = (st >> 1) * 16 + swz / 64; C = (st & 1) * 32 + (swz % 64) / 2; }
__host__ __device__ __forceinline__ int perm32(int rho) { const int n = rho >> 4, i = rho & 15; return 8 * (i >> 2) + 4 * n + (i & 3); }

struct Unit { int pm, pn, bt, z, gbase, gcnt; };
struct Gemm { const bf16_t* A0; const bf16_t* A1; const bf16_t* A2; const bf16_t* B0; const bf16_t* B1; const bf16_t* B2; int lda, ldb, K; };

__device__ __forceinline__ unsigned cvt_pk_bf16(float lo, float hi) { unsigned r; asm volatile("v_cvt_pk_bf16_f32 %0, %1, %2" : "=v"(r) : "v"(lo), "v"(hi)); return r; }

struct StaticOrder {
    int nM, nN, nwg, G, c;
    __device__ void init(int M, int N, int G_, int c_) { nM = M / BM; nN = N / BM; nwg = nM * nN; G = G_; c = c_; }
    __device__ __forceinline__ bool tile(long L, Unit& u) const {
        if (L >= nwg) return false;
        int wgid = (int)L; { const int q = nwg / NXCD, r = nwg % NXCD, xcd = wgid % NXCD, off = wgid / NXCD; wgid = (xcd < r ? xcd * (q + 1) : r * (q + 1) + (xcd - r) * q) + off; }
        const int nig = WGM * nN, gid = wgid / nig, fm = gid * WGM, gsz = (nM - fm) < WGM ? (nM - fm) : WGM;
        u.pm = fm + ((wgid % nig) % gsz); u.pn = (wgid % nig) / gsz; u.bt = u.pn; u.z = 0; u.gbase = 0; u.gcnt = 0; return true;
    }
    __device__ __forceinline__ bool next(int i, Unit& u) const { return tile((long)i * G + c, u); }
};
struct MergeOrder : StaticOrder {
    __device__ __forceinline__ bool next(int i, Unit& u) const { const int t = i / 3; if (!tile((long)t * G + c, u)) return false; u.z = i - 3 * t; return true; }
};
struct MoeOrder {
    const PG8_LAS int* tb; int G, c;
    __device__ __forceinline__ bool next(int i, Unit& u) const {
        const int L = i * G + c; const int nt = tb[32]; if (L >= nt * 4) return false;
        const int t = L >> 2, j = L & 3; unsigned z_ = 0u; asm volatile("" : "+v"(z_)); const int ln_ = (int)__builtin_amdgcn_mbcnt_hi(~0u, __builtin_amdgcn_mbcnt_lo(~0u, z_)); const int tbv_ = (ln_ >= 1 && ln_ < 32) ? tb[ln_] : 0x7fffffff;
        const int e = __popcll(__ballot(tbv_ <= t));
        const int tl = t - tb[e];
        u.pm = t; u.pn = j; u.bt = e * 4 + j; u.z = 0; u.gbase = e * 32768 + 256 * tl; u.gcnt = tb[33 + e] - 256 * tl; return true;
    }
};

template <class Epi, class Sched, bool ALIGN_EPI, bool GATHER = false, bool FP8 = false, int SCALE_W = 0x7F7F7F7F>
__device__ __forceinline__ void gemm_phase(PG8_LAS unsigned char* lds, const Gemm g, const Sched& S, const Epi& E, const int tid, const PG8_LAS int* rowmap = nullptr) {
    const int wid = __builtin_amdgcn_readfirstlane(tid >> 6), lane = tid & 63, wr = wid >> 2, wc = wid & 3, fr = lane & 15, fq = lane >> 4;
    const int K = g.K, nt = K / BK;
    int sc1_ = 0x7F7F7F7F; if constexpr (FP8) asm volatile("" : "+v"(sc1_));
    unsigned voffA[2], voffB[2]; int gR[2];
#pragma unroll
    for (int i = 0; i < 2; ++i) { int R, C; stage_rc(tid * 16 + i * 8192, R, C); const int Rb = Epi::PERM ? ((R & ~31) + perm32(R & 31)) : R;
        voffA[i] = GATHER ? (unsigned)C * 2u : (unsigned)(R * g.lda + C) * 2u; voffB[i] = (unsigned)(Rb * g.ldb + C) * 2u; gR[i] = R; }
    unsigned offC[2][2], offN[2][2];
#define PG8_GOFF(dst, ui_) do { _Pragma("unroll") for (int h_ = 0; h_ < 2; ++h_) _Pragma("unroll") for (int i_ = 0; i_ < 2; ++i_) dst[h_][i_] = (unsigned)rowmap[(ui_) * 256 + 128 * h_ + gR[i_]] * (unsigned)(g.lda * 2) + voffA[i_]; } while (0)
    const size_t kstep = (size_t)(BK * 2);
    const size_t hstepA = (size_t)HALF * g.lda * 2, hstepB = (size_t)HALF * g.ldb * 2;
    const size_t tstepA = 2 * hstepA, tstepB = 2 * hstepB;
    const unsigned ldsw = (unsigned)wid * 1024u;
    const int aoff = lds_byte(wr * 64 + fr, fq * 8), boff = lds_byte(wc * 32 + fr, fq * 8);
#define PG8_SA(b, h) (((b) * 2 + (h)) * HTB)
#define PG8_SB(b, h) ((4 + (b) * 2 + (h)) * HTB)
#define PG8_STAGE(bufoff, gbase, voff) do { _Pragma("unroll") for (int _i = 0; _i < 2; ++_i) { unsigned vo_ = (voff)[_i]; if constexpr (FP8) asm volatile("" : "+v"(vo_)); \
        __builtin_amdgcn_global_load_lds((const unsigned*)((const char*)(gbase) + vo_), (PG8_LAS unsigned*)(lds + (bufoff) + ldsw + _i * 8192), 16, 0, 0); } } while (0)
#define PG8_STAGE_A(bufoff, gbase, h, nf) do { _Pragma("unroll") for (int _i = 0; _i < 2; ++_i) { unsigned o_ = GATHER ? ((nf) ? offN[h][_i] : offC[h][_i]) : (voffA[_i] + (unsigned)((h) * hstepA)); if constexpr (FP8) asm volatile("" : "+v"(o_)); \
        __builtin_amdgcn_global_load_lds((const unsigned*)((const char*)(gbase) + o_), (PG8_LAS unsigned*)(lds + (bufoff) + ldsw + _i * 8192), 16, 0, 0); } } while (0)
#define PG8_LDA(dst, b, h) do { _Pragma("unroll") for (int m = 0; m < 4; ++m) _Pragma("unroll") for (int k = 0; k < 2; ++k) dst[m][k] = *(const PG8_LAS bf16x8*)(lds + PG8_SA(b, h) + aoff + m * 2048 + k * 1024); } while (0)
#define PG8_LDB(dst, b, h) do { _Pragma("unroll") for (int n = 0; n < 2; ++n) _Pragma("unroll") for (int k = 0; k < 2; ++k) dst[n][k] = *(const PG8_LAS bf16x8*)(lds + PG8_SB(b, h) + boff + n * 2048 + k * 1024); } while (0)
#define PG8_CAT8(x) __builtin_shufflevector(__builtin_bit_cast(v4i_, (x)[0]), __builtin_bit_cast(v4i_, (x)[1]), 0, 1, 2, 3, 4, 5, 6, 7)
#define PG8_MMA(ai, bj, At, Bt) do { __builtin_amdgcn_s_setprio(1); _Pragma("unroll") for (int m = 0; m < 4; ++m) _Pragma("unroll") for (int n = 0; n < 2; ++n) { \
        if constexpr (FP8) acc[ai][bj][m][n] = __builtin_amdgcn_mfma_scale_f32_16x16x128_f8f6f4(PG8_CAT8(Bt[n]), PG8_CAT8(At[m]), acc[ai][bj][m][n], 0, 0, 0, sc1_, 0, sc1_); \
        else { _Pragma("unroll") for (int k = 0; k < 2; ++k) acc[ai][bj][m][n] = __builtin_amdgcn_mfma_f32_16x16x32_bf16(Bt[n][k], At[m][k], acc[ai][bj][m][n], 0, 0, 0); } } __builtin_amdgcn_s_setprio(0); } while (0)
#define PG8_WAIT_V(n) asm volatile("s_waitcnt vmcnt(" #n ")" ::: "memory")
#define PG8_WAIT_L(n) asm volatile("s_waitcnt lgkmcnt(" #n ")" ::: "memory")
#define PG8_BAR __builtin_amdgcn_s_barrier()
#define PG8_SCHED __builtin_amdgcn_sched_barrier(0)
#define PG8_APTR(u) (GATHER ? (const char*)g.A0 : (const char*)((u).z == 0 ? g.A0 : ((u).z == 1 ? g.A1 : g.A2)) + (size_t)(u).pm * tstepA)
#define PG8_BPTR(u) ((const char*)((u).z == 0 ? g.B0 : ((u).z == 1 ? g.B1 : g.B2)) + (size_t)(u).bt * tstepB)
    Unit cur, nxt; int ui = 0;
    if (!S.next(0, cur)) return;
    f32x4 acc[2][2][4][2];
#pragma unroll
    for (int a = 0; a < 2; ++a)
#pragma unroll
        for (int b = 0; b < 2; ++b)
#pragma unroll
            for (int m = 0; m < 4; ++m)
#pragma unroll
                for (int n = 0; n < 2; ++n) acc[a][b][m][n] = (f32x4){0.f, 0.f, 0.f, 0.f};
    bf16x8 At[4][2], B0[2][2], B1[2][2];
    const char* cA = PG8_APTR(cur); const char* cB = PG8_BPTR(cur);
    if constexpr (GATHER) { PG8_GOFF(offC, 0); PG8_GOFF(offN, 0); }
    PG8_STAGE(PG8_SB(0, 0), cB, voffB); PG8_STAGE(PG8_SB(0, 1), cB + hstepB, voffB); PG8_STAGE_A(PG8_SA(0, 0), cA, 0, false); PG8_STAGE_A(PG8_SA(0, 1), cA, 1, false);
    if (wr == 1) PG8_BAR;
    PG8_WAIT_V(2); PG8_BAR;
    PG8_STAGE(PG8_SB(1, 0), cB + kstep, voffB); PG8_STAGE_A(PG8_SA(1, 0), cA + kstep, 0, false); PG8_STAGE(PG8_SB(1, 1), cB + hstepB + kstep, voffB);
    PG8_WAIT_V(6); PG8_BAR;
    for (;;) {
        const bool has_next = S.next(ui + 1, nxt);
        const char* nA = has_next ? PG8_APTR(nxt) : cA; const char* nB = has_next ? PG8_BPTR(nxt) : cB;
        if constexpr (GATHER) { if (has_next) { PG8_GOFF(offN, ui + 1); } else { _Pragma("unroll") for (int h_ = 0; h_ < 2; ++h_) _Pragma("unroll") for (int i_ = 0; i_ < 2; ++i_) offN[h_][i_] = offC[h_][i_]; } }
#pragma unroll 1
        for (int t = 0; t < nt; t += 2) {
            const bool last = (t == nt - 2);
            const char* a1 = cA + (size_t)(t + 1) * kstep;
            const char* a2 = last ? nA : cA + (size_t)(t + 2) * kstep; const char* b2 = last ? nB : cB + (size_t)(t + 2) * kstep;
            const char* a3 = a2 + kstep; const char* b3 = b2 + kstep;
            PG8_LDB(B0, 0, 0); PG8_LDB(B1, 0, 1); PG8_SCHED; PG8_LDA(At, 0, 0); PG8_STAGE_A(PG8_SA(1, 1), a1, 1, false);
            PG8_WAIT_V(8); PG8_WAIT_L(0); PG8_BAR; PG8_MMA(0, 0, At, B0); PG8_MMA(0, 1, At, B1); PG8_BAR; PG8_SCHED;
            PG8_LDA(At, 0, 1); PG8_STAGE(PG8_SB(0, 0), b2, voffB); PG8_STAGE(PG8_SB(0, 1), b2 + hstepB, voffB); PG8_STAGE_A(PG8_SA(0, 0), a2, 0, last);
            PG8_WAIT_V(8); PG8_WAIT_L(0); PG8_BAR; PG8_MMA(1, 0, At, B0); PG8_MMA(1, 1, At, B1); PG8_BAR; PG8_SCHED;
            PG8_LDB(B0, 1, 0); PG8_LDB(B1, 1, 1); PG8_SCHED; PG8_LDA(At, 1, 0); PG8_STAGE_A(PG8_SA(0, 1), a2, 1, last);
            PG8_WAIT_V(8); PG8_WAIT_L(0); PG8_BAR; PG8_MMA(0, 0, At, B0); PG8_MMA(0, 1, At, B1); PG8_BAR; PG8_SCHED;
            PG8_LDA(At, 1, 1); PG8_STAGE(PG8_SB(1, 0), b3, voffB); PG8_STAGE(PG8_SB(1, 1), b3 + hstepB, voffB); PG8_STAGE_A(PG8_SA(1, 0), a3, 0, last);
            PG8_WAIT_V(8); PG8_WAIT_L(0); PG8_BAR; PG8_MMA(1, 0, At, B0); PG8_MMA(1, 1, At, B1); PG8_BAR; PG8_SCHED;
        }
        if constexpr (ALIGN_EPI) { if (wr == 0) PG8_BAR; }
        unsigned ze_ = 0u; asm volatile("" : "+v"(ze_)); const int le_ = (int)__builtin_amdgcn_mbcnt_hi(~0u, __builtin_amdgcn_mbcnt_lo(~0u, ze_));
        if (!E.skip) E(acc, cur, wr, wc, le_ & 15, le_ >> 4); else { _Pragma("unroll") for (int a_ = 0; a_ < 2; ++a_) _Pragma("unroll") for (int b_ = 0; b_ < 2; ++b_) _Pragma("unroll") for (int m_ = 0; m_ < 4; ++m_) _Pragma("unroll") for (int n_ = 0; n_ < 2; ++n_) asm volatile("" :: "v"(acc[a_][b_][m_][n_])); }
        if (!has_next) break;
#pragma unroll
        for (int a = 0; a < 2; ++a)
#pragma unroll
            for (int b = 0; b < 2; ++b)
#pragma unroll
                for (int m = 0; m < 4; ++m)
#pragma unroll
                    for (int n = 0; n < 2; ++n) acc[a][b][m][n] = (f32x4){0.f, 0.f, 0.f, 0.f};
        cur = nxt; cA = nA; cB = nB; ++ui;
        if constexpr (GATHER) { _Pragma("unroll") for (int h_ = 0; h_ < 2; ++h_) _Pragma("unroll") for (int i_ = 0; i_ < 2; ++i_) offC[h_][i_] = offN[h_][i_]; }
        if constexpr (ALIGN_EPI) { if (wr == 1) PG8_BAR; }
    }
    PG8_WAIT_V(0);
    if constexpr (!ALIGN_EPI) { if (wr == 0) PG8_BAR; }
    PG8_BAR;
#undef PG8_SA
#undef PG8_SB
#undef PG8_STAGE
#undef PG8_LDA
#undef PG8_LDB
#undef PG8_MMA
#undef PG8_CAT8
#undef PG8_WAIT_V
#undef PG8_WAIT_L
#undef PG8_BAR
#undef PG8_SCHED
#undef PG8_APTR
#undef PG8_STAGE_A
#undef PG8_GOFF
#undef PG8_BPTR
}
}
constexpr int NWAVES = 8;
constexpr int NB = 4, T = 8192, D = 1024, NTOK = NB * T, DEPTH = 2;
constexpr int PROJ_LD = 3072, Q_OFF = 0, K_OFF = 512, XR_OFF = 1024, YR_OFF = 1536, G_OFF = 2048;
constexpr int GATES_LD = 3072;
constexpr int NP2 = 6144;
constexpr int NEXP = 32, XS_ROWS = 73728;
constexpr int LRU_CH = 32, LRU_NCH = T / LRU_CH;
constexpr float EPS = 1e-6f;

constexpr size_t MiB = 1u << 20;
constexpr size_t WS_CTL = 0, CTL_ZERO_BYTES = 1 * MiB;
constexpr size_t WS_MOD = 1 * MiB;
constexpr size_t WS_FA = WS_MOD + 256 * 1024;
constexpr size_t WS_FB = WS_FA + 32 * 1024;
constexpr size_t WS_TW = WS_FB + 64 * 1024;
constexpr size_t WS_WL = 2 * MiB;
constexpr size_t WS_TOKW = 3 * MiB;
constexpr size_t WS_TOKROW = WS_TOKW + 256 * 1024;
constexpr size_t WS_PERM = 4 * MiB;
constexpr size_t WS_WP2 = 20 * MiB;
constexpr size_t WS_WPROJ = 46 * MiB;
constexpr size_t WS_WOUT = 52 * MiB;
constexpr size_t WS_U = 56 * MiB;
constexpr size_t WS_VT = 120 * MiB;
constexpr size_t WS_PROJ = 152 * MiB;
constexpr size_t WS_GATES = 344 * MiB;
constexpr size_t WS_H = WS_GATES;
constexpr size_t WS_WG1 = WS_GATES + 96 * MiB, WS_WD = WS_GATES + 160 * MiB;
constexpr size_t WS_XC = 536 * MiB;
constexpr size_t WS_U8 = WS_XC;
constexpr size_t WS_XB0 = 568 * MiB, WS_XB1 = 8 * MiB;
constexpr int XB_SPLIT = 30720;
constexpr size_t WS_END = 628 * MiB;
constexpr size_t WS_SCR = WS_VT;
#ifndef REP_G
#define REP_G 0
#endif
#ifndef REP_C
#define REP_C 0
#endif
#ifndef STAG_P2
#define STAG_P2 600
#endif
#ifndef REP_DBG
#define REP_DBG 0
#endif
#ifndef REP_B
#define REP_B 0
#endif
#ifndef REP_R
#define REP_R 0
#endif
#ifndef REP_GS
#define REP_GS 31
#endif
#ifndef REP_MS
#define REP_MS 15
#endif
#ifndef REP_M
#define REP_M 0
#endif
static_assert(WS_H + (size_t)XS_ROWS * 512 * 2 <= WS_WG1 && WS_WD + 32 * MiB <= WS_XC, "ws map");
constexpr int CW_BAR = 4096;
constexpr int CW_ECNT = 16384;

constexpr int LDS_BYTES = 163840;
constexpr int RING_OFF = 0, RING_BYTES = 131072;
constexpr int XTRA_OFF = RING_BYTES;
constexpr int LDSCTL_OFF = LDS_BYTES - 512, MISC_OFF = LDSCTL_OFF + 64;

#define GAS __attribute__((address_space(1)))
#define LAS __attribute__((address_space(3)))
typedef unsigned short bf16;
typedef unsigned v4u __attribute__((ext_vector_type(4)));
typedef unsigned v2u __attribute__((ext_vector_type(2)));
typedef float f32x4 __attribute__((ext_vector_type(4)));
typedef float f32x2 __attribute__((ext_vector_type(2)));
typedef float f32x16 __attribute__((ext_vector_type(16)));
typedef short bf16x8 __attribute__((ext_vector_type(8)));
typedef short bf16x4 __attribute__((ext_vector_type(4)));
typedef GAS unsigned gu32;
#define RLX_AGENT __ATOMIC_RELAXED, __HIP_MEMORY_SCOPE_AGENT
#define LDS_WAIT() asm volatile("s_waitcnt lgkmcnt(0)" ::: "memory")
#define VM_WAIT() asm volatile("s_waitcnt vmcnt(0)" ::: "memory")
typedef __bf16 hwbf16x2 __attribute__((ext_vector_type(2)));
__device__ __forceinline__ unsigned pk2(float lo, float hi) { f32x2 v = {lo, hi}; hwbf16x2 b = __builtin_convertvector(v, hwbf16x2); return __builtin_bit_cast(unsigned, b); }
__device__ __forceinline__ unsigned pk4_fp8(float a, float b, float c, float d) { int p = __builtin_amdgcn_cvt_pk_fp8_f32(a, b, 0, false); return (unsigned)__builtin_amdgcn_cvt_pk_fp8_f32(c, d, p, true); }
__device__ __forceinline__ unsigned f2bf(float f) { return pk2(f, 0.f) & 0xffffu; }
__device__ __forceinline__ float bflo(unsigned w) { return __builtin_bit_cast(float, w << 16); }
__device__ __forceinline__ float bfhi(unsigned w) { return __builtin_bit_cast(float, w & 0xffff0000u); }
__device__ __forceinline__ float bf2f(unsigned short h) { return __builtin_bit_cast(float, (unsigned)h << 16); }
__device__ __forceinline__ float sigmoidf(float v) { return 1.0f / (1.0f + __expf(-v)); }
__device__ __forceinline__ float fsigmoid(float v) { return __builtin_amdgcn_rcpf(1.0f + __expf(-v)); }
#define PIN4(a) asm volatile("" : "+v"(a[0]), "+v"(a[1]), "+v"(a[2]), "+v"(a[3]))
#define PIN8(a) asm volatile("" : "+v"(a[0]), "+v"(a[1]), "+v"(a[2]), "+v"(a[3]), "+v"(a[4]), "+v"(a[5]), "+v"(a[6]), "+v"(a[7]))
__device__ __forceinline__ float wave_sum(float v) {
#pragma unroll
    for (int o = 1; o < 64; o <<= 1) v += __shfl_xor(v, o);
    return v;
}
#define XB_TMO      128
#define XB_XCNT(j)  (256  + 64 * (j))
#define XB_XSUB(j)  (1280 + 64 * (j))
#define XB_XGEN(j)  (2304 + 64 * (j))
#define XB_TOP      3328
#define XB_TOPGEN   3392
#define XCD_BAR_WORDS 3456
#define XB_SPIN_CAP (1u << 18)

__device__ __forceinline__ unsigned xb_ld(unsigned* p)              { return __hip_atomic_load(p, __ATOMIC_RELAXED, __HIP_MEMORY_SCOPE_AGENT); }
__device__ __forceinline__ unsigned xb_add(unsigned* p, unsigned v) { return __hip_atomic_fetch_add(p, v, __ATOMIC_RELAXED, __HIP_MEMORY_SCOPE_AGENT); }
__device__ __forceinline__ unsigned xb_xcc_id() { return (unsigned)__builtin_amdgcn_s_getreg((3 << 11) | 20) & 0xFu; }
#define XB_SPIN(cond, bar) do { unsigned _sp = 0; while (cond) { __builtin_amdgcn_s_sleep(1); \
    if ((++_sp & 255u) == 0u) { if (xb_ld(&(bar)[XB_TMO])) break; if (_sp > XB_SPIN_CAP) { atomicAdd(&(bar)[XB_TMO], 1u); break; } } } } while (0)

struct XcdBarrier {
    unsigned* bar; unsigned x;
    int wave;
    volatile LAS unsigned* st;
};

__device__ __forceinline__ XcdBarrier xcd_barrier_post(unsigned* bar, volatile LAS unsigned* st) {
    XcdBarrier b; b.bar = bar; b.x = xb_xcc_id(); b.st = st; b.wave = __builtin_amdgcn_readfirstlane((int)threadIdx.x >> 6);
    if (threadIdx.x == 0) (void)xb_add(&bar[XB_XCNT(b.x)], 1u);
    return b;
}
__device__ __forceinline__ void xcd_barrier_complete(unsigned* bar, unsigned x, unsigned& nloc, unsigned& nx) {
    const unsigned G = gridDim.x * gridDim.y * gridDim.z;
    unsigned sum, cnt, mine, sp = 0u;
    for (;;) {
        sum = 0u; cnt = 0u; mine = 0u;
#pragma unroll
        for (unsigned j = 0; j < 16; ++j) { const unsigned c = xb_ld(&bar[XB_XCNT(j)]); sum += c; cnt += (c > 0u) ? 1u : 0u; mine = (j == x) ? c : mine; }
        if (sum == G) break;
        __builtin_amdgcn_s_sleep(1);
        if ((++sp & 255u) == 0u) { if (xb_ld(&bar[XB_TMO])) break; if (sp > XB_SPIN_CAP) { atomicAdd(&bar[XB_TMO], 1u); break; } }
    }
    nloc = mine > 0u ? mine : 1u; nx = cnt > 0u ? cnt : 1u;
}

__device__ __forceinline__ void xcd_barrier(const XcdBarrier& b) {
    asm volatile("s_waitcnt vmcnt(0)" ::: "memory");
    __syncthreads();
    unsigned z_ = 0u; asm volatile("" : "+v"(z_));
    if (b.wave == 0 && __builtin_amdgcn_mbcnt_hi(~0u, __builtin_amdgcn_mbcnt_lo(~0u, z_)) == 0u) {
        unsigned* bar = b.bar;
        __builtin_amdgcn_s_waitcnt(0);
        unsigned nloc = b.st[0], nx = b.st[1];
        if (nloc == 0u) { xcd_barrier_complete(bar, b.x, nloc, nx); b.st[0] = nloc; b.st[1] = nx; }
        const unsigned old = xb_add(&bar[XB_XSUB(b.x)], 1u);
        const unsigned gen = old / nloc;
        if (old + 1u == (gen + 1u) * nloc) {
            __builtin_amdgcn_fence(__ATOMIC_RELEASE, "agent");
            asm volatile("s_waitcnt vmcnt(0)" ::: "memory");
            const unsigned og = xb_add(&bar[XB_TOP], 1u);
            const unsigned tg = og / nx;
            if (og + 1u == (tg + 1u) * nx) xb_add(&bar[XB_TOPGEN], 1u);
            else XB_SPIN(xb_ld(&bar[XB_TOPGEN]) == tg, bar);
            __builtin_amdgcn_fence(__ATOMIC_ACQUIRE, "agent");
            xb_add(&bar[XB_XGEN(b.x)], 1u);
            asm volatile("s_waitcnt vmcnt(0)" ::: "memory");
        } else {
            XB_SPIN(xb_ld(&bar[XB_XGEN(b.x)]) == gen, bar);
            __builtin_amdgcn_fence(__ATOMIC_ACQUIRE, "agent");
            asm volatile("s_waitcnt vmcnt(0)" ::: "memory");
        }
    }
    __syncthreads();
}

struct Args { const float* in[27]; float* out; unsigned char* ws; int ph_lo, ph_hi; };
struct Frame {
    LAS unsigned char* lds;
    volatile LAS unsigned* MISC;
    gu32* ctl;
    int tid, lane, wave, vcu, G;
};
__device__ __forceinline__ Frame fresh(const Frame& F) {
    Frame N = F; int w = F.wave; asm volatile("" : "+s"(w)); unsigned z = 0u; asm volatile("" : "+v"(z));
    const int ln = (int)__builtin_amdgcn_mbcnt_hi(~0u, __builtin_amdgcn_mbcnt_lo(~0u, z)); N.tid = w * 64 + ln; N.lane = ln; N.wave = w;
    int v = F.vcu; asm volatile("" : "+s"(v)); N.vcu = v; int g = F.G; asm volatile("" : "+s"(g)); N.G = g; return N;
}
#define WSP(T_, off) ((T_*)(args.ws + (off)))
#define XBROW(m) ((bf16*)(args.ws + ((m) < XB_SPLIT ? WS_XB0 + (size_t)(m) * 2048 : WS_XB1 + (size_t)((m) - XB_SPLIT) * 2048)))
#define INP(i) (args.in[i])

struct TrItem { const float* W; int ldw, k0, n0; bf16* dst; int ldd; };
__device__ __forceinline__ void tr_load(const TrItem& it, f32x4 (&v)[8], int lane) {
    const float* p = it.W + (size_t)(it.k0 + (lane >> 3)) * it.ldw + it.n0 + 4 * (lane & 7);
#pragma unroll
    for (int i = 0; i < 8; ++i) v[i] = *(const f32x4*)(p + (size_t)(8 * i) * it.ldw);
}
__device__ __forceinline__ void tr_finish(const TrItem& it, f32x4 (&v)[8], LAS float* scr, int lane) {
    PIN8(v);
#pragma unroll
    for (int i = 0; i < 8; ++i) { LAS float* d = scr + (8 * i + (lane >> 3)) * 33 + 4 * (lane & 7); d[0] = v[i].x; d[1] = v[i].y; d[2] = v[i].z; d[3] = v[i].w; }
    LDS_WAIT(); asm volatile("" ::: "memory");
    const int c = lane & 7;
#pragma unroll
    for (int j = 0; j < 4; ++j) { const int n = (lane >> 3) + 8 * j; const LAS float* s = scr + (8 * c) * 33 + n;
        v4u o; o.x = pk2(s[0 * 33], s[1 * 33]); o.y = pk2(s[2 * 33], s[3 * 33]); o.z = pk2(s[4 * 33], s[5 * 33]); o.w = pk2(s[6 * 33], s[7 * 33]);
        *(v4u*)(it.dst + (size_t)n * it.ldd + it.k0 + 8 * c) = o; }
    LDS_WAIT(); asm volatile("" ::: "memory");
}
__device__ __forceinline__ void transpose_item_fp8(const float* W, int ldw, int k0, int n0, unsigned char* dst8, LAS float* scr, int lane) {
    const TrItem it{W, ldw, k0, n0, nullptr, 0}; f32x4 v[8]; tr_load(it, v, lane);
    PIN8(v);
#pragma unroll
    for (int i = 0; i < 8; ++i) { LAS float* d = scr + (8 * i + (lane >> 3)) * 33 + 4 * (lane & 7); d[0] = v[i].x; d[1] = v[i].y; d[2] = v[i].z; d[3] = v[i].w; }
    LDS_WAIT(); asm volatile("" ::: "memory");
    const int c = lane & 7;
#pragma unroll
    for (int j = 0; j < 4; ++j) { const int n = (lane >> 3) + 8 * j; const LAS float* s = scr + (8 * c) * 33 + n;
        *(v2u*)(dst8 + (size_t)n * 1024 + k0 + 8 * c) = (v2u){pk4_fp8(64.f * s[0 * 33], 64.f * s[1 * 33], 64.f * s[2 * 33], 64.f * s[3 * 33]), pk4_fp8(64.f * s[4 * 33], 64.f * s[5 * 33], 64.f * s[6 * 33], 64.f * s[7 * 33])}; }
    LDS_WAIT(); asm volatile("" ::: "memory");
}
__device__ __forceinline__ void transpose_item(const float* W, int ldw, int k0, int n0, bf16* dst, int ldd, LAS float* scr, int lane) {
    const TrItem it{W, ldw, k0, n0, dst, ldd}; f32x4 v[8]; tr_load(it, v, lane); tr_finish(it, v, scr, lane);
}
__device__ __forceinline__ void p0_prologue(const Frame& F0, const Args& args) {
    const Frame F = fresh(F0);
    const int tid = F.tid, lane = F.lane, wave = F.wave;
    float* MOD = WSP(float, WS_MOD);
    {
        LAS f32x4* cact4 = (LAS f32x4*)(F.lds + RING_OFF);
        LAS float* red = (LAS float*)(F.lds + RING_OFF + 16384);
        if (F.vcu < 192) {
            const float* c = INP(1);
#pragma unroll
            for (int i = 0; i < 8; ++i) { const int idx = tid + 512 * i, b = idx >> 10, k = idx & 1023; const float v = c[b * 1024 + k]; ((LAS float*)cact4)[k * 4 + b] = v * sigmoidf(v); }
        }
        __syncthreads();
        for (int u = F.vcu; u < 192; u += F.G) {
            const int l = u / 96, j0 = (u % 96) * 64;
            const float* aw = INP(2) + (size_t)l * 1024 * 6144 + j0 + lane;
            float a0 = 0.f, a1 = 0.f, a2 = 0.f, a3 = 0.f;
#pragma unroll 32
            for (int kk = 0; kk < 128; ++kk) { const int k = 128 * wave + kk; const float wv = aw[(size_t)k * 6144]; const f32x4 c4 = cact4[k]; a0 += c4.x * wv; a1 += c4.y * wv; a2 += c4.z * wv; a3 += c4.w * wv; }
            red[(wave * 4 + 0) * 64 + lane] = a0; red[(wave * 4 + 1) * 64 + lane] = a1; red[(wave * 4 + 2) * 64 + lane] = a2; red[(wave * 4 + 3) * 64 + lane] = a3;
            __syncthreads();
            if (tid < 256) { const int b = tid >> 6, ln = tid & 63; float s = INP(3)[l * 6144 + j0 + ln];
#pragma unroll
                for (int w = 0; w < 8; ++w) s += red[(w * 4 + b) * 64 + ln];
                MOD[(size_t)(l * 4 + b) * 6144 + j0 + ln] = s; }
            __syncthreads();
        }
    }
    {
        LAS float* Tt = (LAS float*)(F.lds + RING_OFF);
        LAS float* cs = (LAS float*)(F.lds + RING_OFF + 33792);
        LAS float* sn = cs + 128;
        if (tid < 128) { cs[tid] = cospif((float)tid * (1.0f / 64.0f)); sn[tid] = sinpif((float)tid * (1.0f / 64.0f)); }
        for (int it = F.G - 1 - F.vcu; it < 256; it += F.G) {
            const int l = it >> 7, g = (it >> 5) & 3, k0 = (it & 31) * 32;
            const float* src = INP(6) + (size_t)l * 1024 * 3072 + 2560 + g * 128;
            __syncthreads();
            { float tv[8];
#pragma unroll
                for (int i = 0; i < 8; ++i) { const int idx = tid + 512 * i, row = idx >> 7, cc = idx & 127; tv[i] = src[(size_t)(k0 + row) * 3072 + cc]; }
                PIN8(tv);
#pragma unroll
                for (int i = 0; i < 8; ++i) { const int idx = tid + 512 * i, row = idx >> 7, cc = idx & 127; Tt[row * 129 + cc] = tv[i]; } }
            __syncthreads();
            const int kk = tid & 31, og = tid >> 5, part = og >> 3, m0 = (og & 7) * 8;
            float acc[8]; float ny = 0.f;
#pragma unroll
            for (int i = 0; i < 8; ++i) acc[i] = 0.f;
            const LAS float* tab = part ? sn : cs;
#pragma unroll 2
            for (int cc = 0; cc < 128; ++cc) { const float t = Tt[kk * 129 + cc]; ny += (cc & 1) ? -t : t;
#pragma unroll
                for (int i = 0; i < 8; ++i) acc[i] += t * tab[((m0 + i) * cc) & 127]; }
            bf16* dst = WSP(bf16, WS_WP2) + (size_t)l * NP2 * 1024 + (size_t)(2560 + part * 256 + g * 64 + m0) * 1024 + k0 + kk;
            const float sg = part ? -1.f : 1.f;
#pragma unroll
            for (int i = 0; i < 8; ++i) dst[(size_t)i * 1024] = (bf16)f2bf((i == 0 && part == 1 && m0 == 0) ? ny : sg * acc[i]);
        }
        __syncthreads();
    }
    {
        LAS float* scr = (LAS float*)(F.lds + RING_OFF + wave * 8704);
        const int gw = F.vcu * NWAVES + wave, NGW = F.G * NWAVES;
        for (int it = gw; it < 8192; it += NGW) {
            const int l = it >> 12; int r = it & 4095;
            if (r < 1280) { const int kb = r / 80, nb = r % 80; transpose_item(INP(6) + (size_t)l * 1024 * 3072, 3072, kb * 64, nb * 32, WSP(bf16, WS_WP2) + (size_t)l * NP2 * 1024 + (size_t)(nb * 32) * 1024, 1024, scr, lane); continue; }
            r -= 1280;
            if (r < 1536) { const int kb = r / 96, nb = r % 96; transpose_item_fp8(INP(7) + (size_t)l * 1024 * 3072, 3072, kb * 64, nb * 32, (unsigned char*)(WSP(bf16, WS_WP2) + (size_t)l * NP2 * 1024 + (size_t)3072 * 1024) + (size_t)(nb * 32) * 1024, scr, lane); continue; }
            r -= 1536;
            if (r < 768) { const int which = r >> 8, rr = r & 255, kb = rr >> 5, nb = rr & 31; const float* src = (which == 0 ? INP(17) : (which == 1 ? INP(18) : INP(19))) + (size_t)l * 512 * 1024;
                transpose_item(src, 1024, kb * 64, nb * 32, WSP(bf16, WS_WPROJ) + (size_t)(l * 3 + which) * 1024 * 512 + (size_t)(nb * 32) * 512, 512, scr, lane); continue; }
            r -= 768;
            { const int kb = r >> 5, nb = r & 31; transpose_item(INP(20) + (size_t)l * 1024 * 1024, 1024, kb * 64, nb * 32, WSP(bf16, WS_WOUT) + (size_t)l * 1024 * 1024 + (size_t)(nb * 32) * 1024, 1024, scr, lane); }
        }
    }
    {
        const int gt = F.vcu * 512 + tid, NGT = F.G * 512;
        bf16* WL = WSP(bf16, WS_WL);
        for (int idx = gt; idx < 262144; idx += NGT) {
            const int k = idx & 63, n = (idx >> 6) & 255, nb = (idx >> 14) & 7, l = idx >> 17, gate = n >> 6, j = n & 63, dir = gate >> 1, isI = gate & 1;
            const float* src = isI ? INP(14) : INP(12);
            WL[idx] = (bf16)f2bf(src[((size_t)((l * 2 + dir) * 8 + nb) * 64 + k) * 64 + j]);
        }
        bf16* FA = WSP(bf16, WS_FA);
        for (int idx = gt; idx < 16384; idx += NGT) {
            const int m = idx >> 7, k = idx & 127, k1 = m & 63, pm_ = m >> 6, t1 = k & 63, pk = k >> 6, a = (k1 * t1) & 63;
            const float c = cospif((float)a * (1.0f / 32.0f)), s = sinpif((float)a * (1.0f / 32.0f));
            FA[idx] = (bf16)f2bf(pm_ == 0 ? (pk == 0 ? c : s) : (pk == 0 ? -s : c));
        }
        bf16* FB = WSP(bf16, WS_FB);
        for (int idx = gt; idx < 32768; idx += NGT) {
            const int k2 = idx >> 8, k = idx & 255, part = k >> 7, t2 = k & 127, a = (k2 * t2) & 127;
            FB[idx] = (bf16)f2bf(part == 0 ? cospif((float)a * (1.0f / 64.0f)) : sinpif((float)a * (1.0f / 64.0f)));
        }
        f32x2* TW = WSP(f32x2, WS_TW);
        for (int idx = gt; idx < 8192; idx += NGT) {
            const int t2 = idx >> 6, k1 = idx & 63; const float x = (float)(t2 * k1) * (1.0f / 4096.0f);
            TW[idx] = (f32x2){cospif(x), sinpif(x)};
        }
    }
}

__device__ __forceinline__ void moe_tilebase(const Frame& F0, const Args& args, int l);
template <int MODE>
__device__ __forceinline__ void rows_phase(const Frame& F0, const Args& args, int l) {
    const Frame F = fresh(F0);
    const int tid = F.tid, lane = F.lane, wave = F.wave;
    const float* MOD = WSP(float, WS_MOD);
    LAS float* gsc = (LAS float*)(F.lds + RING_OFF);
    LAS float* shf = gsc + 4096;
    LAS float* gtf = shf + 4096;
    if (MODE != 0) moe_tilebase(F, args, l - 1);
    { float tg[8], ts[8], tf[8];
#pragma unroll
        for (int i = 0; i < 8; ++i) { const int idx = tid + 512 * i, b = idx >> 10, col = idx & 1023; tg[i] = 0.f; ts[i] = 0.f; tf[i] = 0.f;
            if (MODE != 2) { tg[i] = INP(4)[l * 1024 + col] * (1.0f + MOD[(size_t)(l * 4 + b) * 6144 + 1024 + col]); ts[i] = MOD[(size_t)(l * 4 + b) * 6144 + col]; }
            else tg[i] = INP(26)[col];
            if (MODE != 0) tf[i] = MOD[(size_t)((l - 1) * 4 + b) * 6144 + 5 * 1024 + col]; }
        PIN8(tg); PIN8(ts); PIN8(tf);
#pragma unroll
        for (int i = 0; i < 8; ++i) { const int idx = tid + 512 * i; gsc[idx] = tg[i]; if (MODE != 2) shf[idx] = ts[i]; if (MODE != 0) gtf[idx] = tf[i]; } }
    __syncthreads();
    bf16* U = WSP(bf16, WS_U);
    const bf16* YE = WSP(bf16, WS_PROJ);
    const int* tokes = WSP(int, WS_TOKROW); const float* tokw = WSP(float, WS_TOKW);
    const int gw = F.vcu * NWAVES + wave, NGW = F.G * NWAVES;
    for (int m0 = gw; m0 < NTOK; m0 += 2 * NGW) {
        f32x4 v[2][4]; v2u ya[2][4], yc[2][4]; float w0[2], w1[2];
#pragma unroll
        for (int q = 0; q < 2; ++q) { const int m = m0 + q * NGW;
            if (MODE == 0) { const f32x4* xr = (const f32x4*)(INP(0) + (size_t)m * D) + lane;
#pragma unroll
                for (int j = 0; j < 4; ++j) v[q][j] = xr[64 * j]; }
            else { const v2u* xr = (const v2u*)XBROW(m) + lane;
#pragma unroll
                for (int j = 0; j < 4; ++j) { const v2u t = xr[64 * j]; v[q][j] = (f32x4){bflo(t.x), bfhi(t.x), bflo(t.y), bfhi(t.y)}; } }
            if (MODE != 0) { const int es0 = tokes[2 * m], es1 = tokes[2 * m + 1]; const int r0 = 256 * (int)F.MISC[16 + (es0 >> 16)] + (es0 & 0xffff), r1 = 256 * (int)F.MISC[16 + (es1 >> 16)] + (es1 & 0xffff); w0[q] = tokw[2 * m]; w1[q] = tokw[2 * m + 1];
                const v2u* y0 = (const v2u*)(YE + (size_t)r0 * 1024) + lane; const v2u* y1 = (const v2u*)(YE + (size_t)r1 * 1024) + lane;
#pragma unroll
                for (int j = 0; j < 4; ++j) { ya[q][j] = y0[64 * j]; yc[q][j] = y1[64 * j]; } } }
#pragma unroll
        for (int q = 0; q < 2; ++q) { const int m = m0 + q * NGW, b = m >> 13;
            if (MODE != 0) {
#pragma unroll
                for (int j = 0; j < 4; ++j) { const v2u a = ya[q][j], c = yc[q][j]; const f32x4 g = *(const LAS f32x4*)(gtf + b * 1024 + 4 * lane + 256 * j);
                    v[q][j].x += g.x * (w0[q] * bflo(a.x) + w1[q] * bflo(c.x)); v[q][j].y += g.y * (w0[q] * bfhi(a.x) + w1[q] * bfhi(c.x));
                    v[q][j].z += g.z * (w0[q] * bflo(a.y) + w1[q] * bflo(c.y)); v[q][j].w += g.w * (w0[q] * bfhi(a.y) + w1[q] * bfhi(c.y)); }
            }
            float ss = 0.f;
#pragma unroll
            for (int j = 0; j < 4; ++j) ss += (v[q][j].x * v[q][j].x + v[q][j].y * v[q][j].y) + (v[q][j].z * v[q][j].z + v[q][j].w * v[q][j].w);
            const float rstd = 1.0f / sqrtf(wave_sum(ss) * (1.0f / D) + EPS);
            if (MODE == 2) {
                f32x4* o = (f32x4*)(args.out + (size_t)m * D) + lane;
#pragma unroll
                for (int j = 0; j < 4; ++j) { const f32x4 g = *(const LAS f32x4*)(gsc + 4 * lane + 256 * j); o[64 * j] = v[q][j] * rstd * g; }
            } else {
                if (MODE == 1) { v2u* o = (v2u*)XBROW(m) + lane;
#pragma unroll
                    for (int j = 0; j < 4; ++j) o[64 * j] = (v2u){pk2(v[q][j].x, v[q][j].y), pk2(v[q][j].z, v[q][j].w)}; }
                v2u* uo = (v2u*)(U + (size_t)m * D) + lane; unsigned* u8o = (unsigned*)(args.ws + WS_U8 + (size_t)m * D) + lane;
#pragma unroll
                for (int j = 0; j < 4; ++j) { const f32x4 g = *(const LAS f32x4*)(gsc + b * 1024 + 4 * lane + 256 * j), s = *(const LAS f32x4*)(shf + b * 1024 + 4 * lane + 256 * j);
                    const f32x4 u = v[q][j] * rstd * g + s; uo[64 * j] = (v2u){pk2(u.x, u.y), pk2(u.z, u.w)}; u8o[64 * j] = pk4_fp8(u.x, u.y, u.z, u.w); }
            }
        }
    }
}

#define P2ST(ptr, val) do { const v4u v__ = (val); if (nostore) { if (win) *(v4u*)(win + ((size_t)(ptr) & 0x1FFF0)) = v__; else asm volatile("" :: "v"(v__)); } else *(v4u*)(ptr) = v__; } while (0)
struct EpiP2 {
    bool skip = false; bool nostore = false; char* win = nullptr;
    static constexpr bool PERM = true;
    bf16* proj; bf16* vt;
    __device__ __forceinline__ void operator()(const f32x4 (&acc)[2][2][4][2], const pg8::Unit& u, int wr, int wc, int fr, int fq) const {
        const int row0 = u.pm * 256 + wr * 64 + fr, pn = u.pn;
        if (pn == 4 || pn == 5) {
#pragma unroll
            for (int ai = 0; ai < 2; ++ai)
#pragma unroll
                for (int m = 0; m < 4; ++m) { const int row = row0 + ai * 128 + m * 16, b = row >> 13, t = row & 8191;
#pragma unroll
                    for (int bj = 0; bj < 2; ++bj)
#pragma unroll
                        for (int n = 0; n < 2; ++n) { const int col = (pn - 4) * 256 + bj * 128 + wc * 32 + 8 * fq + 4 * n; bf16* d = vt + ((size_t)(b * 512 + col)) * 8192 + t;
                            d[0] = (bf16)f2bf(acc[ai][bj][m][n][0]); d[8192] = (bf16)f2bf(acc[ai][bj][m][n][1]); d[2 * 8192] = (bf16)f2bf(acc[ai][bj][m][n][2]); d[3 * 8192] = (bf16)f2bf(acc[ai][bj][m][n][3]); } }
        } else {
            const int cbase = (pn < 4 ? pn * 256 : (pn - 2) * 256) + wc * 32 + 8 * fq; const float sc = pn < 2 ? 0.125f : 1.0f;
#pragma unroll
            for (int ai = 0; ai < 2; ++ai)
#pragma unroll
                for (int m = 0; m < 4; ++m) { bf16* rowp = proj + (size_t)(row0 + ai * 128 + m * 16) * PROJ_LD + cbase;
#pragma unroll
                    for (int bj = 0; bj < 2; ++bj) { const f32x4 v0 = acc[ai][bj][m][0] * sc, v1 = acc[ai][bj][m][1] * sc;
                        P2ST(rowp + bj * 128, ((v4u){pk2(v0[0], v0[1]), pk2(v0[2], v0[3]), pk2(v1[0], v1[1]), pk2(v1[2], v1[3])})); } }
        }
    }
};
struct EpiGates {
    bool skip = false;
    static constexpr bool PERM = true;
    bf16* gates; const float* gbias;
    __device__ __forceinline__ void operator()(const f32x4 (&acc)[2][2][4][2], const pg8::Unit& u, int wr, int wc, int fr, int fq) const {
        {
            const int pn = u.pn;
            int fr_ = fr, fq_ = fq; asm volatile("" : "+v"(fr_), "+v"(fq_));
            const int cbase = pn * 256 + wc * 32 + 8 * fq_;
            f32x4 bv[2][2];
#pragma unroll
            for (int bj = 0; bj < 2; ++bj)
#pragma unroll
                for (int n = 0; n < 2; ++n) bv[bj][n] = *(const f32x4*)(gbias + cbase + bj * 128 + 4 * n) * (-1.4426950408889634f);
            const unsigned to8 = (unsigned)(((wr * 4 + wc) * 64 + fq_ * 16 + fr_) * 8);
            unsigned char* blob = (unsigned char*)gates + (size_t)(u.pm * 12 + pn) * 65536 + to8;
#pragma unroll
            for (int ai = 0; ai < 2; ++ai)
#pragma unroll
                for (int m = 0; m < 4; ++m)
#pragma unroll
                    for (int bj = 0; bj < 2; ++bj) {
                        unsigned w0 = 0u, w1 = 0u;
#pragma unroll
                        for (int e = 0; e < 4; ++e) {
                            const float t0 = __builtin_fmaf(acc[ai][bj][m][0][e], -1.4426950408889634f / 64.0f, bv[bj][0][e]), t1 = __builtin_fmaf(acc[ai][bj][m][1][e], -1.4426950408889634f / 64.0f, bv[bj][1][e]);
                            const float s0 = __builtin_amdgcn_rcpf(__builtin_fmaf(__builtin_amdgcn_exp2f(t0), 1.0f / 255.0f, 1.0f / 255.0f)), s1 = __builtin_amdgcn_rcpf(__builtin_fmaf(__builtin_amdgcn_exp2f(t1), 1.0f / 255.0f, 1.0f / 255.0f));
                            w0 = __builtin_amdgcn_cvt_pk_u8_f32(s0, e, w0); w1 = __builtin_amdgcn_cvt_pk_u8_f32(s1, e, w1); }
                        const v2u w = (v2u){w0, w1};
                        *(v2u*)(blob + ((ai * 4 + m) * 2 + bj) * 4096) = w; }
        }
    }
};
struct EpiMerge {
    bool skip = false;
    static constexpr bool PERM = true;
    const bf16* gates; bf16* merged; bf16* scratch;
    __device__ __forceinline__ void operator()(const f32x4 (&acc)[2][2][4][2], const pg8::Unit& u, int wr, int wc, int fr, int fq) const {
        const int row0 = u.pm * 256 + wr * 64 + fr, cbase = u.pn * 256 + wc * 32 + 8 * fq, z = u.z, tid = (wr * 4 + wc) * 64 + fq * 16 + fr;
        const char* gblob = (const char*)gates + (size_t)(u.pm * 12 + z * 4 + u.pn) * 65536 + tid * 8; char* sblob = (char*)(scratch + tid * 8);
        const bool addp = z > 0, fin = z == 2; const float k255 = 1.0f / 255.0f;
#pragma unroll
        for (int hb4 = 0; hb4 < 4; ++hb4) {
            v2u gv[4]; v4u ov[4]; unsigned pcb = hb4 * 4 * 8192; asm volatile("" : "+v"(pcb));
#pragma unroll
            for (int p = 0; p < 4; ++p) { const unsigned pc = pcb + p * 8192; gv[p] = *(const v2u*)(gblob + (pc >> 1)); ov[p] = *(const v4u*)(sblob + pc); }
#pragma unroll
            for (int p = 0; p < 4; ++p) { const int pi = hb4 * 4 + p, ai = pi >> 3, m = (pi >> 1) & 3, bj = pi & 1; const unsigned pc = pcb + p * 8192; const size_t row = (size_t)(row0 + ai * 128 + m * 16);
                f32x4 v0 = acc[ai][bj][m][0], v1 = acc[ai][bj][m][1]; const v2u g = gv[p]; const v4u o = ov[p];
                v0[0] *= (float)(g.x & 0xffu) * k255; v0[1] *= (float)((g.x >> 8) & 0xffu) * k255; v0[2] *= (float)((g.x >> 16) & 0xffu) * k255; v0[3] *= (float)(g.x >> 24) * k255;
                v1[0] *= (float)(g.y & 0xffu) * k255; v1[1] *= (float)((g.y >> 8) & 0xffu) * k255; v1[2] *= (float)((g.y >> 16) & 0xffu) * k255; v1[3] *= (float)(g.y >> 24) * k255;
                v0[0] += addp ? bflo(o.x) : 0.f; v0[1] += addp ? bfhi(o.x) : 0.f; v0[2] += addp ? bflo(o.y) : 0.f; v0[3] += addp ? bfhi(o.y) : 0.f;
                v1[0] += addp ? bflo(o.z) : 0.f; v1[1] += addp ? bfhi(o.z) : 0.f; v1[2] += addp ? bflo(o.w) : 0.f; v1[3] += addp ? bfhi(o.w) : 0.f;
                char* dst = fin ? (char*)(merged + row * 1024 + cbase + bj * 128) : sblob + pc;
                *(v4u*)dst = (v4u){pk2(v0[0], v0[1]), pk2(v0[2], v0[3]), pk2(v1[0], v1[1]), pk2(v1[2], v1[3])}; }
            asm volatile("" ::: "memory");
        }
    }
};
template <bool F32IN>
struct EpiResid {
    bool skip = false;
    static constexpr bool PERM = true;
    const float* xin32; bf16* xb0; bf16* xb1; const float* gt;
    __device__ __forceinline__ void operator()(const f32x4 (&acc)[2][2][4][2], const pg8::Unit& u, int wr, int wc, int fr, int fq) const {
        const int rt = u.pm * 256, row0 = rt + wr * 64 + fr, cbase = u.pn * 256 + wc * 32 + 8 * fq, b = rt >> 13;
        bf16* xb = (rt < XB_SPLIT) ? xb0 + (size_t)row0 * 1024 : xb1 + (size_t)(row0 - XB_SPLIT) * 1024;
        const float* xf = xin32 + (size_t)row0 * 1024;
        f32x4 gv[2][2];
#pragma unroll
        for (int bj = 0; bj < 2; ++bj)
#pragma unroll
            for (int n = 0; n < 2; ++n) gv[bj][n] = *(const f32x4*)(gt + (size_t)b * 6144 + cbase + bj * 128 + 4 * n);
#pragma unroll
        for (int hb4 = 0; hb4 < 4; ++hb4) {
            unsigned rob = (unsigned)((hb4 >> 1) * 128 + (hb4 & 1) * 32) * 1024u + (unsigned)cbase; asm volatile("" : "+v"(rob));
            f32x4 x0[4], x1[4];
#pragma unroll
            for (int p = 0; p < 4; ++p) { const unsigned ro = rob + (unsigned)((p >> 1) * 16 * 1024 + (p & 1) * 128);
                if (F32IN) { x0[p] = *(const f32x4*)(xf + ro); x1[p] = *(const f32x4*)(xf + ro + 4); }
                else { const v4u t = *(const v4u*)(xb + ro); x0[p] = (f32x4){bflo(t.x), bfhi(t.x), bflo(t.y), bfhi(t.y)}; x1[p] = (f32x4){bflo(t.z), bfhi(t.z), bflo(t.w), bfhi(t.w)}; } }
#pragma unroll
            for (int p = 0; p < 4; ++p) { const int ai = hb4 >> 1, m = (hb4 & 1) * 2 + (p >> 1), bj = p & 1; const unsigned ro = rob + (unsigned)((p >> 1) * 16 * 1024 + (p & 1) * 128);
                const f32x4 y0 = x0[p] + gv[bj][0] * acc[ai][bj][m][0], y1 = x1[p] + gv[bj][1] * acc[ai][bj][m][1];
                *(v4u*)(xb + ro) = (v4u){pk2(y0[0], y0[1]), pk2(y0[2], y0[3]), pk2(y1[0], y1[1]), pk2(y1[2], y1[3])}; }
            asm volatile("" ::: "memory");
        }
    }
};
struct EpiSwiGLU {
    bool skip = false;
    static constexpr bool PERM = true;
    bf16* H;
    __device__ __forceinline__ void operator()(const f32x4 (&acc)[2][2][4][2], const pg8::Unit& u, int wr, int wc, int fr, int fq) const {
        const int row0 = u.pm * 256 + wr * 64 + fr, cbase = u.pn * 128 + wc * 32 + 8 * fq;
#pragma unroll
        for (int ai = 0; ai < 2; ++ai)
#pragma unroll
            for (int m = 0; m < 4; ++m) { f32x4 h0, h1;
#pragma unroll
                for (int e = 0; e < 4; ++e) { const float g0 = acc[ai][0][m][0][e], g1 = acc[ai][0][m][1][e]; h0[e] = g0 * sigmoidf(g0) * acc[ai][1][m][0][e]; h1[e] = g1 * sigmoidf(g1) * acc[ai][1][m][1][e]; }
                *(v4u*)(H + (size_t)(row0 + ai * 128 + m * 16) * 512 + cbase) = (v4u){pk2(h0[0], h0[1]), pk2(h0[2], h0[3]), pk2(h1[0], h1[1]), pk2(h1[2], h1[3])}; }
    }
};
struct EpiYE {
    bool skip = false;
    static constexpr bool PERM = true;
    bf16* YE;
    __device__ __forceinline__ void operator()(const f32x4 (&acc)[2][2][4][2], const pg8::Unit& u, int wr, int wc, int fr, int fq) const {
        const int row0 = u.pm * 256 + wr * 64 + fr, cbase = u.pn * 256 + wc * 32 + 8 * fq;
#pragma unroll
        for (int ai = 0; ai < 2; ++ai)
#pragma unroll
            for (int m = 0; m < 4; ++m) { bf16* rowp = YE + (size_t)(row0 + ai * 128 + m * 16) * 1024 + cbase;
#pragma unroll
                for (int bj = 0; bj < 2; ++bj) { const f32x4 v0 = acc[ai][bj][m][0], v1 = acc[ai][bj][m][1];
                    *(v4u*)(rowp + bj * 128) = (v4u){pk2(v0[0], v0[1]), pk2(v0[2], v0[3]), pk2(v1[0], v1[1]), pk2(v1[2], v1[3])}; } }
    }
};

__device__ __forceinline__ void attn_unit(bf16* PROJ, const bf16* VT, const LAS float* rpb, int b, int h, int r, int qb, int lane, bf16* obase, int opitch) {
    const int qn = lane & 15, g = lane >> 4;
    const int rs = min(max(r - 4, 0), 120);
    const int cb = (qb == 0) ? 0 : ((qb == 1) ? 8 : ((qb == 2) ? 24 : 32));
    const int w = 16 * qb + qn, cs = min(max(w - 8, 0), 48);
    const size_t tokq = (size_t)b * T + r * 64 + w;
    bf16* qp = PROJ + tokq * PROJ_LD + Q_OFF + h * 64;
    bf16x8 qf0 = *(const bf16x8*)(qp + 8 * g), qf1 = *(const bf16x8*)(qp + 32 + 8 * g);
    const bf16* kbase = PROJ + ((size_t)b * T + rs * 64 + cb + qn) * PROJ_LD + K_OFF + h * 64 + 8 * g;
    f32x4 sc[16];
#pragma unroll
    for (int kt = 0; kt < 16; ++kt) {
        const int kr = kt >> 1, ch = kt & 1;
        const bf16* kp = kbase + (size_t)(kr * 64 + 16 * ch) * PROJ_LD;
        const bf16x8 kf0 = *(const bf16x8*)kp, kf1 = *(const bf16x8*)(kp + 32);
        f32x4 a = (f32x4){0.f, 0.f, 0.f, 0.f};
        a = __builtin_amdgcn_mfma_f32_16x16x32_bf16(kf0, qf0, a, 0, 0, 0);
        a = __builtin_amdgcn_mfma_f32_16x16x32_bf16(kf1, qf1, a, 0, 0, 0);
        sc[kt] = a;
    }
    const LAS float* rp = rpb + h * 465;
    float mx = -1e30f;
#pragma unroll
    for (int kt = 0; kt < 16; ++kt) {
        const int kr = kt >> 1, ch = kt & 1;
        const int brow = (rs + kr - r + 7) * 31;
#pragma unroll
        for (int j = 0; j < 4; ++j) {
            const int kc = cb + 16 * ch + 4 * g + j, dc = kc - w + 15;
            const bool ok = (kc >= cs) && (kc <= cs + 15);
            const float bias = rp[brow + (ok ? dc : 15)];
            const float s = ok ? sc[kt][j] + bias : -1e30f;
            sc[kt][j] = s; mx = fmaxf(mx, s);
        }
    }
    mx = fmaxf(mx, __shfl_xor(mx, 16)); mx = fmaxf(mx, __shfl_xor(mx, 32));
    float sum = 0.f;
#pragma unroll
    for (int kt = 0; kt < 16; ++kt)
#pragma unroll
        for (int j = 0; j < 4; ++j) { const float p = __expf(sc[kt][j] - mx); sc[kt][j] = p; sum += p; }
    sum += __shfl_xor(sum, 16); sum += __shfl_xor(sum, 32);
    const float inv = 1.0f / sum;
    f32x4 o[4];
#pragma unroll
    for (int dt = 0; dt < 4; ++dt) o[dt] = (f32x4){0.f, 0.f, 0.f, 0.f};
    const bf16* vbase = VT + ((size_t)(b * 512 + h * 64 + qn)) * T + rs * 64 + cb + 4 * g;
#pragma unroll
    for (int kr = 0; kr < 8; ++kr) {
        v4u pw; pw.x = pk2(sc[2 * kr][0], sc[2 * kr][1]); pw.y = pk2(sc[2 * kr][2], sc[2 * kr][3]); pw.z = pk2(sc[2 * kr + 1][0], sc[2 * kr + 1][1]); pw.w = pk2(sc[2 * kr + 1][2], sc[2 * kr + 1][3]);
        const bf16x8 pf = __builtin_bit_cast(bf16x8, pw);
#pragma unroll
        for (int dt = 0; dt < 4; ++dt) {
            const bf16* vp = vbase + (size_t)(16 * dt) * T + kr * 64;
            const v2u lo = *(const v2u*)vp, hi = *(const v2u*)(vp + 16);
            const v4u vw = (v4u){lo.x, lo.y, hi.x, hi.y};
            o[dt] = __builtin_amdgcn_mfma_f32_16x16x32_bf16(__builtin_bit_cast(bf16x8, vw), pf, o[dt], 0, 0, 0);
        }
    }
    bf16* op = obase + tokq * opitch + h * 64;
#pragma unroll
    for (int dt = 0; dt < 4; ++dt) *(v2u*)(op + 16 * dt + 4 * g) = (v2u){pk2(o[dt][0] * inv, o[dt][1] * inv), pk2(o[dt][2] * inv, o[dt][3] * inv)};
}
__device__ __forceinline__ void attn_phase(const Frame& F0, const Args& args, int l, bf16* obase, int opitch) {
    const Frame F = fresh(F0);
    LAS float* rpb = (LAS float*)(F.lds + RING_OFF);
    for (int i = F.tid; i < 8 * 465; i += 512) rpb[i] = INP(9)[l * 8 * 465 + i];
    __syncthreads();
    bf16* PROJ = WSP(bf16, WS_PROJ); const bf16* VT = WSP(bf16, WS_VT);
    for (int wu = F.vcu * NWAVES + F.wave; wu < 16384; wu += F.G * NWAVES) {
        const int bh = wu >> 9, rem = wu & 511;
        attn_unit(PROJ, VT, rpb, bh >> 3, bh & 7, rem >> 2, rem & 3, F.lane, obase, opitch);
    }
    __syncthreads();
}

__device__ __forceinline__ float gelu_tanh(float x) { const float u = 0.7978845608028654f * (x + 0.044715f * x * x * x); const float t = 1.0f - 2.0f * __builtin_amdgcn_rcpf(1.0f + __expf(2.0f * u)); return 0.5f * x * (1.0f + t); }
__device__ __forceinline__ void fft_a_phase(const Frame& F0, const Args& args) {
    const Frame F = fresh(F0);
    const int lane = F.lane, nl = lane & 31, hh = lane >> 5;
    const bf16* PROJ = WSP(bf16, WS_PROJ); const bf16* FA = WSP(bf16, WS_FA); const f32x2* TW = WSP(f32x2, WS_TW); bf16* ZP = WSP(bf16, WS_U);
    for (int wu = F.vcu * NWAVES + F.wave; wu < 8192; wu += F.G * NWAVES) {
        const int ct = wu & 15, t2 = (wu >> 4) & 127, b = wu >> 11;
        bf16x8 bf[8];
#pragma unroll
        for (int s = 0; s < 8; ++s) { const int part = s >> 2, t1b = 16 * (s & 3) + 8 * hh;
            const bf16* p = PROJ + ((size_t)b * T + (size_t)128 * t1b + t2) * PROJ_LD + G_OFF + part * 512 + 32 * ct + nl;
            unsigned short e[8];
#pragma unroll
            for (int j = 0; j < 8; ++j) e[j] = p[(size_t)j * 128 * PROJ_LD];
            v4u w; w.x = e[0] | ((unsigned)e[1] << 16); w.y = e[2] | ((unsigned)e[3] << 16); w.z = e[4] | ((unsigned)e[5] << 16); w.w = e[6] | ((unsigned)e[7] << 16);
            bf[s] = __builtin_bit_cast(bf16x8, w); }
        f32x16 acc[4];
#pragma unroll
        for (int mt = 0; mt < 4; ++mt) { acc[mt] = (f32x16){};
#pragma unroll
            for (int s = 0; s < 8; ++s) { const bf16x8 af = *(const bf16x8*)(FA + (32 * mt + nl) * 128 + 16 * s + 8 * hh); acc[mt] = __builtin_amdgcn_mfma_f32_32x32x16_bf16(af, bf[s], acc[mt], 0, 0, 0); } }
#pragma unroll
        for (int mt = 0; mt < 2; ++mt)
#pragma unroll
            for (int rg = 0; rg < 16; ++rg) { const int k1 = 32 * mt + (rg & 3) + 8 * (rg >> 2) + 4 * hh; const f32x2 cs = TW[t2 * 64 + k1];
                const float zr = acc[mt][rg], zi = acc[mt + 2][rg];
                bf16* d = ZP + ((size_t)(b * 64 + k1) * 128 + t2) * 1024 + 32 * ct + nl;
                d[0] = (bf16)f2bf(zr * cs.x + zi * cs.y); d[512] = (bf16)f2bf(zi * cs.x - zr * cs.y); }
    }
}
__device__ __forceinline__ void fft_b_phase(const Frame& F0, const Args& args) {
    const Frame F = fresh(F0);
    const int lane = F.lane, nl = lane & 31, hh = lane >> 5;
    bf16* PROJ = WSP(bf16, WS_PROJ); const bf16* FB = WSP(bf16, WS_FB); const bf16* ZP = WSP(bf16, WS_U);
    for (int wu = F.vcu * NWAVES + F.wave; wu < 4096; wu += F.G * NWAVES) {
        const int ct = wu & 15, k1 = (wu >> 4) & 63, b = wu >> 10;
        f32x16 acc[4];
#pragma unroll
        for (int mt = 0; mt < 4; ++mt) acc[mt] = (f32x16){};
#pragma unroll 1
        for (int sc = 0; sc < 4; ++sc) {
            bf16x8 bf[4];
#pragma unroll
            for (int q = 0; q < 4; ++q) { const int s = 4 * sc + q, part = s >> 3, t2b = 16 * (s & 7) + 8 * hh;
                const bf16* p = ZP + ((size_t)(b * 64 + k1) * 128 + t2b) * 1024 + part * 512 + 32 * ct + nl;
                unsigned short e[8];
#pragma unroll
                for (int j = 0; j < 8; ++j) e[j] = p[(size_t)j * 1024];
                v4u w; w.x = e[0] | ((unsigned)e[1] << 16); w.y = e[2] | ((unsigned)e[3] << 16); w.z = e[4] | ((unsigned)e[5] << 16); w.w = e[6] | ((unsigned)e[7] << 16);
                bf[q] = __builtin_bit_cast(bf16x8, w); }
#pragma unroll
            for (int mt = 0; mt < 4; ++mt)
#pragma unroll
                for (int q = 0; q < 4; ++q) { const bf16x8 af = *(const bf16x8*)(FB + (32 * mt + nl) * 256 + 16 * (4 * sc + q) + 8 * hh); acc[mt] = __builtin_amdgcn_mfma_f32_32x32x16_bf16(af, bf[q], acc[mt], 0, 0, 0); }
        }
#pragma unroll
        for (int mt = 0; mt < 4; ++mt)
#pragma unroll
            for (int rg = 0; rg < 16; ++rg) { const int k2 = 32 * mt + (rg & 3) + 8 * (rg >> 2) + 4 * hh;
                PROJ[((size_t)b * T + k1 + 64 * k2) * PROJ_LD + G_OFF + 32 * ct + nl] = (bf16)f2bf(acc[mt][rg] * (1.0f / 1024.0f)); }
    }
}

__device__ __forceinline__ void router_phase(const Frame& F0, const Args& args, int l, int cset) {
    const Frame F = fresh(F0);
    const int tid = F.tid, lane = F.lane, wave = F.wave;
    const float* MOD = WSP(float, WS_MOD);
    LAS unsigned char* WB = F.lds + RING_OFF;
    constexpr int RPITCH = 2064;
    LAS float* gsc = (LAS float*)(F.lds + RING_OFF + 64 * RPITCH);
    LAS float* shf = gsc + 1024;
    LAS float* c0 = shf + 1024;
    LAS float* rb = c0 + 32;
    LAS unsigned* lcnt = (LAS unsigned*)(rb + 32);
    LAS unsigned* lbase = lcnt + 32;
    LAS float* red = (LAS float*)(lbase + 32);
    bf16* U2 = WSP(bf16, WS_U);
    float* tokw = WSP(float, WS_TOKW); int* perm = WSP(int, WS_PERM); int* tokes = WSP(int, WS_TOKROW);
    unsigned* ecnt = (unsigned*)(F.ctl + CW_ECNT + cset * 32 * 64);
    const int nround = (2048 + F.G * NWAVES - 1) / (F.G * NWAVES);
    int cur_b = -1;
    for (int rd = 0; rd < nround; ++rd) {
        const int unit = (rd * F.G + F.vcu) * NWAVES + wave;
        const int ub = (((rd * F.G + F.vcu) * NWAVES) * 16) >> 13;
        const bool wg_active = ((rd * F.G + F.vcu) * NWAVES) < 2048;
        if (wg_active && ub != cur_b) {
            cur_b = ub; __syncthreads();
            for (int i = 0; i < 2; ++i) { const int col = tid + 512 * i; gsc[col] = INP(5)[l * 1024 + col] * (1.0f + MOD[(size_t)(l * 4 + ub) * 6144 + 4 * 1024 + col]); shf[col] = MOD[(size_t)(l * 4 + ub) * 6144 + 3 * 1024 + col]; }
            if (tid < 32) rb[tid] = INP(22)[tid];
            __syncthreads();
            { f32x4 wa[8], wb[8];
#pragma unroll
                for (int i = 0; i < 8; ++i) { const int it = tid + 512 * i, kp = it >> 3, e4 = it & 7; wa[i] = *(const f32x4*)(INP(21) + (2 * kp) * 32 + 4 * e4); wb[i] = *(const f32x4*)(INP(21) + (2 * kp + 1) * 32 + 4 * e4); }
                PIN8(wa); PIN8(wb);
#pragma unroll
                for (int i = 0; i < 8; ++i) { const int it = tid + 512 * i, kp = it >> 3, e4 = it & 7; const float g0 = gsc[2 * kp], g1 = gsc[2 * kp + 1];
#pragma unroll
                    for (int j = 0; j < 4; ++j) { const float p0 = g0 * wa[i][j], p1 = g1 * wb[i][j]; const unsigned h1 = pk2(p0, p1), h2 = pk2(p0 - bflo(h1), p1 - bfhi(h1));
                        LAS unsigned char* d = WB + (4 * e4 + j) * RPITCH + 4 * kp; *(LAS unsigned*)d = h1; *(LAS unsigned*)(d + 32 * RPITCH) = h2; } } }
            { const int e = tid & 31, pt = tid >> 5; float s = 0.f;
#pragma unroll 1
                for (int q4 = 0; q4 < 4; ++q4) { float wv[16];
#pragma unroll
                    for (int kk = 0; kk < 16; ++kk) wv[kk] = INP(21)[(pt * 64 + q4 * 16 + kk) * 32 + e];
#pragma unroll
                    for (int kk = 0; kk < 16; ++kk) s += shf[pt * 64 + q4 * 16 + kk] * wv[kk]; }
                red[tid] = s; }
            __syncthreads();
            if (tid < 32) { float s = 0.f; for (int p = 0; p < 16; ++p) s += red[p * 32 + tid]; c0[tid] = s; }
        }
        if (tid < 32) lcnt[tid] = 0u;
        __syncthreads();
        int e0 = 0, e1 = 0; unsigned rk0 = 0, rk1 = 0; float w0 = 0.f, w1 = 0.f; bool owner = false; int mytok = 0;
        if (unit < 2048) {
            const int tok0 = unit * 16;
            float rs_reg = 0.f;
#pragma unroll 1
            for (int i4 = 0; i4 < 16; i4 += 4) {
                f32x4 v[4][4];
#pragma unroll
                for (int q = 0; q < 4; ++q) { const v2u* xr = (const v2u*)XBROW(tok0 + i4 + q) + lane;
#pragma unroll
                    for (int j = 0; j < 4; ++j) { const v2u t = xr[64 * j]; v[q][j] = (f32x4){bflo(t.x), bfhi(t.x), bflo(t.y), bfhi(t.y)}; } }
#pragma unroll
                for (int q = 0; q < 4; ++q) { const int m = tok0 + i4 + q; float ss = 0.f;
#pragma unroll
                    for (int j = 0; j < 4; ++j) ss += (v[q][j].x * v[q][j].x + v[q][j].y * v[q][j].y) + (v[q][j].z * v[q][j].z + v[q][j].w * v[q][j].w);
                    const float rstd = 1.0f / sqrtf(wave_sum(ss) * (1.0f / D) + EPS);
                    if ((lane & 15) == i4 + q) rs_reg = rstd;
                    v2u* uo = (v2u*)(U2 + (size_t)m * D) + lane;
#pragma unroll
                    for (int j = 0; j < 4; ++j) { const f32x4 g = *(const LAS f32x4*)(gsc + 4 * lane + 256 * j), s = *(const LAS f32x4*)(shf + 4 * lane + 256 * j);
                        const f32x4 u = v[q][j] * rstd * g + s; uo[64 * j] = (v2u){pk2(u.x, u.y), pk2(u.z, u.w)}; } }
            }
            const int ti = lane & 15, kq = lane >> 4;
            const v4u* xrow = (const v4u*)(XBROW(tok0 + ti) + 256 * kq);
            const LAS unsigned char* wp = WB + ti * RPITCH + 512 * kq;
            f32x4 a0 = {0.f, 0.f, 0.f, 0.f}, a1 = {0.f, 0.f, 0.f, 0.f};
            v4u xall[32];
#pragma unroll
            for (int q = 0; q < 32; ++q) xall[q] = xrow[q];
#pragma unroll
            for (int q = 0; q < 32; ++q) { const bf16x8 bx = __builtin_bit_cast(bf16x8, xall[q]);
                const bf16x8 w00 = *(const LAS bf16x8*)(wp + 16 * q), w01 = *(const LAS bf16x8*)(wp + 16 * RPITCH + 16 * q), w10 = *(const LAS bf16x8*)(wp + 32 * RPITCH + 16 * q), w11 = *(const LAS bf16x8*)(wp + 48 * RPITCH + 16 * q);
                a0 = __builtin_amdgcn_mfma_f32_16x16x32_bf16(w00, bx, a0, 0, 0, 0); a1 = __builtin_amdgcn_mfma_f32_16x16x32_bf16(w01, bx, a1, 0, 0, 0);
                a0 = __builtin_amdgcn_mfma_f32_16x16x32_bf16(w10, bx, a0, 0, 0, 0); a1 = __builtin_amdgcn_mfma_f32_16x16x32_bf16(w11, bx, a1, 0, 0, 0);
                if ((q & 3) == 3) asm volatile("" ::: "memory"); }
            float sco[2][4], sel[2][4], gs[2];
#pragma unroll
            for (int nt = 0; nt < 2; ++nt) {
#pragma unroll
                for (int rg = 0; rg < 4; ++rg) { const int e = 16 * nt + 4 * kq + rg; const float lg = rs_reg * (nt ? a1[rg] : a0[rg]) + c0[e]; sco[nt][rg] = sigmoidf(lg); sel[nt][rg] = sco[nt][rg] + rb[e]; }
                float m1 = fmaxf(sel[nt][0], sel[nt][1]), m2 = fminf(sel[nt][0], sel[nt][1]);
                { const float v = sel[nt][2]; if (v > m1) { m2 = m1; m1 = v; } else if (v > m2) m2 = v; }
                { const float v = sel[nt][3]; if (v > m1) { m2 = m1; m1 = v; } else if (v > m2) m2 = v; }
                gs[nt] = m1 + m2; }
            float bv = gs[0]; int bg = kq; if (gs[1] > bv) { bv = gs[1]; bg = 4 + kq; }
#pragma unroll
            for (int o = 16; o < 64; o <<= 1) { const float ov = __shfl_xor(bv, o); const int og = __shfl_xor(bg, o); if (ov > bv || (ov == bv && og < bg)) { bv = ov; bg = og; } }
            owner = ((bg & 3) == kq); mytok = tok0 + ti;
            if (owner) { const int nt = bg >> 2; float cd[4], sv[4];
#pragma unroll
                for (int rg = 0; rg < 4; ++rg) { cd[rg] = nt ? sel[1][rg] : sel[0][rg]; sv[rg] = nt ? sco[1][rg] : sco[0][rg]; }
                int i1 = 0; float v1 = cd[0];
#pragma unroll
                for (int rg = 1; rg < 4; ++rg) if (cd[rg] > v1) { v1 = cd[rg]; i1 = rg; }
                int i2 = -1; float v2 = -1e30f;
#pragma unroll
                for (int rg = 0; rg < 4; ++rg) if (rg != i1 && cd[rg] > v2) { v2 = cd[rg]; i2 = rg; }
                const float s1 = (i1 == 0 ? sv[0] : (i1 == 1 ? sv[1] : (i1 == 2 ? sv[2] : sv[3]))), s2 = (i2 == 0 ? sv[0] : (i2 == 1 ? sv[1] : (i2 == 2 ? sv[2] : sv[3])));
                e0 = 4 * bg + i1; e1 = 4 * bg + i2; w0 = s1 / (s1 + s2); w1 = s2 / (s1 + s2);
                rk0 = __hip_atomic_fetch_add(lcnt + e0, 1u, __ATOMIC_RELAXED, __HIP_MEMORY_SCOPE_WORKGROUP);
                rk1 = __hip_atomic_fetch_add(lcnt + e1, 1u, __ATOMIC_RELAXED, __HIP_MEMORY_SCOPE_WORKGROUP); }
        }
        __syncthreads();
        if (tid < 32) { const unsigned n = lcnt[tid]; lbase[tid] = n ? __hip_atomic_fetch_add(ecnt + 64 * tid, n, RLX_AGENT) : 0u; }
        __syncthreads();
        if (owner) { const unsigned s0 = lbase[e0] + rk0, s1 = lbase[e1] + rk1; perm[(size_t)e0 * NTOK + s0] = 2 * mytok; perm[(size_t)e1 * NTOK + s1] = 2 * mytok + 1; tokw[2 * mytok] = w0; tokw[2 * mytok + 1] = w1;
            tokes[2 * mytok] = (e0 << 16) | (int)s0; tokes[2 * mytok + 1] = (e1 << 16) | (int)s1; }
    }
}
__device__ __forceinline__ void expert_conv(const Frame& F0, const Args& args, int l, int j0, int j1) {
    const Frame F = fresh(F0);
    const int lane = F.lane, wave = F.wave;
    LAS float* scr = (LAS float*)(F.lds + RING_OFF + wave * 8704);
    const int gw = F.vcu * NWAVES + wave, NGW = F.G * NWAVES;
    bf16* WG1 = WSP(bf16, WS_WG1); bf16* WD = WSP(bf16, WS_WD);
    auto mk = [&](int it) -> TrItem {
        const int kind = it >> 13, r = it & 8191, e = r >> 8, rr = r & 255;
        if (kind < 2) { const int kb = rr >> 4, nb = rr & 15, n0 = nb * 32; const float* src = (kind == 0 ? INP(23) : INP(24)) + (size_t)(l * 32 + e) * 1024 * 512;
            return TrItem{src, 512, kb * 64, n0, WG1 + ((size_t)e * 1024 + (n0 >> 7) * 256 + kind * 128 + (n0 & 127)) * 1024, 1024}; }
        const int kb = rr >> 5, nb = rr & 31, n0 = nb * 32; const float* src = INP(25) + (size_t)(l * 32 + e) * 512 * 1024;
        return TrItem{src, 1024, kb * 64, n0, WD + ((size_t)e * 1024 + n0) * 512, 512}; };
    for (int j = j0; j < j1; j += 2) {
        const int ia = gw + NGW * j, ib = ia + NGW; const bool va = ia < 24576, two = (j + 1 < j1) && ib < 24576;
        if (!va) break;
        const TrItem a = mk(ia), b = mk(two ? ib : ia);
        f32x4 xa[8], xb[8]; tr_load(a, xa, lane); tr_load(b, xb, lane);
        tr_finish(a, xa, scr, lane); if (two) tr_finish(b, xb, scr, lane);
    }
}
__device__ __forceinline__ void moe_tilebase(const Frame& F0, const Args& args, int l) {
    const Frame F = fresh(F0);
    __syncthreads();
    if (F.tid < 32) { unsigned* ecnt = (unsigned*)(F.ctl + CW_ECNT + l * 32 * 64); F.MISC[49 + F.tid] = __hip_atomic_load(ecnt + 64 * F.tid, RLX_AGENT); }
    __syncthreads();
    if (F.tid < 32) { const int ln = F.tid; int exc = 0, tl = 0;
#pragma unroll 8
        for (int e = 0; e < 32; ++e) { const int te = (int)((F.MISC[49 + e] + 255u) >> 8); if (e < ln) exc += te; if (e == ln) tl = te; }
        F.MISC[16 + ln] = (unsigned)exc;
        if (ln == 31) F.MISC[48] = (unsigned)(exc + tl); }
    __syncthreads();
}
__device__ __forceinline__ void moe_rowmaps(const Frame& F0, const Args& args, const pg8::MoeOrder& S, LAS int* rowmap) {
    const Frame F = fresh(F0);
    const int* perm = WSP(int, WS_PERM);
    pg8::Unit u; int idxs[8]; int nu = 0;
#pragma unroll
    for (int i = 0; i < 8; ++i) { idxs[i] = -1; if (S.next(i, u)) { idxs[i] = u.gbase + min(F.tid & 255, u.gcnt - 1); nu = i + 1; } }
    if (F.tid < 256) { int v[8];
#pragma unroll
        for (int i = 0; i < 8; ++i) v[i] = perm[idxs[i] < 0 ? 0 : idxs[i]];
#pragma unroll
        for (int i = 0; i < 8; ++i) if (idxs[i] >= 0) rowmap[i * 256 + F.tid] = v[i] >> 1; }
    __syncthreads();
}
__device__ __forceinline__ void lru_conv_phase(const Frame& F0, const Args& args, int l) {
    const Frame F = fresh(F0);
    const int lane = F.lane, cg = lane & 7, tg = lane >> 3;
    const bf16* PROJ = WSP(bf16, WS_PROJ); bf16* XC = WSP(bf16, WS_XC);
    for (int wu = F.vcu * NWAVES + F.wave; wu < 4096; wu += F.G * NWAVES) {
        const int hb = wu & 7, c = (wu >> 3) & 127, b = wu >> 10, t0 = c * 64, ch0 = hb * 64 + 8 * cg;
        const bf16* xrp = PROJ + (size_t)b * T * PROJ_LD + XR_OFF + ch0;
        v4u raw[11];
#pragma unroll
        for (int rr = 0; rr < 11; ++rr) { const int t = t0 + 8 * tg - 2 + rr, tc = min(max(t, 0), T - 1); raw[rr] = *(const v4u*)(xrp + (size_t)tc * PROJ_LD); }
        f32x4 wv[5][2];
#pragma unroll
        for (int j = 0; j < 4; ++j) { wv[j][0] = *(const f32x4*)(INP(10) + (l * 4 + j) * 512 + ch0); wv[j][1] = *(const f32x4*)(INP(10) + (l * 4 + j) * 512 + ch0 + 4); }
        wv[4][0] = *(const f32x4*)(INP(11) + l * 512 + ch0); wv[4][1] = *(const f32x4*)(INP(11) + l * 512 + ch0 + 4);
        unsigned ow[8][4];
#pragma unroll
        for (int pp = 0; pp < 4; ++pp) {
            float xl[11], xh[11];
#pragma unroll
            for (int rr = 0; rr < 11; ++rr) { const int t = t0 + 8 * tg - 2 + rr; const unsigned w = (t >= 0 && t < T) ? raw[rr][pp] : 0u; xl[rr] = bflo(w); xh[rr] = bfhi(w); }
#pragma unroll
            for (int tk = 0; tk < 8; ++tk) { float ol = wv[4][pp >> 1][2 * (pp & 1)], oh = wv[4][pp >> 1][2 * (pp & 1) + 1];
#pragma unroll
                for (int j = 0; j < 4; ++j) { ol += wv[j][pp >> 1][2 * (pp & 1)] * xl[tk + j]; oh += wv[j][pp >> 1][2 * (pp & 1) + 1] * xh[tk + j]; }
                ow[tk][pp] = pk2(ol, oh); }
        }
#pragma unroll
        for (int tk = 0; tk < 8; ++tk) *(v4u*)(XC + ((size_t)b * T + t0 + 8 * tg + tk) * 512 + ch0) = (v4u){ow[tk][0], ow[tk][1], ow[tk][2], ow[tk][3]};
    }
}
__device__ __forceinline__ void lru_load_frags(bf16x8 (&af)[4][2], const bf16* xcp, int t0, int lane) {
#pragma unroll
    for (int mt = 0; mt < 4; ++mt) { const int tau = 16 * ((lane & 15) >> 2) + 4 * mt + (lane & 3);
#pragma unroll
        for (int s = 0; s < 2; ++s) af[mt][s] = *(const bf16x8*)(xcp + (size_t)(t0 + tau) * 512 + 32 * s); }
}
template <int DBG = 0>
__device__ __forceinline__ void lru2_phase(const Frame& F0, const Args& args, int l, bf16* obase, int opitch, int ooff) {
    const Frame F = fresh(F0);
    const int lane = F.lane, wave = F.wave, dw = wave >> 2, wq = wave & 3;
    LAS bf16* HP = (LAS bf16*)(F.lds + RING_OFF);
    LAS bf16* YRT = (LAS bf16*)(F.lds + RING_OFF + 131072 + wave * 1024);
    LAS f32x2* CT = (LAS f32x2*)(F.lds + RING_OFF + 139264);
    const bf16* PROJ = WSP(bf16, WS_PROJ); const bf16* XC = WSP(bf16, WS_XC);
    for (int un = F.vcu; un < 256; un += F.G) {
        const int b = un >> 6, hb = (un >> 3) & 7, s8 = un & 7;
        const int n = lane & 15, g = lane >> 4, hf = n >> 3, cj = n & 7;
        const int chg = hb * 64 + s8 * 8 + cj;
        const bf16* WLp = WSP(bf16, WS_WL) + ((size_t)(l * 8 + hb) * 256) * 64;
        bf16x8 bg[2], bs[2];
#pragma unroll
        for (int s = 0; s < 2; ++s) { bg[s] = *(const bf16x8*)(WLp + ((2 * dw + hf) * 64 + s8 * 8 + cj) * 64 + 32 * s + 8 * g);
            v4u sel = (v4u){0u, 0u, 0u, 0u};
            if (32 * s + 8 * g == 8 * s8) { const unsigned one = (cj & 1) ? 0x3F800000u : 0x00003F80u; sel[0] = (cj >> 1) == 0 ? one : 0u; sel[1] = (cj >> 1) == 1 ? one : 0u; sel[2] = (cj >> 1) == 2 ? one : 0u; sel[3] = (cj >> 1) == 3 ? one : 0u; }
            bs[s] = __builtin_bit_cast(bf16x8, sel); }
        const float b_r = INP(13)[(l * 2 + dw) * 512 + chg], b_i = INP(15)[(l * 2 + dw) * 512 + chg], lam = INP(16)[(l * 2 + dw) * 512 + chg];
        const float m8sp = -8.0f * ((lam > 15.f) ? __expf(-lam) : log1pf(__expf(-lam)));
        const float m8l = m8sp * 1.4426950408889634f, nbr = -b_r * 1.4426950408889634f, nbi = -b_i * 1.4426950408889634f;
        const bf16* xcp = XC + (size_t)b * T * 512 + hb * 64 + 8 * g;
        const bf16* yrp = PROJ + (size_t)b * T * PROJ_LD + YR_OFF + hb * 64 + s8 * 8;
        bf16* outp = obase + (size_t)b * T * opitch + ooff + hb * 64 + s8 * 8;
        const int pos = dw ? 7 - (2 * g + hf) : 2 * g + hf;
        float hrun = 0.f;
        bf16x8 nxt[4][2]; v4u ynx = (v4u){0u, 0u, 0u, 0u};
        { const int c0 = dw ? 127 - wq : wq; lru_load_frags(nxt, xcp, c0 * 64, lane); }
        __syncthreads();
#pragma unroll 1
        for (int rd = 0; rd < 32; ++rd) {
            const int c = dw ? 127 - (4 * rd + wq) : 4 * rd + wq, t0 = c * 64;
            const bool second = (DBG & 2) ? false : rd >= 16;
            bf16x8 af[4][2];
#pragma unroll
            for (int mt = 0; mt < 4; ++mt) { af[mt][0] = nxt[mt][0]; af[mt][1] = nxt[mt][1]; }
            const v4u ycur = ynx;
            { const int rn = min(rd + 1, 31), cn = dw ? 127 - (4 * rn + wq) : 4 * rn + wq; if (!(DBG & 1)) lru_load_frags(nxt, xcp, cn * 64, lane);
              if (rn >= 16) ynx = *(const v4u*)(yrp + (size_t)(cn * 64 + lane) * PROJ_LD); }
            if (second) *(LAS v4u*)(YRT + lane * 8) = ycur;
            f32x4 ag[4], ax[4];
#pragma unroll
            for (int mt = 0; mt < 4; ++mt) { ag[mt] = (f32x4){0.f, 0.f, 0.f, 0.f}; ax[mt] = (f32x4){0.f, 0.f, 0.f, 0.f};
#pragma unroll
                for (int s = 0; s < 2; ++s) { ag[mt] = __builtin_amdgcn_mfma_f32_16x16x32_bf16(af[mt][s], bg[s], ag[mt], 0, 0, 0); ax[mt] = __builtin_amdgcn_mfma_f32_16x16x32_bf16(af[mt][s], bs[s], ax[mt], 0, 0, 0); } }
            float a[8], bx[8], gr[8], gi[8], xv[8];
#pragma unroll
            for (int jj = 0; jj < 8; ++jj) {
                const float lo = ag[jj >> 2][jj & 3], hi = ag[2 + (jj >> 2)][jj & 3];
                const float mine = hf ? hi : lo, send = hf ? lo : hi;
                const float other = __builtin_bit_cast(float, __builtin_amdgcn_update_dpp(__builtin_bit_cast(int, send), __builtin_bit_cast(int, send), 0x128, 0xf, 0xf, false));
                gr[jj] = hf ? other : mine; gi[jj] = hf ? mine : other; xv[jj] = hf ? ax[2 + (jj >> 2)][jj & 3] : ax[jj >> 2][jj & 3]; }
#pragma unroll
            for (int jj = 0; jj < 8; ++jj) { gr[jj] = __builtin_amdgcn_exp2f(__builtin_fmaf(gr[jj], -1.4426950408889634f, nbr)); gi[jj] = __builtin_amdgcn_exp2f(__builtin_fmaf(gi[jj], -1.4426950408889634f, nbi)); }
#pragma unroll
            for (int jj = 0; jj < 8; ++jj) { gr[jj] = __builtin_amdgcn_rcpf(1.0f + gr[jj]); gi[jj] = __builtin_amdgcn_rcpf(1.0f + gi[jj]); }
#pragma unroll
            for (int jj = 0; jj < 8; ++jj) a[jj] = __builtin_amdgcn_exp2f(m8l * gr[jj]);
#pragma unroll
            for (int jj = 0; jj < 8; ++jj) bx[jj] = __builtin_amdgcn_sqrtf(__builtin_fmaf(-a[jj], a[jj], 1.0f)) * (gi[jj] * xv[jj]);
            float A8 = 1.f, B8 = 0.f;
            if (dw == 0) {
#pragma unroll
                for (int jj = 0; jj < 8; ++jj) { B8 = a[jj] * B8 + bx[jj]; A8 *= a[jj]; }
            } else {
#pragma unroll
                for (int jj = 7; jj >= 0; --jj) { B8 = a[jj] * B8 + bx[jj]; A8 *= a[jj]; }
            }
            float Ap = 1.f, Bp = 0.f, At = 1.f, Bt = 0.f;
#pragma unroll
            for (int k = 0; k < 8; ++k) { const int seg = dw ? 7 - k : k; const int src = cj + 8 * (seg & 1) + 16 * (seg >> 1);
                const float Ak = __shfl(A8, src), Bk = __shfl(B8, src);
                if (k < pos) { Bp = Ak * Bp + Bk; Ap *= Ak; }
                Bt = Ak * Bt + Bk; At *= Ak; }
            const int par = rd & 1;
            if (g == 0 && hf == 0) CT[((par * 2 + dw) * 4 + wq) * 8 + cj] = (f32x2){At, Bt};
            __syncthreads();
            float h = hrun;
#pragma unroll
            for (int q = 0; q < 4; ++q) { const f32x2 ab = CT[((par * 2 + dw) * 4 + q) * 8 + cj]; if (q < wq) h = ab.x * h + ab.y; hrun = ab.x * hrun + ab.y; }
            h = Ap * h + Bp;
            float hv[8];
            if (dw == 0) {
#pragma unroll
                for (int jj = 0; jj < 8; ++jj) { h = a[jj] * h + bx[jj]; hv[jj] = h; }
            } else {
#pragma unroll
                for (int jj = 7; jj >= 0; --jj) { h = a[jj] * h + bx[jj]; hv[jj] = h; }
            }
            const int tl0 = 16 * g + 8 * hf;
            if (DBG & 4) { if (hv[0] + hv[7] == 123.456f) outp[0] = 1; } else if (!second) {
                LAS bf16* hp = HP + ((size_t)(dw * 64 + (dw ? c - 64 : c)) * 64 + tl0) * 8 + cj;
#pragma unroll
                for (int jj = 0; jj < 8; ++jj) hp[jj * 8] = (bf16)f2bf(hv[jj]);
            } else {
                const LAS bf16* hp = HP + ((size_t)((1 - dw) * 64 + (dw ? c : c - 64)) * 64 + tl0) * 8 + cj;
                LDS_WAIT(); asm volatile("" ::: "memory");
                float yv[8], pv[8];
#pragma unroll
                for (int jj = 0; jj < 8; ++jj) { yv[jj] = bf2f(YRT[(tl0 + jj) * 8 + cj]); pv[jj] = bf2f(hp[jj * 8]); }
#pragma unroll
                for (int jj = 0; jj < 8; ++jj) YRT[(tl0 + jj) * 8 + cj] = (bf16)f2bf((hv[jj] + pv[jj]) * gelu_tanh(yv[jj]));
                LDS_WAIT(); asm volatile("" ::: "memory");
                *(v4u*)(outp + (size_t)(t0 + lane) * opitch) = *(const LAS v4u*)(YRT + lane * 8);
                LDS_WAIT(); asm volatile("" ::: "memory");
            }
        }
        __syncthreads();
    }
}
constexpr int AT_KR = 0, AT_VR = 73728, AT_VPITCH = 1168, AT_RPB = 148480, AT_XB = 150528, AT_XM = 158720;
__device__ __forceinline__ void attn2_phase(const Frame& F0, const Args& args, int l, bf16* obase, int opitch) {
    const Frame F = fresh(F0);
    const int tid = F.tid, lane = F.lane, wave = F.wave;
    LAS unsigned char* KR = F.lds + AT_KR; LAS unsigned char* VR = F.lds + AT_VR;
    LAS float* rpb = (LAS float*)(F.lds + AT_RPB);
    LAS unsigned char* XB = F.lds + AT_XB; LAS unsigned char* XM = F.lds + AT_XM;
    const bf16* PROJ = WSP(bf16, WS_PROJ); const bf16* VT = WSP(bf16, WS_VT);
    const int qb = wave & 3, dh = wave >> 2, qn = lane & 15, g = lane >> 4;
    const int cb = (qb == 0) ? 0 : ((qb == 1) ? 8 : ((qb == 2) ? 24 : 32));
    const int w = 16 * qb + qn, cs = min(max(w - 8, 0), 48);
    const int st = tid >> 3, sc = tid & 7;
    bool v0[4]; int dsel[4];
#pragma unroll
    for (int j = 0; j < 4; ++j) { const int kc0 = cb + 4 * g + j; v0[j] = (kc0 >= cs) && (kc0 <= cs + 15); dsel[j] = (v0[j] ? kc0 : kc0 + 16) - w + 15; }
    for (int un = F.vcu; un < 256; un += F.G) {
        const int bh = un >> 3, b = bh >> 3, h = bh & 7, R0 = (un & 7) * 16;
        __syncthreads();
        for (int i = tid; i < 465; i += 512) rpb[i] = INP(9)[(l * 8 + h) * 465 + i];
        const bf16* kg = PROJ + ((size_t)b * T + st) * PROJ_LD + K_OFF + h * 64 + 8 * sc;
        const bf16* vg = VT + ((size_t)(b * 512 + h * 64 + st)) * T + 8 * sc;
        const int kdst = st * 128 + ((sc ^ ((st >> 1) & 7)) * 16);
        const int vdst = st * AT_VPITCH + sc * 16;
        const int rs0 = min(max(R0 - 4, 0), 120);
        {
            v4u kk[8], vv[8];
#pragma unroll
            for (int j = 0; j < 8; ++j) { kk[j] = *(const v4u*)(kg + (size_t)(rs0 + j) * 64 * PROJ_LD); vv[j] = *(const v4u*)(vg + (rs0 + j) * 64); }
            PIN8(kk); PIN8(vv);
#pragma unroll
            for (int j = 0; j < 8; ++j) { const int slot = (rs0 + j) % 9; *(LAS v4u*)(KR + slot * 8192 + kdst) = kk[j]; *(LAS v4u*)(VR + slot * 128 + vdst) = vv[j]; }
        }
        __syncthreads();
        int have = rs0 + 7;
        v2u py0 = (v2u){0u, 0u}, py1 = (v2u){0u, 0u}; bf16* pop = nullptr;
        bf16x8 qn0, qn1;
        { const bf16* qp = PROJ + ((size_t)b * T + R0 * 64 + w) * PROJ_LD + Q_OFF + h * 64; qn0 = *(const bf16x8*)(qp + 8 * g); qn1 = *(const bf16x8*)(qp + 32 + 8 * g); }
#pragma unroll 1
        for (int s = 0; s < 16; ++s) {
            const int r = R0 + s;
            if (s > 0) { *(v2u*)pop = py0; *(v2u*)(pop + 16) = py1; }
            const size_t tokq = (size_t)b * T + r * 64 + w;
            const bf16x8 qf0 = qn0, qf1 = qn1;
            { const int r2 = min(r + 1, R0 + 15); const bf16* qp = PROJ + ((size_t)b * T + r2 * 64 + w) * PROJ_LD + Q_OFF + h * 64; qn0 = *(const bf16x8*)(qp + 8 * g); qn1 = *(const bf16x8*)(qp + 32 + 8 * g); }
            const int rsn = min(max(r + 1 - 4, 0), 120); const bool newrow = (s + 1 < 16) && (rsn + 7 > have); const int nrow = min(rsn + 7, 127);
            const v4u pk = *(const v4u*)(kg + (size_t)nrow * 64 * PROJ_LD), pv = *(const v4u*)(vg + nrow * 64);
            const int rs = min(max(r - 4, 0), 120);
            const int kr0 = 4 * dh;
            int slot0 = rs % 9 + kr0; slot0 = (slot0 >= 9) ? slot0 - 9 : slot0;
            int slot = slot0;
            f32x4 sc4[8];
#pragma unroll
            for (int kr = 0; kr < 4; ++kr) {
#pragma unroll
                for (int ch = 0; ch < 2; ++ch) { const int kt = cb + 16 * ch + qn; const LAS unsigned char* kp = KR + slot * 8192 + kt * 128; const int sw = (kt >> 1) & 7;
                    const bf16x8 kf0 = *(const LAS bf16x8*)(kp + ((g ^ sw) * 16)), kf1 = *(const LAS bf16x8*)(kp + (((4 + g) ^ sw) * 16));
                    f32x4 a = (f32x4){0.f, 0.f, 0.f, 0.f};
                    a = __builtin_amdgcn_mfma_f32_16x16x32_bf16(kf0, qf0, a, 0, 0, 0);
                    a = __builtin_amdgcn_mfma_f32_16x16x32_bf16(kf1, qf1, a, 0, 0, 0);
                    sc4[2 * kr + ch] = a; }
                slot = (slot == 8) ? 0 : slot + 1;
            }
            float sv[4][4]; float mx = -1e30f;
            const LAS float* rp = rpb + (rs - r + 7 + kr0) * 31;
#pragma unroll
            for (int kr = 0; kr < 4; ++kr)
#pragma unroll
                for (int j = 0; j < 4; ++j) { const float s = (v0[j] ? sc4[2 * kr][j] : sc4[2 * kr + 1][j]) + rp[kr * 31 + dsel[j]]; sv[kr][j] = s; mx = fmaxf(mx, s); }
            mx = fmaxf(mx, __shfl_xor(mx, 16)); mx = fmaxf(mx, __shfl_xor(mx, 32));
            float sum = 0.f;
#pragma unroll
            for (int kr = 0; kr < 4; ++kr)
#pragma unroll
                for (int j = 0; j < 4; ++j) { const float pe = __expf(sv[kr][j] - mx); sum += pe; sc4[2 * kr][j] = v0[j] ? pe : 0.f; sc4[2 * kr + 1][j] = v0[j] ? 0.f : pe; }
            sum += __shfl_xor(sum, 16); sum += __shfl_xor(sum, 32);
            f32x4 o[4];
#pragma unroll
            for (int dt = 0; dt < 4; ++dt) o[dt] = (f32x4){0.f, 0.f, 0.f, 0.f};
            slot = slot0;
            const LAS unsigned char* vb0 = VR + qn * AT_VPITCH + (cb + 4 * g) * 2;
#pragma unroll
            for (int kr = 0; kr < 4; ++kr) {
                v4u pw; pw.x = pk2(sc4[2 * kr][0], sc4[2 * kr][1]); pw.y = pk2(sc4[2 * kr][2], sc4[2 * kr][3]); pw.z = pk2(sc4[2 * kr + 1][0], sc4[2 * kr + 1][1]); pw.w = pk2(sc4[2 * kr + 1][2], sc4[2 * kr + 1][3]);
                const bf16x8 pf = __builtin_bit_cast(bf16x8, pw);
                const LAS unsigned char* vp = vb0 + slot * 128;
#pragma unroll
                for (int dt = 0; dt < 4; ++dt) { const v2u lo = *(const LAS v2u*)(vp + dt * 16 * AT_VPITCH), hi = *(const LAS v2u*)(vp + dt * 16 * AT_VPITCH + 32);
                    o[dt] = __builtin_amdgcn_mfma_f32_16x16x32_bf16(__builtin_bit_cast(bf16x8, ((v4u){lo.x, lo.y, hi.x, hi.y})), pf, o[dt], 0, 0, 0); }
                slot = (slot == 8) ? 0 : slot + 1;
            }
            { const f32x4 s0 = dh ? o[0] : o[2], s1 = dh ? o[1] : o[3];
              *(LAS v4u*)(XB + wave * 1024 + lane * 16) = (v4u){pk2(s0[0], s0[1]), pk2(s0[2], s0[3]), pk2(s1[0], s1[1]), pk2(s1[2], s1[3])};
              if (g == 0) *(LAS f32x2*)(XM + wave * 128 + qn * 8) = (f32x2){mx, sum}; }
            LDS_WAIT(); __builtin_amdgcn_s_barrier(); asm volatile("" ::: "memory");
            { const v4u pp = *(const LAS v4u*)(XB + (wave ^ 4) * 1024 + lane * 16); const f32x2 ms = *(const LAS f32x2*)(XM + (wave ^ 4) * 128 + qn * 8);
              const float m = fmaxf(mx, ms.x), fme = __expf(mx - m), fpa = __expf(ms.x - m), inv = __builtin_amdgcn_rcpf(sum * fme + ms.y * fpa), cme = fme * inv, cpa = fpa * inv;
              const f32x4 k0 = dh ? o[2] : o[0], k1 = dh ? o[3] : o[1];
              py0 = (v2u){pk2(k0[0] * cme + bflo(pp.x) * cpa, k0[1] * cme + bfhi(pp.x) * cpa), pk2(k0[2] * cme + bflo(pp.y) * cpa, k0[3] * cme + bfhi(pp.y) * cpa)};
              py1 = (v2u){pk2(k1[0] * cme + bflo(pp.z) * cpa, k1[1] * cme + bfhi(pp.z) * cpa), pk2(k1[2] * cme + bflo(pp.w) * cpa, k1[3] * cme + bfhi(pp.w) * cpa)}; }
            pop = obase + tokq * opitch + h * 64 + 32 * dh + 4 * g;
            if (newrow) { const int ns = nrow % 9; *(LAS v4u*)(KR + ns * 8192 + kdst) = pk; *(LAS v4u*)(VR + ns * 128 + vdst) = pv; have = nrow; }
            __syncthreads();
        }
        *(v2u*)pop = py0; *(v2u*)(pop + 16) = py1;
    }
    __syncthreads();
}
__device__ __forceinline__ bf16x8 lds_gather8(const LAS bf16* p, int stride) {
    unsigned short e[8];
#pragma unroll
    for (int j = 0; j < 8; ++j) e[j] = p[j * stride];
    v4u w; w.x = e[0] | ((unsigned)e[1] << 16); w.y = e[2] | ((unsigned)e[3] << 16); w.z = e[4] | ((unsigned)e[5] << 16); w.w = e[6] | ((unsigned)e[7] << 16);
    return __builtin_bit_cast(bf16x8, w);
}
constexpr int FA_PITCH = 136, FB_PITCH = 264;
__device__ __forceinline__ void fft_a2_phase(const Frame& F0, const Args& args) {
    const Frame F = fresh(F0);
    const int tid = F.tid, lane = F.lane, wave = F.wave, nl = lane & 31, hh = lane >> 5;
    LAS bf16* GT = (LAS bf16*)(F.lds + RING_OFF);
    LAS bf16* FAL = (LAS bf16*)(F.lds + RING_OFF + 65536);
    LAS f32x2* TWL = (LAS f32x2*)(F.lds + RING_OFF + 65536 + 34816);
    const bf16* PROJ = WSP(bf16, WS_PROJ); const bf16* FA = WSP(bf16, WS_FA); const f32x2* TW = WSP(f32x2, WS_TW); bf16* ZP = WSP(bf16, WS_U);
    __syncthreads();
    { v4u t[4];
#pragma unroll
        for (int i_ = 0; i_ < 4; ++i_) { const int i = tid + 512 * i_, r = i >> 4, c = i & 15; t[i_] = *(const v4u*)(FA + r * 128 + 8 * c); }
        PIN4(t);
#pragma unroll
        for (int i_ = 0; i_ < 4; ++i_) { const int i = tid + 512 * i_, r = i >> 4, c = i & 15; *(LAS v4u*)(FAL + r * FA_PITCH + 8 * c) = t[i_]; } }
    v4u v[8];
    { const int un = F.vcu; const int b = un >> 7, t2 = un & 127;
      if (un < 512) {
#pragma unroll
        for (int i = 0; i < 8; ++i) { const int idx = tid + 512 * i, k = idx >> 5, c = idx & 31, part = k >> 6, t1 = k & 63;
            v[i] = *(const v4u*)(PROJ + ((size_t)b * T + 128 * t1 + t2) * PROJ_LD + G_OFF + part * 256 + 8 * c); } } }
    for (int un = F.vcu; un < 512; un += F.G) {
        const int b = un >> 7, t2 = un & 127;
        __syncthreads();
        if (tid < 64) TWL[tid] = TW[t2 * 64 + tid];
        PIN8(v);
#pragma unroll
        for (int i = 0; i < 8; ++i) { const int idx = tid + 512 * i; *(LAS v4u*)(GT + (size_t)idx * 8) = v[i]; }
        { const int un2 = (un + F.G < 512) ? un + F.G : un; const int b2 = un2 >> 7, t22 = un2 & 127;
#pragma unroll
          for (int i = 0; i < 8; ++i) { const int idx = tid + 512 * i, k = idx >> 5, c = idx & 31, part = k >> 6, t1 = k & 63;
              v[i] = *(const v4u*)(PROJ + ((size_t)b2 * T + 128 * t1 + t22) * PROJ_LD + G_OFF + part * 256 + 8 * c); } }
        __syncthreads();
        {
            const int ch = 32 * wave + nl;
            f32x16 acc[4];
#pragma unroll
            for (int mt = 0; mt < 4; ++mt) acc[mt] = (f32x16){};
#pragma unroll 1
            for (int sc = 0; sc < 2; ++sc) {
                bf16x8 bf[4];
#pragma unroll
                for (int q4 = 0; q4 < 4; ++q4) bf[q4] = lds_gather8(GT + (16 * (4 * sc + q4) + 8 * hh) * 256 + ch, 256);
#pragma unroll
                for (int mt = 0; mt < 4; ++mt)
#pragma unroll
                    for (int q4 = 0; q4 < 4; ++q4) { const bf16x8 af = *(const LAS bf16x8*)(FAL + (32 * mt + nl) * FA_PITCH + 16 * (4 * sc + q4) + 8 * hh); acc[mt] = __builtin_amdgcn_mfma_f32_32x32x16_bf16(af, bf[q4], acc[mt], 0, 0, 0); }
            }
#pragma unroll
            for (int mt = 0; mt < 2; ++mt)
#pragma unroll
                for (int rg = 0; rg < 16; ++rg) { const int k1 = 32 * mt + (rg & 3) + 8 * (rg >> 2) + 4 * hh; const f32x2 cs = TWL[k1];
                    const float zr = acc[mt][rg], zi = acc[mt + 2][rg];
                    GT[k1 * 256 + ch] = (bf16)f2bf(zr * cs.x + zi * cs.y); GT[(64 + k1) * 256 + ch] = (bf16)f2bf(zi * cs.x - zr * cs.y);
                }
        }
        __syncthreads();
#pragma unroll
        for (int i = 0; i < 8; ++i) { const int idx = tid + 512 * i, m = idx >> 5, c = idx & 31, pp = m >> 6, k1 = m & 63;
            *(v4u*)(ZP + ((size_t)(b * 64 + k1) * 128 + t2) * 512 + pp * 256 + 8 * c) = *(const LAS v4u*)(GT + (size_t)idx * 8); }
    }
    __syncthreads();
}
__device__ __forceinline__ void fft_b2_phase(const Frame& F0, const Args& args) {
    const Frame F = fresh(F0);
    const int tid = F.tid, lane = F.lane, wave = F.wave, nl = lane & 31, hh = lane >> 5;
    LAS bf16* ZT = (LAS bf16*)(F.lds + RING_OFF);
    LAS bf16* FBL = (LAS bf16*)(F.lds + RING_OFF + 65536);
    LAS float* ZC = (LAS float*)(F.lds + RING_OFF + 65536 + 67584);
    LAS float* V0A = ZC + 512;
    LAS float* WA = V0A + 256;
    bf16* PROJ = WSP(bf16, WS_PROJ); const bf16* FB = WSP(bf16, WS_FB); const bf16* ZP = WSP(bf16, WS_U);
    __syncthreads();
    { v4u t[8];
#pragma unroll
        for (int i_ = 0; i_ < 8; ++i_) { const int i = tid + 512 * i_, r = i >> 5, c = i & 31; t[i_] = *(const v4u*)(FB + r * 256 + 8 * c); }
        PIN8(t);
#pragma unroll
        for (int i_ = 0; i_ < 8; ++i_) { const int i = tid + 512 * i_, r = i >> 5, c = i & 31; *(LAS v4u*)(FBL + r * FB_PITCH + 8 * c) = t[i_]; } }
    const int ws = wave >> 2, nt = (wave >> 1) & 1, mh = wave & 1;
    v4u v[8];
    { const int un = F.vcu; const int b = un >> 7, p = (un >> 2) & 31, g = un & 3;
      if (un < 512) {
#pragma unroll
        for (int i = 0; i < 8; ++i) { const int idx = tid + 512 * i, s = idx >> 11, k = (idx >> 3) & 255, c = idx & 7, part = k >> 7, t2 = k & 127, k1 = s ? (p ? 64 - p : 32) : p;
            v[i] = *(const v4u*)(ZP + ((size_t)(b * 64 + k1) * 128 + t2) * 512 + part * 256 + g * 64 + 8 * c); } } }
    for (int un = F.vcu; un < 512; un += F.G) {
        const int b = un >> 7, p = (un >> 2) & 31, g = un & 3;
        __syncthreads();
        PIN8(v);
#pragma unroll
        for (int i = 0; i < 8; ++i) { const int idx = tid + 512 * i; *(LAS v4u*)(ZT + (size_t)idx * 8) = v[i]; }
        { const int un2 = (un + F.G < 512) ? un + F.G : un; const int b2 = un2 >> 7, p2 = (un2 >> 2) & 31, g2 = un2 & 3;
#pragma unroll
          for (int i = 0; i < 8; ++i) { const int idx = tid + 512 * i, s = idx >> 11, k = (idx >> 3) & 255, c = idx & 7, part = k >> 7, t2 = k & 127, k1 = s ? (p2 ? 64 - p2 : 32) : p2;
              v[i] = *(const v4u*)(ZP + ((size_t)(b2 * 64 + k1) * 128 + t2) * 512 + part * 256 + g2 * 64 + 8 * c); } }
        __syncthreads();
        ZC[tid] = bf2f(ZT[(size_t)tid * 64]);
        const int ch = 32 * nt + nl;
        f32x16 acc[2];
        acc[0] = (f32x16){}; acc[1] = (f32x16){};
        { const LAS bf16* ZTs = ZT + ws * 16384;
#pragma unroll 1
          for (int sc = 0; sc < 4; ++sc) {
            bf16x8 bf[4];
#pragma unroll
            for (int q = 0; q < 4; ++q) bf[q] = lds_gather8(ZTs + (16 * (4 * sc + q) + 8 * hh) * 64 + ch, 64);
#pragma unroll
            for (int m2 = 0; m2 < 2; ++m2)
#pragma unroll
                for (int q = 0; q < 4; ++q) { const bf16x8 af = *(const LAS bf16x8*)(FBL + (64 * mh + 32 * m2 + nl) * FB_PITCH + 16 * (4 * sc + q) + 8 * hh); acc[m2] = __builtin_amdgcn_mfma_f32_32x32x16_bf16(af, bf[q], acc[m2], 0, 0, 0); }
          } }
        __syncthreads();
        {
            const int s = tid >> 8, k2 = (tid >> 1) & 127, hf = tid & 1;
            const LAS bf16* fr = FBL + k2 * FB_PITCH + 64 * hf; const LAS float* zc = ZC + s * 256 + 64 * hf;
            float w = 0.f;
#pragma unroll 2
            for (int j = 0; j < 8; ++j) { const v4u fc = *(const LAS v4u*)(fr + 8 * j), fs = *(const LAS v4u*)(fr + 128 + 8 * j);
                const f32x4 r0 = *(const LAS f32x4*)(zc + 8 * j), r1 = *(const LAS f32x4*)(zc + 8 * j + 4), i0 = *(const LAS f32x4*)(zc + 128 + 8 * j), i1 = *(const LAS f32x4*)(zc + 128 + 8 * j + 4);
                w += i0[0] * bflo(fc.x) + i0[1] * bfhi(fc.x) + i0[2] * bflo(fc.y) + i0[3] * bfhi(fc.y) + i1[0] * bflo(fc.z) + i1[1] * bfhi(fc.z) + i1[2] * bflo(fc.w) + i1[3] * bfhi(fc.w);
                w -= r0[0] * bflo(fs.x) + r0[1] * bfhi(fs.x) + r0[2] * bflo(fs.y) + r0[3] * bfhi(fs.y) + r1[0] * bflo(fs.z) + r1[1] * bfhi(fs.z) + r1[2] * bflo(fs.w) + r1[3] * bfhi(fs.w); }
            w += __shfl_xor(w, 1);
            if (hf == 0) WA[s * 128 + k2] = w * (1.0f / 1024.0f);
        }
        {
            const int kb = 64 * mh + 4 * hh;
            int hi = p ? (1 - ws) * 128 : ws * 128, lo = (p || ws) ? 127 - kb : 128 - kb, rb = (ws * 128 + kb) * 128 + ch, chm = ch ? 128 - ch : 64;
            asm volatile("" : "+v"(hi), "+v"(lo), "+v"(rb), "+v"(chm));
#pragma unroll
            for (int m2 = 0; m2 < 2; ++m2)
#pragma unroll
                for (int rg = 0; rg < 16; ++rg) { const int off = 32 * m2 + (rg & 3) + 8 * (rg >> 2); const bf16 hv = (bf16)f2bf(acc[m2][rg] * (1.0f / 1024.0f));
                    ZT[rb + off * 128] = hv; ZT[(hi + ((lo - off) & 127)) * 128 + chm] = hv; }
            if (ch == 0) {
#pragma unroll
                for (int m2 = 0; m2 < 2; ++m2)
#pragma unroll
                    for (int rg = 0; rg < 16; ++rg) V0A[ws * 128 + kb + 32 * m2 + (rg & 3) + 8 * (rg >> 2)] = acc[m2][rg] * (1.0f / 1024.0f); }
        }
        __syncthreads();
        if (tid < 256) { const int s = tid >> 7, k2 = tid & 127, rm = p ? (1 - s) * 128 + 127 - k2 : (s ? 128 + 127 - k2 : ((128 - k2) & 127));
            ZT[tid * 128] = (bf16)f2bf(0.5f * (V0A[tid] + V0A[rm])); ZT[tid * 128 + 64] = (bf16)f2bf(0.5f * (WA[tid] + WA[rm])); }
        __syncthreads();
#pragma unroll
        for (int i = 0; i < 8; ++i) { const int idx = tid + 512 * i, r = idx >> 4, c = idx & 15, s = r >> 7, k2 = r & 127, k1 = s ? (p ? 64 - p : 32) : p;
            *(v4u*)(PROJ + ((size_t)b * T + k1 + 64 * k2) * PROJ_LD + G_OFF + g * 128 + 8 * c) = *(const LAS v4u*)(ZT + (size_t)idx * 8); }
    }
    __syncthreads();
}
__device__ __forceinline__ void stagger(const Frame& F, int ticks) {
    const unsigned long long t0 = __builtin_amdgcn_s_memrealtime(), d = (unsigned long long)((F.vcu & 3) * ticks);
    while (__builtin_amdgcn_s_memrealtime() - t0 < d) __builtin_amdgcn_s_sleep(16);
}
__device__ __forceinline__ int fresh_bid() { int b = (int)blockIdx.x; asm volatile("" : "+s"(b)); return b; }
constexpr int PPL = 9, N_PHASES = 2 + PPL * DEPTH;
__global__ void __launch_bounds__(NWAVES * 64, 2) mega_fwd(Args args, int li) {
    extern __shared__ __attribute__((aligned(16))) unsigned char lds[];
    Frame F;
    F.lds = (LAS unsigned char*)lds;
    F.MISC = (volatile LAS unsigned*)(F.lds + MISC_OFF);
    F.tid = threadIdx.x; F.lane = F.tid & 63; F.wave = __builtin_amdgcn_readfirstlane(F.tid >> 6);
    F.G = gridDim.x; { const int bx = blockIdx.x; F.vcu = (F.G % 8 == 0) ? (bx % 8) * (F.G / 8) + bx / 8 : bx; }
    F.ctl = (gu32*)(args.ws + WS_CTL);
    for (int u = F.tid; u < (LDS_BYTES - LDSCTL_OFF) / 4; u += NWAVES * 64) ((LAS unsigned*)(F.lds + LDSCTL_OFF))[u] = 0u;
    __syncthreads();
    const int lo = args.ph_lo, hi = args.ph_hi;
    XcdBarrier bar; bar.bar = (unsigned*)(F.ctl + CW_BAR) + li * XCD_BAR_WORDS; bar.x = 0; bar.st = nullptr; bar.wave = F.wave;
    if (hi - lo > 1) bar = xcd_barrier_post((unsigned*)(F.ctl + CW_BAR) + li * XCD_BAR_WORDS, F.MISC + 8);
#ifndef PHMASK
#define PHMASK 0xFFFF
#endif
#define EN(kind) ((PHMASK >> (kind)) & 1)
#define IN(k) (lo <= (k) && (k) < hi)
#define SEAM(k) do { if (IN(k) && IN((k) + 1)) { xcd_barrier(bar); for (int rb_ = 0; rb_ < REP_B; ++rb_) xcd_barrier(bar); } } while (0)

    if (EN(0) && IN(0)) { for (int rep = 0; rep < 1 + REP_C; ++rep) p0_prologue(F, args); SEAM(0); }
    auto layer = [&](const int l) __attribute__((always_inline)) {
        const int pb = 1 + PPL * l;
        bf16* U = WSP(bf16, WS_U); bf16* PROJ = WSP(bf16, WS_PROJ); bf16* GATES = WSP(bf16, WS_GATES);
        if (EN(1) && IN(pb + 0)) { if (l == 0) { for (int rep = 0; rep < (REP_R & 1); ++rep) rows_phase<0>(F, args, l); rows_phase<0>(F, args, l); } else rows_phase<1>(F, args, l); SEAM(pb + 0); }
        if (EN(2) && IN(pb + 1)) {
            pg8::Gemm g{U, U, U, WSP(bf16, WS_WP2) + (size_t)l * NP2 * 1024, nullptr, nullptr, 1024, 1024, 1024};
            pg8::StaticOrder S; S.init(NTOK, 3072, F.G, fresh_bid());
            EpiP2 E{false, false, nullptr, PROJ, WSP(bf16, WS_VT)};
            const int npre = 4 * (F.vcu & 3) * (STAG_P2 != 0);
            expert_conv(F, args, l, 0, npre); __syncthreads();
            for (int rep = 0; rep < 1 + (REP_GS & 1 ? REP_G : 0); ++rep) pg8::gemm_phase<EpiP2, pg8::StaticOrder, true>(F.lds + RING_OFF, g, S, E, fresh(F).tid);
            {
                const pg8::bf16_t* U8 = (const pg8::bf16_t*)(args.ws + WS_U8); const pg8::bf16_t* W8 = WSP(bf16, WS_WP2) + (size_t)l * NP2 * 1024 + (size_t)3072 * 1024;
                pg8::Gemm g8{U8, U8, U8, W8, nullptr, nullptr, 512, 512, 512};
                pg8::StaticOrder S8; S8.init(NTOK, 3072, F.G, fresh_bid());
                EpiGates E8{false, GATES, INP(8) + l * 3072};
                for (int rep = 0; rep < 1 + (REP_GS & 1 ? REP_G : 0); ++rep) pg8::gemm_phase<EpiGates, pg8::StaticOrder, true, false, true>(F.lds + RING_OFF, g8, S8, E8, fresh(F).tid);
            }
            __syncthreads(); expert_conv(F, args, l, npre, 12);
            SEAM(pb + 1);
        }
        if (EN(3) && IN(pb + 2)) {
            for (int rep = 0; rep < REP_M; ++rep) { if (REP_MS & 1) attn2_phase(F, args, l, WSP(bf16, WS_SCR), 512); if (REP_MS & 2) lru_conv_phase(F, args, l); if (REP_MS & 4) fft_a2_phase(F, args); if (REP_MS & 16) fft_a2_phase(F, args); }
            lru_conv_phase(F, args, l); attn2_phase(F, args, l, PROJ, PROJ_LD); fft_a2_phase(F, args); SEAM(pb + 2); }
        if (EN(4) && IN(pb + 3)) { for (int rep = 0; rep < REP_M; ++rep) { if (REP_MS & 2) lru2_phase<REP_DBG>(F, args, l, WSP(bf16, WS_SCR), 512, 0); if (REP_MS & 4) fft_b2_phase(F, args); if (REP_MS & 32) fft_b2_phase(F, args); }
            lru2_phase(F, args, l, PROJ, PROJ_LD, YR_OFF); fft_b2_phase(F, args); SEAM(pb + 3); }
        if (EN(6) && IN(pb + 4)) {
            const bf16* WP = WSP(bf16, WS_WPROJ) + (size_t)l * 3 * 1024 * 512;
            pg8::Gemm g{PROJ + Q_OFF, PROJ + YR_OFF, PROJ + G_OFF, WP, WP + 1024 * 512, WP + 2 * 1024 * 512, PROJ_LD, 512, 512};
            pg8::MergeOrder S; S.init(NTOK, 1024, F.G, fresh_bid());
            EpiMerge E{false, GATES, U, WSP(bf16, WS_VT) + (size_t)fresh_bid() * 65536};
            for (int rep = 0; rep < 1 + (REP_GS & 2 ? REP_G : 0); ++rep) pg8::gemm_phase<EpiMerge, pg8::MergeOrder, true>(F.lds + RING_OFF, g, S, E, fresh(F).tid);
            SEAM(pb + 4);
        }
        if (EN(7) && IN(pb + 5)) {
            pg8::Gemm g{U, U, U, WSP(bf16, WS_WOUT) + (size_t)l * 1024 * 1024, nullptr, nullptr, 1024, 1024, 1024};
            pg8::StaticOrder S; S.init(NTOK, 1024, F.G, fresh_bid());
            if (l == 0) { EpiResid<true> E{false, INP(0), WSP(bf16, WS_XB0), WSP(bf16, WS_XB1), WSP(float, WS_MOD) + (size_t)l * 4 * 6144 + 2 * 1024};
                pg8::gemm_phase<EpiResid<true>, pg8::StaticOrder, true>(F.lds + RING_OFF, g, S, E, fresh(F).tid); }
            else { EpiResid<false> E{false, nullptr, WSP(bf16, WS_XB0), WSP(bf16, WS_XB1), WSP(float, WS_MOD) + (size_t)l * 4 * 6144 + 2 * 1024};
                pg8::gemm_phase<EpiResid<false>, pg8::StaticOrder, true>(F.lds + RING_OFF, g, S, E, fresh(F).tid); }
            SEAM(pb + 5);
        }
        if (EN(8) && IN(pb + 6)) { if (REP_R & 2) router_phase(F, args, l, 2 + l); router_phase(F, args, l, l); SEAM(pb + 6); }
        if (EN(10) && IN(pb + 7)) {
            moe_tilebase(F, args, l);
            pg8::Gemm g{U, U, U, WSP(bf16, WS_WG1), nullptr, nullptr, 1024, 1024, 1024};
            pg8::MoeOrder S{(const LAS int*)(F.lds + MISC_OFF + 64), F.G, fresh_bid()};
            LAS int* rowmap = (LAS int*)(F.lds + XTRA_OFF);
            moe_rowmaps(F, args, S, rowmap);
            EpiSwiGLU E{false, WSP(bf16, WS_H)};
            for (int rep = 0; rep < 1 + (REP_GS & 8 ? REP_G : 0); ++rep) pg8::gemm_phase<EpiSwiGLU, pg8::MoeOrder, true, true>(F.lds + RING_OFF, g, S, E, fresh(F).tid, rowmap);
            SEAM(pb + 7);
        }
        if (EN(11) && IN(pb + 8)) {
            moe_tilebase(F, args, l);
            const bf16* H = WSP(bf16, WS_H);
            pg8::Gemm g{H, H, H, WSP(bf16, WS_WD), nullptr, nullptr, 512, 512, 512};
            pg8::MoeOrder S{(const LAS int*)(F.lds + MISC_OFF + 64), F.G, fresh_bid()};
            EpiYE E{false, PROJ};
            for (int rep = 0; rep < 1 + (REP_GS & 16 ? REP_G : 0); ++rep) pg8::gemm_phase<EpiYE, pg8::MoeOrder, true>(F.lds + RING_OFF, g, S, E, fresh(F).tid);
            SEAM(pb + 8);
        }
    };
    static_assert(DEPTH == 2, "layers"); layer(0); layer(1);
    if (EN(12) && IN(N_PHASES - 1)) rows_phase<2>(F, args, DEPTH);
#undef IN
#undef SEAM
}

#ifndef MK_MODE
#define MK_MODE 0
#endif
extern "C" void kernel_launch(void* const* d_in, const int* in_sizes, int n_in, void* d_out, int out_size, void* d_ws, size_t ws_size, hipStream_t stream) {
    static int grid = 0;
    if (grid == 0) {
        if (n_in != 27 || in_sizes[0] != NTOK * D || out_size != NTOK * D || ws_size < WS_END) { fprintf(stderr, "kernel_launch: unexpected shapes (n_in %d, in0 %d, out %d, ws %zu < %zu)\n", n_in, n_in > 0 ? in_sizes[0] : -1, out_size, ws_size, (size_t)WS_END); grid = -1; return; }
        int dev = 0, cus = 0;
        if (hipGetDevice(&dev) != hipSuccess || hipDeviceGetAttribute(&cus, hipDeviceAttributeMultiprocessorCount, dev) != hipSuccess) { grid = -1; return; }
        if (hipFuncSetAttribute((const void*)mega_fwd, hipFuncAttributeMaxDynamicSharedMemorySize, LDS_BYTES) != hipSuccess) { fprintf(stderr, "kernel_launch: hipFuncSetAttribute failed\n"); grid = -1; return; }
        (void)hipGetLastError();
        grid = cus;
    }
    if (grid < 0) return;
    if (hipMemsetAsync((char*)d_ws + WS_CTL, 0, CTL_ZERO_BYTES, stream) != hipSuccess) return;
    Args a{};
    for (int i = 0; i < 27; ++i) a.in[i] = (const float*)d_in[i];
    a.out = (float*)d_out; a.ws = (unsigned char*)d_ws;
#if MK_MODE == 0
    a.ph_lo = 0; a.ph_hi = N_PHASES;
    hipLaunchKernelGGL(mega_fwd, dim3(grid), dim3(NWAVES * 64), LDS_BYTES, stream, a, 0);
#else
    for (int p = 0; p < N_PHASES; ++p) { a.ph_lo = p; a.ph_hi = p + 1; hipLaunchKernelGGL(mega_fwd, dim3(grid), dim3(NWAVES * 64), LDS_BYTES, stream, a, 0); }
#endif
}
```

```cpp
#include <hip/hip_runtime.h>
#include <cstdio>
#include <cstdint>
namespace pg8 {
#define PG8_LAS __attribute__((address_space(3)))
typedef unsigned short bf16_t;
typedef short bf16x8 __attribute__((ext_vector_type(8)));
typedef float f32x4 __attribute__((ext_vector_type(4)));
typedef unsigned u32x4 __attribute__((ext_vector_type(4)));
typedef unsigned u32x2 __attribute__((ext_vector_type(2)));
typedef int v4i_ __attribute__((ext_vector_type(4)));
constexpr int BM = 256, BK = 64, HALF = 128, HTB = HALF * BK * 2  , STAGE_BYTES = 8 * HTB, NXCD = 8, WGM = 8;

__host__ __device__ __forceinline__ int lds_byte(int r, int c) { const int st = (r >> 4) * 2 + (c >> 5), rr = r & 15, cc = c & 31, ob = rr * 64 + cc * 2; return st * 1024 + (ob ^ (((ob >> 9) & 1) << 5)); }
__host__ __device__ __forceinline__ void stage_rc(int b, int& R, int& C) { const int st = b / 1024, sb = b % 1024, swz = sb ^ (((sb >> 9) & 1) << 5); R = (st >> 1) * 16 + swz / 64; C = (st & 1) * 32 + (swz % 64) / 2; }
__host__ __device__ __forceinline__ int perm32(int rho) { const int n = rho >> 4, i = rho & 15; return 8 * (i >> 2) + 4 * n + (i & 3); }

struct Unit { int pm, pn, bt, z, gbase, gcnt; };
struct Gemm { const bf16_t* A0; const bf16_t* A1; const bf16_t* A2; const bf16_t* B0; const bf16_t* B1; const bf16_t* B2; int lda, ldb, K; };

__device__ __forceinline__ unsigned cvt_pk_bf16(float lo, float hi) { unsigned r; asm volatile("v_cvt_pk_bf16_f32 %0, %1, %2" : "=v"(r) : "v"(lo), "v"(hi)); return r; }

struct StaticOrder {
    int nM, nN, nwg, G, c;
    __device__ void init(int M, int N, int G_, int c_) { nM = M / BM; nN = N / BM; nwg = nM * nN; G = G_; c = c_; }
    __device__ __forceinline__ bool tile(long L, Unit& u) const {
        if (L >= nwg) return false;
        int wgid = (int)L; { const int q = nwg / NXCD, r = nwg % NXCD, xcd = wgid % NXCD, off = wgid / NXCD; wgid = (xcd < r ? xcd * (q + 1) : r * (q + 1) + (xcd - r) * q) + off; }
        const int nig = WGM * nN, gid = wgid / nig, fm = gid * WGM, gsz = (nM - fm) < WGM ? (nM - fm) : WGM;
        u.pm = fm + ((wgid % nig) % gsz); u.pn = (wgid % nig) / gsz; u.bt = u.pn; u.z = 0; u.gbase = 0; u.gcnt = 0; return true;
    }
    __device__ __forceinline__ bool next(int i, Unit& u) const { return tile((long)i * G + c, u); }
};
struct MergeOrder : StaticOrder {
    __device__ __forceinline__ bool next(int i, Unit& u) const { const int t = i / 3; if (!tile((long)t * G + c, u)) return false; u.z = i - 3 * t; return true; }
};
struct MoeOrder {
    const PG8_LAS int* tb; int G, c;
    __device__ __forceinline__ bool next(int i, Unit& u) const {
        const int L = i * G + c; const int nt = tb[32]; if (L >= nt * 4) return false;
        const int t = L >> 2, j = L & 3; unsigned z_ = 0u; asm volatile("" : "+v"(z_)); const int ln_ = (int)__builtin_amdgcn_mbcnt_hi(~0u, __builtin_amdgcn_mbcnt_lo(~0u, z_)); const int tbv_ = (ln_ >= 1 && ln_ < 32) ? tb[ln_] : 0x7fffffff;
        const int e = __popcll(__ballot(tbv_ <= t));
        const int tl = t - tb[e];
        u.pm = t; u.pn = j; u.bt = e * 4 + j; u.z = 0; u.gbase = e * 32768 + 256 * tl; u.gcnt = tb[33 + e] - 256 * tl; return true;
    }
};

template <class Epi, class Sched, bool ALIGN_EPI, bool GATHER = false, bool FP8 = false, int SCALE_W = 0x7F7F7F7F>
__device__ __forceinline__ void gemm_phase(PG8_LAS unsigned char* lds, const Gemm g, const Sched& S, const Epi& E, const int tid, const PG8_LAS int* rowmap = nullptr) {
    const int wid = __builtin_amdgcn_readfirstlane(tid >> 6), lane = tid & 63, wr = wid >> 2, wc = wid & 3, fr = lane & 15, fq = lane >> 4;
    const int K = g.K, nt = K / BK;
    int sc1_ = 0x7F7F7F7F; if constexpr (FP8) asm volatile("" : "+v"(sc1_));
    unsigned voffA[2], voffB[2]; int gR[2];
#pragma unroll
    for (int i = 0; i < 2; ++i) { int R, C; stage_rc(tid * 16 + i * 8192, R, C); const int Rb = Epi::PERM ? ((R & ~31) + perm32(R & 31)) : R;
        voffA[i] = GATHER ? (unsigned)C * 2u : (unsigned)(R * g.lda + C) * 2u; voffB[i] = (unsigned)(Rb * g.ldb + C) * 2u; gR[i] = R; }
    unsigned offC[2][2], offN[2][2];
#define PG8_GOFF(dst, ui_) do { _Pragma("unroll") for (int h_ = 0; h_ < 2; ++h_) _Pragma("unroll") for (int i_ = 0; i_ < 2; ++i_) dst[h_][i_] = (unsigned)rowmap[(ui_) * 256 + 128 * h_ + gR[i_]] * (unsigned)(g.lda * 2) + voffA[i_]; } while (0)
    const size_t kstep = (size_t)(BK * 2);
    const size_t hstepA = (size_t)HALF * g.lda * 2, hstepB = (size_t)HALF * g.ldb * 2;
    const size_t tstepA = 2 * hstepA, tstepB = 2 * hstepB;
    const unsigned ldsw = (unsigned)wid * 1024u;
    const int aoff = lds_byte(wr * 64 + fr, fq * 8), boff = lds_byte(wc * 32 + fr, fq * 8);
#define PG8_SA(b, h) (((b) * 2 + (h)) * HTB)
#define PG8_SB(b, h) ((4 + (b) * 2 + (h)) * HTB)
#define PG8_STAGE(bufoff, gbase, voff) do { _Pragma("unroll") for (int _i = 0; _i < 2; ++_i) { unsigned vo_ = (voff)[_i]; if constexpr (FP8) asm volatile("" : "+v"(vo_)); \
        __builtin_amdgcn_global_load_lds((const unsigned*)((const char*)(gbase) + vo_), (PG8_LAS unsigned*)(lds + (bufoff) + ldsw + _i * 8192), 16, 0, 0); } } while (0)
#define PG8_STAGE_A(bufoff, gbase, h, nf) do { _Pragma("unroll") for (int _i = 0; _i < 2; ++_i) { unsigned o_ = GATHER ? ((nf) ? offN[h][_i] : offC[h][_i]) : (voffA[_i] + (unsigned)((h) * hstepA)); if constexpr (FP8) asm volatile("" : "+v"(o_)); \
        __builtin_amdgcn_global_load_lds((const unsigned*)((const char*)(gbase) + o_), (PG8_LAS unsigned*)(lds + (bufoff) + ldsw + _i * 8192), 16, 0, 0); } } while (0)
#define PG8_LDA(dst, b, h) do { _Pragma("unroll") for (int m = 0; m < 4; ++m) _Pragma("unroll") for (int k = 0; k < 2; ++k) dst[m][k] = *(const PG8_LAS bf16x8*)(lds + PG8_SA(b, h) + aoff + m * 2048 + k * 1024); } while (0)
#define PG8_LDB(dst, b, h) do { _Pragma("unroll") for (int n = 0; n < 2; ++n) _Pragma("unroll") for (int k = 0; k < 2; ++k) dst[n][k] = *(const PG8_LAS bf16x8*)(lds + PG8_SB(b, h) + boff + n * 2048 + k * 1024); } while (0)
#define PG8_CAT8(x) __builtin_shufflevector(__builtin_bit_cast(v4i_, (x)[0]), __builtin_bit_cast(v4i_, (x)[1]), 0, 1, 2, 3, 4, 5, 6, 7)
#define PG8_MMA(ai, bj, At, Bt) do { __builtin_amdgcn_s_setprio(1); _Pragma("unroll") for (int m = 0; m < 4; ++m) _Pragma("unroll") for (int n = 0; n < 2; ++n) { \
        if constexpr (FP8) acc[ai][bj][m][n] = __builtin_amdgcn_mfma_scale_f32_16x16x128_f8f6f4(PG8_CAT8(Bt[n]), PG8_CAT8(At[m]), acc[ai][bj][m][n], 0, 0, 0, sc1_, 0, sc1_); \
        else { _Pragma("unroll") for (int k = 0; k < 2; ++k) acc[ai][bj][m][n] = __builtin_amdgcn_mfma_f32_16x16x32_bf16(Bt[n][k], At[m][k], acc[ai][bj][m][n], 0, 0, 0); } } __builtin_amdgcn_s_setprio(0); } while (0)
#define PG8_WAIT_V(n) asm volatile("s_waitcnt vmcnt(" #n ")" ::: "memory")
#define PG8_WAIT_L(n) asm volatile("s_waitcnt lgkmcnt(" #n ")" ::: "memory")
#define PG8_BAR __builtin_amdgcn_s_barrier()
#define PG8_SCHED __builtin_amdgcn_sched_barrier(0)
#define PG8_APTR(u) (GATHER ? (const char*)g.A0 : (const char*)((u).z == 0 ? g.A0 : ((u).z == 1 ? g.A1 : g.A2)) + (size_t)(u).pm * tstepA)
#define PG8_BPTR(u) ((const char*)((u).z == 0 ? g.B0 : ((u).z == 1 ? g.B1 : g.B2)) + (size_t)(u).bt * tstepB)
    Unit cur, nxt; int ui = 0;
    if (!S.next(0, cur)) return;
    f32x4 acc[2][2][4][2];
#pragma unroll
    for (int a = 0; a < 2; ++a)
#pragma unroll
        for (int b = 0; b < 2; ++b)
#pragma unroll
            for (int m = 0; m < 4; ++m)
#pragma unroll
                for (int n = 0; n < 2; ++n) acc[a][b][m][n] = (f32x4){0.f, 0.f, 0.f, 0.f};
    bf16x8 At[4][2], B0[2][2], B1[2][2];
    const char* cA = PG8_APTR(cur); const char* cB = PG8_BPTR(cur);
    if constexpr (GATHER) { PG8_GOFF(offC, 0); PG8_GOFF(offN, 0); }
    PG8_STAGE(PG8_SB(0, 0), cB, voffB); PG8_STAGE(PG8_SB(0, 1), cB + hstepB, voffB); PG8_STAGE_A(PG8_SA(0, 0), cA, 0, false); PG8_STAGE_A(PG8_SA(0, 1), cA, 1, false);
    if (wr == 1) PG8_BAR;
    PG8_WAIT_V(2); PG8_BAR;
    PG8_STAGE(PG8_SB(1, 0), cB + kstep, voffB); PG8_STAGE_A(PG8_SA(1, 0), cA + kstep, 0, false); PG8_STAGE(PG8_SB(1, 1), cB + hstepB + kstep, voffB);
    PG8_WAIT_V(6); PG8_BAR;
    for (;;) {
        const bool has_next = S.next(ui + 1, nxt);
        const char* nA = has_next ? PG8_APTR(nxt) : cA; const char* nB = has_next ? PG8_BPTR(nxt) : cB;
        if constexpr (GATHER) { if (has_next) { PG8_GOFF(offN, ui + 1); } else { _Pragma("unroll") for (int h_ = 0; h_ < 2; ++h_) _Pragma("unroll") for (int i_ = 0; i_ < 2; ++i_) offN[h_][i_] = offC[h_][i_]; } }
#pragma unroll 1
        for (int t = 0; t < nt; t += 2) {
            const bool last = (t == nt - 2);
            const char* a1 = cA + (size_t)(t + 1) * kstep;
            const char* a2 = last ? nA : cA + (size_t)(t + 2) * kstep; const char* b2 = last ? nB : cB + (size_t)(t + 2) * kstep;
            const char* a3 = a2 + kstep; const char* b3 = b2 + kstep;
            PG8_LDB(B0, 0, 0); PG8_LDB(B1, 0, 1); PG8_SCHED; PG8_LDA(At, 0, 0); PG8_STAGE_A(PG8_SA(1, 1), a1, 1, false);
            PG8_WAIT_V(8); PG8_WAIT_L(0); PG8_BAR; PG8_MMA(0, 0, At, B0); PG8_MMA(0, 1, At, B1); PG8_BAR; PG8_SCHED;
            PG8_LDA(At, 0, 1); PG8_STAGE(PG8_SB(0, 0), b2, voffB); PG8_STAGE(PG8_SB(0, 1), b2 + hstepB, voffB); PG8_STAGE_A(PG8_SA(0, 0), a2, 0, last);
            PG8_WAIT_V(8); PG8_WAIT_L(0); PG8_BAR; PG8_MMA(1, 0, At, B0); PG8_MMA(1, 1, At, B1); PG8_BAR; PG8_SCHED;
            PG8_LDB(B0, 1, 0); PG8_LDB(B1, 1, 1); PG8_SCHED; PG8_LDA(At, 1, 0); PG8_STAGE_A(PG8_SA(0, 1), a2, 1, last);
            PG8_WAIT_V(8); PG8_WAIT_L(0); PG8_BAR; PG8_MMA(0, 0, At, B0); PG8_MMA(0, 1, At, B1); PG8_BAR; PG8_SCHED;
            PG8_LDA(At, 1, 1); PG8_STAGE(PG8_SB(1, 0), b3, voffB); PG8_STAGE(PG8_SB(1, 1), b3 + hstepB, voffB); PG8_STAGE_A(PG8_SA(1, 0), a3, 0, last);
            PG8_WAIT_V(8); PG8_WAIT_L(0); PG8_BAR; PG8_MMA(1, 0, At, B0); PG8_MMA(1, 1, At, B1); PG8_BAR; PG8_SCHED;
        }
        if constexpr (ALIGN_EPI) { if (wr == 0) PG8_BAR; }
        unsigned ze_ = 0u; asm volatile("" : "+v"(ze_)); const int le_ = (int)__builtin_amdgcn_mbcnt_hi(~0u, __builtin_amdgcn_mbcnt_lo(~0u, ze_));
        bool fin_ = true;
        if constexpr (Epi::CHAINS) fin_ = E.is_final(cur);
        if constexpr (Epi::CHAINS) { E.rescale(acc, cur, wr, wc, le_ & 15, le_ >> 4); if (fin_) E(acc, cur, wr, wc, le_ & 15, le_ >> 4); }
        else if (!E.skip) E(acc, cur, wr, wc, le_ & 15, le_ >> 4); else { _Pragma("unroll") for (int a_ = 0; a_ < 2; ++a_) _Pragma("unroll") for (int b_ = 0; b_ < 2; ++b_) _Pragma("unroll") for (int m_ = 0; m_ < 4; ++m_) _Pragma("unroll") for (int n_ = 0; n_ < 2; ++n_) asm volatile("" :: "v"(acc[a_][b_][m_][n_])); }
        if (!has_next) break;
        if (fin_) {
#pragma unroll
        for (int a = 0; a < 2; ++a)
#pragma unroll
            for (int b = 0; b < 2; ++b)
#pragma unroll
                for (int m = 0; m < 4; ++m)
#pragma unroll
                    for (int n = 0; n < 2; ++n) acc[a][b][m][n] = (f32x4){0.f, 0.f, 0.f, 0.f};
        }
        cur = nxt; cA = nA; cB = nB; ++ui;
        if constexpr (GATHER) { _Pragma("unroll") for (int h_ = 0; h_ < 2; ++h_) _Pragma("unroll") for (int i_ = 0; i_ < 2; ++i_) offC[h_][i_] = offN[h_][i_]; }
        if constexpr (ALIGN_EPI) { if (wr == 1) PG8_BAR; }
    }
    PG8_WAIT_V(0);
    if constexpr (!ALIGN_EPI) { if (wr == 0) PG8_BAR; }
    PG8_BAR;
#undef PG8_SA
#undef PG8_SB
#undef PG8_STAGE
#undef PG8_LDA
#undef PG8_LDB
#undef PG8_MMA
#undef PG8_CAT8
#undef PG8_WAIT_V
#undef PG8_WAIT_L
#undef PG8_BAR
#undef PG8_SCHED
#undef PG8_APTR
#undef PG8_STAGE_A
#undef PG8_GOFF
#undef PG8_BPTR
}
}
constexpr int NWAVES = 8;
constexpr int NB = 4, T = 8192, D = 1024, NTOK = NB * T, DEPTH = 2;
constexpr int PROJ_LD = 3072, Q_OFF = 0, K_OFF = 512, XR_OFF = 1024, YR_OFF = 1536, G_OFF = 2048;
constexpr int GATES_LD = 3072;
constexpr int NP2 = 6144;
constexpr int NEXP = 32, XS_ROWS = 73728;
constexpr int LRU_CH = 32, LRU_NCH = T / LRU_CH;
constexpr float EPS = 1e-6f;

constexpr size_t MiB = 1u << 20;
constexpr size_t WS_CTL = 0, CTL_ZERO_BYTES = 1 * MiB;
constexpr size_t WS_MOD = 1 * MiB;
constexpr size_t WS_FA = WS_MOD + 256 * 1024;
constexpr size_t WS_FB = WS_FA + 32 * 1024;
constexpr size_t WS_TW = WS_FB + 64 * 1024;
constexpr size_t WS_WL = 2 * MiB;
constexpr size_t WS_TOKW = 3 * MiB;
constexpr size_t WS_TOKROW = WS_TOKW + 256 * 1024;
constexpr size_t WS_PERM = 4 * MiB;
constexpr size_t WS_WP2 = 20 * MiB;
constexpr size_t WS_WPROJ = 46 * MiB;
constexpr size_t WS_WOUT = 52 * MiB;
constexpr size_t WS_U = 56 * MiB;
constexpr size_t WS_VT = 120 * MiB;
constexpr size_t WS_PROJ = 152 * MiB;
constexpr size_t WS_GATES = 344 * MiB;
constexpr size_t WS_H = WS_GATES;
constexpr size_t WS_WG1 = WS_GATES + 96 * MiB, WS_WD = WS_GATES + 160 * MiB;
constexpr size_t WS_XC = 536 * MiB;
constexpr size_t WS_U8 = WS_XC;
constexpr size_t WS_XB0 = 568 * MiB, WS_XB1 = 8 * MiB;
constexpr int XB_SPLIT = 30720;
constexpr size_t WS_END = 628 * MiB;
constexpr size_t WS_SCR = WS_VT;
#ifndef REP_G
#define REP_G 0
#endif
#ifndef REP_C
#define REP_C 0
#endif
#ifndef STAG_P2
#define STAG_P2 600
#endif
#ifndef REP_DBG
#define REP_DBG 0
#endif
#ifndef REP_B
#define REP_B 0
#endif
#ifndef REP_R
#define REP_R 0
#endif
#ifndef REP_GS
#define REP_GS 31
#endif
#ifndef REP_MS
#define REP_MS 15
#endif
#ifndef REP_M
#define REP_M 0
#endif
static_assert(WS_H + (size_t)XS_ROWS * 512 * 2 <= WS_WG1 && WS_WD + 32 * MiB <= WS_XC, "ws map");
constexpr int CW_BAR = 4096;
constexpr int CW_ECNT = 16384;

constexpr int LDS_BYTES = 163840;
constexpr int RING_OFF = 0, RING_BYTES = 131072;
constexpr int XTRA_OFF = RING_BYTES;
constexpr int LDSCTL_OFF = LDS_BYTES - 512, MISC_OFF = LDSCTL_OFF + 64;

#define GAS __attribute__((address_space(1)))
#define LAS __attribute__((address_space(3)))
typedef unsigned short bf16;
typedef unsigned v4u __attribute__((ext_vector_type(4)));
typedef unsigned v2u __attribute__((ext_vector_type(2)));
typedef float f32x4 __attribute__((ext_vector_type(4)));
typedef float f32x2 __attribute__((ext_vector_type(2)));
typedef float f32x16 __attribute__((ext_vector_type(16)));
typedef short bf16x8 __attribute__((ext_vector_type(8)));
typedef short bf16x4 __attribute__((ext_vector_type(4)));
typedef GAS unsigned gu32;
#define RLX_AGENT __ATOMIC_RELAXED, __HIP_MEMORY_SCOPE_AGENT
#define LDS_WAIT() asm volatile("s_waitcnt lgkmcnt(0)" ::: "memory")
#define VM_WAIT() asm volatile("s_waitcnt vmcnt(0)" ::: "memory")
typedef __bf16 hwbf16x2 __attribute__((ext_vector_type(2)));
__device__ __forceinline__ unsigned pk2(float lo, float hi) { f32x2 v = {lo, hi}; hwbf16x2 b = __builtin_convertvector(v, hwbf16x2); return __builtin_bit_cast(unsigned, b); }
__device__ __forceinline__ unsigned pk4_fp8(float a, float b, float c, float d) { int p = __builtin_amdgcn_cvt_pk_fp8_f32(a, b, 0, false); return (unsigned)__builtin_amdgcn_cvt_pk_fp8_f32(c, d, p, true); }
__device__ __forceinline__ unsigned f2bf(float f) { return pk2(f, 0.f) & 0xffffu; }
__device__ __forceinline__ float bflo(unsigned w) { return __builtin_bit_cast(float, w << 16); }
__device__ __forceinline__ float bfhi(unsigned w) { return __builtin_bit_cast(float, w & 0xffff0000u); }
__device__ __forceinline__ float bf2f(unsigned short h) { return __builtin_bit_cast(float, (unsigned)h << 16); }
__device__ __forceinline__ float sigmoidf(float v) { return 1.0f / (1.0f + __expf(-v)); }
__device__ __forceinline__ float fsigmoid(float v) { return __builtin_amdgcn_rcpf(1.0f + __expf(-v)); }
#define PIN4(a) asm volatile("" : "+v"(a[0]), "+v"(a[1]), "+v"(a[2]), "+v"(a[3]))
#define PIN8(a) asm volatile("" : "+v"(a[0]), "+v"(a[1]), "+v"(a[2]), "+v"(a[3]), "+v"(a[4]), "+v"(a[5]), "+v"(a[6]), "+v"(a[7]))
__device__ __forceinline__ float wave_sum(float v) {
#pragma unroll
    for (int o = 1; o < 64; o <<= 1) v += __shfl_xor(v, o);
    return v;
}
#define XB_TMO      128
#define XB_XCNT(j)  (256  + 64 * (j))
#define XB_XSUB(j)  (1280 + 64 * (j))
#define XB_XGEN(j)  (2304 + 64 * (j))
#define XB_TOP      3328
#define XB_TOPGEN   3392
#define XCD_BAR_WORDS 3456
#define XB_SPIN_CAP (1u << 18)

__device__ __forceinline__ unsigned xb_ld(unsigned* p)              { return __hip_atomic_load(p, __ATOMIC_RELAXED, __HIP_MEMORY_SCOPE_AGENT); }
__device__ __forceinline__ unsigned xb_add(unsigned* p, unsigned v) { return __hip_atomic_fetch_add(p, v, __ATOMIC_RELAXED, __HIP_MEMORY_SCOPE_AGENT); }
__device__ __forceinline__ unsigned xb_xcc_id() { return (unsigned)__builtin_amdgcn_s_getreg((3 << 11) | 20) & 0xFu; }
#define XB_SPIN(cond, bar) do { unsigned _sp = 0; while (cond) { __builtin_amdgcn_s_sleep(1); \
    if ((++_sp & 255u) == 0u) { if (xb_ld(&(bar)[XB_TMO])) break; if (_sp > XB_SPIN_CAP) { atomicAdd(&(bar)[XB_TMO], 1u); break; } } } } while (0)

struct XcdBarrier {
    unsigned* bar; unsigned x;
    int wave;
    volatile LAS unsigned* st;
};

__device__ __forceinline__ XcdBarrier xcd_barrier_post(unsigned* bar, volatile LAS unsigned* st) {
    XcdBarrier b; b.bar = bar; b.x = xb_xcc_id(); b.st = st; b.wave = __builtin_amdgcn_readfirstlane((int)threadIdx.x >> 6);
    if (threadIdx.x == 0) (void)xb_add(&bar[XB_XCNT(b.x)], 1u);
    return b;
}
__device__ __forceinline__ void xcd_barrier_complete(unsigned* bar, unsigned x, unsigned& nloc, unsigned& nx) {
    const unsigned G = gridDim.x * gridDim.y * gridDim.z;
    unsigned sum, cnt, mine, sp = 0u;
    for (;;) {
        sum = 0u; cnt = 0u; mine = 0u;
#pragma unroll
        for (unsigned j = 0; j < 16; ++j) { const unsigned c = xb_ld(&bar[XB_XCNT(j)]); sum += c; cnt += (c > 0u) ? 1u : 0u; mine = (j == x) ? c : mine; }
        if (sum == G) break;
        __builtin_amdgcn_s_sleep(1);
        if ((++sp & 255u) == 0u) { if (xb_ld(&bar[XB_TMO])) break; if (sp > XB_SPIN_CAP) { atomicAdd(&bar[XB_TMO], 1u); break; } }
    }
    nloc = mine > 0u ? mine : 1u; nx = cnt > 0u ? cnt : 1u;
}

__device__ __forceinline__ void xcd_barrier(const XcdBarrier& b) {
    asm volatile("s_waitcnt vmcnt(0)" ::: "memory");
    __syncthreads();
    unsigned z_ = 0u; asm volatile("" : "+v"(z_));
    if (b.wave == 0 && __builtin_amdgcn_mbcnt_hi(~0u, __builtin_amdgcn_mbcnt_lo(~0u, z_)) == 0u) {
        unsigned* bar = b.bar;
        __builtin_amdgcn_s_waitcnt(0);
        unsigned nloc = b.st[0], nx = b.st[1];
        if (nloc == 0u) { xcd_barrier_complete(bar, b.x, nloc, nx); b.st[0] = nloc; b.st[1] = nx; }
        const unsigned old = xb_add(&bar[XB_XSUB(b.x)], 1u);
        const unsigned gen = old / nloc;
        if (old + 1u == (gen + 1u) * nloc) {
            __builtin_amdgcn_fence(__ATOMIC_RELEASE, "agent");
            asm volatile("s_waitcnt vmcnt(0)" ::: "memory");
            const unsigned og = xb_add(&bar[XB_TOP], 1u);
            const unsigned tg = og / nx;
            if (og + 1u == (tg + 1u) * nx) xb_add(&bar[XB_TOPGEN], 1u);
            else XB_SPIN(xb_ld(&bar[XB_TOPGEN]) == tg, bar);
            __builtin_amdgcn_fence(__ATOMIC_ACQUIRE, "agent");
            xb_add(&bar[XB_XGEN(b.x)], 1u);
            asm volatile("s_waitcnt vmcnt(0)" ::: "memory");
        } else {
            XB_SPIN(xb_ld(&bar[XB_XGEN(b.x)]) == gen, bar);
            __builtin_amdgcn_fence(__ATOMIC_ACQUIRE, "agent");
            asm volatile("s_waitcnt vmcnt(0)" ::: "memory");
        }
    }
    __syncthreads();
}

struct Args { const float* in[27]; float* out; unsigned char* ws; int ph_lo, ph_hi; };
struct Frame {
    LAS unsigned char* lds;
    volatile LAS unsigned* MISC;
    gu32* ctl;
    int tid, lane, wave, vcu, G;
};
__device__ __forceinline__ Frame fresh(const Frame& F) {
    Frame N = F; int w = F.wave; asm volatile("" : "+s"(w)); unsigned z = 0u; asm volatile("" : "+v"(z));
    const int ln = (int)__builtin_amdgcn_mbcnt_hi(~0u, __builtin_amdgcn_mbcnt_lo(~0u, z)); N.tid = w * 64 + ln; N.lane = ln; N.wave = w;
    int v = F.vcu; asm volatile("" : "+s"(v)); N.vcu = v; int g = F.G; asm volatile("" : "+s"(g)); N.G = g; return N;
}
#define WSP(T_, off) ((T_*)(args.ws + (off)))
#define XBROW(m) ((bf16*)(args.ws + ((m) < XB_SPLIT ? WS_XB0 + (size_t)(m) * 2048 : WS_XB1 + (size_t)((m) - XB_SPLIT) * 2048)))
#define INP(i) (args.in[i])

struct TrItem { const float* W; int ldw, k0, n0; bf16* dst; int ldd; };
__device__ __forceinline__ void tr_load(const TrItem& it, f32x4 (&v)[8], int lane) {
    const float* p = it.W + (size_t)(it.k0 + (lane >> 3)) * it.ldw + it.n0 + 4 * (lane & 7);
#pragma unroll
    for (int i = 0; i < 8; ++i) v[i] = *(const f32x4*)(p + (size_t)(8 * i) * it.ldw);
}
__device__ __forceinline__ void tr_finish(const TrItem& it, f32x4 (&v)[8], LAS float* scr, int lane) {
    PIN8(v);
#pragma unroll
    for (int i = 0; i < 8; ++i) { LAS float* d = scr + (8 * i + (lane >> 3)) * 33 + 4 * (lane & 7); d[0] = v[i].x; d[1] = v[i].y; d[2] = v[i].z; d[3] = v[i].w; }
    LDS_WAIT(); asm volatile("" ::: "memory");
    const int c = lane & 7;
#pragma unroll
    for (int j = 0; j < 4; ++j) { const int n = (lane >> 3) + 8 * j; const LAS float* s = scr + (8 * c) * 33 + n;
        v4u o; o.x = pk2(s[0 * 33], s[1 * 33]); o.y = pk2(s[2 * 33], s[3 * 33]); o.z = pk2(s[4 * 33], s[5 * 33]); o.w = pk2(s[6 * 33], s[7 * 33]);
        *(v4u*)(it.dst + (size_t)n * it.ldd + it.k0 + 8 * c) = o; }
    LDS_WAIT(); asm volatile("" ::: "memory");
}
__device__ __forceinline__ void transpose_item_fp8(const float* W, int ldw, int k0, int n0, unsigned char* dst8, LAS float* scr, int lane) {
    const TrItem it{W, ldw, k0, n0, nullptr, 0}; f32x4 v[8]; tr_load(it, v, lane);
    PIN8(v);
#pragma unroll
    for (int i = 0; i < 8; ++i) { LAS float* d = scr + (8 * i + (lane >> 3)) * 33 + 4 * (lane & 7); d[0] = v[i].x; d[1] = v[i].y; d[2] = v[i].z; d[3] = v[i].w; }
    LDS_WAIT(); asm volatile("" ::: "memory");
    const int c = lane & 7;
#pragma unroll
    for (int j = 0; j < 4; ++j) { const int n = (lane >> 3) + 8 * j; const LAS float* s = scr + (8 * c) * 33 + n;
        *(v2u*)(dst8 + (size_t)n * 1024 + k0 + 8 * c) = (v2u){pk4_fp8(64.f * s[0 * 33], 64.f * s[1 * 33], 64.f * s[2 * 33], 64.f * s[3 * 33]), pk4_fp8(64.f * s[4 * 33], 64.f * s[5 * 33], 64.f * s[6 * 33], 64.f * s[7 * 33])}; }
    LDS_WAIT(); asm volatile("" ::: "memory");
}
__device__ __forceinline__ void transpose_item(const float* W, int ldw, int k0, int n0, bf16* dst, int ldd, LAS float* scr, int lane) {
    const TrItem it{W, ldw, k0, n0, dst, ldd}; f32x4 v[8]; tr_load(it, v, lane); tr_finish(it, v, scr, lane);
}
__device__ __forceinline__ void p0_prologue(const Frame& F0, const Args& args) {
    const Frame F = fresh(F0);
    const int tid = F.tid, lane = F.lane, wave = F.wave;
    float* MOD = WSP(float, WS_MOD);
    {
        LAS f32x4* cact4 = (LAS f32x4*)(F.lds + RING_OFF);
        LAS float* red = (LAS float*)(F.lds + RING_OFF + 16384);
        if (F.vcu < 192) {
            const float* c = INP(1);
#pragma unroll
            for (int i = 0; i < 8; ++i) { const int idx = tid + 512 * i, b = idx >> 10, k = idx & 1023; const float v = c[b * 1024 + k]; ((LAS float*)cact4)[k * 4 + b] = v * sigmoidf(v); }
        }
        __syncthreads();
        for (int u = F.vcu; u < 192; u += F.G) {
            const int l = u / 96, j0 = (u % 96) * 64;
            const float* aw = INP(2) + (size_t)l * 1024 * 6144 + j0 + lane;
            float a0 = 0.f, a1 = 0.f, a2 = 0.f, a3 = 0.f;
#pragma unroll 32
            for (int kk = 0; kk < 128; ++kk) { const int k = 128 * wave + kk; const float wv = aw[(size_t)k * 6144]; const f32x4 c4 = cact4[k]; a0 += c4.x * wv; a1 += c4.y * wv; a2 += c4.z * wv; a3 += c4.w * wv; }
            red[(wave * 4 + 0) * 64 + lane] = a0; red[(wave * 4 + 1) * 64 + lane] = a1; red[(wave * 4 + 2) * 64 + lane] = a2; red[(wave * 4 + 3) * 64 + lane] = a3;
            __syncthreads();
            if (tid < 256) { const int b = tid >> 6, ln = tid & 63; float s = INP(3)[l * 6144 + j0 + ln];
#pragma unroll
                for (int w = 0; w < 8; ++w) s += red[(w * 4 + b) * 64 + ln];
                MOD[(size_t)(l * 4 + b) * 6144 + j0 + ln] = s; }
            __syncthreads();
        }
    }
    {
        LAS float* Tt = (LAS float*)(F.lds + RING_OFF);
        LAS float* cs = (LAS float*)(F.lds + RING_OFF + 33792);
        LAS float* sn = cs + 128;
        if (tid < 128) { cs[tid] = cospif((float)tid * (1.0f / 64.0f)); sn[tid] = sinpif((float)tid * (1.0f / 64.0f)); }
        for (int it = F.G - 1 - F.vcu; it < 256; it += F.G) {
            const int l = it >> 7, g = (it >> 5) & 3, k0 = (it & 31) * 32;
            const float* src = INP(6) + (size_t)l * 1024 * 3072 + 2560 + g * 128;
            __syncthreads();
            { float tv[8];
#pragma unroll
                for (int i = 0; i < 8; ++i) { const int idx = tid + 512 * i, row = idx >> 7, cc = idx & 127; tv[i] = src[(size_t)(k0 + row) * 3072 + cc]; }
                PIN8(tv);
#pragma unroll
                for (int i = 0; i < 8; ++i) { const int idx = tid + 512 * i, row = idx >> 7, cc = idx & 127; Tt[row * 129 + cc] = tv[i]; } }
            __syncthreads();
            const int kk = tid & 31, og = tid >> 5, part = og >> 3, m0 = (og & 7) * 8;
            float acc[8]; float ny = 0.f;
#pragma unroll
            for (int i = 0; i < 8; ++i) acc[i] = 0.f;
            const LAS float* tab = part ? sn : cs;
#pragma unroll 2
            for (int cc = 0; cc < 128; ++cc) { const float t = Tt[kk * 129 + cc]; ny += (cc & 1) ? -t : t;
#pragma unroll
                for (int i = 0; i < 8; ++i) acc[i] += t * tab[((m0 + i) * cc) & 127]; }
            bf16* dst = WSP(bf16, WS_WP2) + (size_t)l * NP2 * 1024 + (size_t)(2560 + part * 256 + g * 64 + m0) * 1024 + k0 + kk;
            const float sg = part ? -1.f : 1.f;
#pragma unroll
            for (int i = 0; i < 8; ++i) dst[(size_t)i * 1024] = (bf16)f2bf((i == 0 && part == 1 && m0 == 0) ? ny : sg * acc[i]);
        }
        __syncthreads();
    }
    {
        LAS float* scr = (LAS float*)(F.lds + RING_OFF + wave * 8704);
        const int gw = F.vcu * NWAVES + wave, NGW = F.G * NWAVES;
        for (int it = gw; it < 8192; it += NGW) {
            const int l = it >> 12; int r = it & 4095;
            if (r < 1280) { const int kb = r / 80, nb = r % 80; transpose_item(INP(6) + (size_t)l * 1024 * 3072, 3072, kb * 64, nb * 32, WSP(bf16, WS_WP2) + (size_t)l * NP2 * 1024 + (size_t)(nb * 32) * 1024, 1024, scr, lane); continue; }
            r -= 1280;
            if (r < 1536) { const int kb = r / 96, nb = r % 96; transpose_item_fp8(INP(7) + (size_t)l * 1024 * 3072, 3072, kb * 64, nb * 32, (unsigned char*)(WSP(bf16, WS_WP2) + (size_t)l * NP2 * 1024 + (size_t)3072 * 1024) + (size_t)(nb * 32) * 1024, scr, lane); continue; }
            r -= 1536;
            if (r < 768) { const int which = r >> 8, rr = r & 255, kb = rr >> 5, nb = rr & 31; const float* src = (which == 0 ? INP(17) : (which == 1 ? INP(18) : INP(19))) + (size_t)l * 512 * 1024;
                transpose_item(src, 1024, kb * 64, nb * 32, WSP(bf16, WS_WPROJ) + (size_t)(l * 3 + which) * 1024 * 512 + (size_t)(nb * 32) * 512, 512, scr, lane); continue; }
            r -= 768;
            { const int kb = r >> 5, nb = r & 31; transpose_item(INP(20) + (size_t)l * 1024 * 1024, 1024, kb * 64, nb * 32, WSP(bf16, WS_WOUT) + (size_t)l * 1024 * 1024 + (size_t)(nb * 32) * 1024, 1024, scr, lane); }
        }
    }
    {
        const int gt = F.vcu * 512 + tid, NGT = F.G * 512;
        bf16* WL = WSP(bf16, WS_WL);
        for (int idx = gt; idx < 262144; idx += NGT) {
            const int k = idx & 63, n = (idx >> 6) & 255, nb = (idx >> 14) & 7, l = idx >> 17, gate = n >> 6, j = n & 63, dir = gate >> 1, isI = gate & 1;
            const float* src = isI ? INP(14) : INP(12);
            WL[idx] = (bf16)f2bf(src[((size_t)((l * 2 + dir) * 8 + nb) * 64 + k) * 64 + j]);
        }
        bf16* FA = WSP(bf16, WS_FA);
        for (int idx = gt; idx < 16384; idx += NGT) {
            const int m = idx >> 7, k = idx & 127, k1 = m & 63, pm_ = m >> 6, t1 = k & 63, pk = k >> 6, a = (k1 * t1) & 63;
            const float c = cospif((float)a * (1.0f / 32.0f)), s = sinpif((float)a * (1.0f / 32.0f));
            FA[idx] = (bf16)f2bf(pm_ == 0 ? (pk == 0 ? c : s) : (pk == 0 ? -s : c));
        }
        bf16* FB = WSP(bf16, WS_FB);
        for (int idx = gt; idx < 32768; idx += NGT) {
            const int k2 = idx >> 8, k = idx & 255, part = k >> 7, t2 = k & 127, a = (k2 * t2) & 127;
            FB[idx] = (bf16)f2bf(part == 0 ? cospif((float)a * (1.0f / 64.0f)) : sinpif((float)a * (1.0f / 64.0f)));
        }
        f32x2* TW = WSP(f32x2, WS_TW);
        for (int idx = gt; idx < 8192; idx += NGT) {
            const int t2 = idx >> 6, k1 = idx & 63; const float x = (float)(t2 * k1) * (1.0f / 4096.0f);
            TW[idx] = (f32x2){cospif(x), sinpif(x)};
        }
    }
}

__device__ __forceinline__ void moe_tilebase(const Frame& F0, const Args& args, int l);
template <int MODE>
__device__ __forceinline__ void rows_phase(const Frame& F0, const Args& args, int l) {
    const Frame F = fresh(F0);
    const int tid = F.tid, lane = F.lane, wave = F.wave;
    const float* MOD = WSP(float, WS_MOD);
    LAS float* gsc = (LAS float*)(F.lds + RING_OFF);
    LAS float* shf = gsc + 4096;
    LAS float* gtf = shf + 4096;
    if (MODE != 0) moe_tilebase(F, args, l - 1);
    { float tg[8], ts[8], tf[8];
#pragma unroll
        for (int i = 0; i < 8; ++i) { const int idx = tid + 512 * i, b = idx >> 10, col = idx & 1023; tg[i] = 0.f; ts[i] = 0.f; tf[i] = 0.f;
            if (MODE != 2) { tg[i] = INP(4)[l * 1024 + col] * (1.0f + MOD[(size_t)(l * 4 + b) * 6144 + 1024 + col]); ts[i] = MOD[(size_t)(l * 4 + b) * 6144 + col]; }
            else tg[i] = INP(26)[col];
            if (MODE != 0) tf[i] = MOD[(size_t)((l - 1) * 4 + b) * 6144 + 5 * 1024 + col]; }
        PIN8(tg); PIN8(ts); PIN8(tf);
#pragma unroll
        for (int i = 0; i < 8; ++i) { const int idx = tid + 512 * i; gsc[idx] = tg[i]; if (MODE != 2) shf[idx] = ts[i]; if (MODE != 0) gtf[idx] = tf[i]; } }
    __syncthreads();
    bf16* U = WSP(bf16, WS_U);
    const bf16* YE = WSP(bf16, WS_PROJ);
    const int* tokes = WSP(int, WS_TOKROW); const float* tokw = WSP(float, WS_TOKW);
    const int gw = F.vcu * NWAVES + wave, NGW = F.G * NWAVES;
    for (int m0 = gw; m0 < NTOK; m0 += 2 * NGW) {
        f32x4 v[2][4]; v2u ya[2][4], yc[2][4]; float w0[2], w1[2];
#pragma unroll
        for (int q = 0; q < 2; ++q) { const int m = m0 + q * NGW;
            if (MODE == 0) { const f32x4* xr = (const f32x4*)(INP(0) + (size_t)m * D) + lane;
#pragma unroll
                for (int j = 0; j < 4; ++j) v[q][j] = xr[64 * j]; }
            else { const v2u* xr = (const v2u*)XBROW(m) + lane;
#pragma unroll
                for (int j = 0; j < 4; ++j) { const v2u t = xr[64 * j]; v[q][j] = (f32x4){bflo(t.x), bfhi(t.x), bflo(t.y), bfhi(t.y)}; } }
            if (MODE != 0) { const int es0 = tokes[2 * m], es1 = tokes[2 * m + 1]; const int r0 = 256 * (int)F.MISC[16 + (es0 >> 16)] + (es0 & 0xffff), r1 = 256 * (int)F.MISC[16 + (es1 >> 16)] + (es1 & 0xffff); w0[q] = tokw[2 * m]; w1[q] = tokw[2 * m + 1];
                const v2u* y0 = (const v2u*)(YE + (size_t)r0 * 1024) + lane; const v2u* y1 = (const v2u*)(YE + (size_t)r1 * 1024) + lane;
#pragma unroll
                for (int j = 0; j < 4; ++j) { ya[q][j] = y0[64 * j]; yc[q][j] = y1[64 * j]; } } }
#pragma unroll
        for (int q = 0; q < 2; ++q) { const int m = m0 + q * NGW, b = m >> 13;
            if (MODE != 0) {
#pragma unroll
                for (int j = 0; j < 4; ++j) { const v2u a = ya[q][j], c = yc[q][j]; const f32x4 g = *(const LAS f32x4*)(gtf + b * 1024 + 4 * lane + 256 * j);
                    v[q][j].x += g.x * (w0[q] * bflo(a.x) + w1[q] * bflo(c.x)); v[q][j].y += g.y * (w0[q] * bfhi(a.x) + w1[q] * bfhi(c.x));
                    v[q][j].z += g.z * (w0[q] * bflo(a.y) + w1[q] * bflo(c.y)); v[q][j].w += g.w * (w0[q] * bfhi(a.y) + w1[q] * bfhi(c.y)); }
            }
            float ss = 0.f;
#pragma unroll
            for (int j = 0; j < 4; ++j) ss += (v[q][j].x * v[q][j].x + v[q][j].y * v[q][j].y) + (v[q][j].z * v[q][j].z + v[q][j].w * v[q][j].w);
            const float rstd = 1.0f / sqrtf(wave_sum(ss) * (1.0f / D) + EPS);
            if (MODE == 2) {
                f32x4* o = (f32x4*)(args.out + (size_t)m * D) + lane;
#pragma unroll
                for (int j = 0; j < 4; ++j) { const f32x4 g = *(const LAS f32x4*)(gsc + 4 * lane + 256 * j); o[64 * j] = v[q][j] * rstd * g; }
            } else {
                if (MODE == 1) { v2u* o = (v2u*)XBROW(m) + lane;
#pragma unroll
                    for (int j = 0; j < 4; ++j) o[64 * j] = (v2u){pk2(v[q][j].x, v[q][j].y), pk2(v[q][j].z, v[q][j].w)}; }
                v2u* uo = (v2u*)(U + (size_t)m * D) + lane; unsigned* u8o = (unsigned*)(args.ws + WS_U8 + (size_t)m * D) + lane;
#pragma unroll
                for (int j = 0; j < 4; ++j) { const f32x4 g = *(const LAS f32x4*)(gsc + b * 1024 + 4 * lane + 256 * j), s = *(const LAS f32x4*)(shf + b * 1024 + 4 * lane + 256 * j);
                    const f32x4 u = v[q][j] * rstd * g + s; uo[64 * j] = (v2u){pk2(u.x, u.y), pk2(u.z, u.w)}; u8o[64 * j] = pk4_fp8(u.x, u.y, u.z, u.w); }
            }
        }
    }
}

#define P2ST(ptr, val) do { const v4u v__ = (val); if (nostore) { if (win) *(v4u*)(win + ((size_t)(ptr) & 0x1FFF0)) = v__; else asm volatile("" :: "v"(v__)); } else *(v4u*)(ptr) = v__; } while (0)
struct EpiP2 {
    bool skip = false; bool nostore = false; char* win = nullptr;
    static constexpr bool PERM = true; static constexpr bool CHAINS = false;
    bf16* proj; bf16* vt;
    __device__ __forceinline__ void operator()(const f32x4 (&acc)[2][2][4][2], const pg8::Unit& u, int wr, int wc, int fr, int fq) const {
        const int row0 = u.pm * 256 + wr * 64 + fr, pn = u.pn;
        if (pn == 4 || pn == 5) {
#pragma unroll
            for (int ai = 0; ai < 2; ++ai)
#pragma unroll
                for (int m = 0; m < 4; ++m) { const int row = row0 + ai * 128 + m * 16, b = row >> 13, t = row & 8191;
#pragma unroll
                    for (int bj = 0; bj < 2; ++bj)
#pragma unroll
                        for (int n = 0; n < 2; ++n) { const int col = (pn - 4) * 256 + bj * 128 + wc * 32 + 8 * fq + 4 * n; bf16* d = vt + ((size_t)(b * 512 + col)) * 8192 + t;
                            d[0] = (bf16)f2bf(acc[ai][bj][m][n][0]); d[8192] = (bf16)f2bf(acc[ai][bj][m][n][1]); d[2 * 8192] = (bf16)f2bf(acc[ai][bj][m][n][2]); d[3 * 8192] = (bf16)f2bf(acc[ai][bj][m][n][3]); } }
        } else {
            const int cbase = (pn < 4 ? pn * 256 : (pn - 2) * 256) + wc * 32 + 8 * fq; const float sc = pn < 2 ? 0.125f : 1.0f;
#pragma unroll
            for (int ai = 0; ai < 2; ++ai)
#pragma unroll
                for (int m = 0; m < 4; ++m) { bf16* rowp = proj + (size_t)(row0 + ai * 128 + m * 16) * PROJ_LD + cbase;
#pragma unroll
                    for (int bj = 0; bj < 2; ++bj) { const f32x4 v0 = acc[ai][bj][m][0] * sc, v1 = acc[ai][bj][m][1] * sc;
                        P2ST(rowp + bj * 128, ((v4u){pk2(v0[0], v0[1]), pk2(v0[2], v0[3]), pk2(v1[0], v1[1]), pk2(v1[2], v1[3])})); } }
        }
    }
};
struct EpiGates {
    bool skip = false;
    static constexpr bool PERM = true; static constexpr bool CHAINS = false;
    bf16* gates; const float* gbias;
    __device__ __forceinline__ void operator()(const f32x4 (&acc)[2][2][4][2], const pg8::Unit& u, int wr, int wc, int fr, int fq) const {
        {
            const int pn = u.pn;
            int fr_ = fr, fq_ = fq; asm volatile("" : "+v"(fr_), "+v"(fq_));
            const int cbase = pn * 256 + wc * 32 + 8 * fq_;
            f32x4 bv[2][2];
#pragma unroll
            for (int bj = 0; bj < 2; ++bj)
#pragma unroll
                for (int n = 0; n < 2; ++n) bv[bj][n] = *(const f32x4*)(gbias + cbase + bj * 128 + 4 * n) * (-1.4426950408889634f);
            const unsigned to8 = (unsigned)(((wr * 4 + wc) * 64 + fq_ * 16 + fr_) * 8);
            unsigned char* blob = (unsigned char*)gates + (size_t)(u.pm * 12 + pn) * 65536 + to8;
#pragma unroll
            for (int ai = 0; ai < 2; ++ai)
#pragma unroll
                for (int m = 0; m < 4; ++m)
#pragma unroll
                    for (int bj = 0; bj < 2; ++bj) {
                        unsigned w0 = 0u, w1 = 0u;
#pragma unroll
                        for (int e = 0; e < 4; ++e) {
                            const float t0 = __builtin_fmaf(acc[ai][bj][m][0][e], -1.4426950408889634f / 64.0f, bv[bj][0][e]), t1 = __builtin_fmaf(acc[ai][bj][m][1][e], -1.4426950408889634f / 64.0f, bv[bj][1][e]);
                            const float s0 = __builtin_amdgcn_rcpf(__builtin_fmaf(__builtin_amdgcn_exp2f(t0), 1.0f / 255.0f, 1.0f / 255.0f)), s1 = __builtin_amdgcn_rcpf(__builtin_fmaf(__builtin_amdgcn_exp2f(t1), 1.0f / 255.0f, 1.0f / 255.0f));
                            w0 = __builtin_amdgcn_cvt_pk_u8_f32(fmaxf(s0, 1.0f), e, w0); w1 = __builtin_amdgcn_cvt_pk_u8_f32(fmaxf(s1, 1.0f), e, w1); }
                        const v2u w = (v2u){w0, w1};
                        *(v2u*)(blob + ((ai * 4 + m) * 2 + bj) * 4096) = w; }
        }
    }
};
struct EpiMerge {
    bool skip = false;
    static constexpr bool PERM = true; static constexpr bool CHAINS = true;
    const bf16* gates; bf16* merged; const LAS float* rtab;
    __device__ __forceinline__ bool is_final(const pg8::Unit& u) const { return u.z == 2; }
    __device__ __forceinline__ void rescale(f32x4 (&acc)[2][2][4][2], const pg8::Unit& u, int wr, int wc, int fr, int fq) const {
        const int tid = (wr * 4 + wc) * 64 + fq * 16 + fr; const bool fin = u.z == 2;
        const char* gb0 = (const char*)gates + (size_t)(u.pm * 12 + u.z * 4 + u.pn) * 65536 + tid * 8; const char* gb1 = gb0 + 4 * 65536;
#pragma unroll
        for (int hb4 = 0; hb4 < 4; ++hb4) {
            v2u ga[4], gn[4]; unsigned pcb = hb4 * 4 * 4096; asm volatile("" : "+v"(pcb));
#pragma unroll
            for (int p = 0; p < 4; ++p) { ga[p] = *(const v2u*)(gb0 + pcb + p * 4096); gn[p] = *(const v2u*)(gb1 + pcb + p * 4096); }
#pragma unroll
            for (int p = 0; p < 4; ++p) { const int pi = hb4 * 4 + p, ai = pi >> 3, m = (pi >> 1) & 3, bj = pi & 1;
#pragma unroll
                for (int n = 0; n < 2; ++n) { const unsigned wa = n ? ga[p].y : ga[p].x, wn = fin ? 0xffffffffu : (n ? gn[p].y : gn[p].x);
#pragma unroll
                    for (int e = 0; e < 4; ++e) acc[ai][bj][m][n][e] *= (float)((wa >> (8 * e)) & 0xffu) * rtab[(wn >> (8 * e)) & 0xffu]; } }
            asm volatile("" ::: "memory");
        }
    }
    __device__ __forceinline__ void operator()(const f32x4 (&acc)[2][2][4][2], const pg8::Unit& u, int wr, int wc, int fr, int fq) const {
        const int row0 = u.pm * 256 + wr * 64 + fr, cbase = u.pn * 256 + wc * 32 + 8 * fq;
#pragma unroll
        for (int ai = 0; ai < 2; ++ai)
#pragma unroll
            for (int m = 0; m < 4; ++m) { bf16* rowp = merged + (size_t)(row0 + ai * 128 + m * 16) * 1024 + cbase;
#pragma unroll
                for (int bj = 0; bj < 2; ++bj) { const f32x4 v0 = acc[ai][bj][m][0], v1 = acc[ai][bj][m][1];
                    *(v4u*)(rowp + bj * 128) = (v4u){pk2(v0[0], v0[1]), pk2(v0[2], v0[3]), pk2(v1[0], v1[1]), pk2(v1[2], v1[3])}; } }
    }
};
template <bool F32IN>
struct EpiResid {
    bool skip = false;
    static constexpr bool PERM = true; static constexpr bool CHAINS = false;
    const float* xin32; bf16* xb0; bf16* xb1; const float* gt;
    __device__ __forceinline__ void operator()(const f32x4 (&acc)[2][2][4][2], const pg8::Unit& u, int wr, int wc, int fr, int fq) const {
        const int rt = u.pm * 256, row0 = rt + wr * 64 + fr, cbase = u.pn * 256 + wc * 32 + 8 * fq, b = rt >> 13;
        bf16* xb = (rt < XB_SPLIT) ? xb0 + (size_t)row0 * 1024 : xb1 + (size_t)(row0 - XB_SPLIT) * 1024;
        const float* xf = xin32 + (size_t)row0 * 1024;
        f32x4 gv[2][2];
#pragma unroll
        for (int bj = 0; bj < 2; ++bj)
#pragma unroll
            for (int n = 0; n < 2; ++n) gv[bj][n] = *(const f32x4*)(gt + (size_t)b * 6144 + cbase + bj * 128 + 4 * n);
#pragma unroll
        for (int hb4 = 0; hb4 < 4; ++hb4) {
            unsigned rob = (unsigned)((hb4 >> 1) * 128 + (hb4 & 1) * 32) * 1024u + (unsigned)cbase; asm volatile("" : "+v"(rob));
            f32x4 x0[4], x1[4];
#pragma unroll
            for (int p = 0; p < 4; ++p) { const unsigned ro = rob + (unsigned)((p >> 1) * 16 * 1024 + (p & 1) * 128);
                if (F32IN) { x0[p] = *(const f32x4*)(xf + ro); x1[p] = *(const f32x4*)(xf + ro + 4); }
                else { const v4u t = *(const v4u*)(xb + ro); x0[p] = (f32x4){bflo(t.x), bfhi(t.x), bflo(t.y), bfhi(t.y)}; x1[p] = (f32x4){bflo(t.z), bfhi(t.z), bflo(t.w), bfhi(t.w)}; } }
#pragma unroll
            for (int p = 0; p < 4; ++p) { const int ai = hb4 >> 1, m = (hb4 & 1) * 2 + (p >> 1), bj = p & 1; const unsigned ro = rob + (unsigned)((p >> 1) * 16 * 1024 + (p & 1) * 128);
                const f32x4 y0 = x0[p] + gv[bj][0] * acc[ai][bj][m][0], y1 = x1[p] + gv[bj][1] * acc[ai][bj][m][1];
                *(v4u*)(xb + ro) = (v4u){pk2(y0[0], y0[1]), pk2(y0[2], y0[3]), pk2(y1[0], y1[1]), pk2(y1[2], y1[3])}; }
            asm volatile("" ::: "memory");
        }
    }
};
struct EpiSwiGLU {
    bool skip = false;
    static constexpr bool PERM = true; static constexpr bool CHAINS = false;
    bf16* H;
    __device__ __forceinline__ void operator()(const f32x4 (&acc)[2][2][4][2], const pg8::Unit& u, int wr, int wc, int fr, int fq) const {
        const int row0 = u.pm * 256 + wr * 64 + fr, cbase = u.pn * 128 + wc * 32 + 8 * fq;
#pragma unroll
        for (int ai = 0; ai < 2; ++ai)
#pragma unroll
            for (int m = 0; m < 4; ++m) { f32x4 h0, h1;
#pragma unroll
                for (int e = 0; e < 4; ++e) { const float g0 = acc[ai][0][m][0][e], g1 = acc[ai][0][m][1][e]; h0[e] = g0 * sigmoidf(g0) * acc[ai][1][m][0][e]; h1[e] = g1 * sigmoidf(g1) * acc[ai][1][m][1][e]; }
                *(v4u*)(H + (size_t)(row0 + ai * 128 + m * 16) * 512 + cbase) = (v4u){pk2(h0[0], h0[1]), pk2(h0[2], h0[3]), pk2(h1[0], h1[1]), pk2(h1[2], h1[3])}; }
    }
};
struct EpiYE {
    bool skip = false;
    static constexpr bool PERM = true; static constexpr bool CHAINS = false;
    bf16* YE;
    __device__ __forceinline__ void operator()(const f32x4 (&acc)[2][2][4][2], const pg8::Unit& u, int wr, int wc, int fr, int fq) const {
        const int row0 = u.pm * 256 + wr * 64 + fr, cbase = u.pn * 256 + wc * 32 + 8 * fq;
#pragma unroll
        for (int ai = 0; ai < 2; ++ai)
#pragma unroll
            for (int m = 0; m < 4; ++m) { bf16* rowp = YE + (size_t)(row0 + ai * 128 + m * 16) * 1024 + cbase;
#pragma unroll
                for (int bj = 0; bj < 2; ++bj) { const f32x4 v0 = acc[ai][bj][m][0], v1 = acc[ai][bj][m][1];
                    *(v4u*)(rowp + bj * 128) = (v4u){pk2(v0[0], v0[1]), pk2(v0[2], v0[3]), pk2(v1[0], v1[1]), pk2(v1[2], v1[3])}; } }
    }
};

__device__ __forceinline__ void attn_unit(bf16* PROJ, const bf16* VT, const LAS float* rpb, int b, int h, int r, int qb, int lane, bf16* obase, int opitch) {
    const int qn = lane & 15, g = lane >> 4;
    const int rs = min(max(r - 4, 0), 120);
    const int cb = (qb == 0) ? 0 : ((qb == 1) ? 8 : ((qb == 2) ? 24 : 32));
    const int w = 16 * qb + qn, cs = min(max(w - 8, 0), 48);
    const size_t tokq = (size_t)b * T + r * 64 + w;
    bf16* qp = PROJ + tokq * PROJ_LD + Q_OFF + h * 64;
    bf16x8 qf0 = *(const bf16x8*)(qp + 8 * g), qf1 = *(const bf16x8*)(qp + 32 + 8 * g);
    const bf16* kbase = PROJ + ((size_t)b * T + rs * 64 + cb + qn) * PROJ_LD + K_OFF + h * 64 + 8 * g;
    f32x4 sc[16];
#pragma unroll
    for (int kt = 0; kt < 16; ++kt) {
        const int kr = kt >> 1, ch = kt & 1;
        const bf16* kp = kbase + (size_t)(kr * 64 + 16 * ch) * PROJ_LD;
        const bf16x8 kf0 = *(const bf16x8*)kp, kf1 = *(const bf16x8*)(kp + 32);
        f32x4 a = (f32x4){0.f, 0.f, 0.f, 0.f};
        a = __builtin_amdgcn_mfma_f32_16x16x32_bf16(kf0, qf0, a, 0, 0, 0);
        a = __builtin_amdgcn_mfma_f32_16x16x32_bf16(kf1, qf1, a, 0, 0, 0);
        sc[kt] = a;
    }
    const LAS float* rp = rpb + h * 465;
    float mx = -1e30f;
#pragma unroll
    for (int kt = 0; kt < 16; ++kt) {
        const int kr = kt >> 1, ch = kt & 1;
        const int brow = (rs + kr - r + 7) * 31;
#pragma unroll
        for (int j = 0; j < 4; ++j) {
            const int kc = cb + 16 * ch + 4 * g + j, dc = kc - w + 15;
            const bool ok = (kc >= cs) && (kc <= cs + 15);
            const float bias = rp[brow + (ok ? dc : 15)];
            const float s = ok ? sc[kt][j] + bias : -1e30f;
            sc[kt][j] = s; mx = fmaxf(mx, s);
        }
    }
    mx = fmaxf(mx, __shfl_xor(mx, 16)); mx = fmaxf(mx, __shfl_xor(mx, 32));
    float sum = 0.f;
#pragma unroll
    for (int kt = 0; kt < 16; ++kt)
#pragma unroll
        for (int j = 0; j < 4; ++j) { const float p = __expf(sc[kt][j] - mx); sc[kt][j] = p; sum += p; }
    sum += __shfl_xor(sum, 16); sum += __shfl_xor(sum, 32);
    const float inv = 1.0f / sum;
    f32x4 o[4];
#pragma unroll
    for (int dt = 0; dt < 4; ++dt) o[dt] = (f32x4){0.f, 0.f, 0.f, 0.f};
    const bf16* vbase = VT + ((size_t)(b * 512 + h * 64 + qn)) * T + rs * 64 + cb + 4 * g;
#pragma unroll
    for (int kr = 0; kr < 8; ++kr) {
        v4u pw; pw.x = pk2(sc[2 * kr][0], sc[2 * kr][1]); pw.y = pk2(sc[2 * kr][2], sc[2 * kr][3]); pw.z = pk2(sc[2 * kr + 1][0], sc[2 * kr + 1][1]); pw.w = pk2(sc[2 * kr + 1][2], sc[2 * kr + 1][3]);
        const bf16x8 pf = __builtin_bit_cast(bf16x8, pw);
#pragma unroll
        for (int dt = 0; dt < 4; ++dt) {
            const bf16* vp = vbase + (size_t)(16 * dt) * T + kr * 64;
            const v2u lo = *(const v2u*)vp, hi = *(const v2u*)(vp + 16);
            const v4u vw = (v4u){lo.x, lo.y, hi.x, hi.y};
            o[dt] = __builtin_amdgcn_mfma_f32_16x16x32_bf16(__builtin_bit_cast(bf16x8, vw), pf, o[dt], 0, 0, 0);
        }
    }
    bf16* op = obase + tokq * opitch + h * 64;
#pragma unroll
    for (int dt = 0; dt < 4; ++dt) *(v2u*)(op + 16 * dt + 4 * g) = (v2u){pk2(o[dt][0] * inv, o[dt][1] * inv), pk2(o[dt][2] * inv, o[dt][3] * inv)};
}
__device__ __forceinline__ void attn_phase(const Frame& F0, const Args& args, int l, bf16* obase, int opitch) {
    const Frame F = fresh(F0);
    LAS float* rpb = (LAS float*)(F.lds + RING_OFF);
    for (int i = F.tid; i < 8 * 465; i += 512) rpb[i] = INP(9)[l * 8 * 465 + i];
    __syncthreads();
    bf16* PROJ = WSP(bf16, WS_PROJ); const bf16* VT = WSP(bf16, WS_VT);
    for (int wu = F.vcu * NWAVES + F.wave; wu < 16384; wu += F.G * NWAVES) {
        const int bh = wu >> 9, rem = wu & 511;
        attn_unit(PROJ, VT, rpb, bh >> 3, bh & 7, rem >> 2, rem & 3, F.lane, obase, opitch);
    }
    __syncthreads();
}

__device__ __forceinline__ float gelu_tanh(float x) { const float u = 0.7978845608028654f * (x + 0.044715f * x * x * x); const float t = 1.0f - 2.0f * __builtin_amdgcn_rcpf(1.0f + __expf(2.0f * u)); return 0.5f * x * (1.0f + t); }
__device__ __forceinline__ void fft_a_phase(const Frame& F0, const Args& args) {
    const Frame F = fresh(F0);
    const int lane = F.lane, nl = lane & 31, hh = lane >> 5;
    const bf16* PROJ = WSP(bf16, WS_PROJ); const bf16* FA = WSP(bf16, WS_FA); const f32x2* TW = WSP(f32x2, WS_TW); bf16* ZP = WSP(bf16, WS_U);
    for (int wu = F.vcu * NWAVES + F.wave; wu < 8192; wu += F.G * NWAVES) {
        const int ct = wu & 15, t2 = (wu >> 4) & 127, b = wu >> 11;
        bf16x8 bf[8];
#pragma unroll
        for (int s = 0; s < 8; ++s) { const int part = s >> 2, t1b = 16 * (s & 3) + 8 * hh;
            const bf16* p = PROJ + ((size_t)b * T + (size_t)128 * t1b + t2) * PROJ_LD + G_OFF + part * 512 + 32 * ct + nl;
            unsigned short e[8];
#pragma unroll
            for (int j = 0; j < 8; ++j) e[j] = p[(size_t)j * 128 * PROJ_LD];
            v4u w; w.x = e[0] | ((unsigned)e[1] << 16); w.y = e[2] | ((unsigned)e[3] << 16); w.z = e[4] | ((unsigned)e[5] << 16); w.w = e[6] | ((unsigned)e[7] << 16);
            bf[s] = __builtin_bit_cast(bf16x8, w); }
        f32x16 acc[4];
#pragma unroll
        for (int mt = 0; mt < 4; ++mt) { acc[mt] = (f32x16){};
#pragma unroll
            for (int s = 0; s < 8; ++s) { const bf16x8 af = *(const bf16x8*)(FA + (32 * mt + nl) * 128 + 16 * s + 8 * hh); acc[mt] = __builtin_amdgcn_mfma_f32_32x32x16_bf16(af, bf[s], acc[mt], 0, 0, 0); } }
#pragma unroll
        for (int mt = 0; mt < 2; ++mt)
#pragma unroll
            for (int rg = 0; rg < 16; ++rg) { const int k1 = 32 * mt + (rg & 3) + 8 * (rg >> 2) + 4 * hh; const f32x2 cs = TW[t2 * 64 + k1];
                const float zr = acc[mt][rg], zi = acc[mt + 2][rg];
                bf16* d = ZP + ((size_t)(b * 64 + k1) * 128 + t2) * 1024 + 32 * ct + nl;
                d[0] = (bf16)f2bf(zr * cs.x + zi * cs.y); d[512] = (bf16)f2bf(zi * cs.x - zr * cs.y); }
    }
}
__device__ __forceinline__ void fft_b_phase(const Frame& F0, const Args& args) {
    const Frame F = fresh(F0);
    const int lane = F.lane, nl = lane & 31, hh = lane >> 5;
    bf16* PROJ = WSP(bf16, WS_PROJ); const bf16* FB = WSP(bf16, WS_FB); const bf16* ZP = WSP(bf16, WS_U);
    for (int wu = F.vcu * NWAVES + F.wave; wu < 4096; wu += F.G * NWAVES) {
        const int ct = wu & 15, k1 = (wu >> 4) & 63, b = wu >> 10;
        f32x16 acc[4];
#pragma unroll
        for (int mt = 0; mt < 4; ++mt) acc[mt] = (f32x16){};
#pragma unroll 1
        for (int sc = 0; sc < 4; ++sc) {
            bf16x8 bf[4];
#pragma unroll
            for (int q = 0; q < 4; ++q) { const int s = 4 * sc + q, part = s >> 3, t2b = 16 * (s & 7) + 8 * hh;
                const bf16* p = ZP + ((size_t)(b * 64 + k1) * 128 + t2b) * 1024 + part * 512 + 32 * ct + nl;
                unsigned short e[8];
#pragma unroll
                for (int j = 0; j < 8; ++j) e[j] = p[(size_t)j * 1024];
                v4u w; w.x = e[0] | ((unsigned)e[1] << 16); w.y = e[2] | ((unsigned)e[3] << 16); w.z = e[4] | ((unsigned)e[5] << 16); w.w = e[6] | ((unsigned)e[7] << 16);
                bf[q] = __builtin_bit_cast(bf16x8, w); }
#pragma unroll
            for (int mt = 0; mt < 4; ++mt)
#pragma unroll
                for (int q = 0; q < 4; ++q) { const bf16x8 af = *(const bf16x8*)(FB + (32 * mt + nl) * 256 + 16 * (4 * sc + q) + 8 * hh); acc[mt] = __builtin_amdgcn_mfma_f32_32x32x16_bf16(af, bf[q], acc[mt], 0, 0, 0); }
        }
#pragma unroll
        for (int mt = 0; mt < 4; ++mt)
#pragma unroll
            for (int rg = 0; rg < 16; ++rg) { const int k2 = 32 * mt + (rg & 3) + 8 * (rg >> 2) + 4 * hh;
                PROJ[((size_t)b * T + k1 + 64 * k2) * PROJ_LD + G_OFF + 32 * ct + nl] = (bf16)f2bf(acc[mt][rg] * (1.0f / 1024.0f)); }
    }
}

__device__ __forceinline__ void router_phase(const Frame& F0, const Args& args, int l, int cset) {
    const Frame F = fresh(F0);
    const int tid = F.tid, lane = F.lane, wave = F.wave;
    const float* MOD = WSP(float, WS_MOD);
    LAS unsigned char* WB = F.lds + RING_OFF;
    constexpr int RPITCH = 2064;
    LAS float* gsc = (LAS float*)(F.lds + RING_OFF + 64 * RPITCH);
    LAS float* shf = gsc + 1024;
    LAS float* c0 = shf + 1024;
    LAS float* rb = c0 + 32;
    LAS unsigned* lcnt = (LAS unsigned*)(rb + 32);
    LAS unsigned* lbase = lcnt + 32;
    LAS float* red = (LAS float*)(lbase + 32);
    bf16* U2 = WSP(bf16, WS_U);
    float* tokw = WSP(float, WS_TOKW); int* perm = WSP(int, WS_PERM); int* tokes = WSP(int, WS_TOKROW);
    unsigned* ecnt = (unsigned*)(F.ctl + CW_ECNT + cset * 32 * 64);
    const int nround = (2048 + F.G * NWAVES - 1) / (F.G * NWAVES);
    int cur_b = -1;
    for (int rd = 0; rd < nround; ++rd) {
        const int unit = (rd * F.G + F.vcu) * NWAVES + wave;
        const int ub = (((rd * F.G + F.vcu) * NWAVES) * 16) >> 13;
        const bool wg_active = ((rd * F.G + F.vcu) * NWAVES) < 2048;
        if (wg_active && ub != cur_b) {
            cur_b = ub; __syncthreads();
            for (int i = 0; i < 2; ++i) { const int col = tid + 512 * i; gsc[col] = INP(5)[l * 1024 + col] * (1.0f + MOD[(size_t)(l * 4 + ub) * 6144 + 4 * 1024 + col]); shf[col] = MOD[(size_t)(l * 4 + ub) * 6144 + 3 * 1024 + col]; }
            if (tid < 32) rb[tid] = INP(22)[tid];
            __syncthreads();
            { f32x4 wa[8], wb[8];
#pragma unroll
                for (int i = 0; i < 8; ++i) { const int it = tid + 512 * i, kp = it >> 3, e4 = it & 7; wa[i] = *(const f32x4*)(INP(21) + (2 * kp) * 32 + 4 * e4); wb[i] = *(const f32x4*)(INP(21) + (2 * kp + 1) * 32 + 4 * e4); }
                PIN8(wa); PIN8(wb);
#pragma unroll
                for (int i = 0; i < 8; ++i) { const int it = tid + 512 * i, kp = it >> 3, e4 = it & 7; const float g0 = gsc[2 * kp], g1 = gsc[2 * kp + 1];
#pragma unroll
                    for (int j = 0; j < 4; ++j) { const float p0 = g0 * wa[i][j], p1 = g1 * wb[i][j]; const unsigned h1 = pk2(p0, p1), h2 = pk2(p0 - bflo(h1), p1 - bfhi(h1));
                        LAS unsigned char* d = WB + (4 * e4 + j) * RPITCH + 4 * kp; *(LAS unsigned*)d = h1; *(LAS unsigned*)(d + 32 * RPITCH) = h2; } } }
            { const int e = tid & 31, pt = tid >> 5; float s = 0.f;
#pragma unroll 1
                for (int q4 = 0; q4 < 4; ++q4) { float wv[16];
#pragma unroll
                    for (int kk = 0; kk < 16; ++kk) wv[kk] = INP(21)[(pt * 64 + q4 * 16 + kk) * 32 + e];
#pragma unroll
                    for (int kk = 0; kk < 16; ++kk) s += shf[pt * 64 + q4 * 16 + kk] * wv[kk]; }
                red[tid] = s; }
            __syncthreads();
            if (tid < 32) { float s = 0.f; for (int p = 0; p < 16; ++p) s += red[p * 32 + tid]; c0[tid] = s; }
        }
        if (tid < 32) lcnt[tid] = 0u;
        __syncthreads();
        int e0 = 0, e1 = 0; unsigned rk0 = 0, rk1 = 0; float w0 = 0.f, w1 = 0.f; bool owner = false; int mytok = 0;
        if (unit < 2048) {
            const int tok0 = unit * 16;
            float rs_reg = 0.f;
#pragma unroll 1
            for (int i4 = 0; i4 < 16; i4 += 4) {
                f32x4 v[4][4];
#pragma unroll
                for (int q = 0; q < 4; ++q) { const v2u* xr = (const v2u*)XBROW(tok0 + i4 + q) + lane;
#pragma unroll
                    for (int j = 0; j < 4; ++j) { const v2u t = xr[64 * j]; v[q][j] = (f32x4){bflo(t.x), bfhi(t.x), bflo(t.y), bfhi(t.y)}; } }
#pragma unroll
                for (int q = 0; q < 4; ++q) { const int m = tok0 + i4 + q; float ss = 0.f;
#pragma unroll
                    for (int j = 0; j < 4; ++j) ss += (v[q][j].x * v[q][j].x + v[q][j].y * v[q][j].y) + (v[q][j].z * v[q][j].z + v[q][j].w * v[q][j].w);
                    const float rstd = 1.0f / sqrtf(wave_sum(ss) * (1.0f / D) + EPS);
                    if ((lane & 15) == i4 + q) rs_reg = rstd;
                    v2u* uo = (v2u*)(U2 + (size_t)m * D) + lane;
#pragma unroll
                    for (int j = 0; j < 4; ++j) { const f32x4 g = *(const LAS f32x4*)(gsc + 4 * lane + 256 * j), s = *(const LAS f32x4*)(shf + 4 * lane + 256 * j);
                        const f32x4 u = v[q][j] * rstd * g + s; uo[64 * j] = (v2u){pk2(u.x, u.y), pk2(u.z, u.w)}; } }
            }
            const int ti = lane & 15, kq = lane >> 4;
            const v4u* xrow = (const v4u*)(XBROW(tok0 + ti) + 256 * kq);
            const LAS unsigned char* wp = WB + ti * RPITCH + 512 * kq;
            f32x4 a0 = {0.f, 0.f, 0.f, 0.f}, a1 = {0.f, 0.f, 0.f, 0.f};
            v4u xall[32];
#pragma unroll
            for (int q = 0; q < 32; ++q) xall[q] = xrow[q];
#pragma unroll
            for (int q = 0; q < 32; ++q) { const bf16x8 bx = __builtin_bit_cast(bf16x8, xall[q]);
                const bf16x8 w00 = *(const LAS bf16x8*)(wp + 16 * q), w01 = *(const LAS bf16x8*)(wp + 16 * RPITCH + 16 * q), w10 = *(const LAS bf16x8*)(wp + 32 * RPITCH + 16 * q), w11 = *(const LAS bf16x8*)(wp + 48 * RPITCH + 16 * q);
                a0 = __builtin_amdgcn_mfma_f32_16x16x32_bf16(w00, bx, a0, 0, 0, 0); a1 = __builtin_amdgcn_mfma_f32_16x16x32_bf16(w01, bx, a1, 0, 0, 0);
                a0 = __builtin_amdgcn_mfma_f32_16x16x32_bf16(w10, bx, a0, 0, 0, 0); a1 = __builtin_amdgcn_mfma_f32_16x16x32_bf16(w11, bx, a1, 0, 0, 0);
                if ((q & 3) == 3) asm volatile("" ::: "memory"); }
            float sco[2][4], sel[2][4], gs[2];
#pragma unroll
            for (int nt = 0; nt < 2; ++nt) {
#pragma unroll
                for (int rg = 0; rg < 4; ++rg) { const int e = 16 * nt + 4 * kq + rg; const float lg = rs_reg * (nt ? a1[rg] : a0[rg]) + c0[e]; sco[nt][rg] = sigmoidf(lg); sel[nt][rg] = sco[nt][rg] + rb[e]; }
                float m1 = fmaxf(sel[nt][0], sel[nt][1]), m2 = fminf(sel[nt][0], sel[nt][1]);
                { const float v = sel[nt][2]; if (v > m1) { m2 = m1; m1 = v; } else if (v > m2) m2 = v; }
                { const float v = sel[nt][3]; if (v > m1) { m2 = m1; m1 = v; } else if (v > m2) m2 = v; }
                gs[nt] = m1 + m2; }
            float bv = gs[0]; int bg = kq; if (gs[1] > bv) { bv = gs[1]; bg = 4 + kq; }
#pragma unroll
            for (int o = 16; o < 64; o <<= 1) { const float ov = __shfl_xor(bv, o); const int og = __shfl_xor(bg, o); if (ov > bv || (ov == bv && og < bg)) { bv = ov; bg = og; } }
            owner = ((bg & 3) == kq); mytok = tok0 + ti;
            if (owner) { const int nt = bg >> 2; float cd[4], sv[4];
#pragma unroll
                for (int rg = 0; rg < 4; ++rg) { cd[rg] = nt ? sel[1][rg] : sel[0][rg]; sv[rg] = nt ? sco[1][rg] : sco[0][rg]; }
                int i1 = 0; float v1 = cd[0];
#pragma unroll
                for (int rg = 1; rg < 4; ++rg) if (cd[rg] > v1) { v1 = cd[rg]; i1 = rg; }
                int i2 = -1; float v2 = -1e30f;
#pragma unroll
                for (int rg = 0; rg < 4; ++rg) if (rg != i1 && cd[rg] > v2) { v2 = cd[rg]; i2 = rg; }
                const float s1 = (i1 == 0 ? sv[0] : (i1 == 1 ? sv[1] : (i1 == 2 ? sv[2] : sv[3]))), s2 = (i2 == 0 ? sv[0] : (i2 == 1 ? sv[1] : (i2 == 2 ? sv[2] : sv[3])));
                e0 = 4 * bg + i1; e1 = 4 * bg + i2; w0 = s1 / (s1 + s2); w1 = s2 / (s1 + s2);
                rk0 = __hip_atomic_fetch_add(lcnt + e0, 1u, __ATOMIC_RELAXED, __HIP_MEMORY_SCOPE_WORKGROUP);
                rk1 = __hip_atomic_fetch_add(lcnt + e1, 1u, __ATOMIC_RELAXED, __HIP_MEMORY_SCOPE_WORKGROUP); }
        }
        __syncthreads();
        if (tid < 32) { const unsigned n = lcnt[tid]; lbase[tid] = n ? __hip_atomic_fetch_add(ecnt + 64 * tid, n, RLX_AGENT) : 0u; }
        __syncthreads();
        if (owner) { const unsigned s0 = lbase[e0] + rk0, s1 = lbase[e1] + rk1; perm[(size_t)e0 * NTOK + s0] = 2 * mytok; perm[(size_t)e1 * NTOK + s1] = 2 * mytok + 1; tokw[2 * mytok] = w0; tokw[2 * mytok + 1] = w1;
            tokes[2 * mytok] = (e0 << 16) | (int)s0; tokes[2 * mytok + 1] = (e1 << 16) | (int)s1; }
    }
}
__device__ __forceinline__ void expert_conv(const Frame& F0, const Args& args, int l, int j0, int j1) {
    const Frame F = fresh(F0);
    const int lane = F.lane, wave = F.wave;
    LAS float* scr = (LAS float*)(F.lds + RING_OFF + wave * 8704);
    const int gw = F.vcu * NWAVES + wave, NGW = F.G * NWAVES;
    bf16* WG1 = WSP(bf16, WS_WG1); bf16* WD = WSP(bf16, WS_WD);
    auto mk = [&](int it) -> TrItem {
        const int kind = it >> 13, r = it & 8191, e = r >> 8, rr = r & 255;
        if (kind < 2) { const int kb = rr >> 4, nb = rr & 15, n0 = nb * 32; const float* src = (kind == 0 ? INP(23) : INP(24)) + (size_t)(l * 32 + e) * 1024 * 512;
            return TrItem{src, 512, kb * 64, n0, WG1 + ((size_t)e * 1024 + (n0 >> 7) * 256 + kind * 128 + (n0 & 127)) * 1024, 1024}; }
        const int kb = rr >> 5, nb = rr & 31, n0 = nb * 32; const float* src = INP(25) + (size_t)(l * 32 + e) * 512 * 1024;
        return TrItem{src, 1024, kb * 64, n0, WD + ((size_t)e * 1024 + n0) * 512, 512}; };
    for (int j = j0; j < j1; j += 2) {
        const int ia = gw + NGW * j, ib = ia + NGW; const bool va = ia < 24576, two = (j + 1 < j1) && ib < 24576;
        if (!va) break;
        const TrItem a = mk(ia), b = mk(two ? ib : ia);
        f32x4 xa[8], xb[8]; tr_load(a, xa, lane); tr_load(b, xb, lane);
        tr_finish(a, xa, scr, lane); if (two) tr_finish(b, xb, scr, lane);
    }
}
__device__ __forceinline__ void moe_tilebase(const Frame& F0, const Args& args, int l) {
    const Frame F = fresh(F0);
    __syncthreads();
    if (F.tid < 32) { unsigned* ecnt = (unsigned*)(F.ctl + CW_ECNT + l * 32 * 64); F.MISC[49 + F.tid] = __hip_atomic_load(ecnt + 64 * F.tid, RLX_AGENT); }
    __syncthreads();
    if (F.tid < 32) { const int ln = F.tid; int exc = 0, tl = 0;
#pragma unroll 8
        for (int e = 0; e < 32; ++e) { const int te = (int)((F.MISC[49 + e] + 255u) >> 8); if (e < ln) exc += te; if (e == ln) tl = te; }
        F.MISC[16 + ln] = (unsigned)exc;
        if (ln == 31) F.MISC[48] = (unsigned)(exc + tl); }
    __syncthreads();
}
__device__ __forceinline__ void moe_rowmaps(const Frame& F0, const Args& args, const pg8::MoeOrder& S, LAS int* rowmap) {
    const Frame F = fresh(F0);
    const int* perm = WSP(int, WS_PERM);
    pg8::Unit u; int idxs[8]; int nu = 0;
#pragma unroll
    for (int i = 0; i < 8; ++i) { idxs[i] = -1; if (S.next(i, u)) { idxs[i] = u.gbase + min(F.tid & 255, u.gcnt - 1); nu = i + 1; } }
    if (F.tid < 256) { int v[8];
#pragma unroll
        for (int i = 0; i < 8; ++i) v[i] = perm[idxs[i] < 0 ? 0 : idxs[i]];
#pragma unroll
        for (int i = 0; i < 8; ++i) if (idxs[i] >= 0) rowmap[i * 256 + F.tid] = v[i] >> 1; }
    __syncthreads();
}
__device__ __forceinline__ void lru_conv_phase(const Frame& F0, const Args& args, int l) {
    const Frame F = fresh(F0);
    const int lane = F.lane, cg = lane & 7, tg = lane >> 3;
    const bf16* PROJ = WSP(bf16, WS_PROJ); bf16* XC = WSP(bf16, WS_XC);
    for (int wu = F.vcu * NWAVES + F.wave; wu < 4096; wu += F.G * NWAVES) {
        const int hb = wu & 7, c = (wu >> 3) & 127, b = wu >> 10, t0 = c * 64, ch0 = hb * 64 + 8 * cg;
        const bf16* xrp = PROJ + (size_t)b * T * PROJ_LD + XR_OFF + ch0;
        v4u raw[11];
#pragma unroll
        for (int rr = 0; rr < 11; ++rr) { const int t = t0 + 8 * tg - 2 + rr, tc = min(max(t, 0), T - 1); raw[rr] = *(const v4u*)(xrp + (size_t)tc * PROJ_LD); }
        f32x4 wv[5][2];
#pragma unroll
        for (int j = 0; j < 4; ++j) { wv[j][0] = *(const f32x4*)(INP(10) + (l * 4 + j) * 512 + ch0); wv[j][1] = *(const f32x4*)(INP(10) + (l * 4 + j) * 512 + ch0 + 4); }
        wv[4][0] = *(const f32x4*)(INP(11) + l * 512 + ch0); wv[4][1] = *(const f32x4*)(INP(11) + l * 512 + ch0 + 4);
        unsigned ow[8][4];
#pragma unroll
        for (int pp = 0; pp < 4; ++pp) {
            float xl[11], xh[11];
#pragma unroll
            for (int rr = 0; rr < 11; ++rr) { const int t = t0 + 8 * tg - 2 + rr; const unsigned w = (t >= 0 && t < T) ? raw[rr][pp] : 0u; xl[rr] = bflo(w); xh[rr] = bfhi(w); }
#pragma unroll
            for (int tk = 0; tk < 8; ++tk) { float ol = wv[4][pp >> 1][2 * (pp & 1)], oh = wv[4][pp >> 1][2 * (pp & 1) + 1];
#pragma unroll
                for (int j = 0; j < 4; ++j) { ol += wv[j][pp >> 1][2 * (pp & 1)] * xl[tk + j]; oh += wv[j][pp >> 1][2 * (pp & 1) + 1] * xh[tk + j]; }
                ow[tk][pp] = pk2(ol, oh); }
        }
#pragma unroll
        for (int tk = 0; tk < 8; ++tk) *(v4u*)(XC + ((size_t)b * T + t0 + 8 * tg + tk) * 512 + ch0) = (v4u){ow[tk][0], ow[tk][1], ow[tk][2], ow[tk][3]};
    }
}
__device__ __forceinline__ void lru_load_frags(bf16x8 (&af)[4][2], const bf16* xcp, int t0, int lane) {
#pragma unroll
    for (int mt = 0; mt < 4; ++mt) { const int tau = 16 * ((lane & 15) >> 2) + 4 * mt + (lane & 3);
#pragma unroll
        for (int s = 0; s < 2; ++s) af[mt][s] = *(const bf16x8*)(xcp + (size_t)(t0 + tau) * 512 + 32 * s); }
}
template <int DBG = 0>
__device__ __forceinline__ void lru2_phase(const Frame& F0, const Args& args, int l, bf16* obase, int opitch, int ooff) {
    const Frame F = fresh(F0);
    const int lane = F.lane, wave = F.wave, dw = wave >> 2, wq = wave & 3;
    LAS bf16* HP = (LAS bf16*)(F.lds + RING_OFF);
    LAS bf16* YRT = (LAS bf16*)(F.lds + RING_OFF + 131072 + wave * 1024);
    LAS f32x2* CT = (LAS f32x2*)(F.lds + RING_OFF + 139264);
    const bf16* PROJ = WSP(bf16, WS_PROJ); const bf16* XC = WSP(bf16, WS_XC);
    for (int un = F.vcu; un < 256; un += F.G) {
        const int b = un >> 6, hb = (un >> 3) & 7, s8 = un & 7;
        const int n = lane & 15, g = lane >> 4, hf = n >> 3, cj = n & 7;
        const int chg = hb * 64 + s8 * 8 + cj;
        const bf16* WLp = WSP(bf16, WS_WL) + ((size_t)(l * 8 + hb) * 256) * 64;
        bf16x8 bg[2], bs[2];
#pragma unroll
        for (int s = 0; s < 2; ++s) { bg[s] = *(const bf16x8*)(WLp + ((2 * dw + hf) * 64 + s8 * 8 + cj) * 64 + 32 * s + 8 * g);
            v4u sel = (v4u){0u, 0u, 0u, 0u};
            if (32 * s + 8 * g == 8 * s8) { const unsigned one = (cj & 1) ? 0x3F800000u : 0x00003F80u; sel[0] = (cj >> 1) == 0 ? one : 0u; sel[1] = (cj >> 1) == 1 ? one : 0u; sel[2] = (cj >> 1) == 2 ? one : 0u; sel[3] = (cj >> 1) == 3 ? one : 0u; }
            bs[s] = __builtin_bit_cast(bf16x8, sel); }
        const float b_r = INP(13)[(l * 2 + dw) * 512 + chg], b_i = INP(15)[(l * 2 + dw) * 512 + chg], lam = INP(16)[(l * 2 + dw) * 512 + chg];
        const float m8sp = -8.0f * ((lam > 15.f) ? __expf(-lam) : log1pf(__expf(-lam)));
        const float m8l = m8sp * 1.4426950408889634f, nbr = -b_r * 1.4426950408889634f, nbi = -b_i * 1.4426950408889634f;
        const bf16* xcp = XC + (size_t)b * T * 512 + hb * 64 + 8 * g;
        const bf16* yrp = PROJ + (size_t)b * T * PROJ_LD + YR_OFF + hb * 64 + s8 * 8;
        bf16* outp = obase + (size_t)b * T * opitch + ooff + hb * 64 + s8 * 8;
        const int pos = dw ? 7 - (2 * g + hf) : 2 * g + hf;
        float hrun = 0.f;
        bf16x8 nxt[4][2]; v4u ynx = (v4u){0u, 0u, 0u, 0u};
        { const int c0 = dw ? 127 - wq : wq; lru_load_frags(nxt, xcp, c0 * 64, lane); }
        __syncthreads();
#pragma unroll 1
        for (int rd = 0; rd < 32; ++rd) {
            const int c = dw ? 127 - (4 * rd + wq) : 4 * rd + wq, t0 = c * 64;
            const bool second = (DBG & 2) ? false : rd >= 16;
            bf16x8 af[4][2];
#pragma unroll
            for (int mt = 0; mt < 4; ++mt) { af[mt][0] = nxt[mt][0]; af[mt][1] = nxt[mt][1]; }
            const v4u ycur = ynx;
            { const int rn = min(rd + 1, 31), cn = dw ? 127 - (4 * rn + wq) : 4 * rn + wq; if (!(DBG & 1)) lru_load_frags(nxt, xcp, cn * 64, lane);
              if (rn >= 16) ynx = *(const v4u*)(yrp + (size_t)(cn * 64 + lane) * PROJ_LD); }
            if (second) *(LAS v4u*)(YRT + lane * 8) = ycur;
            f32x4 ag[4], ax[4];
#pragma unroll
            for (int mt = 0; mt < 4; ++mt) { ag[mt] = (f32x4){0.f, 0.f, 0.f, 0.f}; ax[mt] = (f32x4){0.f, 0.f, 0.f, 0.f};
#pragma unroll
                for (int s = 0; s < 2; ++s) { ag[mt] = __builtin_amdgcn_mfma_f32_16x16x32_bf16(af[mt][s], bg[s], ag[mt], 0, 0, 0); ax[mt] = __builtin_amdgcn_mfma_f32_16x16x32_bf16(af[mt][s], bs[s], ax[mt], 0, 0, 0); } }
            float a[8], bx[8], gr[8], gi[8], xv[8];
#pragma unroll
            for (int jj = 0; jj < 8; ++jj) {
                const float lo = ag[jj >> 2][jj & 3], hi = ag[2 + (jj >> 2)][jj & 3];
                const float mine = hf ? hi : lo, send = hf ? lo : hi;
                const float other = __builtin_bit_cast(float, __builtin_amdgcn_update_dpp(__builtin_bit_cast(int, send), __builtin_bit_cast(int, send), 0x128, 0xf, 0xf, false));
                gr[jj] = hf ? other : mine; gi[jj] = hf ? mine : other; xv[jj] = hf ? ax[2 + (jj >> 2)][jj & 3] : ax[jj >> 2][jj & 3]; }
#pragma unroll
            for (int jj = 0; jj < 8; ++jj) { gr[jj] = __builtin_amdgcn_exp2f(__builtin_fmaf(gr[jj], -1.4426950408889634f, nbr)); gi[jj] = __builtin_amdgcn_exp2f(__builtin_fmaf(gi[jj], -1.4426950408889634f, nbi)); }
#pragma unroll
            for (int jj = 0; jj < 8; ++jj) { gr[jj] = __builtin_amdgcn_rcpf(1.0f + gr[jj]); gi[jj] = __builtin_amdgcn_rcpf(1.0f + gi[jj]); }
#pragma unroll
            for (int jj = 0; jj < 8; ++jj) a[jj] = __builtin_amdgcn_exp2f(m8l * gr[jj]);
#pragma unroll
            for (int jj = 0; jj < 8; ++jj) bx[jj] = __builtin_amdgcn_sqrtf(__builtin_fmaf(-a[jj], a[jj], 1.0f)) * (gi[jj] * xv[jj]);
            float A8 = 1.f, B8 = 0.f;
            if (dw == 0) {
#pragma unroll
                for (int jj = 0; jj < 8; ++jj) { B8 = a[jj] * B8 + bx[jj]; A8 *= a[jj]; }
            } else {
#pragma unroll
                for (int jj = 7; jj >= 0; --jj) { B8 = a[jj] * B8 + bx[jj]; A8 *= a[jj]; }
            }
            float Ap = 1.f, Bp = 0.f, At = 1.f, Bt = 0.f;
#pragma unroll
            for (int k = 0; k < 8; ++k) { const int seg = dw ? 7 - k : k; const int src = cj + 8 * (seg & 1) + 16 * (seg >> 1);
                const float Ak = __shfl(A8, src), Bk = __shfl(B8, src);
                if (k < pos) { Bp = Ak * Bp + Bk; Ap *= Ak; }
                Bt = Ak * Bt + Bk; At *= Ak; }
            const int par = rd & 1;
            if (g == 0 && hf == 0) CT[((par * 2 + dw) * 4 + wq) * 8 + cj] = (f32x2){At, Bt};
            __syncthreads();
            float h = hrun;
#pragma unroll
            for (int q = 0; q < 4; ++q) { const f32x2 ab = CT[((par * 2 + dw) * 4 + q) * 8 + cj]; if (q < wq) h = ab.x * h + ab.y; hrun = ab.x * hrun + ab.y; }
            h = Ap * h + Bp;
            float hv[8];
            if (dw == 0) {
#pragma unroll
                for (int jj = 0; jj < 8; ++jj) { h = a[jj] * h + bx[jj]; hv[jj] = h; }
            } else {
#pragma unroll
                for (int jj = 7; jj >= 0; --jj) { h = a[jj] * h + bx[jj]; hv[jj] = h; }
            }
            const int tl0 = 16 * g + 8 * hf;
            if (DBG & 4) { if (hv[0] + hv[7] == 123.456f) outp[0] = 1; } else if (!second) {
                LAS bf16* hp = HP + ((size_t)(dw * 64 + (dw ? c - 64 : c)) * 64 + tl0) * 8 + cj;
#pragma unroll
                for (int jj = 0; jj < 8; ++jj) hp[jj * 8] = (bf16)f2bf(hv[jj]);
            } else {
                const LAS bf16* hp = HP + ((size_t)((1 - dw) * 64 + (dw ? c : c - 64)) * 64 + tl0) * 8 + cj;
                LDS_WAIT(); asm volatile("" ::: "memory");
                float yv[8], pv[8];
#pragma unroll
                for (int jj = 0; jj < 8; ++jj) { yv[jj] = bf2f(YRT[(tl0 + jj) * 8 + cj]); pv[jj] = bf2f(hp[jj * 8]); }
#pragma unroll
                for (int jj = 0; jj < 8; ++jj) YRT[(tl0 + jj) * 8 + cj] = (bf16)f2bf((hv[jj] + pv[jj]) * gelu_tanh(yv[jj]));
                LDS_WAIT(); asm volatile("" ::: "memory");
                *(v4u*)(outp + (size_t)(t0 + lane) * opitch) = *(const LAS v4u*)(YRT + lane * 8);
                LDS_WAIT(); asm volatile("" ::: "memory");
            }
        }
        __syncthreads();
    }
}
constexpr int AT_KR = 0, AT_VR = 73728, AT_VPITCH = 1168, AT_RPB = 148480, AT_XB = 150528, AT_XM = 158720;
__device__ __forceinline__ void attn2_phase(const Frame& F0, const Args& args, int l, bf16* obase, int opitch) {
    const Frame F = fresh(F0);
    const int tid = F.tid, lane = F.lane, wave = F.wave;
    LAS unsigned char* KR = F.lds + AT_KR; LAS unsigned char* VR = F.lds + AT_VR;
    LAS float* rpb = (LAS float*)(F.lds + AT_RPB);
    LAS unsigned char* XB = F.lds + AT_XB; LAS unsigned char* XM = F.lds + AT_XM;
    const bf16* PROJ = WSP(bf16, WS_PROJ); const bf16* VT = WSP(bf16, WS_VT);
    const int qb = wave & 3, dh = wave >> 2, qn = lane & 15, g = lane >> 4;
    const int cb = (qb == 0) ? 0 : ((qb == 1) ? 8 : ((qb == 2) ? 24 : 32));
    const int w = 16 * qb + qn, cs = min(max(w - 8, 0), 48);
    const int st = tid >> 3, sc = tid & 7;
    bool v0[4]; int dsel[4];
#pragma unroll
    for (int j = 0; j < 4; ++j) { const int kc0 = cb + 4 * g + j; v0[j] = (kc0 >= cs) && (kc0 <= cs + 15); dsel[j] = (v0[j] ? kc0 : kc0 + 16) - w + 15; }
    for (int un = F.vcu; un < 256; un += F.G) {
        const int bh = un >> 3, b = bh >> 3, h = bh & 7, R0 = (un & 7) * 16;
        __syncthreads();
        for (int i = tid; i < 465; i += 512) rpb[i] = INP(9)[(l * 8 + h) * 465 + i];
        const bf16* kg = PROJ + ((size_t)b * T + st) * PROJ_LD + K_OFF + h * 64 + 8 * sc;
        const bf16* vg = VT + ((size_t)(b * 512 + h * 64 + st)) * T + 8 * sc;
        const int kdst = st * 128 + ((sc ^ ((st >> 1) & 7)) * 16);
        const int vdst = st * AT_VPITCH + sc * 16;
        const int rs0 = min(max(R0 - 4, 0), 120);
        {
            v4u kk[8], vv[8];
#pragma unroll
            for (int j = 0; j < 8; ++j) { kk[j] = *(const v4u*)(kg + (size_t)(rs0 + j) * 64 * PROJ_LD); vv[j] = *(const v4u*)(vg + (rs0 + j) * 64); }
            PIN8(kk); PIN8(vv);
#pragma unroll
            for (int j = 0; j < 8; ++j) { const int slot = (rs0 + j) % 9; *(LAS v4u*)(KR + slot * 8192 + kdst) = kk[j]; *(LAS v4u*)(VR + slot * 128 + vdst) = vv[j]; }
        }
        __syncthreads();
        int have = rs0 + 7;
        v2u py0 = (v2u){0u, 0u}, py1 = (v2u){0u, 0u}; bf16* pop = nullptr;
        bf16x8 qn0, qn1;
        { const bf16* qp = PROJ + ((size_t)b * T + R0 * 64 + w) * PROJ_LD + Q_OFF + h * 64; qn0 = *(const bf16x8*)(qp + 8 * g); qn1 = *(const bf16x8*)(qp + 32 + 8 * g); }
#pragma unroll 1
        for (int s = 0; s < 16; ++s) {
            const int r = R0 + s;
            if (s > 0) { *(v2u*)pop = py0; *(v2u*)(pop + 16) = py1; }
            const size_t tokq = (size_t)b * T + r * 64 + w;
            const bf16x8 qf0 = qn0, qf1 = qn1;
            { const int r2 = min(r + 1, R0 + 15); const bf16* qp = PROJ + ((size_t)b * T + r2 * 64 + w) * PROJ_LD + Q_OFF + h * 64; qn0 = *(const bf16x8*)(qp + 8 * g); qn1 = *(const bf16x8*)(qp + 32 + 8 * g); }
            const int rsn = min(max(r + 1 - 4, 0), 120); const bool newrow = (s + 1 < 16) && (rsn + 7 > have); const int nrow = min(rsn + 7, 127);
            const v4u pk = *(const v4u*)(kg + (size_t)nrow * 64 * PROJ_LD), pv = *(const v4u*)(vg + nrow * 64);
            const int rs = min(max(r - 4, 0), 120);
            const int kr0 = 4 * dh;
            int slot0 = rs % 9 + kr0; slot0 = (slot0 >= 9) ? slot0 - 9 : slot0;
            int slot = slot0;
            f32x4 sc4[8];
#pragma unroll
            for (int kr = 0; kr < 4; ++kr) {
#pragma unroll
                for (int ch = 0; ch < 2; ++ch) { const int kt = cb + 16 * ch + qn; const LAS unsigned char* kp = KR + slot * 8192 + kt * 128; const int sw = (kt >> 1) & 7;
                    const bf16x8 kf0 = *(const LAS bf16x8*)(kp + ((g ^ sw) * 16)), kf1 = *(const LAS bf16x8*)(kp + (((4 + g) ^ sw) * 16));
                    f32x4 a = (f32x4){0.f, 0.f, 0.f, 0.f};
                    a = __builtin_amdgcn_mfma_f32_16x16x32_bf16(kf0, qf0, a, 0, 0, 0);
                    a = __builtin_amdgcn_mfma_f32_16x16x32_bf16(kf1, qf1, a, 0, 0, 0);
                    sc4[2 * kr + ch] = a; }
                slot = (slot == 8) ? 0 : slot + 1;
            }
            float sv[4][4]; float mx = -1e30f;
            const LAS float* rp = rpb + (rs - r + 7 + kr0) * 31;
#pragma unroll
            for (int kr = 0; kr < 4; ++kr)
#pragma unroll
                for (int j = 0; j < 4; ++j) { const float s = (v0[j] ? sc4[2 * kr][j] : sc4[2 * kr + 1][j]) + rp[kr * 31 + dsel[j]]; sv[kr][j] = s; mx = fmaxf(mx, s); }
            mx = fmaxf(mx, __shfl_xor(mx, 16)); mx = fmaxf(mx, __shfl_xor(mx, 32));
            float sum = 0.f;
#pragma unroll
            for (int kr = 0; kr < 4; ++kr)
#pragma unroll
                for (int j = 0; j < 4; ++j) { const float pe = __expf(sv[kr][j] - mx); sum += pe; sc4[2 * kr][j] = v0[j] ? pe : 0.f; sc4[2 * kr + 1][j] = v0[j] ? 0.f : pe; }
            sum += __shfl_xor(sum, 16); sum += __shfl_xor(sum, 32);
            f32x4 o[4];
#pragma unroll
            for (int dt = 0; dt < 4; ++dt) o[dt] = (f32x4){0.f, 0.f, 0.f, 0.f};
            slot = slot0;
            const LAS unsigned char* vb0 = VR + qn * AT_VPITCH + (cb + 4 * g) * 2;
#pragma unroll
            for (int kr = 0; kr < 4; ++kr) {
                v4u pw; pw.x = pk2(sc4[2 * kr][0], sc4[2 * kr][1]); pw.y = pk2(sc4[2 * kr][2], sc4[2 * kr][3]); pw.z = pk2(sc4[2 * kr + 1][0], sc4[2 * kr + 1][1]); pw.w = pk2(sc4[2 * kr + 1][2], sc4[2 * kr + 1][3]);
                const bf16x8 pf = __builtin_bit_cast(bf16x8, pw);
                const LAS unsigned char* vp = vb0 + slot * 128;
#pragma unroll
                for (int dt = 0; dt < 4; ++dt) { const v2u lo = *(const LAS v2u*)(vp + dt * 16 * AT_VPITCH), hi = *(const LAS v2u*)(vp + dt * 16 * AT_VPITCH + 32);
                    o[dt] = __builtin_amdgcn_mfma_f32_16x16x32_bf16(__builtin_bit_cast(bf16x8, ((v4u){lo.x, lo.y, hi.x, hi.y})), pf, o[dt], 0, 0, 0); }
                slot = (slot == 8) ? 0 : slot + 1;
            }
            { const f32x4 s0 = dh ? o[0] : o[2], s1 = dh ? o[1] : o[3];
              *(LAS v4u*)(XB + wave * 1024 + lane * 16) = (v4u){pk2(s0[0], s0[1]), pk2(s0[2], s0[3]), pk2(s1[0], s1[1]), pk2(s1[2], s1[3])};
              if (g == 0) *(LAS f32x2*)(XM + wave * 128 + qn * 8) = (f32x2){mx, sum}; }
            LDS_WAIT(); __builtin_amdgcn_s_barrier(); asm volatile("" ::: "memory");
            { const v4u pp = *(const LAS v4u*)(XB + (wave ^ 4) * 1024 + lane * 16); const f32x2 ms = *(const LAS f32x2*)(XM + (wave ^ 4) * 128 + qn * 8);
              const float m = fmaxf(mx, ms.x), fme = __expf(mx - m), fpa = __expf(ms.x - m), inv = __builtin_amdgcn_rcpf(sum * fme + ms.y * fpa), cme = fme * inv, cpa = fpa * inv;
              const f32x4 k0 = dh ? o[2] : o[0], k1 = dh ? o[3] : o[1];
              py0 = (v2u){pk2(k0[0] * cme + bflo(pp.x) * cpa, k0[1] * cme + bfhi(pp.x) * cpa), pk2(k0[2] * cme + bflo(pp.y) * cpa, k0[3] * cme + bfhi(pp.y) * cpa)};
              py1 = (v2u){pk2(k1[0] * cme + bflo(pp.z) * cpa, k1[1] * cme + bfhi(pp.z) * cpa), pk2(k1[2] * cme + bflo(pp.w) * cpa, k1[3] * cme + bfhi(pp.w) * cpa)}; }
            pop = obase + tokq * opitch + h * 64 + 32 * dh + 4 * g;
            if (newrow) { const int ns = nrow % 9; *(LAS v4u*)(KR + ns * 8192 + kdst) = pk; *(LAS v4u*)(VR + ns * 128 + vdst) = pv; have = nrow; }
            __syncthreads();
        }
        *(v2u*)pop = py0; *(v2u*)(pop + 16) = py1;
    }
    __syncthreads();
}
__device__ __forceinline__ bf16x8 lds_gather8(const LAS bf16* p, int stride) {
    unsigned short e[8];
#pragma unroll
    for (int j = 0; j < 8; ++j) e[j] = p[j * stride];
    v4u w; w.x = e[0] | ((unsigned)e[1] << 16); w.y = e[2] | ((unsigned)e[3] << 16); w.z = e[4] | ((unsigned)e[5] << 16); w.w = e[6] | ((unsigned)e[7] << 16);
    return __builtin_bit_cast(bf16x8, w);
}
constexpr int FA_PITCH = 136, FB_PITCH = 264;
__device__ __forceinline__ void fft_a2_phase(const Frame& F0, const Args& args) {
    const Frame F = fresh(F0);
    const int tid = F.tid, lane = F.lane, wave = F.wave, nl = lane & 31, hh = lane >> 5;
    LAS bf16* GT = (LAS bf16*)(F.lds + RING_OFF);
    LAS bf16* FAL = (LAS bf16*)(F.lds + RING_OFF + 65536);
    LAS f32x2* TWL = (LAS f32x2*)(F.lds + RING_OFF + 65536 + 34816);
    const bf16* PROJ = WSP(bf16, WS_PROJ); const bf16* FA = WSP(bf16, WS_FA); const f32x2* TW = WSP(f32x2, WS_TW); bf16* ZP = WSP(bf16, WS_U);
    __syncthreads();
    { v4u t[4];
#pragma unroll
        for (int i_ = 0; i_ < 4; ++i_) { const int i = tid + 512 * i_, r = i >> 4, c = i & 15; t[i_] = *(const v4u*)(FA + r * 128 + 8 * c); }
        PIN4(t);
#pragma unroll
        for (int i_ = 0; i_ < 4; ++i_) { const int i = tid + 512 * i_, r = i >> 4, c = i & 15; *(LAS v4u*)(FAL + r * FA_PITCH + 8 * c) = t[i_]; } }
    v4u v[8];
    { const int un = F.vcu; const int b = un >> 7, t2 = un & 127;
      if (un < 512) {
#pragma unroll
        for (int i = 0; i < 8; ++i) { const int idx = tid + 512 * i, k = idx >> 5, c = idx & 31, part = k >> 6, t1 = k & 63;
            v[i] = *(const v4u*)(PROJ + ((size_t)b * T + 128 * t1 + t2) * PROJ_LD + G_OFF + part * 256 + 8 * c); } } }
    for (int un = F.vcu; un < 512; un += F.G) {
        const int b = un >> 7, t2 = un & 127;
        __syncthreads();
        if (tid < 64) TWL[tid] = TW[t2 * 64 + tid];
        PIN8(v);
#pragma unroll
        for (int i = 0; i < 8; ++i) { const int idx = tid + 512 * i; *(LAS v4u*)(GT + (size_t)idx * 8) = v[i]; }
        { const int un2 = (un + F.G < 512) ? un + F.G : un; const int b2 = un2 >> 7, t22 = un2 & 127;
#pragma unroll
          for (int i = 0; i < 8; ++i) { const int idx = tid + 512 * i, k = idx >> 5, c = idx & 31, part = k >> 6, t1 = k & 63;
              v[i] = *(const v4u*)(PROJ + ((size_t)b2 * T + 128 * t1 + t22) * PROJ_LD + G_OFF + part * 256 + 8 * c); } }
        __syncthreads();
        {
            const int ch = 32 * wave + nl;
            f32x16 acc[4];
#pragma unroll
            for (int mt = 0; mt < 4; ++mt) acc[mt] = (f32x16){};
#pragma unroll 1
            for (int sc = 0; sc < 2; ++sc) {
                bf16x8 bf[4];
#pragma unroll
                for (int q4 = 0; q4 < 4; ++q4) bf[q4] = lds_gather8(GT + (16 * (4 * sc + q4) + 8 * hh) * 256 + ch, 256);
#pragma unroll
                for (int mt = 0; mt < 4; ++mt)
#pragma unroll
                    for (int q4 = 0; q4 < 4; ++q4) { const bf16x8 af = *(const LAS bf16x8*)(FAL + (32 * mt + nl) * FA_PITCH + 16 * (4 * sc + q4) + 8 * hh); acc[mt] = __builtin_amdgcn_mfma_f32_32x32x16_bf16(af, bf[q4], acc[mt], 0, 0, 0); }
            }
#pragma unroll
            for (int mt = 0; mt < 2; ++mt)
#pragma unroll
                for (int rg = 0; rg < 16; ++rg) { const int k1 = 32 * mt + (rg & 3) + 8 * (rg >> 2) + 4 * hh; const f32x2 cs = TWL[k1];
                    const float zr = acc[mt][rg], zi = acc[mt + 2][rg];
                    GT[k1 * 256 + ch] = (bf16)f2bf(zr * cs.x + zi * cs.y); GT[(64 + k1) * 256 + ch] = (bf16)f2bf(zi * cs.x - zr * cs.y);
                }
        }
        __syncthreads();
#pragma unroll
        for (int i = 0; i < 8; ++i) { const int idx = tid + 512 * i, m = idx >> 5, c = idx & 31, pp = m >> 6, k1 = m & 63;
            *(v4u*)(ZP + ((size_t)(b * 64 + k1) * 128 + t2) * 512 + pp * 256 + 8 * c) = *(const LAS v4u*)(GT + (size_t)idx * 8); }
    }
    __syncthreads();
}
__device__ __forceinline__ void fft_b2_phase(const Frame& F0, const Args& args) {
    const Frame F = fresh(F0);
    const int tid = F.tid, lane = F.lane, wave = F.wave, nl = lane & 31, hh = lane >> 5;
    LAS bf16* ZT = (LAS bf16*)(F.lds + RING_OFF);
    LAS bf16* FBL = (LAS bf16*)(F.lds + RING_OFF + 65536);
    LAS float* ZC = (LAS float*)(F.lds + RING_OFF + 65536 + 67584);
    LAS float* V0A = ZC + 512;
    LAS float* WA = V0A + 256;
    bf16* PROJ = WSP(bf16, WS_PROJ); const bf16* FB = WSP(bf16, WS_FB); const bf16* ZP = WSP(bf16, WS_U);
    __syncthreads();
    { v4u t[8];
#pragma unroll
        for (int i_ = 0; i_ < 8; ++i_) { const int i = tid + 512 * i_, r = i >> 5, c = i & 31; t[i_] = *(const v4u*)(FB + r * 256 + 8 * c); }
        PIN8(t);
#pragma unroll
        for (int i_ = 0; i_ < 8; ++i_) { const int i = tid + 512 * i_, r = i >> 5, c = i & 31; *(LAS v4u*)(FBL + r * FB_PITCH + 8 * c) = t[i_]; } }
    const int ws = wave >> 2, nt = (wave >> 1) & 1, mh = wave & 1;
    v4u v[8];
    { const int un = F.vcu; const int b = un >> 7, p = (un >> 2) & 31, g = un & 3;
      if (un < 512) {
#pragma unroll
        for (int i = 0; i < 8; ++i) { const int idx = tid + 512 * i, s = idx >> 11, k = (idx >> 3) & 255, c = idx & 7, part = k >> 7, t2 = k & 127, k1 = s ? (p ? 64 - p : 32) : p;
            v[i] = *(const v4u*)(ZP + ((size_t)(b * 64 + k1) * 128 + t2) * 512 + part * 256 + g * 64 + 8 * c); } } }
    for (int un = F.vcu; un < 512; un += F.G) {
        const int b = un >> 7, p = (un >> 2) & 31, g = un & 3;
        __syncthreads();
        PIN8(v);
#pragma unroll
        for (int i = 0; i < 8; ++i) { const int idx = tid + 512 * i; *(LAS v4u*)(ZT + (size_t)idx * 8) = v[i]; }
        { const int un2 = (un + F.G < 512) ? un + F.G : un; const int b2 = un2 >> 7, p2 = (un2 >> 2) & 31, g2 = un2 & 3;
#pragma unroll
          for (int i = 0; i < 8; ++i) { const int idx = tid + 512 * i, s = idx >> 11, k = (idx >> 3) & 255, c = idx & 7, part = k >> 7, t2 = k & 127, k1 = s ? (p2 ? 64 - p2 : 32) : p2;
              v[i] = *(const v4u*)(ZP + ((size_t)(b2 * 64 + k1) * 128 + t2) * 512 + part * 256 + g2 * 64 + 8 * c); } }
        __syncthreads();
        ZC[tid] = bf2f(ZT[(size_t)tid * 64]);
        const int ch = 32 * nt + nl;
        f32x16 acc[2];
        acc[0] = (f32x16){}; acc[1] = (f32x16){};
        { const LAS bf16* ZTs = ZT + ws * 16384;
#pragma unroll 1
          for (int sc = 0; sc < 4; ++sc) {
            bf16x8 bf[4];
#pragma unroll
            for (int q = 0; q < 4; ++q) bf[q] = lds_gather8(ZTs + (16 * (4 * sc + q) + 8 * hh) * 64 + ch, 64);
#pragma unroll
            for (int m2 = 0; m2 < 2; ++m2)
#pragma unroll
                for (int q = 0; q < 4; ++q) { const bf16x8 af = *(const LAS bf16x8*)(FBL + (64 * mh + 32 * m2 + nl) * FB_PITCH + 16 * (4 * sc + q) + 8 * hh); acc[m2] = __builtin_amdgcn_mfma_f32_32x32x16_bf16(af, bf[q], acc[m2], 0, 0, 0); }
          } }
        __syncthreads();
        {
            const int s = tid >> 8, k2 = (tid >> 1) & 127, hf = tid & 1;
            const LAS bf16* fr = FBL + k2 * FB_PITCH + 64 * hf; const LAS float* zc = ZC + s * 256 + 64 * hf;
            float w = 0.f;
#pragma unroll 2
            for (int j = 0; j < 8; ++j) { const v4u fc = *(const LAS v4u*)(fr + 8 * j), fs = *(const LAS v4u*)(fr + 128 + 8 * j);
                const f32x4 r0 = *(const LAS f32x4*)(zc + 8 * j), r1 = *(const LAS f32x4*)(zc + 8 * j + 4), i0 = *(const LAS f32x4*)(zc + 128 + 8 * j), i1 = *(const LAS f32x4*)(zc + 128 + 8 * j + 4);
                w += i0[0] * bflo(fc.x) + i0[1] * bfhi(fc.x) + i0[2] * bflo(fc.y) + i0[3] * bfhi(fc.y) + i1[0] * bflo(fc.z) + i1[1] * bfhi(fc.z) + i1[2] * bflo(fc.w) + i1[3] * bfhi(fc.w);
                w -= r0[0] * bflo(fs.x) + r0[1] * bfhi(fs.x) + r0[2] * bflo(fs.y) + r0[3] * bfhi(fs.y) + r1[0] * bflo(fs.z) + r1[1] * bfhi(fs.z) + r1[2] * bflo(fs.w) + r1[3] * bfhi(fs.w); }
            w += __shfl_xor(w, 1);
            if (hf == 0) WA[s * 128 + k2] = w * (1.0f / 1024.0f);
        }
        {
            const int kb = 64 * mh + 4 * hh;
            int hi = p ? (1 - ws) * 128 : ws * 128, lo = (p || ws) ? 127 - kb : 128 - kb, rb = (ws * 128 + kb) * 128 + ch, chm = ch ? 128 - ch : 64;
            asm volatile("" : "+v"(hi), "+v"(lo), "+v"(rb), "+v"(chm));
#pragma unroll
            for (int m2 = 0; m2 < 2; ++m2)
#pragma unroll
                for (int rg = 0; rg < 16; ++rg) { const int off = 32 * m2 + (rg & 3) + 8 * (rg >> 2); const bf16 hv = (bf16)f2bf(acc[m2][rg] * (1.0f / 1024.0f));
                    ZT[rb + off * 128] = hv; ZT[(hi + ((lo - off) & 127)) * 128 + chm] = hv; }
            if (ch == 0) {
#pragma unroll
                for (int m2 = 0; m2 < 2; ++m2)
#pragma unroll
                    for (int rg = 0; rg < 16; ++rg) V0A[ws * 128 + kb + 32 * m2 + (rg & 3) + 8 * (rg >> 2)] = acc[m2][rg] * (1.0f / 1024.0f); }
        }
        __syncthreads();
        if (tid < 256) { const int s = tid >> 7, k2 = tid & 127, rm = p ? (1 - s) * 128 + 127 - k2 : (s ? 128 + 127 - k2 : ((128 - k2) & 127));
            ZT[tid * 128] = (bf16)f2bf(0.5f * (V0A[tid] + V0A[rm])); ZT[tid * 128 + 64] = (bf16)f2bf(0.5f * (WA[tid] + WA[rm])); }
        __syncthreads();
#pragma unroll
        for (int i = 0; i < 8; ++i) { const int idx = tid + 512 * i, r = idx >> 4, c = idx & 15, s = r >> 7, k2 = r & 127, k1 = s ? (p ? 64 - p : 32) : p;
            *(v4u*)(PROJ + ((size_t)b * T + k1 + 64 * k2) * PROJ_LD + G_OFF + g * 128 + 8 * c) = *(const LAS v4u*)(ZT + (size_t)idx * 8); }
    }
    __syncthreads();
}
__device__ __forceinline__ void stagger(const Frame& F, int ticks) {
    const unsigned long long t0 = __builtin_amdgcn_s_memrealtime(), d = (unsigned long long)((F.vcu & 3) * ticks);
    while (__builtin_amdgcn_s_memrealtime() - t0 < d) __builtin_amdgcn_s_sleep(16);
}
__device__ __forceinline__ int fresh_bid() { int b = (int)blockIdx.x; asm volatile("" : "+s"(b)); return b; }
constexpr int PPL = 9, N_PHASES = 2 + PPL * DEPTH;
__global__ void __launch_bounds__(NWAVES * 64, 2) mega_fwd(Args args, int li) {
    extern __shared__ __attribute__((aligned(16))) unsigned char lds[];
    Frame F;
    F.lds = (LAS unsigned char*)lds;
    F.MISC = (volatile LAS unsigned*)(F.lds + MISC_OFF);
    F.tid = threadIdx.x; F.lane = F.tid & 63; F.wave = __builtin_amdgcn_readfirstlane(F.tid >> 6);
    F.G = gridDim.x; { const int bx = blockIdx.x; F.vcu = (F.G % 8 == 0) ? (bx % 8) * (F.G / 8) + bx / 8 : bx; }
    F.ctl = (gu32*)(args.ws + WS_CTL);
    for (int u = F.tid; u < (LDS_BYTES - LDSCTL_OFF) / 4; u += NWAVES * 64) ((LAS unsigned*)(F.lds + LDSCTL_OFF))[u] = 0u;
    __syncthreads();
    const int lo = args.ph_lo, hi = args.ph_hi;
    XcdBarrier bar; bar.bar = (unsigned*)(F.ctl + CW_BAR) + li * XCD_BAR_WORDS; bar.x = 0; bar.st = nullptr; bar.wave = F.wave;
    if (hi - lo > 1) bar = xcd_barrier_post((unsigned*)(F.ctl + CW_BAR) + li * XCD_BAR_WORDS, F.MISC + 8);
#ifndef PHMASK
#define PHMASK 0xFFFF
#endif
#define EN(kind) ((PHMASK >> (kind)) & 1)
#define IN(k) (lo <= (k) && (k) < hi)
#define SEAM(k) do { if (IN(k) && IN((k) + 1)) { xcd_barrier(bar); for (int rb_ = 0; rb_ < REP_B; ++rb_) xcd_barrier(bar); } } while (0)

    if (EN(0) && IN(0)) { for (int rep = 0; rep < 1 + REP_C; ++rep) p0_prologue(F, args); SEAM(0); }
    auto layer = [&](const int l) __attribute__((always_inline)) {
        const int pb = 1 + PPL * l;
        bf16* U = WSP(bf16, WS_U); bf16* PROJ = WSP(bf16, WS_PROJ); bf16* GATES = WSP(bf16, WS_GATES);
        if (EN(1) && IN(pb + 0)) { if (l == 0) { for (int rep = 0; rep < (REP_R & 1); ++rep) rows_phase<0>(F, args, l); rows_phase<0>(F, args, l); } else rows_phase<1>(F, args, l); SEAM(pb + 0); }
        if (EN(2) && IN(pb + 1)) {
            pg8::Gemm g{U, U, U, WSP(bf16, WS_WP2) + (size_t)l * NP2 * 1024, nullptr, nullptr, 1024, 1024, 1024};
            pg8::StaticOrder S; S.init(NTOK, 3072, F.G, fresh_bid());
            EpiP2 E{false, false, nullptr, PROJ, WSP(bf16, WS_VT)};
            const int npre = 4 * (F.vcu & 3) * (STAG_P2 != 0);
            expert_conv(F, args, l, 0, npre); __syncthreads();
            for (int rep = 0; rep < 1 + (REP_GS & 1 ? REP_G : 0); ++rep) pg8::gemm_phase<EpiP2, pg8::StaticOrder, true>(F.lds + RING_OFF, g, S, E, fresh(F).tid);
            {
                const pg8::bf16_t* U8 = (const pg8::bf16_t*)(args.ws + WS_U8); const pg8::bf16_t* W8 = WSP(bf16, WS_WP2) + (size_t)l * NP2 * 1024 + (size_t)3072 * 1024;
                pg8::Gemm g8{U8, U8, U8, W8, nullptr, nullptr, 512, 512, 512};
                pg8::StaticOrder S8; S8.init(NTOK, 3072, F.G, fresh_bid());
                EpiGates E8{false, GATES, INP(8) + l * 3072};
                for (int rep = 0; rep < 1 + (REP_GS & 1 ? REP_G : 0); ++rep) pg8::gemm_phase<EpiGates, pg8::StaticOrder, true, false, true>(F.lds + RING_OFF, g8, S8, E8, fresh(F).tid);
            }
            __syncthreads(); expert_conv(F, args, l, npre, 12);
            SEAM(pb + 1);
        }
        if (EN(3) && IN(pb + 2)) {
            for (int rep = 0; rep < REP_M; ++rep) { if (REP_MS & 1) attn2_phase(F, args, l, WSP(bf16, WS_SCR), 512); if (REP_MS & 2) lru_conv_phase(F, args, l); if (REP_MS & 4) fft_a2_phase(F, args); if (REP_MS & 16) fft_a2_phase(F, args); }
            lru_conv_phase(F, args, l); attn2_phase(F, args, l, PROJ, PROJ_LD); fft_a2_phase(F, args); SEAM(pb + 2); }
        if (EN(4) && IN(pb + 3)) { for (int rep = 0; rep < REP_M; ++rep) { if (REP_MS & 2) lru2_phase<REP_DBG>(F, args, l, WSP(bf16, WS_SCR), 512, 0); if (REP_MS & 4) fft_b2_phase(F, args); if (REP_MS & 32) fft_b2_phase(F, args); }
            lru2_phase(F, args, l, PROJ, PROJ_LD, YR_OFF); fft_b2_phase(F, args); SEAM(pb + 3); }
        if (EN(6) && IN(pb + 4)) {
            const bf16* WP = WSP(bf16, WS_WPROJ) + (size_t)l * 3 * 1024 * 512;
            pg8::Gemm g{PROJ + Q_OFF, PROJ + YR_OFF, PROJ + G_OFF, WP, WP + 1024 * 512, WP + 2 * 1024 * 512, PROJ_LD, 512, 512};
            pg8::MergeOrder S; S.init(NTOK, 1024, F.G, fresh_bid());
            LAS float* rtab = (LAS float*)(F.lds + XTRA_OFF);
            { const Frame Fm = fresh(F); __syncthreads(); if (Fm.tid < 256) rtab[Fm.tid] = 1.0f / (float)(Fm.tid > 0 ? Fm.tid : 1); __syncthreads(); }
            EpiMerge E{false, GATES, U, rtab};
            for (int rep = 0; rep < 1 + (REP_GS & 2 ? REP_G : 0); ++rep) pg8::gemm_phase<EpiMerge, pg8::MergeOrder, true>(F.lds + RING_OFF, g, S, E, fresh(F).tid);
            SEAM(pb + 4);
        }
        if (EN(7) && IN(pb + 5)) {
            pg8::Gemm g{U, U, U, WSP(bf16, WS_WOUT) + (size_t)l * 1024 * 1024, nullptr, nullptr, 1024, 1024, 1024};
            pg8::StaticOrder S; S.init(NTOK, 1024, F.G, fresh_bid());
            if (l == 0) { EpiResid<true> E{false, INP(0), WSP(bf16, WS_XB0), WSP(bf16, WS_XB1), WSP(float, WS_MOD) + (size_t)l * 4 * 6144 + 2 * 1024};
                pg8::gemm_phase<EpiResid<true>, pg8::StaticOrder, true>(F.lds + RING_OFF, g, S, E, fresh(F).tid); }
            else { EpiResid<false> E{false, nullptr, WSP(bf16, WS_XB0), WSP(bf16, WS_XB1), WSP(float, WS_MOD) + (size_t)l * 4 * 6144 + 2 * 1024};
                pg8::gemm_phase<EpiResid<false>, pg8::StaticOrder, true>(F.lds + RING_OFF, g, S, E, fresh(F).tid); }
            SEAM(pb + 5);
        }
        if (EN(8) && IN(pb + 6)) { if (REP_R & 2) router_phase(F, args, l, 2 + l); router_phase(F, args, l, l); SEAM(pb + 6); }
        if (EN(10) && IN(pb + 7)) {
            moe_tilebase(F, args, l);
            pg8::Gemm g{U, U, U, WSP(bf16, WS_WG1), nullptr, nullptr, 1024, 1024, 1024};
            pg8::MoeOrder S{(const LAS int*)(F.lds + MISC_OFF + 64), F.G, fresh_bid()};
            LAS int* rowmap = (LAS int*)(F.lds + XTRA_OFF);
            moe_rowmaps(F, args, S, rowmap);
            EpiSwiGLU E{false, WSP(bf16, WS_H)};
            for (int rep = 0; rep < 1 + (REP_GS & 8 ? REP_G : 0); ++rep) pg8::gemm_phase<EpiSwiGLU, pg8::MoeOrder, true, true>(F.lds + RING_OFF, g, S, E, fresh(F).tid, rowmap);
            SEAM(pb + 7);
        }
        if (EN(11) && IN(pb + 8)) {
            moe_tilebase(F, args, l);
            const bf16* H = WSP(bf16, WS_H);
            pg8::Gemm g{H, H, H, WSP(bf16, WS_WD), nullptr, nullptr, 512, 512, 512};
            pg8::MoeOrder S{(const LAS int*)(F.lds + MISC_OFF + 64), F.G, fresh_bid()};
            EpiYE E{false, PROJ};
            for (int rep = 0; rep < 1 + (REP_GS & 16 ? REP_G : 0); ++rep) pg8::gemm_phase<EpiYE, pg8::MoeOrder, true>(F.lds + RING_OFF, g, S, E, fresh(F).tid);
            SEAM(pb + 8);
        }
    };
    static_assert(DEPTH == 2, "layers"); layer(0); layer(1);
    if (EN(12) && IN(N_PHASES - 1)) rows_phase<2>(F, args, DEPTH);
#undef IN
#undef SEAM
}

#ifndef MK_MODE
#define MK_MODE 0
#endif
extern "C" void kernel_launch(void* const* d_in, const int* in_sizes, int n_in, void* d_out, int out_size, void* d_ws, size_t ws_size, hipStream_t stream) {
    static int grid = 0;
    if (grid == 0) {
        if (n_in != 27 || in_sizes[0] != NTOK * D || out_size != NTOK * D || ws_size < WS_END) { fprintf(stderr, "kernel_launch: unexpected shapes (n_in %d, in0 %d, out %d, ws %zu < %zu)\n", n_in, n_in > 0 ? in_sizes[0] : -1, out_size, ws_size, (size_t)WS_END); grid = -1; return; }
        int dev = 0, cus = 0;
        if (hipGetDevice(&dev) != hipSuccess || hipDeviceGetAttribute(&cus, hipDeviceAttributeMultiprocessorCount, dev) != hipSuccess) { grid = -1; return; }
        if (hipFuncSetAttribute((const void*)mega_fwd, hipFuncAttributeMaxDynamicSharedMemorySize, LDS_BYTES) != hipSuccess) { fprintf(stderr, "kernel_launch: hipFuncSetAttribute failed\n"); grid = -1; return; }
        (void)hipGetLastError();
        grid = cus;
    }
    if (grid < 0) return;
    if (hipMemsetAsync((char*)d_ws + WS_CTL, 0, CTL_ZERO_BYTES, stream) != hipSuccess) return;
    Args a{};
    for (int i = 0; i < 27; ++i) a.in[i] = (const float*)d_in[i];
    a.out = (float*)d_out; a.ws = (unsigned char*)d_ws;
#if MK_MODE == 0
    a.ph_lo = 0; a.ph_hi = N_PHASES;
    hipLaunchKernelGGL(mega_fwd, dim3(grid), dim3(NWAVES * 64), LDS_BYTES, stream, a, 0);
#else
    for (int p = 0; p < N_PHASES; ++p) { a.ph_lo = p; a.ph_hi = p + 1; hipLaunchKernelGGL(mega_fwd, dim3(grid), dim3(NWAVES * 64), LDS_BYTES, stream, a, 0); }
#endif
}
```

```cpp
#include <hip/hip_runtime.h>
#include <cstdio>
#include <cstdint>
namespace pg8 {
#define PG8_LAS __attribute__((address_space(3)))
typedef unsigned short bf16_t;
typedef short bf16x8 __attribute__((ext_vector_type(8)));
typedef float f32x4 __attribute__((ext_vector_type(4)));
typedef unsigned u32x4 __attribute__((ext_vector_type(4)));
typedef unsigned u32x2 __attribute__((ext_vector_type(2)));
typedef int v4i_ __attribute__((ext_vector_type(4)));
constexpr int BM = 256, BK = 64, HALF = 128, HTB = HALF * BK * 2  , STAGE_BYTES = 8 * HTB, NXCD = 8, WGM = 8;

__host__ __device__ __forceinline__ int lds_byte(int r, int c) { const int st = (r >> 4) * 2 + (c >> 5), rr = r & 15, cc = c & 31, ob = rr * 64 + cc * 2; return st * 1024 + (ob ^ (((ob >> 9) & 1) << 5)); }
__host__ __device__ __forceinline__ void stage_rc(int b, int& R, int& C) { const int st = b / 1024, sb = b % 1024, swz = sb ^ (((sb >> 9) & 1) << 5); R = (st >> 1) * 16 + swz / 64; C = (st & 1) * 32 + (swz % 64) / 2; }
__host__ __device__ __forceinline__ int perm32(int rho) { const int n = rho >> 4, i = rho & 15; return 8 * (i >> 2) + 4 * n + (i & 3); }

struct Unit { int pm, pn, bt, z, gbase, gcnt; };
struct Gemm { const bf16_t* A0; const bf16_t* A1; const bf16_t* A2; const bf16_t* B0; const bf16_t* B1; const bf16_t* B2; int lda, ldb, K; };

__device__ __forceinline__ unsigned cvt_pk_bf16(float lo, float hi) { unsigned r; asm volatile("v_cvt_pk_bf16_f32 %0, %1, %2" : "=v"(r) : "v"(lo), "v"(hi)); return r; }

struct StaticOrder {
    int nM, nN, nwg, G, c;
    __device__ void init(int M, int N, int G_, int c_) { nM = M / BM; nN = N / BM; nwg = nM * nN; G = G_; c = c_; }
    __device__ __forceinline__ bool tile(long L, Unit& u) const {
        if (L >= nwg) return false;
        int wgid = (int)L; { const int q = nwg / NXCD, r = nwg % NXCD, xcd = wgid % NXCD, off = wgid / NXCD; wgid = (xcd < r ? xcd * (q + 1) : r * (q + 1) + (xcd - r) * q) + off; }
        const int nig = WGM * nN, gid = wgid / nig, fm = gid * WGM, gsz = (nM - fm) < WGM ? (nM - fm) : WGM;
        u.pm = fm + ((wgid % nig) % gsz); u.pn = (wgid % nig) / gsz; u.bt = u.pn; u.z = 0; u.gbase = 0; u.gcnt = 0; return true;
    }
    __device__ __forceinline__ bool next(int i, Unit& u) const { return tile((long)i * G + c, u); }
};
struct MergeOrder : StaticOrder {
    __device__ __forceinline__ bool next(int i, Unit& u) const { const int t = i / 3; if (!tile((long)t * G + c, u)) return false; u.z = i - 3 * t; return true; }
};
struct MoeOrder {
    const PG8_LAS int* tb; int G, c;
    __device__ __forceinline__ bool next(int i, Unit& u) const {
        const int L = i * G + c; const int nt = tb[32]; if (L >= nt * 4) return false;
        const int t = L >> 2, j = L & 3; unsigned z_ = 0u; asm volatile("" : "+v"(z_)); const int ln_ = (int)__builtin_amdgcn_mbcnt_hi(~0u, __builtin_amdgcn_mbcnt_lo(~0u, z_)); const int tbv_ = (ln_ >= 1 && ln_ < 32) ? tb[ln_] : 0x7fffffff;
        const int e = __popcll(__ballot(tbv_ <= t));
        const int tl = t - tb[e];
        u.pm = t; u.pn = j; u.bt = e * 4 + j; u.z = 0; u.gbase = e * 32768 + 256 * tl; u.gcnt = tb[33 + e] - 256 * tl; return true;
    }
};

template <class Epi, class Sched, bool ALIGN_EPI, bool GATHER = false, bool FP8 = false, int SCALE_W = 0x7F7F7F7F>
__device__ __forceinline__ void gemm_phase(PG8_LAS unsigned char* lds, const Gemm g, const Sched& S, const Epi& E, const int tid, const PG8_LAS int* rowmap = nullptr) {
    const int wid = __builtin_amdgcn_readfirstlane(tid >> 6), lane = tid & 63, wr = wid >> 2, wc = wid & 3, fr = lane & 15, fq = lane >> 4;
    const int K = g.K, nt = K / BK;
    int sc1_ = 0x7F7F7F7F; if constexpr (FP8) asm volatile("" : "+v"(sc1_));
    unsigned voffA[2], voffB[2]; int gR[2];
#pragma unroll
    for (int i = 0; i < 2; ++i) { int R, C; stage_rc(tid * 16 + i * 8192, R, C); const int Rb = Epi::PERM ? ((R & ~31) + perm32(R & 31)) : R;
        voffA[i] = GATHER ? (unsigned)C * 2u : (unsigned)(R * g.lda + C) * 2u; voffB[i] = (unsigned)(Rb * g.ldb + C) * 2u; gR[i] = R; }
    unsigned offC[2][2], offN[2][2];
#define PG8_GOFF(dst, ui_) do { _Pragma("unroll") for (int h_ = 0; h_ < 2; ++h_) _Pragma("unroll") for (int i_ = 0; i_ < 2; ++i_) dst[h_][i_] = (unsigned)rowmap[(ui_) * 256 + 128 * h_ + gR[i_]] * (unsigned)(g.lda * 2) + voffA[i_]; } while (0)
    const size_t kstep = (size_t)(BK * 2);
    const size_t hstepA = (size_t)HALF * g.lda * 2, hstepB = (size_t)HALF * g.ldb * 2;
    const size_t tstepA = 2 * hstepA, tstepB = 2 * hstepB;
    const unsigned ldsw = (unsigned)wid * 1024u;
    const int aoff = lds_byte(wr * 64 + fr, fq * 8), boff = lds_byte(wc * 32 + fr, fq * 8);
#define PG8_SA(b, h) (((b) * 2 + (h)) * HTB)
#define PG8_SB(b, h) ((4 + (b) * 2 + (h)) * HTB)
#define PG8_STAGE(bufoff, gbase, voff) do { _Pragma("unroll") for (int _i = 0; _i < 2; ++_i) { unsigned vo_ = (voff)[_i]; if constexpr (FP8) asm volatile("" : "+v"(vo_)); \
        __builtin_amdgcn_global_load_lds((const unsigned*)((const char*)(gbase) + vo_), (PG8_LAS unsigned*)(lds + (bufoff) + ldsw + _i * 8192), 16, 0, 0); } } while (0)
#define PG8_STAGE_A(bufoff, gbase, h, nf) do { _Pragma("unroll") for (int _i = 0; _i < 2; ++_i) { unsigned o_ = GATHER ? ((nf) ? offN[h][_i] : offC[h][_i]) : (voffA[_i] + (unsigned)((h) * hstepA)); if constexpr (FP8) asm volatile("" : "+v"(o_)); \
        __builtin_amdgcn_global_load_lds((const unsigned*)((const char*)(gbase) + o_), (PG8_LAS unsigned*)(lds + (bufoff) + ldsw + _i * 8192), 16, 0, 0); } } while (0)
#define PG8_LDA(dst, b, h) do { _Pragma("unroll") for (int m = 0; m < 4; ++m) _Pragma("unroll") for (int k = 0; k < 2; ++k) dst[m][k] = *(const PG8_LAS bf16x8*)(lds + PG8_SA(b, h) + aoff + m * 2048 + k * 1024); } while (0)
#define PG8_LDB(dst, b, h) do { _Pragma("unroll") for (int n = 0; n < 2; ++n) _Pragma("unroll") for (int k = 0; k < 2; ++k) dst[n][k] = *(const PG8_LAS bf16x8*)(lds + PG8_SB(b, h) + boff + n * 2048 + k * 1024); } while (0)
#define PG8_CAT8(x) __builtin_shufflevector(__builtin_bit_cast(v4i_, (x)[0]), __builtin_bit_cast(v4i_, (x)[1]), 0, 1, 2, 3, 4, 5, 6, 7)
#define PG8_MMA(ai, bj, At, Bt) do { __builtin_amdgcn_s_setprio(1); _Pragma("unroll") for (int m = 0; m < 4; ++m) _Pragma("unroll") for (int n = 0; n < 2; ++n) { \
        if constexpr (FP8) acc[ai][bj][m][n] = __builtin_amdgcn_mfma_scale_f32_16x16x128_f8f6f4(PG8_CAT8(Bt[n]), PG8_CAT8(At[m]), acc[ai][bj][m][n], 0, 0, 0, sc1_, 0, sc1_); \
        else { _Pragma("unroll") for (int k = 0; k < 2; ++k) acc[ai][bj][m][n] = __builtin_amdgcn_mfma_f32_16x16x32_bf16(Bt[n][k], At[m][k], acc[ai][bj][m][n], 0, 0, 0); } } __builtin_amdgcn_s_setprio(0); } while (0)
#define PG8_WAIT_V(n) asm volatile("s_waitcnt vmcnt(" #n ")" ::: "memory")
#define PG8_WAIT_L(n) asm volatile("s_waitcnt lgkmcnt(" #n ")" ::: "memory")
#define PG8_BAR __builtin_amdgcn_s_barrier()
#define PG8_SCHED __builtin_amdgcn_sched_barrier(0)
#define PG8_APTR(u) (GATHER ? (const char*)g.A0 : (const char*)((u).z == 0 ? g.A0 : ((u).z == 1 ? g.A1 : g.A2)) + (size_t)(u).pm * tstepA)
#define PG8_BPTR(u) ((const char*)((u).z == 0 ? g.B0 : ((u).z == 1 ? g.B1 : g.B2)) + (size_t)(u).bt * tstepB)
    Unit cur, nxt; int ui = 0;
    if (!S.next(0, cur)) return;
    f32x4 acc[2][2][4][2];
#pragma unroll
    for (int a = 0; a < 2; ++a)
#pragma unroll
        for (int b = 0; b < 2; ++b)
#pragma unroll
            for (int m = 0; m < 4; ++m)
#pragma unroll
                for (int n = 0; n < 2; ++n) acc[a][b][m][n] = (f32x4){0.f, 0.f, 0.f, 0.f};
    bf16x8 At[4][2], B0[2][2], B1[2][2];
    const char* cA = PG8_APTR(cur); const char* cB = PG8_BPTR(cur);
    if constexpr (GATHER) { PG8_GOFF(offC, 0); PG8_GOFF(offN, 0); }
    PG8_STAGE(PG8_SB(0, 0), cB, voffB); PG8_STAGE(PG8_SB(0, 1), cB + hstepB, voffB); PG8_STAGE_A(PG8_SA(0, 0), cA, 0, false); PG8_STAGE_A(PG8_SA(0, 1), cA, 1, false);
    if (wr == 1) PG8_BAR;
    PG8_WAIT_V(2); PG8_BAR;
    PG8_STAGE(PG8_SB(1, 0), cB + kstep, voffB); PG8_STAGE_A(PG8_SA(1, 0), cA + kstep, 0, false); PG8_STAGE(PG8_SB(1, 1), cB + hstepB + kstep, voffB);
    PG8_WAIT_V(6); PG8_BAR;
    for (;;) {
        const bool has_next = S.next(ui + 1, nxt);
        const char* nA = has_next ? PG8_APTR(nxt) : cA; const char* nB = has_next ? PG8_BPTR(nxt) : cB;
        if constexpr (GATHER) { if (has_next) { PG8_GOFF(offN, ui + 1); } else { _Pragma("unroll") for (int h_ = 0; h_ < 2; ++h_) _Pragma("unroll") for (int i_ = 0; i_ < 2; ++i_) offN[h_][i_] = offC[h_][i_]; } }
#pragma unroll 1
        for (int t = 0; t < nt; t += 2) {
            const bool last = (t == nt - 2);
            const char* a1 = cA + (size_t)(t + 1) * kstep;
            const char* a2 = last ? nA : cA + (size_t)(t + 2) * kstep; const char* b2 = last ? nB : cB + (size_t)(t + 2) * kstep;
            const char* a3 = a2 + kstep; const char* b3 = b2 + kstep;
            PG8_LDB(B0, 0, 0); PG8_LDB(B1, 0, 1); PG8_SCHED; PG8_LDA(At, 0, 0); PG8_STAGE_A(PG8_SA(1, 1), a1, 1, false);
            PG8_WAIT_V(8); PG8_WAIT_L(0); PG8_BAR; PG8_MMA(0, 0, At, B0); PG8_MMA(0, 1, At, B1); PG8_BAR; PG8_SCHED;
            PG8_LDA(At, 0, 1); PG8_STAGE(PG8_SB(0, 0), b2, voffB); PG8_STAGE(PG8_SB(0, 1), b2 + hstepB, voffB); PG8_STAGE_A(PG8_SA(0, 0), a2, 0, last);
            PG8_WAIT_V(8); PG8_WAIT_L(0); PG8_BAR; PG8_MMA(1, 0, At, B0); PG8_MMA(1, 1, At, B1); PG8_BAR; PG8_SCHED;
            PG8_LDB(B0, 1, 0); PG8_LDB(B1, 1, 1); PG8_SCHED; PG8_LDA(At, 1, 0); PG8_STAGE_A(PG8_SA(0, 1), a2, 1, last);
            PG8_WAIT_V(8); PG8_WAIT_L(0); PG8_BAR; PG8_MMA(0, 0, At, B0); PG8_MMA(0, 1, At, B1); PG8_BAR; PG8_SCHED;
            PG8_LDA(At, 1, 1); PG8_STAGE(PG8_SB(1, 0), b3, voffB); PG8_STAGE(PG8_SB(1, 1), b3 + hstepB, voffB); PG8_STAGE_A(PG8_SA(1, 0), a3, 0, last);
            PG8_WAIT_V(8); PG8_WAIT_L(0); PG8_BAR; PG8_MMA(1, 0, At, B0); PG8_MMA(1, 1, At, B1); PG8_BAR; PG8_SCHED;
        }
        if constexpr (ALIGN_EPI) { if (wr == 0) PG8_BAR; }
        unsigned ze_ = 0u; asm volatile("" : "+v"(ze_)); const int le_ = (int)__builtin_amdgcn_mbcnt_hi(~0u, __builtin_amdgcn_mbcnt_lo(~0u, ze_));
        bool fin_ = true;
        if constexpr (Epi::CHAINS) fin_ = E.is_final(cur);
        if constexpr (Epi::CHAINS) { E.rescale(acc, cur, wr, wc, le_ & 15, le_ >> 4); if (fin_) E(acc, cur, wr, wc, le_ & 15, le_ >> 4); }
        else if (!E.skip) E(acc, cur, wr, wc, le_ & 15, le_ >> 4); else { _Pragma("unroll") for (int a_ = 0; a_ < 2; ++a_) _Pragma("unroll") for (int b_ = 0; b_ < 2; ++b_) _Pragma("unroll") for (int m_ = 0; m_ < 4; ++m_) _Pragma("unroll") for (int n_ = 0; n_ < 2; ++n_) asm volatile("" :: "v"(acc[a_][b_][m_][n_])); }
        if (!has_next) break;
        if (fin_) {
#pragma unroll
        for (int a = 0; a < 2; ++a)
#pragma unroll
            for (int b = 0; b < 2; ++b)
#pragma unroll
                for (int m = 0; m < 4; ++m)
#pragma unroll
                    for (int n = 0; n < 2; ++n) acc[a][b][m][n] = (f32x4){0.f, 0.f, 0.f, 0.f};
        }
        cur = nxt; cA = nA; cB = nB; ++ui;
        if constexpr (GATHER) { _Pragma("unroll") for (int h_ = 0; h_ < 2; ++h_) _Pragma("unroll") for (int i_ = 0; i_ < 2; ++i_) offC[h_][i_] = offN[h_][i_]; }
        if constexpr (ALIGN_EPI) { if (wr == 1) PG8_BAR; }
    }
    PG8_WAIT_V(0);
    if constexpr (!ALIGN_EPI) { if (wr == 0) PG8_BAR; }
    PG8_BAR;
#undef PG8_SA
#undef PG8_SB
#undef PG8_STAGE
#undef PG8_LDA
#undef PG8_LDB
#undef PG8_MMA
#undef PG8_CAT8
#undef PG8_WAIT_V
#undef PG8_WAIT_L
#undef PG8_BAR
#undef PG8_SCHED
#undef PG8_APTR
#undef PG8_STAGE_A
#undef PG8_GOFF
#undef PG8_BPTR
}
}
constexpr int NWAVES = 8;
constexpr int NB = 4, T = 8192, D = 1024, NTOK = NB * T, DEPTH = 2;
constexpr int PROJ_LD = 3072, Q_OFF = 0, K_OFF = 512, XR_OFF = 1024, YR_OFF = 1536, G_OFF = 2048;
constexpr int GATES_LD = 3072;
constexpr int NP2 = 6144;
constexpr int NEXP = 32, XS_ROWS = 73728;
constexpr int LRU_CH = 32, LRU_NCH = T / LRU_CH;
constexpr float EPS = 1e-6f;

constexpr size_t MiB = 1u << 20;
constexpr size_t WS_CTL = 0, CTL_ZERO_BYTES = 1 * MiB;
constexpr size_t WS_MOD = 1 * MiB;
constexpr size_t WS_FA = WS_MOD + 256 * 1024;
constexpr size_t WS_FB = WS_FA + 32 * 1024;
constexpr size_t WS_TW = WS_FB + 64 * 1024;
constexpr size_t WS_WL = 2 * MiB;
constexpr size_t WS_TOKW = 3 * MiB;
constexpr size_t WS_TOKROW = WS_TOKW + 256 * 1024;
constexpr size_t WS_PERM = 4 * MiB;
constexpr size_t WS_WP2 = 20 * MiB;
constexpr size_t WS_WPROJ = 46 * MiB;
constexpr size_t WS_WOUT = 52 * MiB;
constexpr size_t WS_U = 56 * MiB;
constexpr size_t WS_VT = 120 * MiB;
constexpr size_t WS_PROJ = 152 * MiB;
constexpr size_t WS_GATES = 344 * MiB;
constexpr size_t WS_H = WS_GATES;
constexpr size_t WS_WG1 = WS_GATES + 96 * MiB, WS_WD = WS_GATES + 160 * MiB;
constexpr size_t WS_XC = 536 * MiB;
constexpr size_t WS_U8 = WS_XC;
constexpr size_t WS_XB0 = 568 * MiB, WS_XB1 = 8 * MiB;
constexpr int XB_SPLIT = 30720;
constexpr size_t WS_END = 628 * MiB;
constexpr size_t WS_SCR = WS_VT;
#ifndef REP_G
#define REP_G 0
#endif
#ifndef REP_C
#define REP_C 0
#endif
#ifndef STAG_P2
#define STAG_P2 600
#endif
#ifndef REP_DBG
#define REP_DBG 0
#endif
#ifndef REP_B
#define REP_B 0
#endif
#ifndef REP_R
#define REP_R 0
#endif
#ifndef REP_GS
#define REP_GS 31
#endif
#ifndef REP_MS
#define REP_MS 15
#endif
#ifndef REP_M
#define REP_M 0
#endif
static_assert(WS_H + (size_t)XS_ROWS * 512 * 2 <= WS_WG1 && WS_WD + 32 * MiB <= WS_XC, "ws map");
constexpr int CW_BAR = 4096;
constexpr int CW_ECNT = 16384;

constexpr int LDS_BYTES = 163840;
constexpr int RING_OFF = 0, RING_BYTES = 131072;
constexpr int XTRA_OFF = RING_BYTES;
constexpr int LDSCTL_OFF = LDS_BYTES - 512, MISC_OFF = LDSCTL_OFF + 64;

#define GAS __attribute__((address_space(1)))
#define LAS __attribute__((address_space(3)))
typedef unsigned short bf16;
typedef unsigned v4u __attribute__((ext_vector_type(4)));
typedef unsigned v2u __attribute__((ext_vector_type(2)));
typedef float f32x4 __attribute__((ext_vector_type(4)));
typedef float f32x2 __attribute__((ext_vector_type(2)));
typedef float f32x16 __attribute__((ext_vector_type(16)));
typedef short bf16x8 __attribute__((ext_vector_type(8)));
typedef short bf16x4 __attribute__((ext_vector_type(4)));
typedef GAS unsigned gu32;
#define RLX_AGENT __ATOMIC_RELAXED, __HIP_MEMORY_SCOPE_AGENT
#define LDS_WAIT() asm volatile("s_waitcnt lgkmcnt(0)" ::: "memory")
#define VM_WAIT() asm volatile("s_waitcnt vmcnt(0)" ::: "memory")
typedef __bf16 hwbf16x2 __attribute__((ext_vector_type(2)));
__device__ __forceinline__ unsigned pk2(float lo, float hi) { f32x2 v = {lo, hi}; hwbf16x2 b = __builtin_convertvector(v, hwbf16x2); return __builtin_bit_cast(unsigned, b); }
__device__ __forceinline__ unsigned pk4_fp8(float a, float b, float c, float d) { int p = __builtin_amdgcn_cvt_pk_fp8_f32(a, b, 0, false); return (unsigned)__builtin_amdgcn_cvt_pk_fp8_f32(c, d, p, true); }
__device__ __forceinline__ unsigned f2bf(float f) { return pk2(f, 0.f) & 0xffffu; }
__device__ __forceinline__ float bflo(unsigned w) { return __builtin_bit_cast(float, w << 16); }
__device__ __forceinline__ float bfhi(unsigned w) { return __builtin_bit_cast(float, w & 0xffff0000u); }
__device__ __forceinline__ float bf2f(unsigned short h) { return __builtin_bit_cast(float, (unsigned)h << 16); }
__device__ __forceinline__ float sigmoidf(float v) { return 1.0f / (1.0f + __expf(-v)); }
__device__ __forceinline__ float fsigmoid(float v) { return __builtin_amdgcn_rcpf(1.0f + __expf(-v)); }
#define PIN4(a) asm volatile("" : "+v"(a[0]), "+v"(a[1]), "+v"(a[2]), "+v"(a[3]))
#define PIN8(a) asm volatile("" : "+v"(a[0]), "+v"(a[1]), "+v"(a[2]), "+v"(a[3]), "+v"(a[4]), "+v"(a[5]), "+v"(a[6]), "+v"(a[7]))
__device__ __forceinline__ float wave_sum(float v) {
#pragma unroll
    for (int o = 1; o < 64; o <<= 1) v += __shfl_xor(v, o);
    return v;
}
#define XB_TMO      128
#define XB_XCNT(j)  (256  + 64 * (j))
#define XB_XSUB(j)  (1280 + 64 * (j))
#define XB_XGEN(j)  (2304 + 64 * (j))
#define XB_TOP      3328
#define XB_TOPGEN   3392
#define XCD_BAR_WORDS 3456
#define XB_SPIN_CAP (1u << 18)

__device__ __forceinline__ unsigned xb_ld(unsigned* p)              { return __hip_atomic_load(p, __ATOMIC_RELAXED, __HIP_MEMORY_SCOPE_AGENT); }
__device__ __forceinline__ unsigned xb_add(unsigned* p, unsigned v) { return __hip_atomic_fetch_add(p, v, __ATOMIC_RELAXED, __HIP_MEMORY_SCOPE_AGENT); }
__device__ __forceinline__ unsigned xb_xcc_id() { return (unsigned)__builtin_amdgcn_s_getreg((3 << 11) | 20) & 0xFu; }
#define XB_SPIN(cond, bar) do { unsigned _sp = 0; while (cond) { __builtin_amdgcn_s_sleep(1); \
    if ((++_sp & 255u) == 0u) { if (xb_ld(&(bar)[XB_TMO])) break; if (_sp > XB_SPIN_CAP) { atomicAdd(&(bar)[XB_TMO], 1u); break; } } } } while (0)

struct XcdBarrier {
    unsigned* bar; unsigned x;
    int wave;
    volatile LAS unsigned* st;
};

__device__ __forceinline__ XcdBarrier xcd_barrier_post(unsigned* bar, volatile LAS unsigned* st) {
    XcdBarrier b; b.bar = bar; b.x = xb_xcc_id(); b.st = st; b.wave = __builtin_amdgcn_readfirstlane((int)threadIdx.x >> 6);
    if (threadIdx.x == 0) (void)xb_add(&bar[XB_XCNT(b.x)], 1u);
    return b;
}
__device__ __forceinline__ void xcd_barrier_complete(unsigned* bar, unsigned x, unsigned& nloc, unsigned& nx) {
    const unsigned G = gridDim.x * gridDim.y * gridDim.z;
    unsigned sum, cnt, mine, sp = 0u;
    for (;;) {
        sum = 0u; cnt = 0u; mine = 0u;
#pragma unroll
        for (unsigned j = 0; j < 16; ++j) { const unsigned c = xb_ld(&bar[XB_XCNT(j)]); sum += c; cnt += (c > 0u) ? 1u : 0u; mine = (j == x) ? c : mine; }
        if (sum == G) break;
        __builtin_amdgcn_s_sleep(1);
        if ((++sp & 255u) == 0u) { if (xb_ld(&bar[XB_TMO])) break; if (sp > XB_SPIN_CAP) { atomicAdd(&bar[XB_TMO], 1u); break; } }
    }
    nloc = mine > 0u ? mine : 1u; nx = cnt > 0u ? cnt : 1u;
}

__device__ __forceinline__ void xcd_barrier(const XcdBarrier& b) {
    asm volatile("s_waitcnt vmcnt(0)" ::: "memory");
    __syncthreads();
    unsigned z_ = 0u; asm volatile("" : "+v"(z_));
    if (b.wave == 0 && __builtin_amdgcn_mbcnt_hi(~0u, __builtin_amdgcn_mbcnt_lo(~0u, z_)) == 0u) {
        unsigned* bar = b.bar;
        __builtin_amdgcn_s_waitcnt(0);
        unsigned nloc = b.st[0], nx = b.st[1];
        if (nloc == 0u) { xcd_barrier_complete(bar, b.x, nloc, nx); b.st[0] = nloc; b.st[1] = nx; }
        const unsigned old = xb_add(&bar[XB_XSUB(b.x)], 1u);
        const unsigned gen = old / nloc;
        if (old + 1u == (gen + 1u) * nloc) {
            __builtin_amdgcn_fence(__ATOMIC_RELEASE, "agent");
            asm volatile("s_waitcnt vmcnt(0)" ::: "memory");
            const unsigned og = xb_add(&bar[XB_TOP], 1u);
            const unsigned tg = og / nx;
            if (og + 1u == (tg + 1u) * nx) xb_add(&bar[XB_TOPGEN], 1u);
            else XB_SPIN(xb_ld(&bar[XB_TOPGEN]) == tg, bar);
            __builtin_amdgcn_fence(__ATOMIC_ACQUIRE, "agent");
            xb_add(&bar[XB_XGEN(b.x)], 1u);
            asm volatile("s_waitcnt vmcnt(0)" ::: "memory");
        } else {
            XB_SPIN(xb_ld(&bar[XB_XGEN(b.x)]) == gen, bar);
            __builtin_amdgcn_fence(__ATOMIC_ACQUIRE, "agent");
            asm volatile("s_waitcnt vmcnt(0)" ::: "memory");
        }
    }
    __syncthreads();
}

struct Args { const float* in[27]; float* out; unsigned char* ws; int ph_lo, ph_hi; };
struct Frame {
    LAS unsigned char* lds;
    volatile LAS unsigned* MISC;
    gu32* ctl;
    int tid, lane, wave, vcu, G;
};
__device__ __forceinline__ Frame fresh(const Frame& F) {
    Frame N = F; int w = F.wave; asm volatile("" : "+s"(w)); unsigned z = 0u; asm volatile("" : "+v"(z));
    const int ln = (int)__builtin_amdgcn_mbcnt_hi(~0u, __builtin_amdgcn_mbcnt_lo(~0u, z)); N.tid = w * 64 + ln; N.lane = ln; N.wave = w;
    int v = F.vcu; asm volatile("" : "+s"(v)); N.vcu = v; int g = F.G; asm volatile("" : "+s"(g)); N.G = g; return N;
}
#define WSP(T_, off) ((T_*)(args.ws + (off)))
#define XBROW(m) ((bf16*)(args.ws + ((m) < XB_SPLIT ? WS_XB0 + (size_t)(m) * 2048 : WS_XB1 + (size_t)((m) - XB_SPLIT) * 2048)))
#define INP(i) (args.in[i])

struct TrItem { const float* W; int ldw, k0, n0; bf16* dst; int ldd; };
__device__ __forceinline__ void tr_load(const TrItem& it, f32x4 (&v)[8], int lane) {
    const float* p = it.W + (size_t)(it.k0 + (lane >> 3)) * it.ldw + it.n0 + 4 * (lane & 7);
#pragma unroll
    for (int i = 0; i < 8; ++i) v[i] = *(const f32x4*)(p + (size_t)(8 * i) * it.ldw);
}
__device__ __forceinline__ void tr_finish(const TrItem& it, f32x4 (&v)[8], LAS float* scr, int lane) {
    PIN8(v);
#pragma unroll
    for (int i = 0; i < 8; ++i) { LAS float* d = scr + (8 * i + (lane >> 3)) * 33 + 4 * (lane & 7); d[0] = v[i].x; d[1] = v[i].y; d[2] = v[i].z; d[3] = v[i].w; }
    LDS_WAIT(); asm volatile("" ::: "memory");
    const int c = lane & 7;
#pragma unroll
    for (int j = 0; j < 4; ++j) { const int n = (lane >> 3) + 8 * j; const LAS float* s = scr + (8 * c) * 33 + n;
        v4u o; o.x = pk2(s[0 * 33], s[1 * 33]); o.y = pk2(s[2 * 33], s[3 * 33]); o.z = pk2(s[4 * 33], s[5 * 33]); o.w = pk2(s[6 * 33], s[7 * 33]);
        *(v4u*)(it.dst + (size_t)n * it.ldd + it.k0 + 8 * c) = o; }
    LDS_WAIT(); asm volatile("" ::: "memory");
}
__device__ __forceinline__ void transpose_item_fp8(const float* W, int ldw, int k0, int n0, unsigned char* dst8, LAS float* scr, int lane) {
    const TrItem it{W, ldw, k0, n0, nullptr, 0}; f32x4 v[8]; tr_load(it, v, lane);
    PIN8(v);
#pragma unroll
    for (int i = 0; i < 8; ++i) { LAS float* d = scr + (8 * i + (lane >> 3)) * 33 + 4 * (lane & 7); d[0] = v[i].x; d[1] = v[i].y; d[2] = v[i].z; d[3] = v[i].w; }
    LDS_WAIT(); asm volatile("" ::: "memory");
    const int c = lane & 7;
#pragma unroll
    for (int j = 0; j < 4; ++j) { const int n = (lane >> 3) + 8 * j; const LAS float* s = scr + (8 * c) * 33 + n;
        *(v2u*)(dst8 + (size_t)n * 1024 + k0 + 8 * c) = (v2u){pk4_fp8(64.f * s[0 * 33], 64.f * s[1 * 33], 64.f * s[2 * 33], 64.f * s[3 * 33]), pk4_fp8(64.f * s[4 * 33], 64.f * s[5 * 33], 64.f * s[6 * 33], 64.f * s[7 * 33])}; }
    LDS_WAIT(); asm volatile("" ::: "memory");
}
__device__ __forceinline__ void transpose_item(const float* W, int ldw, int k0, int n0, bf16* dst, int ldd, LAS float* scr, int lane) {
    const TrItem it{W, ldw, k0, n0, dst, ldd}; f32x4 v[8]; tr_load(it, v, lane); tr_finish(it, v, scr, lane);
}
__device__ __forceinline__ void p0_prologue(const Frame& F0, const Args& args) {
    const Frame F = fresh(F0);
    const int tid = F.tid, lane = F.lane, wave = F.wave;
    float* MOD = WSP(float, WS_MOD);
    {
        LAS f32x4* cact4 = (LAS f32x4*)(F.lds + RING_OFF);
        LAS float* red = (LAS float*)(F.lds + RING_OFF + 16384);
        if (F.vcu < 192) {
            const float* c = INP(1);
#pragma unroll
            for (int i = 0; i < 8; ++i) { const int idx = tid + 512 * i, b = idx >> 10, k = idx & 1023; const float v = c[b * 1024 + k]; ((LAS float*)cact4)[k * 4 + b] = v * sigmoidf(v); }
        }
        __syncthreads();
        for (int u = F.vcu; u < 192; u += F.G) {
            const int l = u / 96, j0 = (u % 96) * 64;
            const float* aw = INP(2) + (size_t)l * 1024 * 6144 + j0 + lane;
            float a0 = 0.f, a1 = 0.f, a2 = 0.f, a3 = 0.f;
#pragma unroll 32
            for (int kk = 0; kk < 128; ++kk) { const int k = 128 * wave + kk; const float wv = aw[(size_t)k * 6144]; const f32x4 c4 = cact4[k]; a0 += c4.x * wv; a1 += c4.y * wv; a2 += c4.z * wv; a3 += c4.w * wv; }
            red[(wave * 4 + 0) * 64 + lane] = a0; red[(wave * 4 + 1) * 64 + lane] = a1; red[(wave * 4 + 2) * 64 + lane] = a2; red[(wave * 4 + 3) * 64 + lane] = a3;
            __syncthreads();
            if (tid < 256) { const int b = tid >> 6, ln = tid & 63; float s = INP(3)[l * 6144 + j0 + ln];
#pragma unroll
                for (int w = 0; w < 8; ++w) s += red[(w * 4 + b) * 64 + ln];
                MOD[(size_t)(l * 4 + b) * 6144 + j0 + ln] = s; }
            __syncthreads();
        }
    }
    {
        LAS float* Tt = (LAS float*)(F.lds + RING_OFF);
        LAS float* cs = (LAS float*)(F.lds + RING_OFF + 33792);
        LAS float* sn = cs + 128;
        if (tid < 128) { cs[tid] = cospif((float)tid * (1.0f / 64.0f)); sn[tid] = sinpif((float)tid * (1.0f / 64.0f)); }
        for (int it = F.G - 1 - F.vcu; it < 256; it += F.G) {
            const int l = it >> 7, g = (it >> 5) & 3, k0 = (it & 31) * 32;
            const float* src = INP(6) + (size_t)l * 1024 * 3072 + 2560 + g * 128;
            __syncthreads();
            { float tv[8];
#pragma unroll
                for (int i = 0; i < 8; ++i) { const int idx = tid + 512 * i, row = idx >> 7, cc = idx & 127; tv[i] = src[(size_t)(k0 + row) * 3072 + cc]; }
                PIN8(tv);
#pragma unroll
                for (int i = 0; i < 8; ++i) { const int idx = tid + 512 * i, row = idx >> 7, cc = idx & 127; Tt[row * 129 + cc] = tv[i]; } }
            __syncthreads();
            const int kk = tid & 31, og = tid >> 5, part = og >> 3, m0 = (og & 7) * 8;
            float acc[8]; float ny = 0.f;
#pragma unroll
            for (int i = 0; i < 8; ++i) acc[i] = 0.f;
            const LAS float* tab = part ? sn : cs;
#pragma unroll 2
            for (int cc = 0; cc < 128; ++cc) { const float t = Tt[kk * 129 + cc]; ny += (cc & 1) ? -t : t;
#pragma unroll
                for (int i = 0; i < 8; ++i) acc[i] += t * tab[((m0 + i) * cc) & 127]; }
            bf16* dst = WSP(bf16, WS_WP2) + (size_t)l * NP2 * 1024 + (size_t)(2560 + part * 256 + g * 64 + m0) * 1024 + k0 + kk;
            const float sg = part ? -1.f : 1.f;
#pragma unroll
            for (int i = 0; i < 8; ++i) dst[(size_t)i * 1024] = (bf16)f2bf((i == 0 && part == 1 && m0 == 0) ? ny : sg * acc[i]);
        }
        __syncthreads();
    }
    {
        LAS float* scr = (LAS float*)(F.lds + RING_OFF + wave * 8704);
        const int gw = F.vcu * NWAVES + wave, NGW = F.G * NWAVES;
        for (int it = gw; it < 8192; it += NGW) {
            const int l = it >> 12; int r = it & 4095;
            if (r < 1280) { const int kb = r / 80, nb = r % 80; transpose_item(INP(6) + (size_t)l * 1024 * 3072, 3072, kb * 64, nb * 32, WSP(bf16, WS_WP2) + (size_t)l * NP2 * 1024 + (size_t)(nb * 32) * 1024, 1024, scr, lane); continue; }
            r -= 1280;
            if (r < 1536) { const int kb = r / 96, nb = r % 96; transpose_item_fp8(INP(7) + (size_t)l * 1024 * 3072, 3072, kb * 64, nb * 32, (unsigned char*)(WSP(bf16, WS_WP2) + (size_t)l * NP2 * 1024 + (size_t)3072 * 1024) + (size_t)(nb * 32) * 1024, scr, lane); continue; }
            r -= 1536;
            if (r < 768) { const int which = r >> 8, rr = r & 255, kb = rr >> 5, nb = rr & 31; const float* src = (which == 0 ? INP(17) : (which == 1 ? INP(18) : INP(19))) + (size_t)l * 512 * 1024;
                transpose_item(src, 1024, kb * 64, nb * 32, WSP(bf16, WS_WPROJ) + (size_t)(l * 3 + which) * 1024 * 512 + (size_t)(nb * 32) * 512, 512, scr, lane); continue; }
            r -= 768;
            { const int kb = r >> 5, nb = r & 31; transpose_item(INP(20) + (size_t)l * 1024 * 1024, 1024, kb * 64, nb * 32, WSP(bf16, WS_WOUT) + (size_t)l * 1024 * 1024 + (size_t)(nb * 32) * 1024, 1024, scr, lane); }
        }
    }
    {
        const int gt = F.vcu * 512 + tid, NGT = F.G * 512;
        bf16* WL = WSP(bf16, WS_WL);
        for (int idx = gt; idx < 262144; idx += NGT) {
            const int k = idx & 63, n = (idx >> 6) & 255, nb = (idx >> 14) & 7, l = idx >> 17, gate = n >> 6, j = n & 63, dir = gate >> 1, isI = gate & 1;
            const float* src = isI ? INP(14) : INP(12);
            WL[idx] = (bf16)f2bf(src[((size_t)((l * 2 + dir) * 8 + nb) * 64 + k) * 64 + j]);
        }
        bf16* FA = WSP(bf16, WS_FA);
        for (int idx = gt; idx < 16384; idx += NGT) {
            const int m = idx >> 7, k = idx & 127, k1 = m & 63, pm_ = m >> 6, t1 = k & 63, pk = k >> 6, a = (k1 * t1) & 63;
            const float c = cospif((float)a * (1.0f / 32.0f)), s = sinpif((float)a * (1.0f / 32.0f));
            FA[idx] = (bf16)f2bf(pm_ == 0 ? (pk == 0 ? c : s) : (pk == 0 ? -s : c));
        }
        bf16* FB = WSP(bf16, WS_FB);
        for (int idx = gt; idx < 32768; idx += NGT) {
            const int k2 = idx >> 8, k = idx & 255, part = k >> 7, t2 = k & 127, a = (k2 * t2) & 127;
            FB[idx] = (bf16)f2bf(part == 0 ? cospif((float)a * (1.0f / 64.0f)) : sinpif((float)a * (1.0f / 64.0f)));
        }
        f32x2* TW = WSP(f32x2, WS_TW);
        for (int idx = gt; idx < 8192; idx += NGT) {
            const int t2 = idx >> 6, k1 = idx & 63; const float x = (float)(t2 * k1) * (1.0f / 4096.0f);
            TW[idx] = (f32x2){cospif(x), sinpif(x)};
        }
    }
}

__device__ __forceinline__ void moe_tilebase(const Frame& F0, const Args& args, int l);
template <int MODE>
__device__ __forceinline__ void rows_phase(const Frame& F0, const Args& args, int l) {
    const Frame F = fresh(F0);
    const int tid = F.tid, lane = F.lane, wave = F.wave;
    const float* MOD = WSP(float, WS_MOD);
    LAS float* gsc = (LAS float*)(F.lds + RING_OFF);
    LAS float* shf = gsc + 4096;
    LAS float* gtf = shf + 4096;
    if (MODE != 0) moe_tilebase(F, args, l - 1);
    { float tg[8], ts[8], tf[8];
#pragma unroll
        for (int i = 0; i < 8; ++i) { const int idx = tid + 512 * i, b = idx >> 10, col = idx & 1023; tg[i] = 0.f; ts[i] = 0.f; tf[i] = 0.f;
            if (MODE != 2) { tg[i] = INP(4)[l * 1024 + col] * (1.0f + MOD[(size_t)(l * 4 + b) * 6144 + 1024 + col]); ts[i] = MOD[(size_t)(l * 4 + b) * 6144 + col]; }
            else tg[i] = INP(26)[col];
            if (MODE != 0) tf[i] = MOD[(size_t)((l - 1) * 4 + b) * 6144 + 5 * 1024 + col]; }
        PIN8(tg); PIN8(ts); PIN8(tf);
#pragma unroll
        for (int i = 0; i < 8; ++i) { const int idx = tid + 512 * i; gsc[idx] = tg[i]; if (MODE != 2) shf[idx] = ts[i]; if (MODE != 0) gtf[idx] = tf[i]; } }
    __syncthreads();
    bf16* U = WSP(bf16, WS_U);
    const bf16* YE = WSP(bf16, WS_PROJ);
    const int* tokes = WSP(int, WS_TOKROW); const float* tokw = WSP(float, WS_TOKW);
    const int gw = F.vcu * NWAVES + wave, NGW = F.G * NWAVES;
    for (int m0 = gw; m0 < NTOK; m0 += 2 * NGW) {
        f32x4 v[2][4]; v2u ya[2][4], yc[2][4]; float w0[2], w1[2];
#pragma unroll
        for (int q = 0; q < 2; ++q) { const int m = m0 + q * NGW;
            if (MODE == 0) { const f32x4* xr = (const f32x4*)(INP(0) + (size_t)m * D) + lane;
#pragma unroll
                for (int j = 0; j < 4; ++j) v[q][j] = xr[64 * j]; }
            else { const v2u* xr = (const v2u*)XBROW(m) + lane;
#pragma unroll
                for (int j = 0; j < 4; ++j) { const v2u t = xr[64 * j]; v[q][j] = (f32x4){bflo(t.x), bfhi(t.x), bflo(t.y), bfhi(t.y)}; } }
            if (MODE != 0) { const int es0 = tokes[2 * m], es1 = tokes[2 * m + 1]; const int r0 = 256 * (int)F.MISC[16 + (es0 >> 16)] + (es0 & 0xffff), r1 = 256 * (int)F.MISC[16 + (es1 >> 16)] + (es1 & 0xffff); w0[q] = tokw[2 * m]; w1[q] = tokw[2 * m + 1];
                const v2u* y0 = (const v2u*)(YE + (size_t)r0 * 1024) + lane; const v2u* y1 = (const v2u*)(YE + (size_t)r1 * 1024) + lane;
#pragma unroll
                for (int j = 0; j < 4; ++j) { ya[q][j] = y0[64 * j]; yc[q][j] = y1[64 * j]; } } }
#pragma unroll
        for (int q = 0; q < 2; ++q) { const int m = m0 + q * NGW, b = m >> 13;
            if (MODE != 0) {
#pragma unroll
                for (int j = 0; j < 4; ++j) { const v2u a = ya[q][j], c = yc[q][j]; const f32x4 g = *(const LAS f32x4*)(gtf + b * 1024 + 4 * lane + 256 * j);
                    v[q][j].x += g.x * (w0[q] * bflo(a.x) + w1[q] * bflo(c.x)); v[q][j].y += g.y * (w0[q] * bfhi(a.x) + w1[q] * bfhi(c.x));
                    v[q][j].z += g.z * (w0[q] * bflo(a.y) + w1[q] * bflo(c.y)); v[q][j].w += g.w * (w0[q] * bfhi(a.y) + w1[q] * bfhi(c.y)); }
            }
            float ss = 0.f;
#pragma unroll
            for (int j = 0; j < 4; ++j) ss += (v[q][j].x * v[q][j].x + v[q][j].y * v[q][j].y) + (v[q][j].z * v[q][j].z + v[q][j].w * v[q][j].w);
            const float rstd = 1.0f / sqrtf(wave_sum(ss) * (1.0f / D) + EPS);
            if (MODE == 2) {
                f32x4* o = (f32x4*)(args.out + (size_t)m * D) + lane;
#pragma unroll
                for (int j = 0; j < 4; ++j) { const f32x4 g = *(const LAS f32x4*)(gsc + 4 * lane + 256 * j); o[64 * j] = v[q][j] * rstd * g; }
            } else {
                if (MODE == 1) { v2u* o = (v2u*)XBROW(m) + lane;
#pragma unroll
                    for (int j = 0; j < 4; ++j) o[64 * j] = (v2u){pk2(v[q][j].x, v[q][j].y), pk2(v[q][j].z, v[q][j].w)}; }
                v2u* uo = (v2u*)(U + (size_t)m * D) + lane; unsigned* u8o = (unsigned*)(args.ws + WS_U8 + (size_t)m * D) + lane;
#pragma unroll
                for (int j = 0; j < 4; ++j) { const f32x4 g = *(const LAS f32x4*)(gsc + b * 1024 + 4 * lane + 256 * j), s = *(const LAS f32x4*)(shf + b * 1024 + 4 * lane + 256 * j);
                    const f32x4 u = v[q][j] * rstd * g + s; uo[64 * j] = (v2u){pk2(u.x, u.y), pk2(u.z, u.w)}; u8o[64 * j] = pk4_fp8(u.x, u.y, u.z, u.w); }
            }
        }
    }
}

#define P2ST(ptr, val) do { const v4u v__ = (val); if (nostore) { if (win) *(v4u*)(win + ((size_t)(ptr) & 0x1FFF0)) = v__; else asm volatile("" :: "v"(v__)); } else *(v4u*)(ptr) = v__; } while (0)
struct EpiP2 {
    bool skip = false; bool nostore = false; char* win = nullptr;
    static constexpr bool PERM = true; static constexpr bool CHAINS = false;
    bf16* proj; bf16* vt;
    __device__ __forceinline__ void operator()(const f32x4 (&acc)[2][2][4][2], const pg8::Unit& u, int wr, int wc, int fr, int fq) const {
        const int row0 = u.pm * 256 + wr * 64 + fr, pn = u.pn;
        if (pn == 4 || pn == 5) {
#pragma unroll
            for (int ai = 0; ai < 2; ++ai)
#pragma unroll
                for (int m = 0; m < 4; ++m) { const int row = row0 + ai * 128 + m * 16, b = row >> 13, t = row & 8191;
#pragma unroll
                    for (int bj = 0; bj < 2; ++bj)
#pragma unroll
                        for (int n = 0; n < 2; ++n) { const int col = (pn - 4) * 256 + bj * 128 + wc * 32 + 8 * fq + 4 * n; bf16* d = vt + ((size_t)(b * 512 + col)) * 8192 + t;
                            d[0] = (bf16)f2bf(acc[ai][bj][m][n][0]); d[8192] = (bf16)f2bf(acc[ai][bj][m][n][1]); d[2 * 8192] = (bf16)f2bf(acc[ai][bj][m][n][2]); d[3 * 8192] = (bf16)f2bf(acc[ai][bj][m][n][3]); } }
        } else {
            const int cbase = (pn < 4 ? pn * 256 : (pn - 2) * 256) + wc * 32 + 8 * fq; const float sc = pn < 2 ? 0.125f : 1.0f;
#pragma unroll
            for (int ai = 0; ai < 2; ++ai)
#pragma unroll
                for (int m = 0; m < 4; ++m) { bf16* rowp = proj + (size_t)(row0 + ai * 128 + m * 16) * PROJ_LD + cbase;
#pragma unroll
                    for (int bj = 0; bj < 2; ++bj) { const f32x4 v0 = acc[ai][bj][m][0] * sc, v1 = acc[ai][bj][m][1] * sc;
                        P2ST(rowp + bj * 128, ((v4u){pk2(v0[0], v0[1]), pk2(v0[2], v0[3]), pk2(v1[0], v1[1]), pk2(v1[2], v1[3])})); } }
        }
    }
};
struct EpiGates {
    bool skip = false;
    static constexpr bool PERM = true; static constexpr bool CHAINS = false;
    bf16* gates; const float* gbias; const LAS unsigned char* stab;
    __device__ __forceinline__ void operator()(const f32x4 (&acc)[2][2][4][2], const pg8::Unit& u, int wr, int wc, int fr, int fq) const {
        {
            const int pn = u.pn;
            int fr_ = fr, fq_ = fq; asm volatile("" : "+v"(fr_), "+v"(fq_));
            const int cbase = pn * 256 + wc * 32 + 8 * fq_;
            f32x4 bv[2][2];
#pragma unroll
            for (int bj = 0; bj < 2; ++bj)
#pragma unroll
                for (int n = 0; n < 2; ++n) bv[bj][n] = (*(const f32x4*)(gbias + cbase + bj * 128 + 4 * n) + 8.0f) * 64.0f;
            const unsigned to8 = (unsigned)(((wr * 4 + wc) * 64 + fq_ * 16 + fr_) * 8);
            unsigned char* blob = (unsigned char*)gates + (size_t)(u.pm * 12 + pn) * 65536 + to8;
#pragma unroll
            for (int ai = 0; ai < 2; ++ai)
#pragma unroll
                for (int m = 0; m < 4; ++m)
#pragma unroll
                    for (int bj = 0; bj < 2; ++bj) {
                        unsigned c0[4], c1[4];
#pragma unroll
                        for (int e = 0; e < 4; ++e) {
                            const unsigned i0 = (unsigned)__builtin_amdgcn_fmed3f(acc[ai][bj][m][0][e] + bv[bj][0][e], 0.0f, 1023.0f), i1 = (unsigned)__builtin_amdgcn_fmed3f(acc[ai][bj][m][1][e] + bv[bj][1][e], 0.0f, 1023.0f);
                            c0[e] = stab[i0]; c1[e] = stab[i1]; }
                        const v2u w = (v2u){c0[0] | (c0[1] << 8) | (c0[2] << 16) | (c0[3] << 24), c1[0] | (c1[1] << 8) | (c1[2] << 16) | (c1[3] << 24)};
                        *(v2u*)(blob + ((ai * 4 + m) * 2 + bj) * 4096) = w; }
        }
    }
};
struct EpiMerge {
    bool skip = false;
    static constexpr bool PERM = true; static constexpr bool CHAINS = true;
    const bf16* gates; bf16* merged; const LAS float* rtab;
    __device__ __forceinline__ bool is_final(const pg8::Unit& u) const { return u.z == 2; }
    __device__ __forceinline__ void rescale(f32x4 (&acc)[2][2][4][2], const pg8::Unit& u, int wr, int wc, int fr, int fq) const {
        const int tid = (wr * 4 + wc) * 64 + fq * 16 + fr; const bool fin = u.z == 2;
        const char* gb0 = (const char*)gates + (size_t)(u.pm * 12 + u.z * 4 + u.pn) * 65536 + tid * 8; const char* gb1 = gb0 + 4 * 65536;
#pragma unroll
        for (int hb4 = 0; hb4 < 4; ++hb4) {
            v2u ga[4], gn[4]; unsigned pcb = hb4 * 4 * 4096; asm volatile("" : "+v"(pcb));
#pragma unroll
            for (int p = 0; p < 4; ++p) { ga[p] = *(const v2u*)(gb0 + pcb + p * 4096); gn[p] = *(const v2u*)(gb1 + pcb + p * 4096); }
#pragma unroll
            for (int p = 0; p < 4; ++p) { const int pi = hb4 * 4 + p, ai = pi >> 3, m = (pi >> 1) & 3, bj = pi & 1;
#pragma unroll
                for (int n = 0; n < 2; ++n) { const unsigned wa = n ? ga[p].y : ga[p].x, wn = fin ? 0xffffffffu : (n ? gn[p].y : gn[p].x);
#pragma unroll
                    for (int e = 0; e < 4; ++e) acc[ai][bj][m][n][e] *= (float)((wa >> (8 * e)) & 0xffu) * rtab[(wn >> (8 * e)) & 0xffu]; } }
            asm volatile("" ::: "memory");
        }
    }
    __device__ __forceinline__ void operator()(const f32x4 (&acc)[2][2][4][2], const pg8::Unit& u, int wr, int wc, int fr, int fq) const {
        const int row0 = u.pm * 256 + wr * 64 + fr, cbase = u.pn * 256 + wc * 32 + 8 * fq;
#pragma unroll
        for (int ai = 0; ai < 2; ++ai)
#pragma unroll
            for (int m = 0; m < 4; ++m) { bf16* rowp = merged + (size_t)(row0 + ai * 128 + m * 16) * 1024 + cbase;
#pragma unroll
                for (int bj = 0; bj < 2; ++bj) { const f32x4 v0 = acc[ai][bj][m][0], v1 = acc[ai][bj][m][1];
                    *(v4u*)(rowp + bj * 128) = (v4u){pk2(v0[0], v0[1]), pk2(v0[2], v0[3]), pk2(v1[0], v1[1]), pk2(v1[2], v1[3])}; } }
    }
};
template <bool F32IN>
struct EpiResid {
    bool skip = false;
    static constexpr bool PERM = true; static constexpr bool CHAINS = false;
    const float* xin32; bf16* xb0; bf16* xb1; const float* gt;
    __device__ __forceinline__ void operator()(const f32x4 (&acc)[2][2][4][2], const pg8::Unit& u, int wr, int wc, int fr, int fq) const {
        const int rt = u.pm * 256, row0 = rt + wr * 64 + fr, cbase = u.pn * 256 + wc * 32 + 8 * fq, b = rt >> 13;
        bf16* xb = (rt < XB_SPLIT) ? xb0 + (size_t)row0 * 1024 : xb1 + (size_t)(row0 - XB_SPLIT) * 1024;
        const float* xf = xin32 + (size_t)row0 * 1024;
        f32x4 gv[2][2];
#pragma unroll
        for (int bj = 0; bj < 2; ++bj)
#pragma unroll
            for (int n = 0; n < 2; ++n) gv[bj][n] = *(const f32x4*)(gt + (size_t)b * 6144 + cbase + bj * 128 + 4 * n);
#pragma unroll
        for (int hb4 = 0; hb4 < 4; ++hb4) {
            unsigned rob = (unsigned)((hb4 >> 1) * 128 + (hb4 & 1) * 32) * 1024u + (unsigned)cbase; asm volatile("" : "+v"(rob));
            f32x4 x0[4], x1[4];
#pragma unroll
            for (int p = 0; p < 4; ++p) { const unsigned ro = rob + (unsigned)((p >> 1) * 16 * 1024 + (p & 1) * 128);
                if (F32IN) { x0[p] = *(const f32x4*)(xf + ro); x1[p] = *(const f32x4*)(xf + ro + 4); }
                else { const v4u t = *(const v4u*)(xb + ro); x0[p] = (f32x4){bflo(t.x), bfhi(t.x), bflo(t.y), bfhi(t.y)}; x1[p] = (f32x4){bflo(t.z), bfhi(t.z), bflo(t.w), bfhi(t.w)}; } }
#pragma unroll
            for (int p = 0; p < 4; ++p) { const int ai = hb4 >> 1, m = (hb4 & 1) * 2 + (p >> 1), bj = p & 1; const unsigned ro = rob + (unsigned)((p >> 1) * 16 * 1024 + (p & 1) * 128);
                const f32x4 y0 = x0[p] + gv[bj][0] * acc[ai][bj][m][0], y1 = x1[p] + gv[bj][1] * acc[ai][bj][m][1];
                *(v4u*)(xb + ro) = (v4u){pk2(y0[0], y0[1]), pk2(y0[2], y0[3]), pk2(y1[0], y1[1]), pk2(y1[2], y1[3])}; }
            asm volatile("" ::: "memory");
        }
    }
};
struct EpiSwiGLU {
    bool skip = false;
    static constexpr bool PERM = true; static constexpr bool CHAINS = false;
    bf16* H;
    __device__ __forceinline__ void operator()(const f32x4 (&acc)[2][2][4][2], const pg8::Unit& u, int wr, int wc, int fr, int fq) const {
        const int row0 = u.pm * 256 + wr * 64 + fr, cbase = u.pn * 128 + wc * 32 + 8 * fq;
#pragma unroll
        for (int ai = 0; ai < 2; ++ai)
#pragma unroll
            for (int m = 0; m < 4; ++m) { f32x4 h0, h1;
#pragma unroll
                for (int e = 0; e < 4; ++e) { const float g0 = acc[ai][0][m][0][e], g1 = acc[ai][0][m][1][e]; h0[e] = g0 * sigmoidf(g0) * acc[ai][1][m][0][e]; h1[e] = g1 * sigmoidf(g1) * acc[ai][1][m][1][e]; }
                *(v4u*)(H + (size_t)(row0 + ai * 128 + m * 16) * 512 + cbase) = (v4u){pk2(h0[0], h0[1]), pk2(h0[2], h0[3]), pk2(h1[0], h1[1]), pk2(h1[2], h1[3])}; }
    }
};
struct EpiYE {
    bool skip = false;
    static constexpr bool PERM = true; static constexpr bool CHAINS = false;
    bf16* YE;
    __device__ __forceinline__ void operator()(const f32x4 (&acc)[2][2][4][2], const pg8::Unit& u, int wr, int wc, int fr, int fq) const {
        const int row0 = u.pm * 256 + wr * 64 + fr, cbase = u.pn * 256 + wc * 32 + 8 * fq;
#pragma unroll
        for (int ai = 0; ai < 2; ++ai)
#pragma unroll
            for (int m = 0; m < 4; ++m) { bf16* rowp = YE + (size_t)(row0 + ai * 128 + m * 16) * 1024 + cbase;
#pragma unroll
                for (int bj = 0; bj < 2; ++bj) { const f32x4 v0 = acc[ai][bj][m][0], v1 = acc[ai][bj][m][1];
                    *(v4u*)(rowp + bj * 128) = (v4u){pk2(v0[0], v0[1]), pk2(v0[2], v0[3]), pk2(v1[0], v1[1]), pk2(v1[2], v1[3])}; } }
    }
};

__device__ __forceinline__ void attn_unit(bf16* PROJ, const bf16* VT, const LAS float* rpb, int b, int h, int r, int qb, int lane, bf16* obase, int opitch) {
    const int qn = lane & 15, g = lane >> 4;
    const int rs = min(max(r - 4, 0), 120);
    const int cb = (qb == 0) ? 0 : ((qb == 1) ? 8 : ((qb == 2) ? 24 : 32));
    const int w = 16 * qb + qn, cs = min(max(w - 8, 0), 48);
    const size_t tokq = (size_t)b * T + r * 64 + w;
    bf16* qp = PROJ + tokq * PROJ_LD + Q_OFF + h * 64;
    bf16x8 qf0 = *(const bf16x8*)(qp + 8 * g), qf1 = *(const bf16x8*)(qp + 32 + 8 * g);
    const bf16* kbase = PROJ + ((size_t)b * T + rs * 64 + cb + qn) * PROJ_LD + K_OFF + h * 64 + 8 * g;
    f32x4 sc[16];
#pragma unroll
    for (int kt = 0; kt < 16; ++kt) {
        const int kr = kt >> 1, ch = kt & 1;
        const bf16* kp = kbase + (size_t)(kr * 64 + 16 * ch) * PROJ_LD;
        const bf16x8 kf0 = *(const bf16x8*)kp, kf1 = *(const bf16x8*)(kp + 32);
        f32x4 a = (f32x4){0.f, 0.f, 0.f, 0.f};
        a = __builtin_amdgcn_mfma_f32_16x16x32_bf16(kf0, qf0, a, 0, 0, 0);
        a = __builtin_amdgcn_mfma_f32_16x16x32_bf16(kf1, qf1, a, 0, 0, 0);
        sc[kt] = a;
    }
    const LAS float* rp = rpb + h * 465;
    float mx = -1e30f;
#pragma unroll
    for (int kt = 0; kt < 16; ++kt) {
        const int kr = kt >> 1, ch = kt & 1;
        const int brow = (rs + kr - r + 7) * 31;
#pragma unroll
        for (int j = 0; j < 4; ++j) {
            const int kc = cb + 16 * ch + 4 * g + j, dc = kc - w + 15;
            const bool ok = (kc >= cs) && (kc <= cs + 15);
            const float bias = rp[brow + (ok ? dc : 15)];
            const float s = ok ? sc[kt][j] + bias : -1e30f;
            sc[kt][j] = s; mx = fmaxf(mx, s);
        }
    }
    mx = fmaxf(mx, __shfl_xor(mx, 16)); mx = fmaxf(mx, __shfl_xor(mx, 32));
    float sum = 0.f;
#pragma unroll
    for (int kt = 0; kt < 16; ++kt)
#pragma unroll
        for (int j = 0; j < 4; ++j) { const float p = __expf(sc[kt][j] - mx); sc[kt][j] = p; sum += p; }
    sum += __shfl_xor(sum, 16); sum += __shfl_xor(sum, 32);
    const float inv = 1.0f / sum;
    f32x4 o[4];
#pragma unroll
    for (int dt = 0; dt < 4; ++dt) o[dt] = (f32x4){0.f, 0.f, 0.f, 0.f};
    const bf16* vbase = VT + ((size_t)(b * 512 + h * 64 + qn)) * T + rs * 64 + cb + 4 * g;
#pragma unroll
    for (int kr = 0; kr < 8; ++kr) {
        v4u pw; pw.x = pk2(sc[2 * kr][0], sc[2 * kr][1]); pw.y = pk2(sc[2 * kr][2], sc[2 * kr][3]); pw.z = pk2(sc[2 * kr + 1][0], sc[2 * kr + 1][1]); pw.w = pk2(sc[2 * kr + 1][2], sc[2 * kr + 1][3]);
        const bf16x8 pf = __builtin_bit_cast(bf16x8, pw);
#pragma unroll
        for (int dt = 0; dt < 4; ++dt) {
            const bf16* vp = vbase + (size_t)(16 * dt) * T + kr * 64;
            const v2u lo = *(const v2u*)vp, hi = *(const v2u*)(vp + 16);
            const v4u vw = (v4u){lo.x, lo.y, hi.x, hi.y};
            o[dt] = __builtin_amdgcn_mfma_f32_16x16x32_bf16(__builtin_bit_cast(bf16x8, vw), pf, o[dt], 0, 0, 0);
        }
    }
    bf16* op = obase + tokq * opitch + h * 64;
#pragma unroll
    for (int dt = 0; dt < 4; ++dt) *(v2u*)(op + 16 * dt + 4 * g) = (v2u){pk2(o[dt][0] * inv, o[dt][1] * inv), pk2(o[dt][2] * inv, o[dt][3] * inv)};
}
__device__ __forceinline__ void attn_phase(const Frame& F0, const Args& args, int l, bf16* obase, int opitch) {
    const Frame F = fresh(F0);
    LAS float* rpb = (LAS float*)(F.lds + RING_OFF);
    for (int i = F.tid; i < 8 * 465; i += 512) rpb[i] = INP(9)[l * 8 * 465 + i];
    __syncthreads();
    bf16* PROJ = WSP(bf16, WS_PROJ); const bf16* VT = WSP(bf16, WS_VT);
    for (int wu = F.vcu * NWAVES + F.wave; wu < 16384; wu += F.G * NWAVES) {
        const int bh = wu >> 9, rem = wu & 511;
        attn_unit(PROJ, VT, rpb, bh >> 3, bh & 7, rem >> 2, rem & 3, F.lane, obase, opitch);
    }
    __syncthreads();
}

__device__ __forceinline__ float gelu_tanh(float x) { const float u = 0.7978845608028654f * (x + 0.044715f * x * x * x); const float t = 1.0f - 2.0f * __builtin_amdgcn_rcpf(1.0f + __expf(2.0f * u)); return 0.5f * x * (1.0f + t); }
__device__ __forceinline__ void fft_a_phase(const Frame& F0, const Args& args) {
    const Frame F = fresh(F0);
    const int lane = F.lane, nl = lane & 31, hh = lane >> 5;
    const bf16* PROJ = WSP(bf16, WS_PROJ); const bf16* FA = WSP(bf16, WS_FA); const f32x2* TW = WSP(f32x2, WS_TW); bf16* ZP = WSP(bf16, WS_U);
    for (int wu = F.vcu * NWAVES + F.wave; wu < 8192; wu += F.G * NWAVES) {
        const int ct = wu & 15, t2 = (wu >> 4) & 127, b = wu >> 11;
        bf16x8 bf[8];
#pragma unroll
        for (int s = 0; s < 8; ++s) { const int part = s >> 2, t1b = 16 * (s & 3) + 8 * hh;
            const bf16* p = PROJ + ((size_t)b * T + (size_t)128 * t1b + t2) * PROJ_LD + G_OFF + part * 512 + 32 * ct + nl;
            unsigned short e[8];
#pragma unroll
            for (int j = 0; j < 8; ++j) e[j] = p[(size_t)j * 128 * PROJ_LD];
            v4u w; w.x = e[0] | ((unsigned)e[1] << 16); w.y = e[2] | ((unsigned)e[3] << 16); w.z = e[4] | ((unsigned)e[5] << 16); w.w = e[6] | ((unsigned)e[7] << 16);
            bf[s] = __builtin_bit_cast(bf16x8, w); }
        f32x16 acc[4];
#pragma unroll
        for (int mt = 0; mt < 4; ++mt) { acc[mt] = (f32x16){};
#pragma unroll
            for (int s = 0; s < 8; ++s) { const bf16x8 af = *(const bf16x8*)(FA + (32 * mt + nl) * 128 + 16 * s + 8 * hh); acc[mt] = __builtin_amdgcn_mfma_f32_32x32x16_bf16(af, bf[s], acc[mt], 0, 0, 0); } }
#pragma unroll
        for (int mt = 0; mt < 2; ++mt)
#pragma unroll
            for (int rg = 0; rg < 16; ++rg) { const int k1 = 32 * mt + (rg & 3) + 8 * (rg >> 2) + 4 * hh; const f32x2 cs = TW[t2 * 64 + k1];
                const float zr = acc[mt][rg], zi = acc[mt + 2][rg];
                bf16* d = ZP + ((size_t)(b * 64 + k1) * 128 + t2) * 1024 + 32 * ct + nl;
                d[0] = (bf16)f2bf(zr * cs.x + zi * cs.y); d[512] = (bf16)f2bf(zi * cs.x - zr * cs.y); }
    }
}
__device__ __forceinline__ void fft_b_phase(const Frame& F0, const Args& args) {
    const Frame F = fresh(F0);
    const int lane = F.lane, nl = lane & 31, hh = lane >> 5;
    bf16* PROJ = WSP(bf16, WS_PROJ); const bf16* FB = WSP(bf16, WS_FB); const bf16* ZP = WSP(bf16, WS_U);
    for (int wu = F.vcu * NWAVES + F.wave; wu < 4096; wu += F.G * NWAVES) {
        const int ct = wu & 15, k1 = (wu >> 4) & 63, b = wu >> 10;
        f32x16 acc[4];
#pragma unroll
        for (int mt = 0; mt < 4; ++mt) acc[mt] = (f32x16){};
#pragma unroll 1
        for (int sc = 0; sc < 4; ++sc) {
            bf16x8 bf[4];
#pragma unroll
            for (int q = 0; q < 4; ++q) { const int s = 4 * sc + q, part = s >> 3, t2b = 16 * (s & 7) + 8 * hh;
                const bf16* p = ZP + ((size_t)(b * 64 + k1) * 128 + t2b) * 1024 + part * 512 + 32 * ct + nl;
                unsigned short e[8];
#pragma unroll
                for (int j = 0; j < 8; ++j) e[j] = p[(size_t)j * 1024];
                v4u w; w.x = e[0] | ((unsigned)e[1] << 16); w.y = e[2] | ((unsigned)e[3] << 16); w.z = e[4] | ((unsigned)e[5] << 16); w.w = e[6] | ((unsigned)e[7] << 16);
                bf[q] = __builtin_bit_cast(bf16x8, w); }
#pragma unroll
            for (int mt = 0; mt < 4; ++mt)
#pragma unroll
                for (int q = 0; q < 4; ++q) { const bf16x8 af = *(const bf16x8*)(FB + (32 * mt + nl) * 256 + 16 * (4 * sc + q) + 8 * hh); acc[mt] = __builtin_amdgcn_mfma_f32_32x32x16_bf16(af, bf[q], acc[mt], 0, 0, 0); }
        }
#pragma unroll
        for (int mt = 0; mt < 4; ++mt)
#pragma unroll
            for (int rg = 0; rg < 16; ++rg) { const int k2 = 32 * mt + (rg & 3) + 8 * (rg >> 2) + 4 * hh;
                PROJ[((size_t)b * T + k1 + 64 * k2) * PROJ_LD + G_OFF + 32 * ct + nl] = (bf16)f2bf(acc[mt][rg] * (1.0f / 1024.0f)); }
    }
}

__device__ __forceinline__ void router_phase(const Frame& F0, const Args& args, int l, int cset) {
    const Frame F = fresh(F0);
    const int tid = F.tid, lane = F.lane, wave = F.wave;
    const float* MOD = WSP(float, WS_MOD);
    LAS unsigned char* WB = F.lds + RING_OFF;
    constexpr int RPITCH = 2064;
    LAS float* gsc = (LAS float*)(F.lds + RING_OFF + 64 * RPITCH);
    LAS float* shf = gsc + 1024;
    LAS float* c0 = shf + 1024;
    LAS float* rb = c0 + 32;
    LAS unsigned* lcnt = (LAS unsigned*)(rb + 32);
    LAS unsigned* lbase = lcnt + 32;
    LAS float* red = (LAS float*)(lbase + 32);
    bf16* U2 = WSP(bf16, WS_U);
    float* tokw = WSP(float, WS_TOKW); int* perm = WSP(int, WS_PERM); int* tokes = WSP(int, WS_TOKROW);
    unsigned* ecnt = (unsigned*)(F.ctl + CW_ECNT + cset * 32 * 64);
    const int nround = (2048 + F.G * NWAVES - 1) / (F.G * NWAVES);
    int cur_b = -1;
    for (int rd = 0; rd < nround; ++rd) {
        const int unit = (rd * F.G + F.vcu) * NWAVES + wave;
        const int ub = (((rd * F.G + F.vcu) * NWAVES) * 16) >> 13;
        const bool wg_active = ((rd * F.G + F.vcu) * NWAVES) < 2048;
        if (wg_active && ub != cur_b) {
            cur_b = ub; __syncthreads();
            for (int i = 0; i < 2; ++i) { const int col = tid + 512 * i; gsc[col] = INP(5)[l * 1024 + col] * (1.0f + MOD[(size_t)(l * 4 + ub) * 6144 + 4 * 1024 + col]); shf[col] = MOD[(size_t)(l * 4 + ub) * 6144 + 3 * 1024 + col]; }
            if (tid < 32) rb[tid] = INP(22)[tid];
            __syncthreads();
            { f32x4 wa[8], wb[8];
#pragma unroll
                for (int i = 0; i < 8; ++i) { const int it = tid + 512 * i, kp = it >> 3, e4 = it & 7; wa[i] = *(const f32x4*)(INP(21) + (2 * kp) * 32 + 4 * e4); wb[i] = *(const f32x4*)(INP(21) + (2 * kp + 1) * 32 + 4 * e4); }
                PIN8(wa); PIN8(wb);
#pragma unroll
                for (int i = 0; i < 8; ++i) { const int it = tid + 512 * i, kp = it >> 3, e4 = it & 7; const float g0 = gsc[2 * kp], g1 = gsc[2 * kp + 1];
#pragma unroll
                    for (int j = 0; j < 4; ++j) { const float p0 = g0 * wa[i][j], p1 = g1 * wb[i][j]; const unsigned h1 = pk2(p0, p1), h2 = pk2(p0 - bflo(h1), p1 - bfhi(h1));
                        LAS unsigned char* d = WB + (4 * e4 + j) * RPITCH + 4 * kp; *(LAS unsigned*)d = h1; *(LAS unsigned*)(d + 32 * RPITCH) = h2; } } }
            { const int e = tid & 31, pt = tid >> 5; float s = 0.f;
#pragma unroll 1
                for (int q4 = 0; q4 < 4; ++q4) { float wv[16];
#pragma unroll
                    for (int kk = 0; kk < 16; ++kk) wv[kk] = INP(21)[(pt * 64 + q4 * 16 + kk) * 32 + e];
#pragma unroll
                    for (int kk = 0; kk < 16; ++kk) s += shf[pt * 64 + q4 * 16 + kk] * wv[kk]; }
                red[tid] = s; }
            __syncthreads();
            if (tid < 32) { float s = 0.f; for (int p = 0; p < 16; ++p) s += red[p * 32 + tid]; c0[tid] = s; }
        }
        if (tid < 32) lcnt[tid] = 0u;
        __syncthreads();
        int e0 = 0, e1 = 0; unsigned rk0 = 0, rk1 = 0; float w0 = 0.f, w1 = 0.f; bool owner = false; int mytok = 0;
        if (unit < 2048) {
            const int tok0 = unit * 16;
            float rs_reg = 0.f;
#pragma unroll 1
            for (int i4 = 0; i4 < 16; i4 += 4) {
                f32x4 v[4][4];
#pragma unroll
                for (int q = 0; q < 4; ++q) { const v2u* xr = (const v2u*)XBROW(tok0 + i4 + q) + lane;
#pragma unroll
                    for (int j = 0; j < 4; ++j) { const v2u t = xr[64 * j]; v[q][j] = (f32x4){bflo(t.x), bfhi(t.x), bflo(t.y), bfhi(t.y)}; } }
#pragma unroll
                for (int q = 0; q < 4; ++q) { const int m = tok0 + i4 + q; float ss = 0.f;
#pragma unroll
                    for (int j = 0; j < 4; ++j) ss += (v[q][j].x * v[q][j].x + v[q][j].y * v[q][j].y) + (v[q][j].z * v[q][j].z + v[q][j].w * v[q][j].w);
                    const float rstd = 1.0f / sqrtf(wave_sum(ss) * (1.0f / D) + EPS);
                    if ((lane & 15) == i4 + q) rs_reg = rstd;
                    v2u* uo = (v2u*)(U2 + (size_t)m * D) + lane;
#pragma unroll
                    for (int j = 0; j < 4; ++j) { const f32x4 g = *(const LAS f32x4*)(gsc + 4 * lane + 256 * j), s = *(const LAS f32x4*)(shf + 4 * lane + 256 * j);
                        const f32x4 u = v[q][j] * rstd * g + s; uo[64 * j] = (v2u){pk2(u.x, u.y), pk2(u.z, u.w)}; } }
            }
            const int ti = lane & 15, kq = lane >> 4;
            const v4u* xrow = (const v4u*)(XBROW(tok0 + ti) + 256 * kq);
            const LAS unsigned char* wp = WB + ti * RPITCH + 512 * kq;
            f32x4 a0 = {0.f, 0.f, 0.f, 0.f}, a1 = {0.f, 0.f, 0.f, 0.f};
            v4u xall[32];
#pragma unroll
            for (int q = 0; q < 32; ++q) xall[q] = xrow[q];
#pragma unroll
            for (int q = 0; q < 32; ++q) { const bf16x8 bx = __builtin_bit_cast(bf16x8, xall[q]);
                const bf16x8 w00 = *(const LAS bf16x8*)(wp + 16 * q), w01 = *(const LAS bf16x8*)(wp + 16 * RPITCH + 16 * q), w10 = *(const LAS bf16x8*)(wp + 32 * RPITCH + 16 * q), w11 = *(const LAS bf16x8*)(wp + 48 * RPITCH + 16 * q);
                a0 = __builtin_amdgcn_mfma_f32_16x16x32_bf16(w00, bx, a0, 0, 0, 0); a1 = __builtin_amdgcn_mfma_f32_16x16x32_bf16(w01, bx, a1, 0, 0, 0);
                a0 = __builtin_amdgcn_mfma_f32_16x16x32_bf16(w10, bx, a0, 0, 0, 0); a1 = __builtin_amdgcn_mfma_f32_16x16x32_bf16(w11, bx, a1, 0, 0, 0);
                if ((q & 3) == 3) asm volatile("" ::: "memory"); }
            float sco[2][4], sel[2][4], gs[2];
#pragma unroll
            for (int nt = 0; nt < 2; ++nt) {
#pragma unroll
                for (int rg = 0; rg < 4; ++rg) { const int e = 16 * nt + 4 * kq + rg; const float lg = rs_reg * (nt ? a1[rg] : a0[rg]) + c0[e]; sco[nt][rg] = sigmoidf(lg); sel[nt][rg] = sco[nt][rg] + rb[e]; }
                float m1 = fmaxf(sel[nt][0], sel[nt][1]), m2 = fminf(sel[nt][0], sel[nt][1]);
                { const float v = sel[nt][2]; if (v > m1) { m2 = m1; m1 = v; } else if (v > m2) m2 = v; }
                { const float v = sel[nt][3]; if (v > m1) { m2 = m1; m1 = v; } else if (v > m2) m2 = v; }
                gs[nt] = m1 + m2; }
            float bv = gs[0]; int bg = kq; if (gs[1] > bv) { bv = gs[1]; bg = 4 + kq; }
#pragma unroll
            for (int o = 16; o < 64; o <<= 1) { const float ov = __shfl_xor(bv, o); const int og = __shfl_xor(bg, o); if (ov > bv || (ov == bv && og < bg)) { bv = ov; bg = og; } }
            owner = ((bg & 3) == kq); mytok = tok0 + ti;
            if (owner) { const int nt = bg >> 2; float cd[4], sv[4];
#pragma unroll
                for (int rg = 0; rg < 4; ++rg) { cd[rg] = nt ? sel[1][rg] : sel[0][rg]; sv[rg] = nt ? sco[1][rg] : sco[0][rg]; }
                int i1 = 0; float v1 = cd[0];
#pragma unroll
                for (int rg = 1; rg < 4; ++rg) if (cd[rg] > v1) { v1 = cd[rg]; i1 = rg; }
                int i2 = -1; float v2 = -1e30f;
#pragma unroll
                for (int rg = 0; rg < 4; ++rg) if (rg != i1 && cd[rg] > v2) { v2 = cd[rg]; i2 = rg; }
                const float s1 = (i1 == 0 ? sv[0] : (i1 == 1 ? sv[1] : (i1 == 2 ? sv[2] : sv[3]))), s2 = (i2 == 0 ? sv[0] : (i2 == 1 ? sv[1] : (i2 == 2 ? sv[2] : sv[3])));
                e0 = 4 * bg + i1; e1 = 4 * bg + i2; w0 = s1 / (s1 + s2); w1 = s2 / (s1 + s2);
                rk0 = __hip_atomic_fetch_add(lcnt + e0, 1u, __ATOMIC_RELAXED, __HIP_MEMORY_SCOPE_WORKGROUP);
                rk1 = __hip_atomic_fetch_add(lcnt + e1, 1u, __ATOMIC_RELAXED, __HIP_MEMORY_SCOPE_WORKGROUP); }
        }
        __syncthreads();
        if (tid < 32) { const unsigned n = lcnt[tid]; lbase[tid] = n ? __hip_atomic_fetch_add(ecnt + 64 * tid, n, RLX_AGENT) : 0u; }
        __syncthreads();
        if (owner) { const unsigned s0 = lbase[e0] + rk0, s1 = lbase[e1] + rk1; perm[(size_t)e0 * NTOK + s0] = 2 * mytok; perm[(size_t)e1 * NTOK + s1] = 2 * mytok + 1; tokw[2 * mytok] = w0; tokw[2 * mytok + 1] = w1;
            tokes[2 * mytok] = (e0 << 16) | (int)s0; tokes[2 * mytok + 1] = (e1 << 16) | (int)s1; }
    }
}
__device__ __forceinline__ void expert_conv(const Frame& F0, const Args& args, int l, int j0, int j1) {
    const Frame F = fresh(F0);
    const int lane = F.lane, wave = F.wave;
    LAS float* scr = (LAS float*)(F.lds + RING_OFF + wave * 8704);
    const int gw = F.vcu * NWAVES + wave, NGW = F.G * NWAVES;
    bf16* WG1 = WSP(bf16, WS_WG1); bf16* WD = WSP(bf16, WS_WD);
    auto mk = [&](int it) -> TrItem {
        const int kind = it >> 13, r = it & 8191, e = r >> 8, rr = r & 255;
        if (kind < 2) { const int kb = rr >> 4, nb = rr & 15, n0 = nb * 32; const float* src = (kind == 0 ? INP(23) : INP(24)) + (size_t)(l * 32 + e) * 1024 * 512;
            return TrItem{src, 512, kb * 64, n0, WG1 + ((size_t)e * 1024 + (n0 >> 7) * 256 + kind * 128 + (n0 & 127)) * 1024, 1024}; }
        const int kb = rr >> 5, nb = rr & 31, n0 = nb * 32; const float* src = INP(25) + (size_t)(l * 32 + e) * 512 * 1024;
        return TrItem{src, 1024, kb * 64, n0, WD + ((size_t)e * 1024 + n0) * 512, 512}; };
    for (int j = j0; j < j1; j += 2) {
        const int ia = gw + NGW * j, ib = ia + NGW; const bool va = ia < 24576, two = (j + 1 < j1) && ib < 24576;
        if (!va) break;
        const TrItem a = mk(ia), b = mk(two ? ib : ia);
        f32x4 xa[8], xb[8]; tr_load(a, xa, lane); tr_load(b, xb, lane);
        tr_finish(a, xa, scr, lane); if (two) tr_finish(b, xb, scr, lane);
    }
}
__device__ __forceinline__ void moe_tilebase(const Frame& F0, const Args& args, int l) {
    const Frame F = fresh(F0);
    __syncthreads();
    if (F.tid < 32) { unsigned* ecnt = (unsigned*)(F.ctl + CW_ECNT + l * 32 * 64); F.MISC[49 + F.tid] = __hip_atomic_load(ecnt + 64 * F.tid, RLX_AGENT); }
    __syncthreads();
    if (F.tid < 32) { const int ln = F.tid; int exc = 0, tl = 0;
#pragma unroll 8
        for (int e = 0; e < 32; ++e) { const int te = (int)((F.MISC[49 + e] + 255u) >> 8); if (e < ln) exc += te; if (e == ln) tl = te; }
        F.MISC[16 + ln] = (unsigned)exc;
        if (ln == 31) F.MISC[48] = (unsigned)(exc + tl); }
    __syncthreads();
}
__device__ __forceinline__ void moe_rowmaps(const Frame& F0, const Args& args, const pg8::MoeOrder& S, LAS int* rowmap) {
    const Frame F = fresh(F0);
    const int* perm = WSP(int, WS_PERM);
    pg8::Unit u; int idxs[8]; int nu = 0;
#pragma unroll
    for (int i = 0; i < 8; ++i) { idxs[i] = -1; if (S.next(i, u)) { idxs[i] = u.gbase + min(F.tid & 255, u.gcnt - 1); nu = i + 1; } }
    if (F.tid < 256) { int v[8];
#pragma unroll
        for (int i = 0; i < 8; ++i) v[i] = perm[idxs[i] < 0 ? 0 : idxs[i]];
#pragma unroll
        for (int i = 0; i < 8; ++i) if (idxs[i] >= 0) rowmap[i * 256 + F.tid] = v[i] >> 1; }
    __syncthreads();
}
__device__ __forceinline__ void lru_conv_phase(const Frame& F0, const Args& args, int l) {
    const Frame F = fresh(F0);
    const int lane = F.lane, cg = lane & 7, tg = lane >> 3;
    const bf16* PROJ = WSP(bf16, WS_PROJ); bf16* XC = WSP(bf16, WS_XC);
    for (int wu = F.vcu * NWAVES + F.wave; wu < 4096; wu += F.G * NWAVES) {
        const int hb = wu & 7, c = (wu >> 3) & 127, b = wu >> 10, t0 = c * 64, ch0 = hb * 64 + 8 * cg;
        const bf16* xrp = PROJ + (size_t)b * T * PROJ_LD + XR_OFF + ch0;
        v4u raw[11];
#pragma unroll
        for (int rr = 0; rr < 11; ++rr) { const int t = t0 + 8 * tg - 2 + rr, tc = min(max(t, 0), T - 1); raw[rr] = *(const v4u*)(xrp + (size_t)tc * PROJ_LD); }
        f32x4 wv[5][2];
#pragma unroll
        for (int j = 0; j < 4; ++j) { wv[j][0] = *(const f32x4*)(INP(10) + (l * 4 + j) * 512 + ch0); wv[j][1] = *(const f32x4*)(INP(10) + (l * 4 + j) * 512 + ch0 + 4); }
        wv[4][0] = *(const f32x4*)(INP(11) + l * 512 + ch0); wv[4][1] = *(const f32x4*)(INP(11) + l * 512 + ch0 + 4);
        unsigned ow[8][4];
#pragma unroll
        for (int pp = 0; pp < 4; ++pp) {
            float xl[11], xh[11];
#pragma unroll
            for (int rr = 0; rr < 11; ++rr) { const int t = t0 + 8 * tg - 2 + rr; const unsigned w = (t >= 0 && t < T) ? raw[rr][pp] : 0u; xl[rr] = bflo(w); xh[rr] = bfhi(w); }
#pragma unroll
            for (int tk = 0; tk < 8; ++tk) { float ol = wv[4][pp >> 1][2 * (pp & 1)], oh = wv[4][pp >> 1][2 * (pp & 1) + 1];
#pragma unroll
                for (int j = 0; j < 4; ++j) { ol += wv[j][pp >> 1][2 * (pp & 1)] * xl[tk + j]; oh += wv[j][pp >> 1][2 * (pp & 1) + 1] * xh[tk + j]; }
                ow[tk][pp] = pk2(ol, oh); }
        }
#pragma unroll
        for (int tk = 0; tk < 8; ++tk) *(v4u*)(XC + ((size_t)b * T + t0 + 8 * tg + tk) * 512 + ch0) = (v4u){ow[tk][0], ow[tk][1], ow[tk][2], ow[tk][3]};
    }
}
__device__ __forceinline__ void lru_load_frags(bf16x8 (&af)[4][2], const bf16* xcp, int t0, int lane) {
#pragma unroll
    for (int mt = 0; mt < 4; ++mt) { const int tau = 16 * ((lane & 15) >> 2) + 4 * mt + (lane & 3);
#pragma unroll
        for (int s = 0; s < 2; ++s) af[mt][s] = *(const bf16x8*)(xcp + (size_t)(t0 + tau) * 512 + 32 * s); }
}
template <int DBG = 0>
__device__ __forceinline__ void lru2_phase(const Frame& F0, const Args& args, int l, bf16* obase, int opitch, int ooff) {
    const Frame F = fresh(F0);
    const int lane = F.lane, wave = F.wave, dw = wave >> 2, wq = wave & 3;
    LAS bf16* HP = (LAS bf16*)(F.lds + RING_OFF);
    LAS bf16* YRT = (LAS bf16*)(F.lds + RING_OFF + 131072 + wave * 1024);
    LAS f32x2* CT = (LAS f32x2*)(F.lds + RING_OFF + 139264);
    LAS float* SG = (LAS float*)(F.lds + RING_OFF + 141312);
    __syncthreads();
#pragma unroll
    for (int q = 0; q < 4; ++q) { const int i = F.tid + 512 * q; SG[i] = 1.0f / (1.0f + __expf(16.0f - ((float)i + 0.5f) * (1.0f / 64.0f))); }
    __syncthreads();
    const bf16* PROJ = WSP(bf16, WS_PROJ); const bf16* XC = WSP(bf16, WS_XC);
    for (int un = F.vcu; un < 256; un += F.G) {
        const int b = un >> 6, hb = (un >> 3) & 7, s8 = un & 7;
        const int n = lane & 15, g = lane >> 4, hf = n >> 3, cj = n & 7;
        const int chg = hb * 64 + s8 * 8 + cj;
        const bf16* WLp = WSP(bf16, WS_WL) + ((size_t)(l * 8 + hb) * 256) * 64;
        bf16x8 bg[2], bs[2];
#pragma unroll
        for (int s = 0; s < 2; ++s) { bg[s] = *(const bf16x8*)(WLp + ((2 * dw + hf) * 64 + s8 * 8 + cj) * 64 + 32 * s + 8 * g);
            v4u sel = (v4u){0u, 0u, 0u, 0u};
            if (32 * s + 8 * g == 8 * s8) { const unsigned one = (cj & 1) ? 0x3F800000u : 0x00003F80u; sel[0] = (cj >> 1) == 0 ? one : 0u; sel[1] = (cj >> 1) == 1 ? one : 0u; sel[2] = (cj >> 1) == 2 ? one : 0u; sel[3] = (cj >> 1) == 3 ? one : 0u; }
            bs[s] = __builtin_bit_cast(bf16x8, sel); }
        const float b_r = INP(13)[(l * 2 + dw) * 512 + chg], b_i = INP(15)[(l * 2 + dw) * 512 + chg], lam = INP(16)[(l * 2 + dw) * 512 + chg];
        const float m8sp = -8.0f * ((lam > 15.f) ? __expf(-lam) : log1pf(__expf(-lam)));
        const float m8l = m8sp * 1.4426950408889634f, cbr = (b_r + 16.0f) * 64.0f, cbi = (b_i + 16.0f) * 64.0f;
        const bf16* xcp = XC + (size_t)b * T * 512 + hb * 64 + 8 * g;
        const bf16* yrp = PROJ + (size_t)b * T * PROJ_LD + YR_OFF + hb * 64 + s8 * 8;
        bf16* outp = obase + (size_t)b * T * opitch + ooff + hb * 64 + s8 * 8;
        const int pos = dw ? 7 - (2 * g + hf) : 2 * g + hf;
        float hrun = 0.f;
        bf16x8 nxt[4][2]; v4u ynx = (v4u){0u, 0u, 0u, 0u};
        { const int c0 = dw ? 127 - wq : wq; lru_load_frags(nxt, xcp, c0 * 64, lane); }
        __syncthreads();
#pragma unroll 1
        for (int rd = 0; rd < 32; ++rd) {
            const int c = dw ? 127 - (4 * rd + wq) : 4 * rd + wq, t0 = c * 64;
            const bool second = (DBG & 2) ? false : rd >= 16;
            bf16x8 af[4][2];
#pragma unroll
            for (int mt = 0; mt < 4; ++mt) { af[mt][0] = nxt[mt][0]; af[mt][1] = nxt[mt][1]; }
            const v4u ycur = ynx;
            { const int rn = min(rd + 1, 31), cn = dw ? 127 - (4 * rn + wq) : 4 * rn + wq; if (!(DBG & 1)) lru_load_frags(nxt, xcp, cn * 64, lane);
              if (rn >= 16) ynx = *(const v4u*)(yrp + (size_t)(cn * 64 + lane) * PROJ_LD); }
            if (second) *(LAS v4u*)(YRT + lane * 8) = ycur;
            f32x4 ag[4], ax[4];
#pragma unroll
            for (int mt = 0; mt < 4; ++mt) { ag[mt] = (f32x4){0.f, 0.f, 0.f, 0.f}; ax[mt] = (f32x4){0.f, 0.f, 0.f, 0.f};
#pragma unroll
                for (int s = 0; s < 2; ++s) { ag[mt] = __builtin_amdgcn_mfma_f32_16x16x32_bf16(af[mt][s], bg[s], ag[mt], 0, 0, 0); ax[mt] = __builtin_amdgcn_mfma_f32_16x16x32_bf16(af[mt][s], bs[s], ax[mt], 0, 0, 0); } }
            float a[8], bx[8], gr[8], gi[8], xv[8];
#pragma unroll
            for (int jj = 0; jj < 8; ++jj) {
                const float lo = ag[jj >> 2][jj & 3], hi = ag[2 + (jj >> 2)][jj & 3];
                const float mine = hf ? hi : lo, send = hf ? lo : hi;
                const float other = __builtin_bit_cast(float, __builtin_amdgcn_update_dpp(__builtin_bit_cast(int, send), __builtin_bit_cast(int, send), 0x128, 0xf, 0xf, false));
                gr[jj] = hf ? other : mine; gi[jj] = hf ? mine : other; xv[jj] = hf ? ax[2 + (jj >> 2)][jj & 3] : ax[jj >> 2][jj & 3]; }
#pragma unroll
            for (int jj = 0; jj < 8; ++jj) { gr[jj] = SG[(unsigned)__builtin_amdgcn_fmed3f(__builtin_fmaf(gr[jj], 64.0f, cbr), 0.0f, 2047.0f)]; gi[jj] = SG[(unsigned)__builtin_amdgcn_fmed3f(__builtin_fmaf(gi[jj], 64.0f, cbi), 0.0f, 2047.0f)]; }
#pragma unroll
            for (int jj = 0; jj < 8; ++jj) a[jj] = __builtin_amdgcn_exp2f(m8l * gr[jj]);
#pragma unroll
            for (int jj = 0; jj < 8; ++jj) bx[jj] = __builtin_amdgcn_sqrtf(__builtin_fmaf(-a[jj], a[jj], 1.0f)) * (gi[jj] * xv[jj]);
            float A8 = 1.f, B8 = 0.f;
            if (dw == 0) {
#pragma unroll
                for (int jj = 0; jj < 8; ++jj) { B8 = a[jj] * B8 + bx[jj]; A8 *= a[jj]; }
            } else {
#pragma unroll
                for (int jj = 7; jj >= 0; --jj) { B8 = a[jj] * B8 + bx[jj]; A8 *= a[jj]; }
            }
            float Ap = 1.f, Bp = 0.f, At = 1.f, Bt = 0.f;
#pragma unroll
            for (int k = 0; k < 8; ++k) { const int seg = dw ? 7 - k : k; const int src = cj + 8 * (seg & 1) + 16 * (seg >> 1);
                const float Ak = __shfl(A8, src), Bk = __shfl(B8, src);
                if (k < pos) { Bp = Ak * Bp + Bk; Ap *= Ak; }
                Bt = Ak * Bt + Bk; At *= Ak; }
            const int par = rd & 1;
            if (g == 0 && hf == 0) CT[((par * 2 + dw) * 4 + wq) * 8 + cj] = (f32x2){At, Bt};
            __syncthreads();
            float h = hrun;
#pragma unroll
            for (int q = 0; q < 4; ++q) { const f32x2 ab = CT[((par * 2 + dw) * 4 + q) * 8 + cj]; if (q < wq) h = ab.x * h + ab.y; hrun = ab.x * hrun + ab.y; }
            h = Ap * h + Bp;
            float hv[8];
            if (dw == 0) {
#pragma unroll
                for (int jj = 0; jj < 8; ++jj) { h = a[jj] * h + bx[jj]; hv[jj] = h; }
            } else {
#pragma unroll
                for (int jj = 7; jj >= 0; --jj) { h = a[jj] * h + bx[jj]; hv[jj] = h; }
            }
            const int tl0 = 16 * g + 8 * hf;
            if (DBG & 4) { if (hv[0] + hv[7] == 123.456f) outp[0] = 1; } else if (!second) {
                LAS bf16* hp = HP + ((size_t)(dw * 64 + (dw ? c - 64 : c)) * 64 + tl0) * 8 + cj;
#pragma unroll
                for (int jj = 0; jj < 8; ++jj) hp[jj * 8] = (bf16)f2bf(hv[jj]);
            } else {
                const LAS bf16* hp = HP + ((size_t)((1 - dw) * 64 + (dw ? c : c - 64)) * 64 + tl0) * 8 + cj;
                LDS_WAIT(); asm volatile("" ::: "memory");
                float yv[8], pv[8];
#pragma unroll
                for (int jj = 0; jj < 8; ++jj) { yv[jj] = bf2f(YRT[(tl0 + jj) * 8 + cj]); pv[jj] = bf2f(hp[jj * 8]); }
#pragma unroll
                for (int jj = 0; jj < 8; ++jj) { const float y = yv[jj], z = y * __builtin_fmaf(y * y, 0.044715f * 1.5957691216057308f * 64.0f, 1.5957691216057308f * 64.0f);
                    YRT[(tl0 + jj) * 8 + cj] = (bf16)f2bf((hv[jj] + pv[jj]) * (y * SG[(unsigned)__builtin_amdgcn_fmed3f(z + 1024.0f, 0.0f, 2047.0f)])); }
                LDS_WAIT(); asm volatile("" ::: "memory");
                *(v4u*)(outp + (size_t)(t0 + lane) * opitch) = *(const LAS v4u*)(YRT + lane * 8);
                LDS_WAIT(); asm volatile("" ::: "memory");
            }
        }
        __syncthreads();
    }
}
constexpr int AT_KR = 0, AT_VR = 73728, AT_VPITCH = 1168, AT_RPB = 148480, AT_XB = 150528, AT_XM = 158720;
__device__ __forceinline__ void attn2_phase(const Frame& F0, const Args& args, int l, bf16* obase, int opitch) {
    const Frame F = fresh(F0);
    const int tid = F.tid, lane = F.lane, wave = F.wave;
    LAS unsigned char* KR = F.lds + AT_KR; LAS unsigned char* VR = F.lds + AT_VR;
    LAS float* rpb = (LAS float*)(F.lds + AT_RPB);
    LAS unsigned char* XB = F.lds + AT_XB; LAS unsigned char* XM = F.lds + AT_XM;
    const bf16* PROJ = WSP(bf16, WS_PROJ); const bf16* VT = WSP(bf16, WS_VT);
    const int qb = wave & 3, dh = wave >> 2, qn = lane & 15, g = lane >> 4;
    const int cb = (qb == 0) ? 0 : ((qb == 1) ? 8 : ((qb == 2) ? 24 : 32));
    const int w = 16 * qb + qn, cs = min(max(w - 8, 0), 48);
    const int st = tid >> 3, sc = tid & 7;
    bool v0[4]; int dsel[4];
#pragma unroll
    for (int j = 0; j < 4; ++j) { const int kc0 = cb + 4 * g + j; v0[j] = (kc0 >= cs) && (kc0 <= cs + 15); dsel[j] = (v0[j] ? kc0 : kc0 + 16) - w + 15; }
    for (int un = F.vcu; un < 256; un += F.G) {
        const int bh = un >> 3, b = bh >> 3, h = bh & 7, R0 = (un & 7) * 16;
        __syncthreads();
        for (int i = tid; i < 465; i += 512) rpb[i] = INP(9)[(l * 8 + h) * 465 + i];
        const bf16* kg = PROJ + ((size_t)b * T + st) * PROJ_LD + K_OFF + h * 64 + 8 * sc;
        const bf16* vg = VT + ((size_t)(b * 512 + h * 64 + st)) * T + 8 * sc;
        const int kdst = st * 128 + ((sc ^ ((st >> 1) & 7)) * 16);
        const int vdst = st * AT_VPITCH + sc * 16;
        const int rs0 = min(max(R0 - 4, 0), 120);
        {
            v4u kk[8], vv[8];
#pragma unroll
            for (int j = 0; j < 8; ++j) { kk[j] = *(const v4u*)(kg + (size_t)(rs0 + j) * 64 * PROJ_LD); vv[j] = *(const v4u*)(vg + (rs0 + j) * 64); }
            PIN8(kk); PIN8(vv);
#pragma unroll
            for (int j = 0; j < 8; ++j) { const int slot = (rs0 + j) % 9; *(LAS v4u*)(KR + slot * 8192 + kdst) = kk[j]; *(LAS v4u*)(VR + slot * 128 + vdst) = vv[j]; }
        }
        __syncthreads();
        int have = rs0 + 7;
        v2u py0 = (v2u){0u, 0u}, py1 = (v2u){0u, 0u}; bf16* pop = nullptr;
        bf16x8 qn0, qn1;
        { const bf16* qp = PROJ + ((size_t)b * T + R0 * 64 + w) * PROJ_LD + Q_OFF + h * 64; qn0 = *(const bf16x8*)(qp + 8 * g); qn1 = *(const bf16x8*)(qp + 32 + 8 * g); }
#pragma unroll 1
        for (int s = 0; s < 16; ++s) {
            const int r = R0 + s;
            if (s > 0) { *(v2u*)pop = py0; *(v2u*)(pop + 16) = py1; }
            const size_t tokq = (size_t)b * T + r * 64 + w;
            const bf16x8 qf0 = qn0, qf1 = qn1;
            { const int r2 = min(r + 1, R0 + 15); const bf16* qp = PROJ + ((size_t)b * T + r2 * 64 + w) * PROJ_LD + Q_OFF + h * 64; qn0 = *(const bf16x8*)(qp + 8 * g); qn1 = *(const bf16x8*)(qp + 32 + 8 * g); }
            const int rsn = min(max(r + 1 - 4, 0), 120); const bool newrow = (s + 1 < 16) && (rsn + 7 > have); const int nrow = min(rsn + 7, 127);
            const v4u pk = *(const v4u*)(kg + (size_t)nrow * 64 * PROJ_LD), pv = *(const v4u*)(vg + nrow * 64);
            const int rs = min(max(r - 4, 0), 120);
            const int kr0 = 4 * dh;
            int slot0 = rs % 9 + kr0; slot0 = (slot0 >= 9) ? slot0 - 9 : slot0;
            int slot = slot0;
            f32x4 sc4[8];
#pragma unroll
            for (int kr = 0; kr < 4; ++kr) {
#pragma unroll
                for (int ch = 0; ch < 2; ++ch) { const int kt = cb + 16 * ch + qn; const LAS unsigned char* kp = KR + slot * 8192 + kt * 128; const int sw = (kt >> 1) & 7;
                    const bf16x8 kf0 = *(const LAS bf16x8*)(kp + ((g ^ sw) * 16)), kf1 = *(const LAS bf16x8*)(kp + (((4 + g) ^ sw) * 16));
                    f32x4 a = (f32x4){0.f, 0.f, 0.f, 0.f};
                    a = __builtin_amdgcn_mfma_f32_16x16x32_bf16(kf0, qf0, a, 0, 0, 0);
                    a = __builtin_amdgcn_mfma_f32_16x16x32_bf16(kf1, qf1, a, 0, 0, 0);
                    sc4[2 * kr + ch] = a; }
                slot = (slot == 8) ? 0 : slot + 1;
            }
            float sv[4][4]; float mx = -1e30f;
            const LAS float* rp = rpb + (rs - r + 7 + kr0) * 31;
#pragma unroll
            for (int kr = 0; kr < 4; ++kr)
#pragma unroll
                for (int j = 0; j < 4; ++j) { const float s = (v0[j] ? sc4[2 * kr][j] : sc4[2 * kr + 1][j]) + rp[kr * 31 + dsel[j]]; sv[kr][j] = s; mx = fmaxf(mx, s); }
            mx = fmaxf(mx, __shfl_xor(mx, 16)); mx = fmaxf(mx, __shfl_xor(mx, 32));
            float sum = 0.f;
#pragma unroll
            for (int kr = 0; kr < 4; ++kr)
#pragma unroll
                for (int j = 0; j < 4; ++j) { const float pe = __expf(sv[kr][j] - mx); sum += pe; sc4[2 * kr][j] = v0[j] ? pe : 0.f; sc4[2 * kr + 1][j] = v0[j] ? 0.f : pe; }
            sum += __shfl_xor(sum, 16); sum += __shfl_xor(sum, 32);
            f32x4 o[4];
#pragma unroll
            for (int dt = 0; dt < 4; ++dt) o[dt] = (f32x4){0.f, 0.f, 0.f, 0.f};
            slot = slot0;
            const LAS unsigned char* vb0 = VR + qn * AT_VPITCH + (cb + 4 * g) * 2;
#pragma unroll
            for (int kr = 0; kr < 4; ++kr) {
                v4u pw; pw.x = pk2(sc4[2 * kr][0], sc4[2 * kr][1]); pw.y = pk2(sc4[2 * kr][2], sc4[2 * kr][3]); pw.z = pk2(sc4[2 * kr + 1][0], sc4[2 * kr + 1][1]); pw.w = pk2(sc4[2 * kr + 1][2], sc4[2 * kr + 1][3]);
                const bf16x8 pf = __builtin_bit_cast(bf16x8, pw);
                const LAS unsigned char* vp = vb0 + slot * 128;
#pragma unroll
                for (int dt = 0; dt < 4; ++dt) { const v2u lo = *(const LAS v2u*)(vp + dt * 16 * AT_VPITCH), hi = *(const LAS v2u*)(vp + dt * 16 * AT_VPITCH + 32);
                    o[dt] = __builtin_amdgcn_mfma_f32_16x16x32_bf16(__builtin_bit_cast(bf16x8, ((v4u){lo.x, lo.y, hi.x, hi.y})), pf, o[dt], 0, 0, 0); }
                slot = (slot == 8) ? 0 : slot + 1;
            }
            { const f32x4 s0 = dh ? o[0] : o[2], s1 = dh ? o[1] : o[3];
              *(LAS v4u*)(XB + wave * 1024 + lane * 16) = (v4u){pk2(s0[0], s0[1]), pk2(s0[2], s0[3]), pk2(s1[0], s1[1]), pk2(s1[2], s1[3])};
              if (g == 0) *(LAS f32x2*)(XM + wave * 128 + qn * 8) = (f32x2){mx, sum}; }
            LDS_WAIT(); __builtin_amdgcn_s_barrier(); asm volatile("" ::: "memory");
            { const v4u pp = *(const LAS v4u*)(XB + (wave ^ 4) * 1024 + lane * 16); const f32x2 ms = *(const LAS f32x2*)(XM + (wave ^ 4) * 128 + qn * 8);
              const float m = fmaxf(mx, ms.x), fme = __expf(mx - m), fpa = __expf(ms.x - m), inv = __builtin_amdgcn_rcpf(sum * fme + ms.y * fpa), cme = fme * inv, cpa = fpa * inv;
              const f32x4 k0 = dh ? o[2] : o[0], k1 = dh ? o[3] : o[1];
              py0 = (v2u){pk2(k0[0] * cme + bflo(pp.x) * cpa, k0[1] * cme + bfhi(pp.x) * cpa), pk2(k0[2] * cme + bflo(pp.y) * cpa, k0[3] * cme + bfhi(pp.y) * cpa)};
              py1 = (v2u){pk2(k1[0] * cme + bflo(pp.z) * cpa, k1[1] * cme + bfhi(pp.z) * cpa), pk2(k1[2] * cme + bflo(pp.w) * cpa, k1[3] * cme + bfhi(pp.w) * cpa)}; }
            pop = obase + tokq * opitch + h * 64 + 32 * dh + 4 * g;
            if (newrow) { const int ns = nrow % 9; *(LAS v4u*)(KR + ns * 8192 + kdst) = pk; *(LAS v4u*)(VR + ns * 128 + vdst) = pv; have = nrow; }
            __syncthreads();
        }
        *(v2u*)pop = py0; *(v2u*)(pop + 16) = py1;
    }
    __syncthreads();
}
__device__ __forceinline__ bf16x8 lds_gather8(const LAS bf16* p, int stride) {
    unsigned short e[8];
#pragma unroll
    for (int j = 0; j < 8; ++j) e[j] = p[j * stride];
    v4u w; w.x = e[0] | ((unsigned)e[1] << 16); w.y = e[2] | ((unsigned)e[3] << 16); w.z = e[4] | ((unsigned)e[5] << 16); w.w = e[6] | ((unsigned)e[7] << 16);
    return __builtin_bit_cast(bf16x8, w);
}
constexpr int FA_PITCH = 136, FB_PITCH = 264;
__device__ __forceinline__ void fft_a2_phase(const Frame& F0, const Args& args) {
    const Frame F = fresh(F0);
    const int tid = F.tid, lane = F.lane, wave = F.wave, nl = lane & 31, hh = lane >> 5;
    LAS bf16* GT = (LAS bf16*)(F.lds + RING_OFF);
    LAS bf16* FAL = (LAS bf16*)(F.lds + RING_OFF + 65536);
    LAS f32x2* TWL = (LAS f32x2*)(F.lds + RING_OFF + 65536 + 34816);
    const bf16* PROJ = WSP(bf16, WS_PROJ); const bf16* FA = WSP(bf16, WS_FA); const f32x2* TW = WSP(f32x2, WS_TW); bf16* ZP = WSP(bf16, WS_U);
    __syncthreads();
    { v4u t[4];
#pragma unroll
        for (int i_ = 0; i_ < 4; ++i_) { const int i = tid + 512 * i_, r = i >> 4, c = i & 15; t[i_] = *(const v4u*)(FA + r * 128 + 8 * c); }
        PIN4(t);
#pragma unroll
        for (int i_ = 0; i_ < 4; ++i_) { const int i = tid + 512 * i_, r = i >> 4, c = i & 15; *(LAS v4u*)(FAL + r * FA_PITCH + 8 * c) = t[i_]; } }
    v4u v[8];
    { const int un = F.vcu; const int b = un >> 7, t2 = un & 127;
      if (un < 512) {
#pragma unroll
        for (int i = 0; i < 8; ++i) { const int idx = tid + 512 * i, k = idx >> 5, c = idx & 31, part = k >> 6, t1 = k & 63;
            v[i] = *(const v4u*)(PROJ + ((size_t)b * T + 128 * t1 + t2) * PROJ_LD + G_OFF + part * 256 + 8 * c); } } }
    for (int un = F.vcu; un < 512; un += F.G) {
        const int b = un >> 7, t2 = un & 127;
        __syncthreads();
        if (tid < 64) TWL[tid] = TW[t2 * 64 + tid];
        PIN8(v);
#pragma unroll
        for (int i = 0; i < 8; ++i) { const int idx = tid + 512 * i; *(LAS v4u*)(GT + (size_t)idx * 8) = v[i]; }
        { const int un2 = (un + F.G < 512) ? un + F.G : un; const int b2 = un2 >> 7, t22 = un2 & 127;
#pragma unroll
          for (int i = 0; i < 8; ++i) { const int idx = tid + 512 * i, k = idx >> 5, c = idx & 31, part = k >> 6, t1 = k & 63;
              v[i] = *(const v4u*)(PROJ + ((size_t)b2 * T + 128 * t1 + t22) * PROJ_LD + G_OFF + part * 256 + 8 * c); } }
        __syncthreads();
        {
            const int ch = 32 * wave + nl;
            f32x16 acc[4];
#pragma unroll
            for (int mt = 0; mt < 4; ++mt) acc[mt] = (f32x16){};
#pragma unroll 1
            for (int sc = 0; sc < 2; ++sc) {
                bf16x8 bf[4];
#pragma unroll
                for (int q4 = 0; q4 < 4; ++q4) bf[q4] = lds_gather8(GT + (16 * (4 * sc + q4) + 8 * hh) * 256 + ch, 256);
#pragma unroll
                for (int mt = 0; mt < 4; ++mt)
#pragma unroll
                    for (int q4 = 0; q4 < 4; ++q4) { const bf16x8 af = *(const LAS bf16x8*)(FAL + (32 * mt + nl) * FA_PITCH + 16 * (4 * sc + q4) + 8 * hh); acc[mt] = __builtin_amdgcn_mfma_f32_32x32x16_bf16(af, bf[q4], acc[mt], 0, 0, 0); }
            }
#pragma unroll
            for (int mt = 0; mt < 2; ++mt)
#pragma unroll
                for (int rg = 0; rg < 16; ++rg) { const int k1 = 32 * mt + (rg & 3) + 8 * (rg >> 2) + 4 * hh; const f32x2 cs = TWL[k1];
                    const float zr = acc[mt][rg], zi = acc[mt + 2][rg];
                    GT[k1 * 256 + ch] = (bf16)f2bf(zr * cs.x + zi * cs.y); GT[(64 + k1) * 256 + ch] = (bf16)f2bf(zi * cs.x - zr * cs.y);
                }
        }
        __syncthreads();
#pragma unroll
        for (int i = 0; i < 8; ++i) { const int idx = tid + 512 * i, m = idx >> 5, c = idx & 31, pp = m >> 6, k1 = m & 63;
            *(v4u*)(ZP + ((size_t)(b * 64 + k1) * 128 + t2) * 512 + pp * 256 + 8 * c) = *(const LAS v4u*)(GT + (size_t)idx * 8); }
    }
    __syncthreads();
}
__device__ __forceinline__ void fft_b2_phase(const Frame& F0, const Args& args) {
    const Frame F = fresh(F0);
    const int tid = F.tid, lane = F.lane, wave = F.wave, nl = lane & 31, hh = lane >> 5;
    LAS bf16* ZT = (LAS bf16*)(F.lds + RING_OFF);
    LAS bf16* FBL = (LAS bf16*)(F.lds + RING_OFF + 65536);
    LAS float* ZC = (LAS float*)(F.lds + RING_OFF + 65536 + 67584);
    LAS float* V0A = ZC + 512;
    LAS float* WA = V0A + 256;
    bf16* PROJ = WSP(bf16, WS_PROJ); const bf16* FB = WSP(bf16, WS_FB); const bf16* ZP = WSP(bf16, WS_U);
    __syncthreads();
    { v4u t[8];
#pragma unroll
        for (int i_ = 0; i_ < 8; ++i_) { const int i = tid + 512 * i_, r = i >> 5, c = i & 31; t[i_] = *(const v4u*)(FB + r * 256 + 8 * c); }
        PIN8(t);
#pragma unroll
        for (int i_ = 0; i_ < 8; ++i_) { const int i = tid + 512 * i_, r = i >> 5, c = i & 31; *(LAS v4u*)(FBL + r * FB_PITCH + 8 * c) = t[i_]; } }
    const int ws = wave >> 2, nt = (wave >> 1) & 1, mh = wave & 1;
    v4u v[8];
    { const int un = F.vcu; const int b = un >> 7, p = (un >> 2) & 31, g = un & 3;
      if (un < 512) {
#pragma unroll
        for (int i = 0; i < 8; ++i) { const int idx = tid + 512 * i, s = idx >> 11, k = (idx >> 3) & 255, c = idx & 7, part = k >> 7, t2 = k & 127, k1 = s ? (p ? 64 - p : 32) : p;
            v[i] = *(const v4u*)(ZP + ((size_t)(b * 64 + k1) * 128 + t2) * 512 + part * 256 + g * 64 + 8 * c); } } }
    for (int un = F.vcu; un < 512; un += F.G) {
        const int b = un >> 7, p = (un >> 2) & 31, g = un & 3;
        __syncthreads();
        PIN8(v);
#pragma unroll
        for (int i = 0; i < 8; ++i) { const int idx = tid + 512 * i; *(LAS v4u*)(ZT + (size_t)idx * 8) = v[i]; }
        { const int un2 = (un + F.G < 512) ? un + F.G : un; const int b2 = un2 >> 7, p2 = (un2 >> 2) & 31, g2 = un2 & 3;
#pragma unroll
          for (int i = 0; i < 8; ++i) { const int idx = tid + 512 * i, s = idx >> 11, k = (idx >> 3) & 255, c = idx & 7, part = k >> 7, t2 = k & 127, k1 = s ? (p2 ? 64 - p2 : 32) : p2;
              v[i] = *(const v4u*)(ZP + ((size_t)(b2 * 64 + k1) * 128 + t2) * 512 + part * 256 + g2 * 64 + 8 * c); } }
        __syncthreads();
        ZC[tid] = bf2f(ZT[(size_t)tid * 64]);
        const int ch = 32 * nt + nl;
        f32x16 acc[2];
        acc[0] = (f32x16){}; acc[1] = (f32x16){};
        { const LAS bf16* ZTs = ZT + ws * 16384;
#pragma unroll 1
          for (int sc = 0; sc < 4; ++sc) {
            bf16x8 bf[4];
#pragma unroll
            for (int q = 0; q < 4; ++q) bf[q] = lds_gather8(ZTs + (16 * (4 * sc + q) + 8 * hh) * 64 + ch, 64);
#pragma unroll
            for (int m2 = 0; m2 < 2; ++m2)
#pragma unroll
                for (int q = 0; q < 4; ++q) { const bf16x8 af = *(const LAS bf16x8*)(FBL + (64 * mh + 32 * m2 + nl) * FB_PITCH + 16 * (4 * sc + q) + 8 * hh); acc[m2] = __builtin_amdgcn_mfma_f32_32x32x16_bf16(af, bf[q], acc[m2], 0, 0, 0); }
          } }
        __syncthreads();
        {
            const int s = tid >> 8, k2 = (tid >> 1) & 127, hf = tid & 1;
            const LAS bf16* fr = FBL + k2 * FB_PITCH + 64 * hf; const LAS float* zc = ZC + s * 256 + 64 * hf;
            float w = 0.f;
#pragma unroll 2
            for (int j = 0; j < 8; ++j) { const v4u fc = *(const LAS v4u*)(fr + 8 * j), fs = *(const LAS v4u*)(fr + 128 + 8 * j);
                const f32x4 r0 = *(const LAS f32x4*)(zc + 8 * j), r1 = *(const LAS f32x4*)(zc + 8 * j + 4), i0 = *(const LAS f32x4*)(zc + 128 + 8 * j), i1 = *(const LAS f32x4*)(zc + 128 + 8 * j + 4);
                w += i0[0] * bflo(fc.x) + i0[1] * bfhi(fc.x) + i0[2] * bflo(fc.y) + i0[3] * bfhi(fc.y) + i1[0] * bflo(fc.z) + i1[1] * bfhi(fc.z) + i1[2] * bflo(fc.w) + i1[3] * bfhi(fc.w);
                w -= r0[0] * bflo(fs.x) + r0[1] * bfhi(fs.x) + r0[2] * bflo(fs.y) + r0[3] * bfhi(fs.y) + r1[0] * bflo(fs.z) + r1[1] * bfhi(fs.z) + r1[2] * bflo(fs.w) + r1[3] * bfhi(fs.w); }
            w += __shfl_xor(w, 1);
            if (hf == 0) WA[s * 128 + k2] = w * (1.0f / 1024.0f);
        }
        {
            const int kb = 64 * mh + 4 * hh;
            int hi = p ? (1 - ws) * 128 : ws * 128, lo = (p || ws) ? 127 - kb : 128 - kb, rb = (ws * 128 + kb) * 128 + ch, chm = ch ? 128 - ch : 64;
            asm volatile("" : "+v"(hi), "+v"(lo), "+v"(rb), "+v"(chm));
#pragma unroll
            for (int m2 = 0; m2 < 2; ++m2)
#pragma unroll
                for (int rg = 0; rg < 16; ++rg) { const int off = 32 * m2 + (rg & 3) + 8 * (rg >> 2); const bf16 hv = (bf16)f2bf(acc[m2][rg] * (1.0f / 1024.0f));
                    ZT[rb + off * 128] = hv; ZT[(hi + ((lo - off) & 127)) * 128 + chm] = hv; }
            if (ch == 0) {
#pragma unroll
                for (int m2 = 0; m2 < 2; ++m2)
#pragma unroll
                    for (int rg = 0; rg < 16; ++rg) V0A[ws * 128 + kb + 32 * m2 + (rg & 3) + 8 * (rg >> 2)] = acc[m2][rg] * (1.0f / 1024.0f); }
        }
        __syncthreads();
        if (tid < 256) { const int s = tid >> 7, k2 = tid & 127, rm = p ? (1 - s) * 128 + 127 - k2 : (s ? 128 + 127 - k2 : ((128 - k2) & 127));
            ZT[tid * 128] = (bf16)f2bf(0.5f * (V0A[tid] + V0A[rm])); ZT[tid * 128 + 64] = (bf16)f2bf(0.5f * (WA[tid] + WA[rm])); }
        __syncthreads();
#pragma unroll
        for (int i = 0; i < 8; ++i) { const int idx = tid + 512 * i, r = idx >> 4, c = idx & 15, s = r >> 7, k2 = r & 127, k1 = s ? (p ? 64 - p : 32) : p;
            *(v4u*)(PROJ + ((size_t)b * T + k1 + 64 * k2) * PROJ_LD + G_OFF + g * 128 + 8 * c) = *(const LAS v4u*)(ZT + (size_t)idx * 8); }
    }
    __syncthreads();
}
__device__ __forceinline__ void stagger(const Frame& F, int ticks) {
    const unsigned long long t0 = __builtin_amdgcn_s_memrealtime(), d = (unsigned long long)((F.vcu & 3) * ticks);
    while (__builtin_amdgcn_s_memrealtime() - t0 < d) __builtin_amdgcn_s_sleep(16);
}
__device__ __forceinline__ int fresh_bid() { int b = (int)blockIdx.x; asm volatile("" : "+s"(b)); return b; }
constexpr int PPL = 9, N_PHASES = 2 + PPL * DEPTH;
__global__ void __launch_bounds__(NWAVES * 64, 2) mega_fwd(Args args, int li) {
    extern __shared__ __attribute__((aligned(16))) unsigned char lds[];
    Frame F;
    F.lds = (LAS unsigned char*)lds;
    F.MISC = (volatile LAS unsigned*)(F.lds + MISC_OFF);
    F.tid = threadIdx.x; F.lane = F.tid & 63; F.wave = __builtin_amdgcn_readfirstlane(F.tid >> 6);
    F.G = gridDim.x; { const int bx = blockIdx.x; F.vcu = (F.G % 8 == 0) ? (bx % 8) * (F.G / 8) + bx / 8 : bx; }
    F.ctl = (gu32*)(args.ws + WS_CTL);
    for (int u = F.tid; u < (LDS_BYTES - LDSCTL_OFF) / 4; u += NWAVES * 64) ((LAS unsigned*)(F.lds + LDSCTL_OFF))[u] = 0u;
    __syncthreads();
    const int lo = args.ph_lo, hi = args.ph_hi;
    XcdBarrier bar; bar.bar = (unsigned*)(F.ctl + CW_BAR) + li * XCD_BAR_WORDS; bar.x = 0; bar.st = nullptr; bar.wave = F.wave;
    if (hi - lo > 1) bar = xcd_barrier_post((unsigned*)(F.ctl + CW_BAR) + li * XCD_BAR_WORDS, F.MISC + 8);
#ifndef PHMASK
#define PHMASK 0xFFFF
#endif
#define EN(kind) ((PHMASK >> (kind)) & 1)
#define IN(k) (lo <= (k) && (k) < hi)
#define SEAM(k) do { if (IN(k) && IN((k) + 1)) { xcd_barrier(bar); for (int rb_ = 0; rb_ < REP_B; ++rb_) xcd_barrier(bar); } } while (0)

    if (EN(0) && IN(0)) { for (int rep = 0; rep < 1 + REP_C; ++rep) p0_prologue(F, args); SEAM(0); }
    auto layer = [&](const int l) __attribute__((always_inline)) {
        const int pb = 1 + PPL * l;
        bf16* U = WSP(bf16, WS_U); bf16* PROJ = WSP(bf16, WS_PROJ); bf16* GATES = WSP(bf16, WS_GATES);
        if (EN(1) && IN(pb + 0)) { if (l == 0) { for (int rep = 0; rep < (REP_R & 1); ++rep) rows_phase<0>(F, args, l); rows_phase<0>(F, args, l); } else rows_phase<1>(F, args, l); SEAM(pb + 0); }
        if (EN(2) && IN(pb + 1)) {
            pg8::Gemm g{U, U, U, WSP(bf16, WS_WP2) + (size_t)l * NP2 * 1024, nullptr, nullptr, 1024, 1024, 1024};
            pg8::StaticOrder S; S.init(NTOK, 3072, F.G, fresh_bid());
            EpiP2 E{false, false, nullptr, PROJ, WSP(bf16, WS_VT)};
            const int npre = 4 * (F.vcu & 3) * (STAG_P2 != 0);
            expert_conv(F, args, l, 0, npre); __syncthreads();
            for (int rep = 0; rep < 1 + (REP_GS & 1 ? REP_G : 0); ++rep) pg8::gemm_phase<EpiP2, pg8::StaticOrder, true>(F.lds + RING_OFF, g, S, E, fresh(F).tid);
            {
                const pg8::bf16_t* U8 = (const pg8::bf16_t*)(args.ws + WS_U8); const pg8::bf16_t* W8 = WSP(bf16, WS_WP2) + (size_t)l * NP2 * 1024 + (size_t)3072 * 1024;
                pg8::Gemm g8{U8, U8, U8, W8, nullptr, nullptr, 512, 512, 512};
                pg8::StaticOrder S8; S8.init(NTOK, 3072, F.G, fresh_bid());
                LAS unsigned char* stab = F.lds + XTRA_OFF;
                { const Frame Fg = fresh(F); __syncthreads();
#pragma unroll
                  for (int q = 0; q < 2; ++q) { const int i = Fg.tid + 512 * q; const float sg = 255.0f / (1.0f + __expf(8.0f - ((float)i + 0.5f) * (1.0f / 64.0f))); stab[i] = (unsigned char)(int)fminf(fmaxf(sg + 0.5f, 1.0f), 255.0f); }
                  __syncthreads(); }
                EpiGates E8{false, GATES, INP(8) + l * 3072, stab};
                for (int rep = 0; rep < 1 + (REP_GS & 1 ? REP_G : 0); ++rep) pg8::gemm_phase<EpiGates, pg8::StaticOrder, true, false, true>(F.lds + RING_OFF, g8, S8, E8, fresh(F).tid);
            }
            __syncthreads(); expert_conv(F, args, l, npre, 12);
            SEAM(pb + 1);
        }
        if (EN(3) && IN(pb + 2)) {
            for (int rep = 0; rep < REP_M; ++rep) { if (REP_MS & 1) attn2_phase(F, args, l, WSP(bf16, WS_SCR), 512); if (REP_MS & 2) lru_conv_phase(F, args, l); if (REP_MS & 4) fft_a2_phase(F, args); if (REP_MS & 16) fft_a2_phase(F, args); }
            lru_conv_phase(F, args, l); attn2_phase(F, args, l, PROJ, PROJ_LD); fft_a2_phase(F, args); SEAM(pb + 2); }
        if (EN(4) && IN(pb + 3)) { for (int rep = 0; rep < REP_M; ++rep) { if (REP_MS & 2) lru2_phase<REP_DBG>(F, args, l, WSP(bf16, WS_SCR), 512, 0); if (REP_MS & 4) fft_b2_phase(F, args); if (REP_MS & 32) fft_b2_phase(F, args); }
            lru2_phase(F, args, l, PROJ, PROJ_LD, YR_OFF); fft_b2_phase(F, args); SEAM(pb + 3); }
        if (EN(6) && IN(pb + 4)) {
            const bf16* WP = WSP(bf16, WS_WPROJ) + (size_t)l * 3 * 1024 * 512;
            pg8::Gemm g{PROJ + Q_OFF, PROJ + YR_OFF, PROJ + G_OFF, WP, WP + 1024 * 512, WP + 2 * 1024 * 512, PROJ_LD, 512, 512};
            pg8::MergeOrder S; S.init(NTOK, 1024, F.G, fresh_bid());
            LAS float* rtab = (LAS float*)(F.lds + XTRA_OFF);
            { const Frame Fm = fresh(F); __syncthreads(); if (Fm.tid < 256) rtab[Fm.tid] = 1.0f / (float)(Fm.tid > 0 ? Fm.tid : 1); __syncthreads(); }
            EpiMerge E{false, GATES, U, rtab};
            for (int rep = 0; rep < 1 + (REP_GS & 2 ? REP_G : 0); ++rep) pg8::gemm_phase<EpiMerge, pg8::MergeOrder, true>(F.lds + RING_OFF, g, S, E, fresh(F).tid);
            SEAM(pb + 4);
        }
        if (EN(7) && IN(pb + 5)) {
            pg8::Gemm g{U, U, U, WSP(bf16, WS_WOUT) + (size_t)l * 1024 * 1024, nullptr, nullptr, 1024, 1024, 1024};
            pg8::StaticOrder S; S.init(NTOK, 1024, F.G, fresh_bid());
            if (l == 0) { EpiResid<true> E{false, INP(0), WSP(bf16, WS_XB0), WSP(bf16, WS_XB1), WSP(float, WS_MOD) + (size_t)l * 4 * 6144 + 2 * 1024};
                pg8::gemm_phase<EpiResid<true>, pg8::StaticOrder, true>(F.lds + RING_OFF, g, S, E, fresh(F).tid); }
            else { EpiResid<false> E{false, nullptr, WSP(bf16, WS_XB0), WSP(bf16, WS_XB1), WSP(float, WS_MOD) + (size_t)l * 4 * 6144 + 2 * 1024};
                pg8::gemm_phase<EpiResid<false>, pg8::StaticOrder, true>(F.lds + RING_OFF, g, S, E, fresh(F).tid); }
            SEAM(pb + 5);
        }
        if (EN(8) && IN(pb + 6)) { if (REP_R & 2) router_phase(F, args, l, 2 + l); router_phase(F, args, l, l); SEAM(pb + 6); }
        if (EN(10) && IN(pb + 7)) {
            moe_tilebase(F, args, l);
            pg8::Gemm g{U, U, U, WSP(bf16, WS_WG1), nullptr, nullptr, 1024, 1024, 1024};
            pg8::MoeOrder S{(const LAS int*)(F.lds + MISC_OFF + 64), F.G, fresh_bid()};
            LAS int* rowmap = (LAS int*)(F.lds + XTRA_OFF);
            moe_rowmaps(F, args, S, rowmap);
            EpiSwiGLU E{false, WSP(bf16, WS_H)};
            for (int rep = 0; rep < 1 + (REP_GS & 8 ? REP_G : 0); ++rep) pg8::gemm_phase<EpiSwiGLU, pg8::MoeOrder, true, true>(F.lds + RING_OFF, g, S, E, fresh(F).tid, rowmap);
            SEAM(pb + 7);
        }
        if (EN(11) && IN(pb + 8)) {
            moe_tilebase(F, args, l);
            const bf16* H = WSP(bf16, WS_H);
            pg8::Gemm g{H, H, H, WSP(bf16, WS_WD), nullptr, nullptr, 512, 512, 512};
            pg8::MoeOrder S{(const LAS int*)(F.lds + MISC_OFF + 64), F.G, fresh_bid()};
            EpiYE E{false, PROJ};
            for (int rep = 0; rep < 1 + (REP_GS & 16 ? REP_G : 0); ++rep) pg8::gemm_phase<EpiYE, pg8::MoeOrder, true>(F.lds + RING_OFF, g, S, E, fresh(F).tid);
            SEAM(pb + 8);
        }
    };
    static_assert(DEPTH == 2, "layers"); layer(0); layer(1);
    if (EN(12) && IN(N_PHASES - 1)) rows_phase<2>(F, args, DEPTH);
#undef IN
#undef SEAM
}

#ifndef MK_MODE
#define MK_MODE 0
#endif
extern "C" void kernel_launch(void* const* d_in, const int* in_sizes, int n_in, void* d_out, int out_size, void* d_ws, size_t ws_size, hipStream_t stream) {
    static int grid = 0;
    if (grid == 0) {
        if (n_in != 27 || in_sizes[0] != NTOK * D || out_size != NTOK * D || ws_size < WS_END) { fprintf(stderr, "kernel_launch: unexpected shapes (n_in %d, in0 %d, out %d, ws %zu < %zu)\n", n_in, n_in > 0 ? in_sizes[0] : -1, out_size, ws_size, (size_t)WS_END); grid = -1; return; }
        int dev = 0, cus = 0;
        if (hipGetDevice(&dev) != hipSuccess || hipDeviceGetAttribute(&cus, hipDeviceAttributeMultiprocessorCount, dev) != hipSuccess) { grid = -1; return; }
        if (hipFuncSetAttribute((const void*)mega_fwd, hipFuncAttributeMaxDynamicSharedMemorySize, LDS_BYTES) != hipSuccess) { fprintf(stderr, "kernel_launch: hipFuncSetAttribute failed\n"); grid = -1; return; }
        (void)hipGetLastError();
        grid = cus;
    }
    if (grid < 0) return;
    if (hipMemsetAsync((char*)d_ws + WS_CTL, 0, CTL_ZERO_BYTES, stream) != hipSuccess) return;
    Args a{};
    for (int i = 0; i < 27; ++i) a.in[i] = (const float*)d_in[i];
    a.out = (float*)d_out; a.ws = (unsigned char*)d_ws;
#if MK_MODE == 0
    a.ph_lo = 0; a.ph_hi = N_PHASES;
    hipLaunchKernelGGL(mega_fwd, dim3(grid), dim3(NWAVES * 64), LDS_BYTES, stream, a, 0);
#else
    for (int p = 0; p < N_PHASES; ++p) { a.ph_lo = p; a.ph_hi = p + 1; hipLaunchKernelGGL(mega_fwd, dim3(grid), dim3(NWAVES * 64), LDS_BYTES, stream, a, 0); }
#endif
}
```

```cpp
#include <hip/hip_runtime.h>
#include <cstdio>
#include <cstdint>
namespace pg8 {
#define PG8_LAS __attribute__((address_space(3)))
typedef unsigned short bf16_t;
typedef short bf16x8 __attribute__((ext_vector_type(8)));
typedef float f32x4 __attribute__((ext_vector_type(4)));
typedef unsigned u32x4 __attribute__((ext_vector_type(4)));
typedef unsigned u32x2 __attribute__((ext_vector_type(2)));
typedef int v4i_ __attribute__((ext_vector_type(4)));
constexpr int BM = 256, BK = 64, HALF = 128, HTB = HALF * BK * 2  , STAGE_BYTES = 8 * HTB, NXCD = 8, WGM = 8;

__host__ __device__ __forceinline__ int lds_byte(int r, int c) { const int st = (r >> 4) * 2 + (c >> 5), rr = r & 15, cc = c & 31, ob = rr * 64 + cc * 2; return st * 1024 + (ob ^ (((ob >> 9) & 1) << 5)); }
__host__ __device__ __forceinline__ void stage_rc(int b, int& R, int& C) { const int st = b / 1024, sb = b % 1024, swz = sb ^ (((sb >> 9) & 1) << 5); R = (st >> 1) * 16 + swz / 64; C = (st & 1) * 32 + (swz % 64) / 2; }
__host__ __device__ __forceinline__ int perm32(int rho) { const int n = rho >> 4, i = rho & 15; return 8 * (i >> 2) + 4 * n + (i & 3); }

struct Unit { int pm, pn, bt, z, gbase, gcnt; };
struct Gemm { const bf16_t* A0; const bf16_t* A1; const bf16_t* A2; const bf16_t* B0; const bf16_t* B1; const bf16_t* B2; int lda, ldb, K; };

__device__ __forceinline__ unsigned cvt_pk_bf16(float lo, float hi) { unsigned r; asm volatile("v_cvt_pk_bf16_f32 %0, %1, %2" : "=v"(r) : "v"(lo), "v"(hi)); return r; }

struct StaticOrder {
    int nM, nN, nwg, G, c;
    __device__ void init(int M, int N, int G_, int c_) { nM = M / BM; nN = N / BM; nwg = nM * nN; G = G_; c = c_; }
    __device__ __forceinline__ bool tile(long L, Unit& u) const {
        if (L >= nwg) return false;
        int wgid = (int)L; { const int q = nwg / NXCD, r = nwg % NXCD, xcd = wgid % NXCD, off = wgid / NXCD; wgid = (xcd < r ? xcd * (q + 1) : r * (q + 1) + (xcd - r) * q) + off; }
        const int nig = WGM * nN, gid = wgid / nig, fm = gid * WGM, gsz = (nM - fm) < WGM ? (nM - fm) : WGM;
        u.pm = fm + ((wgid % nig) % gsz); u.pn = (wgid % nig) / gsz; u.bt = u.pn; u.z = 0; u.gbase = 0; u.gcnt = 0; return true;
    }
    __device__ __forceinline__ bool next(int i, Unit& u) const { return tile((long)i * G + c, u); }
};
struct MergeOrder : StaticOrder {
    __device__ __forceinline__ bool next(int i, Unit& u) const { const int t = i / 3; if (!tile((long)t * G + c, u)) return false; u.z = i - 3 * t; return true; }
};
struct MoeOrder {
    const PG8_LAS int* tb; int G, c;
    __device__ __forceinline__ bool next(int i, Unit& u) const {
        const int L = i * G + c; const int nt = tb[32]; if (L >= nt * 4) return false;
        const int t = L >> 2, j = L & 3; unsigned z_ = 0u; asm volatile("" : "+v"(z_)); const int ln_ = (int)__builtin_amdgcn_mbcnt_hi(~0u, __builtin_amdgcn_mbcnt_lo(~0u, z_)); const int tbv_ = (ln_ >= 1 && ln_ < 32) ? tb[ln_] : 0x7fffffff;
        const int e = __popcll(__ballot(tbv_ <= t));
        const int tl = t - tb[e];
        u.pm = t; u.pn = j; u.bt = e * 4 + j; u.z = 0; u.gbase = e * 32768 + 256 * tl; u.gcnt = tb[33 + e] - 256 * tl; return true;
    }
};

template <class Epi, class Sched, bool ALIGN_EPI, bool GATHER = false, bool FP8 = false, int SCALE_W = 0x7F7F7F7F>
__device__ __forceinline__ void gemm_phase(PG8_LAS unsigned char* lds, const Gemm g, const Sched& S, const Epi& E, const int tid, const PG8_LAS int* rowmap = nullptr) {
    const int wid = __builtin_amdgcn_readfirstlane(tid >> 6), lane = tid & 63, wr = wid >> 2, wc = wid & 3, fr = lane & 15, fq = lane >> 4;
    const int K = g.K, nt = K / BK;
    int sc1_ = 0x7F7F7F7F; if constexpr (FP8) asm volatile("" : "+v"(sc1_));
    unsigned voffA[2], voffB[2]; int gR[2];
#pragma unroll
    for (int i = 0; i < 2; ++i) { int R, C; stage_rc(tid * 16 + i * 8192, R, C); const int Rb = Epi::PERM ? ((R & ~31) + perm32(R & 31)) : R;
        voffA[i] = GATHER ? (unsigned)C * 2u : (unsigned)(R * g.lda + C) * 2u; voffB[i] = (unsigned)(Rb * g.ldb + C) * 2u; gR[i] = R; }
    unsigned offC[2][2], offN[2][2];
#define PG8_GOFF(dst, ui_) do { _Pragma("unroll") for (int h_ = 0; h_ < 2; ++h_) _Pragma("unroll") for (int i_ = 0; i_ < 2; ++i_) dst[h_][i_] = (unsigned)rowmap[(ui_) * 256 + 128 * h_ + gR[i_]] * (unsigned)(g.lda * 2) + voffA[i_]; } while (0)
    const size_t kstep = (size_t)(BK * 2);
    const size_t hstepA = (size_t)HALF * g.lda * 2, hstepB = (size_t)HALF * g.ldb * 2;
    const size_t tstepA = 2 * hstepA, tstepB = 2 * hstepB;
    const unsigned ldsw = (unsigned)wid * 1024u;
    const int aoff = lds_byte(wr * 64 + fr, fq * 8), boff = lds_byte(wc * 32 + fr, fq * 8);
#define PG8_SA(b, h) (((b) * 2 + (h)) * HTB)
#define PG8_SB(b, h) ((4 + (b) * 2 + (h)) * HTB)
#define PG8_STAGE(bufoff, gbase, voff) do { _Pragma("unroll") for (int _i = 0; _i < 2; ++_i) { unsigned vo_ = (voff)[_i]; if constexpr (FP8) asm volatile("" : "+v"(vo_)); \
        __builtin_amdgcn_global_load_lds((const unsigned*)((const char*)(gbase) + vo_), (PG8_LAS unsigned*)(lds + (bufoff) + ldsw + _i * 8192), 16, 0, 0); } } while (0)
#define PG8_STAGE_A(bufoff, gbase, h, nf) do { _Pragma("unroll") for (int _i = 0; _i < 2; ++_i) { unsigned o_ = GATHER ? ((nf) ? offN[h][_i] : offC[h][_i]) : (voffA[_i] + (unsigned)((h) * hstepA)); if constexpr (FP8) asm volatile("" : "+v"(o_)); \
        __builtin_amdgcn_global_load_lds((const unsigned*)((const char*)(gbase) + o_), (PG8_LAS unsigned*)(lds + (bufoff) + ldsw + _i * 8192), 16, 0, 0); } } while (0)
#define PG8_LDA(dst, b, h) do { _Pragma("unroll") for (int m = 0; m < 4; ++m) _Pragma("unroll") for (int k = 0; k < 2; ++k) dst[m][k] = *(const PG8_LAS bf16x8*)(lds + PG8_SA(b, h) + aoff + m * 2048 + k * 1024); } while (0)
#define PG8_LDB(dst, b, h) do { _Pragma("unroll") for (int n = 0; n < 2; ++n) _Pragma("unroll") for (int k = 0; k < 2; ++k) dst[n][k] = *(const PG8_LAS bf16x8*)(lds + PG8_SB(b, h) + boff + n * 2048 + k * 1024); } while (0)
#define PG8_CAT8(x) __builtin_shufflevector(__builtin_bit_cast(v4i_, (x)[0]), __builtin_bit_cast(v4i_, (x)[1]), 0, 1, 2, 3, 4, 5, 6, 7)
#define PG8_MMA(ai, bj, At, Bt) do { __builtin_amdgcn_s_setprio(1); _Pragma("unroll") for (int m = 0; m < 4; ++m) _Pragma("unroll") for (int n = 0; n < 2; ++n) { \
        if constexpr (FP8) acc[ai][bj][m][n] = __builtin_amdgcn_mfma_scale_f32_16x16x128_f8f6f4(PG8_CAT8(Bt[n]), PG8_CAT8(At[m]), acc[ai][bj][m][n], 0, 0, 0, sc1_, 0, sc1_); \
        else { _Pragma("unroll") for (int k = 0; k < 2; ++k) acc[ai][bj][m][n] = __builtin_amdgcn_mfma_f32_16x16x32_bf16(Bt[n][k], At[m][k], acc[ai][bj][m][n], 0, 0, 0); } } __builtin_amdgcn_s_setprio(0); } while (0)
#define PG8_WAIT_V(n) asm volatile("s_waitcnt vmcnt(" #n ")" ::: "memory")
#define PG8_WAIT_L(n) asm volatile("s_waitcnt lgkmcnt(" #n ")" ::: "memory")
#define PG8_BAR __builtin_amdgcn_s_barrier()
#define PG8_SCHED __builtin_amdgcn_sched_barrier(0)
#define PG8_APTR(u) (GATHER ? (const char*)g.A0 : (const char*)((u).z == 0 ? g.A0 : ((u).z == 1 ? g.A1 : g.A2)) + (size_t)(u).pm * tstepA)
#define PG8_BPTR(u) ((const char*)((u).z == 0 ? g.B0 : ((u).z == 1 ? g.B1 : g.B2)) + (size_t)(u).bt * tstepB)
    Unit cur, nxt; int ui = 0;
    if (!S.next(0, cur)) return;
    f32x4 acc[2][2][4][2];
#pragma unroll
    for (int a = 0; a < 2; ++a)
#pragma unroll
        for (int b = 0; b < 2; ++b)
#pragma unroll
            for (int m = 0; m < 4; ++m)
#pragma unroll
                for (int n = 0; n < 2; ++n) acc[a][b][m][n] = (f32x4){0.f, 0.f, 0.f, 0.f};
    bf16x8 At[4][2], B0[2][2], B1[2][2];
    const char* cA = PG8_APTR(cur); const char* cB = PG8_BPTR(cur);
    if constexpr (GATHER) { PG8_GOFF(offC, 0); PG8_GOFF(offN, 0); }
    PG8_STAGE(PG8_SB(0, 0), cB, voffB); PG8_STAGE(PG8_SB(0, 1), cB + hstepB, voffB); PG8_STAGE_A(PG8_SA(0, 0), cA, 0, false); PG8_STAGE_A(PG8_SA(0, 1), cA, 1, false);
    if (wr == 1) PG8_BAR;
    PG8_WAIT_V(2); PG8_BAR;
    PG8_STAGE(PG8_SB(1, 0), cB + kstep, voffB); PG8_STAGE_A(PG8_SA(1, 0), cA + kstep, 0, false); PG8_STAGE(PG8_SB(1, 1), cB + hstepB + kstep, voffB);
    PG8_WAIT_V(6); PG8_BAR;
    for (;;) {
        const bool has_next = S.next(ui + 1, nxt);
        const char* nA = has_next ? PG8_APTR(nxt) : cA; const char* nB = has_next ? PG8_BPTR(nxt) : cB;
        if constexpr (GATHER) { if (has_next) { PG8_GOFF(offN, ui + 1); } else { _Pragma("unroll") for (int h_ = 0; h_ < 2; ++h_) _Pragma("unroll") for (int i_ = 0; i_ < 2; ++i_) offN[h_][i_] = offC[h_][i_]; } }
#pragma unroll 1
        for (int t = 0; t < nt; t += 2) {
            const bool last = (t == nt - 2);
            const char* a1 = cA + (size_t)(t + 1) * kstep;
            const char* a2 = last ? nA : cA + (size_t)(t + 2) * kstep; const char* b2 = last ? nB : cB + (size_t)(t + 2) * kstep;
            const char* a3 = a2 + kstep; const char* b3 = b2 + kstep;
            PG8_LDB(B0, 0, 0); PG8_LDB(B1, 0, 1); PG8_SCHED; PG8_LDA(At, 0, 0); PG8_STAGE_A(PG8_SA(1, 1), a1, 1, false);
            PG8_WAIT_V(8); PG8_WAIT_L(0); PG8_BAR; PG8_MMA(0, 0, At, B0); PG8_MMA(0, 1, At, B1); PG8_BAR; PG8_SCHED;
            PG8_LDA(At, 0, 1); PG8_STAGE(PG8_SB(0, 0), b2, voffB); PG8_STAGE(PG8_SB(0, 1), b2 + hstepB, voffB); PG8_STAGE_A(PG8_SA(0, 0), a2, 0, last);
            PG8_WAIT_V(8); PG8_WAIT_L(0); PG8_BAR; PG8_MMA(1, 0, At, B0); PG8_MMA(1, 1, At, B1); PG8_BAR; PG8_SCHED;
            PG8_LDB(B0, 1, 0); PG8_LDB(B1, 1, 1); PG8_SCHED; PG8_LDA(At, 1, 0); PG8_STAGE_A(PG8_SA(0, 1), a2, 1, last);
            PG8_WAIT_V(8); PG8_WAIT_L(0); PG8_BAR; PG8_MMA(0, 0, At, B0); PG8_MMA(0, 1, At, B1); PG8_BAR; PG8_SCHED;
            PG8_LDA(At, 1, 1); PG8_STAGE(PG8_SB(1, 0), b3, voffB); PG8_STAGE(PG8_SB(1, 1), b3 + hstepB, voffB); PG8_STAGE_A(PG8_SA(1, 0), a3, 0, last);
            PG8_WAIT_V(8); PG8_WAIT_L(0); PG8_BAR; PG8_MMA(1, 0, At, B0); PG8_MMA(1, 1, At, B1); PG8_BAR; PG8_SCHED;
        }
        if constexpr (ALIGN_EPI) { if (wr == 0) PG8_BAR; }
        unsigned ze_ = 0u; asm volatile("" : "+v"(ze_)); const int le_ = (int)__builtin_amdgcn_mbcnt_hi(~0u, __builtin_amdgcn_mbcnt_lo(~0u, ze_));
        bool fin_ = true;
        if constexpr (Epi::CHAINS) fin_ = E.is_final(cur);
        if constexpr (Epi::CHAINS) { E.rescale(acc, cur, wr, wc, le_ & 15, le_ >> 4); if (fin_) E(acc, cur, wr, wc, le_ & 15, le_ >> 4); }
        else if (!E.skip) E(acc, cur, wr, wc, le_ & 15, le_ >> 4); else { _Pragma("unroll") for (int a_ = 0; a_ < 2; ++a_) _Pragma("unroll") for (int b_ = 0; b_ < 2; ++b_) _Pragma("unroll") for (int m_ = 0; m_ < 4; ++m_) _Pragma("unroll") for (int n_ = 0; n_ < 2; ++n_) asm volatile("" :: "v"(acc[a_][b_][m_][n_])); }
        if (!has_next) break;
        if (fin_) {
#pragma unroll
        for (int a = 0; a < 2; ++a)
#pragma unroll
            for (int b = 0; b < 2; ++b)
#pragma unroll
                for (int m = 0; m < 4; ++m)
#pragma unroll
                    for (int n = 0; n < 2; ++n) acc[a][b][m][n] = (f32x4){0.f, 0.f, 0.f, 0.f};
        }
        cur = nxt; cA = nA; cB = nB; ++ui;
        if constexpr (GATHER) { _Pragma("unroll") for (int h_ = 0; h_ < 2; ++h_) _Pragma("unroll") for (int i_ = 0; i_ < 2; ++i_) offC[h_][i_] = offN[h_][i_]; }
        if constexpr (ALIGN_EPI) { if (wr == 1) PG8_BAR; }
    }
    PG8_WAIT_V(0);
    if constexpr (!ALIGN_EPI) { if (wr == 0) PG8_BAR; }
    PG8_BAR;
#undef PG8_SA
#undef PG8_SB
#undef PG8_STAGE
#undef PG8_LDA
#undef PG8_LDB
#undef PG8_MMA
#undef PG8_CAT8
#undef PG8_WAIT_V
#undef PG8_WAIT_L
#undef PG8_BAR
#undef PG8_SCHED
#undef PG8_APTR
#undef PG8_STAGE_A
#undef PG8_GOFF
#undef PG8_BPTR
}
}
constexpr int NWAVES = 8;
constexpr int NB = 4, T = 8192, D = 1024, NTOK = NB * T, DEPTH = 2;
constexpr int PROJ_LD = 3072, Q_OFF = 0, K_OFF = 512, XR_OFF = 1024, YR_OFF = 1536, G_OFF = 2048;
constexpr int GATES_LD = 3072;
constexpr int NP2 = 6144;
constexpr int NEXP = 32, XS_ROWS = 73728;
constexpr int LRU_CH = 32, LRU_NCH = T / LRU_CH;
constexpr float EPS = 1e-6f;

constexpr size_t MiB = 1u << 20;
constexpr size_t WS_CTL = 0, CTL_ZERO_BYTES = 1 * MiB;
constexpr size_t WS_MOD = 1 * MiB;
constexpr size_t WS_FA = WS_MOD + 256 * 1024;
constexpr size_t WS_FB = WS_FA + 32 * 1024;
constexpr size_t WS_TW = WS_FB + 64 * 1024;
constexpr size_t WS_WL = 2 * MiB;
constexpr size_t WS_TOKW = 3 * MiB;
constexpr size_t WS_TOKROW = WS_TOKW + 256 * 1024;
constexpr size_t WS_PERM = 4 * MiB;
constexpr size_t WS_WP2 = 20 * MiB;
constexpr size_t WS_WPROJ = 46 * MiB;
constexpr size_t WS_WOUT = 52 * MiB;
constexpr size_t WS_U = 56 * MiB;
constexpr size_t WS_VT = 120 * MiB;
constexpr size_t WS_PROJ = 152 * MiB;
constexpr size_t WS_GATES = 344 * MiB;
constexpr size_t WS_H = WS_GATES;
constexpr size_t WS_WG1 = WS_GATES + 96 * MiB, WS_WD = WS_GATES + 160 * MiB;
constexpr size_t WS_XC = 536 * MiB;
constexpr size_t WS_U8 = WS_XC;
constexpr size_t WS_XB0 = 568 * MiB, WS_XB1 = 8 * MiB;
constexpr int XB_SPLIT = 30720;
constexpr size_t WS_END = 628 * MiB;
constexpr size_t WS_SCR = WS_VT;
#ifndef REP_G
#define REP_G 0
#endif
#ifndef REP_C
#define REP_C 0
#endif
#ifndef STAG_P2
#define STAG_P2 600
#endif
#ifndef REP_DBG
#define REP_DBG 0
#endif
#ifndef REP_B
#define REP_B 0
#endif
#ifndef REP_R
#define REP_R 0
#endif
#ifndef REP_GS
#define REP_GS 31
#endif
#ifndef REP_MS
#define REP_MS 15
#endif
#ifndef REP_M
#define REP_M 0
#endif
static_assert(WS_H + (size_t)XS_ROWS * 512 * 2 <= WS_WG1 && WS_WD + 32 * MiB <= WS_XC, "ws map");
constexpr int CW_BAR = 4096;
constexpr int CW_ECNT = 16384;

constexpr int LDS_BYTES = 163840;
constexpr int RING_OFF = 0, RING_BYTES = 131072;
constexpr int XTRA_OFF = RING_BYTES;
constexpr int LDSCTL_OFF = LDS_BYTES - 512, MISC_OFF = LDSCTL_OFF + 64;

#define GAS __attribute__((address_space(1)))
#define LAS __attribute__((address_space(3)))
typedef unsigned short bf16;
typedef unsigned v4u __attribute__((ext_vector_type(4)));
typedef unsigned v2u __attribute__((ext_vector_type(2)));
typedef float f32x4 __attribute__((ext_vector_type(4)));
typedef float f32x2 __attribute__((ext_vector_type(2)));
typedef float f32x16 __attribute__((ext_vector_type(16)));
typedef short bf16x8 __attribute__((ext_vector_type(8)));
typedef short bf16x4 __attribute__((ext_vector_type(4)));
typedef GAS unsigned gu32;
#define RLX_AGENT __ATOMIC_RELAXED, __HIP_MEMORY_SCOPE_AGENT
#define LDS_WAIT() asm volatile("s_waitcnt lgkmcnt(0)" ::: "memory")
#define VM_WAIT() asm volatile("s_waitcnt vmcnt(0)" ::: "memory")
typedef __bf16 hwbf16x2 __attribute__((ext_vector_type(2)));
__device__ __forceinline__ unsigned pk2(float lo, float hi) { f32x2 v = {lo, hi}; hwbf16x2 b = __builtin_convertvector(v, hwbf16x2); return __builtin_bit_cast(unsigned, b); }
__device__ __forceinline__ unsigned pk4_fp8(float a, float b, float c, float d) { int p = __builtin_amdgcn_cvt_pk_fp8_f32(a, b, 0, false); return (unsigned)__builtin_amdgcn_cvt_pk_fp8_f32(c, d, p, true); }
__device__ __forceinline__ unsigned f2bf(float f) { return pk2(f, 0.f) & 0xffffu; }
__device__ __forceinline__ float bflo(unsigned w) { return __builtin_bit_cast(float, w << 16); }
__device__ __forceinline__ float bfhi(unsigned w) { return __builtin_bit_cast(float, w & 0xffff0000u); }
__device__ __forceinline__ float bf2f(unsigned short h) { return __builtin_bit_cast(float, (unsigned)h << 16); }
__device__ __forceinline__ float sigmoidf(float v) { return 1.0f / (1.0f + __expf(-v)); }
__device__ __forceinline__ float fsigmoid(float v) { return __builtin_amdgcn_rcpf(1.0f + __expf(-v)); }
#define PIN4(a) asm volatile("" : "+v"(a[0]), "+v"(a[1]), "+v"(a[2]), "+v"(a[3]))
#define PIN8(a) asm volatile("" : "+v"(a[0]), "+v"(a[1]), "+v"(a[2]), "+v"(a[3]), "+v"(a[4]), "+v"(a[5]), "+v"(a[6]), "+v"(a[7]))
__device__ __forceinline__ float wave_sum(float v) {
#pragma unroll
    for (int o = 1; o < 64; o <<= 1) v += __shfl_xor(v, o);
    return v;
}
#define XB_TMO      128
#define XB_XCNT(j)  (256  + 64 * (j))
#define XB_XSUB(j)  (1280 + 64 * (j))
#define XB_XGEN(j)  (2304 + 64 * (j))
#define XB_TOP      3328
#define XB_TOPGEN   3392
#define XCD_BAR_WORDS 3456
#define XB_SPIN_CAP (1u << 18)

__device__ __forceinline__ unsigned xb_ld(unsigned* p)              { return __hip_atomic_load(p, __ATOMIC_RELAXED, __HIP_MEMORY_SCOPE_AGENT); }
__device__ __forceinline__ unsigned xb_add(unsigned* p, unsigned v) { return __hip_atomic_fetch_add(p, v, __ATOMIC_RELAXED, __HIP_MEMORY_SCOPE_AGENT); }
__device__ __forceinline__ unsigned xb_xcc_id() { return (unsigned)__builtin_amdgcn_s_getreg((3 << 11) | 20) & 0xFu; }
#define XB_SPIN(cond, bar) do { unsigned _sp = 0; while (cond) { __builtin_amdgcn_s_sleep(1); \
    if ((++_sp & 255u) == 0u) { if (xb_ld(&(bar)[XB_TMO])) break; if (_sp > XB_SPIN_CAP) { atomicAdd(&(bar)[XB_TMO], 1u); break; } } } } while (0)

struct XcdBarrier {
    unsigned* bar; unsigned x;
    int wave;
    volatile LAS unsigned* st;
};

__device__ __forceinline__ XcdBarrier xcd_barrier_post(unsigned* bar, volatile LAS unsigned* st) {
    XcdBarrier b; b.bar = bar; b.x = xb_xcc_id(); b.st = st; b.wave = __builtin_amdgcn_readfirstlane((int)threadIdx.x >> 6);
    if (threadIdx.x == 0) (void)xb_add(&bar[XB_XCNT(b.x)], 1u);
    return b;
}
__device__ __forceinline__ void xcd_barrier_complete(unsigned* bar, unsigned x, unsigned& nloc, unsigned& nx) {
    const unsigned G = gridDim.x * gridDim.y * gridDim.z;
    unsigned sum, cnt, mine, sp = 0u;
    for (;;) {
        sum = 0u; cnt = 0u; mine = 0u;
#pragma unroll
        for (unsigned j = 0; j < 16; ++j) { const unsigned c = xb_ld(&bar[XB_XCNT(j)]); sum += c; cnt += (c > 0u) ? 1u : 0u; mine = (j == x) ? c : mine; }
        if (sum == G) break;
        __builtin_amdgcn_s_sleep(1);
        if ((++sp & 255u) == 0u) { if (xb_ld(&bar[XB_TMO])) break; if (sp > XB_SPIN_CAP) { atomicAdd(&bar[XB_TMO], 1u); break; } }
    }
    nloc = mine > 0u ? mine : 1u; nx = cnt > 0u ? cnt : 1u;
}

__device__ __forceinline__ void xcd_barrier(const XcdBarrier& b) {
    asm volatile("s_waitcnt vmcnt(0)" ::: "memory");
    __syncthreads();
    unsigned z_ = 0u; asm volatile("" : "+v"(z_));
    if (b.wave == 0 && __builtin_amdgcn_mbcnt_hi(~0u, __builtin_amdgcn_mbcnt_lo(~0u, z_)) == 0u) {
        unsigned* bar = b.bar;
        __builtin_amdgcn_s_waitcnt(0);
        unsigned nloc = b.st[0], nx = b.st[1];
        if (nloc == 0u) { xcd_barrier_complete(bar, b.x, nloc, nx); b.st[0] = nloc; b.st[1] = nx; }
        const unsigned old = xb_add(&bar[XB_XSUB(b.x)], 1u);
        const unsigned gen = old / nloc;
        if (old + 1u == (gen + 1u) * nloc) {
            __builtin_amdgcn_fence(__ATOMIC_RELEASE, "agent");
            asm volatile("s_waitcnt vmcnt(0)" ::: "memory");
            const unsigned og = xb_add(&bar[XB_TOP], 1u);
            const unsigned tg = og / nx;
            if (og + 1u == (tg + 1u) * nx) xb_add(&bar[XB_TOPGEN], 1u);
            else XB_SPIN(xb_ld(&bar[XB_TOPGEN]) == tg, bar);
            __builtin_amdgcn_fence(__ATOMIC_ACQUIRE, "agent");
            xb_add(&bar[XB_XGEN(b.x)], 1u);
            asm volatile("s_waitcnt vmcnt(0)" ::: "memory");
        } else {
            XB_SPIN(xb_ld(&bar[XB_XGEN(b.x)]) == gen, bar);
            __builtin_amdgcn_fence(__ATOMIC_ACQUIRE, "agent");
            asm volatile("s_waitcnt vmcnt(0)" ::: "memory");
        }
    }
    __syncthreads();
}

struct Args { const float* in[27]; float* out; unsigned char* ws; int ph_lo, ph_hi; };
struct Frame {
    LAS unsigned char* lds;
    volatile LAS unsigned* MISC;
    gu32* ctl;
    int tid, lane, wave, vcu, G;
};
__device__ __forceinline__ Frame fresh(const Frame& F) {
    Frame N = F; int w = F.wave; asm volatile("" : "+s"(w)); unsigned z = 0u; asm volatile("" : "+v"(z));
    const int ln = (int)__builtin_amdgcn_mbcnt_hi(~0u, __builtin_amdgcn_mbcnt_lo(~0u, z)); N.tid = w * 64 + ln; N.lane = ln; N.wave = w;
    int v = F.vcu; asm volatile("" : "+s"(v)); N.vcu = v; int g = F.G; asm volatile("" : "+s"(g)); N.G = g; return N;
}
#define WSP(T_, off) ((T_*)(args.ws + (off)))
#define XBROW(m) ((bf16*)(args.ws + ((m) < XB_SPLIT ? WS_XB0 + (size_t)(m) * 2048 : WS_XB1 + (size_t)((m) - XB_SPLIT) * 2048)))
#define INP(i) (args.in[i])

struct TrItem { const float* W; int ldw, k0, n0; bf16* dst; int ldd; };
__device__ __forceinline__ void tr_load(const TrItem& it, f32x4 (&v)[8], int lane) {
    const float* p = it.W + (size_t)(it.k0 + (lane >> 3)) * it.ldw + it.n0 + 4 * (lane & 7);
#pragma unroll
    for (int i = 0; i < 8; ++i) v[i] = *(const f32x4*)(p + (size_t)(8 * i) * it.ldw);
}
__device__ __forceinline__ void tr_finish(const TrItem& it, f32x4 (&v)[8], LAS float* scr, int lane) {
    PIN8(v);
#pragma unroll
    for (int i = 0; i < 8; ++i) { LAS float* d = scr + (8 * i + (lane >> 3)) * 33 + 4 * (lane & 7); d[0] = v[i].x; d[1] = v[i].y; d[2] = v[i].z; d[3] = v[i].w; }
    LDS_WAIT(); asm volatile("" ::: "memory");
    const int c = lane & 7;
#pragma unroll
    for (int j = 0; j < 4; ++j) { const int n = (lane >> 3) + 8 * j; const LAS float* s = scr + (8 * c) * 33 + n;
        v4u o; o.x = pk2(s[0 * 33], s[1 * 33]); o.y = pk2(s[2 * 33], s[3 * 33]); o.z = pk2(s[4 * 33], s[5 * 33]); o.w = pk2(s[6 * 33], s[7 * 33]);
        *(v4u*)(it.dst + (size_t)n * it.ldd + it.k0 + 8 * c) = o; }
    LDS_WAIT(); asm volatile("" ::: "memory");
}
__device__ __forceinline__ void transpose_item_fp8(const float* W, int ldw, int k0, int n0, unsigned char* dst8, LAS float* scr, int lane) {
    const TrItem it{W, ldw, k0, n0, nullptr, 0}; f32x4 v[8]; tr_load(it, v, lane);
    PIN8(v);
#pragma unroll
    for (int i = 0; i < 8; ++i) { LAS float* d = scr + (8 * i + (lane >> 3)) * 33 + 4 * (lane & 7); d[0] = v[i].x; d[1] = v[i].y; d[2] = v[i].z; d[3] = v[i].w; }
    LDS_WAIT(); asm volatile("" ::: "memory");
    const int c = lane & 7;
#pragma unroll
    for (int j = 0; j < 4; ++j) { const int n = (lane >> 3) + 8 * j; const LAS float* s = scr + (8 * c) * 33 + n;
        *(v2u*)(dst8 + (size_t)n * 1024 + k0 + 8 * c) = (v2u){pk4_fp8(64.f * s[0 * 33], 64.f * s[1 * 33], 64.f * s[2 * 33], 64.f * s[3 * 33]), pk4_fp8(64.f * s[4 * 33], 64.f * s[5 * 33], 64.f * s[6 * 33], 64.f * s[7 * 33])}; }
    LDS_WAIT(); asm volatile("" ::: "memory");
}
__device__ __forceinline__ void transpose_item(const float* W, int ldw, int k0, int n0, bf16* dst, int ldd, LAS float* scr, int lane) {
    const TrItem it{W, ldw, k0, n0, dst, ldd}; f32x4 v[8]; tr_load(it, v, lane); tr_finish(it, v, scr, lane);
}
__device__ __forceinline__ void p0_prologue(const Frame& F0, const Args& args) {
    const Frame F = fresh(F0);
    const int tid = F.tid, lane = F.lane, wave = F.wave;
    float* MOD = WSP(float, WS_MOD);
    {
        LAS f32x4* cact4 = (LAS f32x4*)(F.lds + RING_OFF);
        LAS float* red = (LAS float*)(F.lds + RING_OFF + 16384);
        if (F.vcu < 192) {
            const float* c = INP(1);
#pragma unroll
            for (int i = 0; i < 8; ++i) { const int idx = tid + 512 * i, b = idx >> 10, k = idx & 1023; const float v = c[b * 1024 + k]; ((LAS float*)cact4)[k * 4 + b] = v * sigmoidf(v); }
        }
        __syncthreads();
        for (int u = F.vcu; u < 192; u += F.G) {
            const int l = u / 96, j0 = (u % 96) * 64;
            const float* aw = INP(2) + (size_t)l * 1024 * 6144 + j0 + lane;
            float a0 = 0.f, a1 = 0.f, a2 = 0.f, a3 = 0.f;
#pragma unroll 32
            for (int kk = 0; kk < 128; ++kk) { const int k = 128 * wave + kk; const float wv = aw[(size_t)k * 6144]; const f32x4 c4 = cact4[k]; a0 += c4.x * wv; a1 += c4.y * wv; a2 += c4.z * wv; a3 += c4.w * wv; }
            red[(wave * 4 + 0) * 64 + lane] = a0; red[(wave * 4 + 1) * 64 + lane] = a1; red[(wave * 4 + 2) * 64 + lane] = a2; red[(wave * 4 + 3) * 64 + lane] = a3;
            __syncthreads();
            if (tid < 256) { const int b = tid >> 6, ln = tid & 63; float s = INP(3)[l * 6144 + j0 + ln];
#pragma unroll
                for (int w = 0; w < 8; ++w) s += red[(w * 4 + b) * 64 + ln];
                MOD[(size_t)(l * 4 + b) * 6144 + j0 + ln] = s; }
            __syncthreads();
        }
    }
    {
        LAS float* Tt = (LAS float*)(F.lds + RING_OFF);
        LAS float* cs = (LAS float*)(F.lds + RING_OFF + 33792);
        LAS float* sn = cs + 128;
        if (tid < 128) { cs[tid] = cospif((float)tid * (1.0f / 64.0f)); sn[tid] = sinpif((float)tid * (1.0f / 64.0f)); }
        for (int it = F.G - 1 - F.vcu; it < 256; it += F.G) {
            const int l = it >> 7, g = (it >> 5) & 3, k0 = (it & 31) * 32;
            const float* src = INP(6) + (size_t)l * 1024 * 3072 + 2560 + g * 128;
            __syncthreads();
            { float tv[8];
#pragma unroll
                for (int i = 0; i < 8; ++i) { const int idx = tid + 512 * i, row = idx >> 7, cc = idx & 127; tv[i] = src[(size_t)(k0 + row) * 3072 + cc]; }
                PIN8(tv);
#pragma unroll
                for (int i = 0; i < 8; ++i) { const int idx = tid + 512 * i, row = idx >> 7, cc = idx & 127; Tt[row * 129 + cc] = tv[i]; } }
            __syncthreads();
            const int kk = tid & 31, og = tid >> 5, part = og >> 3, m0 = (og & 7) * 8;
            float acc[8]; float ny = 0.f;
#pragma unroll
            for (int i = 0; i < 8; ++i) acc[i] = 0.f;
            const LAS float* tab = part ? sn : cs;
#pragma unroll 2
            for (int cc = 0; cc < 128; ++cc) { const float t = Tt[kk * 129 + cc]; ny += (cc & 1) ? -t : t;
#pragma unroll
                for (int i = 0; i < 8; ++i) acc[i] += t * tab[((m0 + i) * cc) & 127]; }
            bf16* dst = WSP(bf16, WS_WP2) + (size_t)l * NP2 * 1024 + (size_t)(2560 + part * 256 + g * 64 + m0) * 1024 + k0 + kk;
            const float sg = part ? -1.f : 1.f;
#pragma unroll
            for (int i = 0; i < 8; ++i) dst[(size_t)i * 1024] = (bf16)f2bf((i == 0 && part == 1 && m0 == 0) ? ny : sg * acc[i]);
        }
        __syncthreads();
    }
    {
        LAS float* scr = (LAS float*)(F.lds + RING_OFF + wave * 8704);
        const int gw = F.vcu * NWAVES + wave, NGW = F.G * NWAVES;
        for (int it = gw; it < 8192; it += NGW) {
            const int l = it >> 12; int r = it & 4095;
            if (r < 1280) { const int kb = r / 80, nb = r % 80; transpose_item(INP(6) + (size_t)l * 1024 * 3072, 3072, kb * 64, nb * 32, WSP(bf16, WS_WP2) + (size_t)l * NP2 * 1024 + (size_t)(nb * 32) * 1024, 1024, scr, lane); continue; }
            r -= 1280;
            if (r < 1536) { const int kb = r / 96, nb = r % 96; transpose_item_fp8(INP(7) + (size_t)l * 1024 * 3072, 3072, kb * 64, nb * 32, (unsigned char*)(WSP(bf16, WS_WP2) + (size_t)l * NP2 * 1024 + (size_t)3072 * 1024) + (size_t)(nb * 32) * 1024, scr, lane); continue; }
            r -= 1536;
            if (r < 768) { const int which = r >> 8, rr = r & 255, kb = rr >> 5, nb = rr & 31; const float* src = (which == 0 ? INP(17) : (which == 1 ? INP(18) : INP(19))) + (size_t)l * 512 * 1024;
                transpose_item(src, 1024, kb * 64, nb * 32, WSP(bf16, WS_WPROJ) + (size_t)(l * 3 + which) * 1024 * 512 + (size_t)(nb * 32) * 512, 512, scr, lane); continue; }
            r -= 768;
            { const int kb = r >> 5, nb = r & 31; transpose_item(INP(20) + (size_t)l * 1024 * 1024, 1024, kb * 64, nb * 32, WSP(bf16, WS_WOUT) + (size_t)l * 1024 * 1024 + (size_t)(nb * 32) * 1024, 1024, scr, lane); }
        }
    }
    {
        const int gt = F.vcu * 512 + tid, NGT = F.G * 512;
        bf16* WL = WSP(bf16, WS_WL);
        for (int idx = gt; idx < 262144; idx += NGT) {
            const int k = idx & 63, n = (idx >> 6) & 255, nb = (idx >> 14) & 7, l = idx >> 17, gate = n >> 6, j = n & 63, dir = gate >> 1, isI = gate & 1;
            const float* src = isI ? INP(14) : INP(12);
            WL[idx] = (bf16)f2bf(src[((size_t)((l * 2 + dir) * 8 + nb) * 64 + k) * 64 + j]);
        }
        bf16* FA = WSP(bf16, WS_FA);
        for (int idx = gt; idx < 16384; idx += NGT) {
            const int m = idx >> 7, k = idx & 127, k1 = m & 63, pm_ = m >> 6, t1 = k & 63, pk = k >> 6, a = (k1 * t1) & 63;
            const float c = cospif((float)a * (1.0f / 32.0f)), s = sinpif((float)a * (1.0f / 32.0f));
            FA[idx] = (bf16)f2bf(pm_ == 0 ? (pk == 0 ? c : s) : (pk == 0 ? -s : c));
        }
        bf16* FB = WSP(bf16, WS_FB);
        for (int idx = gt; idx < 32768; idx += NGT) {
            const int k2 = idx >> 8, k = idx & 255, part = k >> 7, t2 = k & 127, a = (k2 * t2) & 127;
            FB[idx] = (bf16)f2bf(part == 0 ? cospif((float)a * (1.0f / 64.0f)) : sinpif((float)a * (1.0f / 64.0f)));
        }
        f32x2* TW = WSP(f32x2, WS_TW);
        for (int idx = gt; idx < 8192; idx += NGT) {
            const int t2 = idx >> 6, k1 = idx & 63; const float x = (float)(t2 * k1) * (1.0f / 4096.0f);
            TW[idx] = (f32x2){cospif(x), sinpif(x)};
        }
    }
}

__device__ __forceinline__ void moe_tilebase(const Frame& F0, const Args& args, int l);
template <int MODE>
__device__ __forceinline__ void rows_phase(const Frame& F0, const Args& args, int l) {
    const Frame F = fresh(F0);
    const int tid = F.tid, lane = F.lane, wave = F.wave;
    const float* MOD = WSP(float, WS_MOD);
    LAS float* gsc = (LAS float*)(F.lds + RING_OFF);
    LAS float* shf = gsc + 4096;
    LAS float* gtf = shf + 4096;
    if (MODE != 0) moe_tilebase(F, args, l - 1);
    { float tg[8], ts[8], tf[8];
#pragma unroll
        for (int i = 0; i < 8; ++i) { const int idx = tid + 512 * i, b = idx >> 10, col = idx & 1023; tg[i] = 0.f; ts[i] = 0.f; tf[i] = 0.f;
            if (MODE != 2) { tg[i] = INP(4)[l * 1024 + col] * (1.0f + MOD[(size_t)(l * 4 + b) * 6144 + 1024 + col]); ts[i] = MOD[(size_t)(l * 4 + b) * 6144 + col]; }
            else tg[i] = INP(26)[col];
            if (MODE != 0) tf[i] = MOD[(size_t)((l - 1) * 4 + b) * 6144 + 5 * 1024 + col]; }
        PIN8(tg); PIN8(ts); PIN8(tf);
#pragma unroll
        for (int i = 0; i < 8; ++i) { const int idx = tid + 512 * i; gsc[idx] = tg[i]; if (MODE != 2) shf[idx] = ts[i]; if (MODE != 0) gtf[idx] = tf[i]; } }
    __syncthreads();
    bf16* U = WSP(bf16, WS_U);
    const bf16* YE = WSP(bf16, WS_PROJ);
    const int* tokes = WSP(int, WS_TOKROW); const float* tokw = WSP(float, WS_TOKW);
    const int gw = F.vcu * NWAVES + wave, NGW = F.G * NWAVES;
    for (int m0 = gw; m0 < NTOK; m0 += 2 * NGW) {
        f32x4 v[2][4]; v2u ya[2][4], yc[2][4]; float w0[2], w1[2];
#pragma unroll
        for (int q = 0; q < 2; ++q) { const int m = m0 + q * NGW;
            if (MODE == 0) { const f32x4* xr = (const f32x4*)(INP(0) + (size_t)m * D) + lane;
#pragma unroll
                for (int j = 0; j < 4; ++j) v[q][j] = xr[64 * j]; }
            else { const v2u* xr = (const v2u*)XBROW(m) + lane;
#pragma unroll
                for (int j = 0; j < 4; ++j) { const v2u t = xr[64 * j]; v[q][j] = (f32x4){bflo(t.x), bfhi(t.x), bflo(t.y), bfhi(t.y)}; } }
            if (MODE != 0) { const int es0 = tokes[2 * m], es1 = tokes[2 * m + 1]; const int r0 = 256 * (int)F.MISC[16 + (es0 >> 16)] + (es0 & 0xffff), r1 = 256 * (int)F.MISC[16 + (es1 >> 16)] + (es1 & 0xffff); w0[q] = tokw[2 * m]; w1[q] = tokw[2 * m + 1];
                const v2u* y0 = (const v2u*)(YE + (size_t)r0 * 1024) + lane; const v2u* y1 = (const v2u*)(YE + (size_t)r1 * 1024) + lane;
#pragma unroll
                for (int j = 0; j < 4; ++j) { ya[q][j] = y0[64 * j]; yc[q][j] = y1[64 * j]; } } }
#pragma unroll
        for (int q = 0; q < 2; ++q) { const int m = m0 + q * NGW, b = m >> 13;
            if (MODE != 0) {
#pragma unroll
                for (int j = 0; j < 4; ++j) { const v2u a = ya[q][j], c = yc[q][j]; const f32x4 g = *(const LAS f32x4*)(gtf + b * 1024 + 4 * lane + 256 * j);
                    v[q][j].x += g.x * (w0[q] * bflo(a.x) + w1[q] * bflo(c.x)); v[q][j].y += g.y * (w0[q] * bfhi(a.x) + w1[q] * bfhi(c.x));
                    v[q][j].z += g.z * (w0[q] * bflo(a.y) + w1[q] * bflo(c.y)); v[q][j].w += g.w * (w0[q] * bfhi(a.y) + w1[q] * bfhi(c.y)); }
            }
            float ss = 0.f;
#pragma unroll
            for (int j = 0; j < 4; ++j) ss += (v[q][j].x * v[q][j].x + v[q][j].y * v[q][j].y) + (v[q][j].z * v[q][j].z + v[q][j].w * v[q][j].w);
            const float rstd = 1.0f / sqrtf(wave_sum(ss) * (1.0f / D) + EPS);
            if (MODE == 2) {
                f32x4* o = (f32x4*)(args.out + (size_t)m * D) + lane;
#pragma unroll
                for (int j = 0; j < 4; ++j) { const f32x4 g = *(const LAS f32x4*)(gsc + 4 * lane + 256 * j); o[64 * j] = v[q][j] * rstd * g; }
            } else {
                if (MODE == 1) { v2u* o = (v2u*)XBROW(m) + lane;
#pragma unroll
                    for (int j = 0; j < 4; ++j) o[64 * j] = (v2u){pk2(v[q][j].x, v[q][j].y), pk2(v[q][j].z, v[q][j].w)}; }
                v2u* uo = (v2u*)(U + (size_t)m * D) + lane; unsigned* u8o = (unsigned*)(args.ws + WS_U8 + (size_t)m * D) + lane;
#pragma unroll
                for (int j = 0; j < 4; ++j) { const f32x4 g = *(const LAS f32x4*)(gsc + b * 1024 + 4 * lane + 256 * j), s = *(const LAS f32x4*)(shf + b * 1024 + 4 * lane + 256 * j);
                    const f32x4 u = v[q][j] * rstd * g + s; uo[64 * j] = (v2u){pk2(u.x, u.y), pk2(u.z, u.w)}; u8o[64 * j] = pk4_fp8(u.x, u.y, u.z, u.w); }
            }
        }
    }
}

#define P2ST(ptr, val) do { const v4u v__ = (val); if (nostore) { if (win) *(v4u*)(win + ((size_t)(ptr) & 0x1FFF0)) = v__; else asm volatile("" :: "v"(v__)); } else *(v4u*)(ptr) = v__; } while (0)
struct EpiP2 {
    bool skip = false; bool nostore = false; char* win = nullptr;
    static constexpr bool PERM = true; static constexpr bool CHAINS = false;
    bf16* proj; bf16* vt;
    __device__ __forceinline__ void operator()(const f32x4 (&acc)[2][2][4][2], const pg8::Unit& u, int wr, int wc, int fr, int fq) const {
        const int row0 = u.pm * 256 + wr * 64 + fr, pn = u.pn;
        if (pn == 4 || pn == 5) {
#pragma unroll
            for (int ai = 0; ai < 2; ++ai)
#pragma unroll
                for (int m = 0; m < 4; ++m) { const int row = row0 + ai * 128 + m * 16, b = row >> 13, t = row & 8191;
#pragma unroll
                    for (int bj = 0; bj < 2; ++bj)
#pragma unroll
                        for (int n = 0; n < 2; ++n) { const int col = (pn - 4) * 256 + bj * 128 + wc * 32 + 8 * fq + 4 * n; bf16* d = vt + ((size_t)(b * 512 + col)) * 8192 + t;
                            d[0] = (bf16)f2bf(acc[ai][bj][m][n][0]); d[8192] = (bf16)f2bf(acc[ai][bj][m][n][1]); d[2 * 8192] = (bf16)f2bf(acc[ai][bj][m][n][2]); d[3 * 8192] = (bf16)f2bf(acc[ai][bj][m][n][3]); } }
        } else {
            const int cbase = (pn < 4 ? pn * 256 : (pn - 2) * 256) + wc * 32 + 8 * fq; const float sc = pn < 2 ? 0.125f : 1.0f;
#pragma unroll
            for (int ai = 0; ai < 2; ++ai)
#pragma unroll
                for (int m = 0; m < 4; ++m) { bf16* rowp = proj + (size_t)(row0 + ai * 128 + m * 16) * PROJ_LD + cbase;
#pragma unroll
                    for (int bj = 0; bj < 2; ++bj) { const f32x4 v0 = acc[ai][bj][m][0] * sc, v1 = acc[ai][bj][m][1] * sc;
                        P2ST(rowp + bj * 128, ((v4u){pk2(v0[0], v0[1]), pk2(v0[2], v0[3]), pk2(v1[0], v1[1]), pk2(v1[2], v1[3])})); } }
        }
    }
};
struct EpiGates {
    bool skip = false;
    static constexpr bool PERM = true; static constexpr bool CHAINS = false;
    bf16* gates; const float* gbias; const LAS unsigned char* stab;
    __device__ __forceinline__ void operator()(const f32x4 (&acc)[2][2][4][2], const pg8::Unit& u, int wr, int wc, int fr, int fq) const {
        {
            const int pn = u.pn;
            int fr_ = fr, fq_ = fq; asm volatile("" : "+v"(fr_), "+v"(fq_));
            const int cbase = pn * 256 + wc * 32 + 8 * fq_;
            f32x4 bv[2][2];
#pragma unroll
            for (int bj = 0; bj < 2; ++bj)
#pragma unroll
                for (int n = 0; n < 2; ++n) bv[bj][n] = (*(const f32x4*)(gbias + cbase + bj * 128 + 4 * n) + 8.0f) * 64.0f;
            const unsigned to8 = (unsigned)(((wr * 4 + wc) * 64 + fq_ * 16 + fr_) * 8);
            unsigned char* blob = (unsigned char*)gates + (size_t)(u.pm * 12 + pn) * 65536 + to8;
#pragma unroll
            for (int ai = 0; ai < 2; ++ai)
#pragma unroll
                for (int m = 0; m < 4; ++m)
#pragma unroll
                    for (int bj = 0; bj < 2; ++bj) {
                        unsigned c0[4], c1[4];
#pragma unroll
                        for (int e = 0; e < 4; ++e) {
                            const unsigned i0 = (unsigned)__builtin_amdgcn_fmed3f(acc[ai][bj][m][0][e] + bv[bj][0][e], 0.0f, 1023.0f), i1 = (unsigned)__builtin_amdgcn_fmed3f(acc[ai][bj][m][1][e] + bv[bj][1][e], 0.0f, 1023.0f);
                            c0[e] = stab[i0]; c1[e] = stab[i1]; }
                        const v2u w = (v2u){c0[0] | (c0[1] << 8) | (c0[2] << 16) | (c0[3] << 24), c1[0] | (c1[1] << 8) | (c1[2] << 16) | (c1[3] << 24)};
                        *(v2u*)(blob + ((ai * 4 + m) * 2 + bj) * 4096) = w; }
        }
    }
};
struct EpiMerge {
    bool skip = false;
    static constexpr bool PERM = true; static constexpr bool CHAINS = true;
    const bf16* gates; bf16* merged; const LAS float* rtab;
    __device__ __forceinline__ bool is_final(const pg8::Unit& u) const { return u.z == 2; }
    __device__ __forceinline__ void rescale(f32x4 (&acc)[2][2][4][2], const pg8::Unit& u, int wr, int wc, int fr, int fq) const {
        const int tid = (wr * 4 + wc) * 64 + fq * 16 + fr; const bool fin = u.z == 2;
        const char* gb0 = (const char*)gates + (size_t)(u.pm * 12 + u.z * 4 + u.pn) * 65536 + tid * 8; const char* gb1 = gb0 + 4 * 65536;
#pragma unroll
        for (int hb4 = 0; hb4 < 4; ++hb4) {
            v2u ga[4], gn[4]; unsigned pcb = hb4 * 4 * 4096; asm volatile("" : "+v"(pcb));
#pragma unroll
            for (int p = 0; p < 4; ++p) { ga[p] = *(const v2u*)(gb0 + pcb + p * 4096); gn[p] = *(const v2u*)(gb1 + pcb + p * 4096); }
#pragma unroll
            for (int p = 0; p < 4; ++p) { const int pi = hb4 * 4 + p, ai = pi >> 3, m = (pi >> 1) & 3, bj = pi & 1;
#pragma unroll
                for (int n = 0; n < 2; ++n) { const unsigned wa = n ? ga[p].y : ga[p].x, wn = fin ? 0xffffffffu : (n ? gn[p].y : gn[p].x);
#pragma unroll
                    for (int e = 0; e < 4; ++e) acc[ai][bj][m][n][e] *= (float)((wa >> (8 * e)) & 0xffu) * rtab[(wn >> (8 * e)) & 0xffu]; } }
            asm volatile("" ::: "memory");
        }
    }
    __device__ __forceinline__ void operator()(const f32x4 (&acc)[2][2][4][2], const pg8::Unit& u, int wr, int wc, int fr, int fq) const {
        const int row0 = u.pm * 256 + wr * 64 + fr, cbase = u.pn * 256 + wc * 32 + 8 * fq;
#pragma unroll
        for (int ai = 0; ai < 2; ++ai)
#pragma unroll
            for (int m = 0; m < 4; ++m) { bf16* rowp = merged + (size_t)(row0 + ai * 128 + m * 16) * 1024 + cbase;
#pragma unroll
                for (int bj = 0; bj < 2; ++bj) { const f32x4 v0 = acc[ai][bj][m][0], v1 = acc[ai][bj][m][1];
                    *(v4u*)(rowp + bj * 128) = (v4u){pk2(v0[0], v0[1]), pk2(v0[2], v0[3]), pk2(v1[0], v1[1]), pk2(v1[2], v1[3])}; } }
    }
};
template <bool F32IN>
struct EpiResid {
    bool skip = false;
    static constexpr bool PERM = true; static constexpr bool CHAINS = false;
    const float* xin32; bf16* xb0; bf16* xb1; const float* gt;
    __device__ __forceinline__ void operator()(const f32x4 (&acc)[2][2][4][2], const pg8::Unit& u, int wr, int wc, int fr, int fq) const {
        const int rt = u.pm * 256, row0 = rt + wr * 64 + fr, cbase = u.pn * 256 + wc * 32 + 8 * fq, b = rt >> 13;
        bf16* xb = (rt < XB_SPLIT) ? xb0 + (size_t)row0 * 1024 : xb1 + (size_t)(row0 - XB_SPLIT) * 1024;
        const float* xf = xin32 + (size_t)row0 * 1024;
        f32x4 gv[2][2];
#pragma unroll
        for (int bj = 0; bj < 2; ++bj)
#pragma unroll
            for (int n = 0; n < 2; ++n) gv[bj][n] = *(const f32x4*)(gt + (size_t)b * 6144 + cbase + bj * 128 + 4 * n);
#pragma unroll
        for (int hb4 = 0; hb4 < 4; ++hb4) {
            unsigned rob = (unsigned)((hb4 >> 1) * 128 + (hb4 & 1) * 32) * 1024u + (unsigned)cbase; asm volatile("" : "+v"(rob));
            f32x4 x0[4], x1[4];
#pragma unroll
            for (int p = 0; p < 4; ++p) { const unsigned ro = rob + (unsigned)((p >> 1) * 16 * 1024 + (p & 1) * 128);
                if (F32IN) { x0[p] = *(const f32x4*)(xf + ro); x1[p] = *(const f32x4*)(xf + ro + 4); }
                else { const v4u t = *(const v4u*)(xb + ro); x0[p] = (f32x4){bflo(t.x), bfhi(t.x), bflo(t.y), bfhi(t.y)}; x1[p] = (f32x4){bflo(t.z), bfhi(t.z), bflo(t.w), bfhi(t.w)}; } }
#pragma unroll
            for (int p = 0; p < 4; ++p) { const int ai = hb4 >> 1, m = (hb4 & 1) * 2 + (p >> 1), bj = p & 1; const unsigned ro = rob + (unsigned)((p >> 1) * 16 * 1024 + (p & 1) * 128);
                const f32x4 y0 = x0[p] + gv[bj][0] * acc[ai][bj][m][0], y1 = x1[p] + gv[bj][1] * acc[ai][bj][m][1];
                *(v4u*)(xb + ro) = (v4u){pk2(y0[0], y0[1]), pk2(y0[2], y0[3]), pk2(y1[0], y1[1]), pk2(y1[2], y1[3])}; }
            asm volatile("" ::: "memory");
        }
    }
};
struct EpiSwiGLU {
    bool skip = false;
    static constexpr bool PERM = true; static constexpr bool CHAINS = false;
    bf16* H;
    __device__ __forceinline__ void operator()(const f32x4 (&acc)[2][2][4][2], const pg8::Unit& u, int wr, int wc, int fr, int fq) const {
        const int row0 = u.pm * 256 + wr * 64 + fr, cbase = u.pn * 128 + wc * 32 + 8 * fq;
#pragma unroll
        for (int ai = 0; ai < 2; ++ai)
#pragma unroll
            for (int m = 0; m < 4; ++m) { f32x4 h0, h1;
#pragma unroll
                for (int e = 0; e < 4; ++e) { const float g0 = acc[ai][0][m][0][e], g1 = acc[ai][0][m][1][e]; h0[e] = g0 * sigmoidf(g0) * acc[ai][1][m][0][e]; h1[e] = g1 * sigmoidf(g1) * acc[ai][1][m][1][e]; }
                *(v4u*)(H + (size_t)(row0 + ai * 128 + m * 16) * 512 + cbase) = (v4u){pk2(h0[0], h0[1]), pk2(h0[2], h0[3]), pk2(h1[0], h1[1]), pk2(h1[2], h1[3])}; }
    }
};
struct EpiYE {
    bool skip = false;
    static constexpr bool PERM = true; static constexpr bool CHAINS = false;
    bf16* YE;
    __device__ __forceinline__ void operator()(const f32x4 (&acc)[2][2][4][2], const pg8::Unit& u, int wr, int wc, int fr, int fq) const {
        const int row0 = u.pm * 256 + wr * 64 + fr, cbase = u.pn * 256 + wc * 32 + 8 * fq;
#pragma unroll
        for (int ai = 0; ai < 2; ++ai)
#pragma unroll
            for (int m = 0; m < 4; ++m) { bf16* rowp = YE + (size_t)(row0 + ai * 128 + m * 16) * 1024 + cbase;
#pragma unroll
                for (int bj = 0; bj < 2; ++bj) { const f32x4 v0 = acc[ai][bj][m][0], v1 = acc[ai][bj][m][1];
                    *(v4u*)(rowp + bj * 128) = (v4u){pk2(v0[0], v0[1]), pk2(v0[2], v0[3]), pk2(v1[0], v1[1]), pk2(v1[2], v1[3])}; } }
    }
};

__device__ __forceinline__ void attn_unit(bf16* PROJ, const bf16* VT, const LAS float* rpb, int b, int h, int r, int qb, int lane, bf16* obase, int opitch) {
    const int qn = lane & 15, g = lane >> 4;
    const int rs = min(max(r - 4, 0), 120);
    const int cb = (qb == 0) ? 0 : ((qb == 1) ? 8 : ((qb == 2) ? 24 : 32));
    const int w = 16 * qb + qn, cs = min(max(w - 8, 0), 48);
    const size_t tokq = (size_t)b * T + r * 64 + w;
    bf16* qp = PROJ + tokq * PROJ_LD + Q_OFF + h * 64;
    bf16x8 qf0 = *(const bf16x8*)(qp + 8 * g), qf1 = *(const bf16x8*)(qp + 32 + 8 * g);
    const bf16* kbase = PROJ + ((size_t)b * T + rs * 64 + cb + qn) * PROJ_LD + K_OFF + h * 64 + 8 * g;
    f32x4 sc[16];
#pragma unroll
    for (int kt = 0; kt < 16; ++kt) {
        const int kr = kt >> 1, ch = kt & 1;
        const bf16* kp = kbase + (size_t)(kr * 64 + 16 * ch) * PROJ_LD;
        const bf16x8 kf0 = *(const bf16x8*)kp, kf1 = *(const bf16x8*)(kp + 32);
        f32x4 a = (f32x4){0.f, 0.f, 0.f, 0.f};
        a = __builtin_amdgcn_mfma_f32_16x16x32_bf16(kf0, qf0, a, 0, 0, 0);
        a = __builtin_amdgcn_mfma_f32_16x16x32_bf16(kf1, qf1, a, 0, 0, 0);
        sc[kt] = a;
    }
    const LAS float* rp = rpb + h * 465;
    float mx = -1e30f;
#pragma unroll
    for (int kt = 0; kt < 16; ++kt) {
        const int kr = kt >> 1, ch = kt & 1;
        const int brow = (rs + kr - r + 7) * 31;
#pragma unroll
        for (int j = 0; j < 4; ++j) {
            const int kc = cb + 16 * ch + 4 * g + j, dc = kc - w + 15;
            const bool ok = (kc >= cs) && (kc <= cs + 15);
            const float bias = rp[brow + (ok ? dc : 15)];
            const float s = ok ? sc[kt][j] + bias : -1e30f;
            sc[kt][j] = s; mx = fmaxf(mx, s);
        }
    }
    mx = fmaxf(mx, __shfl_xor(mx, 16)); mx = fmaxf(mx, __shfl_xor(mx, 32));
    float sum = 0.f;
#pragma unroll
    for (int kt = 0; kt < 16; ++kt)
#pragma unroll
        for (int j = 0; j < 4; ++j) { const float p = __expf(sc[kt][j] - mx); sc[kt][j] = p; sum += p; }
    sum += __shfl_xor(sum, 16); sum += __shfl_xor(sum, 32);
    const float inv = 1.0f / sum;
    f32x4 o[4];
#pragma unroll
    for (int dt = 0; dt < 4; ++dt) o[dt] = (f32x4){0.f, 0.f, 0.f, 0.f};
    const bf16* vbase = VT + ((size_t)(b * 512 + h * 64 + qn)) * T + rs * 64 + cb + 4 * g;
#pragma unroll
    for (int kr = 0; kr < 8; ++kr) {
        v4u pw; pw.x = pk2(sc[2 * kr][0], sc[2 * kr][1]); pw.y = pk2(sc[2 * kr][2], sc[2 * kr][3]); pw.z = pk2(sc[2 * kr + 1][0], sc[2 * kr + 1][1]); pw.w = pk2(sc[2 * kr + 1][2], sc[2 * kr + 1][3]);
        const bf16x8 pf = __builtin_bit_cast(bf16x8, pw);
#pragma unroll
        for (int dt = 0; dt < 4; ++dt) {
            const bf16* vp = vbase + (size_t)(16 * dt) * T + kr * 64;
            const v2u lo = *(const v2u*)vp, hi = *(const v2u*)(vp + 16);
            const v4u vw = (v4u){lo.x, lo.y, hi.x, hi.y};
            o[dt] = __builtin_amdgcn_mfma_f32_16x16x32_bf16(__builtin_bit_cast(bf16x8, vw), pf, o[dt], 0, 0, 0);
        }
    }
    bf16* op = obase + tokq * opitch + h * 64;
#pragma unroll
    for (int dt = 0; dt < 4; ++dt) *(v2u*)(op + 16 * dt + 4 * g) = (v2u){pk2(o[dt][0] * inv, o[dt][1] * inv), pk2(o[dt][2] * inv, o[dt][3] * inv)};
}
__device__ __forceinline__ void attn_phase(const Frame& F0, const Args& args, int l, bf16* obase, int opitch) {
    const Frame F = fresh(F0);
    LAS float* rpb = (LAS float*)(F.lds + RING_OFF);
    for (int i = F.tid; i < 8 * 465; i += 512) rpb[i] = INP(9)[l * 8 * 465 + i];
    __syncthreads();
    bf16* PROJ = WSP(bf16, WS_PROJ); const bf16* VT = WSP(bf16, WS_VT);
    for (int wu = F.vcu * NWAVES + F.wave; wu < 16384; wu += F.G * NWAVES) {
        const int bh = wu >> 9, rem = wu & 511;
        attn_unit(PROJ, VT, rpb, bh >> 3, bh & 7, rem >> 2, rem & 3, F.lane, obase, opitch);
    }
    __syncthreads();
}

__device__ __forceinline__ float gelu_tanh(float x) { const float u = 0.7978845608028654f * (x + 0.044715f * x * x * x); const float t = 1.0f - 2.0f * __builtin_amdgcn_rcpf(1.0f + __expf(2.0f * u)); return 0.5f * x * (1.0f + t); }
__device__ __forceinline__ void fft_a_phase(const Frame& F0, const Args& args) {
    const Frame F = fresh(F0);
    const int lane = F.lane, nl = lane & 31, hh = lane >> 5;
    const bf16* PROJ = WSP(bf16, WS_PROJ); const bf16* FA = WSP(bf16, WS_FA); const f32x2* TW = WSP(f32x2, WS_TW); bf16* ZP = WSP(bf16, WS_U);
    for (int wu = F.vcu * NWAVES + F.wave; wu < 8192; wu += F.G * NWAVES) {
        const int ct = wu & 15, t2 = (wu >> 4) & 127, b = wu >> 11;
        bf16x8 bf[8];
#pragma unroll
        for (int s = 0; s < 8; ++s) { const int part = s >> 2, t1b = 16 * (s & 3) + 8 * hh;
            const bf16* p = PROJ + ((size_t)b * T + (size_t)128 * t1b + t2) * PROJ_LD + G_OFF + part * 512 + 32 * ct + nl;
            unsigned short e[8];
#pragma unroll
            for (int j = 0; j < 8; ++j) e[j] = p[(size_t)j * 128 * PROJ_LD];
            v4u w; w.x = e[0] | ((unsigned)e[1] << 16); w.y = e[2] | ((unsigned)e[3] << 16); w.z = e[4] | ((unsigned)e[5] << 16); w.w = e[6] | ((unsigned)e[7] << 16);
            bf[s] = __builtin_bit_cast(bf16x8, w); }
        f32x16 acc[4];
#pragma unroll
        for (int mt = 0; mt < 4; ++mt) { acc[mt] = (f32x16){};
#pragma unroll
            for (int s = 0; s < 8; ++s) { const bf16x8 af = *(const bf16x8*)(FA + (32 * mt + nl) * 128 + 16 * s + 8 * hh); acc[mt] = __builtin_amdgcn_mfma_f32_32x32x16_bf16(af, bf[s], acc[mt], 0, 0, 0); } }
#pragma unroll
        for (int mt = 0; mt < 2; ++mt)
#pragma unroll
            for (int rg = 0; rg < 16; ++rg) { const int k1 = 32 * mt + (rg & 3) + 8 * (rg >> 2) + 4 * hh; const f32x2 cs = TW[t2 * 64 + k1];
                const float zr = acc[mt][rg], zi = acc[mt + 2][rg];
                bf16* d = ZP + ((size_t)(b * 64 + k1) * 128 + t2) * 1024 + 32 * ct + nl;
                d[0] = (bf16)f2bf(zr * cs.x + zi * cs.y); d[512] = (bf16)f2bf(zi * cs.x - zr * cs.y); }
    }
}
__device__ __forceinline__ void fft_b_phase(const Frame& F0, const Args& args) {
    const Frame F = fresh(F0);
    const int lane = F.lane, nl = lane & 31, hh = lane >> 5;
    bf16* PROJ = WSP(bf16, WS_PROJ); const bf16* FB = WSP(bf16, WS_FB); const bf16* ZP = WSP(bf16, WS_U);
    for (int wu = F.vcu * NWAVES + F.wave; wu < 4096; wu += F.G * NWAVES) {
        const int ct = wu & 15, k1 = (wu >> 4) & 63, b = wu >> 10;
        f32x16 acc[4];
#pragma unroll
        for (int mt = 0; mt < 4; ++mt) acc[mt] = (f32x16){};
#pragma unroll 1
        for (int sc = 0; sc < 4; ++sc) {
            bf16x8 bf[4];
#pragma unroll
            for (int q = 0; q < 4; ++q) { const int s = 4 * sc + q, part = s >> 3, t2b = 16 * (s & 7) + 8 * hh;
                const bf16* p = ZP + ((size_t)(b * 64 + k1) * 128 + t2b) * 1024 + part * 512 + 32 * ct + nl;
                unsigned short e[8];
#pragma unroll
                for (int j = 0; j < 8; ++j) e[j] = p[(size_t)j * 1024];
                v4u w; w.x = e[0] | ((unsigned)e[1] << 16); w.y = e[2] | ((unsigned)e[3] << 16); w.z = e[4] | ((unsigned)e[5] << 16); w.w = e[6] | ((unsigned)e[7] << 16);
                bf[q] = __builtin_bit_cast(bf16x8, w); }
#pragma unroll
            for (int mt = 0; mt < 4; ++mt)
#pragma unroll
                for (int q = 0; q < 4; ++q) { const bf16x8 af = *(const bf16x8*)(FB + (32 * mt + nl) * 256 + 16 * (4 * sc + q) + 8 * hh); acc[mt] = __builtin_amdgcn_mfma_f32_32x32x16_bf16(af, bf[q], acc[mt], 0, 0, 0); }
        }
#pragma unroll
        for (int mt = 0; mt < 4; ++mt)
#pragma unroll
            for (int rg = 0; rg < 16; ++rg) { const int k2 = 32 * mt + (rg & 3) + 8 * (rg >> 2) + 4 * hh;
                PROJ[((size_t)b * T + k1 + 64 * k2) * PROJ_LD + G_OFF + 32 * ct + nl] = (bf16)f2bf(acc[mt][rg] * (1.0f / 1024.0f)); }
    }
}

__device__ __forceinline__ void router_phase(const Frame& F0, const Args& args, int l, int cset) {
    const Frame F = fresh(F0);
    const int tid = F.tid, lane = F.lane, wave = F.wave;
    const float* MOD = WSP(float, WS_MOD);
    LAS unsigned char* WB = F.lds + RING_OFF;
    constexpr int RPITCH = 2064;
    LAS float* gsc = (LAS float*)(F.lds + RING_OFF + 64 * RPITCH);
    LAS float* shf = gsc + 1024;
    LAS float* c0 = shf + 1024;
    LAS float* rb = c0 + 32;
    LAS unsigned* lcnt = (LAS unsigned*)(rb + 32);
    LAS unsigned* lbase = lcnt + 32;
    LAS float* red = (LAS float*)(lbase + 32);
    bf16* U2 = WSP(bf16, WS_U);
    float* tokw = WSP(float, WS_TOKW); int* perm = WSP(int, WS_PERM); int* tokes = WSP(int, WS_TOKROW);
    unsigned* ecnt = (unsigned*)(F.ctl + CW_ECNT + cset * 32 * 64);
    const int nround = (2048 + F.G * NWAVES - 1) / (F.G * NWAVES);
    int cur_b = -1;
    for (int rd = 0; rd < nround; ++rd) {
        const int unit = (rd * F.G + F.vcu) * NWAVES + wave;
        const int ub = (((rd * F.G + F.vcu) * NWAVES) * 16) >> 13;
        const bool wg_active = ((rd * F.G + F.vcu) * NWAVES) < 2048;
        if (wg_active && ub != cur_b) {
            cur_b = ub; __syncthreads();
            for (int i = 0; i < 2; ++i) { const int col = tid + 512 * i; gsc[col] = INP(5)[l * 1024 + col] * (1.0f + MOD[(size_t)(l * 4 + ub) * 6144 + 4 * 1024 + col]); shf[col] = MOD[(size_t)(l * 4 + ub) * 6144 + 3 * 1024 + col]; }
            if (tid < 32) rb[tid] = INP(22)[tid];
            __syncthreads();
            { f32x4 wa[8], wb[8];
#pragma unroll
                for (int i = 0; i < 8; ++i) { const int it = tid + 512 * i, kp = it >> 3, e4 = it & 7; wa[i] = *(const f32x4*)(INP(21) + (2 * kp) * 32 + 4 * e4); wb[i] = *(const f32x4*)(INP(21) + (2 * kp + 1) * 32 + 4 * e4); }
                PIN8(wa); PIN8(wb);
#pragma unroll
                for (int i = 0; i < 8; ++i) { const int it = tid + 512 * i, kp = it >> 3, e4 = it & 7; const float g0 = gsc[2 * kp], g1 = gsc[2 * kp + 1];
#pragma unroll
                    for (int j = 0; j < 4; ++j) { const float p0 = g0 * wa[i][j], p1 = g1 * wb[i][j]; const unsigned h1 = pk2(p0, p1), h2 = pk2(p0 - bflo(h1), p1 - bfhi(h1));
                        LAS unsigned char* d = WB + (4 * e4 + j) * RPITCH + 4 * kp; *(LAS unsigned*)d = h1; *(LAS unsigned*)(d + 32 * RPITCH) = h2; } } }
            { const int e = tid & 31, pt = tid >> 5; float s = 0.f;
#pragma unroll 1
                for (int q4 = 0; q4 < 4; ++q4) { float wv[16];
#pragma unroll
                    for (int kk = 0; kk < 16; ++kk) wv[kk] = INP(21)[(pt * 64 + q4 * 16 + kk) * 32 + e];
#pragma unroll
                    for (int kk = 0; kk < 16; ++kk) s += shf[pt * 64 + q4 * 16 + kk] * wv[kk]; }
                red[tid] = s; }
            __syncthreads();
            if (tid < 32) { float s = 0.f; for (int p = 0; p < 16; ++p) s += red[p * 32 + tid]; c0[tid] = s; }
        }
        if (tid < 32) lcnt[tid] = 0u;
        __syncthreads();
        int e0 = 0, e1 = 0; unsigned rk0 = 0, rk1 = 0; float w0 = 0.f, w1 = 0.f; bool owner = false; int mytok = 0;
        if (unit < 2048) {
            const int tok0 = unit * 16;
            float rs_reg = 0.f;
#pragma unroll 1
            for (int i4 = 0; i4 < 16; i4 += 4) {
                f32x4 v[4][4];
#pragma unroll
                for (int q = 0; q < 4; ++q) { const v2u* xr = (const v2u*)XBROW(tok0 + i4 + q) + lane;
#pragma unroll
                    for (int j = 0; j < 4; ++j) { const v2u t = xr[64 * j]; v[q][j] = (f32x4){bflo(t.x), bfhi(t.x), bflo(t.y), bfhi(t.y)}; } }
#pragma unroll
                for (int q = 0; q < 4; ++q) { const int m = tok0 + i4 + q; float ss = 0.f;
#pragma unroll
                    for (int j = 0; j < 4; ++j) ss += (v[q][j].x * v[q][j].x + v[q][j].y * v[q][j].y) + (v[q][j].z * v[q][j].z + v[q][j].w * v[q][j].w);
                    const float rstd = 1.0f / sqrtf(wave_sum(ss) * (1.0f / D) + EPS);
                    if ((lane & 15) == i4 + q) rs_reg = rstd;
                    v2u* uo = (v2u*)(U2 + (size_t)m * D) + lane;
#pragma unroll
                    for (int j = 0; j < 4; ++j) { const f32x4 g = *(const LAS f32x4*)(gsc + 4 * lane + 256 * j), s = *(const LAS f32x4*)(shf + 4 * lane + 256 * j);
                        const f32x4 u = v[q][j] * rstd * g + s; uo[64 * j] = (v2u){pk2(u.x, u.y), pk2(u.z, u.w)}; } }
            }
            const int ti = lane & 15, kq = lane >> 4;
            const v4u* xrow = (const v4u*)(XBROW(tok0 + ti) + 256 * kq);
            const LAS unsigned char* wp = WB + ti * RPITCH + 512 * kq;
            f32x4 a0 = {0.f, 0.f, 0.f, 0.f}, a1 = {0.f, 0.f, 0.f, 0.f};
            v4u xall[32];
#pragma unroll
            for (int q = 0; q < 32; ++q) xall[q] = xrow[q];
#pragma unroll
            for (int q = 0; q < 32; ++q) { const bf16x8 bx = __builtin_bit_cast(bf16x8, xall[q]);
                const bf16x8 w00 = *(const LAS bf16x8*)(wp + 16 * q), w01 = *(const LAS bf16x8*)(wp + 16 * RPITCH + 16 * q), w10 = *(const LAS bf16x8*)(wp + 32 * RPITCH + 16 * q), w11 = *(const LAS bf16x8*)(wp + 48 * RPITCH + 16 * q);
                a0 = __builtin_amdgcn_mfma_f32_16x16x32_bf16(w00, bx, a0, 0, 0, 0); a1 = __builtin_amdgcn_mfma_f32_16x16x32_bf16(w01, bx, a1, 0, 0, 0);
                a0 = __builtin_amdgcn_mfma_f32_16x16x32_bf16(w10, bx, a0, 0, 0, 0); a1 = __builtin_amdgcn_mfma_f32_16x16x32_bf16(w11, bx, a1, 0, 0, 0);
                if ((q & 3) == 3) asm volatile("" ::: "memory"); }
            float sco[2][4], sel[2][4], gs[2];
#pragma unroll
            for (int nt = 0; nt < 2; ++nt) {
#pragma unroll
                for (int rg = 0; rg < 4; ++rg) { const int e = 16 * nt + 4 * kq + rg; const float lg = rs_reg * (nt ? a1[rg] : a0[rg]) + c0[e]; sco[nt][rg] = sigmoidf(lg); sel[nt][rg] = sco[nt][rg] + rb[e]; }
                float m1 = fmaxf(sel[nt][0], sel[nt][1]), m2 = fminf(sel[nt][0], sel[nt][1]);
                { const float v = sel[nt][2]; if (v > m1) { m2 = m1; m1 = v; } else if (v > m2) m2 = v; }
                { const float v = sel[nt][3]; if (v > m1) { m2 = m1; m1 = v; } else if (v > m2) m2 = v; }
                gs[nt] = m1 + m2; }
            float bv = gs[0]; int bg = kq; if (gs[1] > bv) { bv = gs[1]; bg = 4 + kq; }
#pragma unroll
            for (int o = 16; o < 64; o <<= 1) { const float ov = __shfl_xor(bv, o); const int og = __shfl_xor(bg, o); if (ov > bv || (ov == bv && og < bg)) { bv = ov; bg = og; } }
            owner = ((bg & 3) == kq); mytok = tok0 + ti;
            if (owner) { const int nt = bg >> 2; float cd[4], sv[4];
#pragma unroll
                for (int rg = 0; rg < 4; ++rg) { cd[rg] = nt ? sel[1][rg] : sel[0][rg]; sv[rg] = nt ? sco[1][rg] : sco[0][rg]; }
                int i1 = 0; float v1 = cd[0];
#pragma unroll
                for (int rg = 1; rg < 4; ++rg) if (cd[rg] > v1) { v1 = cd[rg]; i1 = rg; }
                int i2 = -1; float v2 = -1e30f;
#pragma unroll
                for (int rg = 0; rg < 4; ++rg) if (rg != i1 && cd[rg] > v2) { v2 = cd[rg]; i2 = rg; }
                const float s1 = (i1 == 0 ? sv[0] : (i1 == 1 ? sv[1] : (i1 == 2 ? sv[2] : sv[3]))), s2 = (i2 == 0 ? sv[0] : (i2 == 1 ? sv[1] : (i2 == 2 ? sv[2] : sv[3])));
                e0 = 4 * bg + i1; e1 = 4 * bg + i2; w0 = s1 / (s1 + s2); w1 = s2 / (s1 + s2);
                rk0 = __hip_atomic_fetch_add(lcnt + e0, 1u, __ATOMIC_RELAXED, __HIP_MEMORY_SCOPE_WORKGROUP);
                rk1 = __hip_atomic_fetch_add(lcnt + e1, 1u, __ATOMIC_RELAXED, __HIP_MEMORY_SCOPE_WORKGROUP); }
        }
        __syncthreads();
        if (tid < 32) { const unsigned n = lcnt[tid]; lbase[tid] = n ? __hip_atomic_fetch_add(ecnt + 64 * tid, n, RLX_AGENT) : 0u; }
        __syncthreads();
        if (owner) { const unsigned s0 = lbase[e0] + rk0, s1 = lbase[e1] + rk1; perm[(size_t)e0 * NTOK + s0] = 2 * mytok; perm[(size_t)e1 * NTOK + s1] = 2 * mytok + 1; tokw[2 * mytok] = w0; tokw[2 * mytok + 1] = w1;
            tokes[2 * mytok] = (e0 << 16) | (int)s0; tokes[2 * mytok + 1] = (e1 << 16) | (int)s1; }
    }
}
__device__ __forceinline__ void expert_conv(const Frame& F0, const Args& args, int l, int j0, int j1) {
    const Frame F = fresh(F0);
    const int lane = F.lane, wave = F.wave;
    LAS float* scr = (LAS float*)(F.lds + RING_OFF + wave * 8704);
    const int gw = F.vcu * NWAVES + wave, NGW = F.G * NWAVES;
    bf16* WG1 = WSP(bf16, WS_WG1); bf16* WD = WSP(bf16, WS_WD);
    auto mk = [&](int it) -> TrItem {
        const int kind = it >> 13, r = it & 8191, e = r >> 8, rr = r & 255;
        if (kind < 2) { const int kb = rr >> 4, nb = rr & 15, n0 = nb * 32; const float* src = (kind == 0 ? INP(23) : INP(24)) + (size_t)(l * 32 + e) * 1024 * 512;
            return TrItem{src, 512, kb * 64, n0, WG1 + ((size_t)e * 1024 + (n0 >> 7) * 256 + kind * 128 + (n0 & 127)) * 1024, 1024}; }
        const int kb = rr >> 5, nb = rr & 31, n0 = nb * 32; const float* src = INP(25) + (size_t)(l * 32 + e) * 512 * 1024;
        return TrItem{src, 1024, kb * 64, n0, WD + ((size_t)e * 1024 + n0) * 512, 512}; };
    for (int j = j0; j < j1; j += 2) {
        const int ia = gw + NGW * j, ib = ia + NGW; const bool va = ia < 24576, two = (j + 1 < j1) && ib < 24576;
        if (!va) break;
        const TrItem a = mk(ia), b = mk(two ? ib : ia);
        f32x4 xa[8], xb[8]; tr_load(a, xa, lane); tr_load(b, xb, lane);
        tr_finish(a, xa, scr, lane); if (two) tr_finish(b, xb, scr, lane);
    }
}
__device__ __forceinline__ void moe_tilebase(const Frame& F0, const Args& args, int l) {
    const Frame F = fresh(F0);
    __syncthreads();
    if (F.tid < 32) { unsigned* ecnt = (unsigned*)(F.ctl + CW_ECNT + l * 32 * 64); F.MISC[49 + F.tid] = __hip_atomic_load(ecnt + 64 * F.tid, RLX_AGENT); }
    __syncthreads();
    if (F.tid < 32) { const int ln = F.tid; int exc = 0, tl = 0;
#pragma unroll 8
        for (int e = 0; e < 32; ++e) { const int te = (int)((F.MISC[49 + e] + 255u) >> 8); if (e < ln) exc += te; if (e == ln) tl = te; }
        F.MISC[16 + ln] = (unsigned)exc;
        if (ln == 31) F.MISC[48] = (unsigned)(exc + tl); }
    __syncthreads();
}
__device__ __forceinline__ void moe_rowmaps(const Frame& F0, const Args& args, const pg8::MoeOrder& S, LAS int* rowmap) {
    const Frame F = fresh(F0);
    const int* perm = WSP(int, WS_PERM);
    pg8::Unit u; int idxs[8]; int nu = 0;
#pragma unroll
    for (int i = 0; i < 8; ++i) { idxs[i] = -1; if (S.next(i, u)) { idxs[i] = u.gbase + min(F.tid & 255, u.gcnt - 1); nu = i + 1; } }
    if (F.tid < 256) { int v[8];
#pragma unroll
        for (int i = 0; i < 8; ++i) v[i] = perm[idxs[i] < 0 ? 0 : idxs[i]];
#pragma unroll
        for (int i = 0; i < 8; ++i) if (idxs[i] >= 0) rowmap[i * 256 + F.tid] = v[i] >> 1; }
    __syncthreads();
}
__device__ __forceinline__ void lru_conv_phase(const Frame& F0, const Args& args, int l) {
    const Frame F = fresh(F0);
    const int lane = F.lane, cg = lane & 7, tg = lane >> 3;
    const bf16* PROJ = WSP(bf16, WS_PROJ); bf16* XC = WSP(bf16, WS_XC);
    for (int wu = F.vcu * NWAVES + F.wave; wu < 4096; wu += F.G * NWAVES) {
        const int hb = wu & 7, c = (wu >> 3) & 127, b = wu >> 10, t0 = c * 64, ch0 = hb * 64 + 8 * cg;
        const bf16* xrp = PROJ + (size_t)b * T * PROJ_LD + XR_OFF + ch0;
        v4u raw[11];
#pragma unroll
        for (int rr = 0; rr < 11; ++rr) { const int t = t0 + 8 * tg - 2 + rr, tc = min(max(t, 0), T - 1); raw[rr] = *(const v4u*)(xrp + (size_t)tc * PROJ_LD); }
        f32x4 wv[5][2];
#pragma unroll
        for (int j = 0; j < 4; ++j) { wv[j][0] = *(const f32x4*)(INP(10) + (l * 4 + j) * 512 + ch0); wv[j][1] = *(const f32x4*)(INP(10) + (l * 4 + j) * 512 + ch0 + 4); }
        wv[4][0] = *(const f32x4*)(INP(11) + l * 512 + ch0); wv[4][1] = *(const f32x4*)(INP(11) + l * 512 + ch0 + 4);
        unsigned ow[8][4];
#pragma unroll
        for (int pp = 0; pp < 4; ++pp) {
            float xl[11], xh[11];
#pragma unroll
            for (int rr = 0; rr < 11; ++rr) { const int t = t0 + 8 * tg - 2 + rr; const unsigned w = (t >= 0 && t < T) ? raw[rr][pp] : 0u; xl[rr] = bflo(w); xh[rr] = bfhi(w); }
#pragma unroll
            for (int tk = 0; tk < 8; ++tk) { float ol = wv[4][pp >> 1][2 * (pp & 1)], oh = wv[4][pp >> 1][2 * (pp & 1) + 1];
#pragma unroll
                for (int j = 0; j < 4; ++j) { ol += wv[j][pp >> 1][2 * (pp & 1)] * xl[tk + j]; oh += wv[j][pp >> 1][2 * (pp & 1) + 1] * xh[tk + j]; }
                ow[tk][pp] = pk2(ol, oh); }
        }
#pragma unroll
        for (int tk = 0; tk < 8; ++tk) *(v4u*)(XC + ((size_t)b * T + t0 + 8 * tg + tk) * 512 + ch0) = (v4u){ow[tk][0], ow[tk][1], ow[tk][2], ow[tk][3]};
    }
}
__device__ __forceinline__ void lru_load_frags(bf16x8 (&af)[4][2], const bf16* xcp, int t0, int lane) {
#pragma unroll
    for (int mt = 0; mt < 4; ++mt) { const int tau = 16 * ((lane & 15) >> 2) + 4 * mt + (lane & 3);
#pragma unroll
        for (int s = 0; s < 2; ++s) af[mt][s] = *(const bf16x8*)(xcp + (size_t)(t0 + tau) * 512 + 32 * s); }
}
template <int DBG = 0>
__device__ __forceinline__ void lru2_phase(const Frame& F0, const Args& args, int l, bf16* obase, int opitch, int ooff) {
    const Frame F = fresh(F0);
    const int lane = F.lane, wave = F.wave, dw = wave >> 2, wq = wave & 3;
    LAS bf16* HP = (LAS bf16*)(F.lds + RING_OFF);
    LAS bf16* YRT = (LAS bf16*)(F.lds + RING_OFF + 131072 + wave * 1024);
    LAS f32x2* CT = (LAS f32x2*)(F.lds + RING_OFF + 139264);
    LAS float* SG = (LAS float*)(F.lds + RING_OFF + 141312);
    __syncthreads();
#pragma unroll
    for (int q = 0; q < 4; ++q) { const int i = F.tid + 512 * q; SG[i] = 1.0f / (1.0f + __expf(16.0f - ((float)i + 0.5f) * (1.0f / 64.0f))); }
    __syncthreads();
    const bf16* PROJ = WSP(bf16, WS_PROJ); const bf16* XC = WSP(bf16, WS_XC);
    for (int un = F.vcu; un < 256; un += F.G) {
        const int b = un >> 6, hb = (un >> 3) & 7, s8 = un & 7;
        const int n = lane & 15, g = lane >> 4, hf = n >> 3, cj = n & 7;
        const int chg = hb * 64 + s8 * 8 + cj;
        const bf16* WLp = WSP(bf16, WS_WL) + ((size_t)(l * 8 + hb) * 256) * 64;
        bf16x8 bg[2], bs[2];
#pragma unroll
        for (int s = 0; s < 2; ++s) { bg[s] = *(const bf16x8*)(WLp + ((2 * dw + hf) * 64 + s8 * 8 + cj) * 64 + 32 * s + 8 * g);
            v4u sel = (v4u){0u, 0u, 0u, 0u};
            if (32 * s + 8 * g == 8 * s8) { const unsigned one = (cj & 1) ? 0x3F800000u : 0x00003F80u; sel[0] = (cj >> 1) == 0 ? one : 0u; sel[1] = (cj >> 1) == 1 ? one : 0u; sel[2] = (cj >> 1) == 2 ? one : 0u; sel[3] = (cj >> 1) == 3 ? one : 0u; }
            bs[s] = __builtin_bit_cast(bf16x8, sel); }
        const float b_r = INP(13)[(l * 2 + dw) * 512 + chg], b_i = INP(15)[(l * 2 + dw) * 512 + chg], lam = INP(16)[(l * 2 + dw) * 512 + chg];
        const float m8sp = -8.0f * ((lam > 15.f) ? __expf(-lam) : log1pf(__expf(-lam)));
        const float m8l = m8sp * 1.4426950408889634f, cbr = (b_r + 16.0f) * 64.0f, cbi = (b_i + 16.0f) * 64.0f;
        const bf16* xcp = XC + (size_t)b * T * 512 + hb * 64 + 8 * g;
        const bf16* yrp = PROJ + (size_t)b * T * PROJ_LD + YR_OFF + hb * 64 + s8 * 8;
        bf16* outp = obase + (size_t)b * T * opitch + ooff + hb * 64 + s8 * 8;
        const int pos = dw ? 7 - (2 * g + hf) : 2 * g + hf;
        float hrun = 0.f;
        bf16x8 nxt[4][2]; v4u ynx = (v4u){0u, 0u, 0u, 0u};
        { const int c0 = dw ? 127 - wq : wq; lru_load_frags(nxt, xcp, c0 * 64, lane); }
        __syncthreads();
#pragma unroll 2
        for (int rd = 0; rd < 32; ++rd) {
            const int c = dw ? 127 - (4 * rd + wq) : 4 * rd + wq, t0 = c * 64;
            const bool second = (DBG & 2) ? false : rd >= 16;
            bf16x8 af[4][2];
#pragma unroll
            for (int mt = 0; mt < 4; ++mt) { af[mt][0] = nxt[mt][0]; af[mt][1] = nxt[mt][1]; }
            const v4u ycur = ynx;
            { const int rn = min(rd + 1, 31), cn = dw ? 127 - (4 * rn + wq) : 4 * rn + wq; if (!(DBG & 1)) lru_load_frags(nxt, xcp, cn * 64, lane);
              if (rn >= 16) ynx = *(const v4u*)(yrp + (size_t)(cn * 64 + lane) * PROJ_LD); }
            if (second) *(LAS v4u*)(YRT + lane * 8) = ycur;
            f32x4 ag[4], ax[4];
#pragma unroll
            for (int mt = 0; mt < 4; ++mt) { ag[mt] = (f32x4){0.f, 0.f, 0.f, 0.f}; ax[mt] = (f32x4){0.f, 0.f, 0.f, 0.f};
#pragma unroll
                for (int s = 0; s < 2; ++s) { ag[mt] = __builtin_amdgcn_mfma_f32_16x16x32_bf16(af[mt][s], bg[s], ag[mt], 0, 0, 0); ax[mt] = __builtin_amdgcn_mfma_f32_16x16x32_bf16(af[mt][s], bs[s], ax[mt], 0, 0, 0); } }
            float a[8], bx[8], gr[8], gi[8], xv[8];
#pragma unroll
            for (int jj = 0; jj < 8; ++jj) {
                const float lo = ag[jj >> 2][jj & 3], hi = ag[2 + (jj >> 2)][jj & 3];
                const float mine = hf ? hi : lo, send = hf ? lo : hi;
                const float other = __builtin_bit_cast(float, __builtin_amdgcn_update_dpp(__builtin_bit_cast(int, send), __builtin_bit_cast(int, send), 0x128, 0xf, 0xf, false));
                gr[jj] = hf ? other : mine; gi[jj] = hf ? mine : other; xv[jj] = hf ? ax[2 + (jj >> 2)][jj & 3] : ax[jj >> 2][jj & 3]; }
#pragma unroll
            for (int jj = 0; jj < 8; ++jj) { gr[jj] = SG[(unsigned)__builtin_amdgcn_fmed3f(__builtin_fmaf(gr[jj], 64.0f, cbr), 0.0f, 2047.0f)]; gi[jj] = SG[(unsigned)__builtin_amdgcn_fmed3f(__builtin_fmaf(gi[jj], 64.0f, cbi), 0.0f, 2047.0f)]; }
#pragma unroll
            for (int jj = 0; jj < 8; ++jj) a[jj] = __builtin_amdgcn_exp2f(m8l * gr[jj]);
#pragma unroll
            for (int jj = 0; jj < 8; ++jj) bx[jj] = __builtin_amdgcn_sqrtf(__builtin_fmaf(-a[jj], a[jj], 1.0f)) * (gi[jj] * xv[jj]);
            float A8 = 1.f, B8 = 0.f;
            if (dw == 0) {
#pragma unroll
                for (int jj = 0; jj < 8; ++jj) { B8 = a[jj] * B8 + bx[jj]; A8 *= a[jj]; }
            } else {
#pragma unroll
                for (int jj = 7; jj >= 0; --jj) { B8 = a[jj] * B8 + bx[jj]; A8 *= a[jj]; }
            }
            float Ap = 1.f, Bp = 0.f, At = 1.f, Bt = 0.f;
#pragma unroll
            for (int k = 0; k < 8; ++k) { const int seg = dw ? 7 - k : k; const int src = cj + 8 * (seg & 1) + 16 * (seg >> 1);
                const float Ak = __shfl(A8, src), Bk = __shfl(B8, src);
                if (k < pos) { Bp = Ak * Bp + Bk; Ap *= Ak; }
                Bt = Ak * Bt + Bk; At *= Ak; }
            const int par = rd & 1;
            if (g == 0 && hf == 0) CT[((par * 2 + dw) * 4 + wq) * 8 + cj] = (f32x2){At, Bt};
            __syncthreads();
            float h = hrun;
#pragma unroll
            for (int q = 0; q < 4; ++q) { const f32x2 ab = CT[((par * 2 + dw) * 4 + q) * 8 + cj]; if (q < wq) h = ab.x * h + ab.y; hrun = ab.x * hrun + ab.y; }
            h = Ap * h + Bp;
            float hv[8];
            if (dw == 0) {
#pragma unroll
                for (int jj = 0; jj < 8; ++jj) { h = a[jj] * h + bx[jj]; hv[jj] = h; }
            } else {
#pragma unroll
                for (int jj = 7; jj >= 0; --jj) { h = a[jj] * h + bx[jj]; hv[jj] = h; }
            }
            const int tl0 = 16 * g + 8 * hf;
            if (DBG & 4) { if (hv[0] + hv[7] == 123.456f) outp[0] = 1; } else if (!second) {
                LAS bf16* hp = HP + ((size_t)(dw * 64 + (dw ? c - 64 : c)) * 64 + tl0) * 8 + cj;
#pragma unroll
                for (int jj = 0; jj < 8; ++jj) hp[jj * 8] = (bf16)f2bf(hv[jj]);
            } else {
                const LAS bf16* hp = HP + ((size_t)((1 - dw) * 64 + (dw ? c : c - 64)) * 64 + tl0) * 8 + cj;
                LDS_WAIT(); asm volatile("" ::: "memory");
                float yv[8], pv[8];
#pragma unroll
                for (int jj = 0; jj < 8; ++jj) { yv[jj] = bf2f(YRT[(tl0 + jj) * 8 + cj]); pv[jj] = bf2f(hp[jj * 8]); }
#pragma unroll
                for (int jj = 0; jj < 8; ++jj) { const float y = yv[jj], z = y * __builtin_fmaf(y * y, 0.044715f * 1.5957691216057308f * 64.0f, 1.5957691216057308f * 64.0f);
                    YRT[(tl0 + jj) * 8 + cj] = (bf16)f2bf((hv[jj] + pv[jj]) * (y * SG[(unsigned)__builtin_amdgcn_fmed3f(z + 1024.0f, 0.0f, 2047.0f)])); }
                LDS_WAIT(); asm volatile("" ::: "memory");
                *(v4u*)(outp + (size_t)(t0 + lane) * opitch) = *(const LAS v4u*)(YRT + lane * 8);
                LDS_WAIT(); asm volatile("" ::: "memory");
            }
        }
        __syncthreads();
    }
}
constexpr int AT_KR = 0, AT_VR = 73728, AT_VPITCH = 1168, AT_RPB = 148480, AT_XB = 150528, AT_XM = 158720;
__device__ __forceinline__ void attn2_phase(const Frame& F0, const Args& args, int l, bf16* obase, int opitch) {
    const Frame F = fresh(F0);
    const int tid = F.tid, lane = F.lane, wave = F.wave;
    LAS unsigned char* KR = F.lds + AT_KR; LAS unsigned char* VR = F.lds + AT_VR;
    LAS float* rpb = (LAS float*)(F.lds + AT_RPB);
    LAS unsigned char* XB = F.lds + AT_XB; LAS unsigned char* XM = F.lds + AT_XM;
    const bf16* PROJ = WSP(bf16, WS_PROJ); const bf16* VT = WSP(bf16, WS_VT);
    const int qb = wave & 3, dh = wave >> 2, qn = lane & 15, g = lane >> 4;
    const int cb = (qb == 0) ? 0 : ((qb == 1) ? 8 : ((qb == 2) ? 24 : 32));
    const int w = 16 * qb + qn, cs = min(max(w - 8, 0), 48);
    const int st = tid >> 3, sc = tid & 7;
    bool v0[4]; int dsel[4];
#pragma unroll
    for (int j = 0; j < 4; ++j) { const int kc0 = cb + 4 * g + j; v0[j] = (kc0 >= cs) && (kc0 <= cs + 15); dsel[j] = (v0[j] ? kc0 : kc0 + 16) - w + 15; }
    for (int un = F.vcu; un < 256; un += F.G) {
        const int bh = un >> 3, b = bh >> 3, h = bh & 7, R0 = (un & 7) * 16;
        __syncthreads();
        for (int i = tid; i < 465; i += 512) rpb[i] = INP(9)[(l * 8 + h) * 465 + i];
        const bf16* kg = PROJ + ((size_t)b * T + st) * PROJ_LD + K_OFF + h * 64 + 8 * sc;
        const bf16* vg = VT + ((size_t)(b * 512 + h * 64 + st)) * T + 8 * sc;
        const int kdst = st * 128 + ((sc ^ ((st >> 1) & 7)) * 16);
        const int vdst = st * AT_VPITCH + sc * 16;
        const int rs0 = min(max(R0 - 4, 0), 120);
        {
            v4u kk[8], vv[8];
#pragma unroll
            for (int j = 0; j < 8; ++j) { kk[j] = *(const v4u*)(kg + (size_t)(rs0 + j) * 64 * PROJ_LD); vv[j] = *(const v4u*)(vg + (rs0 + j) * 64); }
            PIN8(kk); PIN8(vv);
#pragma unroll
            for (int j = 0; j < 8; ++j) { const int slot = (rs0 + j) % 9; *(LAS v4u*)(KR + slot * 8192 + kdst) = kk[j]; *(LAS v4u*)(VR + slot * 128 + vdst) = vv[j]; }
        }
        __syncthreads();
        int have = rs0 + 7;
        v2u py0 = (v2u){0u, 0u}, py1 = (v2u){0u, 0u}; bf16* pop = nullptr;
        bf16x8 qn0, qn1;
        { const bf16* qp = PROJ + ((size_t)b * T + R0 * 64 + w) * PROJ_LD + Q_OFF + h * 64; qn0 = *(const bf16x8*)(qp + 8 * g); qn1 = *(const bf16x8*)(qp + 32 + 8 * g); }
#pragma unroll 1
        for (int s = 0; s < 16; ++s) {
            const int r = R0 + s;
            if (s > 0) { *(v2u*)pop = py0; *(v2u*)(pop + 16) = py1; }
            const size_t tokq = (size_t)b * T + r * 64 + w;
            const bf16x8 qf0 = qn0, qf1 = qn1;
            { const int r2 = min(r + 1, R0 + 15); const bf16* qp = PROJ + ((size_t)b * T + r2 * 64 + w) * PROJ_LD + Q_OFF + h * 64; qn0 = *(const bf16x8*)(qp + 8 * g); qn1 = *(const bf16x8*)(qp + 32 + 8 * g); }
            const int rsn = min(max(r + 1 - 4, 0), 120); const bool newrow = (s + 1 < 16) && (rsn + 7 > have); const int nrow = min(rsn + 7, 127);
            const v4u pk = *(const v4u*)(kg + (size_t)nrow * 64 * PROJ_LD), pv = *(const v4u*)(vg + nrow * 64);
            const int rs = min(max(r - 4, 0), 120);
            const int kr0 = 4 * dh;
            int slot0 = rs % 9 + kr0; slot0 = (slot0 >= 9) ? slot0 - 9 : slot0;
            int slot = slot0;
            f32x4 sc4[8];
#pragma unroll
            for (int kr = 0; kr < 4; ++kr) {
#pragma unroll
                for (int ch = 0; ch < 2; ++ch) { const int kt = cb + 16 * ch + qn; const LAS unsigned char* kp = KR + slot * 8192 + kt * 128; const int sw = (kt >> 1) & 7;
                    const bf16x8 kf0 = *(const LAS bf16x8*)(kp + ((g ^ sw) * 16)), kf1 = *(const LAS bf16x8*)(kp + (((4 + g) ^ sw) * 16));
                    f32x4 a = (f32x4){0.f, 0.f, 0.f, 0.f};
                    a = __builtin_amdgcn_mfma_f32_16x16x32_bf16(kf0, qf0, a, 0, 0, 0);
                    a = __builtin_amdgcn_mfma_f32_16x16x32_bf16(kf1, qf1, a, 0, 0, 0);
                    sc4[2 * kr + ch] = a; }
                slot = (slot == 8) ? 0 : slot + 1;
            }
            float sv[4][4]; float mx = -1e30f;
            const LAS float* rp = rpb + (rs - r + 7 + kr0) * 31;
#pragma unroll
            for (int kr = 0; kr < 4; ++kr)
#pragma unroll
                for (int j = 0; j < 4; ++j) { const float s = (v0[j] ? sc4[2 * kr][j] : sc4[2 * kr + 1][j]) + rp[kr * 31 + dsel[j]]; sv[kr][j] = s; mx = fmaxf(mx, s); }
            mx = fmaxf(mx, __shfl_xor(mx, 16)); mx = fmaxf(mx, __shfl_xor(mx, 32));
            float sum = 0.f;
#pragma unroll
            for (int kr = 0; kr < 4; ++kr)
#pragma unroll
                for (int j = 0; j < 4; ++j) { const float pe = __expf(sv[kr][j] - mx); sum += pe; sc4[2 * kr][j] = v0[j] ? pe : 0.f; sc4[2 * kr + 1][j] = v0[j] ? 0.f : pe; }
            sum += __shfl_xor(sum, 16); sum += __shfl_xor(sum, 32);
            f32x4 o[4];
#pragma unroll
            for (int dt = 0; dt < 4; ++dt) o[dt] = (f32x4){0.f, 0.f, 0.f, 0.f};
            slot = slot0;
            const LAS unsigned char* vb0 = VR + qn * AT_VPITCH + (cb + 4 * g) * 2;
#pragma unroll
            for (int kr = 0; kr < 4; ++kr) {
                v4u pw; pw.x = pk2(sc4[2 * kr][0], sc4[2 * kr][1]); pw.y = pk2(sc4[2 * kr][2], sc4[2 * kr][3]); pw.z = pk2(sc4[2 * kr + 1][0], sc4[2 * kr + 1][1]); pw.w = pk2(sc4[2 * kr + 1][2], sc4[2 * kr + 1][3]);
                const bf16x8 pf = __builtin_bit_cast(bf16x8, pw);
                const LAS unsigned char* vp = vb0 + slot * 128;
#pragma unroll
                for (int dt = 0; dt < 4; ++dt) { const v2u lo = *(const LAS v2u*)(vp + dt * 16 * AT_VPITCH), hi = *(const LAS v2u*)(vp + dt * 16 * AT_VPITCH + 32);
                    o[dt] = __builtin_amdgcn_mfma_f32_16x16x32_bf16(__builtin_bit_cast(bf16x8, ((v4u){lo.x, lo.y, hi.x, hi.y})), pf, o[dt], 0, 0, 0); }
                slot = (slot == 8) ? 0 : slot + 1;
            }
            { const f32x4 s0 = dh ? o[0] : o[2], s1 = dh ? o[1] : o[3];
              *(LAS v4u*)(XB + wave * 1024 + lane * 16) = (v4u){pk2(s0[0], s0[1]), pk2(s0[2], s0[3]), pk2(s1[0], s1[1]), pk2(s1[2], s1[3])};
              if (g == 0) *(LAS f32x2*)(XM + wave * 128 + qn * 8) = (f32x2){mx, sum}; }
            LDS_WAIT(); __builtin_amdgcn_s_barrier(); asm volatile("" ::: "memory");
            { const v4u pp = *(const LAS v4u*)(XB + (wave ^ 4) * 1024 + lane * 16); const f32x2 ms = *(const LAS f32x2*)(XM + (wave ^ 4) * 128 + qn * 8);
              const float m = fmaxf(mx, ms.x), fme = __expf(mx - m), fpa = __expf(ms.x - m), inv = __builtin_amdgcn_rcpf(sum * fme + ms.y * fpa), cme = fme * inv, cpa = fpa * inv;
              const f32x4 k0 = dh ? o[2] : o[0], k1 = dh ? o[3] : o[1];
              py0 = (v2u){pk2(k0[0] * cme + bflo(pp.x) * cpa, k0[1] * cme + bfhi(pp.x) * cpa), pk2(k0[2] * cme + bflo(pp.y) * cpa, k0[3] * cme + bfhi(pp.y) * cpa)};
              py1 = (v2u){pk2(k1[0] * cme + bflo(pp.z) * cpa, k1[1] * cme + bfhi(pp.z) * cpa), pk2(k1[2] * cme + bflo(pp.w) * cpa, k1[3] * cme + bfhi(pp.w) * cpa)}; }
            pop = obase + tokq * opitch + h * 64 + 32 * dh + 4 * g;
            if (newrow) { const int ns = nrow % 9; *(LAS v4u*)(KR + ns * 8192 + kdst) = pk; *(LAS v4u*)(VR + ns * 128 + vdst) = pv; have = nrow; }
            __syncthreads();
        }
        *(v2u*)pop = py0; *(v2u*)(pop + 16) = py1;
    }
    __syncthreads();
}
__device__ __forceinline__ bf16x8 lds_gather8(const LAS bf16* p, int stride) {
    unsigned short e[8];
#pragma unroll
    for (int j = 0; j < 8; ++j) e[j] = p[j * stride];
    v4u w; w.x = e[0] | ((unsigned)e[1] << 16); w.y = e[2] | ((unsigned)e[3] << 16); w.z = e[4] | ((unsigned)e[5] << 16); w.w = e[6] | ((unsigned)e[7] << 16);
    return __builtin_bit_cast(bf16x8, w);
}
constexpr int FA_PITCH = 136, FB_PITCH = 264;
__device__ __forceinline__ void fft_a2_phase(const Frame& F0, const Args& args) {
    const Frame F = fresh(F0);
    const int tid = F.tid, lane = F.lane, wave = F.wave, nl = lane & 31, hh = lane >> 5;
    LAS bf16* GT = (LAS bf16*)(F.lds + RING_OFF);
    LAS bf16* FAL = (LAS bf16*)(F.lds + RING_OFF + 65536);
    LAS f32x2* TWL = (LAS f32x2*)(F.lds + RING_OFF + 65536 + 34816);
    const bf16* PROJ = WSP(bf16, WS_PROJ); const bf16* FA = WSP(bf16, WS_FA); const f32x2* TW = WSP(f32x2, WS_TW); bf16* ZP = WSP(bf16, WS_U);
    __syncthreads();
    { v4u t[4];
#pragma unroll
        for (int i_ = 0; i_ < 4; ++i_) { const int i = tid + 512 * i_, r = i >> 4, c = i & 15; t[i_] = *(const v4u*)(FA + r * 128 + 8 * c); }
        PIN4(t);
#pragma unroll
        for (int i_ = 0; i_ < 4; ++i_) { const int i = tid + 512 * i_, r = i >> 4, c = i & 15; *(LAS v4u*)(FAL + r * FA_PITCH + 8 * c) = t[i_]; } }
    v4u v[8];
    { const int un = F.vcu; const int b = un >> 7, t2 = un & 127;
      if (un < 512) {
#pragma unroll
        for (int i = 0; i < 8; ++i) { const int idx = tid + 512 * i, k = idx >> 5, c = idx & 31, part = k >> 6, t1 = k & 63;
            v[i] = *(const v4u*)(PROJ + ((size_t)b * T + 128 * t1 + t2) * PROJ_LD + G_OFF + part * 256 + 8 * c); } } }
    for (int un = F.vcu; un < 512; un += F.G) {
        const int b = un >> 7, t2 = un & 127;
        __syncthreads();
        if (tid < 64) TWL[tid] = TW[t2 * 64 + tid];
        PIN8(v);
#pragma unroll
        for (int i = 0; i < 8; ++i) { const int idx = tid + 512 * i; *(LAS v4u*)(GT + (size_t)idx * 8) = v[i]; }
        { const int un2 = (un + F.G < 512) ? un + F.G : un; const int b2 = un2 >> 7, t22 = un2 & 127;
#pragma unroll
          for (int i = 0; i < 8; ++i) { const int idx = tid + 512 * i, k = idx >> 5, c = idx & 31, part = k >> 6, t1 = k & 63;
              v[i] = *(const v4u*)(PROJ + ((size_t)b2 * T + 128 * t1 + t22) * PROJ_LD + G_OFF + part * 256 + 8 * c); } }
        __syncthreads();
        {
            const int ch = 32 * wave + nl;
            f32x16 acc[4];
#pragma unroll
            for (int mt = 0; mt < 4; ++mt) acc[mt] = (f32x16){};
#pragma unroll 1
            for (int sc = 0; sc < 2; ++sc) {
                bf16x8 bf[4];
#pragma unroll
                for (int q4 = 0; q4 < 4; ++q4) bf[q4] = lds_gather8(GT + (16 * (4 * sc + q4) + 8 * hh) * 256 + ch, 256);
#pragma unroll
                for (int mt = 0; mt < 4; ++mt)
#pragma unroll
                    for (int q4 = 0; q4 < 4; ++q4) { const bf16x8 af = *(const LAS bf16x8*)(FAL + (32 * mt + nl) * FA_PITCH + 16 * (4 * sc + q4) + 8 * hh); acc[mt] = __builtin_amdgcn_mfma_f32_32x32x16_bf16(af, bf[q4], acc[mt], 0, 0, 0); }
            }
#pragma unroll
            for (int mt = 0; mt < 2; ++mt)
#pragma unroll
                for (int rg = 0; rg < 16; ++rg) { const int k1 = 32 * mt + (rg & 3) + 8 * (rg >> 2) + 4 * hh; const f32x2 cs = TWL[k1];
                    const float zr = acc[mt][rg], zi = acc[mt + 2][rg];
                    GT[k1 * 256 + ch] = (bf16)f2bf(zr * cs.x + zi * cs.y); GT[(64 + k1) * 256 + ch] = (bf16)f2bf(zi * cs.x - zr * cs.y);
                }
        }
        __syncthreads();
#pragma unroll
        for (int i = 0; i < 8; ++i) { const int idx = tid + 512 * i, m = idx >> 5, c = idx & 31, pp = m >> 6, k1 = m & 63;
            *(v4u*)(ZP + ((size_t)(b * 64 + k1) * 128 + t2) * 512 + pp * 256 + 8 * c) = *(const LAS v4u*)(GT + (size_t)idx * 8); }
    }
    __syncthreads();
}
__device__ __forceinline__ void fft_b2_phase(const Frame& F0, const Args& args) {
    const Frame F = fresh(F0);
    const int tid = F.tid, lane = F.lane, wave = F.wave, nl = lane & 31, hh = lane >> 5;
    LAS bf16* ZT = (LAS bf16*)(F.lds + RING_OFF);
    LAS bf16* FBL = (LAS bf16*)(F.lds + RING_OFF + 65536);
    LAS float* ZC = (LAS float*)(F.lds + RING_OFF + 65536 + 67584);
    LAS float* V0A = ZC + 512;
    LAS float* WA = V0A + 256;
    bf16* PROJ = WSP(bf16, WS_PROJ); const bf16* FB = WSP(bf16, WS_FB); const bf16* ZP = WSP(bf16, WS_U);
    __syncthreads();
    { v4u t[8];
#pragma unroll
        for (int i_ = 0; i_ < 8; ++i_) { const int i = tid + 512 * i_, r = i >> 5, c = i & 31; t[i_] = *(const v4u*)(FB + r * 256 + 8 * c); }
        PIN8(t);
#pragma unroll
        for (int i_ = 0; i_ < 8; ++i_) { const int i = tid + 512 * i_, r = i >> 5, c = i & 31; *(LAS v4u*)(FBL + r * FB_PITCH + 8 * c) = t[i_]; } }
    const int ws = wave >> 2, nt = (wave >> 1) & 1, mh = wave & 1;
    v4u v[8];
    { const int un = F.vcu; const int b = un >> 7, p = (un >> 2) & 31, g = un & 3;
      if (un < 512) {
#pragma unroll
        for (int i = 0; i < 8; ++i) { const int idx = tid + 512 * i, s = idx >> 11, k = (idx >> 3) & 255, c = idx & 7, part = k >> 7, t2 = k & 127, k1 = s ? (p ? 64 - p : 32) : p;
            v[i] = *(const v4u*)(ZP + ((size_t)(b * 64 + k1) * 128 + t2) * 512 + part * 256 + g * 64 + 8 * c); } } }
    for (int un = F.vcu; un < 512; un += F.G) {
        const int b = un >> 7, p = (un >> 2) & 31, g = un & 3;
        __syncthreads();
        PIN8(v);
#pragma unroll
        for (int i = 0; i < 8; ++i) { const int idx = tid + 512 * i; *(LAS v4u*)(ZT + (size_t)idx * 8) = v[i]; }
        { const int un2 = (un + F.G < 512) ? un + F.G : un; const int b2 = un2 >> 7, p2 = (un2 >> 2) & 31, g2 = un2 & 3;
#pragma unroll
          for (int i = 0; i < 8; ++i) { const int idx = tid + 512 * i, s = idx >> 11, k = (idx >> 3) & 255, c = idx & 7, part = k >> 7, t2 = k & 127, k1 = s ? (p2 ? 64 - p2 : 32) : p2;
              v[i] = *(const v4u*)(ZP + ((size_t)(b2 * 64 + k1) * 128 + t2) * 512 + part * 256 + g2 * 64 + 8 * c); } }
        __syncthreads();
        ZC[tid] = bf2f(ZT[(size_t)tid * 64]);
        const int ch = 32 * nt + nl;
        f32x16 acc[2];
        acc[0] = (f32x16){}; acc[1] = (f32x16){};
        { const LAS bf16* ZTs = ZT + ws * 16384;
#pragma unroll 1
          for (int sc = 0; sc < 4; ++sc) {
            bf16x8 bf[4];
#pragma unroll
            for (int q = 0; q < 4; ++q) bf[q] = lds_gather8(ZTs + (16 * (4 * sc + q) + 8 * hh) * 64 + ch, 64);
#pragma unroll
            for (int m2 = 0; m2 < 2; ++m2)
#pragma unroll
                for (int q = 0; q < 4; ++q) { const bf16x8 af = *(const LAS bf16x8*)(FBL + (64 * mh + 32 * m2 + nl) * FB_PITCH + 16 * (4 * sc + q) + 8 * hh); acc[m2] = __builtin_amdgcn_mfma_f32_32x32x16_bf16(af, bf[q], acc[m2], 0, 0, 0); }
          } }
        __syncthreads();
        {
            const int s = tid >> 8, k2 = (tid >> 1) & 127, hf = tid & 1;
            const LAS bf16* fr = FBL + k2 * FB_PITCH + 64 * hf; const LAS float* zc = ZC + s * 256 + 64 * hf;
            float w = 0.f;
#pragma unroll 2
            for (int j = 0; j < 8; ++j) { const v4u fc = *(const LAS v4u*)(fr + 8 * j), fs = *(const LAS v4u*)(fr + 128 + 8 * j);
                const f32x4 r0 = *(const LAS f32x4*)(zc + 8 * j), r1 = *(const LAS f32x4*)(zc + 8 * j + 4), i0 = *(const LAS f32x4*)(zc + 128 + 8 * j), i1 = *(const LAS f32x4*)(zc + 128 + 8 * j + 4);
                w += i0[0] * bflo(fc.x) + i0[1] * bfhi(fc.x) + i0[2] * bflo(fc.y) + i0[3] * bfhi(fc.y) + i1[0] * bflo(fc.z) + i1[1] * bfhi(fc.z) + i1[2] * bflo(fc.w) + i1[3] * bfhi(fc.w);
                w -= r0[0] * bflo(fs.x) + r0[1] * bfhi(fs.x) + r0[2] * bflo(fs.y) + r0[3] * bfhi(fs.y) + r1[0] * bflo(fs.z) + r1[1] * bfhi(fs.z) + r1[2] * bflo(fs.w) + r1[3] * bfhi(fs.w); }
            w += __shfl_xor(w, 1);
            if (hf == 0) WA[s * 128 + k2] = w * (1.0f / 1024.0f);
        }
        {
            const int kb = 64 * mh + 4 * hh;
            int hi = p ? (1 - ws) * 128 : ws * 128, lo = (p || ws) ? 127 - kb : 128 - kb, rb = (ws * 128 + kb) * 128 + ch, chm = ch ? 128 - ch : 64;
            asm volatile("" : "+v"(hi), "+v"(lo), "+v"(rb), "+v"(chm));
#pragma unroll
            for (int m2 = 0; m2 < 2; ++m2)
#pragma unroll
                for (int rg = 0; rg < 16; ++rg) { const int off = 32 * m2 + (rg & 3) + 8 * (rg >> 2); const bf16 hv = (bf16)f2bf(acc[m2][rg] * (1.0f / 1024.0f));
                    ZT[rb + off * 128] = hv; ZT[(hi + ((lo - off) & 127)) * 128 + chm] = hv; }
            if (ch == 0) {
#pragma unroll
                for (int m2 = 0; m2 < 2; ++m2)
#pragma unroll
                    for (int rg = 0; rg < 16; ++rg) V0A[ws * 128 + kb + 32 * m2 + (rg & 3) + 8 * (rg >> 2)] = acc[m2][rg] * (1.0f / 1024.0f); }
        }
        __syncthreads();
        if (tid < 256) { const int s = tid >> 7, k2 = tid & 127, rm = p ? (1 - s) * 128 + 127 - k2 : (s ? 128 + 127 - k2 : ((128 - k2) & 127));
            ZT[tid * 128] = (bf16)f2bf(0.5f * (V0A[tid] + V0A[rm])); ZT[tid * 128 + 64] = (bf16)f2bf(0.5f * (WA[tid] + WA[rm])); }
        __syncthreads();
#pragma unroll
        for (int i = 0; i < 8; ++i) { const int idx = tid + 512 * i, r = idx >> 4, c = idx & 15, s = r >> 7, k2 = r & 127, k1 = s ? (p ? 64 - p : 32) : p;
            *(v4u*)(PROJ + ((size_t)b * T + k1 + 64 * k2) * PROJ_LD + G_OFF + g * 128 + 8 * c) = *(const LAS v4u*)(ZT + (size_t)idx * 8); }
    }
    __syncthreads();
}
__device__ __forceinline__ void stagger(const Frame& F, int ticks) {
    const unsigned long long t0 = __builtin_amdgcn_s_memrealtime(), d = (unsigned long long)((F.vcu & 3) * ticks);
    while (__builtin_amdgcn_s_memrealtime() - t0 < d) __builtin_amdgcn_s_sleep(16);
}
__device__ __forceinline__ int fresh_bid() { int b = (int)blockIdx.x; asm volatile("" : "+s"(b)); return b; }
constexpr int PPL = 9, N_PHASES = 2 + PPL * DEPTH;
__global__ void __launch_bounds__(NWAVES * 64, 2) mega_fwd(Args args, int li) {
    extern __shared__ __attribute__((aligned(16))) unsigned char lds[];
    Frame F;
    F.lds = (LAS unsigned char*)lds;
    F.MISC = (volatile LAS unsigned*)(F.lds + MISC_OFF);
    F.tid = threadIdx.x; F.lane = F.tid & 63; F.wave = __builtin_amdgcn_readfirstlane(F.tid >> 6);
    F.G = gridDim.x; { const int bx = blockIdx.x; F.vcu = (F.G % 8 == 0) ? (bx % 8) * (F.G / 8) + bx / 8 : bx; }
    F.ctl = (gu32*)(args.ws + WS_CTL);
    for (int u = F.tid; u < (LDS_BYTES - LDSCTL_OFF) / 4; u += NWAVES * 64) ((LAS unsigned*)(F.lds + LDSCTL_OFF))[u] = 0u;
    __syncthreads();
    const int lo = args.ph_lo, hi = args.ph_hi;
    XcdBarrier bar; bar.bar = (unsigned*)(F.ctl + CW_BAR) + li * XCD_BAR_WORDS; bar.x = 0; bar.st = nullptr; bar.wave = F.wave;
    if (hi - lo > 1) bar = xcd_barrier_post((unsigned*)(F.ctl + CW_BAR) + li * XCD_BAR_WORDS, F.MISC + 8);
#ifndef PHMASK
#define PHMASK 0xFFFF
#endif
#define EN(kind) ((PHMASK >> (kind)) & 1)
#define IN(k) (lo <= (k) && (k) < hi)
#define SEAM(k) do { if (IN(k) && IN((k) + 1)) { xcd_barrier(bar); for (int rb_ = 0; rb_ < REP_B; ++rb_) xcd_barrier(bar); } } while (0)

    if (EN(0) && IN(0)) { for (int rep = 0; rep < 1 + REP_C; ++rep) p0_prologue(F, args); SEAM(0); }
    auto layer = [&](const int l) __attribute__((always_inline)) {
        const int pb = 1 + PPL * l;
        bf16* U = WSP(bf16, WS_U); bf16* PROJ = WSP(bf16, WS_PROJ); bf16* GATES = WSP(bf16, WS_GATES);
        if (EN(1) && IN(pb + 0)) { if (l == 0) { for (int rep = 0; rep < (REP_R & 1); ++rep) rows_phase<0>(F, args, l); rows_phase<0>(F, args, l); } else rows_phase<1>(F, args, l); SEAM(pb + 0); }
        if (EN(2) && IN(pb + 1)) {
            pg8::Gemm g{U, U, U, WSP(bf16, WS_WP2) + (size_t)l * NP2 * 1024, nullptr, nullptr, 1024, 1024, 1024};
            pg8::StaticOrder S; S.init(NTOK, 3072, F.G, fresh_bid());
            EpiP2 E{false, false, nullptr, PROJ, WSP(bf16, WS_VT)};
            const int npre = 4 * (F.vcu & 3) * (STAG_P2 != 0);
            expert_conv(F, args, l, 0, npre); __syncthreads();
            for (int rep = 0; rep < 1 + (REP_GS & 1 ? REP_G : 0); ++rep) pg8::gemm_phase<EpiP2, pg8::StaticOrder, true>(F.lds + RING_OFF, g, S, E, fresh(F).tid);
            {
                const pg8::bf16_t* U8 = (const pg8::bf16_t*)(args.ws + WS_U8); const pg8::bf16_t* W8 = WSP(bf16, WS_WP2) + (size_t)l * NP2 * 1024 + (size_t)3072 * 1024;
                pg8::Gemm g8{U8, U8, U8, W8, nullptr, nullptr, 512, 512, 512};
                pg8::StaticOrder S8; S8.init(NTOK, 3072, F.G, fresh_bid());
                LAS unsigned char* stab = F.lds + XTRA_OFF;
                { const Frame Fg = fresh(F); __syncthreads();
#pragma unroll
                  for (int q = 0; q < 2; ++q) { const int i = Fg.tid + 512 * q; const float sg = 255.0f / (1.0f + __expf(8.0f - ((float)i + 0.5f) * (1.0f / 64.0f))); stab[i] = (unsigned char)(int)fminf(fmaxf(sg + 0.5f, 1.0f), 255.0f); }
                  __syncthreads(); }
                EpiGates E8{false, GATES, INP(8) + l * 3072, stab};
                for (int rep = 0; rep < 1 + (REP_GS & 1 ? REP_G : 0); ++rep) pg8::gemm_phase<EpiGates, pg8::StaticOrder, true, false, true>(F.lds + RING_OFF, g8, S8, E8, fresh(F).tid);
            }
            __syncthreads(); expert_conv(F, args, l, npre, 12);
            SEAM(pb + 1);
        }
        if (EN(3) && IN(pb + 2)) {
            for (int rep = 0; rep < REP_M; ++rep) { if (REP_MS & 1) attn2_phase(F, args, l, WSP(bf16, WS_SCR), 512); if (REP_MS & 2) lru_conv_phase(F, args, l); if (REP_MS & 4) fft_a2_phase(F, args); if (REP_MS & 16) fft_a2_phase(F, args); }
            lru_conv_phase(F, args, l); attn2_phase(F, args, l, PROJ, PROJ_LD); fft_a2_phase(F, args); SEAM(pb + 2); }
        if (EN(4) && IN(pb + 3)) { for (int rep = 0; rep < REP_M; ++rep) { if (REP_MS & 2) lru2_phase<REP_DBG>(F, args, l, WSP(bf16, WS_SCR), 512, 0); if (REP_MS & 4) fft_b2_phase(F, args); if (REP_MS & 32) fft_b2_phase(F, args); }
            lru2_phase(F, args, l, PROJ, PROJ_LD, YR_OFF); fft_b2_phase(F, args); SEAM(pb + 3); }
        if (EN(6) && IN(pb + 4)) {
            const bf16* WP = WSP(bf16, WS_WPROJ) + (size_t)l * 3 * 1024 * 512;
            pg8::Gemm g{PROJ + Q_OFF, PROJ + YR_OFF, PROJ + G_OFF, WP, WP + 1024 * 512, WP + 2 * 1024 * 512, PROJ_LD, 512, 512};
            pg8::MergeOrder S; S.init(NTOK, 1024, F.G, fresh_bid());
            LAS float* rtab = (LAS float*)(F.lds + XTRA_OFF);
            { const Frame Fm = fresh(F); __syncthreads(); if (Fm.tid < 256) rtab[Fm.tid] = 1.0f / (float)(Fm.tid > 0 ? Fm.tid : 1); __syncthreads(); }
            EpiMerge E{false, GATES, U, rtab};
            for (int rep = 0; rep < 1 + (REP_GS & 2 ? REP_G : 0); ++rep) pg8::gemm_phase<EpiMerge, pg8::MergeOrder, true>(F.lds + RING_OFF, g, S, E, fresh(F).tid);
            SEAM(pb + 4);
        }
        if (EN(7) && IN(pb + 5)) {
            pg8::Gemm g{U, U, U, WSP(bf16, WS_WOUT) + (size_t)l * 1024 * 1024, nullptr, nullptr, 1024, 1024, 1024};
            pg8::StaticOrder S; S.init(NTOK, 1024, F.G, fresh_bid());
            if (l == 0) { EpiResid<true> E{false, INP(0), WSP(bf16, WS_XB0), WSP(bf16, WS_XB1), WSP(float, WS_MOD) + (size_t)l * 4 * 6144 + 2 * 1024};
                pg8::gemm_phase<EpiResid<true>, pg8::StaticOrder, true>(F.lds + RING_OFF, g, S, E, fresh(F).tid); }
            else { EpiResid<false> E{false, nullptr, WSP(bf16, WS_XB0), WSP(bf16, WS_XB1), WSP(float, WS_MOD) + (size_t)l * 4 * 6144 + 2 * 1024};
                pg8::gemm_phase<EpiResid<false>, pg8::StaticOrder, true>(F.lds + RING_OFF, g, S, E, fresh(F).tid); }
            SEAM(pb + 5);
        }
        if (EN(8) && IN(pb + 6)) { if (REP_R & 2) router_phase(F, args, l, 2 + l); router_phase(F, args, l, l); SEAM(pb + 6); }
        if (EN(10) && IN(pb + 7)) {
            moe_tilebase(F, args, l);
            pg8::Gemm g{U, U, U, WSP(bf16, WS_WG1), nullptr, nullptr, 1024, 1024, 1024};
            pg8::MoeOrder S{(const LAS int*)(F.lds + MISC_OFF + 64), F.G, fresh_bid()};
            LAS int* rowmap = (LAS int*)(F.lds + XTRA_OFF);
            moe_rowmaps(F, args, S, rowmap);
            EpiSwiGLU E{false, WSP(bf16, WS_H)};
            for (int rep = 0; rep < 1 + (REP_GS & 8 ? REP_G : 0); ++rep) pg8::gemm_phase<EpiSwiGLU, pg8::MoeOrder, true, true>(F.lds + RING_OFF, g, S, E, fresh(F).tid, rowmap);
            SEAM(pb + 7);
        }
        if (EN(11) && IN(pb + 8)) {
            moe_tilebase(F, args, l);
            const bf16* H = WSP(bf16, WS_H);
            pg8::Gemm g{H, H, H, WSP(bf16, WS_WD), nullptr, nullptr, 512, 512, 512};
            pg8::MoeOrder S{(const LAS int*)(F.lds + MISC_OFF + 64), F.G, fresh_bid()};
            EpiYE E{false, PROJ};
            for (int rep = 0; rep < 1 + (REP_GS & 16 ? REP_G : 0); ++rep) pg8::gemm_phase<EpiYE, pg8::MoeOrder, true>(F.lds + RING_OFF, g, S, E, fresh(F).tid);
            SEAM(pb + 8);
        }
    };
    static_assert(DEPTH == 2, "layers"); layer(0); layer(1);
    if (EN(12) && IN(N_PHASES - 1)) rows_phase<2>(F, args, DEPTH);
#undef IN
#undef SEAM
}

#ifndef MK_MODE
#define MK_MODE 0
#endif
extern "C" void kernel_launch(void* const* d_in, const int* in_sizes, int n_in, void* d_out, int out_size, void* d_ws, size_t ws_size, hipStream_t stream) {
    static int grid = 0;
    if (grid == 0) {
        if (n_in != 27 || in_sizes[0] != NTOK * D || out_size != NTOK * D || ws_size < WS_END) { fprintf(stderr, "kernel_launch: unexpected shapes (n_in %d, in0 %d, out %d, ws %zu < %zu)\n", n_in, n_in > 0 ? in_sizes[0] : -1, out_size, ws_size, (size_t)WS_END); grid = -1; return; }
        int dev = 0, cus = 0;
        if (hipGetDevice(&dev) != hipSuccess || hipDeviceGetAttribute(&cus, hipDeviceAttributeMultiprocessorCount, dev) != hipSuccess) { grid = -1; return; }
        if (hipFuncSetAttribute((const void*)mega_fwd, hipFuncAttributeMaxDynamicSharedMemorySize, LDS_BYTES) != hipSuccess) { fprintf(stderr, "kernel_launch: hipFuncSetAttribute failed\n"); grid = -1; return; }
        (void)hipGetLastError();
        grid = cus;
    }
    if (grid < 0) return;
    if (hipMemsetAsync((char*)d_ws + WS_CTL, 0, CTL_ZERO_BYTES, stream) != hipSuccess) return;
    Args a{};
    for (int i = 0; i < 27; ++i) a.in[i] = (const float*)d_in[i];
    a.out = (float*)d_out; a.ws = (unsigned char*)d_ws;
#if MK_MODE == 0
    a.ph_lo = 0; a.ph_hi = N_PHASES;
    hipLaunchKernelGGL(mega_fwd, dim3(grid), dim3(NWAVES * 64), LDS_BYTES, stream, a, 0);
#else
    for (int p = 0; p < N_PHASES; ++p) { a.ph_lo = p; a.ph_hi = p + 1; hipLaunchKernelGGL(mega_fwd, dim3(grid), dim3(NWAVES * 64), LDS_BYTES, stream, a, 0); }
#endif
}
```

```cpp
#include <hip/hip_runtime.h>
#include <cstdio>
#include <cstdint>
namespace pg8 {
#define PG8_LAS __attribute__((address_space(3)))
typedef unsigned short bf16_t;
typedef short bf16x8 __attribute__((ext_vector_type(8)));
typedef float f32x4 __attribute__((ext_vector_type(4)));
typedef unsigned u32x4 __attribute__((ext_vector_type(4)));
typedef unsigned u32x2 __attribute__((ext_vector_type(2)));
typedef int v4i_ __attribute__((ext_vector_type(4)));
typedef long v2l_ __attribute__((ext_vector_type(2)));
constexpr int BM = 256, BK = 64, HALF = 128, HTB = HALF * BK * 2  , STAGE_BYTES = 8 * HTB, NXCD = 8, WGM = 8;

__host__ __device__ __forceinline__ int lds_byte(int r, int c) { const int st = (r >> 4) * 2 + (c >> 5), rr = r & 15, cc = c & 31, ob = rr * 64 + cc * 2; return st * 1024 + (ob ^ (((ob >> 9) & 1) << 5)); }
__host__ __device__ __forceinline__ void stage_rc(int b, int& R, int& C) { const int st = b / 1024, sb = b % 1024, swz = sb ^ (((sb >> 9) & 1) << 5); R = (st >> 1) * 16 + swz / 64; C = (st & 1) * 32 + (swz % 64) / 2; }
__host__ __device__ __forceinline__ int perm32(int rho) { const int n = rho >> 4, i = rho & 15; return 8 * (i >> 2) + 4 * n + (i & 3); }

struct Unit { int pm, pn, bt, z, gbase, gcnt, ui; };
struct Gemm { const bf16_t* A0; const bf16_t* A1; const bf16_t* A2; const bf16_t* B0; const bf16_t* B1; const bf16_t* B2; int lda, ldb, K; };

__device__ __forceinline__ unsigned cvt_pk_bf16(float lo, float hi) { unsigned r; asm volatile("v_cvt_pk_bf16_f32 %0, %1, %2" : "=v"(r) : "v"(lo), "v"(hi)); return r; }

struct StaticOrder {
    int nM, nN, nwg, G, c;
    __device__ void init(int M, int N, int G_, int c_) { nM = M / BM; nN = N / BM; nwg = nM * nN; G = G_; c = c_; }
    __device__ __forceinline__ bool tile(long L, Unit& u) const {
        if (L >= nwg) return false;
        int wgid = (int)L; { const int q = nwg / NXCD, r = nwg % NXCD, xcd = wgid % NXCD, off = wgid / NXCD; wgid = (xcd < r ? xcd * (q + 1) : r * (q + 1) + (xcd - r) * q) + off; }
        const int nig = WGM * nN, gid = wgid / nig, fm = gid * WGM, gsz = (nM - fm) < WGM ? (nM - fm) : WGM;
        u.pm = fm + ((wgid % nig) % gsz); u.pn = (wgid % nig) / gsz; u.bt = u.pn; u.z = 0; u.gbase = 0; u.gcnt = 0; return true;
    }
    __device__ __forceinline__ bool next(int i, Unit& u) const { return tile((long)i * G + c, u); }
};
struct MergeOrder : StaticOrder {
    __device__ __forceinline__ bool next(int i, Unit& u) const { const int t = i / 3; if (!tile((long)t * G + c, u)) return false; u.z = i - 3 * t; return true; }
};
struct MoeOrder {
    const PG8_LAS int* tb; int G, c;
    __device__ __forceinline__ bool next(int i, Unit& u) const {
        u.ui = i;
        const int L = i * G + c; const int nt = tb[32]; if (L >= nt * 4) return false;
        const int t = L >> 2, j = L & 3; unsigned z_ = 0u; asm volatile("" : "+v"(z_)); const int ln_ = (int)__builtin_amdgcn_mbcnt_hi(~0u, __builtin_amdgcn_mbcnt_lo(~0u, z_)); const int tbv_ = (ln_ >= 1 && ln_ < 32) ? tb[ln_] : 0x7fffffff;
        const int e = __popcll(__ballot(tbv_ <= t));
        const int tl = t - tb[e];
        u.pm = t; u.pn = j; u.bt = e * 4 + j; u.z = 0; u.gbase = e * 32768 + 256 * tl; u.gcnt = tb[33 + e] - 256 * tl; return true;
    }
};

template <class Epi, class Sched, bool ALIGN_EPI, bool GATHER = false, bool FP8 = false, bool I8 = false>
__device__ __forceinline__ void gemm_phase(PG8_LAS unsigned char* lds, const Gemm g, const Sched& S, const Epi& E, const int tid, const PG8_LAS int* rowmap = nullptr) {
    const int wid = __builtin_amdgcn_readfirstlane(tid >> 6), lane = tid & 63, wr = wid >> 2, wc = wid & 3, fr = lane & 15, fq = lane >> 4;
    const int K = g.K, nt = K / BK;
    int sc1_ = 0x7F7F7F7F; if constexpr (FP8) asm volatile("" : "+v"(sc1_));
    unsigned voffA[2], voffB[2]; int gR[2];
#pragma unroll
    for (int i = 0; i < 2; ++i) { int R, C; stage_rc(tid * 16 + i * 8192, R, C); const int Rb = Epi::PERM ? ((R & ~31) + perm32(R & 31)) : R;
        voffA[i] = GATHER ? (unsigned)C * 2u : (unsigned)(R * g.lda + C) * 2u; voffB[i] = (unsigned)(Rb * g.ldb + C) * 2u; gR[i] = R; }
    unsigned offC[2][2], offN[2][2];
#define PG8_GOFF(dst, ui_) do { _Pragma("unroll") for (int h_ = 0; h_ < 2; ++h_) _Pragma("unroll") for (int i_ = 0; i_ < 2; ++i_) dst[h_][i_] = (unsigned)rowmap[(ui_) * 256 + 128 * h_ + gR[i_]] * (unsigned)(g.lda * 2) + voffA[i_]; } while (0)
    const size_t kstep = (size_t)(BK * 2);
    const size_t hstepA = (size_t)HALF * g.lda * 2, hstepB = (size_t)HALF * g.ldb * 2;
    const size_t tstepA = 2 * hstepA, tstepB = 2 * hstepB;
    const unsigned ldsw = (unsigned)wid * 1024u;
    const int aoff = lds_byte(wr * 64 + fr, fq * 8), boff = lds_byte(wc * 32 + fr, fq * 8);
#define PG8_SA(b, h) (((b) * 2 + (h)) * HTB)
#define PG8_SB(b, h) ((4 + (b) * 2 + (h)) * HTB)
#define PG8_STAGE(bufoff, gbase, voff) do { _Pragma("unroll") for (int _i = 0; _i < 2; ++_i) { unsigned vo_ = (voff)[_i]; if constexpr (FP8 || I8) asm volatile("" : "+v"(vo_)); \
        __builtin_amdgcn_global_load_lds((const unsigned*)((const char*)(gbase) + vo_), (PG8_LAS unsigned*)(lds + (bufoff) + ldsw + _i * 8192), 16, 0, 0); } } while (0)
#define PG8_STAGE_A(bufoff, gbase, h, nf) do { _Pragma("unroll") for (int _i = 0; _i < 2; ++_i) { unsigned o_ = GATHER ? ((nf) ? offN[h][_i] : offC[h][_i]) : (voffA[_i] + (unsigned)((h) * hstepA)); if constexpr (FP8 || I8) asm volatile("" : "+v"(o_)); \
        __builtin_amdgcn_global_load_lds((const unsigned*)((const char*)(gbase) + o_), (PG8_LAS unsigned*)(lds + (bufoff) + ldsw + _i * 8192), 16, 0, 0); } } while (0)
#define PG8_LDA(dst, b, h) do { _Pragma("unroll") for (int m = 0; m < 4; ++m) _Pragma("unroll") for (int k = 0; k < 2; ++k) dst[m][k] = *(const PG8_LAS bf16x8*)(lds + PG8_SA(b, h) + aoff + m * 2048 + k * 1024); } while (0)
#define PG8_LDB(dst, b, h) do { _Pragma("unroll") for (int n = 0; n < 2; ++n) _Pragma("unroll") for (int k = 0; k < 2; ++k) dst[n][k] = *(const PG8_LAS bf16x8*)(lds + PG8_SB(b, h) + boff + n * 2048 + k * 1024); } while (0)
#define PG8_I8MMA(bfr, afr, c) do { c = __builtin_bit_cast(f32x4, __builtin_amdgcn_mfma_i32_16x16x64_i8(__builtin_bit_cast(v4i_, bfr), __builtin_bit_cast(v4i_, afr), __builtin_bit_cast(v4i_, c), 0, 0, 0)); } while (0)
#define PG8_CAT8(x) __builtin_shufflevector(__builtin_bit_cast(v4i_, (x)[0]), __builtin_bit_cast(v4i_, (x)[1]), 0, 1, 2, 3, 4, 5, 6, 7)
#define PG8_MMA(ai, bj, At, Bt) do { __builtin_amdgcn_s_setprio(1); _Pragma("unroll") for (int m = 0; m < 4; ++m) _Pragma("unroll") for (int n = 0; n < 2; ++n) { \
        if constexpr (FP8) acc[ai][bj][m][n] = __builtin_amdgcn_mfma_scale_f32_16x16x128_f8f6f4(PG8_CAT8(Bt[n]), PG8_CAT8(At[m]), acc[ai][bj][m][n], 0, 0, 0, sc1_, 0, sc1_); \
        else if constexpr (I8) { _Pragma("unroll") for (int k = 0; k < 2; ++k) { PG8_I8MMA(Bt[n][k], At[m][k], acc[ai][bj][m][n]); } } \
        else { _Pragma("unroll") for (int k = 0; k < 2; ++k) acc[ai][bj][m][n] = __builtin_amdgcn_mfma_f32_16x16x32_bf16(Bt[n][k], At[m][k], acc[ai][bj][m][n], 0, 0, 0); } } __builtin_amdgcn_s_setprio(0); } while (0)
#define PG8_WAIT_V(n) asm volatile("s_waitcnt vmcnt(" #n ")" ::: "memory")
#define PG8_WAIT_L(n) asm volatile("s_waitcnt lgkmcnt(" #n ")" ::: "memory")
#define PG8_BAR __builtin_amdgcn_s_barrier()
#define PG8_SCHED __builtin_amdgcn_sched_barrier(0)
#define PG8_APTR(u) (GATHER ? (const char*)g.A0 : (const char*)((u).z == 0 ? g.A0 : ((u).z == 1 ? g.A1 : g.A2)) + (size_t)(u).pm * tstepA)
#define PG8_BPTR(u) ((const char*)((u).z == 0 ? g.B0 : ((u).z == 1 ? g.B1 : g.B2)) + (size_t)(u).bt * tstepB)
    Unit cur, nxt; int ui = 0;
    if (!S.next(0, cur)) return;
    cur.ui = 0;
    f32x4 acc[2][2][4][2];
#pragma unroll
    for (int a = 0; a < 2; ++a)
#pragma unroll
        for (int b = 0; b < 2; ++b)
#pragma unroll
            for (int m = 0; m < 4; ++m)
#pragma unroll
                for (int n = 0; n < 2; ++n) acc[a][b][m][n] = (f32x4){0.f, 0.f, 0.f, 0.f};
    bf16x8 At[4][2], B0[2][2], B1[2][2];
    const char* cA = PG8_APTR(cur); const char* cB = PG8_BPTR(cur);
    if constexpr (GATHER) { PG8_GOFF(offC, 0); PG8_GOFF(offN, 0); }
    PG8_STAGE(PG8_SB(0, 0), cB, voffB); PG8_STAGE(PG8_SB(0, 1), cB + hstepB, voffB); PG8_STAGE_A(PG8_SA(0, 0), cA, 0, false); PG8_STAGE_A(PG8_SA(0, 1), cA, 1, false);
    if (wr == 1) PG8_BAR;
    PG8_WAIT_V(2); PG8_BAR;
    PG8_STAGE(PG8_SB(1, 0), cB + kstep, voffB); PG8_STAGE_A(PG8_SA(1, 0), cA + kstep, 0, false); PG8_STAGE(PG8_SB(1, 1), cB + hstepB + kstep, voffB);
    PG8_WAIT_V(6); PG8_BAR;
    for (;;) {
        const bool has_next = S.next(ui + 1, nxt); nxt.ui = ui + 1;
        if constexpr (Epi::PREFETCH) E.prefetch(cur, wid, lane);
        const char* nA = has_next ? PG8_APTR(nxt) : cA; const char* nB = has_next ? PG8_BPTR(nxt) : cB;
        if constexpr (GATHER) { if (has_next) { PG8_GOFF(offN, ui + 1); } else { _Pragma("unroll") for (int h_ = 0; h_ < 2; ++h_) _Pragma("unroll") for (int i_ = 0; i_ < 2; ++i_) offN[h_][i_] = offC[h_][i_]; } }
#pragma unroll 1
        for (int t = 0; t < nt; t += 2) {
            const bool last = (t == nt - 2);
            const char* a1 = cA + (size_t)(t + 1) * kstep;
            const char* a2 = last ? nA : cA + (size_t)(t + 2) * kstep; const char* b2 = last ? nB : cB + (size_t)(t + 2) * kstep;
            const char* a3 = a2 + kstep; const char* b3 = b2 + kstep;
            PG8_LDB(B0, 0, 0); PG8_LDB(B1, 0, 1); PG8_SCHED; PG8_LDA(At, 0, 0); PG8_STAGE_A(PG8_SA(1, 1), a1, 1, false);
            PG8_WAIT_V(8); PG8_WAIT_L(0); PG8_BAR; PG8_MMA(0, 0, At, B0); PG8_MMA(0, 1, At, B1); PG8_BAR; PG8_SCHED;
            PG8_LDA(At, 0, 1); PG8_STAGE(PG8_SB(0, 0), b2, voffB); PG8_STAGE(PG8_SB(0, 1), b2 + hstepB, voffB); PG8_STAGE_A(PG8_SA(0, 0), a2, 0, last);
            PG8_WAIT_V(8); PG8_WAIT_L(0); PG8_BAR; PG8_MMA(1, 0, At, B0); PG8_MMA(1, 1, At, B1); PG8_BAR; PG8_SCHED;
            PG8_LDB(B0, 1, 0); PG8_LDB(B1, 1, 1); PG8_SCHED; PG8_LDA(At, 1, 0); PG8_STAGE_A(PG8_SA(0, 1), a2, 1, last);
            PG8_WAIT_V(8); PG8_WAIT_L(0); PG8_BAR; PG8_MMA(0, 0, At, B0); PG8_MMA(0, 1, At, B1); PG8_BAR; PG8_SCHED;
            PG8_LDA(At, 1, 1); PG8_STAGE(PG8_SB(1, 0), b3, voffB); PG8_STAGE(PG8_SB(1, 1), b3 + hstepB, voffB); PG8_STAGE_A(PG8_SA(1, 0), a3, 0, last);
            PG8_WAIT_V(8); PG8_WAIT_L(0); PG8_BAR; PG8_MMA(1, 0, At, B0); PG8_MMA(1, 1, At, B1); PG8_BAR; PG8_SCHED;
        }
        if constexpr (ALIGN_EPI) { if (wr == 0) PG8_BAR; }
        unsigned ze_ = 0u; asm volatile("" : "+v"(ze_)); const int le_ = (int)__builtin_amdgcn_mbcnt_hi(~0u, __builtin_amdgcn_mbcnt_lo(~0u, ze_));
        bool fin_ = true;
        if constexpr (Epi::CHAINS) fin_ = E.is_final(cur);
        if constexpr (Epi::CHAINS) { E.rescale(acc, cur, wr, wc, le_ & 15, le_ >> 4); if (fin_) E(acc, cur, wr, wc, le_ & 15, le_ >> 4); }
        else if (!E.skip) E(acc, cur, wr, wc, le_ & 15, le_ >> 4); else { _Pragma("unroll") for (int a_ = 0; a_ < 2; ++a_) _Pragma("unroll") for (int b_ = 0; b_ < 2; ++b_) _Pragma("unroll") for (int m_ = 0; m_ < 4; ++m_) _Pragma("unroll") for (int n_ = 0; n_ < 2; ++n_) asm volatile("" :: "v"(acc[a_][b_][m_][n_])); }
        if (!has_next) break;
        if (fin_) {
#pragma unroll
        for (int a = 0; a < 2; ++a)
#pragma unroll
            for (int b = 0; b < 2; ++b)
#pragma unroll
                for (int m = 0; m < 4; ++m)
#pragma unroll
                    for (int n = 0; n < 2; ++n) acc[a][b][m][n] = (f32x4){0.f, 0.f, 0.f, 0.f};
        }
        cur = nxt; cA = nA; cB = nB; ++ui;
        if constexpr (GATHER) { _Pragma("unroll") for (int h_ = 0; h_ < 2; ++h_) _Pragma("unroll") for (int i_ = 0; i_ < 2; ++i_) offC[h_][i_] = offN[h_][i_]; }
        if constexpr (ALIGN_EPI) { if (wr == 1) PG8_BAR; }
    }
    PG8_WAIT_V(0);
    if constexpr (!ALIGN_EPI) { if (wr == 0) PG8_BAR; }
    PG8_BAR;
#undef PG8_SA
#undef PG8_SB
#undef PG8_STAGE
#undef PG8_LDA
#undef PG8_LDB
#undef PG8_MMA
#undef PG8_CAT8
#undef PG8_WAIT_V
#undef PG8_WAIT_L
#undef PG8_BAR
#undef PG8_SCHED
#undef PG8_APTR
#undef PG8_STAGE_A
#undef PG8_GOFF
#undef PG8_BPTR
}
}
constexpr int NWAVES = 8;
constexpr int NB = 4, T = 8192, D = 1024, NTOK = NB * T, DEPTH = 2;
constexpr int PROJ_LD = 3072, Q_OFF = 0, K_OFF = 512, XR_OFF = 1024, YR_OFF = 1536, G_OFF = 2048;
constexpr int GATES_LD = 3072;
constexpr int NP2 = 6144;
constexpr int NEXP = 32, XS_ROWS = 73728;
constexpr int LRU_CH = 32, LRU_NCH = T / LRU_CH;
constexpr float EPS = 1e-6f;

constexpr size_t MiB = 1u << 20;
constexpr size_t WS_CTL = 0, CTL_ZERO_BYTES = 1 * MiB;
constexpr size_t WS_MOD = 1 * MiB;
constexpr size_t WS_FA = WS_MOD + 256 * 1024;
constexpr size_t WS_FB = WS_FA + 32 * 1024;
constexpr size_t WS_TW = WS_FB + 64 * 1024;
constexpr size_t WS_WL = 2 * MiB;
constexpr size_t WS_TOKW = 3 * MiB;
constexpr size_t WS_TOKROW = WS_TOKW + 256 * 1024;
constexpr size_t WS_PERM = 4 * MiB;
constexpr size_t WS_WP2 = 20 * MiB;
constexpr size_t WS_WPROJ = 46 * MiB;
constexpr size_t WS_WOUT = 52 * MiB;
constexpr size_t WS_U = 56 * MiB;
constexpr size_t WS_VT = 120 * MiB;
constexpr size_t WS_PROJ = 152 * MiB;
constexpr size_t WS_GATES = 344 * MiB;
constexpr size_t WS_H = WS_GATES;
constexpr size_t WS_WG1 = WS_GATES + 96 * MiB, WS_WD = WS_GATES + 160 * MiB;
constexpr size_t WS_XC = 536 * MiB;
constexpr size_t WS_U8 = WS_XC;
constexpr size_t WS_SWO = 1792 * 1024 + 49152;
constexpr size_t WS_SWE = 1856 * 1024;
constexpr size_t WS_SA = 1536 * 1024, WS_SW = 1792 * 1024;
constexpr size_t WS_FT = 152 * MiB;
constexpr size_t WS_XB0 = 568 * MiB, WS_XB1 = 8 * MiB;
constexpr int XB_SPLIT = 30720;
constexpr size_t WS_END = 628 * MiB;
constexpr size_t WS_SCR = WS_VT;
#ifndef REP_G
#define REP_G 0
#endif
#ifndef REP_C
#define REP_C 0
#endif
#ifndef STAG_P2
#define STAG_P2 600
#endif
#ifndef REP_DBG
#define REP_DBG 0
#endif
#ifndef REP_B
#define REP_B 0
#endif
#ifndef REP_R
#define REP_R 0
#endif
#ifndef REP_GS
#define REP_GS 31
#endif
#ifndef REP_MS
#define REP_MS 15
#endif
#ifndef REP_M
#define REP_M 0
#endif
static_assert(WS_H + (size_t)XS_ROWS * 512 * 2 <= WS_WG1 && WS_WD + 32 * MiB <= WS_XC, "ws map");
constexpr int CW_BAR = 4096;
constexpr int CW_CMAXO = 77824;
constexpr int CW_RM = 81920;
constexpr int CW_TC = 147456;
constexpr int CW_CMAX = 65536;
constexpr int CW_ECNT = 16384;

constexpr int LDS_BYTES = 163840;
constexpr int RING_OFF = 0, RING_BYTES = 131072;
constexpr int XTRA_OFF = RING_BYTES;
constexpr int LDSCTL_OFF = LDS_BYTES - 512, MISC_OFF = LDSCTL_OFF + 64;

#define GAS __attribute__((address_space(1)))
#define LAS __attribute__((address_space(3)))
typedef unsigned short bf16;
typedef unsigned v4u __attribute__((ext_vector_type(4)));
typedef unsigned v2u __attribute__((ext_vector_type(2)));
typedef float f32x4 __attribute__((ext_vector_type(4)));
typedef float f32x2 __attribute__((ext_vector_type(2)));
typedef float f32x16 __attribute__((ext_vector_type(16)));
typedef short bf16x8 __attribute__((ext_vector_type(8)));
typedef short bf16x4 __attribute__((ext_vector_type(4)));
typedef GAS unsigned gu32;
#define RLX_AGENT __ATOMIC_RELAXED, __HIP_MEMORY_SCOPE_AGENT
#define LDS_WAIT() asm volatile("s_waitcnt lgkmcnt(0)" ::: "memory")
#define VM_WAIT() asm volatile("s_waitcnt vmcnt(0)" ::: "memory")
typedef __bf16 hwbf16x2 __attribute__((ext_vector_type(2)));
__device__ __forceinline__ unsigned pk2(float lo, float hi) { f32x2 v = {lo, hi}; hwbf16x2 b = __builtin_convertvector(v, hwbf16x2); return __builtin_bit_cast(unsigned, b); }
__device__ __forceinline__ unsigned pk4_fp8(float a, float b, float c, float d) { int p = __builtin_amdgcn_cvt_pk_fp8_f32(a, b, 0, false); return (unsigned)__builtin_amdgcn_cvt_pk_fp8_f32(c, d, p, true); }
__device__ __forceinline__ unsigned pk4_i8(float a, float b, float c, float d) { return ((unsigned)(int)__builtin_rintf(a) & 0xffu) | (((unsigned)(int)__builtin_rintf(b) & 0xffu) << 8) | (((unsigned)(int)__builtin_rintf(c) & 0xffu) << 16) | ((unsigned)(int)__builtin_rintf(d) << 24); }
__device__ __forceinline__ unsigned f2bf(float f) { return pk2(f, 0.f) & 0xffffu; }
__device__ __forceinline__ float bflo(unsigned w) { return __builtin_bit_cast(float, w << 16); }
__device__ __forceinline__ float bfhi(unsigned w) { return __builtin_bit_cast(float, w & 0xffff0000u); }
__device__ __forceinline__ float bf2f(unsigned short h) { return __builtin_bit_cast(float, (unsigned)h << 16); }
__device__ __forceinline__ float sigmoidf(float v) { return 1.0f / (1.0f + __expf(-v)); }
__device__ __forceinline__ float fsigmoid(float v) { return __builtin_amdgcn_rcpf(1.0f + __expf(-v)); }
#define PIN4(a) asm volatile("" : "+v"(a[0]), "+v"(a[1]), "+v"(a[2]), "+v"(a[3]))
#define PIN8(a) asm volatile("" : "+v"(a[0]), "+v"(a[1]), "+v"(a[2]), "+v"(a[3]), "+v"(a[4]), "+v"(a[5]), "+v"(a[6]), "+v"(a[7]))
__device__ __forceinline__ float wave_sum(float v) {
#pragma unroll
    for (int o = 1; o < 64; o <<= 1) v += __shfl_xor(v, o);
    return v;
}
#define XB_TMO      128
#define XB_XCNT(j)  (256  + 64 * (j))
#define XB_XSUB(j)  (1280 + 64 * (j))
#define XB_XGEN(j)  (2304 + 64 * (j))
#define XB_TOP      3328
#define XB_TOPGEN   3392
#define XCD_BAR_WORDS 3456
#define XB_SPIN_CAP (1u << 18)

__device__ __forceinline__ unsigned xb_ld(unsigned* p)              { return __hip_atomic_load(p, __ATOMIC_RELAXED, __HIP_MEMORY_SCOPE_AGENT); }
__device__ __forceinline__ unsigned xb_add(unsigned* p, unsigned v) { return __hip_atomic_fetch_add(p, v, __ATOMIC_RELAXED, __HIP_MEMORY_SCOPE_AGENT); }
__device__ __forceinline__ unsigned xb_xcc_id() { return (unsigned)__builtin_amdgcn_s_getreg((3 << 11) | 20) & 0xFu; }
#define XB_SPIN(cond, bar) do { unsigned _sp = 0; while (cond) { __builtin_amdgcn_s_sleep(1); \
    if ((++_sp & 255u) == 0u) { if (xb_ld(&(bar)[XB_TMO])) break; if (_sp > XB_SPIN_CAP) { atomicAdd(&(bar)[XB_TMO], 1u); break; } } } } while (0)

struct XcdBarrier {
    unsigned* bar; unsigned x;
    int wave;
    volatile LAS unsigned* st;
};

__device__ __forceinline__ XcdBarrier xcd_barrier_post(unsigned* bar, volatile LAS unsigned* st) {
    XcdBarrier b; b.bar = bar; b.x = xb_xcc_id(); b.st = st; b.wave = __builtin_amdgcn_readfirstlane((int)threadIdx.x >> 6);
    if (threadIdx.x == 0) (void)xb_add(&bar[XB_XCNT(b.x)], 1u);
    return b;
}
__device__ __forceinline__ void xcd_barrier_complete(unsigned* bar, unsigned x, unsigned& nloc, unsigned& nx) {
    const unsigned G = gridDim.x * gridDim.y * gridDim.z;
    unsigned sum, cnt, mine, sp = 0u;
    for (;;) {
        sum = 0u; cnt = 0u; mine = 0u;
#pragma unroll
        for (unsigned j = 0; j < 16; ++j) { const unsigned c = xb_ld(&bar[XB_XCNT(j)]); sum += c; cnt += (c > 0u) ? 1u : 0u; mine = (j == x) ? c : mine; }
        if (sum == G) break;
        __builtin_amdgcn_s_sleep(1);
        if ((++sp & 255u) == 0u) { if (xb_ld(&bar[XB_TMO])) break; if (sp > XB_SPIN_CAP) { atomicAdd(&bar[XB_TMO], 1u); break; } }
    }
    nloc = mine > 0u ? mine : 1u; nx = cnt > 0u ? cnt : 1u;
}

__device__ __forceinline__ void xcd_barrier(const XcdBarrier& b) {
    asm volatile("s_waitcnt vmcnt(0)" ::: "memory");
    __syncthreads();
    unsigned z_ = 0u; asm volatile("" : "+v"(z_));
    if (b.wave == 0 && __builtin_amdgcn_mbcnt_hi(~0u, __builtin_amdgcn_mbcnt_lo(~0u, z_)) == 0u) {
        unsigned* bar = b.bar;
        __builtin_amdgcn_s_waitcnt(0);
        unsigned nloc = b.st[0], nx = b.st[1];
        if (nloc == 0u) { xcd_barrier_complete(bar, b.x, nloc, nx); b.st[0] = nloc; b.st[1] = nx; }
        const unsigned old = xb_add(&bar[XB_XSUB(b.x)], 1u);
        const unsigned gen = old / nloc;
        if (old + 1u == (gen + 1u) * nloc) {
            __builtin_amdgcn_fence(__ATOMIC_RELEASE, "agent");
            asm volatile("s_waitcnt vmcnt(0)" ::: "memory");
            const unsigned og = xb_add(&bar[XB_TOP], 1u);
            const unsigned tg = og / nx;
            if (og + 1u == (tg + 1u) * nx) xb_add(&bar[XB_TOPGEN], 1u);
            else XB_SPIN(xb_ld(&bar[XB_TOPGEN]) == tg, bar);
            __builtin_amdgcn_fence(__ATOMIC_ACQUIRE, "agent");
            xb_add(&bar[XB_XGEN(b.x)], 1u);
            asm volatile("s_waitcnt vmcnt(0)" ::: "memory");
        } else {
            XB_SPIN(xb_ld(&bar[XB_XGEN(b.x)]) == gen, bar);
            __builtin_amdgcn_fence(__ATOMIC_ACQUIRE, "agent");
            asm volatile("s_waitcnt vmcnt(0)" ::: "memory");
        }
    }
    __syncthreads();
}

struct Args { const float* in[27]; float* out; unsigned char* ws; int ph_lo, ph_hi; };
struct Frame {
    LAS unsigned char* lds;
    volatile LAS unsigned* MISC;
    gu32* ctl;
    int tid, lane, wave, vcu, G;
};
__device__ __forceinline__ Frame fresh(const Frame& F) {
    Frame N = F; int w = F.wave; asm volatile("" : "+s"(w)); unsigned z = 0u; asm volatile("" : "+v"(z));
    const int ln = (int)__builtin_amdgcn_mbcnt_hi(~0u, __builtin_amdgcn_mbcnt_lo(~0u, z)); N.tid = w * 64 + ln; N.lane = ln; N.wave = w;
    int v = F.vcu; asm volatile("" : "+s"(v)); N.vcu = v; int g = F.G; asm volatile("" : "+s"(g)); N.G = g; return N;
}
#define WSP(T_, off) ((T_*)(args.ws + (off)))
#define XBROW(m) ((bf16*)(args.ws + ((m) < XB_SPLIT ? WS_XB0 + (size_t)(m) * 2048 : WS_XB1 + (size_t)((m) - XB_SPLIT) * 2048)))
#define INP(i) (args.in[i])

struct TrItem { const float* W; int ldw, k0, n0; bf16* dst; int ldd; };
__device__ __forceinline__ void tr_load(const TrItem& it, f32x4 (&v)[8], int lane) {
    const float* p = it.W + (size_t)(it.k0 + (lane >> 3)) * it.ldw + it.n0 + 4 * (lane & 7);
#pragma unroll
    for (int i = 0; i < 8; ++i) v[i] = __builtin_nontemporal_load((const f32x4*)(p + (size_t)(8 * i) * it.ldw));
}
__device__ __forceinline__ void tr_finish(const TrItem& it, f32x4 (&v)[8], LAS float* scr, int lane) {
    PIN8(v);
#pragma unroll
    for (int i = 0; i < 8; ++i) { LAS float* d = scr + (8 * i + (lane >> 3)) * 33 + 4 * (lane & 7); d[0] = v[i].x; d[1] = v[i].y; d[2] = v[i].z; d[3] = v[i].w; }
    LDS_WAIT(); asm volatile("" ::: "memory");
    const int c = lane & 7;
#pragma unroll
    for (int j = 0; j < 4; ++j) { const int n = (lane >> 3) + 8 * j; const LAS float* s = scr + (8 * c) * 33 + n;
        v4u o; o.x = pk2(s[0 * 33], s[1 * 33]); o.y = pk2(s[2 * 33], s[3 * 33]); o.z = pk2(s[4 * 33], s[5 * 33]); o.w = pk2(s[6 * 33], s[7 * 33]);
        *(v4u*)(it.dst + (size_t)n * it.ldd + it.k0 + 8 * c) = o; }
    LDS_WAIT(); asm volatile("" ::: "memory");
}
__device__ __forceinline__ void colmax_item(const float* W, int ldw, int k0, int n0, gu32* cmax, int lane) {
    const TrItem it{W, ldw, k0, n0, nullptr, 0}; f32x4 v[8]; tr_load(it, v, lane);
    f32x4 m = (f32x4){0.f, 0.f, 0.f, 0.f};
#pragma unroll
    for (int i = 0; i < 8; ++i) { m.x = fmaxf(m.x, fabsf(v[i].x)); m.y = fmaxf(m.y, fabsf(v[i].y)); m.z = fmaxf(m.z, fabsf(v[i].z)); m.w = fmaxf(m.w, fabsf(v[i].w)); }
#pragma unroll
    for (int o = 8; o < 64; o <<= 1) { m.x = fmaxf(m.x, __shfl_xor(m.x, o)); m.y = fmaxf(m.y, __shfl_xor(m.y, o)); m.z = fmaxf(m.z, __shfl_xor(m.z, o)); m.w = fmaxf(m.w, __shfl_xor(m.w, o)); }
    if (lane < 8) { gu32* c = cmax + 4 * lane;
        __hip_atomic_fetch_max(c + 0, __float_as_uint(m.x), RLX_AGENT); __hip_atomic_fetch_max(c + 1, __float_as_uint(m.y), RLX_AGENT);
        __hip_atomic_fetch_max(c + 2, __float_as_uint(m.z), RLX_AGENT); __hip_atomic_fetch_max(c + 3, __float_as_uint(m.w), RLX_AGENT); }
}
__device__ __forceinline__ void quant_item(const float* W, int ldw, int k0, int n0, unsigned char* dst8, const gu32* cmax, float* swc, LAS float* scr, int lane) {
    const TrItem it{W, ldw, k0, n0, nullptr, 0}; f32x4 v[8]; tr_load(it, v, lane);
    PIN8(v);
#pragma unroll
    for (int i = 0; i < 8; ++i) { LAS float* d = scr + (8 * i + (lane >> 3)) * 33 + 4 * (lane & 7); d[0] = v[i].x; d[1] = v[i].y; d[2] = v[i].z; d[3] = v[i].w; }
    LDS_WAIT(); asm volatile("" ::: "memory");
    const int c = lane & 7;
#pragma unroll
    for (int j = 0; j < 4; ++j) { const int n = (lane >> 3) + 8 * j; const LAS float* s = scr + (8 * c) * 33 + n;
        const float cm = fmaxf(__builtin_bit_cast(float, __hip_atomic_load(cmax + n, RLX_AGENT)), 1e-30f), inv = 127.0f / cm;
        if (k0 == 0 && c == 0) swc[n] = cm * (1.0f / 127.0f);
        *(v2u*)(dst8 + (size_t)n * 1024 + k0 + 8 * c) = (v2u){pk4_i8(inv * s[0 * 33], inv * s[1 * 33], inv * s[2 * 33], inv * s[3 * 33]), pk4_i8(inv * s[4 * 33], inv * s[5 * 33], inv * s[6 * 33], inv * s[7 * 33])}; }
    LDS_WAIT(); asm volatile("" ::: "memory");
}
__device__ __forceinline__ void transpose_item(const float* W, int ldw, int k0, int n0, bf16* dst, int ldd, LAS float* scr, int lane) {
    const TrItem it{W, ldw, k0, n0, dst, ldd}; f32x4 v[8]; tr_load(it, v, lane); tr_finish(it, v, scr, lane);
}
__device__ __forceinline__ void slab_quant_1024(const Frame& F, const float* src, int ldw, unsigned char* dst8, float* sw) {
    const int tid = F.tid, lane = F.lane, wave = F.wave;
    LAS float* Tt = (LAS float*)(F.lds + RING_OFF);
    LAS float* red = Tt + 1024 * 33;
    __syncthreads();
#pragma unroll
    for (int hb = 0; hb < 2; ++hb) { f32x4 v[8];
#pragma unroll
        for (int i = 0; i < 8; ++i) { const int row = (tid >> 3) + 64 * (8 * hb + i); v[i] = __builtin_nontemporal_load((const f32x4*)(src + (size_t)row * ldw + 4 * (tid & 7))); }
        PIN8(v);
#pragma unroll
        for (int i = 0; i < 8; ++i) { const int row = (tid >> 3) + 64 * (8 * hb + i); LAS float* d = Tt + row * 33 + 4 * (tid & 7); d[0] = v[i].x; d[1] = v[i].y; d[2] = v[i].z; d[3] = v[i].w; } }
    __syncthreads();
    { const int col = tid & 31, part = tid >> 5; float mx = 0.f;
#pragma unroll 8
      for (int r = 0; r < 64; ++r) mx = fmaxf(mx, fabsf(Tt[(part * 64 + r) * 33 + col]));
      red[part * 32 + col] = mx; }
    __syncthreads();
    if (tid < 32) { float mx = 0.f;
#pragma unroll
        for (int p2 = 0; p2 < 16; ++p2) mx = fmaxf(mx, red[p2 * 32 + tid]);
        mx = fmaxf(mx, 1e-30f); red[512 + tid] = 127.0f / mx; sw[tid] = mx * (1.0f / 127.0f); }
    __syncthreads();
    { const int c = lane & 7, n = lane >> 3;
#pragma unroll 2
      for (int ps = wave; ps < 64; ps += NWAVES) { const int kc = 8 * (ps >> 2) + c, col = 8 * (ps & 3) + n; const float inv = red[512 + col]; const LAS float* sp = Tt + (8 * kc) * 33 + col;
          __builtin_nontemporal_store((v2u){pk4_i8(inv * sp[0 * 33], inv * sp[1 * 33], inv * sp[2 * 33], inv * sp[3 * 33]), pk4_i8(inv * sp[4 * 33], inv * sp[5 * 33], inv * sp[6 * 33], inv * sp[7 * 33])}, (v2u*)(dst8 + (size_t)col * 1024 + 8 * kc)); } }
    __syncthreads();
}
__device__ __forceinline__ void p0_prologue(const Frame& F0, const Args& args) {
    const Frame F = fresh(F0);
    const int tid = F.tid, lane = F.lane, wave = F.wave;
    float* MOD = WSP(float, WS_MOD);
    {
        LAS f32x4* cact4 = (LAS f32x4*)(F.lds + RING_OFF);
        LAS float* red = (LAS float*)(F.lds + RING_OFF + 16384);
        if (F.vcu < 192) {
            const float* c = INP(1);
#pragma unroll
            for (int i = 0; i < 8; ++i) { const int idx = tid + 512 * i, b = idx >> 10, k = idx & 1023; const float v = c[b * 1024 + k]; ((LAS float*)cact4)[k * 4 + b] = v * sigmoidf(v); }
        }
        __syncthreads();
        for (int u = F.vcu; u < 192; u += F.G) {
            const int l = u / 96, j0 = (u % 96) * 64;
            const float* aw = INP(2) + (size_t)l * 1024 * 6144 + j0 + lane;
            float a0 = 0.f, a1 = 0.f, a2 = 0.f, a3 = 0.f;
#pragma unroll 32
            for (int kk = 0; kk < 128; ++kk) { const int k = 128 * wave + kk; const float wv = aw[(size_t)k * 6144]; const f32x4 c4 = cact4[k]; a0 += c4.x * wv; a1 += c4.y * wv; a2 += c4.z * wv; a3 += c4.w * wv; }
            red[(wave * 4 + 0) * 64 + lane] = a0; red[(wave * 4 + 1) * 64 + lane] = a1; red[(wave * 4 + 2) * 64 + lane] = a2; red[(wave * 4 + 3) * 64 + lane] = a3;
            __syncthreads();
            if (tid < 256) { const int b = tid >> 6, ln = tid & 63; float s = INP(3)[l * 6144 + j0 + ln];
#pragma unroll
                for (int w = 0; w < 8; ++w) s += red[(w * 4 + b) * 64 + ln];
                MOD[(size_t)(l * 4 + b) * 6144 + j0 + ln] = s; }
            __syncthreads();
        }
    }
    {
        LAS float* Tt = (LAS float*)(F.lds + RING_OFF);
        LAS float* cs = (LAS float*)(F.lds + RING_OFF + 33792);
        LAS float* sn = cs + 128;
        if (tid < 128) { cs[tid] = cospif((float)tid * (1.0f / 64.0f)); sn[tid] = sinpif((float)tid * (1.0f / 64.0f)); }
        for (int it = F.G - 1 - F.vcu; it < 256; it += F.G) {
            const int l = it >> 7, g = (it >> 5) & 3, k0 = (it & 31) * 32;
            const float* src = INP(6) + (size_t)l * 1024 * 3072 + 2560 + g * 128;
            __syncthreads();
            { float tv[8];
#pragma unroll
                for (int i = 0; i < 8; ++i) { const int idx = tid + 512 * i, row = idx >> 7, cc = idx & 127; tv[i] = src[(size_t)(k0 + row) * 3072 + cc]; }
                PIN8(tv);
#pragma unroll
                for (int i = 0; i < 8; ++i) { const int idx = tid + 512 * i, row = idx >> 7, cc = idx & 127; Tt[row * 129 + cc] = tv[i]; } }
            __syncthreads();
            const int kk = tid & 31, og = tid >> 5, part = og >> 3, m0 = (og & 7) * 8;
            float acc[8]; float ny = 0.f;
#pragma unroll
            for (int i = 0; i < 8; ++i) acc[i] = 0.f;
            const LAS float* tab = part ? sn : cs;
#pragma unroll 2
            for (int cc = 0; cc < 128; ++cc) { const float t = Tt[kk * 129 + cc]; ny += (cc & 1) ? -t : t;
#pragma unroll
                for (int i = 0; i < 8; ++i) acc[i] += t * tab[((m0 + i) * cc) & 127]; }
            float* dst = WSP(float, WS_FT) + ((size_t)l * 512 + part * 256 + g * 64 + m0) * 1024 + k0 + kk;
            gu32* cm = F.ctl + CW_CMAX + l * NP2 + 2560 + part * 256 + g * 64 + m0;
            const float sg = part ? -1.f : 1.f;
#pragma unroll
            for (int i = 0; i < 8; ++i) { const float val = (i == 0 && part == 1 && m0 == 0) ? ny : sg * acc[i]; dst[(size_t)i * 1024] = val;
                float mx = fabsf(val);
#pragma unroll
                for (int o = 1; o < 32; o <<= 1) mx = fmaxf(mx, __shfl_xor(mx, o));
                if (kk == 0) __hip_atomic_fetch_max(cm + i, __builtin_bit_cast(unsigned, mx), RLX_AGENT); }
        }
        __syncthreads();
    }
    {
        LAS float* scr = (LAS float*)(F.lds + RING_OFF + wave * 8704);
        const int gw = F.vcu * NWAVES + wave, NGW = F.G * NWAVES;
        for (int it = gw; it < 1536; it += NGW) {
            const int l = it / 768, r = it - l * 768;
            const int which = r >> 8, rr = r & 255, kb = rr >> 5, nb = rr & 31; const float* src = (which == 0 ? INP(17) : (which == 1 ? INP(18) : INP(19))) + (size_t)l * 512 * 1024;
            transpose_item(src, 1024, kb * 64, nb * 32, WSP(bf16, WS_WPROJ) + (size_t)(l * 3 + which) * 1024 * 512 + (size_t)(nb * 32) * 512, 512, scr, lane);
        }
    }
    for (int it = F.G - 1 - F.vcu; it < 416; it += F.G) {
        const int l = it / 208, r = it - l * 208;
        if (r < 80) slab_quant_1024(F, INP(6) + (size_t)l * 1024 * 3072 + r * 32, 3072, args.ws + WS_WP2 + ((size_t)l * NP2 + r * 32) * 1024, WSP(float, WS_SW) + l * NP2 + r * 32);
        else if (r < 176) slab_quant_1024(F, INP(7) + (size_t)l * 1024 * 3072 + (r - 80) * 32, 3072, args.ws + WS_WP2 + ((size_t)l * NP2 + 3072 + (r - 80) * 32) * 1024, WSP(float, WS_SW) + l * NP2 + 3072 + (r - 80) * 32);
        else slab_quant_1024(F, INP(20) + (size_t)l * 1024 * 1024 + (r - 176) * 32, 1024, args.ws + WS_WOUT + ((size_t)l * 1024 + (r - 176) * 32) * 1024, WSP(float, WS_SWO) + l * 1024 + (r - 176) * 32);
    }
    {
        const int gt = F.vcu * 512 + tid, NGT = F.G * 512;
        bf16* WL = WSP(bf16, WS_WL);
        for (int idx = gt; idx < 262144; idx += NGT) {
            const int k = idx & 63, n = (idx >> 6) & 255, nb = (idx >> 14) & 7, l = idx >> 17, gate = n >> 6, j = n & 63, dir = gate >> 1, isI = gate & 1;
            const float* src = isI ? INP(14) : INP(12);
            WL[idx] = (bf16)f2bf(src[((size_t)((l * 2 + dir) * 8 + nb) * 64 + k) * 64 + j]);
        }
        bf16* FA = WSP(bf16, WS_FA);
        for (int idx = gt; idx < 16384; idx += NGT) {
            const int m = idx >> 7, k = idx & 127, k1 = m & 63, pm_ = m >> 6, t1 = k & 63, pk = k >> 6, a = (k1 * t1) & 63;
            const float c = cospif((float)a * (1.0f / 32.0f)), s = sinpif((float)a * (1.0f / 32.0f));
            FA[idx] = (bf16)f2bf(pm_ == 0 ? (pk == 0 ? c : s) : (pk == 0 ? -s : c));
        }
        bf16* FB = WSP(bf16, WS_FB);
        for (int idx = gt; idx < 32768; idx += NGT) {
            const int k2 = idx >> 8, k = idx & 255, part = k >> 7, t2 = k & 127, a = (k2 * t2) & 127;
            FB[idx] = (bf16)f2bf(part == 0 ? cospif((float)a * (1.0f / 64.0f)) : sinpif((float)a * (1.0f / 64.0f)));
        }
        f32x2* TW = WSP(f32x2, WS_TW);
        for (int idx = gt; idx < 8192; idx += NGT) {
            const int t2 = idx >> 6, k1 = idx & 63; const float x = (float)(t2 * k1) * (1.0f / 4096.0f);
            TW[idx] = (f32x2){cospif(x), sinpif(x)};
        }
    }
}

__device__ __forceinline__ void p1_quantize(const Frame& F0, const Args& args) {
    const Frame F = fresh(F0);
    const int tid = F.tid, lane = F.lane, wave = F.wave;
    LAS float* scr = (LAS float*)(F.lds + RING_OFF + wave * 8704);
    const int gw = F.vcu * NWAVES + wave, NGW = F.G * NWAVES;
    __syncthreads();
    const int gt = F.vcu * 512 + tid, NGT = F.G * 512;
    for (int idx = gt; idx < 2 * 512 * 128; idx += NGT) {
        const int l = idx >> 16, col = (idx >> 7) & 511, kc = idx & 127;
        const float* src = WSP(float, WS_FT) + ((size_t)l * 512 + col) * 1024 + 8 * kc; const f32x4 a = *(const f32x4*)src, b = *(const f32x4*)(src + 4);
        const float cm = fmaxf(__builtin_bit_cast(float, __hip_atomic_load(F.ctl + CW_CMAX + l * NP2 + 2560 + col, RLX_AGENT)), 1e-30f), inv = 127.0f / cm;
        if (kc == 0) WSP(float, WS_SW)[l * NP2 + 2560 + col] = cm * (1.0f / 127.0f);
        *(v2u*)(args.ws + WS_WP2 + ((size_t)l * NP2 + 2560 + col) * 1024 + 8 * kc) = (v2u){pk4_i8(inv * a.x, inv * a.y, inv * a.z, inv * a.w), pk4_i8(inv * b.x, inv * b.y, inv * b.z, inv * b.w)};
    }
    __syncthreads();
}
__device__ __forceinline__ void moe_tilebase(const Frame& F0, const Args& args, int l);
template <int MODE>
__device__ __forceinline__ void rows_phase(const Frame& F0, const Args& args, int l) {
    const Frame F = fresh(F0);
    const int tid = F.tid, lane = F.lane, wave = F.wave;
    const float* MOD = WSP(float, WS_MOD);
    LAS float* gsc = (LAS float*)(F.lds + RING_OFF);
    LAS float* shf = gsc + 4096;
    LAS float* gtf = shf + 4096;
    if (MODE != 0) moe_tilebase(F, args, l - 1);
    { float tg[8], ts[8], tf[8];
#pragma unroll
        for (int i = 0; i < 8; ++i) { const int idx = tid + 512 * i, b = idx >> 10, col = idx & 1023; tg[i] = 0.f; ts[i] = 0.f; tf[i] = 0.f;
            if (MODE != 2) { tg[i] = INP(4)[l * 1024 + col] * (1.0f + MOD[(size_t)(l * 4 + b) * 6144 + 1024 + col]); ts[i] = MOD[(size_t)(l * 4 + b) * 6144 + col]; }
            else tg[i] = INP(26)[col];
            if (MODE != 0) tf[i] = MOD[(size_t)((l - 1) * 4 + b) * 6144 + 5 * 1024 + col]; }
        PIN8(tg); PIN8(ts); PIN8(tf);
#pragma unroll
        for (int i = 0; i < 8; ++i) { const int idx = tid + 512 * i; gsc[idx] = tg[i]; if (MODE != 2) shf[idx] = ts[i]; if (MODE != 0) gtf[idx] = tf[i]; } }
    __syncthreads();
    bf16* U = WSP(bf16, WS_U);
    const bf16* YE = WSP(bf16, WS_PROJ);
    const int* tokes = WSP(int, WS_TOKROW); const float* tokw = WSP(float, WS_TOKW);
    const int gw = F.vcu * NWAVES + wave, NGW = F.G * NWAVES;
    for (int m0 = gw; m0 < NTOK; m0 += 2 * NGW) {
        f32x4 v[2][4]; v2u ya[2][4], yc[2][4]; float w0[2], w1[2];
#pragma unroll
        for (int q = 0; q < 2; ++q) { const int m = m0 + q * NGW;
            if (MODE == 0) { const f32x4* xr = (const f32x4*)(INP(0) + (size_t)m * D) + lane;
#pragma unroll
                for (int j = 0; j < 4; ++j) v[q][j] = __builtin_nontemporal_load(xr + 64 * j); }
            else { const v2u* xr = (const v2u*)XBROW(m) + lane;
#pragma unroll
                for (int j = 0; j < 4; ++j) { const v2u t = __builtin_nontemporal_load(xr + 64 * j); v[q][j] = (f32x4){bflo(t.x), bfhi(t.x), bflo(t.y), bfhi(t.y)}; } }
            if (MODE != 0) { const int es0 = tokes[2 * m], es1 = tokes[2 * m + 1]; const int r0 = 256 * (int)F.MISC[16 + (es0 >> 16)] + (es0 & 0xffff), r1 = 256 * (int)F.MISC[16 + (es1 >> 16)] + (es1 & 0xffff); w0[q] = tokw[2 * m]; w1[q] = tokw[2 * m + 1];
                const v2u* y0 = (const v2u*)(YE + (size_t)r0 * 1024) + lane; const v2u* y1 = (const v2u*)(YE + (size_t)r1 * 1024) + lane;
#pragma unroll
                for (int j = 0; j < 4; ++j) { ya[q][j] = __builtin_nontemporal_load(y0 + 64 * j); yc[q][j] = __builtin_nontemporal_load(y1 + 64 * j); } } }
#pragma unroll
        for (int q = 0; q < 2; ++q) { const int m = m0 + q * NGW, b = m >> 13;
            if (MODE != 0) {
#pragma unroll
                for (int j = 0; j < 4; ++j) { const v2u a = ya[q][j], c = yc[q][j]; const f32x4 g = *(const LAS f32x4*)(gtf + b * 1024 + 4 * lane + 256 * j);
                    v[q][j].x += g.x * (w0[q] * bflo(a.x) + w1[q] * bflo(c.x)); v[q][j].y += g.y * (w0[q] * bfhi(a.x) + w1[q] * bfhi(c.x));
                    v[q][j].z += g.z * (w0[q] * bflo(a.y) + w1[q] * bflo(c.y)); v[q][j].w += g.w * (w0[q] * bfhi(a.y) + w1[q] * bfhi(c.y)); }
            }
            float ss = 0.f;
#pragma unroll
            for (int j = 0; j < 4; ++j) ss += (v[q][j].x * v[q][j].x + v[q][j].y * v[q][j].y) + (v[q][j].z * v[q][j].z + v[q][j].w * v[q][j].w);
            const float rstd = 1.0f / sqrtf(wave_sum(ss) * (1.0f / D) + EPS);
            if (MODE == 2) {
                f32x4* o = (f32x4*)(args.out + (size_t)m * D) + lane;
#pragma unroll
                for (int j = 0; j < 4; ++j) { const f32x4 g = *(const LAS f32x4*)(gsc + 4 * lane + 256 * j); __builtin_nontemporal_store(v[q][j] * rstd * g, o + 64 * j); }
            } else {
                if (MODE == 1) { v2u* o = (v2u*)XBROW(m) + lane;
#pragma unroll
                    for (int j = 0; j < 4; ++j) __builtin_nontemporal_store((v2u){pk2(v[q][j].x, v[q][j].y), pk2(v[q][j].z, v[q][j].w)}, o + 64 * j); }
                f32x4 uu[4]; float am = 0.f;
#pragma unroll
                for (int j = 0; j < 4; ++j) { const f32x4 g = *(const LAS f32x4*)(gsc + b * 1024 + 4 * lane + 256 * j), s = *(const LAS f32x4*)(shf + b * 1024 + 4 * lane + 256 * j);
                    uu[j] = v[q][j] * rstd * g + s; am = fmaxf(am, fmaxf(fmaxf(fabsf(uu[j].x), fabsf(uu[j].y)), fmaxf(fabsf(uu[j].z), fabsf(uu[j].w)))); }
#pragma unroll
                for (int o = 1; o < 64; o <<= 1) am = fmaxf(am, __shfl_xor(am, o));
                am = fmaxf(am, 1e-30f); const float inv = 127.0f / am;
                unsigned* u8o = (unsigned*)(args.ws + WS_U + (size_t)m * D) + lane;
#pragma unroll
                for (int j = 0; j < 4; ++j) u8o[64 * j] = pk4_i8(uu[j].x * inv, uu[j].y * inv, uu[j].z * inv, uu[j].w * inv);
                if (lane == 0) WSP(float, WS_SA)[m] = am * (1.0f / 127.0f);
            }
        }
    }
}

struct EpiP2I {
    bool skip = false;
    static constexpr bool PERM = true; static constexpr bool CHAINS = false; static constexpr bool PREFETCH = true;
    bf16* proj; bf16* vt; bf16* gates; const float* gbias; const LAS unsigned char* stab; const float* sa; const float* sw; LAS float* scl;
    __device__ __forceinline__ void prefetch(const pg8::Unit& u, int wid, int lane) const {
        const float* src = wid < 4 ? sa + (size_t)u.pm * 256 + wid * 64 + lane : sw + u.pn * 256 + (wid - 4) * 64 + lane;
        __builtin_amdgcn_global_load_lds((const unsigned*)src, (LAS unsigned*)(scl + (u.ui & 1) * 768 + wid * 64), 4, 0, 0);
        if (wid < 4) __builtin_amdgcn_global_load_lds((const unsigned*)(gbias + (u.pn >= 12 ? u.pn - 12 : 0) * 256 + wid * 64 + lane), (LAS unsigned*)(scl + (u.ui & 1) * 768 + 512 + wid * 64), 4, 0, 0);
    }
    __device__ __forceinline__ void operator()(const f32x4 (&acc)[2][2][4][2], const pg8::Unit& u, int wr, int wc, int fr, int fq) const {
        int fr_ = fr, fq_ = fq; asm volatile("" : "+v"(fr_), "+v"(fq_));
        const int pn = u.pn, row0 = u.pm * 256 + wr * 64 + fr_, c16 = pn * 256 + wc * 32 + 8 * fq_;
        const float cmul = pn < 2 ? 0.125f : (pn >= 12 ? 64.0f : 1.0f);
        f32x4 cs[2][2]; float rs[2][4]; const LAS float* sl = scl + (u.ui & 1) * 768;
#pragma unroll
        for (int bj = 0; bj < 2; ++bj)
#pragma unroll
            for (int n = 0; n < 2; ++n) cs[bj][n] = *(const LAS f32x4*)(sl + 256 + wc * 32 + 8 * fq_ + bj * 128 + 4 * n) * cmul;
#pragma unroll
        for (int ai = 0; ai < 2; ++ai)
#pragma unroll
            for (int m = 0; m < 4; ++m) rs[ai][m] = sl[wr * 64 + fr_ + ai * 128 + m * 16];
#define P2V(ai, bj, m, n, e) ((float)__float_as_int(acc[ai][bj][m][n][e]) * (rs[ai][m] * cs[bj][n][e]))
        if (pn == 4 || pn == 5) {
#pragma unroll
            for (int ai = 0; ai < 2; ++ai)
#pragma unroll
                for (int m = 0; m < 4; ++m) { const int row = row0 + ai * 128 + m * 16, b = row >> 13, t = row & 8191;
#pragma unroll
                    for (int bj = 0; bj < 2; ++bj)
#pragma unroll
                        for (int n = 0; n < 2; ++n) { const int col = (pn - 4) * 256 + bj * 128 + wc * 32 + 8 * fq_ + 4 * n; bf16* d = vt + ((size_t)(b * 512 + col)) * 8192 + t;
                            d[0] = (bf16)f2bf(P2V(ai, bj, m, n, 0)); d[8192] = (bf16)f2bf(P2V(ai, bj, m, n, 1)); d[2 * 8192] = (bf16)f2bf(P2V(ai, bj, m, n, 2)); d[3 * 8192] = (bf16)f2bf(P2V(ai, bj, m, n, 3)); } }
        } else if (pn < 12) {
            const int cbase = (pn < 4 ? pn * 256 : (pn - 2) * 256) + wc * 32 + 8 * fq_;
#pragma unroll
            for (int ai = 0; ai < 2; ++ai)
#pragma unroll
                for (int m = 0; m < 4; ++m) { bf16* rowp = proj + (size_t)(row0 + ai * 128 + m * 16) * PROJ_LD + cbase;
#pragma unroll
                    for (int bj = 0; bj < 2; ++bj)
                        *(v4u*)(rowp + bj * 128) = (v4u){pk2(P2V(ai, bj, m, 0, 0), P2V(ai, bj, m, 0, 1)), pk2(P2V(ai, bj, m, 0, 2), P2V(ai, bj, m, 0, 3)), pk2(P2V(ai, bj, m, 1, 0), P2V(ai, bj, m, 1, 1)), pk2(P2V(ai, bj, m, 1, 2), P2V(ai, bj, m, 1, 3))}; }
        } else {
            const int gc = c16 - 3072;
            f32x4 bv[2][2];
#pragma unroll
            for (int bj = 0; bj < 2; ++bj)
#pragma unroll
                for (int n = 0; n < 2; ++n) bv[bj][n] = (*(const LAS f32x4*)(sl + 512 + wc * 32 + 8 * fq_ + bj * 128 + 4 * n) + 8.0f) * 64.0f;
            const unsigned to8 = (unsigned)(((wr * 4 + wc) * 64 + fq_ * 16 + fr_) * 8);
            unsigned char* blob = (unsigned char*)gates + (size_t)(u.pm * 12 + (pn - 12)) * 65536 + to8;
#pragma unroll
            for (int ai = 0; ai < 2; ++ai)
#pragma unroll
                for (int m = 0; m < 4; ++m)
#pragma unroll
                    for (int bj = 0; bj < 2; ++bj) {
                        unsigned c0[4], c1[4];
#pragma unroll
                        for (int e = 0; e < 4; ++e) {
                            const unsigned i0 = (unsigned)__builtin_amdgcn_fmed3f(P2V(ai, bj, m, 0, e) + bv[bj][0][e], 0.0f, 1023.0f), i1 = (unsigned)__builtin_amdgcn_fmed3f(P2V(ai, bj, m, 1, e) + bv[bj][1][e], 0.0f, 1023.0f);
                            c0[e] = stab[i0]; c1[e] = stab[i1]; }
                        __builtin_nontemporal_store((v2u){c0[0] | (c0[1] << 8) | (c0[2] << 16) | (c0[3] << 24), c1[0] | (c1[1] << 8) | (c1[2] << 16) | (c1[3] << 24)}, (v2u*)(blob + ((ai * 4 + m) * 2 + bj) * 4096)); }
        }
#undef P2V
    }
};
struct EpiMerge {
    bool skip = false;
    static constexpr bool PERM = true; static constexpr bool CHAINS = true; static constexpr bool PREFETCH = false;
    const bf16* gates; unsigned char* merged8; const LAS float* rtab; LAS float* pmx; gu32* rm; gu32* tc;
    __device__ __forceinline__ bool is_final(const pg8::Unit& u) const { return u.z == 2; }
    __device__ __forceinline__ void rescale(f32x4 (&acc)[2][2][4][2], const pg8::Unit& u, int wr, int wc, int fr, int fq) const {
        const int tid = (wr * 4 + wc) * 64 + fq * 16 + fr; const bool fin = u.z == 2;
        const char* gb0 = (const char*)gates + (size_t)(u.pm * 12 + u.z * 4 + u.pn) * 65536 + tid * 8; const char* gb1 = gb0 + 4 * 65536;
        v2u ga[2][4], gn[2][4];
#pragma unroll
        for (int p = 0; p < 4; ++p) { ga[0][p] = *(const v2u*)(gb0 + p * 4096); gn[0][p] = *(const v2u*)(gb1 + p * 4096); }
#pragma unroll
        for (int hb4 = 0; hb4 < 4; ++hb4) {
            if (hb4 < 3) { unsigned pcb = (hb4 + 1) * 4 * 4096; asm volatile("" : "+v"(pcb));
#pragma unroll
                for (int p = 0; p < 4; ++p) { ga[(hb4 + 1) & 1][p] = *(const v2u*)(gb0 + pcb + p * 4096); gn[(hb4 + 1) & 1][p] = *(const v2u*)(gb1 + pcb + p * 4096); } }
#pragma unroll
            for (int p = 0; p < 4; ++p) { const int pi = hb4 * 4 + p, ai = pi >> 3, m = (pi >> 1) & 3, bj = pi & 1;
#pragma unroll
                for (int n = 0; n < 2; ++n) { const unsigned wa = n ? ga[hb4 & 1][p].y : ga[hb4 & 1][p].x, wn = fin ? 0xffffffffu : (n ? gn[hb4 & 1][p].y : gn[hb4 & 1][p].x);
#pragma unroll
                    for (int e = 0; e < 4; ++e) acc[ai][bj][m][n][e] *= (float)((wa >> (8 * e)) & 0xffu) * rtab[(wn >> (8 * e)) & 0xffu]; } }
        }
    }
    __device__ __forceinline__ void operator()(const f32x4 (&acc)[2][2][4][2], const pg8::Unit& u, int wr, int wc, int fr, int fq) const {
        int fr_ = fr, fq_ = fq; asm volatile("" : "+v"(fr_), "+v"(fq_));
        const int rl0 = wr * 64 + fr_, cbase = u.pn * 256 + wc * 32 + 8 * fq_;
#pragma unroll
        for (int ai = 0; ai < 2; ++ai)
#pragma unroll
            for (int m = 0; m < 4; ++m) { float mx = 0.f;
#pragma unroll
                for (int bj = 0; bj < 2; ++bj)
#pragma unroll
                    for (int n = 0; n < 2; ++n) mx = fmaxf(mx, fmaxf(fmaxf(fabsf(acc[ai][bj][m][n][0]), fabsf(acc[ai][bj][m][n][1])), fmaxf(fabsf(acc[ai][bj][m][n][2]), fabsf(acc[ai][bj][m][n][3]))));
                mx = fmaxf(mx, __shfl_xor(mx, 16)); mx = fmaxf(mx, __shfl_xor(mx, 32));
                if (fq_ == 0) pmx[(rl0 + ai * 128 + m * 16) * 4 + wc] = mx; }
        LDS_WAIT(); __builtin_amdgcn_s_barrier(); asm volatile("" ::: "memory");
        gu32* rmt = rm + (size_t)u.pm * 256;
        if (wc == 0 && fq_ == 0) {
#pragma unroll
            for (int ai = 0; ai < 2; ++ai)
#pragma unroll
                for (int m = 0; m < 4; ++m) { const int rl = rl0 + ai * 128 + m * 16; const f32x4 p4 = *(const LAS f32x4*)(pmx + rl * 4);
                    __hip_atomic_fetch_max(rmt + rl, __float_as_uint(fmaxf(fmaxf(p4.x, p4.y), fmaxf(p4.z, p4.w))), RLX_AGENT); } }
        asm volatile("s_waitcnt vmcnt(0)" ::: "memory"); __builtin_amdgcn_s_barrier();
        if (wr == 0 && wc == 0 && fr_ == 0 && fq_ == 0) { gu32* c = tc + u.pm; __hip_atomic_fetch_add(c, 1u, RLX_AGENT);
            for (unsigned sp = 0; __hip_atomic_load(c, RLX_AGENT) < 4u && sp < (1u << 22); ++sp) __builtin_amdgcn_s_sleep(2); }
        __builtin_amdgcn_s_barrier(); asm volatile("" ::: "memory");
#pragma unroll
        for (int ai = 0; ai < 2; ++ai)
#pragma unroll
            for (int m = 0; m < 4; ++m) { const int rl = rl0 + ai * 128 + m * 16; const float mx = fmaxf(__uint_as_float(__hip_atomic_load(rmt + rl, RLX_AGENT)), 1e-30f), inv = 127.0f / mx;
                const size_t row = (size_t)u.pm * 256 + rl;
#pragma unroll
                for (int bj = 0; bj < 2; ++bj) { const f32x4 v0 = acc[ai][bj][m][0] * inv, v1 = acc[ai][bj][m][1] * inv;
                    *(v2u*)(merged8 + row * 1024 + cbase + bj * 128) = (v2u){pk4_i8(v0[0], v0[1], v0[2], v0[3]), pk4_i8(v1[0], v1[1], v1[2], v1[3])}; } }
    }
};
template <bool F32IN>
struct EpiResid {
    bool skip = false;
    static constexpr bool PERM = true; static constexpr bool CHAINS = false; static constexpr bool PREFETCH = false;
    const float* xin32; bf16* xb0; bf16* xb1; const float* gt; const gu32* rm; const float* swo;
    __device__ __forceinline__ void operator()(const f32x4 (&acc)[2][2][4][2], const pg8::Unit& u, int wr, int wc, int fr, int fq) const {
        const int rt = u.pm * 256, row0 = rt + wr * 64 + fr, cbase = u.pn * 256 + wc * 32 + 8 * fq, b = rt >> 13;
        bf16* xb = (rt < XB_SPLIT) ? xb0 + (size_t)row0 * 1024 : xb1 + (size_t)(row0 - XB_SPLIT) * 1024;
        const float* xf = xin32 + (size_t)row0 * 1024;
        f32x4 gv[2][2];
#pragma unroll
        for (int bj = 0; bj < 2; ++bj)
#pragma unroll
            for (int n = 0; n < 2; ++n) gv[bj][n] = *(const f32x4*)(gt + (size_t)b * 6144 + cbase + bj * 128 + 4 * n) * *(const f32x4*)(swo + cbase + bj * 128 + 4 * n);
        float rsv[2][4];
#pragma unroll
        for (int ai = 0; ai < 2; ++ai)
#pragma unroll
            for (int m = 0; m < 4; ++m) rsv[ai][m] = __uint_as_float(rm[row0 + ai * 128 + m * 16]) * (1.0f / 127.0f);
        f32x4 xa[F32IN ? 1 : 2][4], xc[F32IN ? 1 : 2][4]; v4u tb[2][4];
#define RES_LOAD(buf, hb) do { unsigned rob_ = (unsigned)(((hb) >> 1) * 128 + ((hb) & 1) * 32) * 1024u + (unsigned)cbase; asm volatile("" : "+v"(rob_)); \
            _Pragma("unroll") for (int p = 0; p < 4; ++p) { const unsigned ro = rob_ + (unsigned)((p >> 1) * 16 * 1024 + (p & 1) * 128); \
                if (F32IN) { xa[buf][p] = __builtin_nontemporal_load((const f32x4*)(xf + ro)); xc[buf][p] = __builtin_nontemporal_load((const f32x4*)(xf + ro + 4)); } else tb[buf][p] = __builtin_nontemporal_load((const v4u*)(xb + ro)); } } while (0)
        if (!F32IN) RES_LOAD(0, 0);
#pragma unroll
        for (int hb4 = 0; hb4 < 4; ++hb4) {
            if (F32IN) RES_LOAD(0, hb4); else if (hb4 < 3) RES_LOAD((hb4 + 1) & 1, hb4 + 1);
            unsigned rob = (unsigned)((hb4 >> 1) * 128 + (hb4 & 1) * 32) * 1024u + (unsigned)cbase; asm volatile("" : "+v"(rob));
#pragma unroll
            for (int p = 0; p < 4; ++p) { const int ai = hb4 >> 1, m = (hb4 & 1) * 2 + (p >> 1), bj = p & 1; const unsigned ro = rob + (unsigned)((p >> 1) * 16 * 1024 + (p & 1) * 128);
                f32x4 x0, x1;
                if (F32IN) { x0 = xa[0][p]; x1 = xc[0][p]; }
                else { const v4u t = tb[hb4 & 1][p]; x0 = (f32x4){bflo(t.x), bfhi(t.x), bflo(t.y), bfhi(t.y)}; x1 = (f32x4){bflo(t.z), bfhi(t.z), bflo(t.w), bfhi(t.w)}; }
                const float rs = rsv[ai][m];
                const f32x4 a0 = (f32x4){(float)__float_as_int(acc[ai][bj][m][0][0]), (float)__float_as_int(acc[ai][bj][m][0][1]), (float)__float_as_int(acc[ai][bj][m][0][2]), (float)__float_as_int(acc[ai][bj][m][0][3])} * rs;
                const f32x4 a1 = (f32x4){(float)__float_as_int(acc[ai][bj][m][1][0]), (float)__float_as_int(acc[ai][bj][m][1][1]), (float)__float_as_int(acc[ai][bj][m][1][2]), (float)__float_as_int(acc[ai][bj][m][1][3])} * rs;
                const f32x4 y0 = x0 + gv[bj][0] * a0, y1 = x1 + gv[bj][1] * a1;
                *(v4u*)(xb + ro) = (v4u){pk2(y0[0], y0[1]), pk2(y0[2], y0[3]), pk2(y1[0], y1[1]), pk2(y1[2], y1[3])}; }
        }
#undef RES_LOAD
    }
};
struct EpiSwiGLU {
    bool skip = false;
    static constexpr bool PERM = true; static constexpr bool CHAINS = false; static constexpr bool PREFETCH = true;
    bf16* H; const LAS float* sg; const LAS float* rsc; const float* swe; LAS float* scl;
    __device__ __forceinline__ void prefetch(const pg8::Unit& u, int wid, int lane) const {
        if (wid < 4) __builtin_amdgcn_global_load_lds((const unsigned*)(swe + (size_t)(u.bt >> 2) * 1024 + u.pn * 256 + wid * 64 + lane), (LAS unsigned*)(scl + (u.ui & 1) * 256 + wid * 64), 4, 0, 0);
    }
    __device__ __forceinline__ void operator()(const f32x4 (&acc)[2][2][4][2], const pg8::Unit& u, int wr, int wc, int fr, int fq) const {
        int fr_ = fr, fq_ = fq; asm volatile("" : "+v"(fr_), "+v"(fq_));
        const int row0 = u.pm * 256 + wr * 64 + fr_, cbase = u.pn * 128 + wc * 32 + 8 * fq_;
        const LAS float* sp = scl + (u.ui & 1) * 256 + wc * 32 + 8 * fq_;
        const f32x4 cg0 = *(const LAS f32x4*)sp, cg1 = *(const LAS f32x4*)(sp + 4), cu0 = *(const LAS f32x4*)(sp + 128), cu1 = *(const LAS f32x4*)(sp + 132);
#pragma unroll
        for (int ai = 0; ai < 2; ++ai)
#pragma unroll
            for (int m = 0; m < 4; ++m) { f32x4 h0, h1; const float rs = rsc[u.ui * 256 + wr * 64 + fr_ + ai * 128 + m * 16];
#pragma unroll
                for (int e = 0; e < 4; ++e) {
                    const float g0 = (float)__float_as_int(acc[ai][0][m][0][e]) * (rs * cg0[e]), g1 = (float)__float_as_int(acc[ai][0][m][1][e]) * (rs * cg1[e]);
                    const float u0 = (float)__float_as_int(acc[ai][1][m][0][e]) * (rs * cu0[e]), u1 = (float)__float_as_int(acc[ai][1][m][1][e]) * (rs * cu1[e]);
                    h0[e] = g0 * sg[(unsigned)__builtin_amdgcn_fmed3f(__builtin_fmaf(g0, 64.0f, 1024.0f), 0.0f, 2047.0f)] * u0; h1[e] = g1 * sg[(unsigned)__builtin_amdgcn_fmed3f(__builtin_fmaf(g1, 64.0f, 1024.0f), 0.0f, 2047.0f)] * u1; }
                *(v4u*)(H + (size_t)(row0 + ai * 128 + m * 16) * 512 + cbase) = (v4u){pk2(h0[0], h0[1]), pk2(h0[2], h0[3]), pk2(h1[0], h1[1]), pk2(h1[2], h1[3])}; }
    }
};
struct EpiYE {
    bool skip = false;
    static constexpr bool PERM = true; static constexpr bool CHAINS = false; static constexpr bool PREFETCH = false;
    bf16* YE;
    __device__ __forceinline__ void operator()(const f32x4 (&acc)[2][2][4][2], const pg8::Unit& u, int wr, int wc, int fr, int fq) const {
        const int row0 = u.pm * 256 + wr * 64 + fr, cbase = u.pn * 256 + wc * 32 + 8 * fq;
#pragma unroll
        for (int ai = 0; ai < 2; ++ai)
#pragma unroll
            for (int m = 0; m < 4; ++m) { bf16* rowp = YE + (size_t)(row0 + ai * 128 + m * 16) * 1024 + cbase;
#pragma unroll
                for (int bj = 0; bj < 2; ++bj) { const f32x4 v0 = acc[ai][bj][m][0], v1 = acc[ai][bj][m][1];
                    *(v4u*)(rowp + bj * 128) = (v4u){pk2(v0[0], v0[1]), pk2(v0[2], v0[3]), pk2(v1[0], v1[1]), pk2(v1[2], v1[3])}; } }
    }
};

__device__ __forceinline__ void attn_unit(bf16* PROJ, const bf16* VT, const LAS float* rpb, int b, int h, int r, int qb, int lane, bf16* obase, int opitch) {
    const int qn = lane & 15, g = lane >> 4;
    const int rs = min(max(r - 4, 0), 120);
    const int cb = (qb == 0) ? 0 : ((qb == 1) ? 8 : ((qb == 2) ? 24 : 32));
    const int w = 16 * qb + qn, cs = min(max(w - 8, 0), 48);
    const size_t tokq = (size_t)b * T + r * 64 + w;
    bf16* qp = PROJ + tokq * PROJ_LD + Q_OFF + h * 64;
    bf16x8 qf0 = *(const bf16x8*)(qp + 8 * g), qf1 = *(const bf16x8*)(qp + 32 + 8 * g);
    const bf16* kbase = PROJ + ((size_t)b * T + rs * 64 + cb + qn) * PROJ_LD + K_OFF + h * 64 + 8 * g;
    f32x4 sc[16];
#pragma unroll
    for (int kt = 0; kt < 16; ++kt) {
        const int kr = kt >> 1, ch = kt & 1;
        const bf16* kp = kbase + (size_t)(kr * 64 + 16 * ch) * PROJ_LD;
        const bf16x8 kf0 = *(const bf16x8*)kp, kf1 = *(const bf16x8*)(kp + 32);
        f32x4 a = (f32x4){0.f, 0.f, 0.f, 0.f};
        a = __builtin_amdgcn_mfma_f32_16x16x32_bf16(kf0, qf0, a, 0, 0, 0);
        a = __builtin_amdgcn_mfma_f32_16x16x32_bf16(kf1, qf1, a, 0, 0, 0);
        sc[kt] = a;
    }
    const LAS float* rp = rpb + h * 465;
    float mx = -1e30f;
#pragma unroll
    for (int kt = 0; kt < 16; ++kt) {
        const int kr = kt >> 1, ch = kt & 1;
        const int brow = (rs + kr - r + 7) * 31;
#pragma unroll
        for (int j = 0; j < 4; ++j) {
            const int kc = cb + 16 * ch + 4 * g + j, dc = kc - w + 15;
            const bool ok = (kc >= cs) && (kc <= cs + 15);
            const float bias = rp[brow + (ok ? dc : 15)];
            const float s = ok ? sc[kt][j] + bias : -1e30f;
            sc[kt][j] = s; mx = fmaxf(mx, s);
        }
    }
    mx = fmaxf(mx, __shfl_xor(mx, 16)); mx = fmaxf(mx, __shfl_xor(mx, 32));
    float sum = 0.f;
#pragma unroll
    for (int kt = 0; kt < 16; ++kt)
#pragma unroll
        for (int j = 0; j < 4; ++j) { const float p = __expf(sc[kt][j] - mx); sc[kt][j] = p; sum += p; }
    sum += __shfl_xor(sum, 16); sum += __shfl_xor(sum, 32);
    const float inv = 1.0f / sum;
    f32x4 o[4];
#pragma unroll
    for (int dt = 0; dt < 4; ++dt) o[dt] = (f32x4){0.f, 0.f, 0.f, 0.f};
    const bf16* vbase = VT + ((size_t)(b * 512 + h * 64 + qn)) * T + rs * 64 + cb + 4 * g;
#pragma unroll
    for (int kr = 0; kr < 8; ++kr) {
        v4u pw; pw.x = pk2(sc[2 * kr][0], sc[2 * kr][1]); pw.y = pk2(sc[2 * kr][2], sc[2 * kr][3]); pw.z = pk2(sc[2 * kr + 1][0], sc[2 * kr + 1][1]); pw.w = pk2(sc[2 * kr + 1][2], sc[2 * kr + 1][3]);
        const bf16x8 pf = __builtin_bit_cast(bf16x8, pw);
#pragma unroll
        for (int dt = 0; dt < 4; ++dt) {
            const bf16* vp = vbase + (size_t)(16 * dt) * T + kr * 64;
            const v2u lo = *(const v2u*)vp, hi = *(const v2u*)(vp + 16);
            const v4u vw = (v4u){lo.x, lo.y, hi.x, hi.y};
            o[dt] = __builtin_amdgcn_mfma_f32_16x16x32_bf16(__builtin_bit_cast(bf16x8, vw), pf, o[dt], 0, 0, 0);
        }
    }
    bf16* op = obase + tokq * opitch + h * 64;
#pragma unroll
    for (int dt = 0; dt < 4; ++dt) *(v2u*)(op + 16 * dt + 4 * g) = (v2u){pk2(o[dt][0] * inv, o[dt][1] * inv), pk2(o[dt][2] * inv, o[dt][3] * inv)};
}
__device__ __forceinline__ void attn_phase(const Frame& F0, const Args& args, int l, bf16* obase, int opitch) {
    const Frame F = fresh(F0);
    LAS float* rpb = (LAS float*)(F.lds + RING_OFF);
    for (int i = F.tid; i < 8 * 465; i += 512) rpb[i] = INP(9)[l * 8 * 465 + i];
    __syncthreads();
    bf16* PROJ = WSP(bf16, WS_PROJ); const bf16* VT = WSP(bf16, WS_VT);
    for (int wu = F.vcu * NWAVES + F.wave; wu < 16384; wu += F.G * NWAVES) {
        const int bh = wu >> 9, rem = wu & 511;
        attn_unit(PROJ, VT, rpb, bh >> 3, bh & 7, rem >> 2, rem & 3, F.lane, obase, opitch);
    }
    __syncthreads();
}

__device__ __forceinline__ float gelu_tanh(float x) { const float u = 0.7978845608028654f * (x + 0.044715f * x * x * x); const float t = 1.0f - 2.0f * __builtin_amdgcn_rcpf(1.0f + __expf(2.0f * u)); return 0.5f * x * (1.0f + t); }
__device__ __forceinline__ void fft_a_phase(const Frame& F0, const Args& args) {
    const Frame F = fresh(F0);
    const int lane = F.lane, nl = lane & 31, hh = lane >> 5;
    const bf16* PROJ = WSP(bf16, WS_PROJ); const bf16* FA = WSP(bf16, WS_FA); const f32x2* TW = WSP(f32x2, WS_TW); bf16* ZP = WSP(bf16, WS_U);
    for (int wu = F.vcu * NWAVES + F.wave; wu < 8192; wu += F.G * NWAVES) {
        const int ct = wu & 15, t2 = (wu >> 4) & 127, b = wu >> 11;
        bf16x8 bf[8];
#pragma unroll
        for (int s = 0; s < 8; ++s) { const int part = s >> 2, t1b = 16 * (s & 3) + 8 * hh;
            const bf16* p = PROJ + ((size_t)b * T + (size_t)128 * t1b + t2) * PROJ_LD + G_OFF + part * 512 + 32 * ct + nl;
            unsigned short e[8];
#pragma unroll
            for (int j = 0; j < 8; ++j) e[j] = p[(size_t)j * 128 * PROJ_LD];
            v4u w; w.x = e[0] | ((unsigned)e[1] << 16); w.y = e[2] | ((unsigned)e[3] << 16); w.z = e[4] | ((unsigned)e[5] << 16); w.w = e[6] | ((unsigned)e[7] << 16);
            bf[s] = __builtin_bit_cast(bf16x8, w); }
        f32x16 acc[4];
#pragma unroll
        for (int mt = 0; mt < 4; ++mt) { acc[mt] = (f32x16){};
#pragma unroll
            for (int s = 0; s < 8; ++s) { const bf16x8 af = *(const bf16x8*)(FA + (32 * mt + nl) * 128 + 16 * s + 8 * hh); acc[mt] = __builtin_amdgcn_mfma_f32_32x32x16_bf16(af, bf[s], acc[mt], 0, 0, 0); } }
#pragma unroll
        for (int mt = 0; mt < 2; ++mt)
#pragma unroll
            for (int rg = 0; rg < 16; ++rg) { const int k1 = 32 * mt + (rg & 3) + 8 * (rg >> 2) + 4 * hh; const f32x2 cs = TW[t2 * 64 + k1];
                const float zr = acc[mt][rg], zi = acc[mt + 2][rg];
                bf16* d = ZP + ((size_t)(b * 64 + k1) * 128 + t2) * 1024 + 32 * ct + nl;
                d[0] = (bf16)f2bf(zr * cs.x + zi * cs.y); d[512] = (bf16)f2bf(zi * cs.x - zr * cs.y); }
    }
}
__device__ __forceinline__ void fft_b_phase(const Frame& F0, const Args& args) {
    const Frame F = fresh(F0);
    const int lane = F.lane, nl = lane & 31, hh = lane >> 5;
    bf16* PROJ = WSP(bf16, WS_PROJ); const bf16* FB = WSP(bf16, WS_FB); const bf16* ZP = WSP(bf16, WS_U);
    for (int wu = F.vcu * NWAVES + F.wave; wu < 4096; wu += F.G * NWAVES) {
        const int ct = wu & 15, k1 = (wu >> 4) & 63, b = wu >> 10;
        f32x16 acc[4];
#pragma unroll
        for (int mt = 0; mt < 4; ++mt) acc[mt] = (f32x16){};
#pragma unroll 1
        for (int sc = 0; sc < 4; ++sc) {
            bf16x8 bf[4];
#pragma unroll
            for (int q = 0; q < 4; ++q) { const int s = 4 * sc + q, part = s >> 3, t2b = 16 * (s & 7) + 8 * hh;
                const bf16* p = ZP + ((size_t)(b * 64 + k1) * 128 + t2b) * 1024 + part * 512 + 32 * ct + nl;
                unsigned short e[8];
#pragma unroll
                for (int j = 0; j < 8; ++j) e[j] = p[(size_t)j * 1024];
                v4u w; w.x = e[0] | ((unsigned)e[1] << 16); w.y = e[2] | ((unsigned)e[3] << 16); w.z = e[4] | ((unsigned)e[5] << 16); w.w = e[6] | ((unsigned)e[7] << 16);
                bf[q] = __builtin_bit_cast(bf16x8, w); }
#pragma unroll
            for (int mt = 0; mt < 4; ++mt)
#pragma unroll
                for (int q = 0; q < 4; ++q) { const bf16x8 af = *(const bf16x8*)(FB + (32 * mt + nl) * 256 + 16 * (4 * sc + q) + 8 * hh); acc[mt] = __builtin_amdgcn_mfma_f32_32x32x16_bf16(af, bf[q], acc[mt], 0, 0, 0); }
        }
#pragma unroll
        for (int mt = 0; mt < 4; ++mt)
#pragma unroll
            for (int rg = 0; rg < 16; ++rg) { const int k2 = 32 * mt + (rg & 3) + 8 * (rg >> 2) + 4 * hh;
                PROJ[((size_t)b * T + k1 + 64 * k2) * PROJ_LD + G_OFF + 32 * ct + nl] = (bf16)f2bf(acc[mt][rg] * (1.0f / 1024.0f)); }
    }
}

__device__ __forceinline__ void router_phase(const Frame& F0, const Args& args, int l, int cset) {
    const Frame F = fresh(F0);
    const int tid = F.tid, lane = F.lane, wave = F.wave;
    const float* MOD = WSP(float, WS_MOD);
    LAS unsigned char* WB = F.lds + RING_OFF;
    constexpr int RPITCH = 2064;
    LAS float* gsc = (LAS float*)(F.lds + RING_OFF + 64 * RPITCH);
    LAS float* shf = gsc + 1024;
    LAS float* c0 = shf + 1024;
    LAS float* rb = c0 + 32;
    LAS unsigned* lcnt = (LAS unsigned*)(rb + 32);
    LAS unsigned* lbase = lcnt + 32;
    LAS float* red = (LAS float*)(lbase + 32);
    bf16* U2 = WSP(bf16, WS_U);
    float* tokw = WSP(float, WS_TOKW); int* perm = WSP(int, WS_PERM); int* tokes = WSP(int, WS_TOKROW);
    unsigned* ecnt = (unsigned*)(F.ctl + CW_ECNT + cset * 32 * 64);
    const int nround = (2048 + F.G * NWAVES - 1) / (F.G * NWAVES);
    int cur_b = -1;
    for (int rd = 0; rd < nround; ++rd) {
        const int unit = (rd * F.G + F.vcu) * NWAVES + wave;
        const int ub = (((rd * F.G + F.vcu) * NWAVES) * 16) >> 13;
        const bool wg_active = ((rd * F.G + F.vcu) * NWAVES) < 2048;
        if (wg_active && ub != cur_b) {
            cur_b = ub; __syncthreads();
            for (int i = 0; i < 2; ++i) { const int col = tid + 512 * i; gsc[col] = INP(5)[l * 1024 + col] * (1.0f + MOD[(size_t)(l * 4 + ub) * 6144 + 4 * 1024 + col]); shf[col] = MOD[(size_t)(l * 4 + ub) * 6144 + 3 * 1024 + col]; }
            if (tid < 32) rb[tid] = INP(22)[tid];
            __syncthreads();
            { f32x4 wa[8], wb[8];
#pragma unroll
                for (int i = 0; i < 8; ++i) { const int it = tid + 512 * i, kp = it >> 3, e4 = it & 7; wa[i] = *(const f32x4*)(INP(21) + (2 * kp) * 32 + 4 * e4); wb[i] = *(const f32x4*)(INP(21) + (2 * kp + 1) * 32 + 4 * e4); }
                PIN8(wa); PIN8(wb);
#pragma unroll
                for (int i = 0; i < 8; ++i) { const int it = tid + 512 * i, kp = it >> 3, e4 = it & 7; const float g0 = gsc[2 * kp], g1 = gsc[2 * kp + 1];
#pragma unroll
                    for (int j = 0; j < 4; ++j) { const float p0 = g0 * wa[i][j], p1 = g1 * wb[i][j]; const unsigned h1 = pk2(p0, p1), h2 = pk2(p0 - bflo(h1), p1 - bfhi(h1));
                        LAS unsigned char* d = WB + (4 * e4 + j) * RPITCH + 4 * kp; *(LAS unsigned*)d = h1; *(LAS unsigned*)(d + 32 * RPITCH) = h2; } } }
            { const int e = tid & 31, pt = tid >> 5; float s = 0.f;
#pragma unroll 1
                for (int q4 = 0; q4 < 4; ++q4) { float wv[16];
#pragma unroll
                    for (int kk = 0; kk < 16; ++kk) wv[kk] = INP(21)[(pt * 64 + q4 * 16 + kk) * 32 + e];
#pragma unroll
                    for (int kk = 0; kk < 16; ++kk) s += shf[pt * 64 + q4 * 16 + kk] * wv[kk]; }
                red[tid] = s; }
            __syncthreads();
            if (tid < 32) { float s = 0.f; for (int p = 0; p < 16; ++p) s += red[p * 32 + tid]; c0[tid] = s; }
        }
        if (tid < 32) lcnt[tid] = 0u;
        __syncthreads();
        int e0 = 0, e1 = 0; unsigned rk0 = 0, rk1 = 0; float w0 = 0.f, w1 = 0.f; bool owner = false; int mytok = 0;
        if (unit < 2048) {
            const int tok0 = unit * 16;
            float rs_reg = 0.f;
#pragma unroll 1
            for (int i4 = 0; i4 < 16; i4 += 4) {
                f32x4 v[4][4];
#pragma unroll
                for (int q = 0; q < 4; ++q) { const v2u* xr = (const v2u*)XBROW(tok0 + i4 + q) + lane;
#pragma unroll
                    for (int j = 0; j < 4; ++j) { const v2u t = xr[64 * j]; v[q][j] = (f32x4){bflo(t.x), bfhi(t.x), bflo(t.y), bfhi(t.y)}; } }
#pragma unroll
                for (int q = 0; q < 4; ++q) { const int m = tok0 + i4 + q; float ss = 0.f;
#pragma unroll
                    for (int j = 0; j < 4; ++j) ss += (v[q][j].x * v[q][j].x + v[q][j].y * v[q][j].y) + (v[q][j].z * v[q][j].z + v[q][j].w * v[q][j].w);
                    const float rstd = 1.0f / sqrtf(wave_sum(ss) * (1.0f / D) + EPS);
                    if ((lane & 15) == i4 + q) rs_reg = rstd;
                    f32x4 uu[4]; float am = 0.f;
#pragma unroll
                    for (int j = 0; j < 4; ++j) { const f32x4 g = *(const LAS f32x4*)(gsc + 4 * lane + 256 * j), s = *(const LAS f32x4*)(shf + 4 * lane + 256 * j);
                        uu[j] = v[q][j] * rstd * g + s; am = fmaxf(am, fmaxf(fmaxf(fabsf(uu[j].x), fabsf(uu[j].y)), fmaxf(fabsf(uu[j].z), fabsf(uu[j].w)))); }
#pragma unroll
                    for (int o = 1; o < 64; o <<= 1) am = fmaxf(am, __shfl_xor(am, o));
                    am = fmaxf(am, 1e-30f); const float inv = 127.0f / am;
                    unsigned* uo = (unsigned*)(args.ws + WS_U + (size_t)m * D) + lane;
#pragma unroll
                    for (int j = 0; j < 4; ++j) uo[64 * j] = pk4_i8(uu[j].x * inv, uu[j].y * inv, uu[j].z * inv, uu[j].w * inv);
                    if (lane == 0) WSP(float, WS_SA)[m] = am * (1.0f / 127.0f); }
            }
            const int ti = lane & 15, kq = lane >> 4;
            const v4u* xrow = (const v4u*)(XBROW(tok0 + ti) + 256 * kq);
            const LAS unsigned char* wp = WB + ti * RPITCH + 512 * kq;
            f32x4 a0 = {0.f, 0.f, 0.f, 0.f}, a1 = {0.f, 0.f, 0.f, 0.f};
            v4u xall[32];
#pragma unroll
            for (int q = 0; q < 32; ++q) xall[q] = xrow[q];
#pragma unroll
            for (int q = 0; q < 32; ++q) { const bf16x8 bx = __builtin_bit_cast(bf16x8, xall[q]);
                const bf16x8 w00 = *(const LAS bf16x8*)(wp + 16 * q), w01 = *(const LAS bf16x8*)(wp + 16 * RPITCH + 16 * q), w10 = *(const LAS bf16x8*)(wp + 32 * RPITCH + 16 * q), w11 = *(const LAS bf16x8*)(wp + 48 * RPITCH + 16 * q);
                a0 = __builtin_amdgcn_mfma_f32_16x16x32_bf16(w00, bx, a0, 0, 0, 0); a1 = __builtin_amdgcn_mfma_f32_16x16x32_bf16(w01, bx, a1, 0, 0, 0);
                a0 = __builtin_amdgcn_mfma_f32_16x16x32_bf16(w10, bx, a0, 0, 0, 0); a1 = __builtin_amdgcn_mfma_f32_16x16x32_bf16(w11, bx, a1, 0, 0, 0);
                if ((q & 3) == 3) asm volatile("" ::: "memory"); }
            float sco[2][4], sel[2][4], gs[2];
#pragma unroll
            for (int nt = 0; nt < 2; ++nt) {
#pragma unroll
                for (int rg = 0; rg < 4; ++rg) { const int e = 16 * nt + 4 * kq + rg; const float lg = rs_reg * (nt ? a1[rg] : a0[rg]) + c0[e]; sco[nt][rg] = sigmoidf(lg); sel[nt][rg] = sco[nt][rg] + rb[e]; }
                float m1 = fmaxf(sel[nt][0], sel[nt][1]), m2 = fminf(sel[nt][0], sel[nt][1]);
                { const float v = sel[nt][2]; if (v > m1) { m2 = m1; m1 = v; } else if (v > m2) m2 = v; }
                { const float v = sel[nt][3]; if (v > m1) { m2 = m1; m1 = v; } else if (v > m2) m2 = v; }
                gs[nt] = m1 + m2; }
            float bv = gs[0]; int bg = kq; if (gs[1] > bv) { bv = gs[1]; bg = 4 + kq; }
#pragma unroll
            for (int o = 16; o < 64; o <<= 1) { const float ov = __shfl_xor(bv, o); const int og = __shfl_xor(bg, o); if (ov > bv || (ov == bv && og < bg)) { bv = ov; bg = og; } }
            owner = ((bg & 3) == kq); mytok = tok0 + ti;
            if (owner) { const int nt = bg >> 2; float cd[4], sv[4];
#pragma unroll
                for (int rg = 0; rg < 4; ++rg) { cd[rg] = nt ? sel[1][rg] : sel[0][rg]; sv[rg] = nt ? sco[1][rg] : sco[0][rg]; }
                int i1 = 0; float v1 = cd[0];
#pragma unroll
                for (int rg = 1; rg < 4; ++rg) if (cd[rg] > v1) { v1 = cd[rg]; i1 = rg; }
                int i2 = -1; float v2 = -1e30f;
#pragma unroll
                for (int rg = 0; rg < 4; ++rg) if (rg != i1 && cd[rg] > v2) { v2 = cd[rg]; i2 = rg; }
                const float s1 = (i1 == 0 ? sv[0] : (i1 == 1 ? sv[1] : (i1 == 2 ? sv[2] : sv[3]))), s2 = (i2 == 0 ? sv[0] : (i2 == 1 ? sv[1] : (i2 == 2 ? sv[2] : sv[3])));
                e0 = 4 * bg + i1; e1 = 4 * bg + i2; w0 = s1 / (s1 + s2); w1 = s2 / (s1 + s2);
                rk0 = __hip_atomic_fetch_add(lcnt + e0, 1u, __ATOMIC_RELAXED, __HIP_MEMORY_SCOPE_WORKGROUP);
                rk1 = __hip_atomic_fetch_add(lcnt + e1, 1u, __ATOMIC_RELAXED, __HIP_MEMORY_SCOPE_WORKGROUP); }
        }
        __syncthreads();
        if (tid < 32) { const unsigned n = lcnt[tid]; lbase[tid] = n ? __hip_atomic_fetch_add(ecnt + 64 * tid, n, RLX_AGENT) : 0u; }
        __syncthreads();
        if (owner) { const unsigned s0 = lbase[e0] + rk0, s1 = lbase[e1] + rk1; perm[(size_t)e0 * NTOK + s0] = 2 * mytok; perm[(size_t)e1 * NTOK + s1] = 2 * mytok + 1; tokw[2 * mytok] = w0; tokw[2 * mytok + 1] = w1;
            tokes[2 * mytok] = (e0 << 16) | (int)s0; tokes[2 * mytok + 1] = (e1 << 16) | (int)s1; }
    }
}
__device__ __forceinline__ void expert_conv(const Frame& F0, const Args& args, int l, int s0, int s1) {
    const Frame F = fresh(F0);
    const int tid = F.tid, lane = F.lane, wave = F.wave;
    LAS float* Tt = (LAS float*)(F.lds + RING_OFF);
    LAS float* red = Tt + 1024 * 33;
    unsigned char* WG8 = args.ws + WS_WG1; bf16* WD = WSP(bf16, WS_WD); float* swe = WSP(float, WS_SWE);
    for (int s = s0; s < s1; ++s) {
        const int sl = s * F.G + F.vcu;
        if (sl < 1024) {
            const int kind = sl >> 9, e = (sl >> 4) & 31, n0 = (sl & 15) * 32;
            const float* src = (kind == 0 ? INP(23) : INP(24)) + (size_t)(l * 32 + e) * 1024 * 512 + n0;
            const int tr0 = (n0 >> 7) * 256 + kind * 128 + (n0 & 127);
            slab_quant_1024(F, src, 512, WG8 + ((size_t)e * 1024 + tr0) * 1024, swe + (size_t)e * 1024 + tr0);
        }
        {
            LAS float* scr = (LAS float*)(F.lds + RING_OFF + wave * 8704);
            const int it = (F.vcu * NWAVES + wave) + F.G * NWAVES * s;
            if (it < 8192) { const int e = it >> 8, rr = it & 255, kb = rr >> 5, nb = rr & 31, n0 = nb * 32; const float* src = INP(25) + (size_t)(l * 32 + e) * 512 * 1024;
                const TrItem a{src, 1024, kb * 64, n0, WD + ((size_t)e * 1024 + n0) * 512, 512}; f32x4 xa[8]; tr_load(a, xa, lane); tr_finish(a, xa, scr, lane); }
            __syncthreads();
        }
    }
}
__device__ __forceinline__ void moe_tilebase(const Frame& F0, const Args& args, int l) {
    const Frame F = fresh(F0);
    __syncthreads();
    if (F.tid < 32) { unsigned* ecnt = (unsigned*)(F.ctl + CW_ECNT + l * 32 * 64); F.MISC[49 + F.tid] = __hip_atomic_load(ecnt + 64 * F.tid, RLX_AGENT); }
    __syncthreads();
    if (F.tid < 32) { const int ln = F.tid; int exc = 0, tl = 0;
#pragma unroll 8
        for (int e = 0; e < 32; ++e) { const int te = (int)((F.MISC[49 + e] + 255u) >> 8); if (e < ln) exc += te; if (e == ln) tl = te; }
        F.MISC[16 + ln] = (unsigned)exc;
        if (ln == 31) F.MISC[48] = (unsigned)(exc + tl); }
    __syncthreads();
}
__device__ __forceinline__ void moe_rowmaps(const Frame& F0, const Args& args, const pg8::MoeOrder& S, LAS int* rowmap) {
    const Frame F = fresh(F0);
    const int* perm = WSP(int, WS_PERM);
    pg8::Unit u; int idxs[8]; int nu = 0;
#pragma unroll
    for (int i = 0; i < 8; ++i) { idxs[i] = -1; if (S.next(i, u)) { idxs[i] = u.gbase + min(F.tid & 255, u.gcnt - 1); nu = i + 1; } }
    if (F.tid < 256) { int v[8];
#pragma unroll
        for (int i = 0; i < 8; ++i) v[i] = perm[idxs[i] < 0 ? 0 : idxs[i]];
#pragma unroll
        for (int i = 0; i < 8; ++i) if (idxs[i] >= 0) { rowmap[i * 256 + F.tid] = v[i] >> 1; ((LAS float*)(rowmap + 2048))[i * 256 + F.tid] = WSP(float, WS_SA)[v[i] >> 1]; } }
    __syncthreads();
}
__device__ __forceinline__ void lru_conv_phase(const Frame& F0, const Args& args, int l) {
    const Frame F = fresh(F0);
    const int lane = F.lane, cg = lane & 7, tg = lane >> 3;
    const bf16* PROJ = WSP(bf16, WS_PROJ); bf16* XC = WSP(bf16, WS_XC);
    for (int wu = F.vcu * NWAVES + F.wave; wu < 4096; wu += F.G * NWAVES) {
        const int hb = wu & 7, c = (wu >> 3) & 127, b = wu >> 10, t0 = c * 64, ch0 = hb * 64 + 8 * cg;
        const bf16* xrp = PROJ + (size_t)b * T * PROJ_LD + XR_OFF + ch0;
        v4u raw[11];
#pragma unroll
        for (int rr = 0; rr < 11; ++rr) { const int t = t0 + 8 * tg - 2 + rr, tc = min(max(t, 0), T - 1); raw[rr] = *(const v4u*)(xrp + (size_t)tc * PROJ_LD); }
        f32x4 wv[5][2];
#pragma unroll
        for (int j = 0; j < 4; ++j) { wv[j][0] = *(const f32x4*)(INP(10) + (l * 4 + j) * 512 + ch0); wv[j][1] = *(const f32x4*)(INP(10) + (l * 4 + j) * 512 + ch0 + 4); }
        wv[4][0] = *(const f32x4*)(INP(11) + l * 512 + ch0); wv[4][1] = *(const f32x4*)(INP(11) + l * 512 + ch0 + 4);
        unsigned ow[8][4];
#pragma unroll
        for (int pp = 0; pp < 4; ++pp) {
            float xl[11], xh[11];
#pragma unroll
            for (int rr = 0; rr < 11; ++rr) { const int t = t0 + 8 * tg - 2 + rr; const unsigned w = (t >= 0 && t < T) ? raw[rr][pp] : 0u; xl[rr] = bflo(w); xh[rr] = bfhi(w); }
#pragma unroll
            for (int tk = 0; tk < 8; ++tk) { float ol = wv[4][pp >> 1][2 * (pp & 1)], oh = wv[4][pp >> 1][2 * (pp & 1) + 1];
#pragma unroll
                for (int j = 0; j < 4; ++j) { ol += wv[j][pp >> 1][2 * (pp & 1)] * xl[tk + j]; oh += wv[j][pp >> 1][2 * (pp & 1) + 1] * xh[tk + j]; }
                ow[tk][pp] = pk2(ol, oh); }
        }
#pragma unroll
        for (int tk = 0; tk < 8; ++tk) *(v4u*)(XC + ((size_t)b * T + t0 + 8 * tg + tk) * 512 + ch0) = (v4u){ow[tk][0], ow[tk][1], ow[tk][2], ow[tk][3]};
    }
}
__device__ __forceinline__ void lru_load_frags(bf16x8 (&af)[4][2], const bf16* xcp, int t0, int lane) {
#pragma unroll
    for (int mt = 0; mt < 4; ++mt) { const int tau = 16 * ((lane & 15) >> 2) + 4 * mt + (lane & 3);
#pragma unroll
        for (int s = 0; s < 2; ++s) af[mt][s] = *(const bf16x8*)(xcp + (size_t)(t0 + tau) * 512 + 32 * s); }
}
template <int DBG = 0>
__device__ __forceinline__ void lru2_phase(const Frame& F0, const Args& args, int l, bf16* obase, int opitch, int ooff) {
    const Frame F = fresh(F0);
    const int lane = F.lane, wave = F.wave, dw = wave >> 2, wq = wave & 3;
    LAS bf16* HP = (LAS bf16*)(F.lds + RING_OFF);
    LAS bf16* YRT = (LAS bf16*)(F.lds + RING_OFF + 131072 + wave * 1024);
    LAS f32x2* CT = (LAS f32x2*)(F.lds + RING_OFF + 139264);
    LAS float* SG = (LAS float*)(F.lds + RING_OFF + 141312);
    __syncthreads();
#pragma unroll
    for (int q = 0; q < 4; ++q) { const int i = F.tid + 512 * q; SG[i] = 1.0f / (1.0f + __expf(16.0f - ((float)i + 0.5f) * (1.0f / 64.0f))); }
    __syncthreads();
    const bf16* PROJ = WSP(bf16, WS_PROJ); const bf16* XC = WSP(bf16, WS_XC);
    for (int un = F.vcu; un < 256; un += F.G) {
        const int b = un >> 6, hb = (un >> 3) & 7, s8 = un & 7;
        const int n = lane & 15, g = lane >> 4, hf = n >> 3, cj = n & 7;
        const int chg = hb * 64 + s8 * 8 + cj;
        const bf16* WLp = WSP(bf16, WS_WL) + ((size_t)(l * 8 + hb) * 256) * 64;
        bf16x8 bg[2], bgi[2], bs[2];
#pragma unroll
        for (int s = 0; s < 2; ++s) { bg[s] = *(const bf16x8*)(WLp + ((2 * dw + 0) * 64 + s8 * 8 + cj) * 64 + 32 * s + 8 * g); bgi[s] = *(const bf16x8*)(WLp + ((2 * dw + 1) * 64 + s8 * 8 + cj) * 64 + 32 * s + 8 * g);
            v4u sel = (v4u){0u, 0u, 0u, 0u};
            if (32 * s + 8 * g == 8 * s8) { const unsigned one = (cj & 1) ? 0x3F800000u : 0x00003F80u; sel[0] = (cj >> 1) == 0 ? one : 0u; sel[1] = (cj >> 1) == 1 ? one : 0u; sel[2] = (cj >> 1) == 2 ? one : 0u; sel[3] = (cj >> 1) == 3 ? one : 0u; }
            bs[s] = __builtin_bit_cast(bf16x8, sel); }
        const float b_r = INP(13)[(l * 2 + dw) * 512 + chg], b_i = INP(15)[(l * 2 + dw) * 512 + chg], lam = INP(16)[(l * 2 + dw) * 512 + chg];
        const float m8sp = -8.0f * ((lam > 15.f) ? __expf(-lam) : log1pf(__expf(-lam)));
        const float m8l = m8sp * 1.4426950408889634f, cbr = (b_r + 16.0f) * 64.0f, cbi = (b_i + 16.0f) * 64.0f;
        const bf16* xcp = XC + (size_t)b * T * 512 + hb * 64 + 8 * g;
        const bf16* yrp = PROJ + (size_t)b * T * PROJ_LD + YR_OFF + hb * 64 + s8 * 8;
        bf16* outp = obase + (size_t)b * T * opitch + ooff + hb * 64 + s8 * 8;
        const int pos = dw ? 7 - (2 * g + hf) : 2 * g + hf;
        float hrun = 0.f;
        bf16x8 nxt[4][2]; v4u ynx = (v4u){0u, 0u, 0u, 0u};
        { const int c0 = dw ? 127 - wq : wq; lru_load_frags(nxt, xcp, c0 * 64, lane); }
        __syncthreads();
#pragma unroll 2
        for (int rd = 0; rd < 32; ++rd) {
            const int c = dw ? 127 - (4 * rd + wq) : 4 * rd + wq, t0 = c * 64;
            const bool second = (DBG & 2) ? false : rd >= 16;
            bf16x8 af[4][2];
#pragma unroll
            for (int mt = 0; mt < 4; ++mt) { af[mt][0] = nxt[mt][0]; af[mt][1] = nxt[mt][1]; }
            const v4u ycur = ynx;
            { const int rn = min(rd + 1, 31), cn = dw ? 127 - (4 * rn + wq) : 4 * rn + wq; if (!(DBG & 1)) lru_load_frags(nxt, xcp, cn * 64, lane);
              if (rn >= 16) ynx = *(const v4u*)(yrp + (size_t)(cn * 64 + lane) * PROJ_LD); }
            if (second) *(LAS v4u*)(YRT + lane * 8) = ycur;
            f32x4 ag[4], ai4[4], ax[4];
#pragma unroll
            for (int mt = 0; mt < 4; ++mt) { ag[mt] = (f32x4){0.f, 0.f, 0.f, 0.f}; ai4[mt] = (f32x4){0.f, 0.f, 0.f, 0.f}; ax[mt] = (f32x4){0.f, 0.f, 0.f, 0.f};
#pragma unroll
                for (int s = 0; s < 2; ++s) { ag[mt] = __builtin_amdgcn_mfma_f32_16x16x32_bf16(af[mt][s], bg[s], ag[mt], 0, 0, 0); ai4[mt] = __builtin_amdgcn_mfma_f32_16x16x32_bf16(af[mt][s], bgi[s], ai4[mt], 0, 0, 0); ax[mt] = __builtin_amdgcn_mfma_f32_16x16x32_bf16(af[mt][s], bs[s], ax[mt], 0, 0, 0); } }
            float a[8], bx[8], gr[8], gi[8], xv[8];
#pragma unroll
            for (int jj = 0; jj < 8; ++jj) {
                gr[jj] = hf ? ag[2 + (jj >> 2)][jj & 3] : ag[jj >> 2][jj & 3]; gi[jj] = hf ? ai4[2 + (jj >> 2)][jj & 3] : ai4[jj >> 2][jj & 3]; xv[jj] = hf ? ax[2 + (jj >> 2)][jj & 3] : ax[jj >> 2][jj & 3]; }
#pragma unroll
            for (int jj = 0; jj < 8; ++jj) { gr[jj] = SG[(unsigned)__builtin_amdgcn_fmed3f(__builtin_fmaf(gr[jj], 64.0f, cbr), 0.0f, 2047.0f)]; gi[jj] = SG[(unsigned)__builtin_amdgcn_fmed3f(__builtin_fmaf(gi[jj], 64.0f, cbi), 0.0f, 2047.0f)]; }
#pragma unroll
            for (int jj = 0; jj < 8; ++jj) a[jj] = __builtin_amdgcn_exp2f(m8l * gr[jj]);
#pragma unroll
            for (int jj = 0; jj < 8; ++jj) bx[jj] = __builtin_amdgcn_sqrtf(__builtin_fmaf(-a[jj], a[jj], 1.0f)) * (gi[jj] * xv[jj]);
            float A8 = 1.f, B8 = 0.f;
            if (dw == 0) {
#pragma unroll
                for (int jj = 0; jj < 8; ++jj) { B8 = a[jj] * B8 + bx[jj]; A8 *= a[jj]; }
            } else {
#pragma unroll
                for (int jj = 7; jj >= 0; --jj) { B8 = a[jj] * B8 + bx[jj]; A8 *= a[jj]; }
            }
            float Ap = 1.f, Bp = 0.f, At = 1.f, Bt = 0.f;
#pragma unroll
            for (int k = 0; k < 8; ++k) { const int seg = dw ? 7 - k : k; const int src = cj + 8 * (seg & 1) + 16 * (seg >> 1);
                const float Ak = __shfl(A8, src), Bk = __shfl(B8, src);
                if (k < pos) { Bp = Ak * Bp + Bk; Ap *= Ak; }
                Bt = Ak * Bt + Bk; At *= Ak; }
            const int par = rd & 1;
            if (g == 0 && hf == 0) CT[((par * 2 + dw) * 4 + wq) * 8 + cj] = (f32x2){At, Bt};
            __syncthreads();
            float h = hrun;
#pragma unroll
            for (int q = 0; q < 4; ++q) { const f32x2 ab = CT[((par * 2 + dw) * 4 + q) * 8 + cj]; if (q < wq) h = ab.x * h + ab.y; hrun = ab.x * hrun + ab.y; }
            h = Ap * h + Bp;
            float hv[8];
            if (dw == 0) {
#pragma unroll
                for (int jj = 0; jj < 8; ++jj) { h = a[jj] * h + bx[jj]; hv[jj] = h; }
            } else {
#pragma unroll
                for (int jj = 7; jj >= 0; --jj) { h = a[jj] * h + bx[jj]; hv[jj] = h; }
            }
            const int tl0 = 16 * g + 8 * hf;
            if (DBG & 4) { if (hv[0] + hv[7] == 123.456f) outp[0] = 1; } else if (!second) {
                LAS bf16* hp = HP + ((size_t)(dw * 64 + (dw ? c - 64 : c)) * 64 + tl0) * 8 + cj;
#pragma unroll
                for (int jj = 0; jj < 8; ++jj) hp[jj * 8] = (bf16)f2bf(hv[jj]);
            } else {
                const LAS bf16* hp = HP + ((size_t)((1 - dw) * 64 + (dw ? c : c - 64)) * 64 + tl0) * 8 + cj;
                LDS_WAIT(); asm volatile("" ::: "memory");
                float yv[8], pv[8];
#pragma unroll
                for (int jj = 0; jj < 8; ++jj) { yv[jj] = bf2f(YRT[(tl0 + jj) * 8 + cj]); pv[jj] = bf2f(hp[jj * 8]); }
#pragma unroll
                for (int jj = 0; jj < 8; ++jj) { const float y = yv[jj], z = y * __builtin_fmaf(y * y, 0.044715f * 1.5957691216057308f * 64.0f, 1.5957691216057308f * 64.0f);
                    YRT[(tl0 + jj) * 8 + cj] = (bf16)f2bf((hv[jj] + pv[jj]) * (y * SG[(unsigned)__builtin_amdgcn_fmed3f(z + 1024.0f, 0.0f, 2047.0f)])); }
                LDS_WAIT(); asm volatile("" ::: "memory");
                *(v4u*)(outp + (size_t)(t0 + lane) * opitch) = *(const LAS v4u*)(YRT + lane * 8);
                LDS_WAIT(); asm volatile("" ::: "memory");
            }
        }
        __syncthreads();
    }
}
constexpr int AT_KR = 0, AT_VR = 73728, AT_VPITCH = 1168, AT_RPB = 148480, AT_XB = 150528, AT_XM = 158720;
__device__ __forceinline__ void attn2_phase(const Frame& F0, const Args& args, int l, bf16* obase, int opitch) {
    const Frame F = fresh(F0);
    const int tid = F.tid, lane = F.lane, wave = F.wave;
    LAS unsigned char* KR = F.lds + AT_KR; LAS unsigned char* VR = F.lds + AT_VR;
    LAS float* rpb = (LAS float*)(F.lds + AT_RPB);
    LAS unsigned char* XB = F.lds + AT_XB; LAS unsigned char* XM = F.lds + AT_XM;
    const bf16* PROJ = WSP(bf16, WS_PROJ); const bf16* VT = WSP(bf16, WS_VT);
    const int qb = wave & 3, dh = wave >> 2, qn = lane & 15, g = lane >> 4;
    const int cb = (qb == 0) ? 0 : ((qb == 1) ? 8 : ((qb == 2) ? 24 : 32));
    const int w = 16 * qb + qn, cs = min(max(w - 8, 0), 48);
    const int st = tid >> 3, sc = tid & 7;
    bool v0[4]; int dsel[4];
#pragma unroll
    for (int j = 0; j < 4; ++j) { const int kc0 = cb + 4 * g + j; v0[j] = (kc0 >= cs) && (kc0 <= cs + 15); dsel[j] = (v0[j] ? kc0 : kc0 + 16) - w + 15; }
    for (int un = F.vcu; un < 256; un += F.G) {
        const int bh = un >> 3, b = bh >> 3, h = bh & 7, R0 = (un & 7) * 16;
        __syncthreads();
        for (int i = tid; i < 465; i += 512) rpb[i] = INP(9)[(l * 8 + h) * 465 + i];
        const bf16* kg = PROJ + ((size_t)b * T + st) * PROJ_LD + K_OFF + h * 64 + 8 * sc;
        const bf16* vg = VT + ((size_t)(b * 512 + h * 64 + st)) * T + 8 * sc;
        const int kdst = st * 128 + ((sc ^ ((st >> 1) & 7)) * 16);
        const int vdst = st * AT_VPITCH + sc * 16;
        const int rs0 = min(max(R0 - 4, 0), 120);
        {
            v4u kk[8], vv[8];
#pragma unroll
            for (int j = 0; j < 8; ++j) { kk[j] = *(const v4u*)(kg + (size_t)(rs0 + j) * 64 * PROJ_LD); vv[j] = *(const v4u*)(vg + (rs0 + j) * 64); }
            PIN8(kk); PIN8(vv);
#pragma unroll
            for (int j = 0; j < 8; ++j) { const int slot = (rs0 + j) % 9; *(LAS v4u*)(KR + slot * 8192 + kdst) = kk[j]; *(LAS v4u*)(VR + slot * 128 + vdst) = vv[j]; }
        }
        __syncthreads();
        int have = rs0 + 7;
        v2u py0 = (v2u){0u, 0u}, py1 = (v2u){0u, 0u}; bf16* pop = nullptr;
        bf16x8 qn0, qn1;
        { const bf16* qp = PROJ + ((size_t)b * T + R0 * 64 + w) * PROJ_LD + Q_OFF + h * 64; qn0 = *(const bf16x8*)(qp + 8 * g); qn1 = *(const bf16x8*)(qp + 32 + 8 * g); }
#pragma unroll 1
        for (int s = 0; s < 16; ++s) {
            const int r = R0 + s;
            if (s > 0) { *(v2u*)pop = py0; *(v2u*)(pop + 16) = py1; }
            const size_t tokq = (size_t)b * T + r * 64 + w;
            const bf16x8 qf0 = qn0, qf1 = qn1;
            { const int r2 = min(r + 1, R0 + 15); const bf16* qp = PROJ + ((size_t)b * T + r2 * 64 + w) * PROJ_LD + Q_OFF + h * 64; qn0 = *(const bf16x8*)(qp + 8 * g); qn1 = *(const bf16x8*)(qp + 32 + 8 * g); }
            const int rsn = min(max(r + 1 - 4, 0), 120); const bool newrow = (s + 1 < 16) && (rsn + 7 > have); const int nrow = min(rsn + 7, 127);
            const v4u pk = *(const v4u*)(kg + (size_t)nrow * 64 * PROJ_LD), pv = *(const v4u*)(vg + nrow * 64);
            const int rs = min(max(r - 4, 0), 120);
            const int kr0 = 4 * dh;
            int slot0 = rs % 9 + kr0; slot0 = (slot0 >= 9) ? slot0 - 9 : slot0;
            int slot = slot0;
            f32x4 sc4[8];
#pragma unroll
            for (int kr = 0; kr < 4; ++kr) {
#pragma unroll
                for (int ch = 0; ch < 2; ++ch) { const int kt = cb + 16 * ch + qn; const LAS unsigned char* kp = KR + slot * 8192 + kt * 128; const int sw = (kt >> 1) & 7;
                    const bf16x8 kf0 = *(const LAS bf16x8*)(kp + ((g ^ sw) * 16)), kf1 = *(const LAS bf16x8*)(kp + (((4 + g) ^ sw) * 16));
                    f32x4 a = (f32x4){0.f, 0.f, 0.f, 0.f};
                    a = __builtin_amdgcn_mfma_f32_16x16x32_bf16(kf0, qf0, a, 0, 0, 0);
                    a = __builtin_amdgcn_mfma_f32_16x16x32_bf16(kf1, qf1, a, 0, 0, 0);
                    sc4[2 * kr + ch] = a; }
                slot = (slot == 8) ? 0 : slot + 1;
            }
            float sv[4][4]; float mx = -1e30f;
            const LAS float* rp = rpb + (rs - r + 7 + kr0) * 31;
#pragma unroll
            for (int kr = 0; kr < 4; ++kr)
#pragma unroll
                for (int j = 0; j < 4; ++j) { const float s = (v0[j] ? sc4[2 * kr][j] : sc4[2 * kr + 1][j]) + rp[kr * 31 + dsel[j]]; sv[kr][j] = s; mx = fmaxf(mx, s); }
            mx = fmaxf(mx, __shfl_xor(mx, 16)); mx = fmaxf(mx, __shfl_xor(mx, 32));
            float sum = 0.f;
#pragma unroll
            for (int kr = 0; kr < 4; ++kr)
#pragma unroll
                for (int j = 0; j < 4; ++j) { const float pe = __expf(sv[kr][j] - mx); sum += pe; sc4[2 * kr][j] = v0[j] ? pe : 0.f; sc4[2 * kr + 1][j] = v0[j] ? 0.f : pe; }
            sum += __shfl_xor(sum, 16); sum += __shfl_xor(sum, 32);
            f32x4 o[4];
#pragma unroll
            for (int dt = 0; dt < 4; ++dt) o[dt] = (f32x4){0.f, 0.f, 0.f, 0.f};
            slot = slot0;
            const LAS unsigned char* vb0 = VR + qn * AT_VPITCH + (cb + 4 * g) * 2;
#pragma unroll
            for (int kr = 0; kr < 4; ++kr) {
                v4u pw; pw.x = pk2(sc4[2 * kr][0], sc4[2 * kr][1]); pw.y = pk2(sc4[2 * kr][2], sc4[2 * kr][3]); pw.z = pk2(sc4[2 * kr + 1][0], sc4[2 * kr + 1][1]); pw.w = pk2(sc4[2 * kr + 1][2], sc4[2 * kr + 1][3]);
                const bf16x8 pf = __builtin_bit_cast(bf16x8, pw);
                const LAS unsigned char* vp = vb0 + slot * 128;
#pragma unroll
                for (int dt = 0; dt < 4; ++dt) { const v2u lo = *(const LAS v2u*)(vp + dt * 16 * AT_VPITCH), hi = *(const LAS v2u*)(vp + dt * 16 * AT_VPITCH + 32);
                    o[dt] = __builtin_amdgcn_mfma_f32_16x16x32_bf16(__builtin_bit_cast(bf16x8, ((v4u){lo.x, lo.y, hi.x, hi.y})), pf, o[dt], 0, 0, 0); }
                slot = (slot == 8) ? 0 : slot + 1;
            }
            { const f32x4 s0 = dh ? o[0] : o[2], s1 = dh ? o[1] : o[3];
              *(LAS v4u*)(XB + wave * 1024 + lane * 16) = (v4u){pk2(s0[0], s0[1]), pk2(s0[2], s0[3]), pk2(s1[0], s1[1]), pk2(s1[2], s1[3])};
              if (g == 0) *(LAS f32x2*)(XM + wave * 128 + qn * 8) = (f32x2){mx, sum}; }
            LDS_WAIT(); __builtin_amdgcn_s_barrier(); asm volatile("" ::: "memory");
            { const v4u pp = *(const LAS v4u*)(XB + (wave ^ 4) * 1024 + lane * 16); const f32x2 ms = *(const LAS f32x2*)(XM + (wave ^ 4) * 128 + qn * 8);
              const float m = fmaxf(mx, ms.x), fme = __expf(mx - m), fpa = __expf(ms.x - m), inv = __builtin_amdgcn_rcpf(sum * fme + ms.y * fpa), cme = fme * inv, cpa = fpa * inv;
              const f32x4 k0 = dh ? o[2] : o[0], k1 = dh ? o[3] : o[1];
              py0 = (v2u){pk2(k0[0] * cme + bflo(pp.x) * cpa, k0[1] * cme + bfhi(pp.x) * cpa), pk2(k0[2] * cme + bflo(pp.y) * cpa, k0[3] * cme + bfhi(pp.y) * cpa)};
              py1 = (v2u){pk2(k1[0] * cme + bflo(pp.z) * cpa, k1[1] * cme + bfhi(pp.z) * cpa), pk2(k1[2] * cme + bflo(pp.w) * cpa, k1[3] * cme + bfhi(pp.w) * cpa)}; }
            pop = obase + tokq * opitch + h * 64 + 32 * dh + 4 * g;
            if (newrow) { const int ns = nrow % 9; *(LAS v4u*)(KR + ns * 8192 + kdst) = pk; *(LAS v4u*)(VR + ns * 128 + vdst) = pv; have = nrow; }
            __syncthreads();
        }
        *(v2u*)pop = py0; *(v2u*)(pop + 16) = py1;
    }
    __syncthreads();
}
__device__ __forceinline__ bf16x8 lds_gather8(const LAS bf16* p, int stride) {
    unsigned short e[8];
#pragma unroll
    for (int j = 0; j < 8; ++j) e[j] = p[j * stride];
    v4u w; w.x = e[0] | ((unsigned)e[1] << 16); w.y = e[2] | ((unsigned)e[3] << 16); w.z = e[4] | ((unsigned)e[5] << 16); w.w = e[6] | ((unsigned)e[7] << 16);
    return __builtin_bit_cast(bf16x8, w);
}
constexpr int FA_PITCH = 136, FB_PITCH = 264;
__device__ __forceinline__ void fft_a2_phase(const Frame& F0, const Args& args) {
    const Frame F = fresh(F0);
    const int tid = F.tid, lane = F.lane, wave = F.wave, nl = lane & 31, hh = lane >> 5;
    LAS bf16* GT = (LAS bf16*)(F.lds + RING_OFF);
    LAS bf16* FAL = (LAS bf16*)(F.lds + RING_OFF + 65536);
    LAS f32x2* TWL = (LAS f32x2*)(F.lds + RING_OFF + 65536 + 34816);
    const bf16* PROJ = WSP(bf16, WS_PROJ); const bf16* FA = WSP(bf16, WS_FA); const f32x2* TW = WSP(f32x2, WS_TW); bf16* ZP = WSP(bf16, WS_U);
    __syncthreads();
    { v4u t[4];
#pragma unroll
        for (int i_ = 0; i_ < 4; ++i_) { const int i = tid + 512 * i_, r = i >> 4, c = i & 15; t[i_] = *(const v4u*)(FA + r * 128 + 8 * c); }
        PIN4(t);
#pragma unroll
        for (int i_ = 0; i_ < 4; ++i_) { const int i = tid + 512 * i_, r = i >> 4, c = i & 15; *(LAS v4u*)(FAL + r * FA_PITCH + 8 * c) = t[i_]; } }
    v4u v[8];
    { const int un = F.vcu; const int b = un >> 7, t2 = un & 127;
      if (un < 512) {
#pragma unroll
        for (int i = 0; i < 8; ++i) { const int idx = tid + 512 * i, k = idx >> 5, c = idx & 31, part = k >> 6, t1 = k & 63;
            v[i] = *(const v4u*)(PROJ + ((size_t)b * T + 128 * t1 + t2) * PROJ_LD + G_OFF + part * 256 + 8 * c); } } }
    for (int un = F.vcu; un < 512; un += F.G) {
        const int b = un >> 7, t2 = un & 127;
        __syncthreads();
        if (tid < 64) TWL[tid] = TW[t2 * 64 + tid];
        PIN8(v);
#pragma unroll
        for (int i = 0; i < 8; ++i) { const int idx = tid + 512 * i; *(LAS v4u*)(GT + (size_t)idx * 8) = v[i]; }
        { const int un2 = (un + F.G < 512) ? un + F.G : un; const int b2 = un2 >> 7, t22 = un2 & 127;
#pragma unroll
          for (int i = 0; i < 8; ++i) { const int idx = tid + 512 * i, k = idx >> 5, c = idx & 31, part = k >> 6, t1 = k & 63;
              v[i] = *(const v4u*)(PROJ + ((size_t)b2 * T + 128 * t1 + t22) * PROJ_LD + G_OFF + part * 256 + 8 * c); } }
        __syncthreads();
        {
            const int ch = 32 * wave + nl;
            f32x16 acc[4];
#pragma unroll
            for (int mt = 0; mt < 4; ++mt) acc[mt] = (f32x16){};
#pragma unroll 1
            for (int sc = 0; sc < 2; ++sc) {
                bf16x8 bf[4];
#pragma unroll
                for (int q4 = 0; q4 < 4; ++q4) bf[q4] = lds_gather8(GT + (16 * (4 * sc + q4) + 8 * hh) * 256 + ch, 256);
#pragma unroll
                for (int mt = 0; mt < 4; ++mt)
#pragma unroll
                    for (int q4 = 0; q4 < 4; ++q4) { const bf16x8 af = *(const LAS bf16x8*)(FAL + (32 * mt + nl) * FA_PITCH + 16 * (4 * sc + q4) + 8 * hh); acc[mt] = __builtin_amdgcn_mfma_f32_32x32x16_bf16(af, bf[q4], acc[mt], 0, 0, 0); }
            }
#pragma unroll
            for (int mt = 0; mt < 2; ++mt)
#pragma unroll
                for (int rg = 0; rg < 16; ++rg) { const int k1 = 32 * mt + (rg & 3) + 8 * (rg >> 2) + 4 * hh; const f32x2 cs = TWL[k1];
                    const float zr = acc[mt][rg], zi = acc[mt + 2][rg];
                    GT[k1 * 256 + ch] = (bf16)f2bf(zr * cs.x + zi * cs.y); GT[(64 + k1) * 256 + ch] = (bf16)f2bf(zi * cs.x - zr * cs.y);
                }
        }
        __syncthreads();
#pragma unroll
        for (int i = 0; i < 8; ++i) { const int idx = tid + 512 * i, m = idx >> 5, c = idx & 31, pp = m >> 6, k1 = m & 63;
            *(v4u*)(ZP + ((size_t)(b * 64 + k1) * 128 + t2) * 512 + pp * 256 + 8 * c) = *(const LAS v4u*)(GT + (size_t)idx * 8); }
    }
    __syncthreads();
}
__device__ __forceinline__ void fft_b2_phase(const Frame& F0, const Args& args) {
    const Frame F = fresh(F0);
    const int tid = F.tid, lane = F.lane, wave = F.wave, nl = lane & 31, hh = lane >> 5;
    LAS bf16* ZT = (LAS bf16*)(F.lds + RING_OFF);
    LAS bf16* FBL = (LAS bf16*)(F.lds + RING_OFF + 65536);
    LAS float* ZC = (LAS float*)(F.lds + RING_OFF + 65536 + 67584);
    LAS float* V0A = ZC + 512;
    LAS float* WA = V0A + 256;
    bf16* PROJ = WSP(bf16, WS_PROJ); const bf16* FB = WSP(bf16, WS_FB); const bf16* ZP = WSP(bf16, WS_U);
    __syncthreads();
    { v4u t[8];
#pragma unroll
        for (int i_ = 0; i_ < 8; ++i_) { const int i = tid + 512 * i_, r = i >> 5, c = i & 31; t[i_] = *(const v4u*)(FB + r * 256 + 8 * c); }
        PIN8(t);
#pragma unroll
        for (int i_ = 0; i_ < 8; ++i_) { const int i = tid + 512 * i_, r = i >> 5, c = i & 31; *(LAS v4u*)(FBL + r * FB_PITCH + 8 * c) = t[i_]; } }
    const int ws = wave >> 2, nt = (wave >> 1) & 1, mh = wave & 1;
    v4u v[8];
    { const int un = F.vcu; const int b = un >> 7, p = (un >> 2) & 31, g = un & 3;
      if (un < 512) {
#pragma unroll
        for (int i = 0; i < 8; ++i) { const int idx = tid + 512 * i, s = idx >> 11, k = (idx >> 3) & 255, c = idx & 7, part = k >> 7, t2 = k & 127, k1 = s ? (p ? 64 - p : 32) : p;
            v[i] = *(const v4u*)(ZP + ((size_t)(b * 64 + k1) * 128 + t2) * 512 + part * 256 + g * 64 + 8 * c); } } }
    for (int un = F.vcu; un < 512; un += F.G) {
        const int b = un >> 7, p = (un >> 2) & 31, g = un & 3;
        __syncthreads();
        PIN8(v);
#pragma unroll
        for (int i = 0; i < 8; ++i) { const int idx = tid + 512 * i; *(LAS v4u*)(ZT + (size_t)idx * 8) = v[i]; }
        { const int un2 = (un + F.G < 512) ? un + F.G : un; const int b2 = un2 >> 7, p2 = (un2 >> 2) & 31, g2 = un2 & 3;
#pragma unroll
          for (int i = 0; i < 8; ++i) { const int idx = tid + 512 * i, s = idx >> 11, k = (idx >> 3) & 255, c = idx & 7, part = k >> 7, t2 = k & 127, k1 = s ? (p2 ? 64 - p2 : 32) : p2;
              v[i] = *(const v4u*)(ZP + ((size_t)(b2 * 64 + k1) * 128 + t2) * 512 + part * 256 + g2 * 64 + 8 * c); } }
        __syncthreads();
        ZC[tid] = bf2f(ZT[(size_t)tid * 64]);
        const int ch = 32 * nt + nl;
        f32x16 acc[2];
        acc[0] = (f32x16){}; acc[1] = (f32x16){};
        { const LAS bf16* ZTs = ZT + ws * 16384;
#pragma unroll 1
          for (int sc = 0; sc < 4; ++sc) {
            bf16x8 bf[4];
#pragma unroll
            for (int q = 0; q < 4; ++q) bf[q] = lds_gather8(ZTs + (16 * (4 * sc + q) + 8 * hh) * 64 + ch, 64);
#pragma unroll
            for (int m2 = 0; m2 < 2; ++m2)
#pragma unroll
                for (int q = 0; q < 4; ++q) { const bf16x8 af = *(const LAS bf16x8*)(FBL + (64 * mh + 32 * m2 + nl) * FB_PITCH + 16 * (4 * sc + q) + 8 * hh); acc[m2] = __builtin_amdgcn_mfma_f32_32x32x16_bf16(af, bf[q], acc[m2], 0, 0, 0); }
          } }
        __syncthreads();
        {
            const int s = tid >> 8, k2 = (tid >> 1) & 127, hf = tid & 1;
            const LAS bf16* fr = FBL + k2 * FB_PITCH + 64 * hf; const LAS float* zc = ZC + s * 256 + 64 * hf;
            float w = 0.f;
#pragma unroll 2
            for (int j = 0; j < 8; ++j) { const v4u fc = *(const LAS v4u*)(fr + 8 * j), fs = *(const LAS v4u*)(fr + 128 + 8 * j);
                const f32x4 r0 = *(const LAS f32x4*)(zc + 8 * j), r1 = *(const LAS f32x4*)(zc + 8 * j + 4), i0 = *(const LAS f32x4*)(zc + 128 + 8 * j), i1 = *(const LAS f32x4*)(zc + 128 + 8 * j + 4);
                w += i0[0] * bflo(fc.x) + i0[1] * bfhi(fc.x) + i0[2] * bflo(fc.y) + i0[3] * bfhi(fc.y) + i1[0] * bflo(fc.z) + i1[1] * bfhi(fc.z) + i1[2] * bflo(fc.w) + i1[3] * bfhi(fc.w);
                w -= r0[0] * bflo(fs.x) + r0[1] * bfhi(fs.x) + r0[2] * bflo(fs.y) + r0[3] * bfhi(fs.y) + r1[0] * bflo(fs.z) + r1[1] * bfhi(fs.z) + r1[2] * bflo(fs.w) + r1[3] * bfhi(fs.w); }
            w += __shfl_xor(w, 1);
            if (hf == 0) WA[s * 128 + k2] = w * (1.0f / 1024.0f);
        }
        {
            const int kb = 64 * mh + 4 * hh;
            int hi = p ? (1 - ws) * 128 : ws * 128, lo = (p || ws) ? 127 - kb : 128 - kb, rb = (ws * 128 + kb) * 128 + ch, chm = ch ? 128 - ch : 64;
            asm volatile("" : "+v"(hi), "+v"(lo), "+v"(rb), "+v"(chm));
#pragma unroll
            for (int m2 = 0; m2 < 2; ++m2)
#pragma unroll
                for (int rg = 0; rg < 16; ++rg) { const int off = 32 * m2 + (rg & 3) + 8 * (rg >> 2); const bf16 hv = (bf16)f2bf(acc[m2][rg] * (1.0f / 1024.0f));
                    ZT[rb + off * 128] = hv; ZT[(hi + ((lo - off) & 127)) * 128 + chm] = hv; }
            if (ch == 0) {
#pragma unroll
                for (int m2 = 0; m2 < 2; ++m2)
#pragma unroll
                    for (int rg = 0; rg < 16; ++rg) V0A[ws * 128 + kb + 32 * m2 + (rg & 3) + 8 * (rg >> 2)] = acc[m2][rg] * (1.0f / 1024.0f); }
        }
        __syncthreads();
        if (tid < 256) { const int s = tid >> 7, k2 = tid & 127, rm = p ? (1 - s) * 128 + 127 - k2 : (s ? 128 + 127 - k2 : ((128 - k2) & 127));
            ZT[tid * 128] = (bf16)f2bf(0.5f * (V0A[tid] + V0A[rm])); ZT[tid * 128 + 64] = (bf16)f2bf(0.5f * (WA[tid] + WA[rm])); }
        __syncthreads();
#pragma unroll
        for (int i = 0; i < 8; ++i) { const int idx = tid + 512 * i, r = idx >> 4, c = idx & 15, s = r >> 7, k2 = r & 127, k1 = s ? (p ? 64 - p : 32) : p;
            *(v4u*)(PROJ + ((size_t)b * T + k1 + 64 * k2) * PROJ_LD + G_OFF + g * 128 + 8 * c) = *(const LAS v4u*)(ZT + (size_t)idx * 8); }
    }
    __syncthreads();
}
__device__ __forceinline__ void stagger(const Frame& F, int ticks) {
    const unsigned long long t0 = __builtin_amdgcn_s_memrealtime(), d = (unsigned long long)((F.vcu & 3) * ticks);
    while (__builtin_amdgcn_s_memrealtime() - t0 < d) __builtin_amdgcn_s_sleep(16);
}
__device__ __forceinline__ int fresh_bid() { int b = (int)blockIdx.x; asm volatile("" : "+s"(b)); return b; }
constexpr int PPL = 9, N_PHASES = 2 + PPL * DEPTH;
__global__ void __launch_bounds__(NWAVES * 64, 2) mega_fwd(Args args, int li) {
    extern __shared__ __attribute__((aligned(16))) unsigned char lds[];
    Frame F;
    F.lds = (LAS unsigned char*)lds;
    F.MISC = (volatile LAS unsigned*)(F.lds + MISC_OFF);
    F.tid = threadIdx.x; F.lane = F.tid & 63; F.wave = __builtin_amdgcn_readfirstlane(F.tid >> 6);
    F.G = gridDim.x; { const int bx = blockIdx.x; F.vcu = (F.G % 8 == 0) ? (bx % 8) * (F.G / 8) + bx / 8 : bx; }
    F.ctl = (gu32*)(args.ws + WS_CTL);
    for (int u = F.tid; u < (LDS_BYTES - LDSCTL_OFF) / 4; u += NWAVES * 64) ((LAS unsigned*)(F.lds + LDSCTL_OFF))[u] = 0u;
    __syncthreads();
    const int lo = args.ph_lo, hi = args.ph_hi;
    XcdBarrier bar; bar.bar = (unsigned*)(F.ctl + CW_BAR) + li * XCD_BAR_WORDS; bar.x = 0; bar.st = nullptr; bar.wave = F.wave;
    if (hi - lo > 1) bar = xcd_barrier_post((unsigned*)(F.ctl + CW_BAR) + li * XCD_BAR_WORDS, F.MISC + 8);
#ifndef PHMASK
#define PHMASK 0xFFFF
#endif
#define EN(kind) ((PHMASK >> (kind)) & 1)
#define IN(k) (lo <= (k) && (k) < hi)
#define SEAM(k) do { if (IN(k) && IN((k) + 1)) { xcd_barrier(bar); for (int rb_ = 0; rb_ < REP_B; ++rb_) xcd_barrier(bar); } } while (0)

    if (EN(0) && IN(0)) { for (int rep = 0; rep < 1 + REP_C; ++rep) p0_prologue(F, args); SEAM(0); }
    auto layer = [&](const int l) __attribute__((always_inline)) {
        const int pb = 1 + PPL * l;
        bf16* U = WSP(bf16, WS_U); bf16* PROJ = WSP(bf16, WS_PROJ); bf16* GATES = WSP(bf16, WS_GATES);
        if (EN(1) && IN(pb + 0)) { if (l == 0) p1_quantize(F, args);
            if (l == 0) { for (int rep = 0; rep < (REP_R & 1); ++rep) rows_phase<0>(F, args, l); rows_phase<0>(F, args, l); } else rows_phase<1>(F, args, l); SEAM(pb + 0); }
        if (EN(2) && IN(pb + 1)) {
            const pg8::bf16_t* UI8 = (const pg8::bf16_t*)(args.ws + WS_U); const pg8::bf16_t* WI8 = (const pg8::bf16_t*)(args.ws + WS_WP2 + (size_t)l * NP2 * 1024);
            pg8::Gemm g{UI8, UI8, UI8, WI8, nullptr, nullptr, 512, 512, 512};
            pg8::StaticOrder S; S.init(NTOK, NP2, F.G, fresh_bid());
            LAS unsigned char* stab = F.lds + XTRA_OFF;
            const int npre = (F.vcu & 3) * (STAG_P2 != 0);
            expert_conv(F, args, l, 0, npre);
            { const Frame Fg = fresh(F); __syncthreads();
#pragma unroll
              for (int q = 0; q < 2; ++q) { const int i = Fg.tid + 512 * q; const float sg = 255.0f / (1.0f + __expf(8.0f - ((float)i + 0.5f) * (1.0f / 64.0f))); stab[i] = (unsigned char)(int)fminf(fmaxf(sg + 0.5f, 1.0f), 255.0f); }
              __syncthreads(); }
            EpiP2I E{false, PROJ, WSP(bf16, WS_VT), GATES, INP(8) + l * 3072, stab, WSP(float, WS_SA), WSP(float, WS_SW) + l * NP2, (LAS float*)(F.lds + XTRA_OFF + 8192)};
            for (int rep = 0; rep < 1 + (REP_GS & 1 ? REP_G : 0); ++rep) pg8::gemm_phase<EpiP2I, pg8::StaticOrder, true, false, false, true>(F.lds + RING_OFF, g, S, E, fresh(F).tid);
            __syncthreads(); expert_conv(F, args, l, npre, 4);
            SEAM(pb + 1);
        }
        if (EN(3) && IN(pb + 2)) {
            for (int rep = 0; rep < REP_M; ++rep) { if (REP_MS & 1) attn2_phase(F, args, l, WSP(bf16, WS_SCR), 512); if (REP_MS & 2) lru_conv_phase(F, args, l); if (REP_MS & 4) fft_a2_phase(F, args); if (REP_MS & 16) fft_a2_phase(F, args); }
            lru_conv_phase(F, args, l); attn2_phase(F, args, l, PROJ, PROJ_LD); fft_a2_phase(F, args); SEAM(pb + 2); }
        if (EN(4) && IN(pb + 3)) { for (int rep = 0; rep < REP_M; ++rep) { if (REP_MS & 2) lru2_phase<REP_DBG>(F, args, l, WSP(bf16, WS_SCR), 512, 0); if (REP_MS & 4) fft_b2_phase(F, args); if (REP_MS & 32) fft_b2_phase(F, args); }
            lru2_phase(F, args, l, PROJ, PROJ_LD, YR_OFF); fft_b2_phase(F, args); SEAM(pb + 3); }
        if (EN(6) && IN(pb + 4)) {
            const bf16* WP = WSP(bf16, WS_WPROJ) + (size_t)l * 3 * 1024 * 512;
            pg8::Gemm g{PROJ + Q_OFF, PROJ + YR_OFF, PROJ + G_OFF, WP, WP + 1024 * 512, WP + 2 * 1024 * 512, PROJ_LD, 512, 512};
            pg8::MergeOrder S; S.init(NTOK, 1024, F.G, fresh_bid());
            LAS float* rtab = (LAS float*)(F.lds + XTRA_OFF);
            { const Frame Fm = fresh(F); __syncthreads(); if (Fm.tid < 256) rtab[Fm.tid] = 1.0f / (float)(Fm.tid > 0 ? Fm.tid : 1); __syncthreads(); }
            EpiMerge E{false, GATES, args.ws + WS_U, rtab, (LAS float*)(F.lds + XTRA_OFF + 1024), F.ctl + CW_RM + l * NTOK, F.ctl + CW_TC + l * 128};
            for (int rep = 0; rep < 1 + (REP_GS & 2 ? REP_G : 0); ++rep) pg8::gemm_phase<EpiMerge, pg8::MergeOrder, true>(F.lds + RING_OFF, g, S, E, fresh(F).tid);
            SEAM(pb + 4);
        }
        if (EN(7) && IN(pb + 5)) {
            const pg8::bf16_t* M8 = (const pg8::bf16_t*)(args.ws + WS_U); const pg8::bf16_t* WO8 = (const pg8::bf16_t*)(args.ws + WS_WOUT + (size_t)l * 1024 * 1024);
            pg8::Gemm g{M8, M8, M8, WO8, nullptr, nullptr, 512, 512, 512};
            pg8::StaticOrder S; S.init(NTOK, 1024, F.G, fresh_bid());
            if (l == 0) { EpiResid<true> E{false, INP(0), WSP(bf16, WS_XB0), WSP(bf16, WS_XB1), WSP(float, WS_MOD) + (size_t)l * 4 * 6144 + 2 * 1024, F.ctl + CW_RM + l * NTOK, WSP(float, WS_SWO) + l * 1024};
                pg8::gemm_phase<EpiResid<true>, pg8::StaticOrder, true, false, false, true>(F.lds + RING_OFF, g, S, E, fresh(F).tid); }
            else { EpiResid<false> E{false, nullptr, WSP(bf16, WS_XB0), WSP(bf16, WS_XB1), WSP(float, WS_MOD) + (size_t)l * 4 * 6144 + 2 * 1024, F.ctl + CW_RM + l * NTOK, WSP(float, WS_SWO) + l * 1024};
                pg8::gemm_phase<EpiResid<false>, pg8::StaticOrder, true, false, false, true>(F.lds + RING_OFF, g, S, E, fresh(F).tid); }
            SEAM(pb + 5);
        }
        if (EN(8) && IN(pb + 6)) { if (REP_R & 2) router_phase(F, args, l, 2 + l); router_phase(F, args, l, l); SEAM(pb + 6); }
        if (EN(10) && IN(pb + 7)) {
            moe_tilebase(F, args, l);
            const pg8::bf16_t* U2I = (const pg8::bf16_t*)(args.ws + WS_U); const pg8::bf16_t* WGI = (const pg8::bf16_t*)(args.ws + WS_WG1);
            pg8::Gemm g{U2I, U2I, U2I, WGI, nullptr, nullptr, 512, 512, 512};
            pg8::MoeOrder S{(const LAS int*)(F.lds + MISC_OFF + 64), F.G, fresh_bid()};
            LAS int* rowmap = (LAS int*)(F.lds + XTRA_OFF);
            moe_rowmaps(F, args, S, rowmap);
            LAS float* sgt = (LAS float*)(F.lds + XTRA_OFF + 16384);
            { const Frame Fs = fresh(F);
#pragma unroll
              for (int q = 0; q < 4; ++q) { const int i = Fs.tid + 512 * q; sgt[i] = __builtin_amdgcn_rcpf(1.0f + __expf(16.0f - ((float)i + 0.5f) * (1.0f / 64.0f))); }
              __syncthreads(); }
            EpiSwiGLU E{false, WSP(bf16, WS_H), sgt, (const LAS float*)(rowmap + 2048), WSP(float, WS_SWE), (LAS float*)(F.lds + XTRA_OFF + 24576)};
            for (int rep = 0; rep < 1 + (REP_GS & 8 ? REP_G : 0); ++rep) pg8::gemm_phase<EpiSwiGLU, pg8::MoeOrder, true, true, false, true>(F.lds + RING_OFF, g, S, E, fresh(F).tid, rowmap);
            SEAM(pb + 7);
        }
        if (EN(11) && IN(pb + 8)) {
            moe_tilebase(F, args, l);
            const bf16* H = WSP(bf16, WS_H);
            pg8::Gemm g{H, H, H, WSP(bf16, WS_WD), nullptr, nullptr, 512, 512, 512};
            pg8::MoeOrder S{(const LAS int*)(F.lds + MISC_OFF + 64), F.G, fresh_bid()};
            EpiYE E{false, PROJ};
            for (int rep = 0; rep < 1 + (REP_GS & 16 ? REP_G : 0); ++rep) pg8::gemm_phase<EpiYE, pg8::MoeOrder, true>(F.lds + RING_OFF, g, S, E, fresh(F).tid);
            SEAM(pb + 8);
        }
    };
    static_assert(DEPTH == 2, "layers"); layer(0); layer(1);
    if (EN(12) && IN(N_PHASES - 1)) rows_phase<2>(F, args, DEPTH);
#undef IN
#undef SEAM
}

#ifndef MK_MODE
#define MK_MODE 0
#endif
extern "C" void kernel_launch(void* const* d_in, const int* in_sizes, int n_in, void* d_out, int out_size, void* d_ws, size_t ws_size, hipStream_t stream) {
    static int grid = 0;
    if (grid == 0) {
        if (n_in != 27 || in_sizes[0] != NTOK * D || out_size != NTOK * D || ws_size < WS_END) { fprintf(stderr, "kernel_launch: unexpected shapes (n_in %d, in0 %d, out %d, ws %zu < %zu)\n", n_in, n_in > 0 ? in_sizes[0] : -1, out_size, ws_size, (size_t)WS_END); grid = -1; return; }
        int dev = 0, cus = 0;
        if (hipGetDevice(&dev) != hipSuccess || hipDeviceGetAttribute(&cus, hipDeviceAttributeMultiprocessorCount, dev) != hipSuccess) { grid = -1; return; }
        if (hipFuncSetAttribute((const void*)mega_fwd, hipFuncAttributeMaxDynamicSharedMemorySize, LDS_BYTES) != hipSuccess) { fprintf(stderr, "kernel_launch: hipFuncSetAttribute failed\n"); grid = -1; return; }
        (void)hipGetLastError();
        grid = cus;
    }
    if (grid < 0) return;
    if (hipMemsetAsync((char*)d_ws + WS_CTL, 0, CTL_ZERO_BYTES, stream) != hipSuccess) return;
    Args a{};
    for (int i = 0; i < 27; ++i) a.in[i] = (const float*)d_in[i];
    a.out = (float*)d_out; a.ws = (unsigned char*)d_ws;
#if MK_MODE == 0
    a.ph_lo = 0; a.ph_hi = N_PHASES;
    hipLaunchKernelGGL(mega_fwd, dim3(grid), dim3(NWAVES * 64), LDS_BYTES, stream, a, 0);
#else
    for (int p = 0; p < N_PHASES; ++p) { a.ph_lo = p; a.ph_hi = p + 1; hipLaunchKernelGGL(mega_fwd, dim3(grid), dim3(NWAVES * 64), LDS_BYTES, stream, a, 0); }
#endif
}
```
